# Optimizing an MI355X kernel written in HIP

```python
import math
import jax, jax.numpy as jnp
from jax import lax
import numpy as np

D_MODEL = 1024
BATCH = 1
SEQ = 16384
DEPTH = 4
DEC_BATCH = 16
DEC_SEQ = 2048
PAST_LEN = 128

EPS = 1e-6
NEG_INF = -1e30
N_MOD = 6
N_BRANCH = 4
A_GROUPS = 4
A_GROUP_W = 192
A_W = A_GROUPS * A_GROUP_W
B_PAIRS = ((128, 1), (512, 4), (2048, 16))
B_N_GROUPS = 3
B_HEADS_PER_GROUP = 2
B_HEADS = B_N_GROUPS * B_HEADS_PER_GROUP
B_HEAD_DIM = 64
B_QKV_W = B_HEADS * B_HEAD_DIM
B_OUT_W = B_HEADS_PER_GROUP * B_HEAD_DIM
REL_BUCKETS = 32
REL_MAX_DIST = 1024
C_HEADS = 4
C_HEAD_W = 96
C_W = C_HEADS * C_HEAD_W
C_CHUNK = 128
D_HEADS = 4
D_Q_LORA = 384
D_KV_LORA = 320
D_NOPE = 64
D_ROPE = 32
D_V = 64
D_OUT_W = D_HEADS * D_V
D_QBLK = 128
ROPE_THETA = 10000.0
IN_SPLITS = (A_W, B_QKV_W, B_QKV_W, B_QKV_W, C_W, C_W, D_Q_LORA, D_KV_LORA, D_ROPE, N_BRANCH * D_MODEL)
MIX_W = A_W + 3 * B_QKV_W + 2 * C_W + D_Q_LORA + D_KV_LORA + D_ROPE
IN_W = MIX_W + N_BRANCH * D_MODEL
D_FF = 4 * D_MODEL

kernel_name = "hybrid_bidir_encoder_fnet_longnet_gmlp_mla"


def _rmsnorm(x, g):
    xf = x.astype(jnp.float32)
    y = xf * lax.rsqrt(jnp.mean(xf * xf, axis=-1, keepdims=True) + EPS)
    return (y * g.astype(jnp.float32)).astype(x.dtype)


def _layernorm(x, g, b):
    xf = x.astype(jnp.float32)
    mu = jnp.mean(xf, axis=-1, keepdims=True)
    xc = xf - mu
    y = xc * lax.rsqrt(jnp.mean(xc * xc, axis=-1, keepdims=True) + EPS)
    return (y * g.astype(jnp.float32) + b.astype(jnp.float32)).astype(x.dtype)


def _split_points():
    return np.cumsum(np.array(IN_SPLITS))[:-1].tolist()


def _t5_bucket(rel):
    half = REL_BUCKETS // 2
    max_exact = half // 2
    ret = jnp.where(rel > 0, half, 0)
    n = jnp.abs(rel)
    large = max_exact + (jnp.log(jnp.maximum(n, max_exact).astype(jnp.float32) / max_exact)
                         / math.log(REL_MAX_DIST / max_exact) * (half - max_exact)).astype(jnp.int32)
    large = jnp.minimum(large, half - 1)
    return ret + jnp.where(n < max_exact, n, large)


def _rope(x, pos):
    half = D_ROPE // 2
    inv = ROPE_THETA ** (-jnp.arange(half, dtype=jnp.float32) / half)
    ang = pos[:, None].astype(jnp.float32) * inv[None, :]
    cos = jnp.cos(ang)[:, None, :]
    sin = jnp.sin(ang)[:, None, :]
    xf = x.astype(jnp.float32)
    x1, x2 = xf[..., :half], xf[..., half:]
    return jnp.concatenate([x1 * cos - x2 * sin, x1 * sin + x2 * cos], axis=-1).astype(x.dtype)


def _fourier_mix(a):
    B, S, _ = a.shape
    ag = a.reshape(B, S, A_GROUPS, A_GROUP_W).astype(jnp.float32)
    f = jnp.fft.fft2(ag, axes=(1, 3), norm="ortho").real
    return f.reshape(B, S, A_W).astype(a.dtype)


def _dilated_group(q, k, v, bias_table, dil, half):
    B, S, H, hd = q.shape
    L = S // dil
    N = B * dil
    blk = half
    nb = -(-L // blk)
    Lp = nb * blk

    def to_sub(t):
        return t.reshape(B, L, dil, H, hd).transpose(0, 2, 1, 3, 4).reshape(N, L, H, hd)

    def windows(t):
        tp = jnp.pad(to_sub(t), ((0, 0), (blk, Lp - L + blk), (0, 0), (0, 0))).reshape(N, nb + 2, blk, H, hd)
        return jnp.concatenate([tp[:, :-2], tp[:, 1:-1], tp[:, 2:]], axis=2)

    qs = jnp.pad(to_sub(q), ((0, 0), (0, Lp - L), (0, 0), (0, 0))).reshape(N, nb, blk, H, hd)
    kw = windows(k)
    vw = windows(v)
    qi = jnp.arange(blk)
    ki = jnp.arange(3 * blk)
    rel = ki[None, :] - blk - qi[:, None]
    band = jnp.abs(rel) <= half
    kpos = jnp.arange(nb)[:, None] * blk - blk + ki[None, :]
    kvalid = (kpos >= 0) & (kpos < L)
    mask = band[None, :, :] & kvalid[:, None, :]
    bias = jnp.transpose(bias_table[_t5_bucket(rel * dil)], (2, 0, 1)).astype(jnp.float32)
    s = jnp.einsum('nbqhd,nbkhd->nbhqk', qs, kw, preferred_element_type=jnp.float32) * (hd ** -0.5) + bias
    s = jnp.where(mask[None, :, None], s, NEG_INF)
    lse = jax.nn.logsumexp(s, axis=-1)
    p = jnp.exp(s - lse[..., None])
    o = jnp.einsum('nbhqk,nbkhd->nbqhd', p.astype(v.dtype), vw)
    o = o.reshape(N, Lp, H, hd)[:, :L]
    lse = lse.transpose(0, 1, 3, 2).reshape(N, Lp, H)[:, :L]
    o = o.reshape(B, dil, L, H, hd).transpose(0, 2, 1, 3, 4).reshape(B, S, H, hd)
    lse = lse.reshape(B, dil, L, H).transpose(0, 2, 1, 3).reshape(B, S, H)
    return o, lse


def _dilated_attention(q, k, v, rel_bias):
    B, S, _ = q.shape
    shp = (B, S, B_N_GROUPS, B_HEADS_PER_GROUP, B_HEAD_DIM)
    q, k, v = q.reshape(shp), k.reshape(shp), v.reshape(shp)
    outs, lses = [], []
    for g, (window, dil) in enumerate(B_PAIRS):
        hs = slice(g * B_HEADS_PER_GROUP, (g + 1) * B_HEADS_PER_GROUP)
        o, l = _dilated_group(q[:, :, g], k[:, :, g], v[:, :, g], rel_bias[:, hs], dil, window // (2 * dil))
        outs.append(o)
        lses.append(l)
    o = jnp.stack(outs).astype(jnp.float32)
    alpha = jax.nn.softmax(jnp.stack(lses), axis=0)
    out = jnp.sum(alpha[..., None] * o, axis=0)
    return out.reshape(B, S, B_OUT_W).astype(q.dtype)


def _spatial_gating(u, v, ln_g, ln_b, w_s, b_s):
    B, S, _ = u.shape
    vn = _layernorm(v, ln_g, ln_b)
    vc = vn.reshape(B, S // C_CHUNK, C_CHUNK, C_HEADS, C_HEAD_W)
    mixed = jnp.einsum('hpq,bnqhc->bnphc', w_s, vc) + b_s.T[:, :, None]
    return u * mixed.reshape(B, S, C_W).astype(u.dtype)


def _mla(cq, ckv, kr, q_norm_g, kv_norm_g, w_uq, w_ukv):
    B, S, _ = cq.shape
    pos = jnp.arange(S)
    q = (_rmsnorm(cq, q_norm_g) @ w_uq).reshape(B, S, D_HEADS, D_NOPE + D_ROPE)
    kv = (_rmsnorm(ckv, kv_norm_g) @ w_ukv).reshape(B, S, D_HEADS, D_NOPE + D_V)
    q_nope = q[..., :D_NOPE]
    q_pe = _rope(q[..., D_NOPE:], pos)
    k_nope = kv[..., :D_NOPE]
    v = kv[..., D_NOPE:]
    k_pe = _rope(kr[:, :, None, :], pos)[:, :, 0]
    scale = (D_NOPE + D_ROPE) ** -0.5
    nqb = S // D_QBLK

    def blocks(t):
        return t.reshape(B, nqb, D_QBLK, t.shape[2], t.shape[3]).swapaxes(0, 1)

    def attend(qb):
        qn, qp = qb
        s = (jnp.einsum('bqhd,bkhd->bhqk', qn, k_nope, preferred_element_type=jnp.float32)
             + jnp.einsum('bqhr,bkr->bhqk', qp, k_pe, preferred_element_type=jnp.float32)) * scale
        p = jax.nn.softmax(s, axis=-1)
        return jnp.einsum('bhqk,bkhd->bqhd', p.astype(v.dtype), v)

    o = lax.map(attend, (blocks(q_nope), blocks(q_pe)))
    return o.swapaxes(0, 1).reshape(B, S, D_OUT_W)


def _layer(x, c, rel_bias, ada_w, ada_b, norm1_g, w_in, q_norm_g, kv_norm_g, w_uq, w_ukv,
           sgu_ln_g, sgu_ln_b, sgu_w, sgu_b, p_a, p_b, p_c, p_d, w_o, norm2_g, w1, w2):
    B, S, D = x.shape
    mod = (jax.nn.silu(c) @ ada_w + ada_b)[:, None, :]
    sh1, sc1, gt1, sh2, sc2, gt2 = jnp.split(mod, N_MOD, axis=-1)
    h = _rmsnorm(x, norm1_g) * (1 + sc1) + sh1
    z = h @ w_in
    za, bq, bk, bv, cu, cv, dcq, dckv, dkr, zg = jnp.split(z, _split_points(), axis=-1)
    ya = _fourier_mix(za) @ p_a
    yb = _dilated_attention(bq, bk, bv, rel_bias) @ p_b
    yc = _spatial_gating(cu, cv, sgu_ln_g, sgu_ln_b, sgu_w, sgu_b) @ p_c
    yd = _mla(dcq, dckv, dkr, q_norm_g, kv_norm_g, w_uq, w_ukv) @ p_d
    g = jax.nn.sigmoid(zg).reshape(B, S, N_BRANCH, D)
    merged = g[:, :, 0] * ya + g[:, :, 1] * yb + g[:, :, 2] * yc + g[:, :, 3] * yd
    x = x + gt1 * (merged @ w_o)
    h = _rmsnorm(x, norm2_g) * (1 + sc2) + sh2
    x = x + gt2 * (jnp.square(jax.nn.relu(h @ w1)) @ w2)
    return x


def setup_inputs(seed: int = 0) -> dict:
    key = jax.random.key(seed)
    ks = jax.random.split(key, 32)
    f32 = jnp.float32

    def nrm(k, shape, fan_in, scale=1.0):
        return jax.random.normal(k, shape, f32) * (scale * fan_in ** -0.5)

    def gain(k, shape):
        return 1.0 + 0.05 * jax.random.normal(k, shape, f32)

    D = D_MODEL
    return {
        "x_prompt": jax.random.normal(ks[0], (BATCH, SEQ, D), f32),
        "x_sample": jax.random.normal(ks[1], (DEC_BATCH, DEC_SEQ, D), f32),
        "c_prompt": jax.random.normal(ks[2], (BATCH, D), f32),
        "c_sample": jax.random.normal(ks[3], (DEC_BATCH, D), f32),
        "rel_bias": 0.1 * jax.random.normal(ks[4], (REL_BUCKETS, B_HEADS), f32),
        "ada_w": nrm(ks[5], (DEPTH, D, N_MOD * D), D, 0.5),
        "ada_b": 0.02 * jax.random.normal(ks[6], (DEPTH, N_MOD * D), f32),
        "norm1_g": gain(ks[7], (DEPTH, D)),
        "w_in": nrm(ks[8], (DEPTH, D, IN_W), D),
        "mla_q_norm_g": gain(ks[9], (DEPTH, D_Q_LORA)),
        "mla_kv_norm_g": gain(ks[10], (DEPTH, D_KV_LORA)),
        "mla_w_uq": nrm(ks[11], (DEPTH, D_Q_LORA, D_HEADS * (D_NOPE + D_ROPE)), D_Q_LORA),
        "mla_w_ukv": nrm(ks[12], (DEPTH, D_KV_LORA, D_HEADS * (D_NOPE + D_V)), D_KV_LORA),
        "sgu_ln_g": gain(ks[13], (DEPTH, C_W)),
        "sgu_ln_b": 0.02 * jax.random.normal(ks[14], (DEPTH, C_W), f32),
        "sgu_w": nrm(ks[15], (DEPTH, C_HEADS, C_CHUNK, C_CHUNK), C_CHUNK),
        "sgu_b": gain(ks[16], (DEPTH, C_HEADS, C_CHUNK)),
        "p_a": nrm(ks[17], (DEPTH, A_W, D), A_W),
        "p_b": nrm(ks[18], (DEPTH, B_OUT_W, D), B_OUT_W),
        "p_c": nrm(ks[19], (DEPTH, C_W, D), C_W),
        "p_d": nrm(ks[20], (DEPTH, D_OUT_W, D), D_OUT_W),
        "w_o": nrm(ks[21], (DEPTH, D, D), D),
        "norm2_g": gain(ks[22], (DEPTH, D)),
        "mlp_w1": nrm(ks[23], (DEPTH, D, D_FF), D),
        "mlp_w2": nrm(ks[24], (DEPTH, D_FF, D), D_FF),
        "final_g": gain(ks[25], (D,)),
    }


def reference(x_prompt, x_sample, c_prompt, c_sample, rel_bias, ada_w, ada_b, norm1_g, w_in,
              mla_q_norm_g, mla_kv_norm_g, mla_w_uq, mla_w_ukv, sgu_ln_g, sgu_ln_b, sgu_w, sgu_b,
              p_a, p_b, p_c, p_d, w_o, norm2_g, mlp_w1, mlp_w2, final_g):
    def run(x, c):
        for l in range(DEPTH):
            x = _layer(x, c, rel_bias, ada_w[l], ada_b[l], norm1_g[l], w_in[l],
                       mla_q_norm_g[l], mla_kv_norm_g[l], mla_w_uq[l], mla_w_ukv[l],
                       sgu_ln_g[l], sgu_ln_b[l], sgu_w[l], sgu_b[l],
                       p_a[l], p_b[l], p_c[l], p_d[l], w_o[l], norm2_g[l], mlp_w1[l], mlp_w2[l])
        return _rmsnorm(x, final_g)

    y_prompt = run(x_prompt, c_prompt)
    y_sample = run(x_sample, c_sample)
    return (y_prompt, y_sample)
```

```cpp
#include <hip/hip_runtime.h>
#include <hip/hip_cooperative_groups.h>
#include <stdint.h>
#include <stdio.h>
namespace cg = cooperative_groups;

#define DI __device__ __forceinline__
#define LAS __attribute__((address_space(3)))
typedef unsigned short u16;
typedef __attribute__((ext_vector_type(8))) short bf16x8;
typedef __attribute__((ext_vector_type(4))) short bf16x4;
typedef __attribute__((ext_vector_type(16))) float f32x16;
typedef __attribute__((ext_vector_type(4))) float f32x4;
typedef __attribute__((ext_vector_type(4))) unsigned u32x4;
typedef __attribute__((ext_vector_type(2))) unsigned u32x2;
typedef __attribute__((ext_vector_type(2))) __bf16 bf2_t;

constexpr int TB = 16384;
constexpr int TBP = TB + 64;
constexpr int NW = 8288;
constexpr int NWP = 8320;
constexpr int LDT = 72;
constexpr int TILE_ELEMS = 128 * LDT;
constexpr int GEMM_SMEM = 4 * TILE_ELEMS * 2;
constexpr int SMEM_BYTES = 131072;
#ifndef PROBE
#define PROBE 0
#endif
constexpr int NTH = 512;
constexpr int HT = 128 * 64;
constexpr float LOG2E = 1.4426950408889634f;
constexpr float LN2 = 0.6931471805599453f;

struct Prm {
  const float *x_prompt, *x_sample, *c_prompt, *c_sample, *rel_bias, *ada_w, *ada_b, *norm1_g, *w_in,
      *qn_g, *kvn_g, *w_uq, *w_ukv, *ln_g, *ln_b, *sgu_w, *sgu_b, *p_a, *p_b, *p_c, *p_d, *w_o,
      *norm2_g, *w1, *w2, *final_g;
  float* out;
  u16 *WinT, *W1T, *W2T, *WoT, *PaT, *PbT, *PcT, *PdT, *WqT, *WkvT, *SgW, *M1a, *M1b, *M2;
  float2 *tw, *rope;
  float *biasT, *mod, *modpart;
  u16 *hbuf, *UT, *Gp, *bqkv, *ob, *cu, *cvT, *dcq, *dckv, *qc, *kc, *vT, *od, *zg;
  float *og, *lse;
  unsigned* bar;
};

DI unsigned pack2(float a, float b) { bf2_t v; v[0] = (__bf16)a; v[1] = (__bf16)b; return __builtin_bit_cast(unsigned, v); }
DI u16 f2bf(float a) { return __builtin_bit_cast(u16, (__bf16)a); }
DI float bf2f(u16 v) { return __uint_as_float(((unsigned)v) << 16); }
DI float bflo(unsigned w) { return __uint_as_float(w << 16); }
DI float bfhi(unsigned w) { return __uint_as_float(w & 0xffff0000u); }
DI void st4bf(u16* dst, float a, float b, float c, float d) { u32x2 v; v[0] = pack2(a, b); v[1] = pack2(c, d); *(u32x2*)dst = v; }
DI void st4bf_nt(u16* dst, float a, float b, float c, float d) { u32x2 v; v[0] = pack2(a, b); v[1] = pack2(c, d); __builtin_nontemporal_store(v, (u32x2*)dst); }
DI int rowmap(int r, int lh) { return (r & 3) + 8 * (r >> 2) + 4 * lh; }
DI f32x16 mfma(bf16x8 a, bf16x8 b, f32x16 c) { return __builtin_amdgcn_mfma_f32_32x32x16_bf16(a, b, c, 0, 0, 0); }
DI u32x4 zero4() { u32x4 z; z[0] = 0; z[1] = 0; z[2] = 0; z[3] = 0; return z; }
DI f32x16 zero16() { f32x16 z; for (int i = 0; i < 16; ++i) z[i] = 0.f; return z; }
DI float ex2(float x) { return __builtin_amdgcn_exp2f(x); }
DI int tidx() { int t = threadIdx.x; asm volatile("" : "+v"(t)); return t; }


#define XB_TMO      128
#define XB_XCNT(j)  (256  + 64 * (j))
#define XB_XSUB(j)  (1280 + 64 * (j))
#define XB_XGEN(j)  (2304 + 64 * (j))
#define XB_TOP      3328
#define XB_TOPGEN   3392
#define XCD_BAR_WORDS 3456
#define XB_SPIN_CAP (1u << 18)
DI unsigned xb_ld(unsigned* p) { return __hip_atomic_load(p, __ATOMIC_RELAXED, __HIP_MEMORY_SCOPE_AGENT); }
DI unsigned xb_add(unsigned* p, unsigned v) { return __hip_atomic_fetch_add(p, v, __ATOMIC_RELAXED, __HIP_MEMORY_SCOPE_AGENT); }
DI unsigned xb_xcc_id() { return (unsigned)__builtin_amdgcn_s_getreg((3 << 11) | 20) & 0xFu; }
#define XB_SPIN(cond, bar) do { unsigned _sp = 0; while (cond) { __builtin_amdgcn_s_sleep(1); \
    if ((++_sp & 255u) == 0u) { if (xb_ld(&(bar)[XB_TMO])) break; if (_sp > XB_SPIN_CAP) { atomicAdd(&(bar)[XB_TMO], 1u); break; } } } } while (0)
struct XcdBarrier { unsigned* bar; unsigned x; volatile LAS unsigned* st; };
DI XcdBarrier xcd_barrier_post(unsigned* bar, volatile LAS unsigned* st) {
  XcdBarrier b; b.bar = bar; b.x = xb_xcc_id(); b.st = st;
  if (threadIdx.x == 0) (void)xb_add(&bar[XB_XCNT(b.x)], 1u);
  return b;
}
DI void xcd_barrier_complete(unsigned* bar, unsigned x, unsigned& nloc, unsigned& nx) {
  const unsigned G = gridDim.x * gridDim.y * gridDim.z;
  unsigned sum, cnt, mine, sp = 0u;
  for (;;) {
    sum = 0u; cnt = 0u; mine = 0u;
#pragma unroll
    for (unsigned j = 0; j < 16; ++j) { const unsigned c = xb_ld(&bar[XB_XCNT(j)]); sum += c; cnt += (c > 0u) ? 1u : 0u; mine = (j == x) ? c : mine; }
    if (sum == G) break;
    __builtin_amdgcn_s_sleep(1);
    if ((++sp & 255u) == 0u) { if (xb_ld(&bar[XB_TMO])) break; if (sp > XB_SPIN_CAP) { atomicAdd(&bar[XB_TMO], 1u); break; } }
  }
  nloc = mine > 0u ? mine : 1u; nx = cnt > 0u ? cnt : 1u;
}
DI void xcd_barrier(const XcdBarrier& b) {
  asm volatile("s_waitcnt vmcnt(0)" ::: "memory");
  __syncthreads();
  if (tidx() == 0) {
    unsigned* bar = b.bar;
    const unsigned bx = (unsigned)__builtin_amdgcn_readfirstlane((int)xb_xcc_id());
    __builtin_amdgcn_s_waitcnt(0);
    unsigned nloc = b.st[0], nx = b.st[1];
    if (nloc == 0u) { xcd_barrier_complete(bar, bx, nloc, nx); b.st[0] = nloc; b.st[1] = nx; }
    const unsigned old = xb_add(&bar[XB_XSUB(bx)], 1u);
    const unsigned gen = old / nloc;
    if (old + 1u == (gen + 1u) * nloc) {
      __builtin_amdgcn_fence(__ATOMIC_RELEASE, "agent");
      asm volatile("s_waitcnt vmcnt(0)" ::: "memory");
      const unsigned og = xb_add(&bar[XB_TOP], 1u);
      const unsigned tg = og / nx;
      if (og + 1u == (tg + 1u) * nx) xb_add(&bar[XB_TOPGEN], 1u);
      else XB_SPIN(xb_ld(&bar[XB_TOPGEN]) == tg, bar);
      __builtin_amdgcn_fence(__ATOMIC_ACQUIRE, "agent");
      xb_add(&bar[XB_XGEN(bx)], 1u);
      asm volatile("s_waitcnt vmcnt(0)" ::: "memory");
    } else {
      XB_SPIN(xb_ld(&bar[XB_XGEN(bx)]) == gen, bar);
      __builtin_amdgcn_fence(__ATOMIC_ACQUIRE, "agent");
      asm volatile("s_waitcnt vmcnt(0)" ::: "memory");
    }
  }
  __syncthreads();
}

#define TASK_LOOP(t, nt, base) for (int t = (int)((blockIdx.x + gridDim.x - ((unsigned)(base) % gridDim.x)) % gridDim.x); t < (nt); t += gridDim.x)

template <bool RFA, bool RFB, class LA, class LB, class EPI>
DI void gemm_tile(u16* smem, int nk, LA la, LB lb, EPI epi) {
  const int tid = tidx(), lane = tid & 63, wave = tid >> 6;
  const int wm = wave >> 2, wn = wave & 3, lr = lane & 31, lh = lane >> 5;
  u16* As = smem;
  u16* Bs = smem + 2 * TILE_ELEMS;
  f32x16 acc[2];
  acc[0] = zero16(); acc[1] = zero16();
  u32x4 ra[2], rb[2];
#define A_ROW(c) (RFA ? ((c) & 127) : ((c) >> 3))
#define A_KC(c) (RFA ? ((c) >> 7) : ((c) & 7))
#define B_ROW(c) (RFB ? ((c) & 127) : ((c) >> 3))
#define B_KC(c) (RFB ? ((c) >> 7) : ((c) & 7))
#pragma unroll
  for (int i = 0; i < 2; ++i) { const int c = tid + NTH * i; ra[i] = la(A_ROW(c), A_KC(c) * 8); rb[i] = lb(B_ROW(c), B_KC(c) * 8); }
#pragma unroll
  for (int i = 0; i < 2; ++i) {
    const int c = tid + NTH * i;
    *(u32x4*)(As + A_ROW(c) * LDT + A_KC(c) * 8) = ra[i];
    *(u32x4*)(Bs + B_ROW(c) * LDT + B_KC(c) * 8) = rb[i];
  }
  __syncthreads();
  for (int kt = 0; kt < nk; ++kt) {
    const int buf = kt & 1;
    if (kt + 1 < nk) {
      const int k0 = (kt + 1) * 64;
#pragma unroll
      for (int i = 0; i < 2; ++i) { const int c = tid + NTH * i; ra[i] = la(A_ROW(c), k0 + A_KC(c) * 8); rb[i] = lb(B_ROW(c), k0 + B_KC(c) * 8); }
    }
    const u16* Ab = As + buf * TILE_ELEMS + (wm * 64 + lr) * LDT + lh * 8;
    const u16* Bb = Bs + buf * TILE_ELEMS + (wn * 32 + lr) * LDT + lh * 8;
#pragma unroll
    for (int ks = 0; ks < 4; ++ks) {
      const bf16x8 a0 = *(const bf16x8*)(Ab + ks * 16);
      const bf16x8 a1 = *(const bf16x8*)(Ab + 32 * LDT + ks * 16);
      const bf16x8 b = *(const bf16x8*)(Bb + ks * 16);
      acc[0] = mfma(a0, b, acc[0]);
      acc[1] = mfma(a1, b, acc[1]);
    }
    if (kt + 1 < nk) {
      u16* Aw = As + (buf ^ 1) * TILE_ELEMS;
      u16* Bw = Bs + (buf ^ 1) * TILE_ELEMS;
#pragma unroll
      for (int i = 0; i < 2; ++i) {
        const int c = tid + NTH * i;
        *(u32x4*)(Aw + A_ROW(c) * LDT + A_KC(c) * 8) = ra[i];
        *(u32x4*)(Bw + B_ROW(c) * LDT + B_KC(c) * 8) = rb[i];
      }
    }
    __syncthreads();
  }
  epi(acc, wm, wn, lane);
}

DI void stage_rc(int b, int& R, int& C) { int st = b / 1024, sb = b % 1024, swz = sb ^ (((sb >> 9) & 1) << 5); R = (st >> 1) * 16 + swz / 64; C = (st & 1) * 32 + (swz % 64) / 2; }

template <class EPI>
DI void gemm256(LAS u16* shm, const u16* __restrict__ A, const u16* __restrict__ Bt, int K, int brow, int bcol, bool pre, bool has_next, int nbrow, int nbcol, EPI epi) {
#define SA(b, h) (shm + ((b) * 2 + (h)) * HT)
#define SB(b, h) (shm + (4 + (b) * 2 + (h)) * HT)
  const int tid = tidx();
  const int wid = __builtin_amdgcn_readfirstlane(tid >> 6), lane = tid & 63, wr = wid >> 2, wc = wid & 3, fr = lane & 15, fq = lane >> 4;
  int r0, c0, r1, c1;
  stage_rc(tid * 16, r0, c0);
  stage_rc(tid * 16 + 8192, r1, c1);
  const unsigned so0 = (unsigned)(r0 * K + c0) * 2u, so1 = (unsigned)(r1 * K + c1) * 2u;
  const unsigned ldsw = (unsigned)wid * 1024u;
  const int lb = ((fr * 64 + fq * 16) ^ ((fr >> 3) << 5));
#define STAGE(P, BASE, br, kt) do { const char* _g = (const char*)((BASE) + (size_t)(br) * K + (kt) * 64); \
    __builtin_amdgcn_global_load_lds((const unsigned*)(_g + so0), (LAS unsigned*)((LAS char*)(P) + ldsw), 16, 0, 0); \
    __builtin_amdgcn_global_load_lds((const unsigned*)(_g + so1), (LAS unsigned*)((LAS char*)(P) + ldsw + 8192), 16, 0, 0); } while (0)
#define LDA(dst, b, h) _Pragma("unroll") for (int m = 0; m < 4; ++m) _Pragma("unroll") for (int k = 0; k < 2; ++k) \
    dst[m][k] = *(const LAS bf16x8*)((const LAS char*)SA(b, h) + ((wr * 4 + m) * 2 + k) * 1024 + lb)
#define LDB(dst, b, h) _Pragma("unroll") for (int n = 0; n < 2; ++n) _Pragma("unroll") for (int k = 0; k < 2; ++k) \
    dst[n][k] = *(const LAS bf16x8*)((const LAS char*)SB(b, h) + ((wc * 2 + n) * 2 + k) * 1024 + lb)
#define MMA(ai, bj, At_, Bt_) do { __builtin_amdgcn_s_setprio(1); \
    _Pragma("unroll") for (int m = 0; m < 4; ++m) _Pragma("unroll") for (int n = 0; n < 2; ++n) _Pragma("unroll") for (int k = 0; k < 2; ++k) \
      acc[ai][bj][m][n] = __builtin_amdgcn_mfma_f32_16x16x32_bf16(At_[m][k], Bt_[n][k], acc[ai][bj][m][n], 0, 0, 0); \
    __builtin_amdgcn_s_setprio(0); } while (0)
#define WAIT_V(n) asm volatile("s_waitcnt vmcnt(" #n ")" ::: "memory")
#define WAIT_L(n) asm volatile("s_waitcnt lgkmcnt(" #n ")" ::: "memory")
#define BAR __builtin_amdgcn_s_barrier()
#define SCHED __builtin_amdgcn_sched_barrier(0)
  f32x4 acc[2][2][4][2];
#pragma unroll
  for (int a = 0; a < 2; ++a)
#pragma unroll
    for (int b = 0; b < 2; ++b)
#pragma unroll
      for (int m = 0; m < 4; ++m)
#pragma unroll
        for (int n = 0; n < 2; ++n) { acc[a][b][m][n][0] = 0.f; acc[a][b][m][n][1] = 0.f; acc[a][b][m][n][2] = 0.f; acc[a][b][m][n][3] = 0.f; }
  bf16x8 At[4][2], B0[2][2], B1[2][2];
  const int nt = K / 64;
  if (!pre) {
    STAGE(SB(0, 0), Bt, bcol, 0); STAGE(SA(0, 0), A, brow, 0);
    STAGE(SB(0, 1), Bt, bcol + 128, 0); STAGE(SA(0, 1), A, brow + 128, 0);
  }
  if (wr == 1) BAR;
  WAIT_V(4); BAR;
  STAGE(SB(1, 0), Bt, bcol, 1); STAGE(SA(1, 0), A, brow, 1); STAGE(SB(1, 1), Bt, bcol + 128, 1);
  WAIT_V(6); BAR;
  for (int t = 0; t < nt - 2; t += 2) {
    LDB(B0, 0, 0); SCHED; LDA(At, 0, 0); STAGE(SA(1, 1), A, brow + 128, t + 1);
    WAIT_L(8); BAR; WAIT_L(0); MMA(0, 0, At, B0); BAR; SCHED;
    LDB(B1, 0, 1); STAGE(SB(0, 0), Bt, bcol, t + 2);
    BAR; WAIT_L(0); MMA(0, 1, At, B1); BAR;
    LDA(At, 0, 1); STAGE(SA(0, 0), A, brow, t + 2);
    BAR; WAIT_L(0); MMA(1, 0, At, B0); BAR; SCHED;
    STAGE(SB(0, 1), Bt, bcol + 128, t + 2);
    WAIT_V(6); BAR; MMA(1, 1, At, B1); BAR;
    LDB(B0, 1, 0); SCHED; LDA(At, 1, 0); STAGE(SA(0, 1), A, brow + 128, t + 2);
    WAIT_L(8); BAR; WAIT_L(0); MMA(0, 0, At, B0); BAR; SCHED;
    LDB(B1, 1, 1); STAGE(SB(1, 0), Bt, bcol, t + 3);
    BAR; WAIT_L(0); MMA(0, 1, At, B1); BAR;
    LDA(At, 1, 1); STAGE(SA(1, 0), A, brow, t + 3);
    BAR; WAIT_L(0); MMA(1, 0, At, B0); BAR; SCHED;
    STAGE(SB(1, 1), Bt, bcol + 128, t + 3);
    WAIT_V(6); BAR; MMA(1, 1, At, B1); BAR;
  }
  { LDB(B0, 0, 0); LDA(At, 0, 0); STAGE(SA(1, 1), A, brow + 128, nt - 1);
    BAR; WAIT_L(0); MMA(0, 0, At, B0); BAR;
    LDB(B1, 0, 1); BAR; WAIT_L(0); MMA(0, 1, At, B1); BAR;
    LDA(At, 0, 1); WAIT_V(4); BAR; WAIT_L(0); MMA(1, 0, At, B0); MMA(1, 1, At, B1); BAR; }
  { LDB(B0, 1, 0); LDA(At, 1, 0); WAIT_V(2); BAR; WAIT_L(0); MMA(0, 0, At, B0); BAR;
    LDB(B1, 1, 1); WAIT_V(0); BAR; WAIT_L(0); MMA(0, 1, At, B1); BAR;
    LDA(At, 1, 1); BAR; WAIT_L(0); MMA(1, 0, At, B0); MMA(1, 1, At, B1); BAR; }
  if (wr == 0) BAR;
  if (has_next) {
    STAGE(SB(0, 0), Bt, nbcol, 0); STAGE(SA(0, 0), A, nbrow, 0);
    STAGE(SB(0, 1), Bt, nbcol + 128, 0); STAGE(SA(0, 1), A, nbrow + 128, 0);
  }
  epi(acc, wr, wc, fr, fq);
  __syncthreads();
}

DI void map256(int t, int nN, int& tn, int& tm) {
  const int p = (t >> 8) * 8 + (t & 7), i = (t >> 3) & 31, pr = nN >> 2;
  const int pm = p / pr;
  tn = ((p + pm) % pr) * 4 + (i & 3);
  tm = pm * 8 + (i >> 2);
}

DI int condrow(int sb, int tok) { return sb == 0 ? 0 : 1 + (sb - 1) * 8 + (tok >> 11); }

DI void convT_tile(float* tile, const float* src, int lds_, int N, u16* dst, int ldd, const float* ksc, int k0, int n0) {
  const int tid = tidx();
#pragma unroll 4
  for (int e = 0; e < 8; ++e) {
    const int idx = tid + NTH * e, kk = idx >> 6, nn = idx & 63;
    float v = (n0 + nn < N) ? src[(size_t)(k0 + kk) * lds_ + n0 + nn] : 0.f;
    if (ksc) v *= ksc[k0 + kk];
    tile[kk * 65 + nn] = v;
  }
  __syncthreads();
#pragma unroll 4
  for (int e = 0; e < 4; ++e) {
    const int idx = tid + NTH * e, nn = idx >> 5, kp = idx & 31;
    if (n0 + nn < N)
      *(unsigned*)(dst + (size_t)(n0 + nn) * ldd + k0 + 2 * kp) = pack2(tile[(2 * kp) * 65 + nn], tile[(2 * kp + 1) * 65 + nn]);
  }
  __syncthreads();
}

DI void convT(float* tile, const float* src, int lds_, int K, int N, u16* dst, int ldd, const float* ksc, int& base) {
  const int ntn = (N + 63) >> 6, nt = (K >> 6) * ntn;
  TASK_LOOP(t, nt, base) {
    const int tn = t % ntn, tk = t / ntn;
    convT_tile(tile, src, lds_, N, dst, ldd, ksc, tk * 64, tn * 64);
  }
  base += nt;
}

DI void prologue_a(const Prm& p, unsigned char* smem_raw, int& base) {
  float* smf = (float*)smem_raw;
  const int tid = tidx();
  const int gtid = blockIdx.x * NTH + tid, gn = gridDim.x * NTH;
  for (int l = 0; l < 4; ++l) {
    convT(smf, p.w_in + (size_t)l * 1024 * 7520 + 768, 7520, 1024, 6752, p.WinT + ((size_t)l * NWP + 1536) * 1024, 1024, nullptr, base);
    convT(smf, p.w1 + (size_t)l * 1024 * 4096, 4096, 1024, 4096, p.W1T + (size_t)l * 4096 * 1024, 1024, nullptr, base);
    convT(smf, p.w2 + (size_t)l * 4096 * 1024, 1024, 4096, 1024, p.W2T + (size_t)l * 1024 * 4096, 4096, nullptr, base);
    convT(smf, p.w_o + (size_t)l * 1024 * 1024, 1024, 1024, 1024, p.WoT + (size_t)l * 1024 * 1024, 1024, nullptr, base);
    convT(smf, p.p_a + (size_t)l * 768 * 1024, 1024, 768, 1024, p.PaT + (size_t)l * 1024 * 768, 768, nullptr, base);
    convT(smf, p.p_b + (size_t)l * 128 * 1024, 1024, 128, 1024, p.PbT + (size_t)l * 1024 * 128, 128, nullptr, base);
    convT(smf, p.p_c + (size_t)l * 384 * 1024, 1024, 384, 1024, p.PcT + (size_t)l * 1024 * 384, 384, nullptr, base);
    convT(smf, p.p_d + (size_t)l * 256 * 1024, 1024, 256, 1024, p.PdT + (size_t)l * 1024 * 256, 256, nullptr, base);
    convT(smf, p.w_uq + (size_t)l * 384 * 384, 384, 384, 384, p.WqT + (size_t)l * 384 * 384, 384, p.qn_g + l * 384, base);
    convT(smf, p.w_ukv + (size_t)l * 320 * 512, 512, 320, 512, p.WkvT + (size_t)l * 512 * 320, 320, p.kvn_g + l * 320, base);
  }
  {
    float* wl = smf;
    float* tab = smf + 32 * 193;
    TASK_LOOP(t, 512, base) {
      const int kb = t & 31, g = (t >> 5) & 3, l = t >> 7, k0 = kb * 32;
      for (int idx = tid; idx < 32 * 192; idx += NTH) {
        const int kk = idx / 192, c = idx - kk * 192;
        wl[kk * 193 + c] = p.w_in[((size_t)l * 1024 + k0 + kk) * 7520 + g * 192 + c];
      }
      if (tid < 192) {
        float s, c;
        sincospif(2.f * (float)tid / 192.f, &s, &c);
        tab[tid] = c; tab[192 + tid] = s;
      }
      __syncthreads();
      for (int e = 0; e < 6; ++e) {
        const int idx = tid + NTH * e, kq = idx & 7, pj = idx >> 3;
        const int part = pj >= 192 ? 1 : 0, j = pj - part * 192;
        const float* tp = tab + part * 192;
        const float* w0 = wl + (kq * 4) * 193;
        float s0 = 0, s1 = 0, s2 = 0, s3 = 0;
        int m = 0;
        for (int c = 0; c < 192; ++c) {
          const float tv = tp[m];
          s0 += w0[c] * tv; s1 += w0[193 + c] * tv; s2 += w0[2 * 193 + c] * tv; s3 += w0[3 * 193 + c] * tv;
          m += j; if (m >= 192) m -= 192;
        }
        if (part) { s0 = -s0; s1 = -s1; s2 = -s2; s3 = -s3; }
        st4bf(p.WinT + ((size_t)l * NWP + part * 768 + g * 192 + j) * 1024 + k0 + kq * 4, s0, s1, s2, s3);
      }
      __syncthreads();
    }
    base += 512;
  }
  {
    float* sil = smf;
    TASK_LOOP(t, 384, base) {
      const int kc = t & 7, cb = (t >> 3) % 12, l = t / 96, k0 = kc * 128;
      for (int idx = tid; idx < 17 * 128; idx += NTH) {
        const int r = idx >> 7, kk = idx & 127;
        const float c = r == 0 ? p.c_prompt[k0 + kk] : p.c_sample[(r - 1) * 1024 + k0 + kk];
        sil[idx] = c / (1.f + __expf(-c));
      }
      __syncthreads();
      const int n = cb * 512 + tid;
      float acc[17];
#pragma unroll
      for (int r = 0; r < 17; ++r) acc[r] = 0.f;
      const float* wp = p.ada_w + ((size_t)l * 1024 + k0) * 6144 + n;
#pragma unroll 4
      for (int kk = 0; kk < 128; ++kk) {
        const float w = wp[(size_t)kk * 6144];
#pragma unroll
        for (int r = 0; r < 17; ++r) acc[r] += sil[r * 128 + kk] * w;
      }
#pragma unroll
      for (int r = 0; r < 17; ++r) p.modpart[((size_t)(kc * 4 + l) * 17 + r) * 6144 + n] = acc[r];
      __syncthreads();
    }
    base += 384;
  }
  for (int idx = gtid; idx < 4 * 32 * 1024; idx += gn) {
    const int l = idx >> 15, rem = idx & 32767;
    p.WinT[((size_t)l * NWP + NW) * 1024 + rem] = 0;
  }
  for (int idx = gtid; idx < 256 * 256; idx += gn) {
    const int row = idx >> 8, kk = idx & 255;
    const int po = row >> 7, k1 = row & 127, pi = kk >> 7, s1 = kk & 127;
    float s, c;
    sincospif(2.f * (float)((k1 * s1) & 127) / 128.f, &s, &c);
    const float v = (po == pi) ? c : (po == 0 ? s : -s);
    p.M1a[idx] = f2bf(v);
  }
  for (int idx = gtid; idx < 32 * 64; idx += gn) {
    const int row = idx >> 6, kk = idx & 63;
    const int po = row >> 4, k1 = row & 15, pi = (kk >> 4) & 1, s1 = kk & 15;
    float s, c;
    sincospif(2.f * (float)((k1 * s1) & 15) / 16.f, &s, &c);
    float v = (po == pi) ? c : (po == 0 ? s : -s);
    if (kk >= 32) v = 0.f;
    p.M1b[idx] = f2bf(v);
  }
  for (int idx = gtid; idx < 128 * 256; idx += gn) {
    const int k2 = idx >> 8, kk = idx & 255, part = kk >> 7, s2 = kk & 127;
    float s, c;
    sincospif(2.f * (float)((k2 * s2) & 127) / 128.f, &s, &c);
    p.M2[idx] = f2bf(part ? s : c);
  }
  for (int idx = gtid; idx < 16384; idx += gn) {
    float s, c;
    sincospif(2.f * (float)idx / 16384.f, &s, &c);
    p.tw[idx] = make_float2(c, s);
  }
  for (int idx = gtid; idx < 16384 * 16; idx += gn) {
    const int pos = idx >> 4, i = idx & 15;
    const float inv = (float)pow(10000.0, -(double)i / 16.0);
    const float ang = (float)pos * inv;
    double rev = (double)ang * 0.15915494309189535;
    rev -= rint(rev);
    float s, c;
    sincospif((float)(2.0 * rev), &s, &c);
    p.rope[idx] = make_float2(c, s);
  }
  for (int idx = gtid; idx < 6 * 129; idx += gn) {
    const int hd = idx / 129, rel = idx - hd * 129 - 64;
    const int dil = 1 << (2 * (hd >> 1));
    const int rd = rel * dil, n = rd < 0 ? -rd : rd;
    int b;
    if (n < 8) b = n;
    else if (n < 15) b = 8; else if (n < 27) b = 9; else if (n < 50) b = 10; else if (n < 91) b = 11;
    else if (n < 166) b = 12; else if (n < 305) b = 13; else if (n < 559) b = 14; else b = 15;
    if (rd > 0) b += 16;
    p.biasT[idx] = p.rel_bias[b * 6 + hd];
  }
  for (int idx = gtid; idx < 4 * 4 * 128 * 128; idx += gn) p.SgW[idx] = f2bf(p.sgu_w[idx]);
}

DI void prologue_b(const Prm& p) {
  const int gtid = blockIdx.x * NTH + tidx(), gn = gridDim.x * NTH;
  for (int idx = gtid; idx < 4 * 17 * 6144; idx += gn) {
    const int l = idx / (17 * 6144), n = idx % 6144;
    float s = p.ada_b[l * 6144 + n];
#pragma unroll
    for (int kc = 0; kc < 8; ++kc) s += p.modpart[(size_t)kc * 4 * 17 * 6144 + idx];
    p.mod[idx] = s;
  }
}

DI void phase_norm(const Prm& p, const float* xsrc, const float* g, const float* modl, int shoff, int scoff, int sb) {
  const int tid = tidx(), lane = tid & 63;
  const int gw = blockIdx.x * 8 + (tid >> 6), nw = gridDim.x * 8;
  for (int row = gw; row < TB; row += nw) {
    const int cond = condrow(sb, row);
    const float* xr = xsrc + (size_t)row * 1024;
    float4 v[4];
    float ss = 0.f;
#pragma unroll
    for (int i = 0; i < 4; ++i) {
      v[i] = *(const float4*)(xr + i * 256 + lane * 4);
      ss += v[i].x * v[i].x + v[i].y * v[i].y + v[i].z * v[i].z + v[i].w * v[i].w;
    }
#pragma unroll
    for (int off = 32; off >= 1; off >>= 1) ss += __shfl_xor(ss, off);
    const float rstd = rsqrtf(ss * (1.f / 1024.f) + 1e-6f);
    const float* sc = modl + cond * 6144 + scoff;
    const float* sh = modl + cond * 6144 + shoff;
#pragma unroll
    for (int i = 0; i < 4; ++i) {
      const int col = i * 256 + lane * 4;
      const float4 gg = *(const float4*)(g + col), s4 = *(const float4*)(sc + col), h4 = *(const float4*)(sh + col);
      st4bf(p.hbuf + (size_t)row * 1024 + col,
            v[i].x * rstd * gg.x * (1.f + s4.x) + h4.x, v[i].y * rstd * gg.y * (1.f + s4.y) + h4.y,
            v[i].z * rstd * gg.z * (1.f + s4.z) + h4.z, v[i].w * rstd * gg.w * (1.f + s4.w) + h4.w);
    }
  }
}

DI float sigm(float x) { return __builtin_amdgcn_rcpf(1.f + __expf(-x)); }

DI void phase_inproj(const Prm& p, unsigned char* smem_raw, int l, int S, int& base) {
  const u16* W = p.WinT + (size_t)l * NWP * 1024;
  LAS u16* shm = (LAS u16*)smem_raw;
  bool pre = false;
  TASK_LOOP(t, 32 * 64, base) {
    int tn, tm;
    map256(t, 32, tn, tm);
    const int brow = tn * 256, bcol = tm * 256;
    const int tnx = t + (int)gridDim.x;
    const bool has_next = tnx < (32 * 64);
    int tn2 = 0, tm2 = 0;
    if (has_next) map256(tnx, 32, tn2, tm2);
    const int nbrow = tn2 * 256, nbcol = tm2 * 256;
    auto epi = [&](f32x4 (&acc)[2][2][4][2], int wr, int wc, int fr, int fq) __attribute__((always_inline)) {
#pragma unroll
      for (int ai = 0; ai < 2; ++ai)
#pragma unroll
        for (int m = 0; m < 4; ++m) {
          const int nb = brow + ai * 128 + wr * 64 + m * 16;
#pragma unroll
          for (int bj = 0; bj < 2; ++bj)
#pragma unroll
            for (int n = 0; n < 2; ++n) {
              const int tok = bcol + bj * 128 + wc * 32 + n * 16 + fr;
              const f32x4 v = acc[ai][bj][m][n];
              const int nn = nb + fq * 4;
              if (nb < 1536) {
#pragma unroll
                for (int j = 0; j < 4; ++j) p.UT[(size_t)(nn + j) * TBP + tok] = f2bf(v[j]);
              } else if (nb < 2688) {
                st4bf(p.bqkv + (size_t)tok * 1152 + (nn - 1536), v[0], v[1], v[2], v[3]);
              } else if (nb < 3072) {
                st4bf(p.cu + (size_t)tok * 384 + (nn - 2688), v[0], v[1], v[2], v[3]);
              } else if (nb < 3456) {
#pragma unroll
                for (int j = 0; j < 4; ++j) p.cvT[(size_t)(nn - 3072 + j) * TBP + tok] = f2bf(v[j]);
              } else if (nb < 3840) {
                st4bf(p.dcq + (size_t)tok * 384 + (nn - 3456), v[0], v[1], v[2], v[3]);
              } else if (nb < 4160) {
                st4bf(p.dckv + (size_t)tok * 320 + (nn - 3840), v[0], v[1], v[2], v[3]);
              } else if (nb < 4192) {
                if (nb == 4160) {
                  const f32x4 v2 = acc[ai][bj][(m + 1) & 3][n];
                  const int pos = tok & (S - 1);
#pragma unroll
                  for (int j = 0; j < 4; ++j) {
                    const int ii = fq * 4 + j;
                    const float2 cs = p.rope[pos * 16 + ii];
                    const u16 o1 = f2bf(v[j] * cs.x - v2[j] * cs.y), o2 = f2bf(v[j] * cs.y + v2[j] * cs.x);
#pragma unroll
                    for (int hh = 0; hh < 4; ++hh) {
                      p.kc[(size_t)tok * 384 + hh * 96 + 64 + ii] = o1;
                      p.kc[(size_t)tok * 384 + hh * 96 + 80 + ii] = o2;
                    }
                  }
                }
              } else {
                st4bf_nt(p.zg + (size_t)tok * 4096 + (nn - 4192), sigm(v[0]), sigm(v[1]), sigm(v[2]), sigm(v[3]));
              }
            }
          __builtin_amdgcn_sched_barrier(0);
        }
    };
    gemm256(shm, W, p.hbuf, 1024, brow, bcol, pre, has_next, nbrow, nbcol, epi);
    pre = has_next;
  }
  base += 32 * 64;
}

DI void phase_inproj_tail(const Prm& p, unsigned char* smem_raw, int l, int& base) {
  const u16* W = p.WinT + (size_t)l * NWP * 1024;
  u16* smem = (u16*)smem_raw;
  TASK_LOOP(t, 128, base) {
    const int n0 = 8192, m0 = t * 128;
    auto la = [&](int row, int k) __attribute__((always_inline)) { return *(const u32x4*)(W + (size_t)(n0 + row) * 1024 + k); };
    auto lb = [&](int row, int k) __attribute__((always_inline)) { return *(const u32x4*)(p.hbuf + (size_t)(m0 + row) * 1024 + k); };
    auto epi = [&](f32x16 (&acc)[2], int wm, int wn, int lane) __attribute__((always_inline)) {
      const int lr = lane & 31, lh = lane >> 5;
      const int tok = m0 + wn * 32 + lr;
#pragma unroll
      for (int i = 0; i < 2; ++i) {
        const int nb = n0 + wm * 64 + i * 32;
        if (nb >= NW) continue;
#pragma unroll
        for (int q = 0; q < 4; ++q)
          st4bf(p.zg + (size_t)tok * 4096 + (nb - 4192) + 8 * q + 4 * lh, sigm(acc[i][4 * q]), sigm(acc[i][4 * q + 1]), sigm(acc[i][4 * q + 2]),
                sigm(acc[i][4 * q + 3]));
      }
    };
    gemm_tile<false, false>(smem, 16, la, lb, epi);
  }
  base += 128;
}


DI void phase_inproj_probe(const Prm& p, unsigned char* smem_raw, int l, int& base) {
  const u16* W = p.WinT + (size_t)l * NWP * 1024;
  LAS u16* shm = (LAS u16*)smem_raw;
  bool pre = false;
  TASK_LOOP(t, 32 * 64, base) {
    int tn, tm;
    map256(t, 32, tn, tm);
    const int brow = tn * 256, bcol = tm * 256;
    const int tnx = t + (int)gridDim.x;
    const bool has_next = tnx < (32 * 64);
    int tn2 = 0, tm2 = 0;
    if (has_next) map256(tnx, 32, tn2, tm2);
    const int nbrow = tn2 * 256, nbcol = tm2 * 256;
    auto epi = [&](f32x4 (&acc)[2][2][4][2], int wr, int wc, int fr, int fq) __attribute__((always_inline)) {
#pragma unroll
      for (int bj = 0; bj < 2; ++bj)
#pragma unroll
        for (int n = 0; n < 2; ++n) {
          const int tok = bcol + bj * 128 + wc * 32 + n * 16 + fr;
#pragma unroll
          for (int ai = 0; ai < 2; ++ai)
#pragma unroll
            for (int m = 0; m < 4; ++m) {
              const int nn = ((brow + ai * 128 + wr * 64 + m * 16) & 1023) + fq * 4;
              const f32x4 v = acc[ai][bj][m][n];
              st4bf(p.Gp + (size_t)tok * 1024 + nn, v[0], v[1], v[2], v[3]);
            }
        }
    };
    gemm256(shm, W, p.hbuf, 1024, brow, bcol, pre, has_next, nbrow, nbcol, epi);
    pre = has_next;
  }
  base += 32 * 64;
}

DI void phase_fft1(const Prm& p, u16* smem, int S, int nseq, int N1, int lgN1, int& base) {
  const int nkt = N1 == 128 ? 2 : 1;
  const u16* M1 = N1 == 128 ? p.M1a : p.M1b;
  const int ldm = N1 == 128 ? 256 : 64;
  const int nk = N1 == 128 ? 4 : 1;
  const int ntask = nseq * 768 * nkt;
  const int twmul = 16384 / S;
  TASK_LOOP(t, ntask, base) {
    const int k1t = t % nkt, col = (t / nkt) % 768, seq = t / (nkt * 768);
    const int k1base = k1t * 64;
    auto la = [&](int row, int k) __attribute__((always_inline)) {
      const int k1 = k1base + (row >> 6) * 32 + (row & 31), ii = (row >> 5) & 1;
      if (k1 >= N1 || k >= 2 * N1) return zero4();
      return *(const u32x4*)(M1 + (ii * N1 + k1) * ldm + k);
    };
    auto lb = [&](int row, int k) __attribute__((always_inline)) {
      if (k >= 2 * N1) return zero4();
      const int part = k >> lgN1, s1 = k & (N1 - 1);
      const u16* src = p.UT + (size_t)(part * 768 + col) * TBP + seq * S + s1 * 128 + row;
      u32x4 v;
#pragma unroll
      for (int jj = 0; jj < 4; ++jj) v[jj] = (unsigned)__builtin_nontemporal_load(src + (2 * jj) * 128) | ((unsigned)__builtin_nontemporal_load(src + (2 * jj + 1) * 128) << 16);
      return v;
    };
    auto epi = [&](f32x16 (&acc)[2], int wm, int wn, int lane) __attribute__((always_inline)) {
      const int lr = lane & 31, lh = lane >> 5;
      const int s2 = wn * 32 + lr;
#pragma unroll
      for (int r = 0; r < 16; ++r) {
        const int k1 = k1base + wm * 32 + rowmap(r, lh);
        if (k1 < N1) {
          const float re = acc[0][r], im = acc[1][r];
          const float2 cs = p.tw[(s2 * k1) * twmul];
          const size_t o = ((size_t)((seq * N1 + k1) * 2) * 768 + col) * 128 + s2;
          p.Gp[o] = f2bf(cs.x * re + cs.y * im);
          p.Gp[o + 768 * 128] = f2bf(cs.x * im - cs.y * re);
        }
      }
    };
    gemm_tile<false, true>(smem, nk, la, lb, epi);
  }
  base += ntask;
}


DI void phase_fft1_small(const Prm& p, int nseq) {
  constexpr float C16[16] = {1.f, 0.92387953251128674f, 0.70710678118654752f, 0.38268343236508977f, 0.f, -0.38268343236508977f, -0.70710678118654752f,
                             -0.92387953251128674f, -1.f, -0.92387953251128674f, -0.70710678118654752f, -0.38268343236508977f, 0.f,
                             0.38268343236508977f, 0.70710678118654752f, 0.92387953251128674f};
  constexpr float S16[16] = {0.f, 0.38268343236508977f, 0.70710678118654752f, 0.92387953251128674f, 1.f, 0.92387953251128674f, 0.70710678118654752f,
                             0.38268343236508977f, 0.f, -0.38268343236508977f, -0.70710678118654752f, -0.92387953251128674f, -1.f,
                             -0.92387953251128674f, -0.70710678118654752f, -0.38268343236508977f};
  const int gtid = blockIdx.x * NTH + tidx(), gn = gridDim.x * NTH;
  for (int idx = gtid; idx < nseq * 768 * 128; idx += gn) {
    const int s2 = idx & 127, col = (idx >> 7) % 768, seq = idx / (768 * 128);
    const u16* ur = p.UT + (size_t)col * TBP + seq * 2048 + s2;
    const u16* ui = ur + (size_t)768 * TBP;
    float xr[16], xi[16];
#pragma unroll
    for (int s1 = 0; s1 < 16; ++s1) { xr[s1] = bf2f(__builtin_nontemporal_load(ur + s1 * 128)); xi[s1] = bf2f(__builtin_nontemporal_load(ui + s1 * 128)); }
    u16* go = p.Gp + ((size_t)(seq * 16 * 2) * 768 + col) * 128 + s2;
#pragma unroll
    for (int k1 = 0; k1 < 16; ++k1) {
      float gr = 0.f, gi = 0.f;
#pragma unroll
      for (int s1 = 0; s1 < 16; ++s1) {
        const float c = C16[(k1 * s1) & 15], sn = S16[(k1 * s1) & 15];
        gr += c * xr[s1] + sn * xi[s1];
        gi += c * xi[s1] - sn * xr[s1];
      }
      const float2 cs = p.tw[(s2 * k1) * 8];
      go[(size_t)(k1 * 2) * 768 * 128] = f2bf(cs.x * gr + cs.y * gi);
      go[(size_t)(k1 * 2 + 1) * 768 * 128] = f2bf(cs.x * gi - cs.y * gr);
    }
  }
}

DI void phase_fft2(const Prm& p, u16* smem, int S, int nseq, int N1, int& base) {
  const int ntask = nseq * N1 * 6;
  const float scale = rsqrtf((float)S * 192.f);
  u16* fa = p.UT;
  TASK_LOOP(t, ntask, base) {
    const int ct = t % 6, k1 = (t / 6) % N1, seq = t / (6 * N1);
    const u16* gb = p.Gp + ((size_t)((seq * N1 + k1) * 2) * 768 + ct * 128) * 128;
    auto la = [&](int row, int k) __attribute__((always_inline)) { return *(const u32x4*)(p.M2 + row * 256 + k); };
    auto lb = [&](int row, int k) __attribute__((always_inline)) {
      const int part = k >> 7, s2 = k & 127;
      return __builtin_nontemporal_load((const u32x4*)(gb + ((size_t)part * 768 + row) * 128 + s2));
    };
    auto epi = [&](f32x16 (&acc)[2], int wm, int wn, int lane) __attribute__((always_inline)) {
      const int lr = lane & 31, lh = lane >> 5;
      const int col = ct * 128 + wn * 32 + lr;
#pragma unroll
      for (int i = 0; i < 2; ++i)
#pragma unroll
        for (int r = 0; r < 16; ++r) {
          const int k2 = wm * 64 + i * 32 + rowmap(r, lh);
          const int tok = seq * S + k1 + N1 * k2;
          fa[(size_t)tok * 768 + col] = f2bf(acc[i][r] * scale);
        }
    };
    gemm_tile<false, false>(smem, 4, la, lb, epi);
  }
  base += ntask;
}

DI void phase_mixc(const Prm& p, unsigned char* smem_raw, int l, int& base) {
  u16* smem = (u16*)smem_raw;
  float* st = (float*)(smem_raw + GEMM_SMEM);
  float* red = (float*)smem_raw;
  const int tid = tidx();
  TASK_LOOP(t, 512, base) {
    const int h = t & 3, ch = t >> 2, tok0 = ch * 128;
    {
      const int q = tid & 127, qf = tid >> 7;
      float s = 0.f, ss = 0.f;
      const u16* src = p.cvT + (size_t)(qf * 96) * TBP + tok0 + q;
      for (int c = 0; c < 96; ++c) { const float v = bf2f(src[(size_t)c * TBP]); s += v; ss += v * v; }
      red[qf * 256 + q * 2] = s; red[qf * 256 + q * 2 + 1] = ss;
      __syncthreads();
      if (tid < 128) {
        const float s1 = red[q * 2] + red[256 + q * 2] + red[512 + q * 2] + red[768 + q * 2];
        const float s2 = red[q * 2 + 1] + red[256 + q * 2 + 1] + red[512 + q * 2 + 1] + red[768 + q * 2 + 1];
        const float mu = s1 * (1.f / 384.f);
        const float var = fmaxf(s2 * (1.f / 384.f) - mu * mu, 0.f);
        st[q] = mu; st[128 + q] = rsqrtf(var + 1e-6f);
      }
      __syncthreads();
    }
    const u16* Wm = p.SgW + (size_t)((l * 4 + h) * 128) * 128;
    auto la = [&](int row, int k) __attribute__((always_inline)) { return *(const u32x4*)(Wm + row * 128 + k); };
    auto lb = [&](int row, int k) __attribute__((always_inline)) {
      if (row >= 96) return zero4();
      const int c = h * 96 + row;
      const u32x4 raw = *(const u32x4*)(p.cvT + (size_t)c * TBP + tok0 + k);
      const float g = p.ln_g[l * 384 + c], b = p.ln_b[l * 384 + c];
      u32x4 o;
#pragma unroll
      for (int jj = 0; jj < 4; ++jj) {
        const float v0 = (bflo(raw[jj]) - st[k + 2 * jj]) * st[128 + k + 2 * jj] * g + b;
        const float v1 = (bfhi(raw[jj]) - st[k + 2 * jj + 1]) * st[128 + k + 2 * jj + 1] * g + b;
        o[jj] = pack2(v0, v1);
      }
      return o;
    };
    auto epi = [&](f32x16 (&acc)[2], int wm, int wn, int lane) __attribute__((always_inline)) {
      const int lr = lane & 31, lh = lane >> 5;
      const int cl = wn * 32 + lr;
      if (cl < 96) {
#pragma unroll
        for (int i = 0; i < 2; ++i)
#pragma unroll
          for (int r = 0; r < 16; ++r) {
            const int pp = wm * 64 + i * 32 + rowmap(r, lh);
            const float val = acc[i][r] + p.sgu_b[(l * 4 + h) * 128 + pp];
            u16* dst = p.cu + (size_t)(tok0 + pp) * 384 + h * 96 + cl;
            *dst = f2bf(bf2f(*dst) * val);
          }
      }
    };
    gemm_tile<false, false>(smem, 2, la, lb, epi);
  }
  base += 512;
}

DI void phase_qup(const Prm& p, unsigned char* smem_raw, int l, int S, int& base) {
  u16* smem = (u16*)smem_raw;
  float* st = (float*)(smem_raw + GEMM_SMEM);
  const int tid = tidx();
  const float QS = 0.10206207261596577f * LOG2E;
  TASK_LOOP(t, 3 * 128, base) {
    const int tn = t % 3, tm = t / 3, n0 = tn * 128, m0 = tm * 128;
    {
      const int row = tid >> 2, qf = tid & 3;
      const u16* src = p.dcq + (size_t)(m0 + row) * 384 + qf * 96;
      float ss = 0.f;
#pragma unroll 4
      for (int c = 0; c < 12; ++c) {
        const u32x4 v = *(const u32x4*)(src + c * 8);
#pragma unroll
        for (int jj = 0; jj < 4; ++jj) { const float a = bflo(v[jj]), b = bfhi(v[jj]); ss += a * a + b * b; }
      }
      ss += __shfl_xor(ss, 1);
      ss += __shfl_xor(ss, 2);
      if (qf == 0) st[row] = rsqrtf(ss * (1.f / 384.f) + 1e-6f);
      __syncthreads();
    }
    const u16* W = p.WqT + (size_t)l * 384 * 384;
    auto la = [&](int row, int k) __attribute__((always_inline)) { return *(const u32x4*)(W + (size_t)(n0 + row) * 384 + k); };
    auto lb = [&](int row, int k) __attribute__((always_inline)) { return *(const u32x4*)(p.dcq + (size_t)(m0 + row) * 384 + k); };
    auto epi = [&](f32x16 (&acc)[2], int wm, int wn, int lane) __attribute__((always_inline)) {
      const int lr = lane & 31, lh = lane >> 5;
      const int tokl = wn * 32 + lr, tok = m0 + tokl;
      const float sc = st[tokl] * QS;
#pragma unroll
      for (int i = 0; i < 2; ++i) {
        const int nb = n0 + wm * 64 + i * 32;
        const int head = nb / 96, within = nb - head * 96;
        const f32x16& a = acc[i];
        if (within < 64) {
#pragma unroll
          for (int q = 0; q < 4; ++q)
            st4bf(p.qc + (size_t)tok * 384 + nb + 8 * q + 4 * lh, a[4 * q] * sc, a[4 * q + 1] * sc, a[4 * q + 2] * sc, a[4 * q + 3] * sc);
        } else {
          const int pos = tok & (S - 1);
#pragma unroll
          for (int q = 0; q < 2; ++q)
#pragma unroll
            for (int e = 0; e < 4; ++e) {
              const int r = 4 * q + e, ii = 8 * q + 4 * lh + e;
              const float2 cs = p.rope[pos * 16 + ii];
              const float x1 = a[r] * sc, x2 = a[r + 8] * sc;
              p.qc[(size_t)tok * 384 + head * 96 + 64 + ii] = f2bf(x1 * cs.x - x2 * cs.y);
              p.qc[(size_t)tok * 384 + head * 96 + 80 + ii] = f2bf(x1 * cs.y + x2 * cs.x);
            }
        }
      }
    };
    gemm_tile<false, false>(smem, 6, la, lb, epi);
    __syncthreads();
  }
  base += 3 * 128;
}

DI void phase_kvup(const Prm& p, unsigned char* smem_raw, int l, int& base) {
  u16* smem = (u16*)smem_raw;
  float* st = (float*)(smem_raw + GEMM_SMEM);
  const int tid = tidx();
  TASK_LOOP(t, 4 * 128, base) {
    const int tn = t & 3, tm = t >> 2, n0 = tn * 128, m0 = tm * 128;
    {
      const int row = tid >> 2, qf = tid & 3;
      const u16* src = p.dckv + (size_t)(m0 + row) * 320 + qf * 80;
      float ss = 0.f;
#pragma unroll 5
      for (int c = 0; c < 10; ++c) {
        const u32x4 v = *(const u32x4*)(src + c * 8);
#pragma unroll
        for (int jj = 0; jj < 4; ++jj) { const float a = bflo(v[jj]), b = bfhi(v[jj]); ss += a * a + b * b; }
      }
      ss += __shfl_xor(ss, 1);
      ss += __shfl_xor(ss, 2);
      if (qf == 0) st[row] = rsqrtf(ss * (1.f / 320.f) + 1e-6f);
      __syncthreads();
    }
    const u16* W = p.WkvT + (size_t)l * 512 * 320;
    auto la = [&](int row, int k) __attribute__((always_inline)) { return *(const u32x4*)(W + (size_t)(n0 + row) * 320 + k); };
    auto lb = [&](int row, int k) __attribute__((always_inline)) { return *(const u32x4*)(p.dckv + (size_t)(m0 + row) * 320 + k); };
    auto epi = [&](f32x16 (&acc)[2], int wm, int wn, int lane) __attribute__((always_inline)) {
      const int lr = lane & 31, lh = lane >> 5;
      const int head = tn;
      const int tokl = wn * 32 + lr, tok = m0 + tokl;
      const float sc = st[tokl];
#pragma unroll
      for (int i = 0; i < 2; ++i) {
        const int within = wm * 64 + i * 32;
        const f32x16& a = acc[i];
        if (within < 64) {
#pragma unroll
          for (int q = 0; q < 4; ++q)
            st4bf(p.kc + (size_t)tok * 384 + head * 96 + within + 8 * q + 4 * lh, a[4 * q] * sc, a[4 * q + 1] * sc, a[4 * q + 2] * sc, a[4 * q + 3] * sc);
        } else {
#pragma unroll
          for (int r = 0; r < 16; ++r)
            p.vT[(size_t)(head * 64 + within - 64 + rowmap(r, lh)) * TBP + tok] = f2bf(a[r] * sc);
        }
      }
    };
    gemm_tile<false, false>(smem, 5, la, lb, epi);
    __syncthreads();
  }
  base += 4 * 128;
}

DI void phase_mixb(const Prm& p, unsigned char* smem_raw, int S, int lgS, int& base) {
  float* bt = (float*)smem_raw;
  const int tid = tidx(), lane = tid & 63, wave = tid >> 6, lr = lane & 31, lh = lane >> 5;
  u16* vt = (u16*)(smem_raw + 3328) + wave * (64 * 40);
  for (int idx = tid; idx < 774; idx += NTH) bt[idx] = p.biasT[idx];
  __syncthreads();
  TASK_LOOP(t, 384, base) {
    const int wt = t * 8 + wave;
    const int hg = wt & 1, g = (wt >> 1) % 3, blk = wt / 6;
    const int seq = blk >> (lgS - 5), b_in = blk & ((S >> 5) - 1);
    const int lgd = 2 * g, L = S >> lgd;
    const int lgbpr = lgS - lgd - 5;
    const int res = b_in >> lgbpr, i0 = (b_in & ((1 << lgbpr) - 1)) << 5;
    const int tokbase = seq * S + res;
    const int hd = g * 2 + hg, hc = hd * 64;
    const int qi = i0 + lr;
    const int qtok = tokbase + (qi << lgd);
    bf16x8 qf[4];
#pragma unroll
    for (int ks = 0; ks < 4; ++ks) qf[ks] = *(const bf16x8*)(p.bqkv + (size_t)qtok * 1152 + hc + ks * 16 + lh * 8);
    f32x16 sc[5];
#pragma unroll
    for (int tt = 0; tt < 5; ++tt) {
      int ik = i0 - 64 + 32 * tt + lr;
      ik = min(max(ik, 0), L - 1);
      const u16* kp = p.bqkv + (size_t)(tokbase + (ik << lgd)) * 1152 + 384 + hc + lh * 8;
      sc[tt] = zero16();
#pragma unroll
      for (int ks = 0; ks < 4; ++ks) sc[tt] = mfma(*(const bf16x8*)(kp + ks * 16), qf[ks], sc[tt]);
    }
    float mx = -1e30f;
#pragma unroll
    for (int tt = 0; tt < 5; ++tt)
#pragma unroll
      for (int r = 0; r < 16; ++r) {
        const int ik = i0 - 64 + 32 * tt + rowmap(r, lh);
        const int rel = ik - qi;
        const bool valid = (rel >= -64) && (rel <= 64) && (ik >= 0) && (ik < L);
        const int bi = min(max(rel + 64, 0), 128);
        const float s = valid ? (sc[tt][r] * 0.125f + bt[hd * 129 + bi]) * LOG2E : -1e30f;
        sc[tt][r] = s;
        mx = fmaxf(mx, s);
      }
    mx = fmaxf(mx, __shfl_xor(mx, 32));
    float sum = 0.f;
#pragma unroll
    for (int tt = 0; tt < 5; ++tt)
#pragma unroll
      for (int r = 0; r < 16; ++r) {
        const float pv = ex2(sc[tt][r] - mx);
        sum += pv;
        sc[tt][r] = pv;
      }
    sum += __shfl_xor(sum, 32);
    f32x16 oacc[2];
    oacc[0] = zero16(); oacc[1] = zero16();
#pragma unroll
    for (int tt = 0; tt < 5; ++tt) {
#pragma unroll
      for (int e = 0; e < 4; ++e) {
        const int c = lane + 64 * e, key = c >> 3, dch = c & 7;
        int ik = i0 - 64 + 32 * tt + key;
        ik = min(max(ik, 0), L - 1);
        const u32x4 raw = *(const u32x4*)(p.bqkv + (size_t)(tokbase + (ik << lgd)) * 1152 + 768 + hc + dch * 8);
#pragma unroll
        for (int jj = 0; jj < 4; ++jj) {
          vt[(dch * 8 + 2 * jj) * 40 + key] = (u16)(raw[jj] & 0xffffu);
          vt[(dch * 8 + 2 * jj + 1) * 40 + key] = (u16)(raw[jj] >> 16);
        }
      }
      __syncthreads();
#pragma unroll
      for (int u = 0; u < 2; ++u) {
        u32x4 pk;
#pragma unroll
        for (int jj = 0; jj < 4; ++jj) pk[jj] = pack2(sc[tt][8 * u + 2 * jj], sc[tt][8 * u + 2 * jj + 1]);
        const bf16x8 pf = __builtin_bit_cast(bf16x8, pk);
#pragma unroll
        for (int dt = 0; dt < 2; ++dt) {
          const u16* vp = vt + (dt * 32 + lr) * 40 + 16 * u + 4 * lh;
          u32x4 vv;
          const u32x2 lo = *(const u32x2*)vp, hi = *(const u32x2*)(vp + 8);
          vv[0] = lo[0]; vv[1] = lo[1]; vv[2] = hi[0]; vv[3] = hi[1];
          oacc[dt] = mfma(__builtin_bit_cast(bf16x8, vv), pf, oacc[dt]);
        }
      }
      __syncthreads();
    }
    const float inv = 1.f / sum;
#pragma unroll
    for (int dt = 0; dt < 2; ++dt)
#pragma unroll
      for (int q = 0; q < 4; ++q) {
        float4 o;
        o.x = oacc[dt][4 * q] * inv; o.y = oacc[dt][4 * q + 1] * inv; o.z = oacc[dt][4 * q + 2] * inv; o.w = oacc[dt][4 * q + 3] * inv;
        *(float4*)(p.og + (size_t)qtok * 384 + hc + dt * 32 + 8 * q + 4 * lh) = o;
      }
    if (lh == 0) p.lse[(size_t)qtok * 6 + hd] = (mx + __log2f(sum)) * LN2;
  }
  base += 384;
  __syncthreads();
}

DI void phase_combb(const Prm& p) {
  const int gtid = blockIdx.x * NTH + tidx(), gn = gridDim.x * NTH;
  for (int idx = gtid; idx < TB * 32; idx += gn) {
    const int dq = idx & 15, hg = (idx >> 4) & 1, tok = idx >> 5;
    const float l0 = p.lse[(size_t)tok * 6 + hg], l1 = p.lse[(size_t)tok * 6 + 2 + hg], l2 = p.lse[(size_t)tok * 6 + 4 + hg];
    const float mx = fmaxf(l0, fmaxf(l1, l2));
    const float e0 = __expf(l0 - mx), e1 = __expf(l1 - mx), e2 = __expf(l2 - mx);
    const float inv = 1.f / (e0 + e1 + e2);
    const float4 a = *(const float4*)(p.og + (size_t)tok * 384 + hg * 64 + dq * 4);
    const float4 b = *(const float4*)(p.og + (size_t)tok * 384 + 128 + hg * 64 + dq * 4);
    const float4 c = *(const float4*)(p.og + (size_t)tok * 384 + 256 + hg * 64 + dq * 4);
    st4bf(p.ob + (size_t)tok * 128 + hg * 64 + dq * 4, (e0 * a.x + e1 * b.x + e2 * c.x) * inv, (e0 * a.y + e1 * b.y + e2 * c.y) * inv,
          (e0 * a.z + e1 * b.z + e2 * c.z) * inv, (e0 * a.w + e1 * b.w + e2 * c.w) * inv);
  }
}

constexpr int KS_ELEMS = 128 * 104, VS_ELEMS = 64 * 136;
DI void phase_mla(const Prm& p, unsigned char* smem_raw, int S, int lgS, int& base) {
  u16* Ks = (u16*)smem_raw;
  u16* Vs = Ks + 2 * KS_ELEMS;
  const int tid = tidx(), lane = tid & 63, wave = tid >> 6, lr = lane & 31, lh = lane >> 5;
  const int nkt = S >> 7;
  TASK_LOOP(t, 256, base) {
    const int head = t & 3, qb = t >> 2, tok0 = qb * 256;
    const int seqtok0 = (tok0 >> lgS) << lgS;
    const int qtok = tok0 + wave * 32 + lr;
    bf16x8 qf[6];
#pragma unroll
    for (int ks = 0; ks < 6; ++ks) qf[ks] = *(const bf16x8*)(p.qc + (size_t)qtok * 384 + head * 96 + ks * 16 + lh * 8);
    const u16* kbase = p.kc + (size_t)seqtok0 * 384 + head * 96;
    const u16* vbase = p.vT + (size_t)(head * 64) * TBP + seqtok0;
    u32x4 rk[3], rv[2];
    auto gload = [&](int kt) __attribute__((always_inline)) {
#pragma unroll
      for (int e = 0; e < 3; ++e) {
        const int c = tid + NTH * e, key = c / 12, dc = c - key * 12;
        rk[e] = *(const u32x4*)(kbase + (size_t)(kt * 128 + key) * 384 + dc * 8);
      }
#pragma unroll
      for (int e = 0; e < 2; ++e) {
        const int c = tid + NTH * e, d = c >> 4, kch = c & 15;
        rv[e] = *(const u32x4*)(vbase + (size_t)d * TBP + kt * 128 + kch * 8);
      }
    };
    auto sstore = [&](int buf) __attribute__((always_inline)) {
#pragma unroll
      for (int e = 0; e < 3; ++e) {
        const int c = tid + NTH * e, key = c / 12, dc = c - key * 12;
        *(u32x4*)(Ks + buf * KS_ELEMS + key * 104 + dc * 8) = rk[e];
      }
#pragma unroll
      for (int e = 0; e < 2; ++e) {
        const int c = tid + NTH * e, d = c >> 4, kch = c & 15;
        *(u32x4*)(Vs + buf * VS_ELEMS + d * 136 + kch * 8) = rv[e];
      }
    };
    float m = -1e30f, lsum = 0.f;
    f32x16 oacc[2];
    oacc[0] = zero16(); oacc[1] = zero16();
    gload(0);
    sstore(0);
    __syncthreads();
    for (int kt = 0; kt < nkt; ++kt) {
      const int buf = kt & 1;
      if (kt + 1 < nkt) gload(kt + 1);
      f32x16 s[4];
#pragma unroll
      for (int kk = 0; kk < 4; ++kk) s[kk] = zero16();
      {
        const u16* kp = Ks + buf * KS_ELEMS + lr * 104 + lh * 8;
        bf16x8 kf[4];
#pragma unroll
        for (int kk = 0; kk < 4; ++kk) kf[kk] = *(const bf16x8*)(kp + kk * 32 * 104);
#pragma unroll
        for (int ks = 0; ks < 6; ++ks) {
          bf16x8 kn[4];
          if (ks < 5) {
#pragma unroll
            for (int kk = 0; kk < 4; ++kk) kn[kk] = *(const bf16x8*)(kp + kk * 32 * 104 + (ks + 1) * 16);
          }
#pragma unroll
          for (int kk = 0; kk < 4; ++kk) s[kk] = mfma(kf[kk], qf[ks], s[kk]);
          if (ks < 5) {
#pragma unroll
            for (int kk = 0; kk < 4; ++kk) kf[kk] = kn[kk];
          }
        }
      }
      float mloc = -1e30f;
#pragma unroll
      for (int kk = 0; kk < 4; ++kk)
#pragma unroll
        for (int r = 0; r < 16; ++r) mloc = fmaxf(mloc, s[kk][r]);
      mloc = fmaxf(mloc, __shfl_xor(mloc, 32));
      const float mnew = fmaxf(m, mloc);
      const float alpha = ex2(m - mnew);
      m = mnew;
      lsum *= alpha;
#pragma unroll
      for (int kk = 0; kk < 4; ++kk)
#pragma unroll
        for (int r = 0; r < 16; ++r) {
          const float pv = ex2(s[kk][r] - mnew);
          lsum += pv;
          s[kk][r] = pv;
        }
#pragma unroll
      for (int dt = 0; dt < 2; ++dt)
#pragma unroll
        for (int r = 0; r < 16; ++r) oacc[dt][r] *= alpha;
#pragma unroll
      for (int kk = 0; kk < 4; ++kk)
#pragma unroll
        for (int u = 0; u < 2; ++u) {
          u32x4 pk;
#pragma unroll
          for (int jj = 0; jj < 4; ++jj) pk[jj] = pack2(s[kk][8 * u + 2 * jj], s[kk][8 * u + 2 * jj + 1]);
          const bf16x8 pf = __builtin_bit_cast(bf16x8, pk);
#pragma unroll
          for (int dt = 0; dt < 2; ++dt) {
            const u16* vp = Vs + buf * VS_ELEMS + (dt * 32 + lr) * 136 + kk * 32 + 16 * u + 4 * lh;
            u32x4 vv;
            const u32x2 lo = *(const u32x2*)vp, hi = *(const u32x2*)(vp + 8);
            vv[0] = lo[0]; vv[1] = lo[1]; vv[2] = hi[0]; vv[3] = hi[1];
            oacc[dt] = mfma(__builtin_bit_cast(bf16x8, vv), pf, oacc[dt]);
          }
        }
      if (kt + 1 < nkt) sstore(buf ^ 1);
      __syncthreads();
    }
    lsum += __shfl_xor(lsum, 32);
    const float inv = 1.f / lsum;
#pragma unroll
    for (int dt = 0; dt < 2; ++dt)
#pragma unroll
      for (int q = 0; q < 4; ++q)
        st4bf(p.od + (size_t)qtok * 256 + head * 64 + dt * 32 + 8 * q + 4 * lh, oacc[dt][4 * q] * inv, oacc[dt][4 * q + 1] * inv,
              oacc[dt][4 * q + 2] * inv, oacc[dt][4 * q + 3] * inv);
  }
  base += 256;
}

template <class ACC>
DI void merge_branch(const Prm& p, u16* smem, const u16* W, const u16* X, int ld, int bi, int n0, int m0, ACC& macc) {
  auto la = [&](int row, int k) __attribute__((always_inline)) { return *(const u32x4*)(W + (size_t)(n0 + row) * ld + k); };
  auto lb = [&](int row, int k) __attribute__((always_inline)) { return *(const u32x4*)(X + (size_t)(m0 + row) * ld + k); };
  auto epi = [&](f32x16 (&acc)[2], int wm, int wn, int lane) __attribute__((always_inline)) {
    const int lr = lane & 31, lh = lane >> 5;
    const int tok = m0 + wn * 32 + lr;
#pragma unroll
    for (int i = 0; i < 2; ++i)
#pragma unroll
      for (int q = 0; q < 4; ++q) {
        const int n = n0 + wm * 64 + i * 32 + 8 * q + 4 * lh;
        const u32x2 gz = *(const u32x2*)(p.zg + (size_t)tok * 4096 + bi * 1024 + n);
        macc[i][4 * q] += bflo(gz[0]) * acc[i][4 * q];
        macc[i][4 * q + 1] += bfhi(gz[0]) * acc[i][4 * q + 1];
        macc[i][4 * q + 2] += bflo(gz[1]) * acc[i][4 * q + 2];
        macc[i][4 * q + 3] += bfhi(gz[1]) * acc[i][4 * q + 3];
      }
  };
  gemm_tile<false, false>(smem, ld >> 6, la, lb, epi);
}

DI void phase_merge(const Prm& p, u16* smem, int l, int& base) {
  TASK_LOOP(t, 8 * 128, base) {
    const int tn = t & 7, tm = t >> 3, n0 = tn * 128, m0 = tm * 128;
    f32x16 macc[2];
    macc[0] = zero16(); macc[1] = zero16();
    merge_branch(p, smem, p.PaT + (size_t)l * 1024 * 768, p.UT, 768, 0, n0, m0, macc);
    merge_branch(p, smem, p.PbT + (size_t)l * 1024 * 128, p.ob, 128, 1, n0, m0, macc);
    merge_branch(p, smem, p.PcT + (size_t)l * 1024 * 384, p.cu, 384, 2, n0, m0, macc);
    merge_branch(p, smem, p.PdT + (size_t)l * 1024 * 256, p.od, 256, 3, n0, m0, macc);
    const int tid2 = tidx(), lane = tid2 & 63, wave = tid2 >> 6, wm = wave >> 2, wn = wave & 3, lr = lane & 31, lh = lane >> 5;
    const int tok = m0 + wn * 32 + lr;
#pragma unroll
    for (int i = 0; i < 2; ++i)
#pragma unroll
      for (int q = 0; q < 4; ++q)
        st4bf(p.hbuf + (size_t)tok * 1024 + n0 + wm * 64 + i * 32 + 8 * q + 4 * lh, macc[i][4 * q], macc[i][4 * q + 1],
              macc[i][4 * q + 2], macc[i][4 * q + 3]);
  }
  base += 8 * 128;
}

DI void phase_resid_gemm(const Prm& p, unsigned char* smem_raw, const u16* W, const u16* X, int K, const float* xsrc, float* xdst,
                         const float* modl, int gtoff, int sb, int& base) {
  LAS u16* shm = (LAS u16*)smem_raw;
  bool pre = false;
  TASK_LOOP(t, 4 * 64, base) {
    int tn, tm;
    map256(t, 4, tn, tm);
    const int brow = tn * 256, bcol = tm * 256;
    const int tnx = t + (int)gridDim.x;
    const bool has_next = tnx < (4 * 64);
    int tn2 = 0, tm2 = 0;
    if (has_next) map256(tnx, 4, tn2, tm2);
    const int nbrow = tn2 * 256, nbcol = tm2 * 256;
    auto epi = [&](f32x4 (&acc)[2][2][4][2], int wr, int wc, int fr, int fq) __attribute__((always_inline)) {
#pragma unroll
      for (int bj = 0; bj < 2; ++bj)
#pragma unroll
        for (int n = 0; n < 2; ++n) {
          const int tok = bcol + bj * 128 + wc * 32 + n * 16 + fr;
          const float* gt = modl + condrow(sb, tok) * 6144 + gtoff;
#pragma unroll
          for (int ai = 0; ai < 2; ++ai)
#pragma unroll
            for (int m = 0; m < 4; ++m) {
              const int nn = brow + ai * 128 + wr * 64 + m * 16 + fq * 4;
              const f32x4 v = acc[ai][bj][m][n];
              const float4 g4 = *(const float4*)(gt + nn);
              const float4 xi = *(const float4*)(xsrc + (size_t)tok * 1024 + nn);
              float4 o;
              o.x = xi.x + g4.x * v[0]; o.y = xi.y + g4.y * v[1]; o.z = xi.z + g4.z * v[2]; o.w = xi.w + g4.w * v[3];
              *(float4*)(xdst + (size_t)tok * 1024 + nn) = o;
            }
        }
    };
    gemm256(shm, W, X, K, brow, bcol, pre, has_next, nbrow, nbcol, epi);
    pre = has_next;
  }
  base += 4 * 64;
}

DI void phase_w1(const Prm& p, unsigned char* smem_raw, int l, int& base) {
  const u16* W = p.W1T + (size_t)l * 4096 * 1024;
  LAS u16* shm = (LAS u16*)smem_raw;
  bool pre = false;
  TASK_LOOP(t, 16 * 64, base) {
    int tn, tm;
    map256(t, 16, tn, tm);
    const int brow = tn * 256, bcol = tm * 256;
    const int tnx = t + (int)gridDim.x;
    const bool has_next = tnx < (16 * 64);
    int tn2 = 0, tm2 = 0;
    if (has_next) map256(tnx, 16, tn2, tm2);
    const int nbrow = tn2 * 256, nbcol = tm2 * 256;
    auto epi = [&](f32x4 (&acc)[2][2][4][2], int wr, int wc, int fr, int fq) __attribute__((always_inline)) {
#pragma unroll
      for (int bj = 0; bj < 2; ++bj)
#pragma unroll
        for (int n = 0; n < 2; ++n) {
          const int tok = bcol + bj * 128 + wc * 32 + n * 16 + fr;
#pragma unroll
          for (int ai = 0; ai < 2; ++ai)
#pragma unroll
            for (int m = 0; m < 4; ++m) {
              const int nn = brow + ai * 128 + wr * 64 + m * 16 + fq * 4;
              const f32x4 v = acc[ai][bj][m][n];
              const float a0 = fmaxf(v[0], 0.f), a1 = fmaxf(v[1], 0.f), a2 = fmaxf(v[2], 0.f), a3 = fmaxf(v[3], 0.f);
              st4bf(p.zg + (size_t)tok * 4096 + nn, a0 * a0, a1 * a1, a2 * a2, a3 * a3);
            }
        }
    };
    gemm256(shm, W, p.hbuf, 1024, brow, bcol, pre, has_next, nbrow, nbcol, epi);
    pre = has_next;
  }
  base += 16 * 64;
}

DI void phase_final(const Prm& p) {
  const int tid = tidx(), lane = tid & 63;
  const int gw = blockIdx.x * 8 + (tid >> 6), nw = gridDim.x * 8;
  for (int row = gw; row < 3 * TB; row += nw) {
    float* xr = p.out + (size_t)row * 1024;
    float4 v[4];
    float ss = 0.f;
#pragma unroll
    for (int i = 0; i < 4; ++i) {
      v[i] = *(const float4*)(xr + i * 256 + lane * 4);
      ss += v[i].x * v[i].x + v[i].y * v[i].y + v[i].z * v[i].z + v[i].w * v[i].w;
    }
#pragma unroll
    for (int off = 32; off >= 1; off >>= 1) ss += __shfl_xor(ss, off);
    const float rstd = rsqrtf(ss * (1.f / 1024.f) + 1e-6f);
#pragma unroll
    for (int i = 0; i < 4; ++i) {
      const int col = i * 256 + lane * 4;
      const float4 gg = *(const float4*)(p.final_g + col);
      float4 o;
      o.x = v[i].x * rstd * gg.x; o.y = v[i].y * rstd * gg.y; o.z = v[i].z * rstd * gg.z; o.w = v[i].w * rstd * gg.w;
      *(float4*)(xr + col) = o;
    }
  }
}

__global__ void __launch_bounds__(512) mega(Prm p) {
  cg::grid_group grid = cg::this_grid();
  __shared__ __attribute__((aligned(16))) unsigned char smem_raw[SMEM_BYTES];
  __shared__ uint4 xb_words;
  u16* smem = (u16*)smem_raw;
  if (threadIdx.x == 0) xb_words = make_uint4(0u, 0u, 0u, 0u);
  __syncthreads();
  const XcdBarrier xb = xcd_barrier_post(p.bar, (volatile LAS unsigned*)&xb_words);
  int base = 0;
  prologue_a(p, smem_raw, base);
  if (PROBE == 11) prologue_a(p, smem_raw, base);
  grid.sync();
  prologue_b(p);
  xcd_barrier(xb);
  for (int sb = 0; sb < 3; ++sb) {
    const int S = sb == 0 ? 16384 : 2048, lgS = sb == 0 ? 14 : 11, nseq = sb == 0 ? 1 : 8;
    const int N1 = S >> 7, lgN1 = lgS - 7;
    const float* xin = sb == 0 ? p.x_prompt : p.x_sample + (size_t)(sb - 1) * TB * 1024;
    float* xo = p.out + (size_t)sb * TB * 1024;
    for (int l = 0; l < 4; ++l) {
      const float* xs = l == 0 ? xin : xo;
      const float* modl = p.mod + (size_t)l * 17 * 6144;
      phase_norm(p, xs, p.norm1_g + l * 1024, modl, 0, 1024, sb);
      xcd_barrier(xb);
      phase_inproj(p, smem_raw, l, S, base);
      if (PROBE == 2 || PROBE == 7) phase_inproj(p, smem_raw, l, S, base);
      if (PROBE == 12) phase_inproj_probe(p, smem_raw, l, base);
      xcd_barrier(xb);
      if (PROBE == 5) xcd_barrier(xb);
      if (N1 == 16) phase_fft1_small(p, nseq); else phase_fft1(p, smem, S, nseq, N1, lgN1, base);
      phase_mixb(p, smem_raw, S, lgS, base);
      phase_mixc(p, smem_raw, l, base);
      phase_qup(p, smem_raw, l, S, base);
      phase_kvup(p, smem_raw, l, base);
      phase_inproj_tail(p, smem_raw, l, base);
      if (PROBE == 13) phase_fft1(p, smem, S, nseq, N1, lgN1, base);
      if (PROBE == 14) phase_mixb(p, smem_raw, S, lgS, base);
      if (PROBE == 15) { phase_qup(p, smem_raw, l, S, base); phase_kvup(p, smem_raw, l, base); phase_inproj_tail(p, smem_raw, l, base); }
      if (PROBE == 4) { phase_fft1(p, smem, S, nseq, N1, lgN1, base); phase_mixb(p, smem_raw, S, lgS, base); phase_qup(p, smem_raw, l, S, base); phase_kvup(p, smem_raw, l, base); }
      xcd_barrier(xb);
      if (PROBE == 5) xcd_barrier(xb);
      phase_mla(p, smem_raw, S, lgS, base);
      if (PROBE == 1) phase_mla(p, smem_raw, S, lgS, base);
      phase_fft2(p, smem, S, nseq, N1, base);
      phase_combb(p);
      if (PROBE == 6) { phase_fft2(p, smem, S, nseq, N1, base); phase_combb(p); }
      xcd_barrier(xb);
      if (PROBE == 5) xcd_barrier(xb);
      phase_merge(p, smem, l, base);
      if (PROBE == 3) phase_merge(p, smem, l, base);
      xcd_barrier(xb);
      if (PROBE == 5) xcd_barrier(xb);
      phase_resid_gemm(p, smem_raw, p.WoT + (size_t)l * 1024 * 1024, p.hbuf, 1024, xs, xo, modl, 2048, sb, base);
      xcd_barrier(xb);
      phase_norm(p, xo, p.norm2_g + l * 1024, modl, 3072, 4096, sb);
      if (PROBE == 9) { phase_norm(p, xo, p.norm2_g + l * 1024, modl, 3072, 4096, sb); phase_norm(p, xo, p.norm2_g + l * 1024, modl, 3072, 4096, sb); }
      xcd_barrier(xb);
      phase_w1(p, smem_raw, l, base);
      if (PROBE == 2 || PROBE == 8) phase_w1(p, smem_raw, l, base);
      xcd_barrier(xb);
      if (PROBE == 5) xcd_barrier(xb);
      phase_resid_gemm(p, smem_raw, p.W2T + (size_t)l * 1024 * 4096, p.zg, 4096, xo, xo, modl, 5120, sb, base);
      xcd_barrier(xb);
    }
  }
  phase_final(p);
}

extern "C" void kernel_launch(void* const* d_in, const int* in_sizes, int n_in, void* d_out, int out_size, void* d_ws, size_t ws_size,
                              hipStream_t stream) {
  Prm p{};
  const float* const* in = (const float* const*)d_in;
  p.x_prompt = in[0]; p.x_sample = in[1]; p.c_prompt = in[2]; p.c_sample = in[3]; p.rel_bias = in[4]; p.ada_w = in[5]; p.ada_b = in[6];
  p.norm1_g = in[7]; p.w_in = in[8]; p.qn_g = in[9]; p.kvn_g = in[10]; p.w_uq = in[11]; p.w_ukv = in[12]; p.ln_g = in[13]; p.ln_b = in[14];
  p.sgu_w = in[15]; p.sgu_b = in[16]; p.p_a = in[17]; p.p_b = in[18]; p.p_c = in[19]; p.p_d = in[20]; p.w_o = in[21]; p.norm2_g = in[22];
  p.w1 = in[23]; p.w2 = in[24]; p.final_g = in[25];
  p.out = (float*)d_out;
  char* w = (char*)d_ws;
  size_t off = 0;
  auto take = [&](size_t bytes) __attribute__((always_inline)) { void* r = w + off; off += (bytes + 255) & ~(size_t)255; return r; };
  p.WinT = (u16*)take((size_t)4 * NWP * 1024 * 2);
  p.W1T = (u16*)take((size_t)4 * 4096 * 1024 * 2);
  p.W2T = (u16*)take((size_t)4 * 4096 * 1024 * 2);
  p.WoT = (u16*)take((size_t)4 * 1024 * 1024 * 2);
  p.PaT = (u16*)take((size_t)4 * 1024 * 768 * 2);
  p.PbT = (u16*)take((size_t)4 * 1024 * 128 * 2);
  p.PcT = (u16*)take((size_t)4 * 1024 * 384 * 2);
  p.PdT = (u16*)take((size_t)4 * 1024 * 256 * 2);
  p.WqT = (u16*)take((size_t)4 * 384 * 384 * 2);
  p.WkvT = (u16*)take((size_t)4 * 512 * 320 * 2);
  p.SgW = (u16*)take((size_t)4 * 4 * 128 * 128 * 2);
  p.M1a = (u16*)take(256 * 256 * 2);
  p.M1b = (u16*)take(32 * 64 * 2);
  p.M2 = (u16*)take(128 * 256 * 2);
  p.tw = (float2*)take(16384 * 8);
  p.rope = (float2*)take((size_t)16384 * 16 * 8);
  p.biasT = (float*)take(6 * 129 * 4);
  p.mod = (float*)take((size_t)4 * 17 * 6144 * 4);
  p.hbuf = (u16*)take((size_t)TB * 1024 * 2);
  p.og = (float*)take((size_t)TB * 384 * 4);
  p.UT = (u16*)take((size_t)1536 * TBP * 2);
  p.Gp = (u16*)take((size_t)1536 * TB * 2);
  p.bqkv = (u16*)take((size_t)TB * 1152 * 2);
  p.ob = (u16*)take((size_t)TB * 128 * 2);
  p.cu = (u16*)take((size_t)TB * 384 * 2);
  p.cvT = (u16*)take((size_t)TBP * 384 * 2);
  p.dcq = (u16*)take((size_t)TB * 384 * 2);
  p.dckv = (u16*)take((size_t)TB * 320 * 2);
  p.qc = (u16*)take((size_t)TB * 384 * 2);
  p.kc = (u16*)take((size_t)TB * 384 * 2);
  p.vT = (u16*)take((size_t)TBP * 256 * 2);
  p.od = (u16*)take((size_t)TB * 256 * 2);
  p.lse = (float*)take((size_t)TB * 6 * 4);
  p.zg = (u16*)take((size_t)TB * 4096 * 2);
  p.bar = (unsigned*)take(XCD_BAR_WORDS * 4);
  p.modpart = (float*)p.zg;
  if (off > ws_size) { fprintf(stderr, "workspace too small: need %zu have %zu\n", off, ws_size); return; }
  static int grid_blocks = 0;
  if (!grid_blocks) {
    int dev = 0, cus = 0, per_cu = 0;
    (void)hipGetDevice(&dev);
    (void)hipDeviceGetAttribute(&cus, hipDeviceAttributeMultiprocessorCount, dev);
    (void)hipOccupancyMaxActiveBlocksPerMultiprocessor(&per_cu, mega, NTH, 0);
    if (per_cu < 1) per_cu = 1;
    if (per_cu > 1) per_cu = 1;
    grid_blocks = cus * per_cu;
  }
  (void)hipMemsetAsync(p.bar, 0, XCD_BAR_WORDS * 4, stream);
  void* args[] = {&p};
  hipError_t e = hipLaunchCooperativeKernel((void*)mega, dim3(grid_blocks), dim3(NTH), args, 0, stream);
  if (e != hipSuccess) fprintf(stderr, "cooperative launch failed: %s (grid %d)\n", hipGetErrorString(e), grid_blocks);
}
```

```cpp
#include <hip/hip_runtime.h>
#include <hip/hip_cooperative_groups.h>
#include <stdint.h>
#include <stdio.h>
namespace cg = cooperative_groups;

#define DI __device__ __forceinline__
#define LAS __attribute__((address_space(3)))
typedef unsigned short u16;
typedef __attribute__((ext_vector_type(8))) short bf16x8;
typedef __attribute__((ext_vector_type(4))) short bf16x4;
typedef __attribute__((ext_vector_type(16))) float f32x16;
typedef __attribute__((ext_vector_type(4))) float f32x4;
typedef __attribute__((ext_vector_type(2))) float f32x2;
typedef __attribute__((ext_vector_type(4))) unsigned u32x4;
typedef __attribute__((ext_vector_type(2))) unsigned u32x2;
typedef __attribute__((ext_vector_type(2))) __bf16 bf2_t;

constexpr int TB = 16384;
constexpr int TBP = TB + 64;
constexpr int NW = 8288;
constexpr int NWP = 8320;
constexpr int LDT = 72;
constexpr int TILE_ELEMS = 128 * LDT;
constexpr int GEMM_SMEM = 4 * TILE_ELEMS * 2;
constexpr int SMEM_BYTES = 131072;
#ifndef PROBE
#define PROBE 0
#endif
constexpr int NTH = 512;
constexpr int HT = 128 * 64;
constexpr float LOG2E = 1.4426950408889634f;
constexpr float LN2 = 0.6931471805599453f;

struct Prm {
  const float *x_prompt, *x_sample, *c_prompt, *c_sample, *rel_bias, *ada_w, *ada_b, *norm1_g, *w_in,
      *qn_g, *kvn_g, *w_uq, *w_ukv, *ln_g, *ln_b, *sgu_w, *sgu_b, *p_a, *p_b, *p_c, *p_d, *w_o,
      *norm2_g, *w1, *w2, *final_g;
  float* out;
  u16 *WinT, *W1T, *W2T, *WoT, *PaT, *PbT, *PcT, *PdT, *WqT, *WkvT, *SgW, *M1a, *M1b, *M2;
  float2 *tw, *rope;
  float *biasT, *mod, *modpart;
  u16 *hbuf, *UT, *Gp, *bqkv, *ob, *cu, *cvT, *dcq, *dckv, *qc, *kc, *vT, *od, *zg;
  float *og, *lse;
  unsigned* bar;
};

DI unsigned pack2(float a, float b) { bf2_t v; v[0] = (__bf16)a; v[1] = (__bf16)b; return __builtin_bit_cast(unsigned, v); }
DI u16 f2bf(float a) { return __builtin_bit_cast(u16, (__bf16)a); }
DI float bf2f(u16 v) { return __uint_as_float(((unsigned)v) << 16); }
DI float bflo(unsigned w) { return __uint_as_float(w << 16); }
DI float bfhi(unsigned w) { return __uint_as_float(w & 0xffff0000u); }
DI void st4bf(u16* dst, float a, float b, float c, float d) { u32x2 v; v[0] = pack2(a, b); v[1] = pack2(c, d); *(u32x2*)dst = v; }
DI void st4bf_nt(u16* dst, float a, float b, float c, float d) { u32x2 v; v[0] = pack2(a, b); v[1] = pack2(c, d); __builtin_nontemporal_store(v, (u32x2*)dst); }
DI int rowmap(int r, int lh) { return (r & 3) + 8 * (r >> 2) + 4 * lh; }
DI f32x16 mfma(bf16x8 a, bf16x8 b, f32x16 c) { return __builtin_amdgcn_mfma_f32_32x32x16_bf16(a, b, c, 0, 0, 0); }
DI u32x4 zero4() { u32x4 z; z[0] = 0; z[1] = 0; z[2] = 0; z[3] = 0; return z; }
DI f32x16 zero16() { f32x16 z; for (int i = 0; i < 16; ++i) z[i] = 0.f; return z; }
DI float ex2(float x) { return __builtin_amdgcn_exp2f(x); }
DI int tidx() { int t = threadIdx.x; asm volatile("" : "+v"(t)); return t; }


#define XB_TMO      128
#define XB_XCNT(j)  (256  + 64 * (j))
#define XB_XSUB(j)  (1280 + 64 * (j))
#define XB_XGEN(j)  (2304 + 64 * (j))
#define XB_TOP      3328
#define XB_TOPGEN   3392
#define XCD_BAR_WORDS 3456
#define XB_SPIN_CAP (1u << 18)
DI unsigned xb_ld(unsigned* p) { return __hip_atomic_load(p, __ATOMIC_RELAXED, __HIP_MEMORY_SCOPE_AGENT); }
DI unsigned xb_add(unsigned* p, unsigned v) { return __hip_atomic_fetch_add(p, v, __ATOMIC_RELAXED, __HIP_MEMORY_SCOPE_AGENT); }
DI unsigned xb_xcc_id() { return (unsigned)__builtin_amdgcn_s_getreg((3 << 11) | 20) & 0xFu; }
#define XB_SPIN(cond, bar) do { unsigned _sp = 0; while (cond) { __builtin_amdgcn_s_sleep(1); \
    if ((++_sp & 255u) == 0u) { if (xb_ld(&(bar)[XB_TMO])) break; if (_sp > XB_SPIN_CAP) { atomicAdd(&(bar)[XB_TMO], 1u); break; } } } } while (0)
struct XcdBarrier { unsigned* bar; unsigned x; volatile LAS unsigned* st; };
DI XcdBarrier xcd_barrier_post(unsigned* bar, volatile LAS unsigned* st) {
  XcdBarrier b; b.bar = bar; b.x = xb_xcc_id(); b.st = st;
  if (threadIdx.x == 0) (void)xb_add(&bar[XB_XCNT(b.x)], 1u);
  return b;
}
DI void xcd_barrier_complete(unsigned* bar, unsigned x, unsigned& nloc, unsigned& nx) {
  const unsigned G = gridDim.x * gridDim.y * gridDim.z;
  unsigned sum, cnt, mine, sp = 0u;
  for (;;) {
    sum = 0u; cnt = 0u; mine = 0u;
#pragma unroll
    for (unsigned j = 0; j < 16; ++j) { const unsigned c = xb_ld(&bar[XB_XCNT(j)]); sum += c; cnt += (c > 0u) ? 1u : 0u; mine = (j == x) ? c : mine; }
    if (sum == G) break;
    __builtin_amdgcn_s_sleep(1);
    if ((++sp & 255u) == 0u) { if (xb_ld(&bar[XB_TMO])) break; if (sp > XB_SPIN_CAP) { atomicAdd(&bar[XB_TMO], 1u); break; } }
  }
  nloc = mine > 0u ? mine : 1u; nx = cnt > 0u ? cnt : 1u;
}
DI void xcd_barrier(const XcdBarrier& b) {
  asm volatile("s_waitcnt vmcnt(0)" ::: "memory");
  __syncthreads();
  if (tidx() == 0) {
    unsigned* bar = b.bar;
    const unsigned bx = (unsigned)__builtin_amdgcn_readfirstlane((int)xb_xcc_id());
    __builtin_amdgcn_s_waitcnt(0);
    unsigned nloc = b.st[0], nx = b.st[1];
    if (nloc == 0u) { xcd_barrier_complete(bar, bx, nloc, nx); b.st[0] = nloc; b.st[1] = nx; }
    const unsigned old = xb_add(&bar[XB_XSUB(bx)], 1u);
    const unsigned gen = old / nloc;
    if (old + 1u == (gen + 1u) * nloc) {
      __builtin_amdgcn_fence(__ATOMIC_RELEASE, "agent");
      asm volatile("s_waitcnt vmcnt(0)" ::: "memory");
      const unsigned og = xb_add(&bar[XB_TOP], 1u);
      const unsigned tg = og / nx;
      if (og + 1u == (tg + 1u) * nx) xb_add(&bar[XB_TOPGEN], 1u);
      else XB_SPIN(xb_ld(&bar[XB_TOPGEN]) == tg, bar);
      __builtin_amdgcn_fence(__ATOMIC_ACQUIRE, "agent");
      xb_add(&bar[XB_XGEN(bx)], 1u);
      asm volatile("s_waitcnt vmcnt(0)" ::: "memory");
    } else {
      XB_SPIN(xb_ld(&bar[XB_XGEN(bx)]) == gen, bar);
      __builtin_amdgcn_fence(__ATOMIC_ACQUIRE, "agent");
      asm volatile("s_waitcnt vmcnt(0)" ::: "memory");
    }
  }
  __syncthreads();
}

#define TASK_LOOP(t, nt, base) for (int t = (int)((blockIdx.x + gridDim.x - ((unsigned)(base) % gridDim.x)) % gridDim.x); t < (nt); t += gridDim.x)

template <bool RFA, bool RFB, class LA, class LB, class EPI>
DI void gemm_tile(u16* smem, int nk, LA la, LB lb, EPI epi) {
  const int tid = tidx(), lane = tid & 63, wave = tid >> 6;
  const int wm = wave >> 2, wn = wave & 3, lr = lane & 31, lh = lane >> 5;
  u16* As = smem;
  u16* Bs = smem + 2 * TILE_ELEMS;
  f32x16 acc[2];
  acc[0] = zero16(); acc[1] = zero16();
  u32x4 ra[2], rb[2];
#define A_ROW(c) (RFA ? ((c) & 127) : ((c) >> 3))
#define A_KC(c) (RFA ? ((c) >> 7) : ((c) & 7))
#define B_ROW(c) (RFB ? ((c) & 127) : ((c) >> 3))
#define B_KC(c) (RFB ? ((c) >> 7) : ((c) & 7))
#pragma unroll
  for (int i = 0; i < 2; ++i) { const int c = tid + NTH * i; ra[i] = la(A_ROW(c), A_KC(c) * 8); rb[i] = lb(B_ROW(c), B_KC(c) * 8); }
#pragma unroll
  for (int i = 0; i < 2; ++i) {
    const int c = tid + NTH * i;
    *(u32x4*)(As + A_ROW(c) * LDT + A_KC(c) * 8) = ra[i];
    *(u32x4*)(Bs + B_ROW(c) * LDT + B_KC(c) * 8) = rb[i];
  }
  __syncthreads();
  for (int kt = 0; kt < nk; ++kt) {
    const int buf = kt & 1;
    if (kt + 1 < nk) {
      const int k0 = (kt + 1) * 64;
#pragma unroll
      for (int i = 0; i < 2; ++i) { const int c = tid + NTH * i; ra[i] = la(A_ROW(c), k0 + A_KC(c) * 8); rb[i] = lb(B_ROW(c), k0 + B_KC(c) * 8); }
    }
    const u16* Ab = As + buf * TILE_ELEMS + (wm * 64 + lr) * LDT + lh * 8;
    const u16* Bb = Bs + buf * TILE_ELEMS + (wn * 32 + lr) * LDT + lh * 8;
#pragma unroll
    for (int ks = 0; ks < 4; ++ks) {
      const bf16x8 a0 = *(const bf16x8*)(Ab + ks * 16);
      const bf16x8 a1 = *(const bf16x8*)(Ab + 32 * LDT + ks * 16);
      const bf16x8 b = *(const bf16x8*)(Bb + ks * 16);
      acc[0] = mfma(a0, b, acc[0]);
      acc[1] = mfma(a1, b, acc[1]);
    }
    if (kt + 1 < nk) {
      u16* Aw = As + (buf ^ 1) * TILE_ELEMS;
      u16* Bw = Bs + (buf ^ 1) * TILE_ELEMS;
#pragma unroll
      for (int i = 0; i < 2; ++i) {
        const int c = tid + NTH * i;
        *(u32x4*)(Aw + A_ROW(c) * LDT + A_KC(c) * 8) = ra[i];
        *(u32x4*)(Bw + B_ROW(c) * LDT + B_KC(c) * 8) = rb[i];
      }
    }
    __syncthreads();
  }
  epi(acc, wm, wn, lane);
}

DI void stage_rc(int b, int& R, int& C) { int st = b / 1024, sb = b % 1024, swz = sb ^ (((sb >> 9) & 1) << 5); R = (st >> 1) * 16 + swz / 64; C = (st & 1) * 32 + (swz % 64) / 2; }

template <class EPI>
DI void gemm256(LAS u16* shm, const u16* __restrict__ A, const u16* __restrict__ Bt, int K, int brow, int bcol, bool pre, bool has_next, int nbrow, int nbcol, EPI epi) {
#define SA(b, h) (shm + ((b) * 2 + (h)) * HT)
#define SB(b, h) (shm + (4 + (b) * 2 + (h)) * HT)
  const int tid = tidx();
  const int wid = __builtin_amdgcn_readfirstlane(tid >> 6), lane = tid & 63, wr = wid >> 2, wc = wid & 3, fr = lane & 15, fq = lane >> 4;
  int r0, c0, r1, c1;
  stage_rc(tid * 16, r0, c0);
  stage_rc(tid * 16 + 8192, r1, c1);
  const unsigned so0 = (unsigned)(r0 * K + c0) * 2u, so1 = (unsigned)(r1 * K + c1) * 2u;
  const unsigned ldsw = (unsigned)wid * 1024u;
  const int lb = ((fr * 64 + fq * 16) ^ ((fr >> 3) << 5));
#define STAGE(P, BASE, br, kt) do { const char* _g = (const char*)((BASE) + (size_t)(br) * K + (kt) * 64); \
    __builtin_amdgcn_global_load_lds((const unsigned*)(_g + so0), (LAS unsigned*)((LAS char*)(P) + ldsw), 16, 0, 0); \
    __builtin_amdgcn_global_load_lds((const unsigned*)(_g + so1), (LAS unsigned*)((LAS char*)(P) + ldsw + 8192), 16, 0, 0); } while (0)
#define LDA(dst, b, h) _Pragma("unroll") for (int m = 0; m < 4; ++m) _Pragma("unroll") for (int k = 0; k < 2; ++k) \
    dst[m][k] = *(const LAS bf16x8*)((const LAS char*)SA(b, h) + ((wr * 4 + m) * 2 + k) * 1024 + lb)
#define LDB(dst, b, h) _Pragma("unroll") for (int n = 0; n < 2; ++n) _Pragma("unroll") for (int k = 0; k < 2; ++k) \
    dst[n][k] = *(const LAS bf16x8*)((const LAS char*)SB(b, h) + ((wc * 2 + n) * 2 + k) * 1024 + lb)
#define MMA(ai, bj, At_, Bt_) do { __builtin_amdgcn_s_setprio(1); \
    _Pragma("unroll") for (int m = 0; m < 4; ++m) _Pragma("unroll") for (int n = 0; n < 2; ++n) _Pragma("unroll") for (int k = 0; k < 2; ++k) \
      acc[ai][bj][m][n] = __builtin_amdgcn_mfma_f32_16x16x32_bf16(At_[m][k], Bt_[n][k], acc[ai][bj][m][n], 0, 0, 0); \
    __builtin_amdgcn_s_setprio(0); } while (0)
#define WAIT_V(n) asm volatile("s_waitcnt vmcnt(" #n ")" ::: "memory")
#define WAIT_L(n) asm volatile("s_waitcnt lgkmcnt(" #n ")" ::: "memory")
#define BAR __builtin_amdgcn_s_barrier()
#define SCHED __builtin_amdgcn_sched_barrier(0)
  f32x4 acc[2][2][4][2];
#pragma unroll
  for (int a = 0; a < 2; ++a)
#pragma unroll
    for (int b = 0; b < 2; ++b)
#pragma unroll
      for (int m = 0; m < 4; ++m)
#pragma unroll
        for (int n = 0; n < 2; ++n) { acc[a][b][m][n][0] = 0.f; acc[a][b][m][n][1] = 0.f; acc[a][b][m][n][2] = 0.f; acc[a][b][m][n][3] = 0.f; }
  bf16x8 At[4][2], B0[2][2], B1[2][2];
  const int nt = K / 64;
  if (!pre) {
    STAGE(SB(0, 0), Bt, bcol, 0); STAGE(SA(0, 0), A, brow, 0);
    STAGE(SB(0, 1), Bt, bcol + 128, 0); STAGE(SA(0, 1), A, brow + 128, 0);
  }
  if (wr == 1) BAR;
  WAIT_V(4); BAR;
  STAGE(SB(1, 0), Bt, bcol, 1); STAGE(SA(1, 0), A, brow, 1); STAGE(SB(1, 1), Bt, bcol + 128, 1);
  WAIT_V(6); BAR;
  for (int t = 0; t < nt - 2; t += 2) {
    LDB(B0, 0, 0); SCHED; LDA(At, 0, 0); STAGE(SA(1, 1), A, brow + 128, t + 1);
    WAIT_L(8); BAR; WAIT_L(0); MMA(0, 0, At, B0); BAR; SCHED;
    LDB(B1, 0, 1); STAGE(SB(0, 0), Bt, bcol, t + 2);
    BAR; WAIT_L(0); MMA(0, 1, At, B1); BAR;
    LDA(At, 0, 1); STAGE(SA(0, 0), A, brow, t + 2);
    BAR; WAIT_L(0); MMA(1, 0, At, B0); BAR; SCHED;
    STAGE(SB(0, 1), Bt, bcol + 128, t + 2);
    WAIT_V(6); BAR; MMA(1, 1, At, B1); BAR;
    LDB(B0, 1, 0); SCHED; LDA(At, 1, 0); STAGE(SA(0, 1), A, brow + 128, t + 2);
    WAIT_L(8); BAR; WAIT_L(0); MMA(0, 0, At, B0); BAR; SCHED;
    LDB(B1, 1, 1); STAGE(SB(1, 0), Bt, bcol, t + 3);
    BAR; WAIT_L(0); MMA(0, 1, At, B1); BAR;
    LDA(At, 1, 1); STAGE(SA(1, 0), A, brow, t + 3);
    BAR; WAIT_L(0); MMA(1, 0, At, B0); BAR; SCHED;
    STAGE(SB(1, 1), Bt, bcol + 128, t + 3);
    WAIT_V(6); BAR; MMA(1, 1, At, B1); BAR;
  }
  { LDB(B0, 0, 0); LDA(At, 0, 0); STAGE(SA(1, 1), A, brow + 128, nt - 1);
    BAR; WAIT_L(0); MMA(0, 0, At, B0); BAR;
    LDB(B1, 0, 1); BAR; WAIT_L(0); MMA(0, 1, At, B1); BAR;
    LDA(At, 0, 1); WAIT_V(4); BAR; WAIT_L(0); MMA(1, 0, At, B0); MMA(1, 1, At, B1); BAR; }
  { LDB(B0, 1, 0); LDA(At, 1, 0); WAIT_V(2); BAR; WAIT_L(0); MMA(0, 0, At, B0); BAR;
    LDB(B1, 1, 1); WAIT_V(0); BAR; WAIT_L(0); MMA(0, 1, At, B1); BAR;
    LDA(At, 1, 1); BAR; WAIT_L(0); MMA(1, 0, At, B0); MMA(1, 1, At, B1); BAR; }
  if (wr == 0) BAR;
  if (has_next) {
    STAGE(SB(0, 0), Bt, nbcol, 0); STAGE(SA(0, 0), A, nbrow, 0);
    STAGE(SB(0, 1), Bt, nbcol + 128, 0); STAGE(SA(0, 1), A, nbrow + 128, 0);
  }
  epi(acc, wr, wc, fr, fq);
  __syncthreads();
}

DI void map256(int t, int nN, int& tn, int& tm) {
  const int p = (t >> 8) * 8 + (t & 7), i = (t >> 3) & 31, pr = nN >> 2;
  const int pm = p / pr;
  tn = ((p + pm) % pr) * 4 + (i & 3);
  tm = pm * 8 + (i >> 2);
}

DI int condrow(int sb, int tok) { return sb == 0 ? 0 : 1 + (sb - 1) * 8 + (tok >> 11); }

DI void convT_tile(float* tile, const float* src, int lds_, int N, u16* dst, int ldd, const float* ksc, int k0, int n0) {
  const int tid = tidx();
#pragma unroll 4
  for (int e = 0; e < 8; ++e) {
    const int idx = tid + NTH * e, kk = idx >> 6, nn = idx & 63;
    float v = (n0 + nn < N) ? src[(size_t)(k0 + kk) * lds_ + n0 + nn] : 0.f;
    if (ksc) v *= ksc[k0 + kk];
    tile[kk * 65 + nn] = v;
  }
  __syncthreads();
#pragma unroll 4
  for (int e = 0; e < 4; ++e) {
    const int idx = tid + NTH * e, nn = idx >> 5, kp = idx & 31;
    if (n0 + nn < N)
      *(unsigned*)(dst + (size_t)(n0 + nn) * ldd + k0 + 2 * kp) = pack2(tile[(2 * kp) * 65 + nn], tile[(2 * kp + 1) * 65 + nn]);
  }
  __syncthreads();
}

DI void convT(float* tile, const float* src, int lds_, int K, int N, u16* dst, int ldd, const float* ksc, int& base) {
  const int ntn = (N + 63) >> 6, nt = (K >> 6) * ntn;
  TASK_LOOP(t, nt, base) {
    const int tn = t % ntn, tk = t / ntn;
    convT_tile(tile, src, lds_, N, dst, ldd, ksc, tk * 64, tn * 64);
  }
  base += nt;
}

DI void prologue_a(const Prm& p, unsigned char* smem_raw, int& base) {
  float* smf = (float*)smem_raw;
  const int tid = tidx();
  const int gtid = blockIdx.x * NTH + tid, gn = gridDim.x * NTH;
  for (int l = 0; l < 4; ++l) {
    convT(smf, p.w_in + (size_t)l * 1024 * 7520 + 768, 7520, 1024, 6752, p.WinT + ((size_t)l * NWP + 1536) * 1024, 1024, nullptr, base);
    convT(smf, p.w1 + (size_t)l * 1024 * 4096, 4096, 1024, 4096, p.W1T + (size_t)l * 4096 * 1024, 1024, nullptr, base);
    convT(smf, p.w2 + (size_t)l * 4096 * 1024, 1024, 4096, 1024, p.W2T + (size_t)l * 1024 * 4096, 4096, nullptr, base);
    convT(smf, p.w_o + (size_t)l * 1024 * 1024, 1024, 1024, 1024, p.WoT + (size_t)l * 1024 * 1024, 1024, nullptr, base);
    convT(smf, p.p_a + (size_t)l * 768 * 1024, 1024, 768, 1024, p.PaT + (size_t)l * 1024 * 768, 768, nullptr, base);
    convT(smf, p.p_b + (size_t)l * 128 * 1024, 1024, 128, 1024, p.PbT + (size_t)l * 1024 * 128, 128, nullptr, base);
    convT(smf, p.p_c + (size_t)l * 384 * 1024, 1024, 384, 1024, p.PcT + (size_t)l * 1024 * 384, 384, nullptr, base);
    convT(smf, p.p_d + (size_t)l * 256 * 1024, 1024, 256, 1024, p.PdT + (size_t)l * 1024 * 256, 256, nullptr, base);
    convT(smf, p.w_uq + (size_t)l * 384 * 384, 384, 384, 384, p.WqT + (size_t)l * 384 * 384, 384, p.qn_g + l * 384, base);
    convT(smf, p.w_ukv + (size_t)l * 320 * 512, 512, 320, 512, p.WkvT + (size_t)l * 512 * 320, 320, p.kvn_g + l * 320, base);
  }
  {
    float* wl = smf;
    float* tab = smf + 32 * 193;
    TASK_LOOP(t, 512, base) {
      const int kb = t & 31, g = (t >> 5) & 3, l = t >> 7, k0 = kb * 32;
      for (int idx = tid; idx < 32 * 192; idx += NTH) {
        const int kk = idx / 192, c = idx - kk * 192;
        wl[kk * 193 + c] = p.w_in[((size_t)l * 1024 + k0 + kk) * 7520 + g * 192 + c];
      }
      if (tid < 192) {
        float s, c;
        sincospif(2.f * (float)tid / 192.f, &s, &c);
        tab[tid] = c; tab[192 + tid] = s;
      }
      __syncthreads();
      for (int e = 0; e < 6; ++e) {
        const int idx = tid + NTH * e, kq = idx & 7, pj = idx >> 3;
        const int part = pj >= 192 ? 1 : 0, j = pj - part * 192;
        const float* tp = tab + part * 192;
        const float* w0 = wl + (kq * 4) * 193;
        float s0 = 0, s1 = 0, s2 = 0, s3 = 0;
        int m = 0;
        for (int c = 0; c < 192; ++c) {
          const float tv = tp[m];
          s0 += w0[c] * tv; s1 += w0[193 + c] * tv; s2 += w0[2 * 193 + c] * tv; s3 += w0[3 * 193 + c] * tv;
          m += j; if (m >= 192) m -= 192;
        }
        if (part) { s0 = -s0; s1 = -s1; s2 = -s2; s3 = -s3; }
        st4bf(p.WinT + ((size_t)l * NWP + part * 768 + g * 192 + j) * 1024 + k0 + kq * 4, s0, s1, s2, s3);
      }
      __syncthreads();
    }
    base += 512;
  }
  {
    float* sil = smf;
    TASK_LOOP(t, 384, base) {
      const int kc = t & 7, cb = (t >> 3) % 12, l = t / 96, k0 = kc * 128;
      for (int idx = tid; idx < 17 * 128; idx += NTH) {
        const int r = idx >> 7, kk = idx & 127;
        const float c = r == 0 ? p.c_prompt[k0 + kk] : p.c_sample[(r - 1) * 1024 + k0 + kk];
        sil[idx] = c / (1.f + __expf(-c));
      }
      __syncthreads();
      const int n = cb * 512 + tid;
      float acc[17];
#pragma unroll
      for (int r = 0; r < 17; ++r) acc[r] = 0.f;
      const float* wp = p.ada_w + ((size_t)l * 1024 + k0) * 6144 + n;
#pragma unroll 4
      for (int kk = 0; kk < 128; ++kk) {
        const float w = wp[(size_t)kk * 6144];
#pragma unroll
        for (int r = 0; r < 17; ++r) acc[r] += sil[r * 128 + kk] * w;
      }
#pragma unroll
      for (int r = 0; r < 17; ++r) p.modpart[((size_t)(kc * 4 + l) * 17 + r) * 6144 + n] = acc[r];
      __syncthreads();
    }
    base += 384;
  }
  for (int idx = gtid; idx < 4 * 32 * 1024; idx += gn) {
    const int l = idx >> 15, rem = idx & 32767;
    p.WinT[((size_t)l * NWP + NW) * 1024 + rem] = 0;
  }
  for (int idx = gtid; idx < 256 * 256; idx += gn) {
    const int row = idx >> 8, kk = idx & 255;
    const int po = row >> 7, k1 = row & 127, pi = kk >> 7, s1 = kk & 127;
    float s, c;
    sincospif(2.f * (float)((k1 * s1) & 127) / 128.f, &s, &c);
    const float v = (po == pi) ? c : (po == 0 ? s : -s);
    p.M1a[idx] = f2bf(v);
  }
  for (int idx = gtid; idx < 32 * 64; idx += gn) {
    const int row = idx >> 6, kk = idx & 63;
    const int po = row >> 4, k1 = row & 15, pi = (kk >> 4) & 1, s1 = kk & 15;
    float s, c;
    sincospif(2.f * (float)((k1 * s1) & 15) / 16.f, &s, &c);
    float v = (po == pi) ? c : (po == 0 ? s : -s);
    if (kk >= 32) v = 0.f;
    p.M1b[idx] = f2bf(v);
  }
  for (int idx = gtid; idx < 128 * 256; idx += gn) {
    const int k2 = idx >> 8, kk = idx & 255, part = kk >> 7, s2 = kk & 127;
    float s, c;
    sincospif(2.f * (float)((k2 * s2) & 127) / 128.f, &s, &c);
    p.M2[idx] = f2bf(part ? s : c);
  }
  for (int idx = gtid; idx < 16384; idx += gn) {
    float s, c;
    sincospif(2.f * (float)idx / 16384.f, &s, &c);
    p.tw[idx] = make_float2(c, s);
  }
  for (int idx = gtid; idx < 16384 * 16; idx += gn) {
    const int pos = idx >> 4, i = idx & 15;
    const float inv = (float)pow(10000.0, -(double)i / 16.0);
    const float ang = (float)pos * inv;
    double rev = (double)ang * 0.15915494309189535;
    rev -= rint(rev);
    float s, c;
    sincospif((float)(2.0 * rev), &s, &c);
    p.rope[idx] = make_float2(c, s);
  }
  for (int idx = gtid; idx < 6 * 129; idx += gn) {
    const int hd = idx / 129, rel = idx - hd * 129 - 64;
    const int dil = 1 << (2 * (hd >> 1));
    const int rd = rel * dil, n = rd < 0 ? -rd : rd;
    int b;
    if (n < 8) b = n;
    else if (n < 15) b = 8; else if (n < 27) b = 9; else if (n < 50) b = 10; else if (n < 91) b = 11;
    else if (n < 166) b = 12; else if (n < 305) b = 13; else if (n < 559) b = 14; else b = 15;
    if (rd > 0) b += 16;
    p.biasT[idx] = p.rel_bias[b * 6 + hd];
  }
  for (int idx = gtid; idx < 4 * 4 * 128 * 128; idx += gn) p.SgW[idx] = f2bf(p.sgu_w[idx]);
}

DI void prologue_b(const Prm& p) {
  const int gtid = blockIdx.x * NTH + tidx(), gn = gridDim.x * NTH;
  for (int idx = gtid; idx < 4 * 17 * 6144; idx += gn) {
    const int l = idx / (17 * 6144), n = idx % 6144;
    float s = p.ada_b[l * 6144 + n];
#pragma unroll
    for (int kc = 0; kc < 8; ++kc) s += p.modpart[(size_t)kc * 4 * 17 * 6144 + idx];
    p.mod[idx] = s;
  }
}

DI void phase_norm(const Prm& p, const float* xsrc, const float* g, const float* modl, int shoff, int scoff, int sb) {
  const int tid = tidx(), lane = tid & 63;
  const int gw = blockIdx.x * 8 + (tid >> 6), nw = gridDim.x * 8;
  for (int row = gw; row < TB; row += nw) {
    const int cond = condrow(sb, row);
    const float* xr = xsrc + (size_t)row * 1024;
    float4 v[4];
    float ss = 0.f;
#pragma unroll
    for (int i = 0; i < 4; ++i) {
      v[i] = *(const float4*)(xr + i * 256 + lane * 4);
      ss += v[i].x * v[i].x + v[i].y * v[i].y + v[i].z * v[i].z + v[i].w * v[i].w;
    }
#pragma unroll
    for (int off = 32; off >= 1; off >>= 1) ss += __shfl_xor(ss, off);
    const float rstd = rsqrtf(ss * (1.f / 1024.f) + 1e-6f);
    const float* sc = modl + cond * 6144 + scoff;
    const float* sh = modl + cond * 6144 + shoff;
#pragma unroll
    for (int i = 0; i < 4; ++i) {
      const int col = i * 256 + lane * 4;
      const float4 gg = *(const float4*)(g + col), s4 = *(const float4*)(sc + col), h4 = *(const float4*)(sh + col);
      st4bf(p.hbuf + (size_t)row * 1024 + col,
            v[i].x * rstd * gg.x * (1.f + s4.x) + h4.x, v[i].y * rstd * gg.y * (1.f + s4.y) + h4.y,
            v[i].z * rstd * gg.z * (1.f + s4.z) + h4.z, v[i].w * rstd * gg.w * (1.f + s4.w) + h4.w);
    }
  }
}

DI float sigm(float x) { return __builtin_amdgcn_rcpf(1.f + __expf(-x)); }

DI void phase_inproj(const Prm& p, unsigned char* smem_raw, int l, int S, int& base) {
  const u16* W = p.WinT + (size_t)l * NWP * 1024;
  LAS u16* shm = (LAS u16*)smem_raw;
  bool pre = false;
  TASK_LOOP(t, 32 * 64, base) {
    int tn, tm;
    map256(t, 32, tn, tm);
    const int brow = tn * 256, bcol = tm * 256;
    const int tnx = t + (int)gridDim.x;
    const bool has_next = tnx < (32 * 64);
    int tn2 = 0, tm2 = 0;
    if (has_next) map256(tnx, 32, tn2, tm2);
    const int nbrow = tn2 * 256, nbcol = tm2 * 256;
    auto epi = [&](f32x4 (&acc)[2][2][4][2], int wr, int wc, int fr, int fq) __attribute__((always_inline)) {
#pragma unroll
      for (int ai = 0; ai < 2; ++ai)
#pragma unroll
        for (int m = 0; m < 4; ++m) {
          const int nb = brow + ai * 128 + wr * 64 + m * 16;
#pragma unroll
          for (int bj = 0; bj < 2; ++bj)
#pragma unroll
            for (int n = 0; n < 2; ++n) {
              const int tok = bcol + bj * 128 + wc * 32 + n * 16 + fr;
              const f32x4 v = acc[ai][bj][m][n];
              const int nn = nb + fq * 4;
              if (nb < 1536) {
#pragma unroll
                for (int j = 0; j < 4; ++j) p.UT[(size_t)(nn + j) * TBP + tok] = f2bf(v[j]);
              } else if (nb < 2688) {
                st4bf(p.bqkv + (size_t)tok * 1152 + (nn - 1536), v[0], v[1], v[2], v[3]);
              } else if (nb < 3072) {
                st4bf(p.cu + (size_t)tok * 384 + (nn - 2688), v[0], v[1], v[2], v[3]);
              } else if (nb < 3456) {
#pragma unroll
                for (int j = 0; j < 4; ++j) p.cvT[(size_t)(nn - 3072 + j) * TBP + tok] = f2bf(v[j]);
              } else if (nb < 3840) {
                st4bf(p.dcq + (size_t)tok * 384 + (nn - 3456), v[0], v[1], v[2], v[3]);
              } else if (nb < 4160) {
                st4bf(p.dckv + (size_t)tok * 320 + (nn - 3840), v[0], v[1], v[2], v[3]);
              } else if (nb < 4192) {
                if (nb == 4160) {
                  const f32x4 v2 = acc[ai][bj][(m + 1) & 3][n];
                  const int pos = tok & (S - 1);
#pragma unroll
                  for (int j = 0; j < 4; ++j) {
                    const int ii = fq * 4 + j;
                    const float2 cs = p.rope[pos * 16 + ii];
                    const u16 o1 = f2bf(v[j] * cs.x - v2[j] * cs.y), o2 = f2bf(v[j] * cs.y + v2[j] * cs.x);
#pragma unroll
                    for (int hh = 0; hh < 4; ++hh) {
                      p.kc[(size_t)tok * 384 + hh * 96 + 64 + ii] = o1;
                      p.kc[(size_t)tok * 384 + hh * 96 + 80 + ii] = o2;
                    }
                  }
                }
              } else {
                st4bf_nt(p.zg + (size_t)tok * 4096 + (nn - 4192), sigm(v[0]), sigm(v[1]), sigm(v[2]), sigm(v[3]));
              }
            }
          __builtin_amdgcn_sched_barrier(0);
        }
    };
    gemm256(shm, W, p.hbuf, 1024, brow, bcol, pre, has_next, nbrow, nbcol, epi);
    pre = has_next;
  }
  base += 32 * 64;
}

DI void phase_inproj_tail(const Prm& p, unsigned char* smem_raw, int l, int& base) {
  const u16* W = p.WinT + (size_t)l * NWP * 1024;
  u16* smem = (u16*)smem_raw;
  TASK_LOOP(t, 128, base) {
    const int n0 = 8192, m0 = t * 128;
    auto la = [&](int row, int k) __attribute__((always_inline)) { return *(const u32x4*)(W + (size_t)(n0 + row) * 1024 + k); };
    auto lb = [&](int row, int k) __attribute__((always_inline)) { return *(const u32x4*)(p.hbuf + (size_t)(m0 + row) * 1024 + k); };
    auto epi = [&](f32x16 (&acc)[2], int wm, int wn, int lane) __attribute__((always_inline)) {
      const int lr = lane & 31, lh = lane >> 5;
      const int tok = m0 + wn * 32 + lr;
#pragma unroll
      for (int i = 0; i < 2; ++i) {
        const int nb = n0 + wm * 64 + i * 32;
        if (nb >= NW) continue;
#pragma unroll
        for (int q = 0; q < 4; ++q)
          st4bf(p.zg + (size_t)tok * 4096 + (nb - 4192) + 8 * q + 4 * lh, sigm(acc[i][4 * q]), sigm(acc[i][4 * q + 1]), sigm(acc[i][4 * q + 2]),
                sigm(acc[i][4 * q + 3]));
      }
    };
    gemm_tile<false, false>(smem, 16, la, lb, epi);
  }
  base += 128;
}


DI void phase_inproj_probe(const Prm& p, unsigned char* smem_raw, int l, int& base) {
  const u16* W = p.WinT + (size_t)l * NWP * 1024;
  LAS u16* shm = (LAS u16*)smem_raw;
  bool pre = false;
  TASK_LOOP(t, 32 * 64, base) {
    int tn, tm;
    map256(t, 32, tn, tm);
    const int brow = tn * 256, bcol = tm * 256;
    const int tnx = t + (int)gridDim.x;
    const bool has_next = tnx < (32 * 64);
    int tn2 = 0, tm2 = 0;
    if (has_next) map256(tnx, 32, tn2, tm2);
    const int nbrow = tn2 * 256, nbcol = tm2 * 256;
    auto epi = [&](f32x4 (&acc)[2][2][4][2], int wr, int wc, int fr, int fq) __attribute__((always_inline)) {
#pragma unroll
      for (int bj = 0; bj < 2; ++bj)
#pragma unroll
        for (int n = 0; n < 2; ++n) {
          const int tok = bcol + bj * 128 + wc * 32 + n * 16 + fr;
#pragma unroll
          for (int ai = 0; ai < 2; ++ai)
#pragma unroll
            for (int m = 0; m < 4; ++m) {
              const int nn = ((brow + ai * 128 + wr * 64 + m * 16) & 1023) + fq * 4;
              const f32x4 v = acc[ai][bj][m][n];
              st4bf(p.Gp + (size_t)tok * 1024 + nn, v[0], v[1], v[2], v[3]);
            }
        }
    };
    gemm256(shm, W, p.hbuf, 1024, brow, bcol, pre, has_next, nbrow, nbcol, epi);
    pre = has_next;
  }
  base += 32 * 64;
}

DI void phase_fft1(const Prm& p, u16* smem, int S, int nseq, int N1, int lgN1, int& base) {
  const int nkt = N1 == 128 ? 2 : 1;
  const u16* M1 = N1 == 128 ? p.M1a : p.M1b;
  const int ldm = N1 == 128 ? 256 : 64;
  const int nk = N1 == 128 ? 4 : 1;
  const int ntask = nseq * 768 * nkt;
  const int twmul = 16384 / S;
  TASK_LOOP(t, ntask, base) {
    const int k1t = t % nkt, col = (t / nkt) % 768, seq = t / (nkt * 768);
    const int k1base = k1t * 64;
    auto la = [&](int row, int k) __attribute__((always_inline)) {
      const int k1 = k1base + (row >> 6) * 32 + (row & 31), ii = (row >> 5) & 1;
      if (k1 >= N1 || k >= 2 * N1) return zero4();
      return *(const u32x4*)(M1 + (ii * N1 + k1) * ldm + k);
    };
    auto lb = [&](int row, int k) __attribute__((always_inline)) {
      if (k >= 2 * N1) return zero4();
      const int part = k >> lgN1, s1 = k & (N1 - 1);
      const u16* src = p.UT + (size_t)(part * 768 + col) * TBP + seq * S + s1 * 128 + row;
      u32x4 v;
#pragma unroll
      for (int jj = 0; jj < 4; ++jj) v[jj] = (unsigned)src[(2 * jj) * 128] | ((unsigned)src[(2 * jj + 1) * 128] << 16);
      return v;
    };
    auto epi = [&](f32x16 (&acc)[2], int wm, int wn, int lane) __attribute__((always_inline)) {
      const int lr = lane & 31, lh = lane >> 5;
      const int s2 = wn * 32 + lr;
#pragma unroll
      for (int r = 0; r < 16; ++r) {
        const int k1 = k1base + wm * 32 + rowmap(r, lh);
        if (k1 < N1) {
          const float re = acc[0][r], im = acc[1][r];
          const float2 cs = p.tw[(s2 * k1) * twmul];
          const size_t o = ((size_t)((seq * N1 + k1) * 2) * 768 + col) * 128 + s2;
          p.Gp[o] = f2bf(cs.x * re + cs.y * im);
          p.Gp[o + 768 * 128] = f2bf(cs.x * im - cs.y * re);
        }
      }
    };
    gemm_tile<false, true>(smem, nk, la, lb, epi);
  }
  base += ntask;
}


DI void phase_fft1_small(const Prm& p, int nseq) {
  constexpr float C16[16] = {1.f, 0.92387953251128674f, 0.70710678118654752f, 0.38268343236508977f, 0.f, -0.38268343236508977f, -0.70710678118654752f,
                             -0.92387953251128674f, -1.f, -0.92387953251128674f, -0.70710678118654752f, -0.38268343236508977f, 0.f,
                             0.38268343236508977f, 0.70710678118654752f, 0.92387953251128674f};
  constexpr float S16[16] = {0.f, 0.38268343236508977f, 0.70710678118654752f, 0.92387953251128674f, 1.f, 0.92387953251128674f, 0.70710678118654752f,
                             0.38268343236508977f, 0.f, -0.38268343236508977f, -0.70710678118654752f, -0.92387953251128674f, -1.f,
                             -0.92387953251128674f, -0.70710678118654752f, -0.38268343236508977f};
  const int gtid = blockIdx.x * NTH + tidx(), gn = gridDim.x * NTH;
  for (int idx = gtid; idx < nseq * 768 * 128; idx += gn) {
    const int s2 = idx & 127, col = (idx >> 7) % 768, seq = idx / (768 * 128);
    const u16* ur = p.UT + (size_t)col * TBP + seq * 2048 + s2;
    const u16* ui = ur + (size_t)768 * TBP;
    float xr[16], xi[16];
#pragma unroll
    for (int s1 = 0; s1 < 16; ++s1) { xr[s1] = bf2f(ur[s1 * 128]); xi[s1] = bf2f(ui[s1 * 128]); }
    u16* go = p.Gp + ((size_t)(seq * 16 * 2) * 768 + col) * 128 + s2;
#pragma unroll
    for (int k1 = 0; k1 < 16; ++k1) {
      float gr = 0.f, gi = 0.f;
#pragma unroll
      for (int s1 = 0; s1 < 16; ++s1) {
        const float c = C16[(k1 * s1) & 15], sn = S16[(k1 * s1) & 15];
        gr += c * xr[s1] + sn * xi[s1];
        gi += c * xi[s1] - sn * xr[s1];
      }
      const float2 cs = p.tw[(s2 * k1) * 8];
      go[(size_t)(k1 * 2) * 768 * 128] = f2bf(cs.x * gr + cs.y * gi);
      go[(size_t)(k1 * 2 + 1) * 768 * 128] = f2bf(cs.x * gi - cs.y * gr);
    }
  }
}

DI void phase_fft2(const Prm& p, u16* smem, int S, int nseq, int N1, int& base) {
  const int ntask = nseq * N1 * 6;
  const float scale = rsqrtf((float)S * 192.f);
  u16* fa = p.UT;
  TASK_LOOP(t, ntask, base) {
    const int ct = t % 6, k1 = (t / 6) % N1, seq = t / (6 * N1);
    const u16* gb = p.Gp + ((size_t)((seq * N1 + k1) * 2) * 768 + ct * 128) * 128;
    auto la = [&](int row, int k) __attribute__((always_inline)) { return *(const u32x4*)(p.M2 + row * 256 + k); };
    auto lb = [&](int row, int k) __attribute__((always_inline)) {
      const int part = k >> 7, s2 = k & 127;
      return *(const u32x4*)(gb + ((size_t)part * 768 + row) * 128 + s2);
    };
    auto epi = [&](f32x16 (&acc)[2], int wm, int wn, int lane) __attribute__((always_inline)) {
      const int lr = lane & 31, lh = lane >> 5;
      const int col = ct * 128 + wn * 32 + lr;
#pragma unroll
      for (int i = 0; i < 2; ++i)
#pragma unroll
        for (int r = 0; r < 16; ++r) {
          const int k2 = wm * 64 + i * 32 + rowmap(r, lh);
          const int tok = seq * S + k1 + N1 * k2;
          fa[(size_t)tok * 768 + col] = f2bf(acc[i][r] * scale);
        }
    };
    gemm_tile<false, false>(smem, 4, la, lb, epi);
  }
  base += ntask;
}

DI void phase_mixc(const Prm& p, unsigned char* smem_raw, int l, int& base) {
  u16* smem = (u16*)smem_raw;
  float* st = (float*)(smem_raw + GEMM_SMEM);
  float* red = (float*)smem_raw;
  const int tid = tidx();
  TASK_LOOP(t, 512, base) {
    const int h = t & 3, ch = t >> 2, tok0 = ch * 128;
    {
      const int q = tid & 127, qf = tid >> 7;
      float s = 0.f, ss = 0.f;
      const u16* src = p.cvT + (size_t)(qf * 96) * TBP + tok0 + q;
      for (int c = 0; c < 96; ++c) { const float v = bf2f(src[(size_t)c * TBP]); s += v; ss += v * v; }
      red[qf * 256 + q * 2] = s; red[qf * 256 + q * 2 + 1] = ss;
      __syncthreads();
      if (tid < 128) {
        const float s1 = red[q * 2] + red[256 + q * 2] + red[512 + q * 2] + red[768 + q * 2];
        const float s2 = red[q * 2 + 1] + red[256 + q * 2 + 1] + red[512 + q * 2 + 1] + red[768 + q * 2 + 1];
        const float mu = s1 * (1.f / 384.f);
        const float var = fmaxf(s2 * (1.f / 384.f) - mu * mu, 0.f);
        st[q] = mu; st[128 + q] = rsqrtf(var + 1e-6f);
      }
      __syncthreads();
    }
    const u16* Wm = p.SgW + (size_t)((l * 4 + h) * 128) * 128;
    auto la = [&](int row, int k) __attribute__((always_inline)) { return *(const u32x4*)(Wm + row * 128 + k); };
    auto lb = [&](int row, int k) __attribute__((always_inline)) {
      if (row >= 96) return zero4();
      const int c = h * 96 + row;
      const u32x4 raw = *(const u32x4*)(p.cvT + (size_t)c * TBP + tok0 + k);
      const float g = p.ln_g[l * 384 + c], b = p.ln_b[l * 384 + c];
      u32x4 o;
#pragma unroll
      for (int jj = 0; jj < 4; ++jj) {
        const float v0 = (bflo(raw[jj]) - st[k + 2 * jj]) * st[128 + k + 2 * jj] * g + b;
        const float v1 = (bfhi(raw[jj]) - st[k + 2 * jj + 1]) * st[128 + k + 2 * jj + 1] * g + b;
        o[jj] = pack2(v0, v1);
      }
      return o;
    };
    auto epi = [&](f32x16 (&acc)[2], int wm, int wn, int lane) __attribute__((always_inline)) {
      const int lr = lane & 31, lh = lane >> 5;
      const int cl = wn * 32 + lr;
      if (cl < 96) {
#pragma unroll
        for (int i = 0; i < 2; ++i)
#pragma unroll
          for (int r = 0; r < 16; ++r) {
            const int pp = wm * 64 + i * 32 + rowmap(r, lh);
            const float val = acc[i][r] + p.sgu_b[(l * 4 + h) * 128 + pp];
            u16* dst = p.cu + (size_t)(tok0 + pp) * 384 + h * 96 + cl;
            *dst = f2bf(bf2f(*dst) * val);
          }
      }
    };
    gemm_tile<false, false>(smem, 2, la, lb, epi);
  }
  base += 512;
}

DI void phase_qup(const Prm& p, unsigned char* smem_raw, int l, int S, int& base) {
  u16* smem = (u16*)smem_raw;
  float* st = (float*)(smem_raw + GEMM_SMEM);
  const int tid = tidx();
  const float QS = 0.10206207261596577f * LOG2E;
  TASK_LOOP(t, 3 * 128, base) {
    const int tn = t % 3, tm = t / 3, n0 = tn * 128, m0 = tm * 128;
    {
      const int row = tid >> 2, qf = tid & 3;
      const u16* src = p.dcq + (size_t)(m0 + row) * 384 + qf * 96;
      float ss = 0.f;
#pragma unroll 4
      for (int c = 0; c < 12; ++c) {
        const u32x4 v = *(const u32x4*)(src + c * 8);
#pragma unroll
        for (int jj = 0; jj < 4; ++jj) { const float a = bflo(v[jj]), b = bfhi(v[jj]); ss += a * a + b * b; }
      }
      ss += __shfl_xor(ss, 1);
      ss += __shfl_xor(ss, 2);
      if (qf == 0) st[row] = rsqrtf(ss * (1.f / 384.f) + 1e-6f);
      __syncthreads();
    }
    const u16* W = p.WqT + (size_t)l * 384 * 384;
    auto la = [&](int row, int k) __attribute__((always_inline)) { return *(const u32x4*)(W + (size_t)(n0 + row) * 384 + k); };
    auto lb = [&](int row, int k) __attribute__((always_inline)) { return *(const u32x4*)(p.dcq + (size_t)(m0 + row) * 384 + k); };
    auto epi = [&](f32x16 (&acc)[2], int wm, int wn, int lane) __attribute__((always_inline)) {
      const int lr = lane & 31, lh = lane >> 5;
      const int tokl = wn * 32 + lr, tok = m0 + tokl;
      const float sc = st[tokl] * QS;
#pragma unroll
      for (int i = 0; i < 2; ++i) {
        const int nb = n0 + wm * 64 + i * 32;
        const int head = nb / 96, within = nb - head * 96;
        const f32x16& a = acc[i];
        if (within < 64) {
#pragma unroll
          for (int q = 0; q < 4; ++q)
            st4bf(p.qc + (size_t)tok * 384 + nb + 8 * q + 4 * lh, a[4 * q] * sc, a[4 * q + 1] * sc, a[4 * q + 2] * sc, a[4 * q + 3] * sc);
        } else {
          const int pos = tok & (S - 1);
#pragma unroll
          for (int q = 0; q < 2; ++q)
#pragma unroll
            for (int e = 0; e < 4; ++e) {
              const int r = 4 * q + e, ii = 8 * q + 4 * lh + e;
              const float2 cs = p.rope[pos * 16 + ii];
              const float x1 = a[r] * sc, x2 = a[r + 8] * sc;
              p.qc[(size_t)tok * 384 + head * 96 + 64 + ii] = f2bf(x1 * cs.x - x2 * cs.y);
              p.qc[(size_t)tok * 384 + head * 96 + 80 + ii] = f2bf(x1 * cs.y + x2 * cs.x);
            }
        }
      }
    };
    gemm_tile<false, false>(smem, 6, la, lb, epi);
    __syncthreads();
  }
  base += 3 * 128;
}

DI void phase_kvup(const Prm& p, unsigned char* smem_raw, int l, int& base) {
  u16* smem = (u16*)smem_raw;
  float* st = (float*)(smem_raw + GEMM_SMEM);
  const int tid = tidx();
  TASK_LOOP(t, 4 * 128, base) {
    const int tn = t & 3, tm = t >> 2, n0 = tn * 128, m0 = tm * 128;
    {
      const int row = tid >> 2, qf = tid & 3;
      const u16* src = p.dckv + (size_t)(m0 + row) * 320 + qf * 80;
      float ss = 0.f;
#pragma unroll 5
      for (int c = 0; c < 10; ++c) {
        const u32x4 v = *(const u32x4*)(src + c * 8);
#pragma unroll
        for (int jj = 0; jj < 4; ++jj) { const float a = bflo(v[jj]), b = bfhi(v[jj]); ss += a * a + b * b; }
      }
      ss += __shfl_xor(ss, 1);
      ss += __shfl_xor(ss, 2);
      if (qf == 0) st[row] = rsqrtf(ss * (1.f / 320.f) + 1e-6f);
      __syncthreads();
    }
    const u16* W = p.WkvT + (size_t)l * 512 * 320;
    auto la = [&](int row, int k) __attribute__((always_inline)) { return *(const u32x4*)(W + (size_t)(n0 + row) * 320 + k); };
    auto lb = [&](int row, int k) __attribute__((always_inline)) { return *(const u32x4*)(p.dckv + (size_t)(m0 + row) * 320 + k); };
    auto epi = [&](f32x16 (&acc)[2], int wm, int wn, int lane) __attribute__((always_inline)) {
      const int lr = lane & 31, lh = lane >> 5;
      const int head = tn;
      const int tokl = wn * 32 + lr, tok = m0 + tokl;
      const float sc = st[tokl];
#pragma unroll
      for (int i = 0; i < 2; ++i) {
        const int within = wm * 64 + i * 32;
        const f32x16& a = acc[i];
        if (within < 64) {
#pragma unroll
          for (int q = 0; q < 4; ++q)
            st4bf(p.kc + (size_t)tok * 384 + head * 96 + within + 8 * q + 4 * lh, a[4 * q] * sc, a[4 * q + 1] * sc, a[4 * q + 2] * sc, a[4 * q + 3] * sc);
        } else {
#pragma unroll
          for (int r = 0; r < 16; ++r)
            p.vT[(size_t)(head * 64 + within - 64 + rowmap(r, lh)) * TBP + tok] = f2bf(a[r] * sc);
        }
      }
    };
    gemm_tile<false, false>(smem, 5, la, lb, epi);
    __syncthreads();
  }
  base += 4 * 128;
}

DI void phase_mixb(const Prm& p, unsigned char* smem_raw, int S, int lgS, int& base) {
  float* bt = (float*)smem_raw;
  const int tid = tidx(), lane = tid & 63, wave = tid >> 6, lr = lane & 31, lh = lane >> 5;
  u16* vt = (u16*)(smem_raw + 3328) + wave * (64 * 40);
  for (int idx = tid; idx < 774; idx += NTH) bt[idx] = p.biasT[idx];
  __syncthreads();
  TASK_LOOP(t, 384, base) {
    const int wt = t * 8 + wave;
    const int hg = wt & 1, g = (wt >> 1) % 3, blk = wt / 6;
    const int seq = blk >> (lgS - 5), b_in = blk & ((S >> 5) - 1);
    const int lgd = 2 * g, L = S >> lgd;
    const int lgbpr = lgS - lgd - 5;
    const int res = b_in >> lgbpr, i0 = (b_in & ((1 << lgbpr) - 1)) << 5;
    const int tokbase = seq * S + res;
    const int hd = g * 2 + hg, hc = hd * 64;
    const int qi = i0 + lr;
    const int qtok = tokbase + (qi << lgd);
    bf16x8 qf[4];
#pragma unroll
    for (int ks = 0; ks < 4; ++ks) qf[ks] = *(const bf16x8*)(p.bqkv + (size_t)qtok * 1152 + hc + ks * 16 + lh * 8);
    f32x16 sc[5];
#pragma unroll
    for (int tt = 0; tt < 5; ++tt) {
      int ik = i0 - 64 + 32 * tt + lr;
      ik = min(max(ik, 0), L - 1);
      const u16* kp = p.bqkv + (size_t)(tokbase + (ik << lgd)) * 1152 + 384 + hc + lh * 8;
      sc[tt] = zero16();
#pragma unroll
      for (int ks = 0; ks < 4; ++ks) sc[tt] = mfma(*(const bf16x8*)(kp + ks * 16), qf[ks], sc[tt]);
    }
    float mx = -1e30f;
#pragma unroll
    for (int tt = 0; tt < 5; ++tt)
#pragma unroll
      for (int r = 0; r < 16; ++r) {
        const int ik = i0 - 64 + 32 * tt + rowmap(r, lh);
        const int rel = ik - qi;
        const bool valid = (rel >= -64) && (rel <= 64) && (ik >= 0) && (ik < L);
        const int bi = min(max(rel + 64, 0), 128);
        const float s = valid ? (sc[tt][r] * 0.125f + bt[hd * 129 + bi]) * LOG2E : -1e30f;
        sc[tt][r] = s;
        mx = fmaxf(mx, s);
      }
    mx = fmaxf(mx, __shfl_xor(mx, 32));
    float sum = 0.f;
#pragma unroll
    for (int tt = 0; tt < 5; ++tt)
#pragma unroll
      for (int r = 0; r < 16; ++r) {
        const float pv = ex2(sc[tt][r] - mx);
        sum += pv;
        sc[tt][r] = pv;
      }
    sum += __shfl_xor(sum, 32);
    f32x16 oacc[2];
    oacc[0] = zero16(); oacc[1] = zero16();
#pragma unroll
    for (int tt = 0; tt < 5; ++tt) {
#pragma unroll
      for (int e = 0; e < 4; ++e) {
        const int c = lane + 64 * e, key = c >> 3, dch = c & 7;
        int ik = i0 - 64 + 32 * tt + key;
        ik = min(max(ik, 0), L - 1);
        const u32x4 raw = *(const u32x4*)(p.bqkv + (size_t)(tokbase + (ik << lgd)) * 1152 + 768 + hc + dch * 8);
#pragma unroll
        for (int jj = 0; jj < 4; ++jj) {
          vt[(dch * 8 + 2 * jj) * 40 + key] = (u16)(raw[jj] & 0xffffu);
          vt[(dch * 8 + 2 * jj + 1) * 40 + key] = (u16)(raw[jj] >> 16);
        }
      }
      __syncthreads();
#pragma unroll
      for (int u = 0; u < 2; ++u) {
        u32x4 pk;
#pragma unroll
        for (int jj = 0; jj < 4; ++jj) pk[jj] = pack2(sc[tt][8 * u + 2 * jj], sc[tt][8 * u + 2 * jj + 1]);
        const bf16x8 pf = __builtin_bit_cast(bf16x8, pk);
#pragma unroll
        for (int dt = 0; dt < 2; ++dt) {
          const u16* vp = vt + (dt * 32 + lr) * 40 + 16 * u + 4 * lh;
          u32x4 vv;
          const u32x2 lo = *(const u32x2*)vp, hi = *(const u32x2*)(vp + 8);
          vv[0] = lo[0]; vv[1] = lo[1]; vv[2] = hi[0]; vv[3] = hi[1];
          oacc[dt] = mfma(__builtin_bit_cast(bf16x8, vv), pf, oacc[dt]);
        }
      }
      __syncthreads();
    }
    const float inv = 1.f / sum;
#pragma unroll
    for (int dt = 0; dt < 2; ++dt)
#pragma unroll
      for (int q = 0; q < 4; ++q) {
        float4 o;
        o.x = oacc[dt][4 * q] * inv; o.y = oacc[dt][4 * q + 1] * inv; o.z = oacc[dt][4 * q + 2] * inv; o.w = oacc[dt][4 * q + 3] * inv;
        *(float4*)(p.og + (size_t)qtok * 384 + hc + dt * 32 + 8 * q + 4 * lh) = o;
      }
    if (lh == 0) p.lse[(size_t)qtok * 6 + hd] = (mx + __log2f(sum)) * LN2;
  }
  base += 384;
  __syncthreads();
}

DI void phase_combb(const Prm& p) {
  const int gtid = blockIdx.x * NTH + tidx(), gn = gridDim.x * NTH;
  for (int idx = gtid; idx < TB * 32; idx += gn) {
    const int dq = idx & 15, hg = (idx >> 4) & 1, tok = idx >> 5;
    const float l0 = p.lse[(size_t)tok * 6 + hg], l1 = p.lse[(size_t)tok * 6 + 2 + hg], l2 = p.lse[(size_t)tok * 6 + 4 + hg];
    const float mx = fmaxf(l0, fmaxf(l1, l2));
    const float e0 = __expf(l0 - mx), e1 = __expf(l1 - mx), e2 = __expf(l2 - mx);
    const float inv = 1.f / (e0 + e1 + e2);
    const float4 a = *(const float4*)(p.og + (size_t)tok * 384 + hg * 64 + dq * 4);
    const float4 b = *(const float4*)(p.og + (size_t)tok * 384 + 128 + hg * 64 + dq * 4);
    const float4 c = *(const float4*)(p.og + (size_t)tok * 384 + 256 + hg * 64 + dq * 4);
    st4bf(p.ob + (size_t)tok * 128 + hg * 64 + dq * 4, (e0 * a.x + e1 * b.x + e2 * c.x) * inv, (e0 * a.y + e1 * b.y + e2 * c.y) * inv,
          (e0 * a.z + e1 * b.z + e2 * c.z) * inv, (e0 * a.w + e1 * b.w + e2 * c.w) * inv);
  }
}

constexpr int KS_ELEMS = 128 * 104, VS_ELEMS = 64 * 136;
DI void phase_mla(const Prm& p, unsigned char* smem_raw, int S, int lgS, int& base) {
  u16* Ks = (u16*)smem_raw;
  u16* Vs = Ks + 2 * KS_ELEMS;
  const int tid = tidx(), lane = tid & 63, wave = tid >> 6, lr = lane & 31, lh = lane >> 5;
  const int nkt = S >> 7;
  TASK_LOOP(t, 256, base) {
    const int head = t & 3, qb = t >> 2, tok0 = qb * 256;
    const int seqtok0 = (tok0 >> lgS) << lgS;
    const int qtok = tok0 + wave * 32 + lr;
    bf16x8 qf[6];
#pragma unroll
    for (int ks = 0; ks < 6; ++ks) qf[ks] = *(const bf16x8*)(p.qc + (size_t)qtok * 384 + head * 96 + ks * 16 + lh * 8);
    const u16* kbase = p.kc + (size_t)seqtok0 * 384 + head * 96;
    const u16* vbase = p.vT + (size_t)(head * 64) * TBP + seqtok0;
    u32x4 rk[3], rv[2];
    auto gload = [&](int kt) __attribute__((always_inline)) {
#pragma unroll
      for (int e = 0; e < 3; ++e) {
        const int c = tid + NTH * e, key = c / 12, dc = c - key * 12;
        rk[e] = *(const u32x4*)(kbase + (size_t)(kt * 128 + key) * 384 + dc * 8);
      }
#pragma unroll
      for (int e = 0; e < 2; ++e) {
        const int c = tid + NTH * e, d = c >> 4, kch = c & 15;
        rv[e] = *(const u32x4*)(vbase + (size_t)d * TBP + kt * 128 + kch * 8);
      }
    };
    auto sstore = [&](int buf) __attribute__((always_inline)) {
#pragma unroll
      for (int e = 0; e < 3; ++e) {
        const int c = tid + NTH * e, key = c / 12, dc = c - key * 12;
        *(u32x4*)(Ks + buf * KS_ELEMS + key * 104 + dc * 8) = rk[e];
      }
#pragma unroll
      for (int e = 0; e < 2; ++e) {
        const int c = tid + NTH * e, d = c >> 4, kch = c & 15;
        *(u32x4*)(Vs + buf * VS_ELEMS + d * 136 + kch * 8) = rv[e];
      }
    };
    float m = -1e30f;
    f32x2 lsum2 = {0.f, 0.f};
    f32x16 oacc[2];
    oacc[0] = zero16(); oacc[1] = zero16();
    gload(0);
    sstore(0);
    __syncthreads();
    for (int kt = 0; kt < nkt; ++kt) {
      const int buf = kt & 1;
      if (kt + 1 < nkt) gload(kt + 1);
      f32x16 s[4];
#pragma unroll
      for (int kk = 0; kk < 4; ++kk) s[kk] = zero16();
      {
        const u16* kp = Ks + buf * KS_ELEMS + lr * 104 + lh * 8;
        bf16x8 kf[4];
#pragma unroll
        for (int kk = 0; kk < 4; ++kk) kf[kk] = *(const bf16x8*)(kp + kk * 32 * 104);
#pragma unroll
        for (int ks = 0; ks < 6; ++ks) {
          bf16x8 kn[4];
          if (ks < 5) {
#pragma unroll
            for (int kk = 0; kk < 4; ++kk) kn[kk] = *(const bf16x8*)(kp + kk * 32 * 104 + (ks + 1) * 16);
          }
#pragma unroll
          for (int kk = 0; kk < 4; ++kk) s[kk] = mfma(kf[kk], qf[ks], s[kk]);
          if (ks < 5) {
#pragma unroll
            for (int kk = 0; kk < 4; ++kk) kf[kk] = kn[kk];
          }
        }
      }
      float mloc = -1e30f;
#pragma unroll
      for (int kk = 0; kk < 4; ++kk)
#pragma unroll
        for (int r = 0; r < 16; ++r) mloc = fmaxf(mloc, s[kk][r]);
      mloc = fmaxf(mloc, __shfl_xor(mloc, 32));
      const float mnew = fmaxf(m, mloc);
      const float alpha = ex2(m - mnew);
      m = mnew;
      lsum2 *= alpha;
      const f32x2 mn2 = {mnew, mnew};
#pragma unroll
      for (int kk = 0; kk < 4; ++kk)
#pragma unroll
        for (int r2 = 0; r2 < 8; ++r2) {
          f32x2 v = {s[kk][2 * r2], s[kk][2 * r2 + 1]};
          v = v - mn2;
          f32x2 pv;
          pv[0] = ex2(v[0]); pv[1] = ex2(v[1]);
          lsum2 += pv;
          s[kk][2 * r2] = pv[0]; s[kk][2 * r2 + 1] = pv[1];
        }
#pragma unroll
      for (int dt = 0; dt < 2; ++dt)
#pragma unroll
        for (int r = 0; r < 16; ++r) oacc[dt][r] *= alpha;
#pragma unroll
      for (int kk = 0; kk < 4; ++kk)
#pragma unroll
        for (int u = 0; u < 2; ++u) {
          u32x4 pk;
#pragma unroll
          for (int jj = 0; jj < 4; ++jj) pk[jj] = pack2(s[kk][8 * u + 2 * jj], s[kk][8 * u + 2 * jj + 1]);
          const bf16x8 pf = __builtin_bit_cast(bf16x8, pk);
#pragma unroll
          for (int dt = 0; dt < 2; ++dt) {
            const u16* vp = Vs + buf * VS_ELEMS + (dt * 32 + lr) * 136 + kk * 32 + 16 * u + 4 * lh;
            u32x4 vv;
            const u32x2 lo = *(const u32x2*)vp, hi = *(const u32x2*)(vp + 8);
            vv[0] = lo[0]; vv[1] = lo[1]; vv[2] = hi[0]; vv[3] = hi[1];
            oacc[dt] = mfma(__builtin_bit_cast(bf16x8, vv), pf, oacc[dt]);
          }
        }
      if (kt + 1 < nkt) sstore(buf ^ 1);
      __syncthreads();
    }
    float lsum = lsum2[0] + lsum2[1];
    lsum += __shfl_xor(lsum, 32);
    const float inv = 1.f / lsum;
#pragma unroll
    for (int dt = 0; dt < 2; ++dt)
#pragma unroll
      for (int q = 0; q < 4; ++q)
        st4bf(p.od + (size_t)qtok * 256 + head * 64 + dt * 32 + 8 * q + 4 * lh, oacc[dt][4 * q] * inv, oacc[dt][4 * q + 1] * inv,
              oacc[dt][4 * q + 2] * inv, oacc[dt][4 * q + 3] * inv);
  }
  base += 256;
}

template <class ACC>
DI void merge_branch(const Prm& p, u16* smem, const u16* W, const u16* X, int ld, int bi, int n0, int m0, ACC& macc) {
  auto la = [&](int row, int k) __attribute__((always_inline)) { return *(const u32x4*)(W + (size_t)(n0 + row) * ld + k); };
  auto lb = [&](int row, int k) __attribute__((always_inline)) { return *(const u32x4*)(X + (size_t)(m0 + row) * ld + k); };
  auto epi = [&](f32x16 (&acc)[2], int wm, int wn, int lane) __attribute__((always_inline)) {
    const int lr = lane & 31, lh = lane >> 5;
    const int tok = m0 + wn * 32 + lr;
#pragma unroll
    for (int i = 0; i < 2; ++i)
#pragma unroll
      for (int q = 0; q < 4; ++q) {
        const int n = n0 + wm * 64 + i * 32 + 8 * q + 4 * lh;
        const u32x2 gz = *(const u32x2*)(p.zg + (size_t)tok * 4096 + bi * 1024 + n);
        macc[i][4 * q] += bflo(gz[0]) * acc[i][4 * q];
        macc[i][4 * q + 1] += bfhi(gz[0]) * acc[i][4 * q + 1];
        macc[i][4 * q + 2] += bflo(gz[1]) * acc[i][4 * q + 2];
        macc[i][4 * q + 3] += bfhi(gz[1]) * acc[i][4 * q + 3];
      }
  };
  gemm_tile<false, false>(smem, ld >> 6, la, lb, epi);
}

DI void phase_merge(const Prm& p, u16* smem, int l, int& base) {
  TASK_LOOP(t, 8 * 128, base) {
    const int tn = t & 7, tm = t >> 3, n0 = tn * 128, m0 = tm * 128;
    f32x16 macc[2];
    macc[0] = zero16(); macc[1] = zero16();
    merge_branch(p, smem, p.PaT + (size_t)l * 1024 * 768, p.UT, 768, 0, n0, m0, macc);
    merge_branch(p, smem, p.PbT + (size_t)l * 1024 * 128, p.ob, 128, 1, n0, m0, macc);
    merge_branch(p, smem, p.PcT + (size_t)l * 1024 * 384, p.cu, 384, 2, n0, m0, macc);
    merge_branch(p, smem, p.PdT + (size_t)l * 1024 * 256, p.od, 256, 3, n0, m0, macc);
    const int tid2 = tidx(), lane = tid2 & 63, wave = tid2 >> 6, wm = wave >> 2, wn = wave & 3, lr = lane & 31, lh = lane >> 5;
    const int tok = m0 + wn * 32 + lr;
#pragma unroll
    for (int i = 0; i < 2; ++i)
#pragma unroll
      for (int q = 0; q < 4; ++q)
        st4bf(p.hbuf + (size_t)tok * 1024 + n0 + wm * 64 + i * 32 + 8 * q + 4 * lh, macc[i][4 * q], macc[i][4 * q + 1],
              macc[i][4 * q + 2], macc[i][4 * q + 3]);
  }
  base += 8 * 128;
}

DI void phase_resid_gemm(const Prm& p, unsigned char* smem_raw, const u16* W, const u16* X, int K, const float* xsrc, float* xdst,
                         const float* modl, int gtoff, int sb, int& base) {
  LAS u16* shm = (LAS u16*)smem_raw;
  bool pre = false;
  TASK_LOOP(t, 4 * 64, base) {
    int tn, tm;
    map256(t, 4, tn, tm);
    const int brow = tn * 256, bcol = tm * 256;
    const int tnx = t + (int)gridDim.x;
    const bool has_next = tnx < (4 * 64);
    int tn2 = 0, tm2 = 0;
    if (has_next) map256(tnx, 4, tn2, tm2);
    const int nbrow = tn2 * 256, nbcol = tm2 * 256;
    auto epi = [&](f32x4 (&acc)[2][2][4][2], int wr, int wc, int fr, int fq) __attribute__((always_inline)) {
#pragma unroll
      for (int bj = 0; bj < 2; ++bj)
#pragma unroll
        for (int n = 0; n < 2; ++n) {
          const int tok = bcol + bj * 128 + wc * 32 + n * 16 + fr;
          const float* gt = modl + condrow(sb, tok) * 6144 + gtoff;
#pragma unroll
          for (int ai = 0; ai < 2; ++ai)
#pragma unroll
            for (int m = 0; m < 4; ++m) {
              const int nn = brow + ai * 128 + wr * 64 + m * 16 + fq * 4;
              const f32x4 v = acc[ai][bj][m][n];
              const float4 g4 = *(const float4*)(gt + nn);
              const float4 xi = *(const float4*)(xsrc + (size_t)tok * 1024 + nn);
              float4 o;
              o.x = xi.x + g4.x * v[0]; o.y = xi.y + g4.y * v[1]; o.z = xi.z + g4.z * v[2]; o.w = xi.w + g4.w * v[3];
              *(float4*)(xdst + (size_t)tok * 1024 + nn) = o;
            }
        }
    };
    gemm256(shm, W, X, K, brow, bcol, pre, has_next, nbrow, nbcol, epi);
    pre = has_next;
  }
  base += 4 * 64;
}

DI void phase_w1(const Prm& p, unsigned char* smem_raw, int l, int& base) {
  const u16* W = p.W1T + (size_t)l * 4096 * 1024;
  LAS u16* shm = (LAS u16*)smem_raw;
  bool pre = false;
  TASK_LOOP(t, 16 * 64, base) {
    int tn, tm;
    map256(t, 16, tn, tm);
    const int brow = tn * 256, bcol = tm * 256;
    const int tnx = t + (int)gridDim.x;
    const bool has_next = tnx < (16 * 64);
    int tn2 = 0, tm2 = 0;
    if (has_next) map256(tnx, 16, tn2, tm2);
    const int nbrow = tn2 * 256, nbcol = tm2 * 256;
    auto epi = [&](f32x4 (&acc)[2][2][4][2], int wr, int wc, int fr, int fq) __attribute__((always_inline)) {
#pragma unroll
      for (int bj = 0; bj < 2; ++bj)
#pragma unroll
        for (int n = 0; n < 2; ++n) {
          const int tok = bcol + bj * 128 + wc * 32 + n * 16 + fr;
#pragma unroll
          for (int ai = 0; ai < 2; ++ai)
#pragma unroll
            for (int m = 0; m < 4; ++m) {
              const int nn = brow + ai * 128 + wr * 64 + m * 16 + fq * 4;
              const f32x4 v = acc[ai][bj][m][n];
              const float a0 = fmaxf(v[0], 0.f), a1 = fmaxf(v[1], 0.f), a2 = fmaxf(v[2], 0.f), a3 = fmaxf(v[3], 0.f);
              st4bf(p.zg + (size_t)tok * 4096 + nn, a0 * a0, a1 * a1, a2 * a2, a3 * a3);
            }
        }
    };
    gemm256(shm, W, p.hbuf, 1024, brow, bcol, pre, has_next, nbrow, nbcol, epi);
    pre = has_next;
  }
  base += 16 * 64;
}

DI void phase_final(const Prm& p) {
  const int tid = tidx(), lane = tid & 63;
  const int gw = blockIdx.x * 8 + (tid >> 6), nw = gridDim.x * 8;
  for (int row = gw; row < 3 * TB; row += nw) {
    float* xr = p.out + (size_t)row * 1024;
    float4 v[4];
    float ss = 0.f;
#pragma unroll
    for (int i = 0; i < 4; ++i) {
      v[i] = *(const float4*)(xr + i * 256 + lane * 4);
      ss += v[i].x * v[i].x + v[i].y * v[i].y + v[i].z * v[i].z + v[i].w * v[i].w;
    }
#pragma unroll
    for (int off = 32; off >= 1; off >>= 1) ss += __shfl_xor(ss, off);
    const float rstd = rsqrtf(ss * (1.f / 1024.f) + 1e-6f);
#pragma unroll
    for (int i = 0; i < 4; ++i) {
      const int col = i * 256 + lane * 4;
      const float4 gg = *(const float4*)(p.final_g + col);
      float4 o;
      o.x = v[i].x * rstd * gg.x; o.y = v[i].y * rstd * gg.y; o.z = v[i].z * rstd * gg.z; o.w = v[i].w * rstd * gg.w;
      *(float4*)(xr + col) = o;
    }
  }
}

__global__ void __launch_bounds__(512) mega(Prm p) {
  cg::grid_group grid = cg::this_grid();
  __shared__ __attribute__((aligned(16))) unsigned char smem_raw[SMEM_BYTES];
  __shared__ uint4 xb_words;
  u16* smem = (u16*)smem_raw;
  if (threadIdx.x == 0) xb_words = make_uint4(0u, 0u, 0u, 0u);
  __syncthreads();
  const XcdBarrier xb = xcd_barrier_post(p.bar, (volatile LAS unsigned*)&xb_words);
  int base = 0;
  prologue_a(p, smem_raw, base);
  if (PROBE == 11) prologue_a(p, smem_raw, base);
  grid.sync();
  prologue_b(p);
  xcd_barrier(xb);
  for (int sb = 0; sb < 3; ++sb) {
    const int S = sb == 0 ? 16384 : 2048, lgS = sb == 0 ? 14 : 11, nseq = sb == 0 ? 1 : 8;
    const int N1 = S >> 7, lgN1 = lgS - 7;
    const float* xin = sb == 0 ? p.x_prompt : p.x_sample + (size_t)(sb - 1) * TB * 1024;
    float* xo = p.out + (size_t)sb * TB * 1024;
    for (int l = 0; l < 4; ++l) {
      const float* xs = l == 0 ? xin : xo;
      const float* modl = p.mod + (size_t)l * 17 * 6144;
      phase_norm(p, xs, p.norm1_g + l * 1024, modl, 0, 1024, sb);
      xcd_barrier(xb);
      phase_inproj(p, smem_raw, l, S, base);
      if (PROBE == 2 || PROBE == 7) phase_inproj(p, smem_raw, l, S, base);
      if (PROBE == 12) phase_inproj_probe(p, smem_raw, l, base);
      xcd_barrier(xb);
      if (PROBE == 5) xcd_barrier(xb);
      if (N1 == 16) phase_fft1_small(p, nseq); else phase_fft1(p, smem, S, nseq, N1, lgN1, base);
      phase_mixb(p, smem_raw, S, lgS, base);
      phase_mixc(p, smem_raw, l, base);
      phase_qup(p, smem_raw, l, S, base);
      phase_kvup(p, smem_raw, l, base);
      phase_inproj_tail(p, smem_raw, l, base);
      if (PROBE == 13) phase_fft1(p, smem, S, nseq, N1, lgN1, base);
      if (PROBE == 14) phase_mixb(p, smem_raw, S, lgS, base);
      if (PROBE == 15) { phase_qup(p, smem_raw, l, S, base); phase_kvup(p, smem_raw, l, base); phase_inproj_tail(p, smem_raw, l, base); }
      if (PROBE == 4) { phase_fft1(p, smem, S, nseq, N1, lgN1, base); phase_mixb(p, smem_raw, S, lgS, base); phase_qup(p, smem_raw, l, S, base); phase_kvup(p, smem_raw, l, base); }
      xcd_barrier(xb);
      if (PROBE == 5) xcd_barrier(xb);
      phase_mla(p, smem_raw, S, lgS, base);
      if (PROBE == 1) phase_mla(p, smem_raw, S, lgS, base);
      phase_fft2(p, smem, S, nseq, N1, base);
      phase_combb(p);
      if (PROBE == 6) { phase_fft2(p, smem, S, nseq, N1, base); phase_combb(p); }
      xcd_barrier(xb);
      if (PROBE == 5) xcd_barrier(xb);
      phase_merge(p, smem, l, base);
      if (PROBE == 3) phase_merge(p, smem, l, base);
      xcd_barrier(xb);
      if (PROBE == 5) xcd_barrier(xb);
      phase_resid_gemm(p, smem_raw, p.WoT + (size_t)l * 1024 * 1024, p.hbuf, 1024, xs, xo, modl, 2048, sb, base);
      xcd_barrier(xb);
      phase_norm(p, xo, p.norm2_g + l * 1024, modl, 3072, 4096, sb);
      if (PROBE == 9) { phase_norm(p, xo, p.norm2_g + l * 1024, modl, 3072, 4096, sb); phase_norm(p, xo, p.norm2_g + l * 1024, modl, 3072, 4096, sb); }
      xcd_barrier(xb);
      phase_w1(p, smem_raw, l, base);
      if (PROBE == 2 || PROBE == 8) phase_w1(p, smem_raw, l, base);
      xcd_barrier(xb);
      if (PROBE == 5) xcd_barrier(xb);
      phase_resid_gemm(p, smem_raw, p.W2T + (size_t)l * 1024 * 4096, p.zg, 4096, xo, xo, modl, 5120, sb, base);
      xcd_barrier(xb);
    }
  }
  phase_final(p);
}

extern "C" void kernel_launch(void* const* d_in, const int* in_sizes, int n_in, void* d_out, int out_size, void* d_ws, size_t ws_size,
                              hipStream_t stream) {
  Prm p{};
  const float* const* in = (const float* const*)d_in;
  p.x_prompt = in[0]; p.x_sample = in[1]; p.c_prompt = in[2]; p.c_sample = in[3]; p.rel_bias = in[4]; p.ada_w = in[5]; p.ada_b = in[6];
  p.norm1_g = in[7]; p.w_in = in[8]; p.qn_g = in[9]; p.kvn_g = in[10]; p.w_uq = in[11]; p.w_ukv = in[12]; p.ln_g = in[13]; p.ln_b = in[14];
  p.sgu_w = in[15]; p.sgu_b = in[16]; p.p_a = in[17]; p.p_b = in[18]; p.p_c = in[19]; p.p_d = in[20]; p.w_o = in[21]; p.norm2_g = in[22];
  p.w1 = in[23]; p.w2 = in[24]; p.final_g = in[25];
  p.out = (float*)d_out;
  char* w = (char*)d_ws;
  size_t off = 0;
  auto take = [&](size_t bytes) __attribute__((always_inline)) { void* r = w + off; off += (bytes + 255) & ~(size_t)255; return r; };
  p.WinT = (u16*)take((size_t)4 * NWP * 1024 * 2);
  p.W1T = (u16*)take((size_t)4 * 4096 * 1024 * 2);
  p.W2T = (u16*)take((size_t)4 * 4096 * 1024 * 2);
  p.WoT = (u16*)take((size_t)4 * 1024 * 1024 * 2);
  p.PaT = (u16*)take((size_t)4 * 1024 * 768 * 2);
  p.PbT = (u16*)take((size_t)4 * 1024 * 128 * 2);
  p.PcT = (u16*)take((size_t)4 * 1024 * 384 * 2);
  p.PdT = (u16*)take((size_t)4 * 1024 * 256 * 2);
  p.WqT = (u16*)take((size_t)4 * 384 * 384 * 2);
  p.WkvT = (u16*)take((size_t)4 * 512 * 320 * 2);
  p.SgW = (u16*)take((size_t)4 * 4 * 128 * 128 * 2);
  p.M1a = (u16*)take(256 * 256 * 2);
  p.M1b = (u16*)take(32 * 64 * 2);
  p.M2 = (u16*)take(128 * 256 * 2);
  p.tw = (float2*)take(16384 * 8);
  p.rope = (float2*)take((size_t)16384 * 16 * 8);
  p.biasT = (float*)take(6 * 129 * 4);
  p.mod = (float*)take((size_t)4 * 17 * 6144 * 4);
  p.hbuf = (u16*)take((size_t)TB * 1024 * 2);
  p.og = (float*)take((size_t)TB * 384 * 4);
  p.UT = (u16*)take((size_t)1536 * TBP * 2);
  p.Gp = (u16*)take((size_t)1536 * TB * 2);
  p.bqkv = (u16*)take((size_t)TB * 1152 * 2);
  p.ob = (u16*)take((size_t)TB * 128 * 2);
  p.cu = (u16*)take((size_t)TB * 384 * 2);
  p.cvT = (u16*)take((size_t)TBP * 384 * 2);
  p.dcq = (u16*)take((size_t)TB * 384 * 2);
  p.dckv = (u16*)take((size_t)TB * 320 * 2);
  p.qc = (u16*)take((size_t)TB * 384 * 2);
  p.kc = (u16*)take((size_t)TB * 384 * 2);
  p.vT = (u16*)take((size_t)TBP * 256 * 2);
  p.od = (u16*)take((size_t)TB * 256 * 2);
  p.lse = (float*)take((size_t)TB * 6 * 4);
  p.zg = (u16*)take((size_t)TB * 4096 * 2);
  p.bar = (unsigned*)take(XCD_BAR_WORDS * 4);
  p.modpart = (float*)p.zg;
  if (off > ws_size) { fprintf(stderr, "workspace too small: need %zu have %zu\n", off, ws_size); return; }
  static int grid_blocks = 0;
  if (!grid_blocks) {
    int dev = 0, cus = 0, per_cu = 0;
    (void)hipGetDevice(&dev);
    (void)hipDeviceGetAttribute(&cus, hipDeviceAttributeMultiprocessorCount, dev);
    (void)hipOccupancyMaxActiveBlocksPerMultiprocessor(&per_cu, mega, NTH, 0);
    if (per_cu < 1) per_cu = 1;
    if (per_cu > 1) per_cu = 1;
    grid_blocks = cus * per_cu;
  }
  (void)hipMemsetAsync(p.bar, 0, XCD_BAR_WORDS * 4, stream);
  void* args[] = {&p};
  hipError_t e = hipLaunchCooperativeKernel((void*)mega, dim3(grid_blocks), dim3(NTH), args, 0, stream);
  if (e != hipSuccess) fprintf(stderr, "cooperative launch failed: %s (grid %d)\n", hipGetErrorString(e), grid_blocks);
}
```

```cpp
#include <hip/hip_runtime.h>
#include <hip/hip_cooperative_groups.h>
#include <stdint.h>
#include <stdio.h>
namespace cg = cooperative_groups;

#define DI __device__ __forceinline__
#define LAS __attribute__((address_space(3)))
typedef unsigned short u16;
typedef __attribute__((ext_vector_type(8))) short bf16x8;
typedef __attribute__((ext_vector_type(4))) short bf16x4;
typedef __attribute__((ext_vector_type(16))) float f32x16;
typedef __attribute__((ext_vector_type(4))) float f32x4;
typedef __attribute__((ext_vector_type(2))) float f32x2;
typedef __attribute__((ext_vector_type(4))) unsigned u32x4;
typedef __attribute__((ext_vector_type(2))) unsigned u32x2;
typedef __attribute__((ext_vector_type(2))) __bf16 bf2_t;

constexpr int TB = 16384;
constexpr int TBP = TB + 64;
constexpr int NW = 8288;
constexpr int NWP = 8320;
constexpr int LDT = 72;
constexpr int TILE_ELEMS = 128 * LDT;
constexpr int GEMM_SMEM = 4 * TILE_ELEMS * 2;
constexpr int SMEM_BYTES = 131072;
#ifndef PROBE
#define PROBE 0
#endif
constexpr int NTH = 512;
constexpr int HT = 128 * 64;
constexpr float LOG2E = 1.4426950408889634f;
constexpr float LN2 = 0.6931471805599453f;

struct Prm {
  const float *x_prompt, *x_sample, *c_prompt, *c_sample, *rel_bias, *ada_w, *ada_b, *norm1_g, *w_in,
      *qn_g, *kvn_g, *w_uq, *w_ukv, *ln_g, *ln_b, *sgu_w, *sgu_b, *p_a, *p_b, *p_c, *p_d, *w_o,
      *norm2_g, *w1, *w2, *final_g;
  float* out;
  u16 *WinT, *W1T, *W2T, *WoT, *PaT, *PbT, *PcT, *PdT, *WqT, *WkvT, *SgW, *M1a, *M1b, *M2;
  float2 *tw, *rope;
  float *biasT, *mod, *modpart;
  u16 *hbuf, *UT, *Gp, *bqkv, *ob, *cu, *cvT, *dcq, *dckv, *qc, *kc, *vT, *od, *zg;
  float *og, *lse;
  unsigned* bar;
};

DI unsigned pack2(float a, float b) { bf2_t v; v[0] = (__bf16)a; v[1] = (__bf16)b; return __builtin_bit_cast(unsigned, v); }
DI u16 f2bf(float a) { return __builtin_bit_cast(u16, (__bf16)a); }
DI float bf2f(u16 v) { return __uint_as_float(((unsigned)v) << 16); }
DI float bflo(unsigned w) { return __uint_as_float(w << 16); }
DI float bfhi(unsigned w) { return __uint_as_float(w & 0xffff0000u); }
DI void st4bf(u16* dst, float a, float b, float c, float d) { u32x2 v; v[0] = pack2(a, b); v[1] = pack2(c, d); *(u32x2*)dst = v; }
DI void st4bf_nt(u16* dst, float a, float b, float c, float d) { u32x2 v; v[0] = pack2(a, b); v[1] = pack2(c, d); __builtin_nontemporal_store(v, (u32x2*)dst); }
DI int rowmap(int r, int lh) { return (r & 3) + 8 * (r >> 2) + 4 * lh; }
DI f32x16 mfma(bf16x8 a, bf16x8 b, f32x16 c) { return __builtin_amdgcn_mfma_f32_32x32x16_bf16(a, b, c, 0, 0, 0); }
DI u32x4 zero4() { u32x4 z; z[0] = 0; z[1] = 0; z[2] = 0; z[3] = 0; return z; }
DI f32x16 zero16() { f32x16 z; for (int i = 0; i < 16; ++i) z[i] = 0.f; return z; }
DI float ex2(float x) { return __builtin_amdgcn_exp2f(x); }
DI int tidx() { int t = threadIdx.x; asm volatile("" : "+v"(t)); return t; }


#define XB_TMO      128
#define XB_XCNT(j)  (256  + 64 * (j))
#define XB_XSUB(j)  (1280 + 64 * (j))
#define XB_XGEN(j)  (2304 + 64 * (j))
#define XB_TOP      3328
#define XB_TOPGEN   3392
#define XCD_BAR_WORDS 3456
#define XB_SPIN_CAP (1u << 18)
DI unsigned xb_ld(unsigned* p) { return __hip_atomic_load(p, __ATOMIC_RELAXED, __HIP_MEMORY_SCOPE_AGENT); }
DI unsigned xb_add(unsigned* p, unsigned v) { return __hip_atomic_fetch_add(p, v, __ATOMIC_RELAXED, __HIP_MEMORY_SCOPE_AGENT); }
DI unsigned xb_xcc_id() { return (unsigned)__builtin_amdgcn_s_getreg((3 << 11) | 20) & 0xFu; }
#define XB_SPIN(cond, bar) do { unsigned _sp = 0; while (cond) { __builtin_amdgcn_s_sleep(1); \
    if ((++_sp & 255u) == 0u) { if (xb_ld(&(bar)[XB_TMO])) break; if (_sp > XB_SPIN_CAP) { atomicAdd(&(bar)[XB_TMO], 1u); break; } } } } while (0)
struct XcdBarrier { unsigned* bar; unsigned x; volatile LAS unsigned* st; };
DI XcdBarrier xcd_barrier_post(unsigned* bar, volatile LAS unsigned* st) {
  XcdBarrier b; b.bar = bar; b.x = xb_xcc_id(); b.st = st;
  if (threadIdx.x == 0) (void)xb_add(&bar[XB_XCNT(b.x)], 1u);
  return b;
}
DI void xcd_barrier_complete(unsigned* bar, unsigned x, unsigned& nloc, unsigned& nx) {
  const unsigned G = gridDim.x * gridDim.y * gridDim.z;
  unsigned sum, cnt, mine, sp = 0u;
  for (;;) {
    sum = 0u; cnt = 0u; mine = 0u;
#pragma unroll
    for (unsigned j = 0; j < 16; ++j) { const unsigned c = xb_ld(&bar[XB_XCNT(j)]); sum += c; cnt += (c > 0u) ? 1u : 0u; mine = (j == x) ? c : mine; }
    if (sum == G) break;
    __builtin_amdgcn_s_sleep(1);
    if ((++sp & 255u) == 0u) { if (xb_ld(&bar[XB_TMO])) break; if (sp > XB_SPIN_CAP) { atomicAdd(&bar[XB_TMO], 1u); break; } }
  }
  nloc = mine > 0u ? mine : 1u; nx = cnt > 0u ? cnt : 1u;
}
DI void xcd_barrier(const XcdBarrier& b) {
  asm volatile("s_waitcnt vmcnt(0)" ::: "memory");
  __syncthreads();
  if (tidx() == 0) {
    unsigned* bar = b.bar;
    const unsigned bx = (unsigned)__builtin_amdgcn_readfirstlane((int)xb_xcc_id());
    __builtin_amdgcn_s_waitcnt(0);
    unsigned nloc = b.st[0], nx = b.st[1];
    if (nloc == 0u) { xcd_barrier_complete(bar, bx, nloc, nx); b.st[0] = nloc; b.st[1] = nx; }
    const unsigned old = xb_add(&bar[XB_XSUB(bx)], 1u);
    const unsigned gen = old / nloc;
    if (old + 1u == (gen + 1u) * nloc) {
      __builtin_amdgcn_fence(__ATOMIC_RELEASE, "agent");
      asm volatile("s_waitcnt vmcnt(0)" ::: "memory");
      const unsigned og = xb_add(&bar[XB_TOP], 1u);
      const unsigned tg = og / nx;
      if (og + 1u == (tg + 1u) * nx) xb_add(&bar[XB_TOPGEN], 1u);
      else XB_SPIN(xb_ld(&bar[XB_TOPGEN]) == tg, bar);
      __builtin_amdgcn_fence(__ATOMIC_ACQUIRE, "agent");
      xb_add(&bar[XB_XGEN(bx)], 1u);
      asm volatile("s_waitcnt vmcnt(0)" ::: "memory");
    } else {
      XB_SPIN(xb_ld(&bar[XB_XGEN(bx)]) == gen, bar);
      __builtin_amdgcn_fence(__ATOMIC_ACQUIRE, "agent");
      asm volatile("s_waitcnt vmcnt(0)" ::: "memory");
    }
  }
  __syncthreads();
}

#define TASK_LOOP(t, nt, base) for (int t = (int)((blockIdx.x + gridDim.x - ((unsigned)(base) % gridDim.x)) % gridDim.x); t < (nt); t += gridDim.x)

template <bool RFA, bool RFB, class LA, class LB, class EPI>
DI void gemm_tile(u16* smem, int nk, LA la, LB lb, EPI epi) {
  const int tid = tidx(), lane = tid & 63, wave = tid >> 6;
  const int wm = wave >> 2, wn = wave & 3, lr = lane & 31, lh = lane >> 5;
  u16* As = smem;
  u16* Bs = smem + 2 * TILE_ELEMS;
  f32x16 acc[2];
  acc[0] = zero16(); acc[1] = zero16();
  u32x4 ra[2], rb[2];
#define A_ROW(c) (RFA ? ((c) & 127) : ((c) >> 3))
#define A_KC(c) (RFA ? ((c) >> 7) : ((c) & 7))
#define B_ROW(c) (RFB ? ((c) & 127) : ((c) >> 3))
#define B_KC(c) (RFB ? ((c) >> 7) : ((c) & 7))
#pragma unroll
  for (int i = 0; i < 2; ++i) { const int c = tid + NTH * i; ra[i] = la(A_ROW(c), A_KC(c) * 8); rb[i] = lb(B_ROW(c), B_KC(c) * 8); }
#pragma unroll
  for (int i = 0; i < 2; ++i) {
    const int c = tid + NTH * i;
    *(u32x4*)(As + A_ROW(c) * LDT + A_KC(c) * 8) = ra[i];
    *(u32x4*)(Bs + B_ROW(c) * LDT + B_KC(c) * 8) = rb[i];
  }
  __syncthreads();
  for (int kt = 0; kt < nk; ++kt) {
    const int buf = kt & 1;
    if (kt + 1 < nk) {
      const int k0 = (kt + 1) * 64;
#pragma unroll
      for (int i = 0; i < 2; ++i) { const int c = tid + NTH * i; ra[i] = la(A_ROW(c), k0 + A_KC(c) * 8); rb[i] = lb(B_ROW(c), k0 + B_KC(c) * 8); }
    }
    const u16* Ab = As + buf * TILE_ELEMS + (wm * 64 + lr) * LDT + lh * 8;
    const u16* Bb = Bs + buf * TILE_ELEMS + (wn * 32 + lr) * LDT + lh * 8;
#pragma unroll
    for (int ks = 0; ks < 4; ++ks) {
      const bf16x8 a0 = *(const bf16x8*)(Ab + ks * 16);
      const bf16x8 a1 = *(const bf16x8*)(Ab + 32 * LDT + ks * 16);
      const bf16x8 b = *(const bf16x8*)(Bb + ks * 16);
      acc[0] = mfma(a0, b, acc[0]);
      acc[1] = mfma(a1, b, acc[1]);
    }
    if (kt + 1 < nk) {
      u16* Aw = As + (buf ^ 1) * TILE_ELEMS;
      u16* Bw = Bs + (buf ^ 1) * TILE_ELEMS;
#pragma unroll
      for (int i = 0; i < 2; ++i) {
        const int c = tid + NTH * i;
        *(u32x4*)(Aw + A_ROW(c) * LDT + A_KC(c) * 8) = ra[i];
        *(u32x4*)(Bw + B_ROW(c) * LDT + B_KC(c) * 8) = rb[i];
      }
    }
    __syncthreads();
  }
  epi(acc, wm, wn, lane);
}

DI void stage_rc(int b, int& R, int& C) { int st = b / 1024, sb = b % 1024, swz = sb ^ (((sb >> 9) & 1) << 5); R = (st >> 1) * 16 + swz / 64; C = (st & 1) * 32 + (swz % 64) / 2; }

template <class EPI>
DI void gemm256(LAS u16* shm, const u16* __restrict__ A, const u16* __restrict__ Bt, int K, int brow, int bcol, bool pre, bool has_next, int nbrow, int nbcol, EPI epi) {
#define SA(b, h) (shm + ((b) * 2 + (h)) * HT)
#define SB(b, h) (shm + (4 + (b) * 2 + (h)) * HT)
  const int tid = tidx();
  const int wid = __builtin_amdgcn_readfirstlane(tid >> 6), lane = tid & 63, wr = wid >> 2, wc = wid & 3, fr = lane & 15, fq = lane >> 4;
  int r0, c0, r1, c1;
  stage_rc(tid * 16, r0, c0);
  stage_rc(tid * 16 + 8192, r1, c1);
  const unsigned so0 = (unsigned)(r0 * K + c0) * 2u, so1 = (unsigned)(r1 * K + c1) * 2u;
  const unsigned ldsw = (unsigned)wid * 1024u;
  const int lb = ((fr * 64 + fq * 16) ^ ((fr >> 3) << 5));
#define STAGE(P, BASE, br, kt) do { const char* _g = (const char*)((BASE) + (size_t)(br) * K + (kt) * 64); \
    __builtin_amdgcn_global_load_lds((const unsigned*)(_g + so0), (LAS unsigned*)((LAS char*)(P) + ldsw), 16, 0, 0); \
    __builtin_amdgcn_global_load_lds((const unsigned*)(_g + so1), (LAS unsigned*)((LAS char*)(P) + ldsw + 8192), 16, 0, 0); } while (0)
#define LDA(dst, b, h) _Pragma("unroll") for (int m = 0; m < 4; ++m) _Pragma("unroll") for (int k = 0; k < 2; ++k) \
    dst[m][k] = *(const LAS bf16x8*)((const LAS char*)SA(b, h) + ((wr * 4 + m) * 2 + k) * 1024 + lb)
#define LDB(dst, b, h) _Pragma("unroll") for (int n = 0; n < 2; ++n) _Pragma("unroll") for (int k = 0; k < 2; ++k) \
    dst[n][k] = *(const LAS bf16x8*)((const LAS char*)SB(b, h) + ((wc * 2 + n) * 2 + k) * 1024 + lb)
#define MMA(ai, bj, At_, Bt_) do { __builtin_amdgcn_s_setprio(1); \
    _Pragma("unroll") for (int m = 0; m < 4; ++m) _Pragma("unroll") for (int n = 0; n < 2; ++n) _Pragma("unroll") for (int k = 0; k < 2; ++k) \
      acc[ai][bj][m][n] = __builtin_amdgcn_mfma_f32_16x16x32_bf16(At_[m][k], Bt_[n][k], acc[ai][bj][m][n], 0, 0, 0); \
    __builtin_amdgcn_s_setprio(0); } while (0)
#define WAIT_V(n) asm volatile("s_waitcnt vmcnt(" #n ")" ::: "memory")
#define WAIT_L(n) asm volatile("s_waitcnt lgkmcnt(" #n ")" ::: "memory")
#define BAR __builtin_amdgcn_s_barrier()
#define SCHED __builtin_amdgcn_sched_barrier(0)
  f32x4 acc[2][2][4][2];
#pragma unroll
  for (int a = 0; a < 2; ++a)
#pragma unroll
    for (int b = 0; b < 2; ++b)
#pragma unroll
      for (int m = 0; m < 4; ++m)
#pragma unroll
        for (int n = 0; n < 2; ++n) { acc[a][b][m][n][0] = 0.f; acc[a][b][m][n][1] = 0.f; acc[a][b][m][n][2] = 0.f; acc[a][b][m][n][3] = 0.f; }
  bf16x8 At[4][2], B0[2][2], B1[2][2];
  const int nt = K / 64;
  if (!pre) {
    STAGE(SB(0, 0), Bt, bcol, 0); STAGE(SA(0, 0), A, brow, 0);
    STAGE(SB(0, 1), Bt, bcol + 128, 0); STAGE(SA(0, 1), A, brow + 128, 0);
  }
  if (wr == 1) BAR;
  WAIT_V(4); BAR;
  STAGE(SB(1, 0), Bt, bcol, 1); STAGE(SA(1, 0), A, brow, 1); STAGE(SB(1, 1), Bt, bcol + 128, 1);
  WAIT_V(6); BAR;
  for (int t = 0; t < nt - 2; t += 2) {
    LDB(B0, 0, 0); SCHED; LDA(At, 0, 0); STAGE(SA(1, 1), A, brow + 128, t + 1);
    WAIT_L(8); BAR; WAIT_L(0); MMA(0, 0, At, B0); BAR; SCHED;
    LDB(B1, 0, 1); STAGE(SB(0, 0), Bt, bcol, t + 2);
    BAR; WAIT_L(0); MMA(0, 1, At, B1); BAR;
    LDA(At, 0, 1); STAGE(SA(0, 0), A, brow, t + 2);
    BAR; WAIT_L(0); MMA(1, 0, At, B0); BAR; SCHED;
    STAGE(SB(0, 1), Bt, bcol + 128, t + 2);
    WAIT_V(6); BAR; MMA(1, 1, At, B1); BAR;
    LDB(B0, 1, 0); SCHED; LDA(At, 1, 0); STAGE(SA(0, 1), A, brow + 128, t + 2);
    WAIT_L(8); BAR; WAIT_L(0); MMA(0, 0, At, B0); BAR; SCHED;
    LDB(B1, 1, 1); STAGE(SB(1, 0), Bt, bcol, t + 3);
    BAR; WAIT_L(0); MMA(0, 1, At, B1); BAR;
    LDA(At, 1, 1); STAGE(SA(1, 0), A, brow, t + 3);
    BAR; WAIT_L(0); MMA(1, 0, At, B0); BAR; SCHED;
    STAGE(SB(1, 1), Bt, bcol + 128, t + 3);
    WAIT_V(6); BAR; MMA(1, 1, At, B1); BAR;
  }
  { LDB(B0, 0, 0); LDA(At, 0, 0); STAGE(SA(1, 1), A, brow + 128, nt - 1);
    BAR; WAIT_L(0); MMA(0, 0, At, B0); BAR;
    LDB(B1, 0, 1); BAR; WAIT_L(0); MMA(0, 1, At, B1); BAR;
    LDA(At, 0, 1); WAIT_V(4); BAR; WAIT_L(0); MMA(1, 0, At, B0); MMA(1, 1, At, B1); BAR; }
  { LDB(B0, 1, 0); LDA(At, 1, 0); WAIT_V(2); BAR; WAIT_L(0); MMA(0, 0, At, B0); BAR;
    LDB(B1, 1, 1); WAIT_V(0); BAR; WAIT_L(0); MMA(0, 1, At, B1); BAR;
    LDA(At, 1, 1); BAR; WAIT_L(0); MMA(1, 0, At, B0); MMA(1, 1, At, B1); BAR; }
  if (wr == 0) BAR;
  if (has_next) {
    STAGE(SB(0, 0), Bt, nbcol, 0); STAGE(SA(0, 0), A, nbrow, 0);
    STAGE(SB(0, 1), Bt, nbcol + 128, 0); STAGE(SA(0, 1), A, nbrow + 128, 0);
  }
  epi(acc, wr, wc, fr, fq);
  __syncthreads();
}

DI void map256(int t, int nN, int& tn, int& tm) {
  const int p = (t >> 8) * 8 + (t & 7), i = (t >> 3) & 31, pr = nN >> 2;
  const int pm = p / pr;
  tn = ((p + pm) % pr) * 4 + (i & 3);
  tm = pm * 8 + (i >> 2);
}

DI int condrow(int sb, int tok) { return sb == 0 ? 0 : 1 + (sb - 1) * 8 + (tok >> 11); }

DI void convT_tile(float* tile, const float* src, int lds_, int N, u16* dst, int ldd, const float* ksc, int k0, int n0) {
  const int tid = tidx();
#pragma unroll 4
  for (int e = 0; e < 8; ++e) {
    const int idx = tid + NTH * e, kk = idx >> 6, nn = idx & 63;
    float v = (n0 + nn < N) ? src[(size_t)(k0 + kk) * lds_ + n0 + nn] : 0.f;
    if (ksc) v *= ksc[k0 + kk];
    tile[kk * 65 + nn] = v;
  }
  __syncthreads();
#pragma unroll 4
  for (int e = 0; e < 4; ++e) {
    const int idx = tid + NTH * e, nn = idx >> 5, kp = idx & 31;
    if (n0 + nn < N)
      *(unsigned*)(dst + (size_t)(n0 + nn) * ldd + k0 + 2 * kp) = pack2(tile[(2 * kp) * 65 + nn], tile[(2 * kp + 1) * 65 + nn]);
  }
  __syncthreads();
}

DI void convT(float* tile, const float* src, int lds_, int K, int N, u16* dst, int ldd, const float* ksc, int& base) {
  const int ntn = (N + 63) >> 6, nt = (K >> 6) * ntn;
  TASK_LOOP(t, nt, base) {
    const int tn = t % ntn, tk = t / ntn;
    convT_tile(tile, src, lds_, N, dst, ldd, ksc, tk * 64, tn * 64);
  }
  base += nt;
}

DI void prologue_a(const Prm& p, unsigned char* smem_raw, int& base) {
  float* smf = (float*)smem_raw;
  const int tid = tidx();
  const int gtid = blockIdx.x * NTH + tid, gn = gridDim.x * NTH;
  for (int l = 0; l < 4; ++l) {
    convT(smf, p.w_in + (size_t)l * 1024 * 7520 + 768, 7520, 1024, 6752, p.WinT + ((size_t)l * NWP + 1536) * 1024, 1024, nullptr, base);
    convT(smf, p.w1 + (size_t)l * 1024 * 4096, 4096, 1024, 4096, p.W1T + (size_t)l * 4096 * 1024, 1024, nullptr, base);
    convT(smf, p.w2 + (size_t)l * 4096 * 1024, 1024, 4096, 1024, p.W2T + (size_t)l * 1024 * 4096, 4096, nullptr, base);
    convT(smf, p.w_o + (size_t)l * 1024 * 1024, 1024, 1024, 1024, p.WoT + (size_t)l * 1024 * 1024, 1024, nullptr, base);
    convT(smf, p.p_a + (size_t)l * 768 * 1024, 1024, 768, 1024, p.PaT + (size_t)l * 1024 * 768, 768, nullptr, base);
    convT(smf, p.p_b + (size_t)l * 128 * 1024, 1024, 128, 1024, p.PbT + (size_t)l * 1024 * 128, 128, nullptr, base);
    convT(smf, p.p_c + (size_t)l * 384 * 1024, 1024, 384, 1024, p.PcT + (size_t)l * 1024 * 384, 384, nullptr, base);
    convT(smf, p.p_d + (size_t)l * 256 * 1024, 1024, 256, 1024, p.PdT + (size_t)l * 1024 * 256, 256, nullptr, base);
    convT(smf, p.w_uq + (size_t)l * 384 * 384, 384, 384, 384, p.WqT + (size_t)l * 384 * 384, 384, p.qn_g + l * 384, base);
    convT(smf, p.w_ukv + (size_t)l * 320 * 512, 512, 320, 512, p.WkvT + (size_t)l * 512 * 320, 320, p.kvn_g + l * 320, base);
  }
  {
    float* wl = smf;
    float* tab = smf + 32 * 193;
    TASK_LOOP(t, 512, base) {
      const int kb = t & 31, g = (t >> 5) & 3, l = t >> 7, k0 = kb * 32;
      for (int idx = tid; idx < 32 * 192; idx += NTH) {
        const int kk = idx / 192, c = idx - kk * 192;
        wl[kk * 193 + c] = p.w_in[((size_t)l * 1024 + k0 + kk) * 7520 + g * 192 + c];
      }
      if (tid < 192) {
        float s, c;
        sincospif(2.f * (float)tid / 192.f, &s, &c);
        tab[tid] = c; tab[192 + tid] = s;
      }
      __syncthreads();
      for (int e = 0; e < 6; ++e) {
        const int idx = tid + NTH * e, kq = idx & 7, pj = idx >> 3;
        const int part = pj >= 192 ? 1 : 0, j = pj - part * 192;
        const float* tp = tab + part * 192;
        const float* w0 = wl + (kq * 4) * 193;
        float s0 = 0, s1 = 0, s2 = 0, s3 = 0;
        int m = 0;
        for (int c = 0; c < 192; ++c) {
          const float tv = tp[m];
          s0 += w0[c] * tv; s1 += w0[193 + c] * tv; s2 += w0[2 * 193 + c] * tv; s3 += w0[3 * 193 + c] * tv;
          m += j; if (m >= 192) m -= 192;
        }
        if (part) { s0 = -s0; s1 = -s1; s2 = -s2; s3 = -s3; }
        st4bf(p.WinT + ((size_t)l * NWP + part * 768 + g * 192 + j) * 1024 + k0 + kq * 4, s0, s1, s2, s3);
      }
      __syncthreads();
    }
    base += 512;
  }
  {
    float* sil = smf;
    TASK_LOOP(t, 384, base) {
      const int kc = t & 7, cb = (t >> 3) % 12, l = t / 96, k0 = kc * 128;
      for (int idx = tid; idx < 17 * 128; idx += NTH) {
        const int r = idx >> 7, kk = idx & 127;
        const float c = r == 0 ? p.c_prompt[k0 + kk] : p.c_sample[(r - 1) * 1024 + k0 + kk];
        sil[idx] = c / (1.f + __expf(-c));
      }
      __syncthreads();
      const int n = cb * 512 + tid;
      float acc[17];
#pragma unroll
      for (int r = 0; r < 17; ++r) acc[r] = 0.f;
      const float* wp = p.ada_w + ((size_t)l * 1024 + k0) * 6144 + n;
#pragma unroll 4
      for (int kk = 0; kk < 128; ++kk) {
        const float w = wp[(size_t)kk * 6144];
#pragma unroll
        for (int r = 0; r < 17; ++r) acc[r] += sil[r * 128 + kk] * w;
      }
#pragma unroll
      for (int r = 0; r < 17; ++r) p.modpart[((size_t)(kc * 4 + l) * 17 + r) * 6144 + n] = acc[r];
      __syncthreads();
    }
    base += 384;
  }
  for (int idx = gtid; idx < 4 * 32 * 1024; idx += gn) {
    const int l = idx >> 15, rem = idx & 32767;
    p.WinT[((size_t)l * NWP + NW) * 1024 + rem] = 0;
  }
  for (int idx = gtid; idx < 256 * 256; idx += gn) {
    const int row = idx >> 8, kk = idx & 255;
    const int po = row >> 7, k1 = row & 127, pi = kk >> 7, s1 = kk & 127;
    float s, c;
    sincospif(2.f * (float)((k1 * s1) & 127) / 128.f, &s, &c);
    const float v = (po == pi) ? c : (po == 0 ? s : -s);
    p.M1a[idx] = f2bf(v);
  }
  for (int idx = gtid; idx < 32 * 64; idx += gn) {
    const int row = idx >> 6, kk = idx & 63;
    const int po = row >> 4, k1 = row & 15, pi = (kk >> 4) & 1, s1 = kk & 15;
    float s, c;
    sincospif(2.f * (float)((k1 * s1) & 15) / 16.f, &s, &c);
    float v = (po == pi) ? c : (po == 0 ? s : -s);
    if (kk >= 32) v = 0.f;
    p.M1b[idx] = f2bf(v);
  }
  for (int idx = gtid; idx < 128 * 256; idx += gn) {
    const int k2 = idx >> 8, kk = idx & 255, part = kk >> 7, s2 = kk & 127;
    float s, c;
    sincospif(2.f * (float)((k2 * s2) & 127) / 128.f, &s, &c);
    p.M2[idx] = f2bf(part ? s : c);
  }
  for (int idx = gtid; idx < 16384; idx += gn) {
    float s, c;
    sincospif(2.f * (float)idx / 16384.f, &s, &c);
    p.tw[idx] = make_float2(c, s);
  }
  for (int idx = gtid; idx < 16384 * 16; idx += gn) {
    const int pos = idx >> 4, i = idx & 15;
    const float inv = (float)pow(10000.0, -(double)i / 16.0);
    const float ang = (float)pos * inv;
    double rev = (double)ang * 0.15915494309189535;
    rev -= rint(rev);
    float s, c;
    sincospif((float)(2.0 * rev), &s, &c);
    p.rope[idx] = make_float2(c, s);
  }
  for (int idx = gtid; idx < 6 * 129; idx += gn) {
    const int hd = idx / 129, rel = idx - hd * 129 - 64;
    const int dil = 1 << (2 * (hd >> 1));
    const int rd = rel * dil, n = rd < 0 ? -rd : rd;
    int b;
    if (n < 8) b = n;
    else if (n < 15) b = 8; else if (n < 27) b = 9; else if (n < 50) b = 10; else if (n < 91) b = 11;
    else if (n < 166) b = 12; else if (n < 305) b = 13; else if (n < 559) b = 14; else b = 15;
    if (rd > 0) b += 16;
    p.biasT[idx] = p.rel_bias[b * 6 + hd];
  }
  for (int idx = gtid; idx < 4 * 4 * 128 * 128; idx += gn) p.SgW[idx] = f2bf(p.sgu_w[idx]);
}

DI void prologue_b(const Prm& p) {
  const int gtid = blockIdx.x * NTH + tidx(), gn = gridDim.x * NTH;
  for (int idx = gtid; idx < 4 * 17 * 6144; idx += gn) {
    const int l = idx / (17 * 6144), n = idx % 6144;
    float s = p.ada_b[l * 6144 + n];
#pragma unroll
    for (int kc = 0; kc < 8; ++kc) s += p.modpart[(size_t)kc * 4 * 17 * 6144 + idx];
    p.mod[idx] = s;
  }
}

DI void phase_norm(const Prm& p, const float* xsrc, const float* g, const float* modl, int shoff, int scoff, int sb) {
  const int tid = tidx(), lane = tid & 63;
  const int gw = blockIdx.x * 8 + (tid >> 6), nw = gridDim.x * 8;
  for (int row = gw; row < TB; row += nw) {
    const int cond = condrow(sb, row);
    const float* xr = xsrc + (size_t)row * 1024;
    float4 v[4];
    float ss = 0.f;
#pragma unroll
    for (int i = 0; i < 4; ++i) {
      v[i] = *(const float4*)(xr + i * 256 + lane * 4);
      ss += v[i].x * v[i].x + v[i].y * v[i].y + v[i].z * v[i].z + v[i].w * v[i].w;
    }
#pragma unroll
    for (int off = 32; off >= 1; off >>= 1) ss += __shfl_xor(ss, off);
    const float rstd = rsqrtf(ss * (1.f / 1024.f) + 1e-6f);
    const float* sc = modl + cond * 6144 + scoff;
    const float* sh = modl + cond * 6144 + shoff;
#pragma unroll
    for (int i = 0; i < 4; ++i) {
      const int col = i * 256 + lane * 4;
      const float4 gg = *(const float4*)(g + col), s4 = *(const float4*)(sc + col), h4 = *(const float4*)(sh + col);
      st4bf(p.hbuf + (size_t)row * 1024 + col,
            v[i].x * rstd * gg.x * (1.f + s4.x) + h4.x, v[i].y * rstd * gg.y * (1.f + s4.y) + h4.y,
            v[i].z * rstd * gg.z * (1.f + s4.z) + h4.z, v[i].w * rstd * gg.w * (1.f + s4.w) + h4.w);
    }
  }
}

DI float sigm(float x) { return __builtin_amdgcn_rcpf(1.f + __expf(-x)); }

DI void phase_inproj(const Prm& p, unsigned char* smem_raw, int l, int S, int& base) {
  const u16* W = p.WinT + (size_t)l * NWP * 1024;
  LAS u16* shm = (LAS u16*)smem_raw;
  bool pre = false;
  TASK_LOOP(t, 32 * 64, base) {
    int tn, tm;
    map256(t, 32, tn, tm);
    const int brow = tn * 256, bcol = tm * 256;
    const int tnx = t + (int)gridDim.x;
    const bool has_next = tnx < (32 * 64);
    int tn2 = 0, tm2 = 0;
    if (has_next) map256(tnx, 32, tn2, tm2);
    const int nbrow = tn2 * 256, nbcol = tm2 * 256;
    auto epi = [&](f32x4 (&acc)[2][2][4][2], int wr, int wc, int fr, int fq) __attribute__((always_inline)) {
#pragma unroll
      for (int ai = 0; ai < 2; ++ai)
#pragma unroll
        for (int m = 0; m < 4; ++m) {
          const int nb = brow + ai * 128 + wr * 64 + m * 16;
#pragma unroll
          for (int bj = 0; bj < 2; ++bj)
#pragma unroll
            for (int n = 0; n < 2; ++n) {
              const int tok = bcol + bj * 128 + wc * 32 + n * 16 + fr;
              const f32x4 v = acc[ai][bj][m][n];
              const int nn = nb + fq * 4;
              if (nb < 1536) {
#pragma unroll
                for (int j = 0; j < 4; ++j) p.UT[(size_t)(nn + j) * TBP + tok] = f2bf(v[j]);
              } else if (nb < 2688) {
                st4bf(p.bqkv + (size_t)tok * 1152 + (nn - 1536), v[0], v[1], v[2], v[3]);
              } else if (nb < 3072) {
                st4bf(p.cu + (size_t)tok * 384 + (nn - 2688), v[0], v[1], v[2], v[3]);
              } else if (nb < 3456) {
#pragma unroll
                for (int j = 0; j < 4; ++j) p.cvT[(size_t)(nn - 3072 + j) * TBP + tok] = f2bf(v[j]);
              } else if (nb < 3840) {
                st4bf(p.dcq + (size_t)tok * 384 + (nn - 3456), v[0], v[1], v[2], v[3]);
              } else if (nb < 4160) {
                st4bf(p.dckv + (size_t)tok * 320 + (nn - 3840), v[0], v[1], v[2], v[3]);
              } else if (nb < 4192) {
                if (nb == 4160) {
                  const f32x4 v2 = acc[ai][bj][(m + 1) & 3][n];
                  const int pos = tok & (S - 1);
#pragma unroll
                  for (int j = 0; j < 4; ++j) {
                    const int ii = fq * 4 + j;
                    const float2 cs = p.rope[pos * 16 + ii];
                    const u16 o1 = f2bf(v[j] * cs.x - v2[j] * cs.y), o2 = f2bf(v[j] * cs.y + v2[j] * cs.x);
#pragma unroll
                    for (int hh = 0; hh < 4; ++hh) {
                      p.kc[(size_t)tok * 384 + hh * 96 + 64 + ii] = o1;
                      p.kc[(size_t)tok * 384 + hh * 96 + 80 + ii] = o2;
                    }
                  }
                }
              } else {
                st4bf_nt(p.zg + (size_t)tok * 4096 + (nn - 4192), sigm(v[0]), sigm(v[1]), sigm(v[2]), sigm(v[3]));
              }
            }
          __builtin_amdgcn_sched_barrier(0);
        }
    };
    gemm256(shm, W, p.hbuf, 1024, brow, bcol, pre, has_next, nbrow, nbcol, epi);
    pre = has_next;
  }
  base += 32 * 64;
}

DI void phase_inproj_tail(const Prm& p, unsigned char* smem_raw, int l, int& base) {
  const u16* W = p.WinT + (size_t)l * NWP * 1024;
  u16* smem = (u16*)smem_raw;
  TASK_LOOP(t, 128, base) {
    const int n0 = 8192, m0 = t * 128;
    auto la = [&](int row, int k) __attribute__((always_inline)) { return *(const u32x4*)(W + (size_t)(n0 + row) * 1024 + k); };
    auto lb = [&](int row, int k) __attribute__((always_inline)) { return *(const u32x4*)(p.hbuf + (size_t)(m0 + row) * 1024 + k); };
    auto epi = [&](f32x16 (&acc)[2], int wm, int wn, int lane) __attribute__((always_inline)) {
      const int lr = lane & 31, lh = lane >> 5;
      const int tok = m0 + wn * 32 + lr;
#pragma unroll
      for (int i = 0; i < 2; ++i) {
        const int nb = n0 + wm * 64 + i * 32;
        if (nb >= NW) continue;
#pragma unroll
        for (int q = 0; q < 4; ++q)
          st4bf(p.zg + (size_t)tok * 4096 + (nb - 4192) + 8 * q + 4 * lh, sigm(acc[i][4 * q]), sigm(acc[i][4 * q + 1]), sigm(acc[i][4 * q + 2]),
                sigm(acc[i][4 * q + 3]));
      }
    };
    gemm_tile<false, false>(smem, 16, la, lb, epi);
  }
  base += 128;
}


DI void phase_inproj_probe(const Prm& p, unsigned char* smem_raw, int l, int& base) {
  const u16* W = p.WinT + (size_t)l * NWP * 1024;
  LAS u16* shm = (LAS u16*)smem_raw;
  bool pre = false;
  TASK_LOOP(t, 32 * 64, base) {
    int tn, tm;
    map256(t, 32, tn, tm);
    const int brow = tn * 256, bcol = tm * 256;
    const int tnx = t + (int)gridDim.x;
    const bool has_next = tnx < (32 * 64);
    int tn2 = 0, tm2 = 0;
    if (has_next) map256(tnx, 32, tn2, tm2);
    const int nbrow = tn2 * 256, nbcol = tm2 * 256;
    auto epi = [&](f32x4 (&acc)[2][2][4][2], int wr, int wc, int fr, int fq) __attribute__((always_inline)) {
#pragma unroll
      for (int bj = 0; bj < 2; ++bj)
#pragma unroll
        for (int n = 0; n < 2; ++n) {
          const int tok = bcol + bj * 128 + wc * 32 + n * 16 + fr;
#pragma unroll
          for (int ai = 0; ai < 2; ++ai)
#pragma unroll
            for (int m = 0; m < 4; ++m) {
              const int nn = ((brow + ai * 128 + wr * 64 + m * 16) & 1023) + fq * 4;
              const f32x4 v = acc[ai][bj][m][n];
              st4bf(p.Gp + (size_t)tok * 1024 + nn, v[0], v[1], v[2], v[3]);
            }
        }
    };
    gemm256(shm, W, p.hbuf, 1024, brow, bcol, pre, has_next, nbrow, nbcol, epi);
    pre = has_next;
  }
  base += 32 * 64;
}

DI void phase_fft1(const Prm& p, u16* smem, int S, int nseq, int N1, int lgN1, int& base) {
  const int nkt = N1 == 128 ? 2 : 1;
  const u16* M1 = N1 == 128 ? p.M1a : p.M1b;
  const int ldm = N1 == 128 ? 256 : 64;
  const int nk = N1 == 128 ? 4 : 1;
  const int ntask = nseq * 768 * nkt;
  const int twmul = 16384 / S;
  TASK_LOOP(t, ntask, base) {
    const int k1t = t % nkt, col = (t / nkt) % 768, seq = t / (nkt * 768);
    const int k1base = k1t * 64;
    auto la = [&](int row, int k) __attribute__((always_inline)) {
      const int k1 = k1base + (row >> 6) * 32 + (row & 31), ii = (row >> 5) & 1;
      if (k1 >= N1 || k >= 2 * N1) return zero4();
      return *(const u32x4*)(M1 + (ii * N1 + k1) * ldm + k);
    };
    auto lb = [&](int row, int k) __attribute__((always_inline)) {
      if (k >= 2 * N1) return zero4();
      const int part = k >> lgN1, s1 = k & (N1 - 1);
      const u16* src = p.UT + (size_t)(part * 768 + col) * TBP + seq * S + s1 * 128 + row;
      u32x4 v;
#pragma unroll
      for (int jj = 0; jj < 4; ++jj) v[jj] = (unsigned)src[(2 * jj) * 128] | ((unsigned)src[(2 * jj + 1) * 128] << 16);
      return v;
    };
    auto epi = [&](f32x16 (&acc)[2], int wm, int wn, int lane) __attribute__((always_inline)) {
      const int lr = lane & 31, lh = lane >> 5;
      const int s2 = wn * 32 + lr;
#pragma unroll
      for (int r = 0; r < 16; ++r) {
        const int k1 = k1base + wm * 32 + rowmap(r, lh);
        if (k1 < N1) {
          const float re = acc[0][r], im = acc[1][r];
          const float2 cs = p.tw[(s2 * k1) * twmul];
          const size_t o = ((size_t)((seq * N1 + k1) * 2) * 768 + col) * 128 + s2;
          p.Gp[o] = f2bf(cs.x * re + cs.y * im);
          p.Gp[o + 768 * 128] = f2bf(cs.x * im - cs.y * re);
        }
      }
    };
    gemm_tile<false, true>(smem, nk, la, lb, epi);
  }
  base += ntask;
}


DI void phase_fft1_small(const Prm& p, int nseq) {
  constexpr float C16[16] = {1.f, 0.92387953251128674f, 0.70710678118654752f, 0.38268343236508977f, 0.f, -0.38268343236508977f, -0.70710678118654752f,
                             -0.92387953251128674f, -1.f, -0.92387953251128674f, -0.70710678118654752f, -0.38268343236508977f, 0.f,
                             0.38268343236508977f, 0.70710678118654752f, 0.92387953251128674f};
  constexpr float S16[16] = {0.f, 0.38268343236508977f, 0.70710678118654752f, 0.92387953251128674f, 1.f, 0.92387953251128674f, 0.70710678118654752f,
                             0.38268343236508977f, 0.f, -0.38268343236508977f, -0.70710678118654752f, -0.92387953251128674f, -1.f,
                             -0.92387953251128674f, -0.70710678118654752f, -0.38268343236508977f};
  const int gtid = blockIdx.x * NTH + tidx(), gn = gridDim.x * NTH;
  for (int idx = gtid; idx < nseq * 768 * 128; idx += gn) {
    const int s2 = idx & 127, col = (idx >> 7) % 768, seq = idx / (768 * 128);
    const u16* ur = p.UT + (size_t)col * TBP + seq * 2048 + s2;
    const u16* ui = ur + (size_t)768 * TBP;
    float xr[16], xi[16];
#pragma unroll
    for (int s1 = 0; s1 < 16; ++s1) { xr[s1] = bf2f(ur[s1 * 128]); xi[s1] = bf2f(ui[s1 * 128]); }
    u16* go = p.Gp + ((size_t)(seq * 16 * 2) * 768 + col) * 128 + s2;
#pragma unroll
    for (int k1 = 0; k1 < 16; ++k1) {
      float gr = 0.f, gi = 0.f;
#pragma unroll
      for (int s1 = 0; s1 < 16; ++s1) {
        const float c = C16[(k1 * s1) & 15], sn = S16[(k1 * s1) & 15];
        gr += c * xr[s1] + sn * xi[s1];
        gi += c * xi[s1] - sn * xr[s1];
      }
      const float2 cs = p.tw[(s2 * k1) * 8];
      go[(size_t)(k1 * 2) * 768 * 128] = f2bf(cs.x * gr + cs.y * gi);
      go[(size_t)(k1 * 2 + 1) * 768 * 128] = f2bf(cs.x * gi - cs.y * gr);
    }
  }
}

DI void phase_fft2(const Prm& p, u16* smem, int S, int nseq, int N1, int& base) {
  const int ntask = nseq * N1 * 6;
  const float scale = rsqrtf((float)S * 192.f);
  u16* fa = p.UT;
  TASK_LOOP(t, ntask, base) {
    const int ct = t % 6, k1 = (t / 6) % N1, seq = t / (6 * N1);
    const u16* gb = p.Gp + ((size_t)((seq * N1 + k1) * 2) * 768 + ct * 128) * 128;
    auto la = [&](int row, int k) __attribute__((always_inline)) { return *(const u32x4*)(p.M2 + row * 256 + k); };
    auto lb = [&](int row, int k) __attribute__((always_inline)) {
      const int part = k >> 7, s2 = k & 127;
      return *(const u32x4*)(gb + ((size_t)part * 768 + row) * 128 + s2);
    };
    auto epi = [&](f32x16 (&acc)[2], int wm, int wn, int lane) __attribute__((always_inline)) {
      const int lr = lane & 31, lh = lane >> 5;
      const int col = ct * 128 + wn * 32 + lr;
#pragma unroll
      for (int i = 0; i < 2; ++i)
#pragma unroll
        for (int r = 0; r < 16; ++r) {
          const int k2 = wm * 64 + i * 32 + rowmap(r, lh);
          const int tok = seq * S + k1 + N1 * k2;
          fa[(size_t)tok * 768 + col] = f2bf(acc[i][r] * scale);
        }
    };
    gemm_tile<false, false>(smem, 4, la, lb, epi);
  }
  base += ntask;
}

DI void phase_mixc(const Prm& p, unsigned char* smem_raw, int l, int& base) {
  u16* smem = (u16*)smem_raw;
  float* st = (float*)(smem_raw + GEMM_SMEM);
  float* red = (float*)smem_raw;
  const int tid = tidx();
  TASK_LOOP(t, 512, base) {
    const int h = t & 3, ch = t >> 2, tok0 = ch * 128;
    {
      const int q = tid & 127, qf = tid >> 7;
      float s = 0.f, ss = 0.f;
      const u16* src = p.cvT + (size_t)(qf * 96) * TBP + tok0 + q;
      for (int c = 0; c < 96; ++c) { const float v = bf2f(src[(size_t)c * TBP]); s += v; ss += v * v; }
      red[qf * 256 + q * 2] = s; red[qf * 256 + q * 2 + 1] = ss;
      __syncthreads();
      if (tid < 128) {
        const float s1 = red[q * 2] + red[256 + q * 2] + red[512 + q * 2] + red[768 + q * 2];
        const float s2 = red[q * 2 + 1] + red[256 + q * 2 + 1] + red[512 + q * 2 + 1] + red[768 + q * 2 + 1];
        const float mu = s1 * (1.f / 384.f);
        const float var = fmaxf(s2 * (1.f / 384.f) - mu * mu, 0.f);
        st[q] = mu; st[128 + q] = rsqrtf(var + 1e-6f);
      }
      __syncthreads();
    }
    const u16* Wm = p.SgW + (size_t)((l * 4 + h) * 128) * 128;
    auto la = [&](int row, int k) __attribute__((always_inline)) { return *(const u32x4*)(Wm + row * 128 + k); };
    auto lb = [&](int row, int k) __attribute__((always_inline)) {
      if (row >= 96) return zero4();
      const int c = h * 96 + row;
      const u32x4 raw = *(const u32x4*)(p.cvT + (size_t)c * TBP + tok0 + k);
      const float g = p.ln_g[l * 384 + c], b = p.ln_b[l * 384 + c];
      u32x4 o;
#pragma unroll
      for (int jj = 0; jj < 4; ++jj) {
        const float v0 = (bflo(raw[jj]) - st[k + 2 * jj]) * st[128 + k + 2 * jj] * g + b;
        const float v1 = (bfhi(raw[jj]) - st[k + 2 * jj + 1]) * st[128 + k + 2 * jj + 1] * g + b;
        o[jj] = pack2(v0, v1);
      }
      return o;
    };
    auto epi = [&](f32x16 (&acc)[2], int wm, int wn, int lane) __attribute__((always_inline)) {
      const int lr = lane & 31, lh = lane >> 5;
      const int cl = wn * 32 + lr;
      if (cl < 96) {
#pragma unroll
        for (int i = 0; i < 2; ++i)
#pragma unroll
          for (int r = 0; r < 16; ++r) {
            const int pp = wm * 64 + i * 32 + rowmap(r, lh);
            const float val = acc[i][r] + p.sgu_b[(l * 4 + h) * 128 + pp];
            u16* dst = p.cu + (size_t)(tok0 + pp) * 384 + h * 96 + cl;
            *dst = f2bf(bf2f(*dst) * val);
          }
      }
    };
    gemm_tile<false, false>(smem, 2, la, lb, epi);
  }
  base += 512;
}

DI void phase_qup(const Prm& p, unsigned char* smem_raw, int l, int S, int& base) {
  u16* smem = (u16*)smem_raw;
  float* st = (float*)(smem_raw + GEMM_SMEM);
  const int tid = tidx();
  const float QS = 0.10206207261596577f * LOG2E;
  TASK_LOOP(t, 3 * 128, base) {
    const int tn = t % 3, tm = t / 3, n0 = tn * 128, m0 = tm * 128;
    {
      const int row = tid >> 2, qf = tid & 3;
      const u16* src = p.dcq + (size_t)(m0 + row) * 384 + qf * 96;
      float ss = 0.f;
#pragma unroll 4
      for (int c = 0; c < 12; ++c) {
        const u32x4 v = *(const u32x4*)(src + c * 8);
#pragma unroll
        for (int jj = 0; jj < 4; ++jj) { const float a = bflo(v[jj]), b = bfhi(v[jj]); ss += a * a + b * b; }
      }
      ss += __shfl_xor(ss, 1);
      ss += __shfl_xor(ss, 2);
      if (qf == 0) st[row] = rsqrtf(ss * (1.f / 384.f) + 1e-6f);
      __syncthreads();
    }
    const u16* W = p.WqT + (size_t)l * 384 * 384;
    auto la = [&](int row, int k) __attribute__((always_inline)) { return *(const u32x4*)(W + (size_t)(n0 + row) * 384 + k); };
    auto lb = [&](int row, int k) __attribute__((always_inline)) { return *(const u32x4*)(p.dcq + (size_t)(m0 + row) * 384 + k); };
    auto epi = [&](f32x16 (&acc)[2], int wm, int wn, int lane) __attribute__((always_inline)) {
      const int lr = lane & 31, lh = lane >> 5;
      const int tokl = wn * 32 + lr, tok = m0 + tokl;
      const float sc = st[tokl] * QS;
#pragma unroll
      for (int i = 0; i < 2; ++i) {
        const int nb = n0 + wm * 64 + i * 32;
        const int head = nb / 96, within = nb - head * 96;
        const f32x16& a = acc[i];
        if (within < 64) {
#pragma unroll
          for (int q = 0; q < 4; ++q)
            st4bf(p.qc + (size_t)tok * 384 + nb + 8 * q + 4 * lh, a[4 * q] * sc, a[4 * q + 1] * sc, a[4 * q + 2] * sc, a[4 * q + 3] * sc);
        } else {
          const int pos = tok & (S - 1);
#pragma unroll
          for (int q = 0; q < 2; ++q)
#pragma unroll
            for (int e = 0; e < 4; ++e) {
              const int r = 4 * q + e, ii = 8 * q + 4 * lh + e;
              const float2 cs = p.rope[pos * 16 + ii];
              const float x1 = a[r] * sc, x2 = a[r + 8] * sc;
              p.qc[(size_t)tok * 384 + head * 96 + 64 + ii] = f2bf(x1 * cs.x - x2 * cs.y);
              p.qc[(size_t)tok * 384 + head * 96 + 80 + ii] = f2bf(x1 * cs.y + x2 * cs.x);
            }
        }
      }
    };
    gemm_tile<false, false>(smem, 6, la, lb, epi);
    __syncthreads();
  }
  base += 3 * 128;
}

DI void phase_kvup(const Prm& p, unsigned char* smem_raw, int l, int& base) {
  u16* smem = (u16*)smem_raw;
  float* st = (float*)(smem_raw + GEMM_SMEM);
  const int tid = tidx();
  TASK_LOOP(t, 4 * 128, base) {
    const int tn = t & 3, tm = t >> 2, n0 = tn * 128, m0 = tm * 128;
    {
      const int row = tid >> 2, qf = tid & 3;
      const u16* src = p.dckv + (size_t)(m0 + row) * 320 + qf * 80;
      float ss = 0.f;
#pragma unroll 5
      for (int c = 0; c < 10; ++c) {
        const u32x4 v = *(const u32x4*)(src + c * 8);
#pragma unroll
        for (int jj = 0; jj < 4; ++jj) { const float a = bflo(v[jj]), b = bfhi(v[jj]); ss += a * a + b * b; }
      }
      ss += __shfl_xor(ss, 1);
      ss += __shfl_xor(ss, 2);
      if (qf == 0) st[row] = rsqrtf(ss * (1.f / 320.f) + 1e-6f);
      __syncthreads();
    }
    const u16* W = p.WkvT + (size_t)l * 512 * 320;
    auto la = [&](int row, int k) __attribute__((always_inline)) { return *(const u32x4*)(W + (size_t)(n0 + row) * 320 + k); };
    auto lb = [&](int row, int k) __attribute__((always_inline)) { return *(const u32x4*)(p.dckv + (size_t)(m0 + row) * 320 + k); };
    auto epi = [&](f32x16 (&acc)[2], int wm, int wn, int lane) __attribute__((always_inline)) {
      const int lr = lane & 31, lh = lane >> 5;
      const int head = tn;
      const int tokl = wn * 32 + lr, tok = m0 + tokl;
      const float sc = st[tokl];
#pragma unroll
      for (int i = 0; i < 2; ++i) {
        const int within = wm * 64 + i * 32;
        const f32x16& a = acc[i];
        if (within < 64) {
#pragma unroll
          for (int q = 0; q < 4; ++q)
            st4bf(p.kc + (size_t)tok * 384 + head * 96 + within + 8 * q + 4 * lh, a[4 * q] * sc, a[4 * q + 1] * sc, a[4 * q + 2] * sc, a[4 * q + 3] * sc);
        } else {
#pragma unroll
          for (int r = 0; r < 16; ++r)
            p.vT[(size_t)(head * 64 + within - 64 + rowmap(r, lh)) * TBP + tok] = f2bf(a[r] * sc);
        }
      }
    };
    gemm_tile<false, false>(smem, 5, la, lb, epi);
    __syncthreads();
  }
  base += 4 * 128;
}

DI void phase_mixb(const Prm& p, unsigned char* smem_raw, int S, int lgS, int& base) {
  float* bt = (float*)smem_raw;
  const int tid = tidx(), lane = tid & 63, wave = tid >> 6, lr = lane & 31, lh = lane >> 5;
  u16* vt = (u16*)(smem_raw + 3328) + wave * (64 * 40);
  for (int idx = tid; idx < 774; idx += NTH) bt[idx] = p.biasT[idx];
  __syncthreads();
  TASK_LOOP(t, 384, base) {
    const int wt = t * 8 + wave;
    const int hg = wt & 1, g = (wt >> 1) % 3, blk = wt / 6;
    const int seq = blk >> (lgS - 5), b_in = blk & ((S >> 5) - 1);
    const int lgd = 2 * g, L = S >> lgd;
    const int lgbpr = lgS - lgd - 5;
    const int res = b_in >> lgbpr, i0 = (b_in & ((1 << lgbpr) - 1)) << 5;
    const int tokbase = seq * S + res;
    const int hd = g * 2 + hg, hc = hd * 64;
    const int qi = i0 + lr;
    const int qtok = tokbase + (qi << lgd);
    bf16x8 qf[4];
#pragma unroll
    for (int ks = 0; ks < 4; ++ks) qf[ks] = *(const bf16x8*)(p.bqkv + (size_t)qtok * 1152 + hc + ks * 16 + lh * 8);
    f32x16 sc[5];
#pragma unroll
    for (int tt = 0; tt < 5; ++tt) {
      int ik = i0 - 64 + 32 * tt + lr;
      ik = min(max(ik, 0), L - 1);
      const u16* kp = p.bqkv + (size_t)(tokbase + (ik << lgd)) * 1152 + 384 + hc + lh * 8;
      sc[tt] = zero16();
#pragma unroll
      for (int ks = 0; ks < 4; ++ks) sc[tt] = mfma(*(const bf16x8*)(kp + ks * 16), qf[ks], sc[tt]);
    }
    float mx = -1e30f;
#pragma unroll
    for (int tt = 0; tt < 5; ++tt)
#pragma unroll
      for (int r = 0; r < 16; ++r) {
        const int ik = i0 - 64 + 32 * tt + rowmap(r, lh);
        const int rel = ik - qi;
        const bool valid = (rel >= -64) && (rel <= 64) && (ik >= 0) && (ik < L);
        const int bi = min(max(rel + 64, 0), 128);
        const float s = valid ? (sc[tt][r] * 0.125f + bt[hd * 129 + bi]) * LOG2E : -1e30f;
        sc[tt][r] = s;
        mx = fmaxf(mx, s);
      }
    mx = fmaxf(mx, __shfl_xor(mx, 32));
    float sum = 0.f;
#pragma unroll
    for (int tt = 0; tt < 5; ++tt)
#pragma unroll
      for (int r = 0; r < 16; ++r) {
        const float pv = ex2(sc[tt][r] - mx);
        sum += pv;
        sc[tt][r] = pv;
      }
    sum += __shfl_xor(sum, 32);
    f32x16 oacc[2];
    oacc[0] = zero16(); oacc[1] = zero16();
#pragma unroll
    for (int tt = 0; tt < 5; ++tt) {
#pragma unroll
      for (int e = 0; e < 4; ++e) {
        const int c = lane + 64 * e, key = c >> 3, dch = c & 7;
        int ik = i0 - 64 + 32 * tt + key;
        ik = min(max(ik, 0), L - 1);
        const u32x4 raw = *(const u32x4*)(p.bqkv + (size_t)(tokbase + (ik << lgd)) * 1152 + 768 + hc + dch * 8);
#pragma unroll
        for (int jj = 0; jj < 4; ++jj) {
          vt[(dch * 8 + 2 * jj) * 40 + key] = (u16)(raw[jj] & 0xffffu);
          vt[(dch * 8 + 2 * jj + 1) * 40 + key] = (u16)(raw[jj] >> 16);
        }
      }
      __syncthreads();
#pragma unroll
      for (int u = 0; u < 2; ++u) {
        u32x4 pk;
#pragma unroll
        for (int jj = 0; jj < 4; ++jj) pk[jj] = pack2(sc[tt][8 * u + 2 * jj], sc[tt][8 * u + 2 * jj + 1]);
        const bf16x8 pf = __builtin_bit_cast(bf16x8, pk);
#pragma unroll
        for (int dt = 0; dt < 2; ++dt) {
          const u16* vp = vt + (dt * 32 + lr) * 40 + 16 * u + 4 * lh;
          u32x4 vv;
          const u32x2 lo = *(const u32x2*)vp, hi = *(const u32x2*)(vp + 8);
          vv[0] = lo[0]; vv[1] = lo[1]; vv[2] = hi[0]; vv[3] = hi[1];
          oacc[dt] = mfma(__builtin_bit_cast(bf16x8, vv), pf, oacc[dt]);
        }
      }
      __syncthreads();
    }
    const float inv = 1.f / sum;
#pragma unroll
    for (int dt = 0; dt < 2; ++dt)
#pragma unroll
      for (int q = 0; q < 4; ++q) {
        float4 o;
        o.x = oacc[dt][4 * q] * inv; o.y = oacc[dt][4 * q + 1] * inv; o.z = oacc[dt][4 * q + 2] * inv; o.w = oacc[dt][4 * q + 3] * inv;
        *(float4*)(p.og + (size_t)qtok * 384 + hc + dt * 32 + 8 * q + 4 * lh) = o;
      }
    if (lh == 0) p.lse[(size_t)qtok * 6 + hd] = (mx + __log2f(sum)) * LN2;
  }
  base += 384;
  __syncthreads();
}

DI void phase_combb(const Prm& p) {
  const int gtid = blockIdx.x * NTH + tidx(), gn = gridDim.x * NTH;
  for (int idx = gtid; idx < TB * 32; idx += gn) {
    const int dq = idx & 15, hg = (idx >> 4) & 1, tok = idx >> 5;
    const float l0 = p.lse[(size_t)tok * 6 + hg], l1 = p.lse[(size_t)tok * 6 + 2 + hg], l2 = p.lse[(size_t)tok * 6 + 4 + hg];
    const float mx = fmaxf(l0, fmaxf(l1, l2));
    const float e0 = __expf(l0 - mx), e1 = __expf(l1 - mx), e2 = __expf(l2 - mx);
    const float inv = 1.f / (e0 + e1 + e2);
    const float4 a = *(const float4*)(p.og + (size_t)tok * 384 + hg * 64 + dq * 4);
    const float4 b = *(const float4*)(p.og + (size_t)tok * 384 + 128 + hg * 64 + dq * 4);
    const float4 c = *(const float4*)(p.og + (size_t)tok * 384 + 256 + hg * 64 + dq * 4);
    st4bf(p.ob + (size_t)tok * 128 + hg * 64 + dq * 4, (e0 * a.x + e1 * b.x + e2 * c.x) * inv, (e0 * a.y + e1 * b.y + e2 * c.y) * inv,
          (e0 * a.z + e1 * b.z + e2 * c.z) * inv, (e0 * a.w + e1 * b.w + e2 * c.w) * inv);
  }
}

constexpr int KS_ELEMS = 128 * 104, VS_ELEMS = 64 * 136;
DI void phase_mla(const Prm& p, unsigned char* smem_raw, int S, int lgS, int& base) {
  u16* Ks = (u16*)smem_raw;
  u16* Vs = Ks + 2 * KS_ELEMS;
  const int tid = tidx(), lane = tid & 63, wave = tid >> 6, lr = lane & 31, lh = lane >> 5;
  const int nkt = S >> 7;
  TASK_LOOP(t, 256, base) {
    const int head = t & 3, qb = t >> 2, tok0 = qb * 256;
    const int seqtok0 = (tok0 >> lgS) << lgS;
    const int qtok = tok0 + wave * 32 + lr;
    bf16x8 qf[6];
#pragma unroll
    for (int ks = 0; ks < 6; ++ks) qf[ks] = *(const bf16x8*)(p.qc + (size_t)qtok * 384 + head * 96 + ks * 16 + lh * 8);
    const u16* kbase = p.kc + (size_t)seqtok0 * 384 + head * 96;
    const u16* vbase = p.vT + (size_t)(head * 64) * TBP + seqtok0;
    u32x4 rk[3], rv[2];
    auto gload = [&](int kt) __attribute__((always_inline)) {
#pragma unroll
      for (int e = 0; e < 3; ++e) {
        const int c = tid + NTH * e, key = c / 12, dc = c - key * 12;
        rk[e] = *(const u32x4*)(kbase + (size_t)(kt * 128 + key) * 384 + dc * 8);
      }
#pragma unroll
      for (int e = 0; e < 2; ++e) {
        const int c = tid + NTH * e, d = c >> 4, kch = c & 15;
        rv[e] = *(const u32x4*)(vbase + (size_t)d * TBP + kt * 128 + kch * 8);
      }
    };
    auto sstore = [&](int buf) __attribute__((always_inline)) {
#pragma unroll
      for (int e = 0; e < 3; ++e) {
        const int c = tid + NTH * e, key = c / 12, dc = c - key * 12;
        *(u32x4*)(Ks + buf * KS_ELEMS + key * 104 + dc * 8) = rk[e];
      }
#pragma unroll
      for (int e = 0; e < 2; ++e) {
        const int c = tid + NTH * e, d = c >> 4, kch = c & 15;
        u16* vd = Vs + buf * VS_ELEMS + d * 136 + (kch >> 1) * 16 + (kch & 1) * 4;
        u32x2 lo, hi;
        lo[0] = rv[e][0]; lo[1] = rv[e][1]; hi[0] = rv[e][2]; hi[1] = rv[e][3];
        *(u32x2*)vd = lo;
        *(u32x2*)(vd + 8) = hi;
      }
    };
    float m = -1e30f;
    f32x2 lsum2 = {0.f, 0.f};
    f32x16 oacc[2];
    oacc[0] = zero16(); oacc[1] = zero16();
    gload(0);
    sstore(0);
    __syncthreads();
    for (int kt = 0; kt < nkt; ++kt) {
      const int buf = kt & 1;
      if (kt + 1 < nkt) gload(kt + 1);
      f32x16 s[4];
#pragma unroll
      for (int kk = 0; kk < 4; ++kk) s[kk] = zero16();
      {
        const u16* kp = Ks + buf * KS_ELEMS + lr * 104 + lh * 8;
        bf16x8 kf[4];
#pragma unroll
        for (int kk = 0; kk < 4; ++kk) kf[kk] = *(const bf16x8*)(kp + kk * 32 * 104);
#pragma unroll
        for (int ks = 0; ks < 6; ++ks) {
          bf16x8 kn[4];
          if (ks < 5) {
#pragma unroll
            for (int kk = 0; kk < 4; ++kk) kn[kk] = *(const bf16x8*)(kp + kk * 32 * 104 + (ks + 1) * 16);
          }
#pragma unroll
          for (int kk = 0; kk < 4; ++kk) s[kk] = mfma(kf[kk], qf[ks], s[kk]);
          if (ks < 5) {
#pragma unroll
            for (int kk = 0; kk < 4; ++kk) kf[kk] = kn[kk];
          }
        }
      }
      float mloc = -1e30f;
#pragma unroll
      for (int kk = 0; kk < 4; ++kk)
#pragma unroll
        for (int r = 0; r < 16; ++r) mloc = fmaxf(mloc, s[kk][r]);
      mloc = fmaxf(mloc, __shfl_xor(mloc, 32));
      const float mnew = fmaxf(m, mloc);
      const float alpha = ex2(m - mnew);
      m = mnew;
      lsum2 *= alpha;
      const f32x2 mn2 = {mnew, mnew};
#pragma unroll
      for (int kk = 0; kk < 4; ++kk)
#pragma unroll
        for (int r2 = 0; r2 < 8; ++r2) {
          f32x2 v = {s[kk][2 * r2], s[kk][2 * r2 + 1]};
          v = v - mn2;
          f32x2 pv;
          pv[0] = ex2(v[0]); pv[1] = ex2(v[1]);
          lsum2 += pv;
          s[kk][2 * r2] = pv[0]; s[kk][2 * r2 + 1] = pv[1];
        }
#pragma unroll
      for (int dt = 0; dt < 2; ++dt)
#pragma unroll
        for (int r = 0; r < 16; ++r) oacc[dt][r] *= alpha;
#pragma unroll
      for (int kk = 0; kk < 4; ++kk)
#pragma unroll
        for (int u = 0; u < 2; ++u) {
          u32x4 pk;
#pragma unroll
          for (int jj = 0; jj < 4; ++jj) pk[jj] = pack2(s[kk][8 * u + 2 * jj], s[kk][8 * u + 2 * jj + 1]);
          const bf16x8 pf = __builtin_bit_cast(bf16x8, pk);
#pragma unroll
          for (int dt = 0; dt < 2; ++dt) {
            const u16* vp = Vs + buf * VS_ELEMS + (dt * 32 + lr) * 136 + kk * 32 + 16 * u + 8 * lh;
            oacc[dt] = mfma(*(const bf16x8*)vp, pf, oacc[dt]);
          }
        }
      if (kt + 1 < nkt) sstore(buf ^ 1);
      __syncthreads();
    }
    float lsum = lsum2[0] + lsum2[1];
    lsum += __shfl_xor(lsum, 32);
    const float inv = 1.f / lsum;
#pragma unroll
    for (int dt = 0; dt < 2; ++dt)
#pragma unroll
      for (int q = 0; q < 4; ++q)
        st4bf(p.od + (size_t)qtok * 256 + head * 64 + dt * 32 + 8 * q + 4 * lh, oacc[dt][4 * q] * inv, oacc[dt][4 * q + 1] * inv,
              oacc[dt][4 * q + 2] * inv, oacc[dt][4 * q + 3] * inv);
  }
  base += 256;
}

template <class ACC>
DI void merge_branch(const Prm& p, u16* smem, const u16* W, const u16* X, int ld, int bi, int n0, int m0, ACC& macc) {
  auto la = [&](int row, int k) __attribute__((always_inline)) { return *(const u32x4*)(W + (size_t)(n0 + row) * ld + k); };
  auto lb = [&](int row, int k) __attribute__((always_inline)) { return *(const u32x4*)(X + (size_t)(m0 + row) * ld + k); };
  auto epi = [&](f32x16 (&acc)[2], int wm, int wn, int lane) __attribute__((always_inline)) {
    const int lr = lane & 31, lh = lane >> 5;
    const int tok = m0 + wn * 32 + lr;
#pragma unroll
    for (int i = 0; i < 2; ++i)
#pragma unroll
      for (int q = 0; q < 4; ++q) {
        const int n = n0 + wm * 64 + i * 32 + 8 * q + 4 * lh;
        const u32x2 gz = *(const u32x2*)(p.zg + (size_t)tok * 4096 + bi * 1024 + n);
        macc[i][4 * q] += bflo(gz[0]) * acc[i][4 * q];
        macc[i][4 * q + 1] += bfhi(gz[0]) * acc[i][4 * q + 1];
        macc[i][4 * q + 2] += bflo(gz[1]) * acc[i][4 * q + 2];
        macc[i][4 * q + 3] += bfhi(gz[1]) * acc[i][4 * q + 3];
      }
  };
  gemm_tile<false, false>(smem, ld >> 6, la, lb, epi);
}

DI void phase_merge(const Prm& p, u16* smem, int l, int& base) {
  TASK_LOOP(t, 8 * 128, base) {
    const int tn = t & 7, tm = t >> 3, n0 = tn * 128, m0 = tm * 128;
    f32x16 macc[2];
    macc[0] = zero16(); macc[1] = zero16();
    merge_branch(p, smem, p.PaT + (size_t)l * 1024 * 768, p.UT, 768, 0, n0, m0, macc);
    merge_branch(p, smem, p.PbT + (size_t)l * 1024 * 128, p.ob, 128, 1, n0, m0, macc);
    merge_branch(p, smem, p.PcT + (size_t)l * 1024 * 384, p.cu, 384, 2, n0, m0, macc);
    merge_branch(p, smem, p.PdT + (size_t)l * 1024 * 256, p.od, 256, 3, n0, m0, macc);
    const int tid2 = tidx(), lane = tid2 & 63, wave = tid2 >> 6, wm = wave >> 2, wn = wave & 3, lr = lane & 31, lh = lane >> 5;
    const int tok = m0 + wn * 32 + lr;
#pragma unroll
    for (int i = 0; i < 2; ++i)
#pragma unroll
      for (int q = 0; q < 4; ++q)
        st4bf(p.hbuf + (size_t)tok * 1024 + n0 + wm * 64 + i * 32 + 8 * q + 4 * lh, macc[i][4 * q], macc[i][4 * q + 1],
              macc[i][4 * q + 2], macc[i][4 * q + 3]);
  }
  base += 8 * 128;
}

DI void phase_resid_gemm(const Prm& p, unsigned char* smem_raw, const u16* W, const u16* X, int K, const float* xsrc, float* xdst,
                         const float* modl, int gtoff, int sb, int& base) {
  LAS u16* shm = (LAS u16*)smem_raw;
  bool pre = false;
  TASK_LOOP(t, 4 * 64, base) {
    int tn, tm;
    map256(t, 4, tn, tm);
    const int brow = tn * 256, bcol = tm * 256;
    const int tnx = t + (int)gridDim.x;
    const bool has_next = tnx < (4 * 64);
    int tn2 = 0, tm2 = 0;
    if (has_next) map256(tnx, 4, tn2, tm2);
    const int nbrow = tn2 * 256, nbcol = tm2 * 256;
    auto epi = [&](f32x4 (&acc)[2][2][4][2], int wr, int wc, int fr, int fq) __attribute__((always_inline)) {
#pragma unroll
      for (int bj = 0; bj < 2; ++bj)
#pragma unroll
        for (int n = 0; n < 2; ++n) {
          const int tok = bcol + bj * 128 + wc * 32 + n * 16 + fr;
          const float* gt = modl + condrow(sb, tok) * 6144 + gtoff;
#pragma unroll
          for (int ai = 0; ai < 2; ++ai)
#pragma unroll
            for (int m = 0; m < 4; ++m) {
              const int nn = brow + ai * 128 + wr * 64 + m * 16 + fq * 4;
              const f32x4 v = acc[ai][bj][m][n];
              const float4 g4 = *(const float4*)(gt + nn);
              const float4 xi = *(const float4*)(xsrc + (size_t)tok * 1024 + nn);
              float4 o;
              o.x = xi.x + g4.x * v[0]; o.y = xi.y + g4.y * v[1]; o.z = xi.z + g4.z * v[2]; o.w = xi.w + g4.w * v[3];
              *(float4*)(xdst + (size_t)tok * 1024 + nn) = o;
            }
        }
    };
    gemm256(shm, W, X, K, brow, bcol, pre, has_next, nbrow, nbcol, epi);
    pre = has_next;
  }
  base += 4 * 64;
}

DI void phase_w1(const Prm& p, unsigned char* smem_raw, int l, int& base) {
  const u16* W = p.W1T + (size_t)l * 4096 * 1024;
  LAS u16* shm = (LAS u16*)smem_raw;
  bool pre = false;
  TASK_LOOP(t, 16 * 64, base) {
    int tn, tm;
    map256(t, 16, tn, tm);
    const int brow = tn * 256, bcol = tm * 256;
    const int tnx = t + (int)gridDim.x;
    const bool has_next = tnx < (16 * 64);
    int tn2 = 0, tm2 = 0;
    if (has_next) map256(tnx, 16, tn2, tm2);
    const int nbrow = tn2 * 256, nbcol = tm2 * 256;
    auto epi = [&](f32x4 (&acc)[2][2][4][2], int wr, int wc, int fr, int fq) __attribute__((always_inline)) {
#pragma unroll
      for (int bj = 0; bj < 2; ++bj)
#pragma unroll
        for (int n = 0; n < 2; ++n) {
          const int tok = bcol + bj * 128 + wc * 32 + n * 16 + fr;
#pragma unroll
          for (int ai = 0; ai < 2; ++ai)
#pragma unroll
            for (int m = 0; m < 4; ++m) {
              const int nn = brow + ai * 128 + wr * 64 + m * 16 + fq * 4;
              const f32x4 v = acc[ai][bj][m][n];
              const float a0 = fmaxf(v[0], 0.f), a1 = fmaxf(v[1], 0.f), a2 = fmaxf(v[2], 0.f), a3 = fmaxf(v[3], 0.f);
              st4bf(p.zg + (size_t)tok * 4096 + nn, a0 * a0, a1 * a1, a2 * a2, a3 * a3);
            }
        }
    };
    gemm256(shm, W, p.hbuf, 1024, brow, bcol, pre, has_next, nbrow, nbcol, epi);
    pre = has_next;
  }
  base += 16 * 64;
}

DI void phase_final(const Prm& p) {
  const int tid = tidx(), lane = tid & 63;
  const int gw = blockIdx.x * 8 + (tid >> 6), nw = gridDim.x * 8;
  for (int row = gw; row < 3 * TB; row += nw) {
    float* xr = p.out + (size_t)row * 1024;
    float4 v[4];
    float ss = 0.f;
#pragma unroll
    for (int i = 0; i < 4; ++i) {
      v[i] = *(const float4*)(xr + i * 256 + lane * 4);
      ss += v[i].x * v[i].x + v[i].y * v[i].y + v[i].z * v[i].z + v[i].w * v[i].w;
    }
#pragma unroll
    for (int off = 32; off >= 1; off >>= 1) ss += __shfl_xor(ss, off);
    const float rstd = rsqrtf(ss * (1.f / 1024.f) + 1e-6f);
#pragma unroll
    for (int i = 0; i < 4; ++i) {
      const int col = i * 256 + lane * 4;
      const float4 gg = *(const float4*)(p.final_g + col);
      float4 o;
      o.x = v[i].x * rstd * gg.x; o.y = v[i].y * rstd * gg.y; o.z = v[i].z * rstd * gg.z; o.w = v[i].w * rstd * gg.w;
      *(float4*)(xr + col) = o;
    }
  }
}

__global__ void __launch_bounds__(512) mega(Prm p) {
  cg::grid_group grid = cg::this_grid();
  __shared__ __attribute__((aligned(16))) unsigned char smem_raw[SMEM_BYTES];
  __shared__ uint4 xb_words;
  u16* smem = (u16*)smem_raw;
  if (threadIdx.x == 0) xb_words = make_uint4(0u, 0u, 0u, 0u);
  __syncthreads();
  const XcdBarrier xb = xcd_barrier_post(p.bar, (volatile LAS unsigned*)&xb_words);
  int base = 0;
  prologue_a(p, smem_raw, base);
  if (PROBE == 11) prologue_a(p, smem_raw, base);
  grid.sync();
  prologue_b(p);
  xcd_barrier(xb);
  for (int sb = 0; sb < 3; ++sb) {
    const int S = sb == 0 ? 16384 : 2048, lgS = sb == 0 ? 14 : 11, nseq = sb == 0 ? 1 : 8;
    const int N1 = S >> 7, lgN1 = lgS - 7;
    const float* xin = sb == 0 ? p.x_prompt : p.x_sample + (size_t)(sb - 1) * TB * 1024;
    float* xo = p.out + (size_t)sb * TB * 1024;
    for (int l = 0; l < 4; ++l) {
      const float* xs = l == 0 ? xin : xo;
      const float* modl = p.mod + (size_t)l * 17 * 6144;
      phase_norm(p, xs, p.norm1_g + l * 1024, modl, 0, 1024, sb);
      xcd_barrier(xb);
      phase_inproj(p, smem_raw, l, S, base);
      if (PROBE == 2 || PROBE == 7) phase_inproj(p, smem_raw, l, S, base);
      if (PROBE == 12) phase_inproj_probe(p, smem_raw, l, base);
      xcd_barrier(xb);
      if (PROBE == 5) xcd_barrier(xb);
      if (N1 == 16) phase_fft1_small(p, nseq); else phase_fft1(p, smem, S, nseq, N1, lgN1, base);
      phase_mixb(p, smem_raw, S, lgS, base);
      phase_mixc(p, smem_raw, l, base);
      phase_qup(p, smem_raw, l, S, base);
      phase_kvup(p, smem_raw, l, base);
      phase_inproj_tail(p, smem_raw, l, base);
      if (PROBE == 13) phase_fft1(p, smem, S, nseq, N1, lgN1, base);
      if (PROBE == 14) phase_mixb(p, smem_raw, S, lgS, base);
      if (PROBE == 15) { phase_qup(p, smem_raw, l, S, base); phase_kvup(p, smem_raw, l, base); phase_inproj_tail(p, smem_raw, l, base); }
      if (PROBE == 4) { phase_fft1(p, smem, S, nseq, N1, lgN1, base); phase_mixb(p, smem_raw, S, lgS, base); phase_qup(p, smem_raw, l, S, base); phase_kvup(p, smem_raw, l, base); }
      xcd_barrier(xb);
      if (PROBE == 5) xcd_barrier(xb);
      phase_mla(p, smem_raw, S, lgS, base);
      if (PROBE == 1) phase_mla(p, smem_raw, S, lgS, base);
      phase_fft2(p, smem, S, nseq, N1, base);
      phase_combb(p);
      if (PROBE == 6) { phase_fft2(p, smem, S, nseq, N1, base); phase_combb(p); }
      xcd_barrier(xb);
      if (PROBE == 5) xcd_barrier(xb);
      phase_merge(p, smem, l, base);
      if (PROBE == 3) phase_merge(p, smem, l, base);
      xcd_barrier(xb);
      if (PROBE == 5) xcd_barrier(xb);
      phase_resid_gemm(p, smem_raw, p.WoT + (size_t)l * 1024 * 1024, p.hbuf, 1024, xs, xo, modl, 2048, sb, base);
      xcd_barrier(xb);
      phase_norm(p, xo, p.norm2_g + l * 1024, modl, 3072, 4096, sb);
      if (PROBE == 9) { phase_norm(p, xo, p.norm2_g + l * 1024, modl, 3072, 4096, sb); phase_norm(p, xo, p.norm2_g + l * 1024, modl, 3072, 4096, sb); }
      xcd_barrier(xb);
      phase_w1(p, smem_raw, l, base);
      if (PROBE == 2 || PROBE == 8) phase_w1(p, smem_raw, l, base);
      xcd_barrier(xb);
      if (PROBE == 5) xcd_barrier(xb);
      phase_resid_gemm(p, smem_raw, p.W2T + (size_t)l * 1024 * 4096, p.zg, 4096, xo, xo, modl, 5120, sb, base);
      xcd_barrier(xb);
    }
  }
  phase_final(p);
}

extern "C" void kernel_launch(void* const* d_in, const int* in_sizes, int n_in, void* d_out, int out_size, void* d_ws, size_t ws_size,
                              hipStream_t stream) {
  Prm p{};
  const float* const* in = (const float* const*)d_in;
  p.x_prompt = in[0]; p.x_sample = in[1]; p.c_prompt = in[2]; p.c_sample = in[3]; p.rel_bias = in[4]; p.ada_w = in[5]; p.ada_b = in[6];
  p.norm1_g = in[7]; p.w_in = in[8]; p.qn_g = in[9]; p.kvn_g = in[10]; p.w_uq = in[11]; p.w_ukv = in[12]; p.ln_g = in[13]; p.ln_b = in[14];
  p.sgu_w = in[15]; p.sgu_b = in[16]; p.p_a = in[17]; p.p_b = in[18]; p.p_c = in[19]; p.p_d = in[20]; p.w_o = in[21]; p.norm2_g = in[22];
  p.w1 = in[23]; p.w2 = in[24]; p.final_g = in[25];
  p.out = (float*)d_out;
  char* w = (char*)d_ws;
  size_t off = 0;
  auto take = [&](size_t bytes) __attribute__((always_inline)) { void* r = w + off; off += (bytes + 255) & ~(size_t)255; return r; };
  p.WinT = (u16*)take((size_t)4 * NWP * 1024 * 2);
  p.W1T = (u16*)take((size_t)4 * 4096 * 1024 * 2);
  p.W2T = (u16*)take((size_t)4 * 4096 * 1024 * 2);
  p.WoT = (u16*)take((size_t)4 * 1024 * 1024 * 2);
  p.PaT = (u16*)take((size_t)4 * 1024 * 768 * 2);
  p.PbT = (u16*)take((size_t)4 * 1024 * 128 * 2);
  p.PcT = (u16*)take((size_t)4 * 1024 * 384 * 2);
  p.PdT = (u16*)take((size_t)4 * 1024 * 256 * 2);
  p.WqT = (u16*)take((size_t)4 * 384 * 384 * 2);
  p.WkvT = (u16*)take((size_t)4 * 512 * 320 * 2);
  p.SgW = (u16*)take((size_t)4 * 4 * 128 * 128 * 2);
  p.M1a = (u16*)take(256 * 256 * 2);
  p.M1b = (u16*)take(32 * 64 * 2);
  p.M2 = (u16*)take(128 * 256 * 2);
  p.tw = (float2*)take(16384 * 8);
  p.rope = (float2*)take((size_t)16384 * 16 * 8);
  p.biasT = (float*)take(6 * 129 * 4);
  p.mod = (float*)take((size_t)4 * 17 * 6144 * 4);
  p.hbuf = (u16*)take((size_t)TB * 1024 * 2);
  p.og = (float*)take((size_t)TB * 384 * 4);
  p.UT = (u16*)take((size_t)1536 * TBP * 2);
  p.Gp = (u16*)take((size_t)1536 * TB * 2);
  p.bqkv = (u16*)take((size_t)TB * 1152 * 2);
  p.ob = (u16*)take((size_t)TB * 128 * 2);
  p.cu = (u16*)take((size_t)TB * 384 * 2);
  p.cvT = (u16*)take((size_t)TBP * 384 * 2);
  p.dcq = (u16*)take((size_t)TB * 384 * 2);
  p.dckv = (u16*)take((size_t)TB * 320 * 2);
  p.qc = (u16*)take((size_t)TB * 384 * 2);
  p.kc = (u16*)take((size_t)TB * 384 * 2);
  p.vT = (u16*)take((size_t)TBP * 256 * 2);
  p.od = (u16*)take((size_t)TB * 256 * 2);
  p.lse = (float*)take((size_t)TB * 6 * 4);
  p.zg = (u16*)take((size_t)TB * 4096 * 2);
  p.bar = (unsigned*)take(XCD_BAR_WORDS * 4);
  p.modpart = (float*)p.zg;
  if (off > ws_size) { fprintf(stderr, "workspace too small: need %zu have %zu\n", off, ws_size); return; }
  static int grid_blocks = 0;
  if (!grid_blocks) {
    int dev = 0, cus = 0, per_cu = 0;
    (void)hipGetDevice(&dev);
    (void)hipDeviceGetAttribute(&cus, hipDeviceAttributeMultiprocessorCount, dev);
    (void)hipOccupancyMaxActiveBlocksPerMultiprocessor(&per_cu, mega, NTH, 0);
    if (per_cu < 1) per_cu = 1;
    if (per_cu > 1) per_cu = 1;
    grid_blocks = cus * per_cu;
  }
  (void)hipMemsetAsync(p.bar, 0, XCD_BAR_WORDS * 4, stream);
  void* args[] = {&p};
  hipError_t e = hipLaunchCooperativeKernel((void*)mega, dim3(grid_blocks), dim3(NTH), args, 0, stream);
  if (e != hipSuccess) fprintf(stderr, "cooperative launch failed: %s (grid %d)\n", hipGetErrorString(e), grid_blocks);
}
```

```cpp
#include <hip/hip_runtime.h>
#include <hip/hip_cooperative_groups.h>
#include <stdint.h>
#include <stdio.h>
namespace cg = cooperative_groups;

#define DI __device__ __forceinline__
#define LAS __attribute__((address_space(3)))
typedef unsigned short u16;
typedef __attribute__((ext_vector_type(8))) short bf16x8;
typedef __attribute__((ext_vector_type(4))) short bf16x4;
typedef __attribute__((ext_vector_type(16))) float f32x16;
typedef __attribute__((ext_vector_type(4))) float f32x4;
typedef __attribute__((ext_vector_type(2))) float f32x2;
typedef __attribute__((ext_vector_type(4))) unsigned u32x4;
typedef __attribute__((ext_vector_type(2))) unsigned u32x2;
typedef __attribute__((ext_vector_type(2))) __bf16 bf2_t;

constexpr int TB = 16384;
constexpr int TBP = TB + 64;
constexpr int NW = 8288;
constexpr int NWP = 8320;
constexpr int LDT = 72;
constexpr int TILE_ELEMS = 128 * LDT;
constexpr int GEMM_SMEM = 4 * TILE_ELEMS * 2;
constexpr int SMEM_BYTES = 131072;
#ifndef PROBE
#define PROBE 0
#endif
constexpr int NTH = 512;
constexpr int HT = 128 * 64;
constexpr float LOG2E = 1.4426950408889634f;
constexpr float LN2 = 0.6931471805599453f;

struct Prm {
  const float *x_prompt, *x_sample, *c_prompt, *c_sample, *rel_bias, *ada_w, *ada_b, *norm1_g, *w_in,
      *qn_g, *kvn_g, *w_uq, *w_ukv, *ln_g, *ln_b, *sgu_w, *sgu_b, *p_a, *p_b, *p_c, *p_d, *w_o,
      *norm2_g, *w1, *w2, *final_g;
  float* out;
  u16 *WinT, *W1T, *W2T, *WoT, *PaT, *PbT, *PcT, *PdT, *WqT, *WkvT, *SgW, *M1a, *M1b, *M2;
  float2 *tw, *rope;
  float *biasT, *mod, *modpart;
  u16 *hbuf, *UT, *Gp, *bqkv, *ob, *cu, *cvT, *dcq, *dckv, *qc, *kc, *vT, *od, *zg;
  float *og, *lse;
  unsigned* bar;
};

DI unsigned pack2(float a, float b) { bf2_t v; v[0] = (__bf16)a; v[1] = (__bf16)b; return __builtin_bit_cast(unsigned, v); }
DI u16 f2bf(float a) { return __builtin_bit_cast(u16, (__bf16)a); }
DI float bf2f(u16 v) { return __uint_as_float(((unsigned)v) << 16); }
DI float bflo(unsigned w) { return __uint_as_float(w << 16); }
DI float bfhi(unsigned w) { return __uint_as_float(w & 0xffff0000u); }
DI void st4bf(u16* dst, float a, float b, float c, float d) { u32x2 v; v[0] = pack2(a, b); v[1] = pack2(c, d); *(u32x2*)dst = v; }
DI void st4bf_nt(u16* dst, float a, float b, float c, float d) { u32x2 v; v[0] = pack2(a, b); v[1] = pack2(c, d); __builtin_nontemporal_store(v, (u32x2*)dst); }
DI int rowmap(int r, int lh) { return (r & 3) + 8 * (r >> 2) + 4 * lh; }
DI f32x16 mfma(bf16x8 a, bf16x8 b, f32x16 c) { return __builtin_amdgcn_mfma_f32_32x32x16_bf16(a, b, c, 0, 0, 0); }
DI u32x4 zero4() { u32x4 z; z[0] = 0; z[1] = 0; z[2] = 0; z[3] = 0; return z; }
DI f32x16 zero16() { f32x16 z; for (int i = 0; i < 16; ++i) z[i] = 0.f; return z; }
DI float ex2(float x) { return __builtin_amdgcn_exp2f(x); }
DI int tidx() { int t = threadIdx.x; asm volatile("" : "+v"(t)); return t; }


#define XB_TMO      128
#define XB_XCNT(j)  (256  + 64 * (j))
#define XB_XSUB(j)  (1280 + 64 * (j))
#define XB_XGEN(j)  (2304 + 64 * (j))
#define XB_TOP      3328
#define XB_TOPGEN   3392
#define XCD_BAR_WORDS 3456
#define XB_SPIN_CAP (1u << 18)
DI unsigned xb_ld(unsigned* p) { return __hip_atomic_load(p, __ATOMIC_RELAXED, __HIP_MEMORY_SCOPE_AGENT); }
DI unsigned xb_add(unsigned* p, unsigned v) { return __hip_atomic_fetch_add(p, v, __ATOMIC_RELAXED, __HIP_MEMORY_SCOPE_AGENT); }
DI unsigned xb_xcc_id() { return (unsigned)__builtin_amdgcn_s_getreg((3 << 11) | 20) & 0xFu; }
#define XB_SPIN(cond, bar) do { unsigned _sp = 0; while (cond) { __builtin_amdgcn_s_sleep(1); \
    if ((++_sp & 255u) == 0u) { if (xb_ld(&(bar)[XB_TMO])) break; if (_sp > XB_SPIN_CAP) { atomicAdd(&(bar)[XB_TMO], 1u); break; } } } } while (0)
struct XcdBarrier { unsigned* bar; unsigned x; volatile LAS unsigned* st; };
DI XcdBarrier xcd_barrier_post(unsigned* bar, volatile LAS unsigned* st) {
  XcdBarrier b; b.bar = bar; b.x = xb_xcc_id(); b.st = st;
  if (threadIdx.x == 0) (void)xb_add(&bar[XB_XCNT(b.x)], 1u);
  return b;
}
DI void xcd_barrier_complete(unsigned* bar, unsigned x, unsigned& nloc, unsigned& nx) {
  const unsigned G = gridDim.x * gridDim.y * gridDim.z;
  unsigned sum, cnt, mine, sp = 0u;
  for (;;) {
    sum = 0u; cnt = 0u; mine = 0u;
#pragma unroll
    for (unsigned j = 0; j < 16; ++j) { const unsigned c = xb_ld(&bar[XB_XCNT(j)]); sum += c; cnt += (c > 0u) ? 1u : 0u; mine = (j == x) ? c : mine; }
    if (sum == G) break;
    __builtin_amdgcn_s_sleep(1);
    if ((++sp & 255u) == 0u) { if (xb_ld(&bar[XB_TMO])) break; if (sp > XB_SPIN_CAP) { atomicAdd(&bar[XB_TMO], 1u); break; } }
  }
  nloc = mine > 0u ? mine : 1u; nx = cnt > 0u ? cnt : 1u;
}
DI void xcd_barrier(const XcdBarrier& b) {
  asm volatile("s_waitcnt vmcnt(0)" ::: "memory");
  __syncthreads();
  if (tidx() == 0) {
    unsigned* bar = b.bar;
    const unsigned bx = (unsigned)__builtin_amdgcn_readfirstlane((int)xb_xcc_id());
    __builtin_amdgcn_s_waitcnt(0);
    unsigned nloc = b.st[0], nx = b.st[1];
    if (nloc == 0u) { xcd_barrier_complete(bar, bx, nloc, nx); b.st[0] = nloc; b.st[1] = nx; }
    const unsigned old = xb_add(&bar[XB_XSUB(bx)], 1u);
    const unsigned gen = old / nloc;
    if (old + 1u == (gen + 1u) * nloc) {
      __builtin_amdgcn_fence(__ATOMIC_RELEASE, "agent");
      asm volatile("s_waitcnt vmcnt(0)" ::: "memory");
      const unsigned og = xb_add(&bar[XB_TOP], 1u);
      const unsigned tg = og / nx;
      if (og + 1u == (tg + 1u) * nx) xb_add(&bar[XB_TOPGEN], 1u);
      else XB_SPIN(xb_ld(&bar[XB_TOPGEN]) == tg, bar);
      __builtin_amdgcn_fence(__ATOMIC_ACQUIRE, "agent");
      xb_add(&bar[XB_XGEN(bx)], 1u);
      asm volatile("s_waitcnt vmcnt(0)" ::: "memory");
    } else {
      XB_SPIN(xb_ld(&bar[XB_XGEN(bx)]) == gen, bar);
      __builtin_amdgcn_fence(__ATOMIC_ACQUIRE, "agent");
      asm volatile("s_waitcnt vmcnt(0)" ::: "memory");
    }
  }
  __syncthreads();
}

#define TASK_LOOP(t, nt, base) for (int t = (int)((blockIdx.x + gridDim.x - ((unsigned)(base) % gridDim.x)) % gridDim.x); t < (nt); t += gridDim.x)

template <bool RFA, bool RFB, class LA, class LB, class EPI>
DI void gemm_tile(u16* smem, int nk, LA la, LB lb, EPI epi) {
  const int tid = tidx(), lane = tid & 63, wave = tid >> 6;
  const int wm = wave >> 2, wn = wave & 3, lr = lane & 31, lh = lane >> 5;
  u16* As = smem;
  u16* Bs = smem + 2 * TILE_ELEMS;
  f32x16 acc[2];
  acc[0] = zero16(); acc[1] = zero16();
  u32x4 ra[2], rb[2];
#define A_ROW(c) (RFA ? ((c) & 127) : ((c) >> 3))
#define A_KC(c) (RFA ? ((c) >> 7) : ((c) & 7))
#define B_ROW(c) (RFB ? ((c) & 127) : ((c) >> 3))
#define B_KC(c) (RFB ? ((c) >> 7) : ((c) & 7))
#pragma unroll
  for (int i = 0; i < 2; ++i) { const int c = tid + NTH * i; ra[i] = la(A_ROW(c), A_KC(c) * 8); rb[i] = lb(B_ROW(c), B_KC(c) * 8); }
#pragma unroll
  for (int i = 0; i < 2; ++i) {
    const int c = tid + NTH * i;
    *(u32x4*)(As + A_ROW(c) * LDT + A_KC(c) * 8) = ra[i];
    *(u32x4*)(Bs + B_ROW(c) * LDT + B_KC(c) * 8) = rb[i];
  }
  __syncthreads();
  for (int kt = 0; kt < nk; ++kt) {
    const int buf = kt & 1;
    if (kt + 1 < nk) {
      const int k0 = (kt + 1) * 64;
#pragma unroll
      for (int i = 0; i < 2; ++i) { const int c = tid + NTH * i; ra[i] = la(A_ROW(c), k0 + A_KC(c) * 8); rb[i] = lb(B_ROW(c), k0 + B_KC(c) * 8); }
    }
    const u16* Ab = As + buf * TILE_ELEMS + (wm * 64 + lr) * LDT + lh * 8;
    const u16* Bb = Bs + buf * TILE_ELEMS + (wn * 32 + lr) * LDT + lh * 8;
#pragma unroll
    for (int ks = 0; ks < 4; ++ks) {
      const bf16x8 a0 = *(const bf16x8*)(Ab + ks * 16);
      const bf16x8 a1 = *(const bf16x8*)(Ab + 32 * LDT + ks * 16);
      const bf16x8 b = *(const bf16x8*)(Bb + ks * 16);
      acc[0] = mfma(a0, b, acc[0]);
      acc[1] = mfma(a1, b, acc[1]);
    }
    if (kt + 1 < nk) {
      u16* Aw = As + (buf ^ 1) * TILE_ELEMS;
      u16* Bw = Bs + (buf ^ 1) * TILE_ELEMS;
#pragma unroll
      for (int i = 0; i < 2; ++i) {
        const int c = tid + NTH * i;
        *(u32x4*)(Aw + A_ROW(c) * LDT + A_KC(c) * 8) = ra[i];
        *(u32x4*)(Bw + B_ROW(c) * LDT + B_KC(c) * 8) = rb[i];
      }
    }
    __syncthreads();
  }
  epi(acc, wm, wn, lane);
}

DI void stage_rc(int b, int& R, int& C) { int st = b / 1024, sb = b % 1024, swz = sb ^ (((sb >> 9) & 1) << 5); R = (st >> 1) * 16 + swz / 64; C = (st & 1) * 32 + (swz % 64) / 2; }

template <class EPI>
DI void gemm256(LAS u16* shm, const u16* __restrict__ A, const u16* __restrict__ Bt, int K, int brow, int bcol, bool pre, bool has_next, int nbrow, int nbcol, EPI epi) {
#define SA(b, h) (shm + ((b) * 2 + (h)) * HT)
#define SB(b, h) (shm + (4 + (b) * 2 + (h)) * HT)
  const int tid = tidx();
  const int wid = __builtin_amdgcn_readfirstlane(tid >> 6), lane = tid & 63, wr = wid >> 2, wc = wid & 3, fr = lane & 15, fq = lane >> 4;
  int r0, c0, r1, c1;
  stage_rc(tid * 16, r0, c0);
  stage_rc(tid * 16 + 8192, r1, c1);
  const unsigned so0 = (unsigned)(r0 * K + c0) * 2u, so1 = (unsigned)(r1 * K + c1) * 2u;
  const unsigned ldsw = (unsigned)wid * 1024u;
  const int lb = ((fr * 64 + fq * 16) ^ ((fr >> 3) << 5));
#define STAGE(P, BASE, br, kt) do { const char* _g = (const char*)((BASE) + (size_t)(br) * K + (kt) * 64); \
    __builtin_amdgcn_global_load_lds((const unsigned*)(_g + so0), (LAS unsigned*)((LAS char*)(P) + ldsw), 16, 0, 0); \
    __builtin_amdgcn_global_load_lds((const unsigned*)(_g + so1), (LAS unsigned*)((LAS char*)(P) + ldsw + 8192), 16, 0, 0); } while (0)
#define LDA(dst, b, h) _Pragma("unroll") for (int m = 0; m < 4; ++m) _Pragma("unroll") for (int k = 0; k < 2; ++k) \
    dst[m][k] = *(const LAS bf16x8*)((const LAS char*)SA(b, h) + ((wr * 4 + m) * 2 + k) * 1024 + lb)
#define LDB(dst, b, h) _Pragma("unroll") for (int n = 0; n < 2; ++n) _Pragma("unroll") for (int k = 0; k < 2; ++k) \
    dst[n][k] = *(const LAS bf16x8*)((const LAS char*)SB(b, h) + ((wc * 2 + n) * 2 + k) * 1024 + lb)
#define MMA(ai, bj, At_, Bt_) do { __builtin_amdgcn_s_setprio(1); \
    _Pragma("unroll") for (int m = 0; m < 4; ++m) _Pragma("unroll") for (int n = 0; n < 2; ++n) _Pragma("unroll") for (int k = 0; k < 2; ++k) \
      acc[ai][bj][m][n] = __builtin_amdgcn_mfma_f32_16x16x32_bf16(At_[m][k], Bt_[n][k], acc[ai][bj][m][n], 0, 0, 0); \
    __builtin_amdgcn_s_setprio(0); } while (0)
#define WAIT_V(n) asm volatile("s_waitcnt vmcnt(" #n ")" ::: "memory")
#define WAIT_L(n) asm volatile("s_waitcnt lgkmcnt(" #n ")" ::: "memory")
#define BAR __builtin_amdgcn_s_barrier()
#define SCHED __builtin_amdgcn_sched_barrier(0)
  f32x4 acc[2][2][4][2];
#pragma unroll
  for (int a = 0; a < 2; ++a)
#pragma unroll
    for (int b = 0; b < 2; ++b)
#pragma unroll
      for (int m = 0; m < 4; ++m)
#pragma unroll
        for (int n = 0; n < 2; ++n) { acc[a][b][m][n][0] = 0.f; acc[a][b][m][n][1] = 0.f; acc[a][b][m][n][2] = 0.f; acc[a][b][m][n][3] = 0.f; }
  bf16x8 At[4][2], B0[2][2], B1[2][2];
  const int nt = K / 64;
  if (!pre) {
    STAGE(SB(0, 0), Bt, bcol, 0); STAGE(SA(0, 0), A, brow, 0);
    STAGE(SB(0, 1), Bt, bcol + 128, 0); STAGE(SA(0, 1), A, brow + 128, 0);
  }
  if (wr == 1) BAR;
  WAIT_V(4); BAR;
  STAGE(SB(1, 0), Bt, bcol, 1); STAGE(SA(1, 0), A, brow, 1); STAGE(SB(1, 1), Bt, bcol + 128, 1);
  WAIT_V(6); BAR;
  for (int t = 0; t < nt - 2; t += 2) {
    LDB(B0, 0, 0); SCHED; LDA(At, 0, 0); STAGE(SA(1, 1), A, brow + 128, t + 1);
    WAIT_L(8); BAR; WAIT_L(0); MMA(0, 0, At, B0); BAR; SCHED;
    LDB(B1, 0, 1); STAGE(SB(0, 0), Bt, bcol, t + 2);
    BAR; WAIT_L(0); MMA(0, 1, At, B1); BAR;
    LDA(At, 0, 1); STAGE(SA(0, 0), A, brow, t + 2);
    BAR; WAIT_L(0); MMA(1, 0, At, B0); BAR; SCHED;
    STAGE(SB(0, 1), Bt, bcol + 128, t + 2);
    WAIT_V(6); BAR; MMA(1, 1, At, B1); BAR;
    LDB(B0, 1, 0); SCHED; LDA(At, 1, 0); STAGE(SA(0, 1), A, brow + 128, t + 2);
    WAIT_L(8); BAR; WAIT_L(0); MMA(0, 0, At, B0); BAR; SCHED;
    LDB(B1, 1, 1); STAGE(SB(1, 0), Bt, bcol, t + 3);
    BAR; WAIT_L(0); MMA(0, 1, At, B1); BAR;
    LDA(At, 1, 1); STAGE(SA(1, 0), A, brow, t + 3);
    BAR; WAIT_L(0); MMA(1, 0, At, B0); BAR; SCHED;
    STAGE(SB(1, 1), Bt, bcol + 128, t + 3);
    WAIT_V(6); BAR; MMA(1, 1, At, B1); BAR;
  }
  { LDB(B0, 0, 0); LDA(At, 0, 0); STAGE(SA(1, 1), A, brow + 128, nt - 1);
    BAR; WAIT_L(0); MMA(0, 0, At, B0); BAR;
    LDB(B1, 0, 1); BAR; WAIT_L(0); MMA(0, 1, At, B1); BAR;
    LDA(At, 0, 1); WAIT_V(4); BAR; WAIT_L(0); MMA(1, 0, At, B0); MMA(1, 1, At, B1); BAR; }
  { LDB(B0, 1, 0); LDA(At, 1, 0); WAIT_V(2); BAR; WAIT_L(0); MMA(0, 0, At, B0); BAR;
    LDB(B1, 1, 1); WAIT_V(0); BAR; WAIT_L(0); MMA(0, 1, At, B1); BAR;
    LDA(At, 1, 1); BAR; WAIT_L(0); MMA(1, 0, At, B0); MMA(1, 1, At, B1); BAR; }
  if (wr == 0) BAR;
  if (has_next) {
    STAGE(SB(0, 0), Bt, nbcol, 0); STAGE(SA(0, 0), A, nbrow, 0);
    STAGE(SB(0, 1), Bt, nbcol + 128, 0); STAGE(SA(0, 1), A, nbrow + 128, 0);
  }
  epi(acc, wr, wc, fr, fq);
  __syncthreads();
}

DI void map256(int t, int nN, int& tn, int& tm) {
  const int p = (t >> 8) * 8 + (t & 7), i = (t >> 3) & 31, pr = nN >> 2;
  const int pm = p / pr;
  tn = ((p + pm) % pr) * 4 + (i & 3);
  tm = pm * 8 + (i >> 2);
}

DI int condrow(int sb, int tok) { return sb == 0 ? 0 : 1 + (sb - 1) * 8 + (tok >> 11); }

DI void convT_tile(float* tile, const float* src, int lds_, int N, u16* dst, int ldd, const float* ksc, int k0, int n0) {
  const int tid = tidx();
#pragma unroll 4
  for (int e = 0; e < 8; ++e) {
    const int idx = tid + NTH * e, kk = idx >> 6, nn = idx & 63;
    float v = (n0 + nn < N) ? src[(size_t)(k0 + kk) * lds_ + n0 + nn] : 0.f;
    if (ksc) v *= ksc[k0 + kk];
    tile[kk * 65 + nn] = v;
  }
  __syncthreads();
#pragma unroll 4
  for (int e = 0; e < 4; ++e) {
    const int idx = tid + NTH * e, nn = idx >> 5, kp = idx & 31;
    if (n0 + nn < N)
      *(unsigned*)(dst + (size_t)(n0 + nn) * ldd + k0 + 2 * kp) = pack2(tile[(2 * kp) * 65 + nn], tile[(2 * kp + 1) * 65 + nn]);
  }
  __syncthreads();
}

DI void convT(float* tile, const float* src, int lds_, int K, int N, u16* dst, int ldd, const float* ksc, int& base) {
  const int ntn = (N + 63) >> 6, nt = (K >> 6) * ntn;
  TASK_LOOP(t, nt, base) {
    const int tn = t % ntn, tk = t / ntn;
    convT_tile(tile, src, lds_, N, dst, ldd, ksc, tk * 64, tn * 64);
  }
  base += nt;
}

DI void prologue_a(const Prm& p, unsigned char* smem_raw, int& base) {
  float* smf = (float*)smem_raw;
  const int tid = tidx();
  const int gtid = blockIdx.x * NTH + tid, gn = gridDim.x * NTH;
  for (int l = 0; l < 4; ++l) {
    convT(smf, p.w_in + (size_t)l * 1024 * 7520 + 768, 7520, 1024, 6752, p.WinT + ((size_t)l * NWP + 1536) * 1024, 1024, nullptr, base);
    convT(smf, p.w1 + (size_t)l * 1024 * 4096, 4096, 1024, 4096, p.W1T + (size_t)l * 4096 * 1024, 1024, nullptr, base);
    convT(smf, p.w2 + (size_t)l * 4096 * 1024, 1024, 4096, 1024, p.W2T + (size_t)l * 1024 * 4096, 4096, nullptr, base);
    convT(smf, p.w_o + (size_t)l * 1024 * 1024, 1024, 1024, 1024, p.WoT + (size_t)l * 1024 * 1024, 1024, nullptr, base);
    convT(smf, p.p_a + (size_t)l * 768 * 1024, 1024, 768, 1024, p.PaT + (size_t)l * 1024 * 768, 768, nullptr, base);
    convT(smf, p.p_b + (size_t)l * 128 * 1024, 1024, 128, 1024, p.PbT + (size_t)l * 1024 * 128, 128, nullptr, base);
    convT(smf, p.p_c + (size_t)l * 384 * 1024, 1024, 384, 1024, p.PcT + (size_t)l * 1024 * 384, 384, nullptr, base);
    convT(smf, p.p_d + (size_t)l * 256 * 1024, 1024, 256, 1024, p.PdT + (size_t)l * 1024 * 256, 256, nullptr, base);
    convT(smf, p.w_uq + (size_t)l * 384 * 384, 384, 384, 384, p.WqT + (size_t)l * 384 * 384, 384, p.qn_g + l * 384, base);
    convT(smf, p.w_ukv + (size_t)l * 320 * 512, 512, 320, 512, p.WkvT + (size_t)l * 512 * 320, 320, p.kvn_g + l * 320, base);
  }
  {
    float* wl = smf;
    float* tab = smf + 32 * 196;
    TASK_LOOP(t, 512, base) {
      const int kb = t & 31, g = (t >> 5) & 3, l = t >> 7, k0 = kb * 32;
      for (int idx = tid; idx < 32 * 192; idx += NTH) {
        const int kk = idx / 192, c = idx - kk * 192;
        wl[kk * 196 + c] = p.w_in[((size_t)l * 1024 + k0 + kk) * 7520 + g * 192 + c];
      }
      if (tid < 192) {
        float s, c;
        sincospif(2.f * (float)tid / 192.f, &s, &c);
        tab[tid] = c; tab[192 + tid] = s;
      }
      __syncthreads();
      for (int e = 0; e < 6; ++e) {
        const int idx = tid + NTH * e, kq = idx & 7, pj = idx >> 3;
        const int part = pj >= 192 ? 1 : 0, j = pj - part * 192;
        const float* tp = tab + part * 192;
        const float* w0 = wl + (kq * 4) * 196;
        float s0 = 0, s1 = 0, s2 = 0, s3 = 0;
        int m = 0;
        for (int c = 0; c < 192; c += 4) {
          const float4 a0 = *(const float4*)(w0 + c), a1 = *(const float4*)(w0 + 196 + c), a2 = *(const float4*)(w0 + 392 + c), a3 = *(const float4*)(w0 + 588 + c);
          const float t0 = tp[m]; m += j; if (m >= 192) m -= 192;
          const float t1 = tp[m]; m += j; if (m >= 192) m -= 192;
          const float t2 = tp[m]; m += j; if (m >= 192) m -= 192;
          const float t3 = tp[m]; m += j; if (m >= 192) m -= 192;
          s0 += a0.x * t0 + a0.y * t1 + a0.z * t2 + a0.w * t3;
          s1 += a1.x * t0 + a1.y * t1 + a1.z * t2 + a1.w * t3;
          s2 += a2.x * t0 + a2.y * t1 + a2.z * t2 + a2.w * t3;
          s3 += a3.x * t0 + a3.y * t1 + a3.z * t2 + a3.w * t3;
        }
        if (part) { s0 = -s0; s1 = -s1; s2 = -s2; s3 = -s3; }
        st4bf(p.WinT + ((size_t)l * NWP + part * 768 + g * 192 + j) * 1024 + k0 + kq * 4, s0, s1, s2, s3);
      }
      __syncthreads();
    }
    base += 512;
  }
  {
    float* sil = smf;
    TASK_LOOP(t, 384, base) {
      const int kc = t & 7, cb = (t >> 3) % 12, l = t / 96, k0 = kc * 128;
      for (int idx = tid; idx < 17 * 128; idx += NTH) {
        const int r = idx >> 7, kk = idx & 127;
        const float c = r == 0 ? p.c_prompt[k0 + kk] : p.c_sample[(r - 1) * 1024 + k0 + kk];
        sil[idx] = c / (1.f + __expf(-c));
      }
      __syncthreads();
      const int n = cb * 512 + tid;
      float acc[17];
#pragma unroll
      for (int r = 0; r < 17; ++r) acc[r] = 0.f;
      const float* wp = p.ada_w + ((size_t)l * 1024 + k0) * 6144 + n;
#pragma unroll 2
      for (int kk = 0; kk < 128; kk += 4) {
        const float w0 = wp[(size_t)kk * 6144], w1 = wp[(size_t)(kk + 1) * 6144], w2 = wp[(size_t)(kk + 2) * 6144], w3 = wp[(size_t)(kk + 3) * 6144];
#pragma unroll
        for (int r = 0; r < 17; ++r) {
          const float4 sv = *(const float4*)(sil + r * 128 + kk);
          acc[r] += sv.x * w0 + sv.y * w1 + sv.z * w2 + sv.w * w3;
        }
      }
#pragma unroll
      for (int r = 0; r < 17; ++r) p.modpart[((size_t)(kc * 4 + l) * 17 + r) * 6144 + n] = acc[r];
      __syncthreads();
    }
    base += 384;
  }
  for (int idx = gtid; idx < 4 * 32 * 1024; idx += gn) {
    const int l = idx >> 15, rem = idx & 32767;
    p.WinT[((size_t)l * NWP + NW) * 1024 + rem] = 0;
  }
  for (int idx = gtid; idx < 256 * 256; idx += gn) {
    const int row = idx >> 8, kk = idx & 255;
    const int po = row >> 7, k1 = row & 127, pi = kk >> 7, s1 = kk & 127;
    float s, c;
    sincospif(2.f * (float)((k1 * s1) & 127) / 128.f, &s, &c);
    const float v = (po == pi) ? c : (po == 0 ? s : -s);
    p.M1a[idx] = f2bf(v);
  }
  for (int idx = gtid; idx < 32 * 64; idx += gn) {
    const int row = idx >> 6, kk = idx & 63;
    const int po = row >> 4, k1 = row & 15, pi = (kk >> 4) & 1, s1 = kk & 15;
    float s, c;
    sincospif(2.f * (float)((k1 * s1) & 15) / 16.f, &s, &c);
    float v = (po == pi) ? c : (po == 0 ? s : -s);
    if (kk >= 32) v = 0.f;
    p.M1b[idx] = f2bf(v);
  }
  for (int idx = gtid; idx < 128 * 256; idx += gn) {
    const int k2 = idx >> 8, kk = idx & 255, part = kk >> 7, s2 = kk & 127;
    float s, c;
    sincospif(2.f * (float)((k2 * s2) & 127) / 128.f, &s, &c);
    p.M2[idx] = f2bf(part ? s : c);
  }
  for (int idx = gtid; idx < 16384; idx += gn) {
    float s, c;
    sincospif(2.f * (float)idx / 16384.f, &s, &c);
    p.tw[idx] = make_float2(c, s);
  }
  for (int idx = gtid; idx < 16384 * 16; idx += gn) {
    const int pos = idx >> 4, i = idx & 15;
    const float inv = (float)pow(10000.0, -(double)i / 16.0);
    const float ang = (float)pos * inv;
    double rev = (double)ang * 0.15915494309189535;
    rev -= rint(rev);
    float s, c;
    sincospif((float)(2.0 * rev), &s, &c);
    p.rope[idx] = make_float2(c, s);
  }
  for (int idx = gtid; idx < 6 * 129; idx += gn) {
    const int hd = idx / 129, rel = idx - hd * 129 - 64;
    const int dil = 1 << (2 * (hd >> 1));
    const int rd = rel * dil, n = rd < 0 ? -rd : rd;
    int b;
    if (n < 8) b = n;
    else if (n < 15) b = 8; else if (n < 27) b = 9; else if (n < 50) b = 10; else if (n < 91) b = 11;
    else if (n < 166) b = 12; else if (n < 305) b = 13; else if (n < 559) b = 14; else b = 15;
    if (rd > 0) b += 16;
    p.biasT[idx] = p.rel_bias[b * 6 + hd];
  }
  for (int idx = gtid; idx < 4 * 4 * 128 * 128; idx += gn) p.SgW[idx] = f2bf(p.sgu_w[idx]);
}

DI void prologue_b(const Prm& p) {
  const int gtid = blockIdx.x * NTH + tidx(), gn = gridDim.x * NTH;
  for (int idx = gtid; idx < 4 * 17 * 6144; idx += gn) {
    const int l = idx / (17 * 6144), n = idx % 6144;
    float s = p.ada_b[l * 6144 + n];
#pragma unroll
    for (int kc = 0; kc < 8; ++kc) s += p.modpart[(size_t)kc * 4 * 17 * 6144 + idx];
    p.mod[idx] = s;
  }
}

DI void phase_norm(const Prm& p, const float* xsrc, const float* g, const float* modl, int shoff, int scoff, int sb) {
  const int tid = tidx(), lane = tid & 63;
  const int gw = blockIdx.x * 8 + (tid >> 6), nw = gridDim.x * 8;
  for (int row = gw; row < TB; row += nw) {
    const int cond = condrow(sb, row);
    const float* xr = xsrc + (size_t)row * 1024;
    float4 v[4];
    float ss = 0.f;
#pragma unroll
    for (int i = 0; i < 4; ++i) {
      v[i] = *(const float4*)(xr + i * 256 + lane * 4);
      ss += v[i].x * v[i].x + v[i].y * v[i].y + v[i].z * v[i].z + v[i].w * v[i].w;
    }
#pragma unroll
    for (int off = 32; off >= 1; off >>= 1) ss += __shfl_xor(ss, off);
    const float rstd = rsqrtf(ss * (1.f / 1024.f) + 1e-6f);
    const float* sc = modl + cond * 6144 + scoff;
    const float* sh = modl + cond * 6144 + shoff;
#pragma unroll
    for (int i = 0; i < 4; ++i) {
      const int col = i * 256 + lane * 4;
      const float4 gg = *(const float4*)(g + col), s4 = *(const float4*)(sc + col), h4 = *(const float4*)(sh + col);
      st4bf(p.hbuf + (size_t)row * 1024 + col,
            v[i].x * rstd * gg.x * (1.f + s4.x) + h4.x, v[i].y * rstd * gg.y * (1.f + s4.y) + h4.y,
            v[i].z * rstd * gg.z * (1.f + s4.z) + h4.z, v[i].w * rstd * gg.w * (1.f + s4.w) + h4.w);
    }
  }
}

DI float sigm(float x) { return __builtin_amdgcn_rcpf(1.f + __expf(-x)); }

DI void phase_inproj(const Prm& p, unsigned char* smem_raw, int l, int S, int& base) {
  const u16* W = p.WinT + (size_t)l * NWP * 1024;
  LAS u16* shm = (LAS u16*)smem_raw;
  bool pre = false;
  TASK_LOOP(t, 32 * 64, base) {
    int tn, tm;
    map256(t, 32, tn, tm);
    const int brow = tn * 256, bcol = tm * 256;
    const int tnx = t + (int)gridDim.x;
    const bool has_next = tnx < (32 * 64);
    int tn2 = 0, tm2 = 0;
    if (has_next) map256(tnx, 32, tn2, tm2);
    const int nbrow = tn2 * 256, nbcol = tm2 * 256;
    auto epi = [&](f32x4 (&acc)[2][2][4][2], int wr, int wc, int fr, int fq) __attribute__((always_inline)) {
#pragma unroll
      for (int ai = 0; ai < 2; ++ai)
#pragma unroll
        for (int m = 0; m < 4; ++m) {
          const int nb = brow + ai * 128 + wr * 64 + m * 16;
#pragma unroll
          for (int bj = 0; bj < 2; ++bj)
#pragma unroll
            for (int n = 0; n < 2; ++n) {
              const int tok = bcol + bj * 128 + wc * 32 + n * 16 + fr;
              const f32x4 v = acc[ai][bj][m][n];
              const int nn = nb + fq * 4;
              if (nb < 1536) {
#pragma unroll
                for (int j = 0; j < 4; ++j) p.UT[(size_t)(nn + j) * TBP + tok] = f2bf(v[j]);
              } else if (nb < 2688) {
                st4bf(p.bqkv + (size_t)tok * 1152 + (nn - 1536), v[0], v[1], v[2], v[3]);
              } else if (nb < 3072) {
                st4bf(p.cu + (size_t)tok * 384 + (nn - 2688), v[0], v[1], v[2], v[3]);
              } else if (nb < 3456) {
#pragma unroll
                for (int j = 0; j < 4; ++j) p.cvT[(size_t)(nn - 3072 + j) * TBP + tok] = f2bf(v[j]);
              } else if (nb < 3840) {
                st4bf(p.dcq + (size_t)tok * 384 + (nn - 3456), v[0], v[1], v[2], v[3]);
              } else if (nb < 4160) {
                st4bf(p.dckv + (size_t)tok * 320 + (nn - 3840), v[0], v[1], v[2], v[3]);
              } else if (nb < 4192) {
                if (nb == 4160) {
                  const f32x4 v2 = acc[ai][bj][(m + 1) & 3][n];
                  const int pos = tok & (S - 1);
#pragma unroll
                  for (int j = 0; j < 4; ++j) {
                    const int ii = fq * 4 + j;
                    const float2 cs = p.rope[pos * 16 + ii];
                    const u16 o1 = f2bf(v[j] * cs.x - v2[j] * cs.y), o2 = f2bf(v[j] * cs.y + v2[j] * cs.x);
#pragma unroll
                    for (int hh = 0; hh < 4; ++hh) {
                      p.kc[(size_t)tok * 384 + hh * 96 + 64 + ii] = o1;
                      p.kc[(size_t)tok * 384 + hh * 96 + 80 + ii] = o2;
                    }
                  }
                }
              } else {
                st4bf_nt(p.zg + (size_t)tok * 4096 + (nn - 4192), sigm(v[0]), sigm(v[1]), sigm(v[2]), sigm(v[3]));
              }
            }
          __builtin_amdgcn_sched_barrier(0);
        }
    };
    gemm256(shm, W, p.hbuf, 1024, brow, bcol, pre, has_next, nbrow, nbcol, epi);
    pre = has_next;
  }
  base += 32 * 64;
}

DI void phase_inproj_tail(const Prm& p, unsigned char* smem_raw, int l, int& base) {
  const u16* W = p.WinT + (size_t)l * NWP * 1024;
  u16* smem = (u16*)smem_raw;
  TASK_LOOP(t, 128, base) {
    const int n0 = 8192, m0 = t * 128;
    auto la = [&](int row, int k) __attribute__((always_inline)) { return *(const u32x4*)(W + (size_t)(n0 + row) * 1024 + k); };
    auto lb = [&](int row, int k) __attribute__((always_inline)) { return *(const u32x4*)(p.hbuf + (size_t)(m0 + row) * 1024 + k); };
    auto epi = [&](f32x16 (&acc)[2], int wm, int wn, int lane) __attribute__((always_inline)) {
      const int lr = lane & 31, lh = lane >> 5;
      const int tok = m0 + wn * 32 + lr;
#pragma unroll
      for (int i = 0; i < 2; ++i) {
        const int nb = n0 + wm * 64 + i * 32;
        if (nb >= NW) continue;
#pragma unroll
        for (int q = 0; q < 4; ++q)
          st4bf(p.zg + (size_t)tok * 4096 + (nb - 4192) + 8 * q + 4 * lh, sigm(acc[i][4 * q]), sigm(acc[i][4 * q + 1]), sigm(acc[i][4 * q + 2]),
                sigm(acc[i][4 * q + 3]));
      }
    };
    gemm_tile<false, false>(smem, 16, la, lb, epi);
  }
  base += 128;
}


DI void phase_inproj_probe(const Prm& p, unsigned char* smem_raw, int l, int& base) {
  const u16* W = p.WinT + (size_t)l * NWP * 1024;
  LAS u16* shm = (LAS u16*)smem_raw;
  bool pre = false;
  TASK_LOOP(t, 32 * 64, base) {
    int tn, tm;
    map256(t, 32, tn, tm);
    const int brow = tn * 256, bcol = tm * 256;
    const int tnx = t + (int)gridDim.x;
    const bool has_next = tnx < (32 * 64);
    int tn2 = 0, tm2 = 0;
    if (has_next) map256(tnx, 32, tn2, tm2);
    const int nbrow = tn2 * 256, nbcol = tm2 * 256;
    auto epi = [&](f32x4 (&acc)[2][2][4][2], int wr, int wc, int fr, int fq) __attribute__((always_inline)) {
#pragma unroll
      for (int bj = 0; bj < 2; ++bj)
#pragma unroll
        for (int n = 0; n < 2; ++n) {
          const int tok = bcol + bj * 128 + wc * 32 + n * 16 + fr;
#pragma unroll
          for (int ai = 0; ai < 2; ++ai)
#pragma unroll
            for (int m = 0; m < 4; ++m) {
              const int nn = ((brow + ai * 128 + wr * 64 + m * 16) & 1023) + fq * 4;
              const f32x4 v = acc[ai][bj][m][n];
              st4bf(p.Gp + (size_t)tok * 1024 + nn, v[0], v[1], v[2], v[3]);
            }
        }
    };
    gemm256(shm, W, p.hbuf, 1024, brow, bcol, pre, has_next, nbrow, nbcol, epi);
    pre = has_next;
  }
  base += 32 * 64;
}

DI void phase_fft1(const Prm& p, u16* smem, int S, int nseq, int N1, int lgN1, int& base) {
  const int nkt = N1 == 128 ? 2 : 1;
  const u16* M1 = N1 == 128 ? p.M1a : p.M1b;
  const int ldm = N1 == 128 ? 256 : 64;
  const int nk = N1 == 128 ? 4 : 1;
  const int ntask = nseq * 768 * nkt;
  const int twmul = 16384 / S;
  TASK_LOOP(t, ntask, base) {
    const int k1t = t % nkt, col = (t / nkt) % 768, seq = t / (nkt * 768);
    const int k1base = k1t * 64;
    auto la = [&](int row, int k) __attribute__((always_inline)) {
      const int k1 = k1base + (row >> 6) * 32 + (row & 31), ii = (row >> 5) & 1;
      if (k1 >= N1 || k >= 2 * N1) return zero4();
      return *(const u32x4*)(M1 + (ii * N1 + k1) * ldm + k);
    };
    auto lb = [&](int row, int k) __attribute__((always_inline)) {
      if (k >= 2 * N1) return zero4();
      const int part = k >> lgN1, s1 = k & (N1 - 1);
      const u16* src = p.UT + (size_t)(part * 768 + col) * TBP + seq * S + s1 * 128 + row;
      u32x4 v;
#pragma unroll
      for (int jj = 0; jj < 4; ++jj) v[jj] = (unsigned)src[(2 * jj) * 128] | ((unsigned)src[(2 * jj + 1) * 128] << 16);
      return v;
    };
    auto epi = [&](f32x16 (&acc)[2], int wm, int wn, int lane) __attribute__((always_inline)) {
      const int lr = lane & 31, lh = lane >> 5;
      const int s2 = wn * 32 + lr;
#pragma unroll
      for (int r = 0; r < 16; ++r) {
        const int k1 = k1base + wm * 32 + rowmap(r, lh);
        if (k1 < N1) {
          const float re = acc[0][r], im = acc[1][r];
          const float2 cs = p.tw[(s2 * k1) * twmul];
          const size_t o = ((size_t)((seq * N1 + k1) * 2) * 768 + col) * 128 + s2;
          p.Gp[o] = f2bf(cs.x * re + cs.y * im);
          p.Gp[o + 768 * 128] = f2bf(cs.x * im - cs.y * re);
        }
      }
    };
    gemm_tile<false, true>(smem, nk, la, lb, epi);
  }
  base += ntask;
}


DI void phase_fft1_small(const Prm& p, int nseq) {
  constexpr float C16[16] = {1.f, 0.92387953251128674f, 0.70710678118654752f, 0.38268343236508977f, 0.f, -0.38268343236508977f, -0.70710678118654752f,
                             -0.92387953251128674f, -1.f, -0.92387953251128674f, -0.70710678118654752f, -0.38268343236508977f, 0.f,
                             0.38268343236508977f, 0.70710678118654752f, 0.92387953251128674f};
  constexpr float S16[16] = {0.f, 0.38268343236508977f, 0.70710678118654752f, 0.92387953251128674f, 1.f, 0.92387953251128674f, 0.70710678118654752f,
                             0.38268343236508977f, 0.f, -0.38268343236508977f, -0.70710678118654752f, -0.92387953251128674f, -1.f,
                             -0.92387953251128674f, -0.70710678118654752f, -0.38268343236508977f};
  const int gtid = blockIdx.x * NTH + tidx(), gn = gridDim.x * NTH;
  for (int idx = gtid; idx < nseq * 768 * 128; idx += gn) {
    const int s2 = idx & 127, col = (idx >> 7) % 768, seq = idx / (768 * 128);
    const u16* ur = p.UT + (size_t)col * TBP + seq * 2048 + s2;
    const u16* ui = ur + (size_t)768 * TBP;
    float xr[16], xi[16];
#pragma unroll
    for (int s1 = 0; s1 < 16; ++s1) { xr[s1] = bf2f(ur[s1 * 128]); xi[s1] = bf2f(ui[s1 * 128]); }
    u16* go = p.Gp + ((size_t)(seq * 16 * 2) * 768 + col) * 128 + s2;
#pragma unroll
    for (int k1 = 0; k1 < 16; ++k1) {
      float gr = 0.f, gi = 0.f;
#pragma unroll
      for (int s1 = 0; s1 < 16; ++s1) {
        const float c = C16[(k1 * s1) & 15], sn = S16[(k1 * s1) & 15];
        gr += c * xr[s1] + sn * xi[s1];
        gi += c * xi[s1] - sn * xr[s1];
      }
      const float2 cs = p.tw[(s2 * k1) * 8];
      go[(size_t)(k1 * 2) * 768 * 128] = f2bf(cs.x * gr + cs.y * gi);
      go[(size_t)(k1 * 2 + 1) * 768 * 128] = f2bf(cs.x * gi - cs.y * gr);
    }
  }
}

DI void phase_fft2(const Prm& p, u16* smem, int S, int nseq, int N1, int& base) {
  const int ntask = nseq * N1 * 6;
  const float scale = rsqrtf((float)S * 192.f);
  u16* fa = p.UT;
  TASK_LOOP(t, ntask, base) {
    const int ct = t % 6, k1 = (t / 6) % N1, seq = t / (6 * N1);
    const u16* gb = p.Gp + ((size_t)((seq * N1 + k1) * 2) * 768 + ct * 128) * 128;
    auto la = [&](int row, int k) __attribute__((always_inline)) { return *(const u32x4*)(p.M2 + row * 256 + k); };
    auto lb = [&](int row, int k) __attribute__((always_inline)) {
      const int part = k >> 7, s2 = k & 127;
      return *(const u32x4*)(gb + ((size_t)part * 768 + row) * 128 + s2);
    };
    auto epi = [&](f32x16 (&acc)[2], int wm, int wn, int lane) __attribute__((always_inline)) {
      const int lr = lane & 31, lh = lane >> 5;
      const int col = ct * 128 + wn * 32 + lr;
#pragma unroll
      for (int i = 0; i < 2; ++i)
#pragma unroll
        for (int r = 0; r < 16; ++r) {
          const int k2 = wm * 64 + i * 32 + rowmap(r, lh);
          const int tok = seq * S + k1 + N1 * k2;
          fa[(size_t)tok * 768 + col] = f2bf(acc[i][r] * scale);
        }
    };
    gemm_tile<false, false>(smem, 4, la, lb, epi);
  }
  base += ntask;
}

DI void phase_mixc(const Prm& p, unsigned char* smem_raw, int l, int& base) {
  u16* smem = (u16*)smem_raw;
  float* st = (float*)(smem_raw + GEMM_SMEM);
  float* red = (float*)smem_raw;
  const int tid = tidx();
  TASK_LOOP(t, 512, base) {
    const int h = t & 3, ch = t >> 2, tok0 = ch * 128;
    {
      const int q = tid & 127, qf = tid >> 7;
      float s = 0.f, ss = 0.f;
      const u16* src = p.cvT + (size_t)(qf * 96) * TBP + tok0 + q;
      for (int c = 0; c < 96; ++c) { const float v = bf2f(src[(size_t)c * TBP]); s += v; ss += v * v; }
      red[qf * 256 + q * 2] = s; red[qf * 256 + q * 2 + 1] = ss;
      __syncthreads();
      if (tid < 128) {
        const float s1 = red[q * 2] + red[256 + q * 2] + red[512 + q * 2] + red[768 + q * 2];
        const float s2 = red[q * 2 + 1] + red[256 + q * 2 + 1] + red[512 + q * 2 + 1] + red[768 + q * 2 + 1];
        const float mu = s1 * (1.f / 384.f);
        const float var = fmaxf(s2 * (1.f / 384.f) - mu * mu, 0.f);
        st[q] = mu; st[128 + q] = rsqrtf(var + 1e-6f);
      }
      __syncthreads();
    }
    const u16* Wm = p.SgW + (size_t)((l * 4 + h) * 128) * 128;
    auto la = [&](int row, int k) __attribute__((always_inline)) { return *(const u32x4*)(Wm + row * 128 + k); };
    auto lb = [&](int row, int k) __attribute__((always_inline)) {
      if (row >= 96) return zero4();
      const int c = h * 96 + row;
      const u32x4 raw = *(const u32x4*)(p.cvT + (size_t)c * TBP + tok0 + k);
      const float g = p.ln_g[l * 384 + c], b = p.ln_b[l * 384 + c];
      u32x4 o;
#pragma unroll
      for (int jj = 0; jj < 4; ++jj) {
        const float v0 = (bflo(raw[jj]) - st[k + 2 * jj]) * st[128 + k + 2 * jj] * g + b;
        const float v1 = (bfhi(raw[jj]) - st[k + 2 * jj + 1]) * st[128 + k + 2 * jj + 1] * g + b;
        o[jj] = pack2(v0, v1);
      }
      return o;
    };
    auto epi = [&](f32x16 (&acc)[2], int wm, int wn, int lane) __attribute__((always_inline)) {
      const int lr = lane & 31, lh = lane >> 5;
      const int cl = wn * 32 + lr;
      if (cl < 96) {
#pragma unroll
        for (int i = 0; i < 2; ++i)
#pragma unroll
          for (int r = 0; r < 16; ++r) {
            const int pp = wm * 64 + i * 32 + rowmap(r, lh);
            const float val = acc[i][r] + p.sgu_b[(l * 4 + h) * 128 + pp];
            u16* dst = p.cu + (size_t)(tok0 + pp) * 384 + h * 96 + cl;
            *dst = f2bf(bf2f(*dst) * val);
          }
      }
    };
    gemm_tile<false, false>(smem, 2, la, lb, epi);
  }
  base += 512;
}

DI void phase_qup(const Prm& p, unsigned char* smem_raw, int l, int S, int& base) {
  u16* smem = (u16*)smem_raw;
  float* st = (float*)(smem_raw + GEMM_SMEM);
  const int tid = tidx();
  const float QS = 0.10206207261596577f * LOG2E;
  TASK_LOOP(t, 3 * 128, base) {
    const int tn = t % 3, tm = t / 3, n0 = tn * 128, m0 = tm * 128;
    {
      const int row = tid >> 2, qf = tid & 3;
      const u16* src = p.dcq + (size_t)(m0 + row) * 384 + qf * 96;
      float ss = 0.f;
#pragma unroll 4
      for (int c = 0; c < 12; ++c) {
        const u32x4 v = *(const u32x4*)(src + c * 8);
#pragma unroll
        for (int jj = 0; jj < 4; ++jj) { const float a = bflo(v[jj]), b = bfhi(v[jj]); ss += a * a + b * b; }
      }
      ss += __shfl_xor(ss, 1);
      ss += __shfl_xor(ss, 2);
      if (qf == 0) st[row] = rsqrtf(ss * (1.f / 384.f) + 1e-6f);
      __syncthreads();
    }
    const u16* W = p.WqT + (size_t)l * 384 * 384;
    auto la = [&](int row, int k) __attribute__((always_inline)) { return *(const u32x4*)(W + (size_t)(n0 + row) * 384 + k); };
    auto lb = [&](int row, int k) __attribute__((always_inline)) { return *(const u32x4*)(p.dcq + (size_t)(m0 + row) * 384 + k); };
    auto epi = [&](f32x16 (&acc)[2], int wm, int wn, int lane) __attribute__((always_inline)) {
      const int lr = lane & 31, lh = lane >> 5;
      const int tokl = wn * 32 + lr, tok = m0 + tokl;
      const float sc = st[tokl] * QS;
#pragma unroll
      for (int i = 0; i < 2; ++i) {
        const int nb = n0 + wm * 64 + i * 32;
        const int head = nb / 96, within = nb - head * 96;
        const f32x16& a = acc[i];
        if (within < 64) {
#pragma unroll
          for (int q = 0; q < 4; ++q)
            st4bf(p.qc + (size_t)tok * 384 + nb + 8 * q + 4 * lh, a[4 * q] * sc, a[4 * q + 1] * sc, a[4 * q + 2] * sc, a[4 * q + 3] * sc);
        } else {
          const int pos = tok & (S - 1);
#pragma unroll
          for (int q = 0; q < 2; ++q)
#pragma unroll
            for (int e = 0; e < 4; ++e) {
              const int r = 4 * q + e, ii = 8 * q + 4 * lh + e;
              const float2 cs = p.rope[pos * 16 + ii];
              const float x1 = a[r] * sc, x2 = a[r + 8] * sc;
              p.qc[(size_t)tok * 384 + head * 96 + 64 + ii] = f2bf(x1 * cs.x - x2 * cs.y);
              p.qc[(size_t)tok * 384 + head * 96 + 80 + ii] = f2bf(x1 * cs.y + x2 * cs.x);
            }
        }
      }
    };
    gemm_tile<false, false>(smem, 6, la, lb, epi);
    __syncthreads();
  }
  base += 3 * 128;
}

DI void phase_kvup(const Prm& p, unsigned char* smem_raw, int l, int& base) {
  u16* smem = (u16*)smem_raw;
  float* st = (float*)(smem_raw + GEMM_SMEM);
  const int tid = tidx();
  TASK_LOOP(t, 4 * 128, base) {
    const int tn = t & 3, tm = t >> 2, n0 = tn * 128, m0 = tm * 128;
    {
      const int row = tid >> 2, qf = tid & 3;
      const u16* src = p.dckv + (size_t)(m0 + row) * 320 + qf * 80;
      float ss = 0.f;
#pragma unroll 5
      for (int c = 0; c < 10; ++c) {
        const u32x4 v = *(const u32x4*)(src + c * 8);
#pragma unroll
        for (int jj = 0; jj < 4; ++jj) { const float a = bflo(v[jj]), b = bfhi(v[jj]); ss += a * a + b * b; }
      }
      ss += __shfl_xor(ss, 1);
      ss += __shfl_xor(ss, 2);
      if (qf == 0) st[row] = rsqrtf(ss * (1.f / 320.f) + 1e-6f);
      __syncthreads();
    }
    const u16* W = p.WkvT + (size_t)l * 512 * 320;
    auto la = [&](int row, int k) __attribute__((always_inline)) { return *(const u32x4*)(W + (size_t)(n0 + row) * 320 + k); };
    auto lb = [&](int row, int k) __attribute__((always_inline)) { return *(const u32x4*)(p.dckv + (size_t)(m0 + row) * 320 + k); };
    auto epi = [&](f32x16 (&acc)[2], int wm, int wn, int lane) __attribute__((always_inline)) {
      const int lr = lane & 31, lh = lane >> 5;
      const int head = tn;
      const int tokl = wn * 32 + lr, tok = m0 + tokl;
      const float sc = st[tokl];
#pragma unroll
      for (int i = 0; i < 2; ++i) {
        const int within = wm * 64 + i * 32;
        const f32x16& a = acc[i];
        if (within < 64) {
#pragma unroll
          for (int q = 0; q < 4; ++q)
            st4bf(p.kc + (size_t)tok * 384 + head * 96 + within + 8 * q + 4 * lh, a[4 * q] * sc, a[4 * q + 1] * sc, a[4 * q + 2] * sc, a[4 * q + 3] * sc);
        } else {
#pragma unroll
          for (int r = 0; r < 16; ++r)
            p.vT[(size_t)(head * 64 + within - 64 + rowmap(r, lh)) * TBP + tok] = f2bf(a[r] * sc);
        }
      }
    };
    gemm_tile<false, false>(smem, 5, la, lb, epi);
    __syncthreads();
  }
  base += 4 * 128;
}

DI void phase_mixb(const Prm& p, unsigned char* smem_raw, int S, int lgS, int& base) {
  float* bt = (float*)smem_raw;
  const int tid = tidx(), lane = tid & 63, wave = tid >> 6, lr = lane & 31, lh = lane >> 5;
  u16* vt = (u16*)(smem_raw + 3328) + wave * (64 * 40);
  for (int idx = tid; idx < 774; idx += NTH) bt[idx] = p.biasT[idx];
  __syncthreads();
  TASK_LOOP(t, 384, base) {
    const int wt = t * 8 + wave;
    const int hg = wt & 1, g = (wt >> 1) % 3, blk = wt / 6;
    const int seq = blk >> (lgS - 5), b_in = blk & ((S >> 5) - 1);
    const int lgd = 2 * g, L = S >> lgd;
    const int lgbpr = lgS - lgd - 5;
    const int res = b_in >> lgbpr, i0 = (b_in & ((1 << lgbpr) - 1)) << 5;
    const int tokbase = seq * S + res;
    const int hd = g * 2 + hg, hc = hd * 64;
    const int qi = i0 + lr;
    const int qtok = tokbase + (qi << lgd);
    bf16x8 qf[4];
#pragma unroll
    for (int ks = 0; ks < 4; ++ks) qf[ks] = *(const bf16x8*)(p.bqkv + (size_t)qtok * 1152 + hc + ks * 16 + lh * 8);
    f32x16 sc[5];
#pragma unroll
    for (int tt = 0; tt < 5; ++tt) {
      int ik = i0 - 64 + 32 * tt + lr;
      ik = min(max(ik, 0), L - 1);
      const u16* kp = p.bqkv + (size_t)(tokbase + (ik << lgd)) * 1152 + 384 + hc + lh * 8;
      sc[tt] = zero16();
#pragma unroll
      for (int ks = 0; ks < 4; ++ks) sc[tt] = mfma(*(const bf16x8*)(kp + ks * 16), qf[ks], sc[tt]);
    }
    float mx = -1e30f;
#pragma unroll
    for (int tt = 0; tt < 5; ++tt)
#pragma unroll
      for (int r = 0; r < 16; ++r) {
        const int ik = i0 - 64 + 32 * tt + rowmap(r, lh);
        const int rel = ik - qi;
        const bool valid = (rel >= -64) && (rel <= 64) && (ik >= 0) && (ik < L);
        const int bi = min(max(rel + 64, 0), 128);
        const float s = valid ? (sc[tt][r] * 0.125f + bt[hd * 129 + bi]) * LOG2E : -1e30f;
        sc[tt][r] = s;
        mx = fmaxf(mx, s);
      }
    mx = fmaxf(mx, __shfl_xor(mx, 32));
    float sum = 0.f;
#pragma unroll
    for (int tt = 0; tt < 5; ++tt)
#pragma unroll
      for (int r = 0; r < 16; ++r) {
        const float pv = ex2(sc[tt][r] - mx);
        sum += pv;
        sc[tt][r] = pv;
      }
    sum += __shfl_xor(sum, 32);
    f32x16 oacc[2];
    oacc[0] = zero16(); oacc[1] = zero16();
#pragma unroll
    for (int tt = 0; tt < 5; ++tt) {
#pragma unroll
      for (int e = 0; e < 4; ++e) {
        const int c = lane + 64 * e, key = c >> 3, dch = c & 7;
        int ik = i0 - 64 + 32 * tt + key;
        ik = min(max(ik, 0), L - 1);
        const u32x4 raw = *(const u32x4*)(p.bqkv + (size_t)(tokbase + (ik << lgd)) * 1152 + 768 + hc + dch * 8);
#pragma unroll
        for (int jj = 0; jj < 4; ++jj) {
          vt[(dch * 8 + 2 * jj) * 40 + key] = (u16)(raw[jj] & 0xffffu);
          vt[(dch * 8 + 2 * jj + 1) * 40 + key] = (u16)(raw[jj] >> 16);
        }
      }
      __syncthreads();
#pragma unroll
      for (int u = 0; u < 2; ++u) {
        u32x4 pk;
#pragma unroll
        for (int jj = 0; jj < 4; ++jj) pk[jj] = pack2(sc[tt][8 * u + 2 * jj], sc[tt][8 * u + 2 * jj + 1]);
        const bf16x8 pf = __builtin_bit_cast(bf16x8, pk);
#pragma unroll
        for (int dt = 0; dt < 2; ++dt) {
          const u16* vp = vt + (dt * 32 + lr) * 40 + 16 * u + 4 * lh;
          u32x4 vv;
          const u32x2 lo = *(const u32x2*)vp, hi = *(const u32x2*)(vp + 8);
          vv[0] = lo[0]; vv[1] = lo[1]; vv[2] = hi[0]; vv[3] = hi[1];
          oacc[dt] = mfma(__builtin_bit_cast(bf16x8, vv), pf, oacc[dt]);
        }
      }
      __syncthreads();
    }
    const float inv = 1.f / sum;
#pragma unroll
    for (int dt = 0; dt < 2; ++dt)
#pragma unroll
      for (int q = 0; q < 4; ++q) {
        float4 o;
        o.x = oacc[dt][4 * q] * inv; o.y = oacc[dt][4 * q + 1] * inv; o.z = oacc[dt][4 * q + 2] * inv; o.w = oacc[dt][4 * q + 3] * inv;
        *(float4*)(p.og + (size_t)qtok * 384 + hc + dt * 32 + 8 * q + 4 * lh) = o;
      }
    if (lh == 0) p.lse[(size_t)qtok * 6 + hd] = (mx + __log2f(sum)) * LN2;
  }
  base += 384;
  __syncthreads();
}

DI void phase_combb(const Prm& p) {
  const int gtid = blockIdx.x * NTH + tidx(), gn = gridDim.x * NTH;
  for (int idx = gtid; idx < TB * 32; idx += gn) {
    const int dq = idx & 15, hg = (idx >> 4) & 1, tok = idx >> 5;
    const float l0 = p.lse[(size_t)tok * 6 + hg], l1 = p.lse[(size_t)tok * 6 + 2 + hg], l2 = p.lse[(size_t)tok * 6 + 4 + hg];
    const float mx = fmaxf(l0, fmaxf(l1, l2));
    const float e0 = __expf(l0 - mx), e1 = __expf(l1 - mx), e2 = __expf(l2 - mx);
    const float inv = 1.f / (e0 + e1 + e2);
    const float4 a = *(const float4*)(p.og + (size_t)tok * 384 + hg * 64 + dq * 4);
    const float4 b = *(const float4*)(p.og + (size_t)tok * 384 + 128 + hg * 64 + dq * 4);
    const float4 c = *(const float4*)(p.og + (size_t)tok * 384 + 256 + hg * 64 + dq * 4);
    st4bf(p.ob + (size_t)tok * 128 + hg * 64 + dq * 4, (e0 * a.x + e1 * b.x + e2 * c.x) * inv, (e0 * a.y + e1 * b.y + e2 * c.y) * inv,
          (e0 * a.z + e1 * b.z + e2 * c.z) * inv, (e0 * a.w + e1 * b.w + e2 * c.w) * inv);
  }
}

constexpr int KS_ELEMS = 128 * 104, VS_ELEMS = 64 * 136;
DI void phase_mla(const Prm& p, unsigned char* smem_raw, int S, int lgS, int& base) {
  u16* Ks = (u16*)smem_raw;
  u16* Vs = Ks + 2 * KS_ELEMS;
  const int tid = tidx(), lane = tid & 63, wave = tid >> 6, lr = lane & 31, lh = lane >> 5;
  const int nkt = S >> 7;
  TASK_LOOP(t, 256, base) {
    const int head = t & 3, qb = t >> 2, tok0 = qb * 256;
    const int seqtok0 = (tok0 >> lgS) << lgS;
    const int qtok = tok0 + wave * 32 + lr;
    bf16x8 qf[6];
#pragma unroll
    for (int ks = 0; ks < 6; ++ks) qf[ks] = *(const bf16x8*)(p.qc + (size_t)qtok * 384 + head * 96 + ks * 16 + lh * 8);
    const u16* kbase = p.kc + (size_t)seqtok0 * 384 + head * 96;
    const u16* vbase = p.vT + (size_t)(head * 64) * TBP + seqtok0;
    u32x4 rk[3], rv[2];
    auto gload = [&](int kt) __attribute__((always_inline)) {
#pragma unroll
      for (int e = 0; e < 3; ++e) {
        const int c = tid + NTH * e, key = c / 12, dc = c - key * 12;
        rk[e] = *(const u32x4*)(kbase + (size_t)(kt * 128 + key) * 384 + dc * 8);
      }
#pragma unroll
      for (int e = 0; e < 2; ++e) {
        const int c = tid + NTH * e, d = c >> 4, kch = c & 15;
        rv[e] = *(const u32x4*)(vbase + (size_t)d * TBP + kt * 128 + kch * 8);
      }
    };
    auto sstore = [&](int buf) __attribute__((always_inline)) {
#pragma unroll
      for (int e = 0; e < 3; ++e) {
        const int c = tid + NTH * e, key = c / 12, dc = c - key * 12;
        *(u32x4*)(Ks + buf * KS_ELEMS + key * 104 + dc * 8) = rk[e];
      }
#pragma unroll
      for (int e = 0; e < 2; ++e) {
        const int c = tid + NTH * e, d = c >> 4, kch = c & 15;
        u16* vd = Vs + buf * VS_ELEMS + d * 136 + (kch >> 1) * 16 + (kch & 1) * 4;
        u32x2 lo, hi;
        lo[0] = rv[e][0]; lo[1] = rv[e][1]; hi[0] = rv[e][2]; hi[1] = rv[e][3];
        *(u32x2*)vd = lo;
        *(u32x2*)(vd + 8) = hi;
      }
    };
    float m = -1e30f;
    f32x2 lsum2 = {0.f, 0.f};
    f32x16 oacc[2];
    oacc[0] = zero16(); oacc[1] = zero16();
    gload(0);
    sstore(0);
    __syncthreads();
    for (int kt = 0; kt < nkt; ++kt) {
      const int buf = kt & 1;
      if (kt + 1 < nkt) gload(kt + 1);
      f32x16 s[4];
#pragma unroll
      for (int kk = 0; kk < 4; ++kk) s[kk] = zero16();
      {
        const u16* kp = Ks + buf * KS_ELEMS + lr * 104 + lh * 8;
        bf16x8 kf[4];
#pragma unroll
        for (int kk = 0; kk < 4; ++kk) kf[kk] = *(const bf16x8*)(kp + kk * 32 * 104);
#pragma unroll
        for (int ks = 0; ks < 6; ++ks) {
          bf16x8 kn[4];
          if (ks < 5) {
#pragma unroll
            for (int kk = 0; kk < 4; ++kk) kn[kk] = *(const bf16x8*)(kp + kk * 32 * 104 + (ks + 1) * 16);
          }
#pragma unroll
          for (int kk = 0; kk < 4; ++kk) s[kk] = mfma(kf[kk], qf[ks], s[kk]);
          if (ks < 5) {
#pragma unroll
            for (int kk = 0; kk < 4; ++kk) kf[kk] = kn[kk];
          }
        }
      }
      float mloc = -1e30f;
#pragma unroll
      for (int kk = 0; kk < 4; ++kk)
#pragma unroll
        for (int r = 0; r < 16; ++r) mloc = fmaxf(mloc, s[kk][r]);
      mloc = fmaxf(mloc, __shfl_xor(mloc, 32));
      const float mnew = fmaxf(m, mloc);
      const float alpha = ex2(m - mnew);
      m = mnew;
      lsum2 *= alpha;
      const f32x2 mn2 = {mnew, mnew};
#pragma unroll
      for (int kk = 0; kk < 4; ++kk)
#pragma unroll
        for (int r2 = 0; r2 < 8; ++r2) {
          f32x2 v = {s[kk][2 * r2], s[kk][2 * r2 + 1]};
          v = v - mn2;
          f32x2 pv;
          pv[0] = ex2(v[0]); pv[1] = ex2(v[1]);
          lsum2 += pv;
          s[kk][2 * r2] = pv[0]; s[kk][2 * r2 + 1] = pv[1];
        }
#pragma unroll
      for (int dt = 0; dt < 2; ++dt)
#pragma unroll
        for (int r = 0; r < 16; ++r) oacc[dt][r] *= alpha;
#pragma unroll
      for (int kk = 0; kk < 4; ++kk)
#pragma unroll
        for (int u = 0; u < 2; ++u) {
          u32x4 pk;
#pragma unroll
          for (int jj = 0; jj < 4; ++jj) pk[jj] = pack2(s[kk][8 * u + 2 * jj], s[kk][8 * u + 2 * jj + 1]);
          const bf16x8 pf = __builtin_bit_cast(bf16x8, pk);
#pragma unroll
          for (int dt = 0; dt < 2; ++dt) {
            const u16* vp = Vs + buf * VS_ELEMS + (dt * 32 + lr) * 136 + kk * 32 + 16 * u + 8 * lh;
            oacc[dt] = mfma(*(const bf16x8*)vp, pf, oacc[dt]);
          }
        }
      if (kt + 1 < nkt) sstore(buf ^ 1);
      __syncthreads();
    }
    float lsum = lsum2[0] + lsum2[1];
    lsum += __shfl_xor(lsum, 32);
    const float inv = 1.f / lsum;
#pragma unroll
    for (int dt = 0; dt < 2; ++dt)
#pragma unroll
      for (int q = 0; q < 4; ++q)
        st4bf(p.od + (size_t)qtok * 256 + head * 64 + dt * 32 + 8 * q + 4 * lh, oacc[dt][4 * q] * inv, oacc[dt][4 * q + 1] * inv,
              oacc[dt][4 * q + 2] * inv, oacc[dt][4 * q + 3] * inv);
  }
  base += 256;
}

template <class ACC>
DI void merge_branch(const Prm& p, u16* smem, const u16* W, const u16* X, int ld, int bi, int n0, int m0, ACC& macc) {
  auto la = [&](int row, int k) __attribute__((always_inline)) { return *(const u32x4*)(W + (size_t)(n0 + row) * ld + k); };
  auto lb = [&](int row, int k) __attribute__((always_inline)) { return *(const u32x4*)(X + (size_t)(m0 + row) * ld + k); };
  auto epi = [&](f32x16 (&acc)[2], int wm, int wn, int lane) __attribute__((always_inline)) {
    const int lr = lane & 31, lh = lane >> 5;
    const int tok = m0 + wn * 32 + lr;
#pragma unroll
    for (int i = 0; i < 2; ++i)
#pragma unroll
      for (int q = 0; q < 4; ++q) {
        const int n = n0 + wm * 64 + i * 32 + 8 * q + 4 * lh;
        const u32x2 gz = *(const u32x2*)(p.zg + (size_t)tok * 4096 + bi * 1024 + n);
        macc[i][4 * q] += bflo(gz[0]) * acc[i][4 * q];
        macc[i][4 * q + 1] += bfhi(gz[0]) * acc[i][4 * q + 1];
        macc[i][4 * q + 2] += bflo(gz[1]) * acc[i][4 * q + 2];
        macc[i][4 * q + 3] += bfhi(gz[1]) * acc[i][4 * q + 3];
      }
  };
  gemm_tile<false, false>(smem, ld >> 6, la, lb, epi);
}

DI void phase_merge(const Prm& p, u16* smem, int l, int& base) {
  TASK_LOOP(t, 8 * 128, base) {
    const int tn = t & 7, tm = t >> 3, n0 = tn * 128, m0 = tm * 128;
    f32x16 macc[2];
    macc[0] = zero16(); macc[1] = zero16();
    merge_branch(p, smem, p.PaT + (size_t)l * 1024 * 768, p.UT, 768, 0, n0, m0, macc);
    merge_branch(p, smem, p.PbT + (size_t)l * 1024 * 128, p.ob, 128, 1, n0, m0, macc);
    merge_branch(p, smem, p.PcT + (size_t)l * 1024 * 384, p.cu, 384, 2, n0, m0, macc);
    merge_branch(p, smem, p.PdT + (size_t)l * 1024 * 256, p.od, 256, 3, n0, m0, macc);
    const int tid2 = tidx(), lane = tid2 & 63, wave = tid2 >> 6, wm = wave >> 2, wn = wave & 3, lr = lane & 31, lh = lane >> 5;
    const int tok = m0 + wn * 32 + lr;
#pragma unroll
    for (int i = 0; i < 2; ++i)
#pragma unroll
      for (int q = 0; q < 4; ++q)
        st4bf(p.hbuf + (size_t)tok * 1024 + n0 + wm * 64 + i * 32 + 8 * q + 4 * lh, macc[i][4 * q], macc[i][4 * q + 1],
              macc[i][4 * q + 2], macc[i][4 * q + 3]);
  }
  base += 8 * 128;
}

DI void phase_resid_gemm(const Prm& p, unsigned char* smem_raw, const u16* W, const u16* X, int K, const float* xsrc, float* xdst,
                         const float* modl, int gtoff, int sb, int& base) {
  LAS u16* shm = (LAS u16*)smem_raw;
  bool pre = false;
  TASK_LOOP(t, 4 * 64, base) {
    int tn, tm;
    map256(t, 4, tn, tm);
    const int brow = tn * 256, bcol = tm * 256;
    const int tnx = t + (int)gridDim.x;
    const bool has_next = tnx < (4 * 64);
    int tn2 = 0, tm2 = 0;
    if (has_next) map256(tnx, 4, tn2, tm2);
    const int nbrow = tn2 * 256, nbcol = tm2 * 256;
    auto epi = [&](f32x4 (&acc)[2][2][4][2], int wr, int wc, int fr, int fq) __attribute__((always_inline)) {
#pragma unroll
      for (int bj = 0; bj < 2; ++bj)
#pragma unroll
        for (int n = 0; n < 2; ++n) {
          const int tok = bcol + bj * 128 + wc * 32 + n * 16 + fr;
          const float* gt = modl + condrow(sb, tok) * 6144 + gtoff;
#pragma unroll
          for (int ai = 0; ai < 2; ++ai)
#pragma unroll
            for (int m = 0; m < 4; ++m) {
              const int nn = brow + ai * 128 + wr * 64 + m * 16 + fq * 4;
              const f32x4 v = acc[ai][bj][m][n];
              const float4 g4 = *(const float4*)(gt + nn);
              const float4 xi = *(const float4*)(xsrc + (size_t)tok * 1024 + nn);
              float4 o;
              o.x = xi.x + g4.x * v[0]; o.y = xi.y + g4.y * v[1]; o.z = xi.z + g4.z * v[2]; o.w = xi.w + g4.w * v[3];
              *(float4*)(xdst + (size_t)tok * 1024 + nn) = o;
            }
        }
    };
    gemm256(shm, W, X, K, brow, bcol, pre, has_next, nbrow, nbcol, epi);
    pre = has_next;
  }
  base += 4 * 64;
}

DI void phase_w1(const Prm& p, unsigned char* smem_raw, int l, int& base) {
  const u16* W = p.W1T + (size_t)l * 4096 * 1024;
  LAS u16* shm = (LAS u16*)smem_raw;
  bool pre = false;
  TASK_LOOP(t, 16 * 64, base) {
    int tn, tm;
    map256(t, 16, tn, tm);
    const int brow = tn * 256, bcol = tm * 256;
    const int tnx = t + (int)gridDim.x;
    const bool has_next = tnx < (16 * 64);
    int tn2 = 0, tm2 = 0;
    if (has_next) map256(tnx, 16, tn2, tm2);
    const int nbrow = tn2 * 256, nbcol = tm2 * 256;
    auto epi = [&](f32x4 (&acc)[2][2][4][2], int wr, int wc, int fr, int fq) __attribute__((always_inline)) {
#pragma unroll
      for (int bj = 0; bj < 2; ++bj)
#pragma unroll
        for (int n = 0; n < 2; ++n) {
          const int tok = bcol + bj * 128 + wc * 32 + n * 16 + fr;
#pragma unroll
          for (int ai = 0; ai < 2; ++ai)
#pragma unroll
            for (int m = 0; m < 4; ++m) {
              const int nn = brow + ai * 128 + wr * 64 + m * 16 + fq * 4;
              const f32x4 v = acc[ai][bj][m][n];
              const float a0 = fmaxf(v[0], 0.f), a1 = fmaxf(v[1], 0.f), a2 = fmaxf(v[2], 0.f), a3 = fmaxf(v[3], 0.f);
              st4bf(p.zg + (size_t)tok * 4096 + nn, a0 * a0, a1 * a1, a2 * a2, a3 * a3);
            }
        }
    };
    gemm256(shm, W, p.hbuf, 1024, brow, bcol, pre, has_next, nbrow, nbcol, epi);
    pre = has_next;
  }
  base += 16 * 64;
}

DI void phase_final(const Prm& p) {
  const int tid = tidx(), lane = tid & 63;
  const int gw = blockIdx.x * 8 + (tid >> 6), nw = gridDim.x * 8;
  for (int row = gw; row < 3 * TB; row += nw) {
    float* xr = p.out + (size_t)row * 1024;
    float4 v[4];
    float ss = 0.f;
#pragma unroll
    for (int i = 0; i < 4; ++i) {
      v[i] = *(const float4*)(xr + i * 256 + lane * 4);
      ss += v[i].x * v[i].x + v[i].y * v[i].y + v[i].z * v[i].z + v[i].w * v[i].w;
    }
#pragma unroll
    for (int off = 32; off >= 1; off >>= 1) ss += __shfl_xor(ss, off);
    const float rstd = rsqrtf(ss * (1.f / 1024.f) + 1e-6f);
#pragma unroll
    for (int i = 0; i < 4; ++i) {
      const int col = i * 256 + lane * 4;
      const float4 gg = *(const float4*)(p.final_g + col);
      float4 o;
      o.x = v[i].x * rstd * gg.x; o.y = v[i].y * rstd * gg.y; o.z = v[i].z * rstd * gg.z; o.w = v[i].w * rstd * gg.w;
      *(float4*)(xr + col) = o;
    }
  }
}

__global__ void __launch_bounds__(512) mega(Prm p) {
  cg::grid_group grid = cg::this_grid();
  __shared__ __attribute__((aligned(16))) unsigned char smem_raw[SMEM_BYTES];
  __shared__ uint4 xb_words;
  u16* smem = (u16*)smem_raw;
  if (threadIdx.x == 0) xb_words = make_uint4(0u, 0u, 0u, 0u);
  __syncthreads();
  const XcdBarrier xb = xcd_barrier_post(p.bar, (volatile LAS unsigned*)&xb_words);
  int base = 0;
  prologue_a(p, smem_raw, base);
  if (PROBE == 11) prologue_a(p, smem_raw, base);
  grid.sync();
  prologue_b(p);
  xcd_barrier(xb);
  for (int sb = 0; sb < 3; ++sb) {
    const int S = sb == 0 ? 16384 : 2048, lgS = sb == 0 ? 14 : 11, nseq = sb == 0 ? 1 : 8;
    const int N1 = S >> 7, lgN1 = lgS - 7;
    const float* xin = sb == 0 ? p.x_prompt : p.x_sample + (size_t)(sb - 1) * TB * 1024;
    float* xo = p.out + (size_t)sb * TB * 1024;
    for (int l = 0; l < 4; ++l) {
      const float* xs = l == 0 ? xin : xo;
      const float* modl = p.mod + (size_t)l * 17 * 6144;
      phase_norm(p, xs, p.norm1_g + l * 1024, modl, 0, 1024, sb);
      xcd_barrier(xb);
      phase_inproj(p, smem_raw, l, S, base);
      if (PROBE == 2 || PROBE == 7) phase_inproj(p, smem_raw, l, S, base);
      if (PROBE == 12) phase_inproj_probe(p, smem_raw, l, base);
      xcd_barrier(xb);
      if (PROBE == 5) xcd_barrier(xb);
      if (N1 == 16) phase_fft1_small(p, nseq); else phase_fft1(p, smem, S, nseq, N1, lgN1, base);
      phase_mixb(p, smem_raw, S, lgS, base);
      phase_mixc(p, smem_raw, l, base);
      phase_qup(p, smem_raw, l, S, base);
      phase_kvup(p, smem_raw, l, base);
      phase_inproj_tail(p, smem_raw, l, base);
      if (PROBE == 13) phase_fft1(p, smem, S, nseq, N1, lgN1, base);
      if (PROBE == 14) phase_mixb(p, smem_raw, S, lgS, base);
      if (PROBE == 15) { phase_qup(p, smem_raw, l, S, base); phase_kvup(p, smem_raw, l, base); phase_inproj_tail(p, smem_raw, l, base); }
      if (PROBE == 4) { phase_fft1(p, smem, S, nseq, N1, lgN1, base); phase_mixb(p, smem_raw, S, lgS, base); phase_qup(p, smem_raw, l, S, base); phase_kvup(p, smem_raw, l, base); }
      xcd_barrier(xb);
      if (PROBE == 5) xcd_barrier(xb);
      phase_mla(p, smem_raw, S, lgS, base);
      if (PROBE == 1) phase_mla(p, smem_raw, S, lgS, base);
      phase_fft2(p, smem, S, nseq, N1, base);
      phase_combb(p);
      if (PROBE == 6) { phase_fft2(p, smem, S, nseq, N1, base); phase_combb(p); }
      xcd_barrier(xb);
      if (PROBE == 5) xcd_barrier(xb);
      phase_merge(p, smem, l, base);
      if (PROBE == 3) phase_merge(p, smem, l, base);
      xcd_barrier(xb);
      if (PROBE == 5) xcd_barrier(xb);
      phase_resid_gemm(p, smem_raw, p.WoT + (size_t)l * 1024 * 1024, p.hbuf, 1024, xs, xo, modl, 2048, sb, base);
      xcd_barrier(xb);
      phase_norm(p, xo, p.norm2_g + l * 1024, modl, 3072, 4096, sb);
      if (PROBE == 9) { phase_norm(p, xo, p.norm2_g + l * 1024, modl, 3072, 4096, sb); phase_norm(p, xo, p.norm2_g + l * 1024, modl, 3072, 4096, sb); }
      xcd_barrier(xb);
      phase_w1(p, smem_raw, l, base);
      if (PROBE == 2 || PROBE == 8) phase_w1(p, smem_raw, l, base);
      xcd_barrier(xb);
      if (PROBE == 5) xcd_barrier(xb);
      phase_resid_gemm(p, smem_raw, p.W2T + (size_t)l * 1024 * 4096, p.zg, 4096, xo, xo, modl, 5120, sb, base);
      xcd_barrier(xb);
    }
  }
  phase_final(p);
}

extern "C" void kernel_launch(void* const* d_in, const int* in_sizes, int n_in, void* d_out, int out_size, void* d_ws, size_t ws_size,
                              hipStream_t stream) {
  Prm p{};
  const float* const* in = (const float* const*)d_in;
  p.x_prompt = in[0]; p.x_sample = in[1]; p.c_prompt = in[2]; p.c_sample = in[3]; p.rel_bias = in[4]; p.ada_w = in[5]; p.ada_b = in[6];
  p.norm1_g = in[7]; p.w_in = in[8]; p.qn_g = in[9]; p.kvn_g = in[10]; p.w_uq = in[11]; p.w_ukv = in[12]; p.ln_g = in[13]; p.ln_b = in[14];
  p.sgu_w = in[15]; p.sgu_b = in[16]; p.p_a = in[17]; p.p_b = in[18]; p.p_c = in[19]; p.p_d = in[20]; p.w_o = in[21]; p.norm2_g = in[22];
  p.w1 = in[23]; p.w2 = in[24]; p.final_g = in[25];
  p.out = (float*)d_out;
  char* w = (char*)d_ws;
  size_t off = 0;
  auto take = [&](size_t bytes) __attribute__((always_inline)) { void* r = w + off; off += (bytes + 255) & ~(size_t)255; return r; };
  p.WinT = (u16*)take((size_t)4 * NWP * 1024 * 2);
  p.W1T = (u16*)take((size_t)4 * 4096 * 1024 * 2);
  p.W2T = (u16*)take((size_t)4 * 4096 * 1024 * 2);
  p.WoT = (u16*)take((size_t)4 * 1024 * 1024 * 2);
  p.PaT = (u16*)take((size_t)4 * 1024 * 768 * 2);
  p.PbT = (u16*)take((size_t)4 * 1024 * 128 * 2);
  p.PcT = (u16*)take((size_t)4 * 1024 * 384 * 2);
  p.PdT = (u16*)take((size_t)4 * 1024 * 256 * 2);
  p.WqT = (u16*)take((size_t)4 * 384 * 384 * 2);
  p.WkvT = (u16*)take((size_t)4 * 512 * 320 * 2);
  p.SgW = (u16*)take((size_t)4 * 4 * 128 * 128 * 2);
  p.M1a = (u16*)take(256 * 256 * 2);
  p.M1b = (u16*)take(32 * 64 * 2);
  p.M2 = (u16*)take(128 * 256 * 2);
  p.tw = (float2*)take(16384 * 8);
  p.rope = (float2*)take((size_t)16384 * 16 * 8);
  p.biasT = (float*)take(6 * 129 * 4);
  p.mod = (float*)take((size_t)4 * 17 * 6144 * 4);
  p.hbuf = (u16*)take((size_t)TB * 1024 * 2);
  p.og = (float*)take((size_t)TB * 384 * 4);
  p.UT = (u16*)take((size_t)1536 * TBP * 2);
  p.Gp = (u16*)take((size_t)1536 * TB * 2);
  p.bqkv = (u16*)take((size_t)TB * 1152 * 2);
  p.ob = (u16*)take((size_t)TB * 128 * 2);
  p.cu = (u16*)take((size_t)TB * 384 * 2);
  p.cvT = (u16*)take((size_t)TBP * 384 * 2);
  p.dcq = (u16*)take((size_t)TB * 384 * 2);
  p.dckv = (u16*)take((size_t)TB * 320 * 2);
  p.qc = (u16*)take((size_t)TB * 384 * 2);
  p.kc = (u16*)take((size_t)TB * 384 * 2);
  p.vT = (u16*)take((size_t)TBP * 256 * 2);
  p.od = (u16*)take((size_t)TB * 256 * 2);
  p.lse = (float*)take((size_t)TB * 6 * 4);
  p.zg = (u16*)take((size_t)TB * 4096 * 2);
  p.bar = (unsigned*)take(XCD_BAR_WORDS * 4);
  p.modpart = (float*)p.zg;
  if (off > ws_size) { fprintf(stderr, "workspace too small: need %zu have %zu\n", off, ws_size); return; }
  static int grid_blocks = 0;
  if (!grid_blocks) {
    int dev = 0, cus = 0, per_cu = 0;
    (void)hipGetDevice(&dev);
    (void)hipDeviceGetAttribute(&cus, hipDeviceAttributeMultiprocessorCount, dev);
    (void)hipOccupancyMaxActiveBlocksPerMultiprocessor(&per_cu, mega, NTH, 0);
    if (per_cu < 1) per_cu = 1;
    if (per_cu > 1) per_cu = 1;
    grid_blocks = cus * per_cu;
  }
  (void)hipMemsetAsync(p.bar, 0, XCD_BAR_WORDS * 4, stream);
  void* args[] = {&p};
  hipError_t e = hipLaunchCooperativeKernel((void*)mega, dim3(grid_blocks), dim3(NTH), args, 0, stream);
  if (e != hipSuccess) fprintf(stderr, "cooperative launch failed: %s (grid %d)\n", hipGetErrorString(e), grid_blocks);
}
```

```cpp
#include <hip/hip_runtime.h>
#include <hip/hip_cooperative_groups.h>
#include <stdint.h>
#include <stdio.h>
namespace cg = cooperative_groups;

#define DI __device__ __forceinline__
#define LAS __attribute__((address_space(3)))
typedef unsigned short u16;
typedef __attribute__((ext_vector_type(8))) short bf16x8;
typedef __attribute__((ext_vector_type(4))) short bf16x4;
typedef __attribute__((ext_vector_type(16))) float f32x16;
typedef __attribute__((ext_vector_type(4))) float f32x4;
typedef __attribute__((ext_vector_type(2))) float f32x2;
typedef __attribute__((ext_vector_type(4))) unsigned u32x4;
typedef __attribute__((ext_vector_type(2))) unsigned u32x2;
typedef __attribute__((ext_vector_type(2))) __bf16 bf2_t;

constexpr int TB = 16384;
constexpr int TBP = TB + 64;
constexpr int NW = 8288;
constexpr int NWP = 8320;
constexpr int LDT = 72;
constexpr int TILE_ELEMS = 128 * LDT;
constexpr int GEMM_SMEM = 4 * TILE_ELEMS * 2;
constexpr int SMEM_BYTES = 131072;
#ifndef PROBE
#define PROBE 0
#endif
constexpr int NTH = 512;
constexpr int HT = 128 * 64;
constexpr float LOG2E = 1.4426950408889634f;
constexpr float LN2 = 0.6931471805599453f;

struct Prm {
  const float *x_prompt, *x_sample, *c_prompt, *c_sample, *rel_bias, *ada_w, *ada_b, *norm1_g, *w_in,
      *qn_g, *kvn_g, *w_uq, *w_ukv, *ln_g, *ln_b, *sgu_w, *sgu_b, *p_a, *p_b, *p_c, *p_d, *w_o,
      *norm2_g, *w1, *w2, *final_g;
  float* out;
  u16 *WinT, *W1T, *W2T, *WoT, *PaT, *PbT, *PcT, *PdT, *WqT, *WkvT, *SgW, *M1a, *M1b, *M2;
  float2 *tw, *rope;
  float *biasT, *mod, *modpart;
  u16 *hbuf, *UT, *Gp, *bqkv, *ob, *cu, *cvT, *dcq, *dckv, *qc, *kc, *vT, *od, *zg;
  float *og, *lse;
  unsigned* bar;
};

DI unsigned pack2(float a, float b) { bf2_t v; v[0] = (__bf16)a; v[1] = (__bf16)b; return __builtin_bit_cast(unsigned, v); }
DI u16 f2bf(float a) { return __builtin_bit_cast(u16, (__bf16)a); }
DI float bf2f(u16 v) { return __uint_as_float(((unsigned)v) << 16); }
DI float bflo(unsigned w) { return __uint_as_float(w << 16); }
DI float bfhi(unsigned w) { return __uint_as_float(w & 0xffff0000u); }
DI void st4bf(u16* dst, float a, float b, float c, float d) { u32x2 v; v[0] = pack2(a, b); v[1] = pack2(c, d); *(u32x2*)dst = v; }
DI void st4bf_nt(u16* dst, float a, float b, float c, float d) { u32x2 v; v[0] = pack2(a, b); v[1] = pack2(c, d); __builtin_nontemporal_store(v, (u32x2*)dst); }
DI int rowmap(int r, int lh) { return (r & 3) + 8 * (r >> 2) + 4 * lh; }
DI f32x16 mfma(bf16x8 a, bf16x8 b, f32x16 c) { return __builtin_amdgcn_mfma_f32_32x32x16_bf16(a, b, c, 0, 0, 0); }
DI u32x4 zero4() { u32x4 z; z[0] = 0; z[1] = 0; z[2] = 0; z[3] = 0; return z; }
DI f32x16 zero16() { f32x16 z; for (int i = 0; i < 16; ++i) z[i] = 0.f; return z; }
DI float ex2(float x) { return __builtin_amdgcn_exp2f(x); }
DI int tidx() { int t = threadIdx.x; asm volatile("" : "+v"(t)); return t; }


#define XB_TMO      128
#define XB_XCNT(j)  (256  + 64 * (j))
#define XB_XSUB(j)  (1280 + 64 * (j))
#define XB_XGEN(j)  (2304 + 64 * (j))
#define XB_TOP      3328
#define XB_TOPGEN   3392
#define XCD_BAR_WORDS 3456
#define XB_SPIN_CAP (1u << 18)
DI unsigned xb_ld(unsigned* p) { return __hip_atomic_load(p, __ATOMIC_RELAXED, __HIP_MEMORY_SCOPE_AGENT); }
DI unsigned xb_add(unsigned* p, unsigned v) { return __hip_atomic_fetch_add(p, v, __ATOMIC_RELAXED, __HIP_MEMORY_SCOPE_AGENT); }
DI unsigned xb_xcc_id() { return (unsigned)__builtin_amdgcn_s_getreg((3 << 11) | 20) & 0xFu; }
#define XB_SPIN(cond, bar) do { unsigned _sp = 0; while (cond) { __builtin_amdgcn_s_sleep(1); \
    if ((++_sp & 255u) == 0u) { if (xb_ld(&(bar)[XB_TMO])) break; if (_sp > XB_SPIN_CAP) { atomicAdd(&(bar)[XB_TMO], 1u); break; } } } } while (0)
struct XcdBarrier { unsigned* bar; unsigned x; volatile LAS unsigned* st; };
DI XcdBarrier xcd_barrier_post(unsigned* bar, volatile LAS unsigned* st) {
  XcdBarrier b; b.bar = bar; b.x = xb_xcc_id(); b.st = st;
  if (threadIdx.x == 0) (void)xb_add(&bar[XB_XCNT(b.x)], 1u);
  return b;
}
DI void xcd_barrier_complete(unsigned* bar, unsigned x, unsigned& nloc, unsigned& nx) {
  const unsigned G = gridDim.x * gridDim.y * gridDim.z;
  unsigned sum, cnt, mine, sp = 0u;
  for (;;) {
    sum = 0u; cnt = 0u; mine = 0u;
#pragma unroll
    for (unsigned j = 0; j < 16; ++j) { const unsigned c = xb_ld(&bar[XB_XCNT(j)]); sum += c; cnt += (c > 0u) ? 1u : 0u; mine = (j == x) ? c : mine; }
    if (sum == G) break;
    __builtin_amdgcn_s_sleep(1);
    if ((++sp & 255u) == 0u) { if (xb_ld(&bar[XB_TMO])) break; if (sp > XB_SPIN_CAP) { atomicAdd(&bar[XB_TMO], 1u); break; } }
  }
  nloc = mine > 0u ? mine : 1u; nx = cnt > 0u ? cnt : 1u;
}
DI void xcd_barrier(const XcdBarrier& b) {
  asm volatile("s_waitcnt vmcnt(0)" ::: "memory");
  __syncthreads();
  if (tidx() == 0) {
    unsigned* bar = b.bar;
    const unsigned bx = (unsigned)__builtin_amdgcn_readfirstlane((int)xb_xcc_id());
    __builtin_amdgcn_s_waitcnt(0);
    unsigned nloc = b.st[0], nx = b.st[1];
    if (nloc == 0u) { xcd_barrier_complete(bar, bx, nloc, nx); b.st[0] = nloc; b.st[1] = nx; }
    const unsigned old = xb_add(&bar[XB_XSUB(bx)], 1u);
    const unsigned gen = old / nloc;
    if (old + 1u == (gen + 1u) * nloc) {
      __builtin_amdgcn_fence(__ATOMIC_RELEASE, "agent");
      asm volatile("s_waitcnt vmcnt(0)" ::: "memory");
      const unsigned og = xb_add(&bar[XB_TOP], 1u);
      const unsigned tg = og / nx;
      if (og + 1u == (tg + 1u) * nx) xb_add(&bar[XB_TOPGEN], 1u);
      else XB_SPIN(xb_ld(&bar[XB_TOPGEN]) == tg, bar);
      __builtin_amdgcn_fence(__ATOMIC_ACQUIRE, "agent");
      xb_add(&bar[XB_XGEN(bx)], 1u);
      asm volatile("s_waitcnt vmcnt(0)" ::: "memory");
    } else {
      XB_SPIN(xb_ld(&bar[XB_XGEN(bx)]) == gen, bar);
      __builtin_amdgcn_fence(__ATOMIC_ACQUIRE, "agent");
      asm volatile("s_waitcnt vmcnt(0)" ::: "memory");
    }
  }
  __syncthreads();
}

#define TASK_LOOP(t, nt, base) for (int t = (int)((blockIdx.x + gridDim.x - ((unsigned)(base) % gridDim.x)) % gridDim.x); t < (nt); t += gridDim.x)

template <bool RFA, bool RFB, class LA, class LB, class EPI>
DI void gemm_tile(u16* smem, int nk, LA la, LB lb, EPI epi) {
  const int tid = tidx(), lane = tid & 63, wave = tid >> 6;
  const int wm = wave >> 2, wn = wave & 3, lr = lane & 31, lh = lane >> 5;
  u16* As = smem;
  u16* Bs = smem + 2 * TILE_ELEMS;
  f32x16 acc[2];
  acc[0] = zero16(); acc[1] = zero16();
  u32x4 ra[2], rb[2];
#define A_ROW(c) (RFA ? ((c) & 127) : ((c) >> 3))
#define A_KC(c) (RFA ? ((c) >> 7) : ((c) & 7))
#define B_ROW(c) (RFB ? ((c) & 127) : ((c) >> 3))
#define B_KC(c) (RFB ? ((c) >> 7) : ((c) & 7))
#pragma unroll
  for (int i = 0; i < 2; ++i) { const int c = tid + NTH * i; ra[i] = la(A_ROW(c), A_KC(c) * 8); rb[i] = lb(B_ROW(c), B_KC(c) * 8); }
#pragma unroll
  for (int i = 0; i < 2; ++i) {
    const int c = tid + NTH * i;
    *(u32x4*)(As + A_ROW(c) * LDT + A_KC(c) * 8) = ra[i];
    *(u32x4*)(Bs + B_ROW(c) * LDT + B_KC(c) * 8) = rb[i];
  }
  __syncthreads();
  for (int kt = 0; kt < nk; ++kt) {
    const int buf = kt & 1;
    if (kt + 1 < nk) {
      const int k0 = (kt + 1) * 64;
#pragma unroll
      for (int i = 0; i < 2; ++i) { const int c = tid + NTH * i; ra[i] = la(A_ROW(c), k0 + A_KC(c) * 8); rb[i] = lb(B_ROW(c), k0 + B_KC(c) * 8); }
    }
    const u16* Ab = As + buf * TILE_ELEMS + (wm * 64 + lr) * LDT + lh * 8;
    const u16* Bb = Bs + buf * TILE_ELEMS + (wn * 32 + lr) * LDT + lh * 8;
#pragma unroll
    for (int ks = 0; ks < 4; ++ks) {
      const bf16x8 a0 = *(const bf16x8*)(Ab + ks * 16);
      const bf16x8 a1 = *(const bf16x8*)(Ab + 32 * LDT + ks * 16);
      const bf16x8 b = *(const bf16x8*)(Bb + ks * 16);
      acc[0] = mfma(a0, b, acc[0]);
      acc[1] = mfma(a1, b, acc[1]);
    }
    if (kt + 1 < nk) {
      u16* Aw = As + (buf ^ 1) * TILE_ELEMS;
      u16* Bw = Bs + (buf ^ 1) * TILE_ELEMS;
#pragma unroll
      for (int i = 0; i < 2; ++i) {
        const int c = tid + NTH * i;
        *(u32x4*)(Aw + A_ROW(c) * LDT + A_KC(c) * 8) = ra[i];
        *(u32x4*)(Bw + B_ROW(c) * LDT + B_KC(c) * 8) = rb[i];
      }
    }
    __syncthreads();
  }
  epi(acc, wm, wn, lane);
}

DI void stage_rc(int b, int& R, int& C) { int st = b / 1024, sb = b % 1024, swz = sb ^ (((sb >> 9) & 1) << 5); R = (st >> 1) * 16 + swz / 64; C = (st & 1) * 32 + (swz % 64) / 2; }

template <class EPI>
DI void gemm256(LAS u16* shm, const u16* __restrict__ A, const u16* __restrict__ Bt, int K, int brow, int bcol, bool pre, bool has_next, int nbrow, int nbcol, EPI epi) {
#define SA(b, h) (shm + ((b) * 2 + (h)) * HT)
#define SB(b, h) (shm + (4 + (b) * 2 + (h)) * HT)
  const int tid = tidx();
  const int wid = __builtin_amdgcn_readfirstlane(tid >> 6), lane = tid & 63, wr = wid >> 2, wc = wid & 3, fr = lane & 15, fq = lane >> 4;
  int r0, c0, r1, c1;
  stage_rc(tid * 16, r0, c0);
  stage_rc(tid * 16 + 8192, r1, c1);
  const unsigned so0 = (unsigned)(r0 * K + c0) * 2u, so1 = (unsigned)(r1 * K + c1) * 2u;
  const unsigned ldsw = (unsigned)wid * 1024u;
  const int lb = ((fr * 64 + fq * 16) ^ ((fr >> 3) << 5));
#define STAGE(P, BASE, br, kt) do { const char* _g = (const char*)((BASE) + (size_t)(br) * K + (kt) * 64); \
    __builtin_amdgcn_global_load_lds((const unsigned*)(_g + so0), (LAS unsigned*)((LAS char*)(P) + ldsw), 16, 0, 0); \
    __builtin_amdgcn_global_load_lds((const unsigned*)(_g + so1), (LAS unsigned*)((LAS char*)(P) + ldsw + 8192), 16, 0, 0); } while (0)
#define LDA(dst, b, h) _Pragma("unroll") for (int m = 0; m < 4; ++m) _Pragma("unroll") for (int k = 0; k < 2; ++k) \
    dst[m][k] = *(const LAS bf16x8*)((const LAS char*)SA(b, h) + ((wr * 4 + m) * 2 + k) * 1024 + lb)
#define LDB(dst, b, h) _Pragma("unroll") for (int n = 0; n < 2; ++n) _Pragma("unroll") for (int k = 0; k < 2; ++k) \
    dst[n][k] = *(const LAS bf16x8*)((const LAS char*)SB(b, h) + ((wc * 2 + n) * 2 + k) * 1024 + lb)
#define MMA(ai, bj, At_, Bt_) do { __builtin_amdgcn_s_setprio(1); \
    _Pragma("unroll") for (int m = 0; m < 4; ++m) _Pragma("unroll") for (int n = 0; n < 2; ++n) _Pragma("unroll") for (int k = 0; k < 2; ++k) \
      acc[ai][bj][m][n] = __builtin_amdgcn_mfma_f32_16x16x32_bf16(At_[m][k], Bt_[n][k], acc[ai][bj][m][n], 0, 0, 0); \
    __builtin_amdgcn_s_setprio(0); } while (0)
#define WAIT_V(n) asm volatile("s_waitcnt vmcnt(" #n ")" ::: "memory")
#define WAIT_L(n) asm volatile("s_waitcnt lgkmcnt(" #n ")" ::: "memory")
#define BAR __builtin_amdgcn_s_barrier()
#define SCHED __builtin_amdgcn_sched_barrier(0)
  f32x4 acc[2][2][4][2];
#pragma unroll
  for (int a = 0; a < 2; ++a)
#pragma unroll
    for (int b = 0; b < 2; ++b)
#pragma unroll
      for (int m = 0; m < 4; ++m)
#pragma unroll
        for (int n = 0; n < 2; ++n) { acc[a][b][m][n][0] = 0.f; acc[a][b][m][n][1] = 0.f; acc[a][b][m][n][2] = 0.f; acc[a][b][m][n][3] = 0.f; }
  bf16x8 At[4][2], B0[2][2], B1[2][2];
  const int nt = K / 64;
  if (!pre) {
    STAGE(SB(0, 0), Bt, bcol, 0); STAGE(SA(0, 0), A, brow, 0);
    STAGE(SB(0, 1), Bt, bcol + 128, 0); STAGE(SA(0, 1), A, brow + 128, 0);
  }
  if (wr == 1) BAR;
  WAIT_V(4); BAR;
  STAGE(SB(1, 0), Bt, bcol, 1); STAGE(SA(1, 0), A, brow, 1); STAGE(SB(1, 1), Bt, bcol + 128, 1);
  WAIT_V(6); BAR;
  for (int t = 0; t < nt - 2; t += 2) {
    LDB(B0, 0, 0); SCHED; LDA(At, 0, 0); STAGE(SA(1, 1), A, brow + 128, t + 1);
    WAIT_L(8); BAR; WAIT_L(0); MMA(0, 0, At, B0); BAR; SCHED;
    LDB(B1, 0, 1); STAGE(SB(0, 0), Bt, bcol, t + 2);
    BAR; WAIT_L(0); MMA(0, 1, At, B1); BAR;
    LDA(At, 0, 1); STAGE(SA(0, 0), A, brow, t + 2);
    BAR; WAIT_L(0); MMA(1, 0, At, B0); BAR; SCHED;
    STAGE(SB(0, 1), Bt, bcol + 128, t + 2);
    WAIT_V(6); BAR; MMA(1, 1, At, B1); BAR;
    LDB(B0, 1, 0); SCHED; LDA(At, 1, 0); STAGE(SA(0, 1), A, brow + 128, t + 2);
    WAIT_L(8); BAR; WAIT_L(0); MMA(0, 0, At, B0); BAR; SCHED;
    LDB(B1, 1, 1); STAGE(SB(1, 0), Bt, bcol, t + 3);
    BAR; WAIT_L(0); MMA(0, 1, At, B1); BAR;
    LDA(At, 1, 1); STAGE(SA(1, 0), A, brow, t + 3);
    BAR; WAIT_L(0); MMA(1, 0, At, B0); BAR; SCHED;
    STAGE(SB(1, 1), Bt, bcol + 128, t + 3);
    WAIT_V(6); BAR; MMA(1, 1, At, B1); BAR;
  }
  { LDB(B0, 0, 0); LDA(At, 0, 0); STAGE(SA(1, 1), A, brow + 128, nt - 1);
    BAR; WAIT_L(0); MMA(0, 0, At, B0); BAR;
    LDB(B1, 0, 1); BAR; WAIT_L(0); MMA(0, 1, At, B1); BAR;
    LDA(At, 0, 1); WAIT_V(4); BAR; WAIT_L(0); MMA(1, 0, At, B0); MMA(1, 1, At, B1); BAR; }
  { LDB(B0, 1, 0); LDA(At, 1, 0); WAIT_V(2); BAR; WAIT_L(0); MMA(0, 0, At, B0); BAR;
    LDB(B1, 1, 1); WAIT_V(0); BAR; WAIT_L(0); MMA(0, 1, At, B1); BAR;
    LDA(At, 1, 1); BAR; WAIT_L(0); MMA(1, 0, At, B0); MMA(1, 1, At, B1); BAR; }
  if (wr == 0) BAR;
  if (has_next) {
    STAGE(SB(0, 0), Bt, nbcol, 0); STAGE(SA(0, 0), A, nbrow, 0);
    STAGE(SB(0, 1), Bt, nbcol + 128, 0); STAGE(SA(0, 1), A, nbrow + 128, 0);
  }
  epi(acc, wr, wc, fr, fq);
  __syncthreads();
}

DI void map256(int t, int nN, int& tn, int& tm) {
  const int p = (t >> 8) * 8 + (t & 7), i = (t >> 3) & 31, pr = nN >> 2;
  const int pm = p / pr;
  tn = ((p + pm) % pr) * 4 + (i & 3);
  tm = pm * 8 + (i >> 2);
}

DI int condrow(int sb, int tok) { return sb == 0 ? 0 : 1 + (sb - 1) * 8 + (tok >> 11); }

DI void convT(float* tile, const float* src, int lds_, int K, int N, u16* dst, int ldd, const float* ksc, int& base) {
  const int tid = tidx();
  const int ntn = (N + 63) >> 6, nt = (K >> 6) * ntn;
  const int kk = tid >> 4, n4 = (tid & 15) * 4;
  float4 cur[2], nxt[2];
  auto ld = [&](float4 (&v)[2], int t) __attribute__((always_inline)) {
    const int tn = t % ntn, tk = t / ntn, k0 = tk * 64, n0 = tn * 64;
#pragma unroll
    for (int e = 0; e < 2; ++e) {
      v[e] = make_float4(0.f, 0.f, 0.f, 0.f);
      if (n0 + n4 < N) v[e] = *(const float4*)(src + (size_t)(k0 + kk + 32 * e) * lds_ + n0 + n4);
    }
  };
  int t = (int)((blockIdx.x + gridDim.x - ((unsigned)base % gridDim.x)) % gridDim.x);
  if (t < nt) ld(cur, t);
  for (; t < nt; t += gridDim.x) {
    const int tnx = t + (int)gridDim.x;
    if (tnx < nt) ld(nxt, tnx);
    const int tn = t % ntn, tk = t / ntn, k0 = tk * 64, n0 = tn * 64;
#pragma unroll
    for (int e = 0; e < 2; ++e) {
      float4 v = cur[e];
      if (ksc) { const float sc = ksc[k0 + kk + 32 * e]; v.x *= sc; v.y *= sc; v.z *= sc; v.w *= sc; }
      float* tp = tile + (kk + 32 * e) * 65 + n4;
      tp[0] = v.x; tp[1] = v.y; tp[2] = v.z; tp[3] = v.w;
    }
    __syncthreads();
#pragma unroll 4
    for (int e = 0; e < 4; ++e) {
      const int idx = tid + NTH * e, nn = idx >> 5, kp = idx & 31;
      if (n0 + nn < N)
        *(unsigned*)(dst + (size_t)(n0 + nn) * ldd + k0 + 2 * kp) = pack2(tile[(2 * kp) * 65 + nn], tile[(2 * kp + 1) * 65 + nn]);
    }
    __syncthreads();
    cur[0] = nxt[0]; cur[1] = nxt[1];
  }
  base += nt;
}

DI void prologue_a(const Prm& p, unsigned char* smem_raw, int& base) {
  float* smf = (float*)smem_raw;
  const int tid = tidx();
  const int gtid = blockIdx.x * NTH + tid, gn = gridDim.x * NTH;
  for (int l = 0; l < 4; ++l) {
    convT(smf, p.w_in + (size_t)l * 1024 * 7520 + 768, 7520, 1024, 6752, p.WinT + ((size_t)l * NWP + 1536) * 1024, 1024, nullptr, base);
    convT(smf, p.w1 + (size_t)l * 1024 * 4096, 4096, 1024, 4096, p.W1T + (size_t)l * 4096 * 1024, 1024, nullptr, base);
    convT(smf, p.w2 + (size_t)l * 4096 * 1024, 1024, 4096, 1024, p.W2T + (size_t)l * 1024 * 4096, 4096, nullptr, base);
    convT(smf, p.w_o + (size_t)l * 1024 * 1024, 1024, 1024, 1024, p.WoT + (size_t)l * 1024 * 1024, 1024, nullptr, base);
    convT(smf, p.p_a + (size_t)l * 768 * 1024, 1024, 768, 1024, p.PaT + (size_t)l * 1024 * 768, 768, nullptr, base);
    convT(smf, p.p_b + (size_t)l * 128 * 1024, 1024, 128, 1024, p.PbT + (size_t)l * 1024 * 128, 128, nullptr, base);
    convT(smf, p.p_c + (size_t)l * 384 * 1024, 1024, 384, 1024, p.PcT + (size_t)l * 1024 * 384, 384, nullptr, base);
    convT(smf, p.p_d + (size_t)l * 256 * 1024, 1024, 256, 1024, p.PdT + (size_t)l * 1024 * 256, 256, nullptr, base);
    convT(smf, p.w_uq + (size_t)l * 384 * 384, 384, 384, 384, p.WqT + (size_t)l * 384 * 384, 384, p.qn_g + l * 384, base);
    convT(smf, p.w_ukv + (size_t)l * 320 * 512, 512, 320, 512, p.WkvT + (size_t)l * 512 * 320, 320, p.kvn_g + l * 320, base);
  }
  {
    float* wl = smf;
    float* tab = smf + 32 * 196;
    TASK_LOOP(t, 512, base) {
      const int kb = t & 31, g = (t >> 5) & 3, l = t >> 7, k0 = kb * 32;
      for (int idx = tid; idx < 32 * 192; idx += NTH) {
        const int kk = idx / 192, c = idx - kk * 192;
        wl[kk * 196 + c] = p.w_in[((size_t)l * 1024 + k0 + kk) * 7520 + g * 192 + c];
      }
      if (tid < 192) {
        float s, c;
        sincospif(2.f * (float)tid / 192.f, &s, &c);
        tab[tid] = c; tab[192 + tid] = s;
      }
      __syncthreads();
      for (int e = 0; e < 6; ++e) {
        const int idx = tid + NTH * e, kq = idx & 7, pj = idx >> 3;
        const int part = pj >= 192 ? 1 : 0, j = pj - part * 192;
        const float* tp = tab + part * 192;
        const float* w0 = wl + (kq * 4) * 196;
        float s0 = 0, s1 = 0, s2 = 0, s3 = 0;
        int m = 0;
        for (int c = 0; c < 192; c += 4) {
          const float4 a0 = *(const float4*)(w0 + c), a1 = *(const float4*)(w0 + 196 + c), a2 = *(const float4*)(w0 + 392 + c), a3 = *(const float4*)(w0 + 588 + c);
          const float t0 = tp[m]; m += j; if (m >= 192) m -= 192;
          const float t1 = tp[m]; m += j; if (m >= 192) m -= 192;
          const float t2 = tp[m]; m += j; if (m >= 192) m -= 192;
          const float t3 = tp[m]; m += j; if (m >= 192) m -= 192;
          s0 += a0.x * t0 + a0.y * t1 + a0.z * t2 + a0.w * t3;
          s1 += a1.x * t0 + a1.y * t1 + a1.z * t2 + a1.w * t3;
          s2 += a2.x * t0 + a2.y * t1 + a2.z * t2 + a2.w * t3;
          s3 += a3.x * t0 + a3.y * t1 + a3.z * t2 + a3.w * t3;
        }
        if (part) { s0 = -s0; s1 = -s1; s2 = -s2; s3 = -s3; }
        st4bf(p.WinT + ((size_t)l * NWP + part * 768 + g * 192 + j) * 1024 + k0 + kq * 4, s0, s1, s2, s3);
      }
      __syncthreads();
    }
    base += 512;
  }
  {
    float* sil = smf;
    TASK_LOOP(t, 384, base) {
      const int kc = t & 7, cb = (t >> 3) % 12, l = t / 96, k0 = kc * 128;
      for (int idx = tid; idx < 17 * 128; idx += NTH) {
        const int r = idx >> 7, kk = idx & 127;
        const float c = r == 0 ? p.c_prompt[k0 + kk] : p.c_sample[(r - 1) * 1024 + k0 + kk];
        sil[idx] = c / (1.f + __expf(-c));
      }
      __syncthreads();
      const int n = cb * 512 + tid;
      float acc[17];
#pragma unroll
      for (int r = 0; r < 17; ++r) acc[r] = 0.f;
      const float* wp = p.ada_w + ((size_t)l * 1024 + k0) * 6144 + n;
#pragma unroll 1
      for (int kb = 0; kb < 128; kb += 32) {
        float w[32];
#pragma unroll
        for (int i = 0; i < 32; ++i) w[i] = wp[(size_t)(kb + i) * 6144];
#pragma unroll
        for (int i = 0; i < 32; i += 4)
#pragma unroll
          for (int r = 0; r < 17; ++r) {
            const float4 sv = *(const float4*)(sil + r * 128 + kb + i);
            acc[r] += sv.x * w[i] + sv.y * w[i + 1] + sv.z * w[i + 2] + sv.w * w[i + 3];
          }
      }
#pragma unroll
      for (int r = 0; r < 17; ++r) p.modpart[((size_t)(kc * 4 + l) * 17 + r) * 6144 + n] = acc[r];
      __syncthreads();
    }
    base += 384;
  }
  for (int idx = gtid; idx < 4 * 32 * 1024; idx += gn) {
    const int l = idx >> 15, rem = idx & 32767;
    p.WinT[((size_t)l * NWP + NW) * 1024 + rem] = 0;
  }
  for (int idx = gtid; idx < 256 * 256; idx += gn) {
    const int row = idx >> 8, kk = idx & 255;
    const int po = row >> 7, k1 = row & 127, pi = kk >> 7, s1 = kk & 127;
    float s, c;
    sincospif(2.f * (float)((k1 * s1) & 127) / 128.f, &s, &c);
    const float v = (po == pi) ? c : (po == 0 ? s : -s);
    p.M1a[idx] = f2bf(v);
  }
  for (int idx = gtid; idx < 32 * 64; idx += gn) {
    const int row = idx >> 6, kk = idx & 63;
    const int po = row >> 4, k1 = row & 15, pi = (kk >> 4) & 1, s1 = kk & 15;
    float s, c;
    sincospif(2.f * (float)((k1 * s1) & 15) / 16.f, &s, &c);
    float v = (po == pi) ? c : (po == 0 ? s : -s);
    if (kk >= 32) v = 0.f;
    p.M1b[idx] = f2bf(v);
  }
  for (int idx = gtid; idx < 128 * 256; idx += gn) {
    const int k2 = idx >> 8, kk = idx & 255, part = kk >> 7, s2 = kk & 127;
    float s, c;
    sincospif(2.f * (float)((k2 * s2) & 127) / 128.f, &s, &c);
    p.M2[idx] = f2bf(part ? s : c);
  }
  for (int idx = gtid; idx < 16384; idx += gn) {
    float s, c;
    sincospif(2.f * (float)idx / 16384.f, &s, &c);
    p.tw[idx] = make_float2(c, s);
  }
  for (int idx = gtid; idx < 16384 * 16; idx += gn) {
    const int pos = idx >> 4, i = idx & 15;
    const float inv = (float)pow(10000.0, -(double)i / 16.0);
    const float ang = (float)pos * inv;
    double rev = (double)ang * 0.15915494309189535;
    rev -= rint(rev);
    float s, c;
    sincospif((float)(2.0 * rev), &s, &c);
    p.rope[idx] = make_float2(c, s);
  }
  for (int idx = gtid; idx < 6 * 129; idx += gn) {
    const int hd = idx / 129, rel = idx - hd * 129 - 64;
    const int dil = 1 << (2 * (hd >> 1));
    const int rd = rel * dil, n = rd < 0 ? -rd : rd;
    int b;
    if (n < 8) b = n;
    else if (n < 15) b = 8; else if (n < 27) b = 9; else if (n < 50) b = 10; else if (n < 91) b = 11;
    else if (n < 166) b = 12; else if (n < 305) b = 13; else if (n < 559) b = 14; else b = 15;
    if (rd > 0) b += 16;
    p.biasT[idx] = p.rel_bias[b * 6 + hd];
  }
  for (int idx = gtid; idx < 4 * 4 * 128 * 128; idx += gn) p.SgW[idx] = f2bf(p.sgu_w[idx]);
}

DI void prologue_b(const Prm& p) {
  const int gtid = blockIdx.x * NTH + tidx(), gn = gridDim.x * NTH;
  for (int idx = gtid; idx < 4 * 17 * 6144; idx += gn) {
    const int l = idx / (17 * 6144), n = idx % 6144;
    float s = p.ada_b[l * 6144 + n];
#pragma unroll
    for (int kc = 0; kc < 8; ++kc) s += p.modpart[(size_t)kc * 4 * 17 * 6144 + idx];
    p.mod[idx] = s;
  }
}

DI void phase_norm(const Prm& p, const float* xsrc, const float* g, const float* modl, int shoff, int scoff, int sb) {
  const int tid = tidx(), lane = tid & 63;
  const int gw = blockIdx.x * 8 + (tid >> 6), nw = gridDim.x * 8;
  for (int row = gw; row < TB; row += nw) {
    const int cond = condrow(sb, row);
    const float* xr = xsrc + (size_t)row * 1024;
    float4 v[4];
    float ss = 0.f;
#pragma unroll
    for (int i = 0; i < 4; ++i) {
      v[i] = *(const float4*)(xr + i * 256 + lane * 4);
      ss += v[i].x * v[i].x + v[i].y * v[i].y + v[i].z * v[i].z + v[i].w * v[i].w;
    }
#pragma unroll
    for (int off = 32; off >= 1; off >>= 1) ss += __shfl_xor(ss, off);
    const float rstd = rsqrtf(ss * (1.f / 1024.f) + 1e-6f);
    const float* sc = modl + cond * 6144 + scoff;
    const float* sh = modl + cond * 6144 + shoff;
#pragma unroll
    for (int i = 0; i < 4; ++i) {
      const int col = i * 256 + lane * 4;
      const float4 gg = *(const float4*)(g + col), s4 = *(const float4*)(sc + col), h4 = *(const float4*)(sh + col);
      st4bf(p.hbuf + (size_t)row * 1024 + col,
            v[i].x * rstd * gg.x * (1.f + s4.x) + h4.x, v[i].y * rstd * gg.y * (1.f + s4.y) + h4.y,
            v[i].z * rstd * gg.z * (1.f + s4.z) + h4.z, v[i].w * rstd * gg.w * (1.f + s4.w) + h4.w);
    }
  }
}

DI float sigm(float x) { return __builtin_amdgcn_rcpf(1.f + __expf(-x)); }

DI void phase_inproj(const Prm& p, unsigned char* smem_raw, int l, int S, int& base) {
  const u16* W = p.WinT + (size_t)l * NWP * 1024;
  LAS u16* shm = (LAS u16*)smem_raw;
  bool pre = false;
  TASK_LOOP(t, 32 * 64, base) {
    int tn, tm;
    map256(t, 32, tn, tm);
    const int brow = tn * 256, bcol = tm * 256;
    const int tnx = t + (int)gridDim.x;
    const bool has_next = tnx < (32 * 64);
    int tn2 = 0, tm2 = 0;
    if (has_next) map256(tnx, 32, tn2, tm2);
    const int nbrow = tn2 * 256, nbcol = tm2 * 256;
    auto epi = [&](f32x4 (&acc)[2][2][4][2], int wr, int wc, int fr, int fq) __attribute__((always_inline)) {
#pragma unroll
      for (int ai = 0; ai < 2; ++ai)
#pragma unroll
        for (int m = 0; m < 4; ++m) {
          const int nb = brow + ai * 128 + wr * 64 + m * 16;
#pragma unroll
          for (int bj = 0; bj < 2; ++bj)
#pragma unroll
            for (int n = 0; n < 2; ++n) {
              const int tok = bcol + bj * 128 + wc * 32 + n * 16 + fr;
              const f32x4 v = acc[ai][bj][m][n];
              const int nn = nb + fq * 4;
              if (nb < 1536) {
#pragma unroll
                for (int j = 0; j < 4; ++j) p.UT[(size_t)(nn + j) * TBP + tok] = f2bf(v[j]);
              } else if (nb < 2688) {
                st4bf(p.bqkv + (size_t)tok * 1152 + (nn - 1536), v[0], v[1], v[2], v[3]);
              } else if (nb < 3072) {
                st4bf(p.cu + (size_t)tok * 384 + (nn - 2688), v[0], v[1], v[2], v[3]);
              } else if (nb < 3456) {
#pragma unroll
                for (int j = 0; j < 4; ++j) p.cvT[(size_t)(nn - 3072 + j) * TBP + tok] = f2bf(v[j]);
              } else if (nb < 3840) {
                st4bf(p.dcq + (size_t)tok * 384 + (nn - 3456), v[0], v[1], v[2], v[3]);
              } else if (nb < 4160) {
                st4bf(p.dckv + (size_t)tok * 320 + (nn - 3840), v[0], v[1], v[2], v[3]);
              } else if (nb < 4192) {
                if (nb == 4160) {
                  const f32x4 v2 = acc[ai][bj][(m + 1) & 3][n];
                  const int pos = tok & (S - 1);
#pragma unroll
                  for (int j = 0; j < 4; ++j) {
                    const int ii = fq * 4 + j;
                    const float2 cs = p.rope[pos * 16 + ii];
                    const u16 o1 = f2bf(v[j] * cs.x - v2[j] * cs.y), o2 = f2bf(v[j] * cs.y + v2[j] * cs.x);
#pragma unroll
                    for (int hh = 0; hh < 4; ++hh) {
                      p.kc[(size_t)tok * 384 + hh * 96 + 64 + ii] = o1;
                      p.kc[(size_t)tok * 384 + hh * 96 + 80 + ii] = o2;
                    }
                  }
                }
              } else {
                st4bf_nt(p.zg + (size_t)tok * 4096 + (nn - 4192), sigm(v[0]), sigm(v[1]), sigm(v[2]), sigm(v[3]));
              }
            }
          __builtin_amdgcn_sched_barrier(0);
        }
    };
    gemm256(shm, W, p.hbuf, 1024, brow, bcol, pre, has_next, nbrow, nbcol, epi);
    pre = has_next;
  }
  base += 32 * 64;
}

DI void phase_inproj_tail(const Prm& p, unsigned char* smem_raw, int l, int& base) {
  const u16* W = p.WinT + (size_t)l * NWP * 1024;
  u16* smem = (u16*)smem_raw;
  TASK_LOOP(t, 128, base) {
    const int n0 = 8192, m0 = t * 128;
    auto la = [&](int row, int k) __attribute__((always_inline)) { return *(const u32x4*)(W + (size_t)(n0 + row) * 1024 + k); };
    auto lb = [&](int row, int k) __attribute__((always_inline)) { return *(const u32x4*)(p.hbuf + (size_t)(m0 + row) * 1024 + k); };
    auto epi = [&](f32x16 (&acc)[2], int wm, int wn, int lane) __attribute__((always_inline)) {
      const int lr = lane & 31, lh = lane >> 5;
      const int tok = m0 + wn * 32 + lr;
#pragma unroll
      for (int i = 0; i < 2; ++i) {
        const int nb = n0 + wm * 64 + i * 32;
        if (nb >= NW) continue;
#pragma unroll
        for (int q = 0; q < 4; ++q)
          st4bf(p.zg + (size_t)tok * 4096 + (nb - 4192) + 8 * q + 4 * lh, sigm(acc[i][4 * q]), sigm(acc[i][4 * q + 1]), sigm(acc[i][4 * q + 2]),
                sigm(acc[i][4 * q + 3]));
      }
    };
    gemm_tile<false, false>(smem, 16, la, lb, epi);
  }
  base += 128;
}


DI void phase_inproj_probe(const Prm& p, unsigned char* smem_raw, int l, int& base) {
  const u16* W = p.WinT + (size_t)l * NWP * 1024;
  LAS u16* shm = (LAS u16*)smem_raw;
  bool pre = false;
  TASK_LOOP(t, 32 * 64, base) {
    int tn, tm;
    map256(t, 32, tn, tm);
    const int brow = tn * 256, bcol = tm * 256;
    const int tnx = t + (int)gridDim.x;
    const bool has_next = tnx < (32 * 64);
    int tn2 = 0, tm2 = 0;
    if (has_next) map256(tnx, 32, tn2, tm2);
    const int nbrow = tn2 * 256, nbcol = tm2 * 256;
    auto epi = [&](f32x4 (&acc)[2][2][4][2], int wr, int wc, int fr, int fq) __attribute__((always_inline)) {
#pragma unroll
      for (int bj = 0; bj < 2; ++bj)
#pragma unroll
        for (int n = 0; n < 2; ++n) {
          const int tok = bcol + bj * 128 + wc * 32 + n * 16 + fr;
#pragma unroll
          for (int ai = 0; ai < 2; ++ai)
#pragma unroll
            for (int m = 0; m < 4; ++m) {
              const int nn = ((brow + ai * 128 + wr * 64 + m * 16) & 1023) + fq * 4;
              const f32x4 v = acc[ai][bj][m][n];
              st4bf(p.Gp + (size_t)tok * 1024 + nn, v[0], v[1], v[2], v[3]);
            }
        }
    };
    gemm256(shm, W, p.hbuf, 1024, brow, bcol, pre, has_next, nbrow, nbcol, epi);
    pre = has_next;
  }
  base += 32 * 64;
}

DI void phase_fft1(const Prm& p, u16* smem, int S, int nseq, int N1, int lgN1, int& base) {
  const int nkt = N1 == 128 ? 2 : 1;
  const u16* M1 = N1 == 128 ? p.M1a : p.M1b;
  const int ldm = N1 == 128 ? 256 : 64;
  const int nk = N1 == 128 ? 4 : 1;
  const int ntask = nseq * 768 * nkt;
  const int twmul = 16384 / S;
  TASK_LOOP(t, ntask, base) {
    const int k1t = t % nkt, col = (t / nkt) % 768, seq = t / (nkt * 768);
    const int k1base = k1t * 64;
    auto la = [&](int row, int k) __attribute__((always_inline)) {
      const int k1 = k1base + (row >> 6) * 32 + (row & 31), ii = (row >> 5) & 1;
      if (k1 >= N1 || k >= 2 * N1) return zero4();
      return *(const u32x4*)(M1 + (ii * N1 + k1) * ldm + k);
    };
    auto lb = [&](int row, int k) __attribute__((always_inline)) {
      if (k >= 2 * N1) return zero4();
      const int part = k >> lgN1, s1 = k & (N1 - 1);
      const u16* src = p.UT + (size_t)(part * 768 + col) * TBP + seq * S + s1 * 128 + row;
      u32x4 v;
#pragma unroll
      for (int jj = 0; jj < 4; ++jj) v[jj] = (unsigned)src[(2 * jj) * 128] | ((unsigned)src[(2 * jj + 1) * 128] << 16);
      return v;
    };
    auto epi = [&](f32x16 (&acc)[2], int wm, int wn, int lane) __attribute__((always_inline)) {
      const int lr = lane & 31, lh = lane >> 5;
      const int s2 = wn * 32 + lr;
#pragma unroll
      for (int r = 0; r < 16; ++r) {
        const int k1 = k1base + wm * 32 + rowmap(r, lh);
        if (k1 < N1) {
          const float re = acc[0][r], im = acc[1][r];
          const float2 cs = p.tw[(s2 * k1) * twmul];
          const size_t o = ((size_t)((seq * N1 + k1) * 2) * 768 + col) * 128 + s2;
          p.Gp[o] = f2bf(cs.x * re + cs.y * im);
          p.Gp[o + 768 * 128] = f2bf(cs.x * im - cs.y * re);
        }
      }
    };
    gemm_tile<false, true>(smem, nk, la, lb, epi);
  }
  base += ntask;
}


DI void phase_fft1_small(const Prm& p, int nseq) {
  constexpr float C16[16] = {1.f, 0.92387953251128674f, 0.70710678118654752f, 0.38268343236508977f, 0.f, -0.38268343236508977f, -0.70710678118654752f,
                             -0.92387953251128674f, -1.f, -0.92387953251128674f, -0.70710678118654752f, -0.38268343236508977f, 0.f,
                             0.38268343236508977f, 0.70710678118654752f, 0.92387953251128674f};
  constexpr float S16[16] = {0.f, 0.38268343236508977f, 0.70710678118654752f, 0.92387953251128674f, 1.f, 0.92387953251128674f, 0.70710678118654752f,
                             0.38268343236508977f, 0.f, -0.38268343236508977f, -0.70710678118654752f, -0.92387953251128674f, -1.f,
                             -0.92387953251128674f, -0.70710678118654752f, -0.38268343236508977f};
  const int gtid = blockIdx.x * NTH + tidx(), gn = gridDim.x * NTH;
  for (int idx = gtid; idx < nseq * 768 * 128; idx += gn) {
    const int s2 = idx & 127, col = (idx >> 7) % 768, seq = idx / (768 * 128);
    const u16* ur = p.UT + (size_t)col * TBP + seq * 2048 + s2;
    const u16* ui = ur + (size_t)768 * TBP;
    float xr[16], xi[16];
#pragma unroll
    for (int s1 = 0; s1 < 16; ++s1) { xr[s1] = bf2f(ur[s1 * 128]); xi[s1] = bf2f(ui[s1 * 128]); }
    u16* go = p.Gp + ((size_t)(seq * 16 * 2) * 768 + col) * 128 + s2;
#pragma unroll
    for (int k1 = 0; k1 < 16; ++k1) {
      float gr = 0.f, gi = 0.f;
#pragma unroll
      for (int s1 = 0; s1 < 16; ++s1) {
        const float c = C16[(k1 * s1) & 15], sn = S16[(k1 * s1) & 15];
        gr += c * xr[s1] + sn * xi[s1];
        gi += c * xi[s1] - sn * xr[s1];
      }
      const float2 cs = p.tw[(s2 * k1) * 8];
      go[(size_t)(k1 * 2) * 768 * 128] = f2bf(cs.x * gr + cs.y * gi);
      go[(size_t)(k1 * 2 + 1) * 768 * 128] = f2bf(cs.x * gi - cs.y * gr);
    }
  }
}

DI void phase_fft2(const Prm& p, u16* smem, int S, int nseq, int N1, int& base) {
  const int ntask = nseq * N1 * 6;
  const float scale = rsqrtf((float)S * 192.f);
  u16* fa = p.UT;
  TASK_LOOP(t, ntask, base) {
    const int ct = t % 6, k1 = (t / 6) % N1, seq = t / (6 * N1);
    const u16* gb = p.Gp + ((size_t)((seq * N1 + k1) * 2) * 768 + ct * 128) * 128;
    auto la = [&](int row, int k) __attribute__((always_inline)) { return *(const u32x4*)(p.M2 + row * 256 + k); };
    auto lb = [&](int row, int k) __attribute__((always_inline)) {
      const int part = k >> 7, s2 = k & 127;
      return *(const u32x4*)(gb + ((size_t)part * 768 + row) * 128 + s2);
    };
    auto epi = [&](f32x16 (&acc)[2], int wm, int wn, int lane) __attribute__((always_inline)) {
      const int lr = lane & 31, lh = lane >> 5;
      const int col = ct * 128 + wn * 32 + lr;
#pragma unroll
      for (int i = 0; i < 2; ++i)
#pragma unroll
        for (int r = 0; r < 16; ++r) {
          const int k2 = wm * 64 + i * 32 + rowmap(r, lh);
          const int tok = seq * S + k1 + N1 * k2;
          fa[(size_t)tok * 768 + col] = f2bf(acc[i][r] * scale);
        }
    };
    gemm_tile<false, false>(smem, 4, la, lb, epi);
  }
  base += ntask;
}

DI void phase_mixc(const Prm& p, unsigned char* smem_raw, int l, int& base) {
  u16* smem = (u16*)smem_raw;
  float* st = (float*)(smem_raw + GEMM_SMEM);
  float* red = (float*)smem_raw;
  const int tid = tidx();
  TASK_LOOP(t, 512, base) {
    const int h = t & 3, ch = t >> 2, tok0 = ch * 128;
    {
      const int q = tid & 127, qf = tid >> 7;
      float s = 0.f, ss = 0.f;
      const u16* src = p.cvT + (size_t)(qf * 96) * TBP + tok0 + q;
      for (int c = 0; c < 96; ++c) { const float v = bf2f(src[(size_t)c * TBP]); s += v; ss += v * v; }
      red[qf * 256 + q * 2] = s; red[qf * 256 + q * 2 + 1] = ss;
      __syncthreads();
      if (tid < 128) {
        const float s1 = red[q * 2] + red[256 + q * 2] + red[512 + q * 2] + red[768 + q * 2];
        const float s2 = red[q * 2 + 1] + red[256 + q * 2 + 1] + red[512 + q * 2 + 1] + red[768 + q * 2 + 1];
        const float mu = s1 * (1.f / 384.f);
        const float var = fmaxf(s2 * (1.f / 384.f) - mu * mu, 0.f);
        st[q] = mu; st[128 + q] = rsqrtf(var + 1e-6f);
      }
      __syncthreads();
    }
    const u16* Wm = p.SgW + (size_t)((l * 4 + h) * 128) * 128;
    auto la = [&](int row, int k) __attribute__((always_inline)) { return *(const u32x4*)(Wm + row * 128 + k); };
    auto lb = [&](int row, int k) __attribute__((always_inline)) {
      if (row >= 96) return zero4();
      const int c = h * 96 + row;
      const u32x4 raw = *(const u32x4*)(p.cvT + (size_t)c * TBP + tok0 + k);
      const float g = p.ln_g[l * 384 + c], b = p.ln_b[l * 384 + c];
      u32x4 o;
#pragma unroll
      for (int jj = 0; jj < 4; ++jj) {
        const float v0 = (bflo(raw[jj]) - st[k + 2 * jj]) * st[128 + k + 2 * jj] * g + b;
        const float v1 = (bfhi(raw[jj]) - st[k + 2 * jj + 1]) * st[128 + k + 2 * jj + 1] * g + b;
        o[jj] = pack2(v0, v1);
      }
      return o;
    };
    auto epi = [&](f32x16 (&acc)[2], int wm, int wn, int lane) __attribute__((always_inline)) {
      const int lr = lane & 31, lh = lane >> 5;
      const int cl = wn * 32 + lr;
      if (cl < 96) {
#pragma unroll
        for (int i = 0; i < 2; ++i)
#pragma unroll
          for (int r = 0; r < 16; ++r) {
            const int pp = wm * 64 + i * 32 + rowmap(r, lh);
            const float val = acc[i][r] + p.sgu_b[(l * 4 + h) * 128 + pp];
            u16* dst = p.cu + (size_t)(tok0 + pp) * 384 + h * 96 + cl;
            *dst = f2bf(bf2f(*dst) * val);
          }
      }
    };
    gemm_tile<false, false>(smem, 2, la, lb, epi);
  }
  base += 512;
}

DI void phase_qup(const Prm& p, unsigned char* smem_raw, int l, int S, int& base) {
  u16* smem = (u16*)smem_raw;
  float* st = (float*)(smem_raw + GEMM_SMEM);
  const int tid = tidx();
  const float QS = 0.10206207261596577f * LOG2E;
  TASK_LOOP(t, 3 * 128, base) {
    const int tn = t % 3, tm = t / 3, n0 = tn * 128, m0 = tm * 128;
    {
      const int row = tid >> 2, qf = tid & 3;
      const u16* src = p.dcq + (size_t)(m0 + row) * 384 + qf * 96;
      float ss = 0.f;
#pragma unroll 4
      for (int c = 0; c < 12; ++c) {
        const u32x4 v = *(const u32x4*)(src + c * 8);
#pragma unroll
        for (int jj = 0; jj < 4; ++jj) { const float a = bflo(v[jj]), b = bfhi(v[jj]); ss += a * a + b * b; }
      }
      ss += __shfl_xor(ss, 1);
      ss += __shfl_xor(ss, 2);
      if (qf == 0) st[row] = rsqrtf(ss * (1.f / 384.f) + 1e-6f);
      __syncthreads();
    }
    const u16* W = p.WqT + (size_t)l * 384 * 384;
    auto la = [&](int row, int k) __attribute__((always_inline)) { return *(const u32x4*)(W + (size_t)(n0 + row) * 384 + k); };
    auto lb = [&](int row, int k) __attribute__((always_inline)) { return *(const u32x4*)(p.dcq + (size_t)(m0 + row) * 384 + k); };
    auto epi = [&](f32x16 (&acc)[2], int wm, int wn, int lane) __attribute__((always_inline)) {
      const int lr = lane & 31, lh = lane >> 5;
      const int tokl = wn * 32 + lr, tok = m0 + tokl;
      const float sc = st[tokl] * QS;
#pragma unroll
      for (int i = 0; i < 2; ++i) {
        const int nb = n0 + wm * 64 + i * 32;
        const int head = nb / 96, within = nb - head * 96;
        const f32x16& a = acc[i];
        if (within < 64) {
#pragma unroll
          for (int q = 0; q < 4; ++q)
            st4bf(p.qc + (size_t)tok * 384 + nb + 8 * q + 4 * lh, a[4 * q] * sc, a[4 * q + 1] * sc, a[4 * q + 2] * sc, a[4 * q + 3] * sc);
        } else {
          const int pos = tok & (S - 1);
#pragma unroll
          for (int q = 0; q < 2; ++q)
#pragma unroll
            for (int e = 0; e < 4; ++e) {
              const int r = 4 * q + e, ii = 8 * q + 4 * lh + e;
              const float2 cs = p.rope[pos * 16 + ii];
              const float x1 = a[r] * sc, x2 = a[r + 8] * sc;
              p.qc[(size_t)tok * 384 + head * 96 + 64 + ii] = f2bf(x1 * cs.x - x2 * cs.y);
              p.qc[(size_t)tok * 384 + head * 96 + 80 + ii] = f2bf(x1 * cs.y + x2 * cs.x);
            }
        }
      }
    };
    gemm_tile<false, false>(smem, 6, la, lb, epi);
    __syncthreads();
  }
  base += 3 * 128;
}

DI void phase_kvup(const Prm& p, unsigned char* smem_raw, int l, int& base) {
  u16* smem = (u16*)smem_raw;
  float* st = (float*)(smem_raw + GEMM_SMEM);
  const int tid = tidx();
  TASK_LOOP(t, 4 * 128, base) {
    const int tn = t & 3, tm = t >> 2, n0 = tn * 128, m0 = tm * 128;
    {
      const int row = tid >> 2, qf = tid & 3;
      const u16* src = p.dckv + (size_t)(m0 + row) * 320 + qf * 80;
      float ss = 0.f;
#pragma unroll 5
      for (int c = 0; c < 10; ++c) {
        const u32x4 v = *(const u32x4*)(src + c * 8);
#pragma unroll
        for (int jj = 0; jj < 4; ++jj) { const float a = bflo(v[jj]), b = bfhi(v[jj]); ss += a * a + b * b; }
      }
      ss += __shfl_xor(ss, 1);
      ss += __shfl_xor(ss, 2);
      if (qf == 0) st[row] = rsqrtf(ss * (1.f / 320.f) + 1e-6f);
      __syncthreads();
    }
    const u16* W = p.WkvT + (size_t)l * 512 * 320;
    auto la = [&](int row, int k) __attribute__((always_inline)) { return *(const u32x4*)(W + (size_t)(n0 + row) * 320 + k); };
    auto lb = [&](int row, int k) __attribute__((always_inline)) { return *(const u32x4*)(p.dckv + (size_t)(m0 + row) * 320 + k); };
    auto epi = [&](f32x16 (&acc)[2], int wm, int wn, int lane) __attribute__((always_inline)) {
      const int lr = lane & 31, lh = lane >> 5;
      const int head = tn;
      const int tokl = wn * 32 + lr, tok = m0 + tokl;
      const float sc = st[tokl];
#pragma unroll
      for (int i = 0; i < 2; ++i) {
        const int within = wm * 64 + i * 32;
        const f32x16& a = acc[i];
        if (within < 64) {
#pragma unroll
          for (int q = 0; q < 4; ++q)
            st4bf(p.kc + (size_t)tok * 384 + head * 96 + within + 8 * q + 4 * lh, a[4 * q] * sc, a[4 * q + 1] * sc, a[4 * q + 2] * sc, a[4 * q + 3] * sc);
        } else {
#pragma unroll
          for (int r = 0; r < 16; ++r)
            p.vT[(size_t)(head * 64 + within - 64 + rowmap(r, lh)) * TBP + tok] = f2bf(a[r] * sc);
        }
      }
    };
    gemm_tile<false, false>(smem, 5, la, lb, epi);
    __syncthreads();
  }
  base += 4 * 128;
}

DI void phase_mixb(const Prm& p, unsigned char* smem_raw, int S, int lgS, int& base) {
  float* bt = (float*)smem_raw;
  const int tid = tidx(), lane = tid & 63, wave = tid >> 6, lr = lane & 31, lh = lane >> 5;
  u16* vt = (u16*)(smem_raw + 3328) + wave * (64 * 40);
  for (int idx = tid; idx < 774; idx += NTH) bt[idx] = p.biasT[idx];
  __syncthreads();
  TASK_LOOP(t, 384, base) {
    const int wt = t * 8 + wave;
    const int hg = wt & 1, g = (wt >> 1) % 3, blk = wt / 6;
    const int seq = blk >> (lgS - 5), b_in = blk & ((S >> 5) - 1);
    const int lgd = 2 * g, L = S >> lgd;
    const int lgbpr = lgS - lgd - 5;
    const int res = b_in >> lgbpr, i0 = (b_in & ((1 << lgbpr) - 1)) << 5;
    const int tokbase = seq * S + res;
    const int hd = g * 2 + hg, hc = hd * 64;
    const int qi = i0 + lr;
    const int qtok = tokbase + (qi << lgd);
    bf16x8 qf[4];
#pragma unroll
    for (int ks = 0; ks < 4; ++ks) qf[ks] = *(const bf16x8*)(p.bqkv + (size_t)qtok * 1152 + hc + ks * 16 + lh * 8);
    f32x16 sc[5];
#pragma unroll
    for (int tt = 0; tt < 5; ++tt) {
      int ik = i0 - 64 + 32 * tt + lr;
      ik = min(max(ik, 0), L - 1);
      const u16* kp = p.bqkv + (size_t)(tokbase + (ik << lgd)) * 1152 + 384 + hc + lh * 8;
      sc[tt] = zero16();
#pragma unroll
      for (int ks = 0; ks < 4; ++ks) sc[tt] = mfma(*(const bf16x8*)(kp + ks * 16), qf[ks], sc[tt]);
    }
    float mx = -1e30f;
#pragma unroll
    for (int tt = 0; tt < 5; ++tt)
#pragma unroll
      for (int r = 0; r < 16; ++r) {
        const int ik = i0 - 64 + 32 * tt + rowmap(r, lh);
        const int rel = ik - qi;
        const bool valid = (rel >= -64) && (rel <= 64) && (ik >= 0) && (ik < L);
        const int bi = min(max(rel + 64, 0), 128);
        const float s = valid ? (sc[tt][r] * 0.125f + bt[hd * 129 + bi]) * LOG2E : -1e30f;
        sc[tt][r] = s;
        mx = fmaxf(mx, s);
      }
    mx = fmaxf(mx, __shfl_xor(mx, 32));
    float sum = 0.f;
#pragma unroll
    for (int tt = 0; tt < 5; ++tt)
#pragma unroll
      for (int r = 0; r < 16; ++r) {
        const float pv = ex2(sc[tt][r] - mx);
        sum += pv;
        sc[tt][r] = pv;
      }
    sum += __shfl_xor(sum, 32);
    f32x16 oacc[2];
    oacc[0] = zero16(); oacc[1] = zero16();
#pragma unroll
    for (int tt = 0; tt < 5; ++tt) {
#pragma unroll
      for (int e = 0; e < 4; ++e) {
        const int c = lane + 64 * e, key = c >> 3, dch = c & 7;
        int ik = i0 - 64 + 32 * tt + key;
        ik = min(max(ik, 0), L - 1);
        const u32x4 raw = *(const u32x4*)(p.bqkv + (size_t)(tokbase + (ik << lgd)) * 1152 + 768 + hc + dch * 8);
#pragma unroll
        for (int jj = 0; jj < 4; ++jj) {
          vt[(dch * 8 + 2 * jj) * 40 + key] = (u16)(raw[jj] & 0xffffu);
          vt[(dch * 8 + 2 * jj + 1) * 40 + key] = (u16)(raw[jj] >> 16);
        }
      }
      __syncthreads();
#pragma unroll
      for (int u = 0; u < 2; ++u) {
        u32x4 pk;
#pragma unroll
        for (int jj = 0; jj < 4; ++jj) pk[jj] = pack2(sc[tt][8 * u + 2 * jj], sc[tt][8 * u + 2 * jj + 1]);
        const bf16x8 pf = __builtin_bit_cast(bf16x8, pk);
#pragma unroll
        for (int dt = 0; dt < 2; ++dt) {
          const u16* vp = vt + (dt * 32 + lr) * 40 + 16 * u + 4 * lh;
          u32x4 vv;
          const u32x2 lo = *(const u32x2*)vp, hi = *(const u32x2*)(vp + 8);
          vv[0] = lo[0]; vv[1] = lo[1]; vv[2] = hi[0]; vv[3] = hi[1];
          oacc[dt] = mfma(__builtin_bit_cast(bf16x8, vv), pf, oacc[dt]);
        }
      }
      __syncthreads();
    }
    const float inv = 1.f / sum;
#pragma unroll
    for (int dt = 0; dt < 2; ++dt)
#pragma unroll
      for (int q = 0; q < 4; ++q) {
        float4 o;
        o.x = oacc[dt][4 * q] * inv; o.y = oacc[dt][4 * q + 1] * inv; o.z = oacc[dt][4 * q + 2] * inv; o.w = oacc[dt][4 * q + 3] * inv;
        *(float4*)(p.og + (size_t)qtok * 384 + hc + dt * 32 + 8 * q + 4 * lh) = o;
      }
    if (lh == 0) p.lse[(size_t)qtok * 6 + hd] = (mx + __log2f(sum)) * LN2;
  }
  base += 384;
  __syncthreads();
}

DI void phase_combb(const Prm& p) {
  const int gtid = blockIdx.x * NTH + tidx(), gn = gridDim.x * NTH;
  for (int idx = gtid; idx < TB * 32; idx += gn) {
    const int dq = idx & 15, hg = (idx >> 4) & 1, tok = idx >> 5;
    const float l0 = p.lse[(size_t)tok * 6 + hg], l1 = p.lse[(size_t)tok * 6 + 2 + hg], l2 = p.lse[(size_t)tok * 6 + 4 + hg];
    const float mx = fmaxf(l0, fmaxf(l1, l2));
    const float e0 = __expf(l0 - mx), e1 = __expf(l1 - mx), e2 = __expf(l2 - mx);
    const float inv = 1.f / (e0 + e1 + e2);
    const float4 a = *(const float4*)(p.og + (size_t)tok * 384 + hg * 64 + dq * 4);
    const float4 b = *(const float4*)(p.og + (size_t)tok * 384 + 128 + hg * 64 + dq * 4);
    const float4 c = *(const float4*)(p.og + (size_t)tok * 384 + 256 + hg * 64 + dq * 4);
    st4bf(p.ob + (size_t)tok * 128 + hg * 64 + dq * 4, (e0 * a.x + e1 * b.x + e2 * c.x) * inv, (e0 * a.y + e1 * b.y + e2 * c.y) * inv,
          (e0 * a.z + e1 * b.z + e2 * c.z) * inv, (e0 * a.w + e1 * b.w + e2 * c.w) * inv);
  }
}

constexpr int KS_ELEMS = 128 * 104, VS_ELEMS = 64 * 136;
DI void phase_mla(const Prm& p, unsigned char* smem_raw, int S, int lgS, int& base) {
  u16* Ks = (u16*)smem_raw;
  u16* Vs = Ks + 2 * KS_ELEMS;
  const int tid = tidx(), lane = tid & 63, wave = tid >> 6, lr = lane & 31, lh = lane >> 5;
  const int nkt = S >> 7;
  TASK_LOOP(t, 256, base) {
    const int head = t & 3, qb = t >> 2, tok0 = qb * 256;
    const int seqtok0 = (tok0 >> lgS) << lgS;
    const int qtok = tok0 + wave * 32 + lr;
    bf16x8 qf[6];
#pragma unroll
    for (int ks = 0; ks < 6; ++ks) qf[ks] = *(const bf16x8*)(p.qc + (size_t)qtok * 384 + head * 96 + ks * 16 + lh * 8);
    const u16* kbase = p.kc + (size_t)seqtok0 * 384 + head * 96;
    const u16* vbase = p.vT + (size_t)(head * 64) * TBP + seqtok0;
    u32x4 rk[3], rv[2];
    auto gload = [&](int kt) __attribute__((always_inline)) {
#pragma unroll
      for (int e = 0; e < 3; ++e) {
        const int c = tid + NTH * e, key = c / 12, dc = c - key * 12;
        rk[e] = *(const u32x4*)(kbase + (size_t)(kt * 128 + key) * 384 + dc * 8);
      }
#pragma unroll
      for (int e = 0; e < 2; ++e) {
        const int c = tid + NTH * e, d = c >> 4, kch = c & 15;
        rv[e] = *(const u32x4*)(vbase + (size_t)d * TBP + kt * 128 + kch * 8);
      }
    };
    auto sstore = [&](int buf) __attribute__((always_inline)) {
#pragma unroll
      for (int e = 0; e < 3; ++e) {
        const int c = tid + NTH * e, key = c / 12, dc = c - key * 12;
        *(u32x4*)(Ks + buf * KS_ELEMS + key * 104 + dc * 8) = rk[e];
      }
#pragma unroll
      for (int e = 0; e < 2; ++e) {
        const int c = tid + NTH * e, d = c >> 4, kch = c & 15;
        u16* vd = Vs + buf * VS_ELEMS + d * 136 + (kch >> 1) * 16 + (kch & 1) * 4;
        u32x2 lo, hi;
        lo[0] = rv[e][0]; lo[1] = rv[e][1]; hi[0] = rv[e][2]; hi[1] = rv[e][3];
        *(u32x2*)vd = lo;
        *(u32x2*)(vd + 8) = hi;
      }
    };
    float m = -1e30f;
    f32x2 lsum2 = {0.f, 0.f};
    f32x16 oacc[2];
    oacc[0] = zero16(); oacc[1] = zero16();
    gload(0);
    sstore(0);
    __syncthreads();
    for (int kt = 0; kt < nkt; ++kt) {
      const int buf = kt & 1;
      if (kt + 1 < nkt) gload(kt + 1);
      f32x16 s[4];
#pragma unroll
      for (int kk = 0; kk < 4; ++kk) s[kk] = zero16();
      {
        const u16* kp = Ks + buf * KS_ELEMS + lr * 104 + lh * 8;
        bf16x8 kf[4];
#pragma unroll
        for (int kk = 0; kk < 4; ++kk) kf[kk] = *(const bf16x8*)(kp + kk * 32 * 104);
#pragma unroll
        for (int ks = 0; ks < 6; ++ks) {
          bf16x8 kn[4];
          if (ks < 5) {
#pragma unroll
            for (int kk = 0; kk < 4; ++kk) kn[kk] = *(const bf16x8*)(kp + kk * 32 * 104 + (ks + 1) * 16);
          }
#pragma unroll
          for (int kk = 0; kk < 4; ++kk) s[kk] = mfma(kf[kk], qf[ks], s[kk]);
          if (ks < 5) {
#pragma unroll
            for (int kk = 0; kk < 4; ++kk) kf[kk] = kn[kk];
          }
        }
      }
      float mloc = -1e30f;
#pragma unroll
      for (int kk = 0; kk < 4; ++kk)
#pragma unroll
        for (int r = 0; r < 16; ++r) mloc = fmaxf(mloc, s[kk][r]);
      mloc = fmaxf(mloc, __shfl_xor(mloc, 32));
      const float mnew = fmaxf(m, mloc);
      const float alpha = ex2(m - mnew);
      m = mnew;
      lsum2 *= alpha;
      const f32x2 mn2 = {mnew, mnew};
#pragma unroll
      for (int kk = 0; kk < 4; ++kk)
#pragma unroll
        for (int r2 = 0; r2 < 8; ++r2) {
          f32x2 v = {s[kk][2 * r2], s[kk][2 * r2 + 1]};
          v = v - mn2;
          f32x2 pv;
          pv[0] = ex2(v[0]); pv[1] = ex2(v[1]);
          lsum2 += pv;
          s[kk][2 * r2] = pv[0]; s[kk][2 * r2 + 1] = pv[1];
        }
#pragma unroll
      for (int dt = 0; dt < 2; ++dt)
#pragma unroll
        for (int r = 0; r < 16; ++r) oacc[dt][r] *= alpha;
#pragma unroll
      for (int kk = 0; kk < 4; ++kk)
#pragma unroll
        for (int u = 0; u < 2; ++u) {
          u32x4 pk;
#pragma unroll
          for (int jj = 0; jj < 4; ++jj) pk[jj] = pack2(s[kk][8 * u + 2 * jj], s[kk][8 * u + 2 * jj + 1]);
          const bf16x8 pf = __builtin_bit_cast(bf16x8, pk);
#pragma unroll
          for (int dt = 0; dt < 2; ++dt) {
            const u16* vp = Vs + buf * VS_ELEMS + (dt * 32 + lr) * 136 + kk * 32 + 16 * u + 8 * lh;
            oacc[dt] = mfma(*(const bf16x8*)vp, pf, oacc[dt]);
          }
        }
      if (kt + 1 < nkt) sstore(buf ^ 1);
      __syncthreads();
    }
    float lsum = lsum2[0] + lsum2[1];
    lsum += __shfl_xor(lsum, 32);
    const float inv = 1.f / lsum;
#pragma unroll
    for (int dt = 0; dt < 2; ++dt)
#pragma unroll
      for (int q = 0; q < 4; ++q)
        st4bf(p.od + (size_t)qtok * 256 + head * 64 + dt * 32 + 8 * q + 4 * lh, oacc[dt][4 * q] * inv, oacc[dt][4 * q + 1] * inv,
              oacc[dt][4 * q + 2] * inv, oacc[dt][4 * q + 3] * inv);
  }
  base += 256;
}

template <class ACC>
DI void merge_branch(const Prm& p, u16* smem, const u16* W, const u16* X, int ld, int bi, int n0, int m0, ACC& macc) {
  auto la = [&](int row, int k) __attribute__((always_inline)) { return *(const u32x4*)(W + (size_t)(n0 + row) * ld + k); };
  auto lb = [&](int row, int k) __attribute__((always_inline)) { return *(const u32x4*)(X + (size_t)(m0 + row) * ld + k); };
  auto epi = [&](f32x16 (&acc)[2], int wm, int wn, int lane) __attribute__((always_inline)) {
    const int lr = lane & 31, lh = lane >> 5;
    const int tok = m0 + wn * 32 + lr;
#pragma unroll
    for (int i = 0; i < 2; ++i)
#pragma unroll
      for (int q = 0; q < 4; ++q) {
        const int n = n0 + wm * 64 + i * 32 + 8 * q + 4 * lh;
        const u32x2 gz = *(const u32x2*)(p.zg + (size_t)tok * 4096 + bi * 1024 + n);
        macc[i][4 * q] += bflo(gz[0]) * acc[i][4 * q];
        macc[i][4 * q + 1] += bfhi(gz[0]) * acc[i][4 * q + 1];
        macc[i][4 * q + 2] += bflo(gz[1]) * acc[i][4 * q + 2];
        macc[i][4 * q + 3] += bfhi(gz[1]) * acc[i][4 * q + 3];
      }
  };
  gemm_tile<false, false>(smem, ld >> 6, la, lb, epi);
}

DI void phase_merge(const Prm& p, u16* smem, int l, int& base) {
  TASK_LOOP(t, 8 * 128, base) {
    const int tn = t & 7, tm = t >> 3, n0 = tn * 128, m0 = tm * 128;
    f32x16 macc[2];
    macc[0] = zero16(); macc[1] = zero16();
    merge_branch(p, smem, p.PaT + (size_t)l * 1024 * 768, p.UT, 768, 0, n0, m0, macc);
    merge_branch(p, smem, p.PbT + (size_t)l * 1024 * 128, p.ob, 128, 1, n0, m0, macc);
    merge_branch(p, smem, p.PcT + (size_t)l * 1024 * 384, p.cu, 384, 2, n0, m0, macc);
    merge_branch(p, smem, p.PdT + (size_t)l * 1024 * 256, p.od, 256, 3, n0, m0, macc);
    const int tid2 = tidx(), lane = tid2 & 63, wave = tid2 >> 6, wm = wave >> 2, wn = wave & 3, lr = lane & 31, lh = lane >> 5;
    const int tok = m0 + wn * 32 + lr;
#pragma unroll
    for (int i = 0; i < 2; ++i)
#pragma unroll
      for (int q = 0; q < 4; ++q)
        st4bf(p.hbuf + (size_t)tok * 1024 + n0 + wm * 64 + i * 32 + 8 * q + 4 * lh, macc[i][4 * q], macc[i][4 * q + 1],
              macc[i][4 * q + 2], macc[i][4 * q + 3]);
  }
  base += 8 * 128;
}

DI void phase_resid_gemm(const Prm& p, unsigned char* smem_raw, const u16* W, const u16* X, int K, const float* xsrc, float* xdst,
                         const float* modl, int gtoff, int sb, int& base) {
  LAS u16* shm = (LAS u16*)smem_raw;
  bool pre = false;
  TASK_LOOP(t, 4 * 64, base) {
    int tn, tm;
    map256(t, 4, tn, tm);
    const int brow = tn * 256, bcol = tm * 256;
    const int tnx = t + (int)gridDim.x;
    const bool has_next = tnx < (4 * 64);
    int tn2 = 0, tm2 = 0;
    if (has_next) map256(tnx, 4, tn2, tm2);
    const int nbrow = tn2 * 256, nbcol = tm2 * 256;
    auto epi = [&](f32x4 (&acc)[2][2][4][2], int wr, int wc, int fr, int fq) __attribute__((always_inline)) {
#pragma unroll
      for (int bj = 0; bj < 2; ++bj)
#pragma unroll
        for (int n = 0; n < 2; ++n) {
          const int tok = bcol + bj * 128 + wc * 32 + n * 16 + fr;
          const float* gt = modl + condrow(sb, tok) * 6144 + gtoff;
#pragma unroll
          for (int ai = 0; ai < 2; ++ai)
#pragma unroll
            for (int m = 0; m < 4; ++m) {
              const int nn = brow + ai * 128 + wr * 64 + m * 16 + fq * 4;
              const f32x4 v = acc[ai][bj][m][n];
              const float4 g4 = *(const float4*)(gt + nn);
              const float4 xi = *(const float4*)(xsrc + (size_t)tok * 1024 + nn);
              float4 o;
              o.x = xi.x + g4.x * v[0]; o.y = xi.y + g4.y * v[1]; o.z = xi.z + g4.z * v[2]; o.w = xi.w + g4.w * v[3];
              *(float4*)(xdst + (size_t)tok * 1024 + nn) = o;
            }
        }
    };
    gemm256(shm, W, X, K, brow, bcol, pre, has_next, nbrow, nbcol, epi);
    pre = has_next;
  }
  base += 4 * 64;
}

DI void phase_w1(const Prm& p, unsigned char* smem_raw, int l, int& base) {
  const u16* W = p.W1T + (size_t)l * 4096 * 1024;
  LAS u16* shm = (LAS u16*)smem_raw;
  bool pre = false;
  TASK_LOOP(t, 16 * 64, base) {
    int tn, tm;
    map256(t, 16, tn, tm);
    const int brow = tn * 256, bcol = tm * 256;
    const int tnx = t + (int)gridDim.x;
    const bool has_next = tnx < (16 * 64);
    int tn2 = 0, tm2 = 0;
    if (has_next) map256(tnx, 16, tn2, tm2);
    const int nbrow = tn2 * 256, nbcol = tm2 * 256;
    auto epi = [&](f32x4 (&acc)[2][2][4][2], int wr, int wc, int fr, int fq) __attribute__((always_inline)) {
#pragma unroll
      for (int bj = 0; bj < 2; ++bj)
#pragma unroll
        for (int n = 0; n < 2; ++n) {
          const int tok = bcol + bj * 128 + wc * 32 + n * 16 + fr;
#pragma unroll
          for (int ai = 0; ai < 2; ++ai)
#pragma unroll
            for (int m = 0; m < 4; ++m) {
              const int nn = brow + ai * 128 + wr * 64 + m * 16 + fq * 4;
              const f32x4 v = acc[ai][bj][m][n];
              const float a0 = fmaxf(v[0], 0.f), a1 = fmaxf(v[1], 0.f), a2 = fmaxf(v[2], 0.f), a3 = fmaxf(v[3], 0.f);
              st4bf(p.zg + (size_t)tok * 4096 + nn, a0 * a0, a1 * a1, a2 * a2, a3 * a3);
            }
        }
    };
    gemm256(shm, W, p.hbuf, 1024, brow, bcol, pre, has_next, nbrow, nbcol, epi);
    pre = has_next;
  }
  base += 16 * 64;
}

DI void phase_final(const Prm& p) {
  const int tid = tidx(), lane = tid & 63;
  const int gw = blockIdx.x * 8 + (tid >> 6), nw = gridDim.x * 8;
  for (int row = gw; row < 3 * TB; row += nw) {
    float* xr = p.out + (size_t)row * 1024;
    float4 v[4];
    float ss = 0.f;
#pragma unroll
    for (int i = 0; i < 4; ++i) {
      v[i] = *(const float4*)(xr + i * 256 + lane * 4);
      ss += v[i].x * v[i].x + v[i].y * v[i].y + v[i].z * v[i].z + v[i].w * v[i].w;
    }
#pragma unroll
    for (int off = 32; off >= 1; off >>= 1) ss += __shfl_xor(ss, off);
    const float rstd = rsqrtf(ss * (1.f / 1024.f) + 1e-6f);
#pragma unroll
    for (int i = 0; i < 4; ++i) {
      const int col = i * 256 + lane * 4;
      const float4 gg = *(const float4*)(p.final_g + col);
      float4 o;
      o.x = v[i].x * rstd * gg.x; o.y = v[i].y * rstd * gg.y; o.z = v[i].z * rstd * gg.z; o.w = v[i].w * rstd * gg.w;
      *(float4*)(xr + col) = o;
    }
  }
}

__global__ void __launch_bounds__(512) mega(Prm p) {
  cg::grid_group grid = cg::this_grid();
  __shared__ __attribute__((aligned(16))) unsigned char smem_raw[SMEM_BYTES];
  __shared__ uint4 xb_words;
  u16* smem = (u16*)smem_raw;
  if (threadIdx.x == 0) xb_words = make_uint4(0u, 0u, 0u, 0u);
  __syncthreads();
  const XcdBarrier xb = xcd_barrier_post(p.bar, (volatile LAS unsigned*)&xb_words);
  int base = 0;
  prologue_a(p, smem_raw, base);
  if (PROBE == 11) prologue_a(p, smem_raw, base);
  grid.sync();
  prologue_b(p);
  xcd_barrier(xb);
  for (int sb = 0; sb < 3; ++sb) {
    const int S = sb == 0 ? 16384 : 2048, lgS = sb == 0 ? 14 : 11, nseq = sb == 0 ? 1 : 8;
    const int N1 = S >> 7, lgN1 = lgS - 7;
    const float* xin = sb == 0 ? p.x_prompt : p.x_sample + (size_t)(sb - 1) * TB * 1024;
    float* xo = p.out + (size_t)sb * TB * 1024;
    for (int l = 0; l < 4; ++l) {
      const float* xs = l == 0 ? xin : xo;
      const float* modl = p.mod + (size_t)l * 17 * 6144;
      phase_norm(p, xs, p.norm1_g + l * 1024, modl, 0, 1024, sb);
      xcd_barrier(xb);
      phase_inproj(p, smem_raw, l, S, base);
      if (PROBE == 2 || PROBE == 7) phase_inproj(p, smem_raw, l, S, base);
      if (PROBE == 12) phase_inproj_probe(p, smem_raw, l, base);
      xcd_barrier(xb);
      if (PROBE == 5) xcd_barrier(xb);
      if (N1 == 16) phase_fft1_small(p, nseq); else phase_fft1(p, smem, S, nseq, N1, lgN1, base);
      phase_mixb(p, smem_raw, S, lgS, base);
      phase_mixc(p, smem_raw, l, base);
      phase_qup(p, smem_raw, l, S, base);
      phase_kvup(p, smem_raw, l, base);
      phase_inproj_tail(p, smem_raw, l, base);
      if (PROBE == 13) phase_fft1(p, smem, S, nseq, N1, lgN1, base);
      if (PROBE == 14) phase_mixb(p, smem_raw, S, lgS, base);
      if (PROBE == 15) { phase_qup(p, smem_raw, l, S, base); phase_kvup(p, smem_raw, l, base); phase_inproj_tail(p, smem_raw, l, base); }
      if (PROBE == 4) { phase_fft1(p, smem, S, nseq, N1, lgN1, base); phase_mixb(p, smem_raw, S, lgS, base); phase_qup(p, smem_raw, l, S, base); phase_kvup(p, smem_raw, l, base); }
      xcd_barrier(xb);
      if (PROBE == 5) xcd_barrier(xb);
      phase_mla(p, smem_raw, S, lgS, base);
      if (PROBE == 1) phase_mla(p, smem_raw, S, lgS, base);
      phase_fft2(p, smem, S, nseq, N1, base);
      phase_combb(p);
      if (PROBE == 6) { phase_fft2(p, smem, S, nseq, N1, base); phase_combb(p); }
      xcd_barrier(xb);
      if (PROBE == 5) xcd_barrier(xb);
      phase_merge(p, smem, l, base);
      if (PROBE == 3) phase_merge(p, smem, l, base);
      xcd_barrier(xb);
      if (PROBE == 5) xcd_barrier(xb);
      phase_resid_gemm(p, smem_raw, p.WoT + (size_t)l * 1024 * 1024, p.hbuf, 1024, xs, xo, modl, 2048, sb, base);
      xcd_barrier(xb);
      phase_norm(p, xo, p.norm2_g + l * 1024, modl, 3072, 4096, sb);
      if (PROBE == 9) { phase_norm(p, xo, p.norm2_g + l * 1024, modl, 3072, 4096, sb); phase_norm(p, xo, p.norm2_g + l * 1024, modl, 3072, 4096, sb); }
      xcd_barrier(xb);
      phase_w1(p, smem_raw, l, base);
      if (PROBE == 2 || PROBE == 8) phase_w1(p, smem_raw, l, base);
      xcd_barrier(xb);
      if (PROBE == 5) xcd_barrier(xb);
      phase_resid_gemm(p, smem_raw, p.W2T + (size_t)l * 1024 * 4096, p.zg, 4096, xo, xo, modl, 5120, sb, base);
      xcd_barrier(xb);
    }
  }
  phase_final(p);
}

extern "C" void kernel_launch(void* const* d_in, const int* in_sizes, int n_in, void* d_out, int out_size, void* d_ws, size_t ws_size,
                              hipStream_t stream) {
  Prm p{};
  const float* const* in = (const float* const*)d_in;
  p.x_prompt = in[0]; p.x_sample = in[1]; p.c_prompt = in[2]; p.c_sample = in[3]; p.rel_bias = in[4]; p.ada_w = in[5]; p.ada_b = in[6];
  p.norm1_g = in[7]; p.w_in = in[8]; p.qn_g = in[9]; p.kvn_g = in[10]; p.w_uq = in[11]; p.w_ukv = in[12]; p.ln_g = in[13]; p.ln_b = in[14];
  p.sgu_w = in[15]; p.sgu_b = in[16]; p.p_a = in[17]; p.p_b = in[18]; p.p_c = in[19]; p.p_d = in[20]; p.w_o = in[21]; p.norm2_g = in[22];
  p.w1 = in[23]; p.w2 = in[24]; p.final_g = in[25];
  p.out = (float*)d_out;
  char* w = (char*)d_ws;
  size_t off = 0;
  auto take = [&](size_t bytes) __attribute__((always_inline)) { void* r = w + off; off += (bytes + 255) & ~(size_t)255; return r; };
  p.WinT = (u16*)take((size_t)4 * NWP * 1024 * 2);
  p.W1T = (u16*)take((size_t)4 * 4096 * 1024 * 2);
  p.W2T = (u16*)take((size_t)4 * 4096 * 1024 * 2);
  p.WoT = (u16*)take((size_t)4 * 1024 * 1024 * 2);
  p.PaT = (u16*)take((size_t)4 * 1024 * 768 * 2);
  p.PbT = (u16*)take((size_t)4 * 1024 * 128 * 2);
  p.PcT = (u16*)take((size_t)4 * 1024 * 384 * 2);
  p.PdT = (u16*)take((size_t)4 * 1024 * 256 * 2);
  p.WqT = (u16*)take((size_t)4 * 384 * 384 * 2);
  p.WkvT = (u16*)take((size_t)4 * 512 * 320 * 2);
  p.SgW = (u16*)take((size_t)4 * 4 * 128 * 128 * 2);
  p.M1a = (u16*)take(256 * 256 * 2);
  p.M1b = (u16*)take(32 * 64 * 2);
  p.M2 = (u16*)take(128 * 256 * 2);
  p.tw = (float2*)take(16384 * 8);
  p.rope = (float2*)take((size_t)16384 * 16 * 8);
  p.biasT = (float*)take(6 * 129 * 4);
  p.mod = (float*)take((size_t)4 * 17 * 6144 * 4);
  p.hbuf = (u16*)take((size_t)TB * 1024 * 2);
  p.og = (float*)take((size_t)TB * 384 * 4);
  p.UT = (u16*)take((size_t)1536 * TBP * 2);
  p.Gp = (u16*)take((size_t)1536 * TB * 2);
  p.bqkv = (u16*)take((size_t)TB * 1152 * 2);
  p.ob = (u16*)take((size_t)TB * 128 * 2);
  p.cu = (u16*)take((size_t)TB * 384 * 2);
  p.cvT = (u16*)take((size_t)TBP * 384 * 2);
  p.dcq = (u16*)take((size_t)TB * 384 * 2);
  p.dckv = (u16*)take((size_t)TB * 320 * 2);
  p.qc = (u16*)take((size_t)TB * 384 * 2);
  p.kc = (u16*)take((size_t)TB * 384 * 2);
  p.vT = (u16*)take((size_t)TBP * 256 * 2);
  p.od = (u16*)take((size_t)TB * 256 * 2);
  p.lse = (float*)take((size_t)TB * 6 * 4);
  p.zg = (u16*)take((size_t)TB * 4096 * 2);
  p.bar = (unsigned*)take(XCD_BAR_WORDS * 4);
  p.modpart = (float*)p.zg;
  if (off > ws_size) { fprintf(stderr, "workspace too small: need %zu have %zu\n", off, ws_size); return; }
  static int grid_blocks = 0;
  if (!grid_blocks) {
    int dev = 0, cus = 0, per_cu = 0;
    (void)hipGetDevice(&dev);
    (void)hipDeviceGetAttribute(&cus, hipDeviceAttributeMultiprocessorCount, dev);
    (void)hipOccupancyMaxActiveBlocksPerMultiprocessor(&per_cu, mega, NTH, 0);
    if (per_cu < 1) per_cu = 1;
    if (per_cu > 1) per_cu = 1;
    grid_blocks = cus * per_cu;
  }
  (void)hipMemsetAsync(p.bar, 0, XCD_BAR_WORDS * 4, stream);
  void* args[] = {&p};
  hipError_t e = hipLaunchCooperativeKernel((void*)mega, dim3(grid_blocks), dim3(NTH), args, 0, stream);
  if (e != hipSuccess) fprintf(stderr, "cooperative launch failed: %s (grid %d)\n", hipGetErrorString(e), grid_blocks);
}
```

```cpp
#include <hip/hip_runtime.h>
#include <hip/hip_cooperative_groups.h>
#include <stdint.h>
#include <stdio.h>
namespace cg = cooperative_groups;

#define DI __device__ __forceinline__
#define LAS __attribute__((address_space(3)))
typedef unsigned short u16;
typedef __attribute__((ext_vector_type(8))) short bf16x8;
typedef __attribute__((ext_vector_type(4))) short bf16x4;
typedef __attribute__((ext_vector_type(16))) float f32x16;
typedef __attribute__((ext_vector_type(4))) float f32x4;
typedef __attribute__((ext_vector_type(2))) float f32x2;
typedef __attribute__((ext_vector_type(4))) unsigned u32x4;
typedef __attribute__((ext_vector_type(2))) unsigned u32x2;
typedef __attribute__((ext_vector_type(2))) __bf16 bf2_t;

constexpr int TB = 16384;
constexpr int TBP = TB + 64;
constexpr int NW = 8288;
constexpr int NWP = 8320;
constexpr int LDT = 72;
constexpr int TILE_ELEMS = 128 * LDT;
constexpr int GEMM_SMEM = 4 * TILE_ELEMS * 2;
constexpr int SMEM_BYTES = 131072;
#ifndef PROBE
#define PROBE 0
#endif
constexpr int NTH = 512;
constexpr int HT = 128 * 64;
constexpr float LOG2E = 1.4426950408889634f;
constexpr float LN2 = 0.6931471805599453f;

struct Prm {
  const float *x_prompt, *x_sample, *c_prompt, *c_sample, *rel_bias, *ada_w, *ada_b, *norm1_g, *w_in,
      *qn_g, *kvn_g, *w_uq, *w_ukv, *ln_g, *ln_b, *sgu_w, *sgu_b, *p_a, *p_b, *p_c, *p_d, *w_o,
      *norm2_g, *w1, *w2, *final_g;
  float* out;
  u16 *WinT, *W1T, *W2T, *WoT, *PaT, *PbT, *PcT, *PdT, *WqT, *WkvT, *SgW, *M1a, *M1b, *M2;
  float2 *tw, *rope;
  float *biasT, *mod, *modpart;
  u16 *hbuf, *UT, *Gp, *bqkv, *ob, *cu, *cvT, *dcq, *dckv, *qc, *kc, *vT, *od, *zg;
  float *og, *lse;
  unsigned* bar;
};

DI unsigned pack2(float a, float b) { bf2_t v; v[0] = (__bf16)a; v[1] = (__bf16)b; return __builtin_bit_cast(unsigned, v); }
DI u16 f2bf(float a) { return __builtin_bit_cast(u16, (__bf16)a); }
DI float bf2f(u16 v) { return __uint_as_float(((unsigned)v) << 16); }
DI float bflo(unsigned w) { return __uint_as_float(w << 16); }
DI float bfhi(unsigned w) { return __uint_as_float(w & 0xffff0000u); }
DI void st4bf(u16* dst, float a, float b, float c, float d) { u32x2 v; v[0] = pack2(a, b); v[1] = pack2(c, d); *(u32x2*)dst = v; }
DI void st4bf_nt(u16* dst, float a, float b, float c, float d) { u32x2 v; v[0] = pack2(a, b); v[1] = pack2(c, d); __builtin_nontemporal_store(v, (u32x2*)dst); }
DI int rowmap(int r, int lh) { return (r & 3) + 8 * (r >> 2) + 4 * lh; }
DI f32x16 mfma(bf16x8 a, bf16x8 b, f32x16 c) { return __builtin_amdgcn_mfma_f32_32x32x16_bf16(a, b, c, 0, 0, 0); }
DI u32x4 zero4() { u32x4 z; z[0] = 0; z[1] = 0; z[2] = 0; z[3] = 0; return z; }
DI f32x16 zero16() { f32x16 z; for (int i = 0; i < 16; ++i) z[i] = 0.f; return z; }
DI float ex2(float x) { return __builtin_amdgcn_exp2f(x); }
DI int tidx() { int t = threadIdx.x; asm volatile("" : "+v"(t)); return t; }


#define XB_TMO      128
#define XB_XCNT(j)  (256  + 64 * (j))
#define XB_XSUB(j)  (1280 + 64 * (j))
#define XB_XGEN(j)  (2304 + 64 * (j))
#define XB_TOP      3328
#define XB_TOPGEN   3392
#define XCD_BAR_WORDS 3456
#define XB_SPIN_CAP (1u << 18)
DI unsigned xb_ld(unsigned* p) { return __hip_atomic_load(p, __ATOMIC_RELAXED, __HIP_MEMORY_SCOPE_AGENT); }
DI unsigned xb_add(unsigned* p, unsigned v) { return __hip_atomic_fetch_add(p, v, __ATOMIC_RELAXED, __HIP_MEMORY_SCOPE_AGENT); }
DI unsigned xb_xcc_id() { return (unsigned)__builtin_amdgcn_s_getreg((3 << 11) | 20) & 0xFu; }
#define XB_SPIN(cond, bar) do { unsigned _sp = 0; while (cond) { __builtin_amdgcn_s_sleep(1); \
    if ((++_sp & 255u) == 0u) { if (xb_ld(&(bar)[XB_TMO])) break; if (_sp > XB_SPIN_CAP) { atomicAdd(&(bar)[XB_TMO], 1u); break; } } } } while (0)
struct XcdBarrier { unsigned* bar; unsigned x; volatile LAS unsigned* st; };
DI XcdBarrier xcd_barrier_post(unsigned* bar, volatile LAS unsigned* st) {
  XcdBarrier b; b.bar = bar; b.x = xb_xcc_id(); b.st = st;
  if (threadIdx.x == 0) (void)xb_add(&bar[XB_XCNT(b.x)], 1u);
  return b;
}
DI void xcd_barrier_complete(unsigned* bar, unsigned x, unsigned& nloc, unsigned& nx) {
  const unsigned G = gridDim.x * gridDim.y * gridDim.z;
  unsigned sum, cnt, mine, sp = 0u;
  for (;;) {
    sum = 0u; cnt = 0u; mine = 0u;
#pragma unroll
    for (unsigned j = 0; j < 16; ++j) { const unsigned c = xb_ld(&bar[XB_XCNT(j)]); sum += c; cnt += (c > 0u) ? 1u : 0u; mine = (j == x) ? c : mine; }
    if (sum == G) break;
    __builtin_amdgcn_s_sleep(1);
    if ((++sp & 255u) == 0u) { if (xb_ld(&bar[XB_TMO])) break; if (sp > XB_SPIN_CAP) { atomicAdd(&bar[XB_TMO], 1u); break; } }
  }
  nloc = mine > 0u ? mine : 1u; nx = cnt > 0u ? cnt : 1u;
}
DI void xcd_barrier(const XcdBarrier& b) {
  asm volatile("s_waitcnt vmcnt(0)" ::: "memory");
  __syncthreads();
  if (tidx() == 0) {
    unsigned* bar = b.bar;
    const unsigned bx = (unsigned)__builtin_amdgcn_readfirstlane((int)xb_xcc_id());
    __builtin_amdgcn_s_waitcnt(0);
    unsigned nloc = b.st[0], nx = b.st[1];
    if (nloc == 0u) { xcd_barrier_complete(bar, bx, nloc, nx); b.st[0] = nloc; b.st[1] = nx; }
    const unsigned old = xb_add(&bar[XB_XSUB(bx)], 1u);
    const unsigned gen = old / nloc;
    if (old + 1u == (gen + 1u) * nloc) {
      __builtin_amdgcn_fence(__ATOMIC_RELEASE, "agent");
      asm volatile("s_waitcnt vmcnt(0)" ::: "memory");
      const unsigned og = xb_add(&bar[XB_TOP], 1u);
      const unsigned tg = og / nx;
      if (og + 1u == (tg + 1u) * nx) xb_add(&bar[XB_TOPGEN], 1u);
      else XB_SPIN(xb_ld(&bar[XB_TOPGEN]) == tg, bar);
      __builtin_amdgcn_fence(__ATOMIC_ACQUIRE, "agent");
      xb_add(&bar[XB_XGEN(bx)], 1u);
      asm volatile("s_waitcnt vmcnt(0)" ::: "memory");
    } else {
      XB_SPIN(xb_ld(&bar[XB_XGEN(bx)]) == gen, bar);
      __builtin_amdgcn_fence(__ATOMIC_ACQUIRE, "agent");
      asm volatile("s_waitcnt vmcnt(0)" ::: "memory");
    }
  }
  __syncthreads();
}

#define TASK_LOOP(t, nt, base) for (int t = (int)((blockIdx.x + gridDim.x - ((unsigned)(base) % gridDim.x)) % gridDim.x); t < (nt); t += gridDim.x)

template <bool RFA, bool RFB, class LA, class LB, class EPI>
DI void gemm_tile(u16* smem, int nk, LA la, LB lb, EPI epi) {
  const int tid = tidx(), lane = tid & 63, wave = tid >> 6;
  const int wm = wave >> 2, wn = wave & 3, lr = lane & 31, lh = lane >> 5;
  u16* As = smem;
  u16* Bs = smem + 2 * TILE_ELEMS;
  f32x16 acc[2];
  acc[0] = zero16(); acc[1] = zero16();
  u32x4 ra[2], rb[2];
#define A_ROW(c) (RFA ? ((c) & 127) : ((c) >> 3))
#define A_KC(c) (RFA ? ((c) >> 7) : ((c) & 7))
#define B_ROW(c) (RFB ? ((c) & 127) : ((c) >> 3))
#define B_KC(c) (RFB ? ((c) >> 7) : ((c) & 7))
#pragma unroll
  for (int i = 0; i < 2; ++i) { const int c = tid + NTH * i; ra[i] = la(A_ROW(c), A_KC(c) * 8); rb[i] = lb(B_ROW(c), B_KC(c) * 8); }
#pragma unroll
  for (int i = 0; i < 2; ++i) {
    const int c = tid + NTH * i;
    *(u32x4*)(As + A_ROW(c) * LDT + A_KC(c) * 8) = ra[i];
    *(u32x4*)(Bs + B_ROW(c) * LDT + B_KC(c) * 8) = rb[i];
  }
  __syncthreads();
  for (int kt = 0; kt < nk; ++kt) {
    const int buf = kt & 1;
    if (kt + 1 < nk) {
      const int k0 = (kt + 1) * 64;
#pragma unroll
      for (int i = 0; i < 2; ++i) { const int c = tid + NTH * i; ra[i] = la(A_ROW(c), k0 + A_KC(c) * 8); rb[i] = lb(B_ROW(c), k0 + B_KC(c) * 8); }
    }
    const u16* Ab = As + buf * TILE_ELEMS + (wm * 64 + lr) * LDT + lh * 8;
    const u16* Bb = Bs + buf * TILE_ELEMS + (wn * 32 + lr) * LDT + lh * 8;
#pragma unroll
    for (int ks = 0; ks < 4; ++ks) {
      const bf16x8 a0 = *(const bf16x8*)(Ab + ks * 16);
      const bf16x8 a1 = *(const bf16x8*)(Ab + 32 * LDT + ks * 16);
      const bf16x8 b = *(const bf16x8*)(Bb + ks * 16);
      acc[0] = mfma(a0, b, acc[0]);
      acc[1] = mfma(a1, b, acc[1]);
    }
    if (kt + 1 < nk) {
      u16* Aw = As + (buf ^ 1) * TILE_ELEMS;
      u16* Bw = Bs + (buf ^ 1) * TILE_ELEMS;
#pragma unroll
      for (int i = 0; i < 2; ++i) {
        const int c = tid + NTH * i;
        *(u32x4*)(Aw + A_ROW(c) * LDT + A_KC(c) * 8) = ra[i];
        *(u32x4*)(Bw + B_ROW(c) * LDT + B_KC(c) * 8) = rb[i];
      }
    }
    __syncthreads();
  }
  epi(acc, wm, wn, lane);
}

DI void stage_rc(int b, int& R, int& C) { int st = b / 1024, sb = b % 1024, swz = sb ^ (((sb >> 9) & 1) << 5); R = (st >> 1) * 16 + swz / 64; C = (st & 1) * 32 + (swz % 64) / 2; }

template <class EPI>
DI void gemm256(LAS u16* shm, const u16* __restrict__ A, const u16* __restrict__ Bt, int K, int brow, int bcol, bool pre, bool has_next, int nbrow, int nbcol, EPI epi) {
#define SA(b, h) (shm + ((b) * 2 + (h)) * HT)
#define SB(b, h) (shm + (4 + (b) * 2 + (h)) * HT)
  const int tid = tidx();
  const int wid = __builtin_amdgcn_readfirstlane(tid >> 6), lane = tid & 63, wr = wid >> 2, wc = wid & 3, fr = lane & 15, fq = lane >> 4;
  int r0, c0, r1, c1;
  stage_rc(tid * 16, r0, c0);
  stage_rc(tid * 16 + 8192, r1, c1);
  const unsigned so0 = (unsigned)(r0 * K + c0) * 2u, so1 = (unsigned)(r1 * K + c1) * 2u;
  const unsigned ldsw = (unsigned)wid * 1024u;
  const int lb = ((fr * 64 + fq * 16) ^ ((fr >> 3) << 5));
#define STAGE(P, BASE, br, kt) do { const char* _g = (const char*)((BASE) + (size_t)(br) * K + (kt) * 64); \
    __builtin_amdgcn_global_load_lds((const unsigned*)(_g + so0), (LAS unsigned*)((LAS char*)(P) + ldsw), 16, 0, 0); \
    __builtin_amdgcn_global_load_lds((const unsigned*)(_g + so1), (LAS unsigned*)((LAS char*)(P) + ldsw + 8192), 16, 0, 0); } while (0)
#define LDA(dst, b, h) _Pragma("unroll") for (int m = 0; m < 4; ++m) _Pragma("unroll") for (int k = 0; k < 2; ++k) \
    dst[m][k] = *(const LAS bf16x8*)((const LAS char*)SA(b, h) + ((wr * 4 + m) * 2 + k) * 1024 + lb)
#define LDB(dst, b, h) _Pragma("unroll") for (int n = 0; n < 2; ++n) _Pragma("unroll") for (int k = 0; k < 2; ++k) \
    dst[n][k] = *(const LAS bf16x8*)((const LAS char*)SB(b, h) + ((wc * 2 + n) * 2 + k) * 1024 + lb)
#define MMA(ai, bj, At_, Bt_) do { __builtin_amdgcn_s_setprio(1); \
    _Pragma("unroll") for (int m = 0; m < 4; ++m) _Pragma("unroll") for (int n = 0; n < 2; ++n) _Pragma("unroll") for (int k = 0; k < 2; ++k) \
      acc[ai][bj][m][n] = __builtin_amdgcn_mfma_f32_16x16x32_bf16(At_[m][k], Bt_[n][k], acc[ai][bj][m][n], 0, 0, 0); \
    __builtin_amdgcn_s_setprio(0); } while (0)
#define WAIT_V(n) asm volatile("s_waitcnt vmcnt(" #n ")" ::: "memory")
#define WAIT_L(n) asm volatile("s_waitcnt lgkmcnt(" #n ")" ::: "memory")
#define BAR __builtin_amdgcn_s_barrier()
#define SCHED __builtin_amdgcn_sched_barrier(0)
  f32x4 acc[2][2][4][2];
#pragma unroll
  for (int a = 0; a < 2; ++a)
#pragma unroll
    for (int b = 0; b < 2; ++b)
#pragma unroll
      for (int m = 0; m < 4; ++m)
#pragma unroll
        for (int n = 0; n < 2; ++n) { acc[a][b][m][n][0] = 0.f; acc[a][b][m][n][1] = 0.f; acc[a][b][m][n][2] = 0.f; acc[a][b][m][n][3] = 0.f; }
  bf16x8 At[4][2], B0[2][2], B1[2][2];
  const int nt = K / 64;
  if (!pre) {
    STAGE(SB(0, 0), Bt, bcol, 0); STAGE(SA(0, 0), A, brow, 0);
    STAGE(SB(0, 1), Bt, bcol + 128, 0); STAGE(SA(0, 1), A, brow + 128, 0);
  }
  if (wr == 1) BAR;
  WAIT_V(4); BAR;
  STAGE(SB(1, 0), Bt, bcol, 1); STAGE(SA(1, 0), A, brow, 1); STAGE(SB(1, 1), Bt, bcol + 128, 1);
  WAIT_V(6); BAR;
  for (int t = 0; t < nt - 2; t += 2) {
    LDB(B0, 0, 0); SCHED; LDA(At, 0, 0); STAGE(SA(1, 1), A, brow + 128, t + 1);
    WAIT_L(8); BAR; WAIT_L(0); MMA(0, 0, At, B0); BAR; SCHED;
    LDB(B1, 0, 1); STAGE(SB(0, 0), Bt, bcol, t + 2);
    BAR; WAIT_L(0); MMA(0, 1, At, B1); BAR;
    LDA(At, 0, 1); STAGE(SA(0, 0), A, brow, t + 2);
    BAR; WAIT_L(0); MMA(1, 0, At, B0); BAR; SCHED;
    STAGE(SB(0, 1), Bt, bcol + 128, t + 2);
    WAIT_V(6); BAR; MMA(1, 1, At, B1); BAR;
    LDB(B0, 1, 0); SCHED; LDA(At, 1, 0); STAGE(SA(0, 1), A, brow + 128, t + 2);
    WAIT_L(8); BAR; WAIT_L(0); MMA(0, 0, At, B0); BAR; SCHED;
    LDB(B1, 1, 1); STAGE(SB(1, 0), Bt, bcol, t + 3);
    BAR; WAIT_L(0); MMA(0, 1, At, B1); BAR;
    LDA(At, 1, 1); STAGE(SA(1, 0), A, brow, t + 3);
    BAR; WAIT_L(0); MMA(1, 0, At, B0); BAR; SCHED;
    STAGE(SB(1, 1), Bt, bcol + 128, t + 3);
    WAIT_V(6); BAR; MMA(1, 1, At, B1); BAR;
  }
  { LDB(B0, 0, 0); LDA(At, 0, 0); STAGE(SA(1, 1), A, brow + 128, nt - 1);
    BAR; WAIT_L(0); MMA(0, 0, At, B0); BAR;
    LDB(B1, 0, 1); BAR; WAIT_L(0); MMA(0, 1, At, B1); BAR;
    LDA(At, 0, 1); WAIT_V(4); BAR; WAIT_L(0); MMA(1, 0, At, B0); MMA(1, 1, At, B1); BAR; }
  { LDB(B0, 1, 0); LDA(At, 1, 0); WAIT_V(2); BAR; WAIT_L(0); MMA(0, 0, At, B0); BAR;
    LDB(B1, 1, 1); WAIT_V(0); BAR; WAIT_L(0); MMA(0, 1, At, B1); BAR;
    LDA(At, 1, 1); BAR; WAIT_L(0); MMA(1, 0, At, B0); MMA(1, 1, At, B1); BAR; }
  if (wr == 0) BAR;
  if (has_next) {
    STAGE(SB(0, 0), Bt, nbcol, 0); STAGE(SA(0, 0), A, nbrow, 0);
    STAGE(SB(0, 1), Bt, nbcol + 128, 0); STAGE(SA(0, 1), A, nbrow + 128, 0);
  }
  epi(acc, wr, wc, fr, fq);
  __syncthreads();
}

DI void map256(int t, int nN, int& tn, int& tm) {
  const int p = (t >> 8) * 8 + (t & 7), i = (t >> 3) & 31, pr = nN >> 2;
  const int pm = p / pr;
  tn = ((p + pm) % pr) * 4 + (i & 3);
  tm = pm * 8 + (i >> 2);
}

DI int condrow(int sb, int tok) { return sb == 0 ? 0 : 1 + (sb - 1) * 8 + (tok >> 11); }

DI void convT(float* tile, const float* src, int lds_, int K, int N, u16* dst, int ldd, const float* ksc, int& base) {
  const int tid = tidx();
  const int ntn = (N + 63) >> 6, nt = (K >> 6) * ntn;
  const int kk = tid >> 4, n4 = (tid & 15) * 4;
  float4 cur[2], nxt[2];
  auto ld = [&](float4 (&v)[2], int t) __attribute__((always_inline)) {
    const int tn = t % ntn, tk = t / ntn, k0 = tk * 64, n0 = tn * 64;
#pragma unroll
    for (int e = 0; e < 2; ++e) {
      v[e] = make_float4(0.f, 0.f, 0.f, 0.f);
      if (n0 + n4 < N) v[e] = *(const float4*)(src + (size_t)(k0 + kk + 32 * e) * lds_ + n0 + n4);
    }
  };
  int t = (int)((blockIdx.x + gridDim.x - ((unsigned)base % gridDim.x)) % gridDim.x);
  if (t < nt) ld(cur, t);
  for (; t < nt; t += gridDim.x) {
    const int tnx = t + (int)gridDim.x;
    if (tnx < nt) ld(nxt, tnx);
    const int tn = t % ntn, tk = t / ntn, k0 = tk * 64, n0 = tn * 64;
#pragma unroll
    for (int e = 0; e < 2; ++e) {
      float4 v = cur[e];
      if (ksc) { const float sc = ksc[k0 + kk + 32 * e]; v.x *= sc; v.y *= sc; v.z *= sc; v.w *= sc; }
      float* tp = tile + (kk + 32 * e) * 65 + n4;
      tp[0] = v.x; tp[1] = v.y; tp[2] = v.z; tp[3] = v.w;
    }
    __syncthreads();
#pragma unroll 4
    for (int e = 0; e < 4; ++e) {
      const int idx = tid + NTH * e, nn = idx >> 5, kp = idx & 31;
      if (n0 + nn < N)
        *(unsigned*)(dst + (size_t)(n0 + nn) * ldd + k0 + 2 * kp) = pack2(tile[(2 * kp) * 65 + nn], tile[(2 * kp + 1) * 65 + nn]);
    }
    __syncthreads();
    cur[0] = nxt[0]; cur[1] = nxt[1];
  }
  base += nt;
}

DI void prologue_a(const Prm& p, unsigned char* smem_raw, int& base) {
  float* smf = (float*)smem_raw;
  const int tid = tidx();
  const int gtid = blockIdx.x * NTH + tid, gn = gridDim.x * NTH;
  for (int l = 0; l < 4; ++l) {
    convT(smf, p.w_in + (size_t)l * 1024 * 7520 + 768, 7520, 1024, 6752, p.WinT + ((size_t)l * NWP + 1536) * 1024, 1024, nullptr, base);
    convT(smf, p.w1 + (size_t)l * 1024 * 4096, 4096, 1024, 4096, p.W1T + (size_t)l * 4096 * 1024, 1024, nullptr, base);
    convT(smf, p.w2 + (size_t)l * 4096 * 1024, 1024, 4096, 1024, p.W2T + (size_t)l * 1024 * 4096, 4096, nullptr, base);
    convT(smf, p.w_o + (size_t)l * 1024 * 1024, 1024, 1024, 1024, p.WoT + (size_t)l * 1024 * 1024, 1024, nullptr, base);
    convT(smf, p.p_a + (size_t)l * 768 * 1024, 1024, 768, 1024, p.PaT + (size_t)l * 1024 * 768, 768, nullptr, base);
    convT(smf, p.p_b + (size_t)l * 128 * 1024, 1024, 128, 1024, p.PbT + (size_t)l * 1024 * 128, 128, nullptr, base);
    convT(smf, p.p_c + (size_t)l * 384 * 1024, 1024, 384, 1024, p.PcT + (size_t)l * 1024 * 384, 384, nullptr, base);
    convT(smf, p.p_d + (size_t)l * 256 * 1024, 1024, 256, 1024, p.PdT + (size_t)l * 1024 * 256, 256, nullptr, base);
    convT(smf, p.w_uq + (size_t)l * 384 * 384, 384, 384, 384, p.WqT + (size_t)l * 384 * 384, 384, p.qn_g + l * 384, base);
    convT(smf, p.w_ukv + (size_t)l * 320 * 512, 512, 320, 512, p.WkvT + (size_t)l * 512 * 320, 320, p.kvn_g + l * 320, base);
  }
  {
    float* tab = (float*)(smem_raw + GEMM_SMEM + 1024);
    if (tid < 192) {
      float sn, cs;
      sincospif(2.f * (float)tid / 192.f, &sn, &cs);
      tab[tid] = cs; tab[192 + tid] = sn;
    }
    __syncthreads();
    u16* smem = (u16*)smem_raw;
    TASK_LOOP(t, 384, base) {
      const int kt = t & 7, rt = (t >> 3) % 3, g = (t / 24) & 3, l = t / 96;
      auto la = [&](int row, int k) __attribute__((always_inline)) {
        const int rr = rt * 128 + row, part = rr >= 192 ? 1 : 0, j = rr - part * 192;
        const float* tp = tab + part * 192;
        const float sg = part ? -1.f : 1.f;
        int m = (j * k) % 192;
        u32x4 o;
#pragma unroll
        for (int jj = 0; jj < 4; ++jj) {
          const float v0 = tp[m] * sg; m += j; if (m >= 192) m -= 192;
          const float v1 = tp[m] * sg; m += j; if (m >= 192) m -= 192;
          o[jj] = pack2(v0, v1);
        }
        return o;
      };
      auto lb = [&](int row, int k) __attribute__((always_inline)) {
        const float* src = p.w_in + ((size_t)l * 1024 + kt * 128 + row) * 7520 + g * 192 + k;
        const float4 a = *(const float4*)src, b = *(const float4*)(src + 4);
        u32x4 o;
        o[0] = pack2(a.x, a.y); o[1] = pack2(a.z, a.w); o[2] = pack2(b.x, b.y); o[3] = pack2(b.z, b.w);
        return o;
      };
      auto epi = [&](f32x16 (&acc)[2], int wm, int wn, int lane) __attribute__((always_inline)) {
        const int lr = lane & 31, lh = lane >> 5;
        const int kcol = kt * 128 + wn * 32 + lr;
#pragma unroll
        for (int i = 0; i < 2; ++i)
#pragma unroll
          for (int r = 0; r < 16; ++r) {
            const int rr = rt * 128 + wm * 64 + i * 32 + rowmap(r, lh), part = rr >= 192 ? 1 : 0, j = rr - part * 192;
            p.WinT[((size_t)l * NWP + part * 768 + g * 192 + j) * 1024 + kcol] = f2bf(acc[i][r]);
          }
      };
      gemm_tile<false, false>(smem, 3, la, lb, epi);
    }
    base += 384;
  }
  {
    float* sil = smf;
    TASK_LOOP(t, 384, base) {
      const int kc = t & 7, cb = (t >> 3) % 12, l = t / 96, k0 = kc * 128;
      for (int idx = tid; idx < 17 * 128; idx += NTH) {
        const int r = idx >> 7, kk = idx & 127;
        const float c = r == 0 ? p.c_prompt[k0 + kk] : p.c_sample[(r - 1) * 1024 + k0 + kk];
        sil[idx] = c / (1.f + __expf(-c));
      }
      __syncthreads();
      const int n = cb * 512 + tid;
      float acc[17];
#pragma unroll
      for (int r = 0; r < 17; ++r) acc[r] = 0.f;
      const float* wp = p.ada_w + ((size_t)l * 1024 + k0) * 6144 + n;
#pragma unroll 1
      for (int kb = 0; kb < 128; kb += 32) {
        float w[32];
#pragma unroll
        for (int i = 0; i < 32; ++i) w[i] = wp[(size_t)(kb + i) * 6144];
#pragma unroll
        for (int i = 0; i < 32; i += 4)
#pragma unroll
          for (int r = 0; r < 17; ++r) {
            const float4 sv = *(const float4*)(sil + r * 128 + kb + i);
            acc[r] += sv.x * w[i] + sv.y * w[i + 1] + sv.z * w[i + 2] + sv.w * w[i + 3];
          }
      }
#pragma unroll
      for (int r = 0; r < 17; ++r) p.modpart[((size_t)(kc * 4 + l) * 17 + r) * 6144 + n] = acc[r];
      __syncthreads();
    }
    base += 384;
  }
  for (int idx = gtid; idx < 4 * 32 * 1024; idx += gn) {
    const int l = idx >> 15, rem = idx & 32767;
    p.WinT[((size_t)l * NWP + NW) * 1024 + rem] = 0;
  }
  for (int idx = gtid; idx < 256 * 256; idx += gn) {
    const int row = idx >> 8, kk = idx & 255;
    const int po = row >> 7, k1 = row & 127, pi = kk >> 7, s1 = kk & 127;
    float s, c;
    sincospif(2.f * (float)((k1 * s1) & 127) / 128.f, &s, &c);
    const float v = (po == pi) ? c : (po == 0 ? s : -s);
    p.M1a[idx] = f2bf(v);
  }
  for (int idx = gtid; idx < 32 * 64; idx += gn) {
    const int row = idx >> 6, kk = idx & 63;
    const int po = row >> 4, k1 = row & 15, pi = (kk >> 4) & 1, s1 = kk & 15;
    float s, c;
    sincospif(2.f * (float)((k1 * s1) & 15) / 16.f, &s, &c);
    float v = (po == pi) ? c : (po == 0 ? s : -s);
    if (kk >= 32) v = 0.f;
    p.M1b[idx] = f2bf(v);
  }
  for (int idx = gtid; idx < 128 * 256; idx += gn) {
    const int k2 = idx >> 8, kk = idx & 255, part = kk >> 7, s2 = kk & 127;
    float s, c;
    sincospif(2.f * (float)((k2 * s2) & 127) / 128.f, &s, &c);
    p.M2[idx] = f2bf(part ? s : c);
  }
  for (int idx = gtid; idx < 16384; idx += gn) {
    float s, c;
    sincospif(2.f * (float)idx / 16384.f, &s, &c);
    p.tw[idx] = make_float2(c, s);
  }
  for (int idx = gtid; idx < 16384 * 16; idx += gn) {
    const int pos = idx >> 4, i = idx & 15;
    const float inv = (float)pow(10000.0, -(double)i / 16.0);
    const float ang = (float)pos * inv;
    double rev = (double)ang * 0.15915494309189535;
    rev -= rint(rev);
    float s, c;
    sincospif((float)(2.0 * rev), &s, &c);
    p.rope[idx] = make_float2(c, s);
  }
  for (int idx = gtid; idx < 6 * 129; idx += gn) {
    const int hd = idx / 129, rel = idx - hd * 129 - 64;
    const int dil = 1 << (2 * (hd >> 1));
    const int rd = rel * dil, n = rd < 0 ? -rd : rd;
    int b;
    if (n < 8) b = n;
    else if (n < 15) b = 8; else if (n < 27) b = 9; else if (n < 50) b = 10; else if (n < 91) b = 11;
    else if (n < 166) b = 12; else if (n < 305) b = 13; else if (n < 559) b = 14; else b = 15;
    if (rd > 0) b += 16;
    p.biasT[idx] = p.rel_bias[b * 6 + hd];
  }
  for (int idx = gtid; idx < 4 * 4 * 128 * 128; idx += gn) p.SgW[idx] = f2bf(p.sgu_w[idx]);
}

DI void prologue_b(const Prm& p) {
  const int gtid = blockIdx.x * NTH + tidx(), gn = gridDim.x * NTH;
  for (int idx = gtid; idx < 4 * 17 * 6144; idx += gn) {
    const int l = idx / (17 * 6144), n = idx % 6144;
    float s = p.ada_b[l * 6144 + n];
#pragma unroll
    for (int kc = 0; kc < 8; ++kc) s += p.modpart[(size_t)kc * 4 * 17 * 6144 + idx];
    p.mod[idx] = s;
  }
}

DI void phase_norm(const Prm& p, const float* xsrc, const float* g, const float* modl, int shoff, int scoff, int sb) {
  const int tid = tidx(), lane = tid & 63;
  const int gw = blockIdx.x * 8 + (tid >> 6), nw = gridDim.x * 8;
  for (int row = gw; row < TB; row += nw) {
    const int cond = condrow(sb, row);
    const float* xr = xsrc + (size_t)row * 1024;
    float4 v[4];
    float ss = 0.f;
#pragma unroll
    for (int i = 0; i < 4; ++i) {
      v[i] = *(const float4*)(xr + i * 256 + lane * 4);
      ss += v[i].x * v[i].x + v[i].y * v[i].y + v[i].z * v[i].z + v[i].w * v[i].w;
    }
#pragma unroll
    for (int off = 32; off >= 1; off >>= 1) ss += __shfl_xor(ss, off);
    const float rstd = rsqrtf(ss * (1.f / 1024.f) + 1e-6f);
    const float* sc = modl + cond * 6144 + scoff;
    const float* sh = modl + cond * 6144 + shoff;
#pragma unroll
    for (int i = 0; i < 4; ++i) {
      const int col = i * 256 + lane * 4;
      const float4 gg = *(const float4*)(g + col), s4 = *(const float4*)(sc + col), h4 = *(const float4*)(sh + col);
      st4bf(p.hbuf + (size_t)row * 1024 + col,
            v[i].x * rstd * gg.x * (1.f + s4.x) + h4.x, v[i].y * rstd * gg.y * (1.f + s4.y) + h4.y,
            v[i].z * rstd * gg.z * (1.f + s4.z) + h4.z, v[i].w * rstd * gg.w * (1.f + s4.w) + h4.w);
    }
  }
}

DI float sigm(float x) { return __builtin_amdgcn_rcpf(1.f + __expf(-x)); }

DI void phase_inproj(const Prm& p, unsigned char* smem_raw, int l, int S, int& base) {
  const u16* W = p.WinT + (size_t)l * NWP * 1024;
  LAS u16* shm = (LAS u16*)smem_raw;
  bool pre = false;
  TASK_LOOP(t, 32 * 64, base) {
    int tn, tm;
    map256(t, 32, tn, tm);
    const int brow = tn * 256, bcol = tm * 256;
    const int tnx = t + (int)gridDim.x;
    const bool has_next = tnx < (32 * 64);
    int tn2 = 0, tm2 = 0;
    if (has_next) map256(tnx, 32, tn2, tm2);
    const int nbrow = tn2 * 256, nbcol = tm2 * 256;
    auto epi = [&](f32x4 (&acc)[2][2][4][2], int wr, int wc, int fr, int fq) __attribute__((always_inline)) {
#pragma unroll
      for (int ai = 0; ai < 2; ++ai)
#pragma unroll
        for (int m = 0; m < 4; ++m) {
          const int nb = brow + ai * 128 + wr * 64 + m * 16;
#pragma unroll
          for (int bj = 0; bj < 2; ++bj)
#pragma unroll
            for (int n = 0; n < 2; ++n) {
              const int tok = bcol + bj * 128 + wc * 32 + n * 16 + fr;
              const f32x4 v = acc[ai][bj][m][n];
              const int nn = nb + fq * 4;
              if (nb < 1536) {
#pragma unroll
                for (int j = 0; j < 4; ++j) p.UT[(size_t)(nn + j) * TBP + tok] = f2bf(v[j]);
              } else if (nb < 2688) {
                st4bf(p.bqkv + (size_t)tok * 1152 + (nn - 1536), v[0], v[1], v[2], v[3]);
              } else if (nb < 3072) {
                st4bf(p.cu + (size_t)tok * 384 + (nn - 2688), v[0], v[1], v[2], v[3]);
              } else if (nb < 3456) {
#pragma unroll
                for (int j = 0; j < 4; ++j) p.cvT[(size_t)(nn - 3072 + j) * TBP + tok] = f2bf(v[j]);
              } else if (nb < 3840) {
                st4bf(p.dcq + (size_t)tok * 384 + (nn - 3456), v[0], v[1], v[2], v[3]);
              } else if (nb < 4160) {
                st4bf(p.dckv + (size_t)tok * 320 + (nn - 3840), v[0], v[1], v[2], v[3]);
              } else if (nb < 4192) {
                if (nb == 4160) {
                  const f32x4 v2 = acc[ai][bj][(m + 1) & 3][n];
                  const int pos = tok & (S - 1);
#pragma unroll
                  for (int j = 0; j < 4; ++j) {
                    const int ii = fq * 4 + j;
                    const float2 cs = p.rope[pos * 16 + ii];
                    const u16 o1 = f2bf(v[j] * cs.x - v2[j] * cs.y), o2 = f2bf(v[j] * cs.y + v2[j] * cs.x);
#pragma unroll
                    for (int hh = 0; hh < 4; ++hh) {
                      p.kc[(size_t)tok * 384 + hh * 96 + 64 + ii] = o1;
                      p.kc[(size_t)tok * 384 + hh * 96 + 80 + ii] = o2;
                    }
                  }
                }
              } else {
                st4bf_nt(p.zg + (size_t)tok * 4096 + (nn - 4192), sigm(v[0]), sigm(v[1]), sigm(v[2]), sigm(v[3]));
              }
            }
          __builtin_amdgcn_sched_barrier(0);
        }
    };
    gemm256(shm, W, p.hbuf, 1024, brow, bcol, pre, has_next, nbrow, nbcol, epi);
    pre = has_next;
  }
  base += 32 * 64;
}

DI void phase_inproj_tail(const Prm& p, unsigned char* smem_raw, int l, int& base) {
  const u16* W = p.WinT + (size_t)l * NWP * 1024;
  u16* smem = (u16*)smem_raw;
  TASK_LOOP(t, 128, base) {
    const int n0 = 8192, m0 = t * 128;
    auto la = [&](int row, int k) __attribute__((always_inline)) { return *(const u32x4*)(W + (size_t)(n0 + row) * 1024 + k); };
    auto lb = [&](int row, int k) __attribute__((always_inline)) { return *(const u32x4*)(p.hbuf + (size_t)(m0 + row) * 1024 + k); };
    auto epi = [&](f32x16 (&acc)[2], int wm, int wn, int lane) __attribute__((always_inline)) {
      const int lr = lane & 31, lh = lane >> 5;
      const int tok = m0 + wn * 32 + lr;
#pragma unroll
      for (int i = 0; i < 2; ++i) {
        const int nb = n0 + wm * 64 + i * 32;
        if (nb >= NW) continue;
#pragma unroll
        for (int q = 0; q < 4; ++q)
          st4bf(p.zg + (size_t)tok * 4096 + (nb - 4192) + 8 * q + 4 * lh, sigm(acc[i][4 * q]), sigm(acc[i][4 * q + 1]), sigm(acc[i][4 * q + 2]),
                sigm(acc[i][4 * q + 3]));
      }
    };
    gemm_tile<false, false>(smem, 16, la, lb, epi);
  }
  base += 128;
}


DI void phase_inproj_probe(const Prm& p, unsigned char* smem_raw, int l, int& base) {
  const u16* W = p.WinT + (size_t)l * NWP * 1024;
  LAS u16* shm = (LAS u16*)smem_raw;
  bool pre = false;
  TASK_LOOP(t, 32 * 64, base) {
    int tn, tm;
    map256(t, 32, tn, tm);
    const int brow = tn * 256, bcol = tm * 256;
    const int tnx = t + (int)gridDim.x;
    const bool has_next = tnx < (32 * 64);
    int tn2 = 0, tm2 = 0;
    if (has_next) map256(tnx, 32, tn2, tm2);
    const int nbrow = tn2 * 256, nbcol = tm2 * 256;
    auto epi = [&](f32x4 (&acc)[2][2][4][2], int wr, int wc, int fr, int fq) __attribute__((always_inline)) {
#pragma unroll
      for (int bj = 0; bj < 2; ++bj)
#pragma unroll
        for (int n = 0; n < 2; ++n) {
          const int tok = bcol + bj * 128 + wc * 32 + n * 16 + fr;
#pragma unroll
          for (int ai = 0; ai < 2; ++ai)
#pragma unroll
            for (int m = 0; m < 4; ++m) {
              const int nn = ((brow + ai * 128 + wr * 64 + m * 16) & 1023) + fq * 4;
              const f32x4 v = acc[ai][bj][m][n];
              st4bf(p.Gp + (size_t)tok * 1024 + nn, v[0], v[1], v[2], v[3]);
            }
        }
    };
    gemm256(shm, W, p.hbuf, 1024, brow, bcol, pre, has_next, nbrow, nbcol, epi);
    pre = has_next;
  }
  base += 32 * 64;
}

DI void phase_fft1(const Prm& p, u16* smem, int S, int nseq, int N1, int lgN1, int& base) {
  const int nkt = N1 == 128 ? 2 : 1;
  const u16* M1 = N1 == 128 ? p.M1a : p.M1b;
  const int ldm = N1 == 128 ? 256 : 64;
  const int nk = N1 == 128 ? 4 : 1;
  const int ntask = nseq * 768 * nkt;
  const int twmul = 16384 / S;
  TASK_LOOP(t, ntask, base) {
    const int k1t = t % nkt, col = (t / nkt) % 768, seq = t / (nkt * 768);
    const int k1base = k1t * 64;
    auto la = [&](int row, int k) __attribute__((always_inline)) {
      const int k1 = k1base + (row >> 6) * 32 + (row & 31), ii = (row >> 5) & 1;
      if (k1 >= N1 || k >= 2 * N1) return zero4();
      return *(const u32x4*)(M1 + (ii * N1 + k1) * ldm + k);
    };
    auto lb = [&](int row, int k) __attribute__((always_inline)) {
      if (k >= 2 * N1) return zero4();
      const int part = k >> lgN1, s1 = k & (N1 - 1);
      const u16* src = p.UT + (size_t)(part * 768 + col) * TBP + seq * S + s1 * 128 + row;
      u32x4 v;
#pragma unroll
      for (int jj = 0; jj < 4; ++jj) v[jj] = (unsigned)src[(2 * jj) * 128] | ((unsigned)src[(2 * jj + 1) * 128] << 16);
      return v;
    };
    auto epi = [&](f32x16 (&acc)[2], int wm, int wn, int lane) __attribute__((always_inline)) {
      const int lr = lane & 31, lh = lane >> 5;
      const int s2 = wn * 32 + lr;
#pragma unroll
      for (int r = 0; r < 16; ++r) {
        const int k1 = k1base + wm * 32 + rowmap(r, lh);
        if (k1 < N1) {
          const float re = acc[0][r], im = acc[1][r];
          const float2 cs = p.tw[(s2 * k1) * twmul];
          const size_t o = ((size_t)((seq * N1 + k1) * 2) * 768 + col) * 128 + s2;
          p.Gp[o] = f2bf(cs.x * re + cs.y * im);
          p.Gp[o + 768 * 128] = f2bf(cs.x * im - cs.y * re);
        }
      }
    };
    gemm_tile<false, true>(smem, nk, la, lb, epi);
  }
  base += ntask;
}


DI void phase_fft1_small(const Prm& p, int nseq) {
  constexpr float C16[16] = {1.f, 0.92387953251128674f, 0.70710678118654752f, 0.38268343236508977f, 0.f, -0.38268343236508977f, -0.70710678118654752f,
                             -0.92387953251128674f, -1.f, -0.92387953251128674f, -0.70710678118654752f, -0.38268343236508977f, 0.f,
                             0.38268343236508977f, 0.70710678118654752f, 0.92387953251128674f};
  constexpr float S16[16] = {0.f, 0.38268343236508977f, 0.70710678118654752f, 0.92387953251128674f, 1.f, 0.92387953251128674f, 0.70710678118654752f,
                             0.38268343236508977f, 0.f, -0.38268343236508977f, -0.70710678118654752f, -0.92387953251128674f, -1.f,
                             -0.92387953251128674f, -0.70710678118654752f, -0.38268343236508977f};
  const int gtid = blockIdx.x * NTH + tidx(), gn = gridDim.x * NTH;
  for (int idx = gtid; idx < nseq * 768 * 128; idx += gn) {
    const int s2 = idx & 127, col = (idx >> 7) % 768, seq = idx / (768 * 128);
    const u16* ur = p.UT + (size_t)col * TBP + seq * 2048 + s2;
    const u16* ui = ur + (size_t)768 * TBP;
    float xr[16], xi[16];
#pragma unroll
    for (int s1 = 0; s1 < 16; ++s1) { xr[s1] = bf2f(ur[s1 * 128]); xi[s1] = bf2f(ui[s1 * 128]); }
    u16* go = p.Gp + ((size_t)(seq * 16 * 2) * 768 + col) * 128 + s2;
#pragma unroll
    for (int k1 = 0; k1 < 16; ++k1) {
      float gr = 0.f, gi = 0.f;
#pragma unroll
      for (int s1 = 0; s1 < 16; ++s1) {
        const float c = C16[(k1 * s1) & 15], sn = S16[(k1 * s1) & 15];
        gr += c * xr[s1] + sn * xi[s1];
        gi += c * xi[s1] - sn * xr[s1];
      }
      const float2 cs = p.tw[(s2 * k1) * 8];
      go[(size_t)(k1 * 2) * 768 * 128] = f2bf(cs.x * gr + cs.y * gi);
      go[(size_t)(k1 * 2 + 1) * 768 * 128] = f2bf(cs.x * gi - cs.y * gr);
    }
  }
}

DI void phase_fft2(const Prm& p, u16* smem, int S, int nseq, int N1, int& base) {
  const int ntask = nseq * N1 * 6;
  const float scale = rsqrtf((float)S * 192.f);
  u16* fa = p.UT;
  TASK_LOOP(t, ntask, base) {
    const int ct = t % 6, k1 = (t / 6) % N1, seq = t / (6 * N1);
    const u16* gb = p.Gp + ((size_t)((seq * N1 + k1) * 2) * 768 + ct * 128) * 128;
    auto la = [&](int row, int k) __attribute__((always_inline)) { return *(const u32x4*)(p.M2 + row * 256 + k); };
    auto lb = [&](int row, int k) __attribute__((always_inline)) {
      const int part = k >> 7, s2 = k & 127;
      return *(const u32x4*)(gb + ((size_t)part * 768 + row) * 128 + s2);
    };
    auto epi = [&](f32x16 (&acc)[2], int wm, int wn, int lane) __attribute__((always_inline)) {
      const int lr = lane & 31, lh = lane >> 5;
      const int col = ct * 128 + wn * 32 + lr;
#pragma unroll
      for (int i = 0; i < 2; ++i)
#pragma unroll
        for (int r = 0; r < 16; ++r) {
          const int k2 = wm * 64 + i * 32 + rowmap(r, lh);
          const int tok = seq * S + k1 + N1 * k2;
          fa[(size_t)tok * 768 + col] = f2bf(acc[i][r] * scale);
        }
    };
    gemm_tile<false, false>(smem, 4, la, lb, epi);
  }
  base += ntask;
}

DI void phase_mixc(const Prm& p, unsigned char* smem_raw, int l, int& base) {
  u16* smem = (u16*)smem_raw;
  float* st = (float*)(smem_raw + GEMM_SMEM);
  float* red = (float*)smem_raw;
  const int tid = tidx();
  TASK_LOOP(t, 512, base) {
    const int h = t & 3, ch = t >> 2, tok0 = ch * 128;
    {
      const int q = tid & 127, qf = tid >> 7;
      float s = 0.f, ss = 0.f;
      const u16* src = p.cvT + (size_t)(qf * 96) * TBP + tok0 + q;
      for (int c = 0; c < 96; ++c) { const float v = bf2f(src[(size_t)c * TBP]); s += v; ss += v * v; }
      red[qf * 256 + q * 2] = s; red[qf * 256 + q * 2 + 1] = ss;
      __syncthreads();
      if (tid < 128) {
        const float s1 = red[q * 2] + red[256 + q * 2] + red[512 + q * 2] + red[768 + q * 2];
        const float s2 = red[q * 2 + 1] + red[256 + q * 2 + 1] + red[512 + q * 2 + 1] + red[768 + q * 2 + 1];
        const float mu = s1 * (1.f / 384.f);
        const float var = fmaxf(s2 * (1.f / 384.f) - mu * mu, 0.f);
        st[q] = mu; st[128 + q] = rsqrtf(var + 1e-6f);
      }
      __syncthreads();
    }
    const u16* Wm = p.SgW + (size_t)((l * 4 + h) * 128) * 128;
    auto la = [&](int row, int k) __attribute__((always_inline)) { return *(const u32x4*)(Wm + row * 128 + k); };
    auto lb = [&](int row, int k) __attribute__((always_inline)) {
      if (row >= 96) return zero4();
      const int c = h * 96 + row;
      const u32x4 raw = *(const u32x4*)(p.cvT + (size_t)c * TBP + tok0 + k);
      const float g = p.ln_g[l * 384 + c], b = p.ln_b[l * 384 + c];
      u32x4 o;
#pragma unroll
      for (int jj = 0; jj < 4; ++jj) {
        const float v0 = (bflo(raw[jj]) - st[k + 2 * jj]) * st[128 + k + 2 * jj] * g + b;
        const float v1 = (bfhi(raw[jj]) - st[k + 2 * jj + 1]) * st[128 + k + 2 * jj + 1] * g + b;
        o[jj] = pack2(v0, v1);
      }
      return o;
    };
    auto epi = [&](f32x16 (&acc)[2], int wm, int wn, int lane) __attribute__((always_inline)) {
      const int lr = lane & 31, lh = lane >> 5;
      const int cl = wn * 32 + lr;
      if (cl < 96) {
#pragma unroll
        for (int i = 0; i < 2; ++i)
#pragma unroll
          for (int r = 0; r < 16; ++r) {
            const int pp = wm * 64 + i * 32 + rowmap(r, lh);
            const float val = acc[i][r] + p.sgu_b[(l * 4 + h) * 128 + pp];
            u16* dst = p.cu + (size_t)(tok0 + pp) * 384 + h * 96 + cl;
            *dst = f2bf(bf2f(*dst) * val);
          }
      }
    };
    gemm_tile<false, false>(smem, 2, la, lb, epi);
  }
  base += 512;
}

DI void phase_qup(const Prm& p, unsigned char* smem_raw, int l, int S, int& base) {
  u16* smem = (u16*)smem_raw;
  float* st = (float*)(smem_raw + GEMM_SMEM);
  const int tid = tidx();
  const float QS = 0.10206207261596577f * LOG2E;
  TASK_LOOP(t, 3 * 128, base) {
    const int tn = t % 3, tm = t / 3, n0 = tn * 128, m0 = tm * 128;
    {
      const int row = tid >> 2, qf = tid & 3;
      const u16* src = p.dcq + (size_t)(m0 + row) * 384 + qf * 96;
      float ss = 0.f;
#pragma unroll 4
      for (int c = 0; c < 12; ++c) {
        const u32x4 v = *(const u32x4*)(src + c * 8);
#pragma unroll
        for (int jj = 0; jj < 4; ++jj) { const float a = bflo(v[jj]), b = bfhi(v[jj]); ss += a * a + b * b; }
      }
      ss += __shfl_xor(ss, 1);
      ss += __shfl_xor(ss, 2);
      if (qf == 0) st[row] = rsqrtf(ss * (1.f / 384.f) + 1e-6f);
      __syncthreads();
    }
    const u16* W = p.WqT + (size_t)l * 384 * 384;
    auto la = [&](int row, int k) __attribute__((always_inline)) { return *(const u32x4*)(W + (size_t)(n0 + row) * 384 + k); };
    auto lb = [&](int row, int k) __attribute__((always_inline)) { return *(const u32x4*)(p.dcq + (size_t)(m0 + row) * 384 + k); };
    auto epi = [&](f32x16 (&acc)[2], int wm, int wn, int lane) __attribute__((always_inline)) {
      const int lr = lane & 31, lh = lane >> 5;
      const int tokl = wn * 32 + lr, tok = m0 + tokl;
      const float sc = st[tokl] * QS;
#pragma unroll
      for (int i = 0; i < 2; ++i) {
        const int nb = n0 + wm * 64 + i * 32;
        const int head = nb / 96, within = nb - head * 96;
        const f32x16& a = acc[i];
        if (within < 64) {
#pragma unroll
          for (int q = 0; q < 4; ++q)
            st4bf(p.qc + (size_t)tok * 384 + nb + 8 * q + 4 * lh, a[4 * q] * sc, a[4 * q + 1] * sc, a[4 * q + 2] * sc, a[4 * q + 3] * sc);
        } else {
          const int pos = tok & (S - 1);
#pragma unroll
          for (int q = 0; q < 2; ++q)
#pragma unroll
            for (int e = 0; e < 4; ++e) {
              const int r = 4 * q + e, ii = 8 * q + 4 * lh + e;
              const float2 cs = p.rope[pos * 16 + ii];
              const float x1 = a[r] * sc, x2 = a[r + 8] * sc;
              p.qc[(size_t)tok * 384 + head * 96 + 64 + ii] = f2bf(x1 * cs.x - x2 * cs.y);
              p.qc[(size_t)tok * 384 + head * 96 + 80 + ii] = f2bf(x1 * cs.y + x2 * cs.x);
            }
        }
      }
    };
    gemm_tile<false, false>(smem, 6, la, lb, epi);
    __syncthreads();
  }
  base += 3 * 128;
}

DI void phase_kvup(const Prm& p, unsigned char* smem_raw, int l, int& base) {
  u16* smem = (u16*)smem_raw;
  float* st = (float*)(smem_raw + GEMM_SMEM);
  const int tid = tidx();
  TASK_LOOP(t, 4 * 128, base) {
    const int tn = t & 3, tm = t >> 2, n0 = tn * 128, m0 = tm * 128;
    {
      const int row = tid >> 2, qf = tid & 3;
      const u16* src = p.dckv + (size_t)(m0 + row) * 320 + qf * 80;
      float ss = 0.f;
#pragma unroll 5
      for (int c = 0; c < 10; ++c) {
        const u32x4 v = *(const u32x4*)(src + c * 8);
#pragma unroll
        for (int jj = 0; jj < 4; ++jj) { const float a = bflo(v[jj]), b = bfhi(v[jj]); ss += a * a + b * b; }
      }
      ss += __shfl_xor(ss, 1);
      ss += __shfl_xor(ss, 2);
      if (qf == 0) st[row] = rsqrtf(ss * (1.f / 320.f) + 1e-6f);
      __syncthreads();
    }
    const u16* W = p.WkvT + (size_t)l * 512 * 320;
    auto la = [&](int row, int k) __attribute__((always_inline)) { return *(const u32x4*)(W + (size_t)(n0 + row) * 320 + k); };
    auto lb = [&](int row, int k) __attribute__((always_inline)) { return *(const u32x4*)(p.dckv + (size_t)(m0 + row) * 320 + k); };
    auto epi = [&](f32x16 (&acc)[2], int wm, int wn, int lane) __attribute__((always_inline)) {
      const int lr = lane & 31, lh = lane >> 5;
      const int head = tn;
      const int tokl = wn * 32 + lr, tok = m0 + tokl;
      const float sc = st[tokl];
#pragma unroll
      for (int i = 0; i < 2; ++i) {
        const int within = wm * 64 + i * 32;
        const f32x16& a = acc[i];
        if (within < 64) {
#pragma unroll
          for (int q = 0; q < 4; ++q)
            st4bf(p.kc + (size_t)tok * 384 + head * 96 + within + 8 * q + 4 * lh, a[4 * q] * sc, a[4 * q + 1] * sc, a[4 * q + 2] * sc, a[4 * q + 3] * sc);
        } else {
#pragma unroll
          for (int r = 0; r < 16; ++r)
            p.vT[(size_t)(head * 64 + within - 64 + rowmap(r, lh)) * TBP + tok] = f2bf(a[r] * sc);
        }
      }
    };
    gemm_tile<false, false>(smem, 5, la, lb, epi);
    __syncthreads();
  }
  base += 4 * 128;
}

DI void phase_mixb(const Prm& p, unsigned char* smem_raw, int S, int lgS, int& base) {
  float* bt = (float*)smem_raw;
  const int tid = tidx(), lane = tid & 63, wave = tid >> 6, lr = lane & 31, lh = lane >> 5;
  u16* vt = (u16*)(smem_raw + 3328) + wave * (64 * 40);
  for (int idx = tid; idx < 774; idx += NTH) bt[idx] = p.biasT[idx];
  __syncthreads();
  TASK_LOOP(t, 384, base) {
    const int wt = t * 8 + wave;
    const int hg = wt & 1, g = (wt >> 1) % 3, blk = wt / 6;
    const int seq = blk >> (lgS - 5), b_in = blk & ((S >> 5) - 1);
    const int lgd = 2 * g, L = S >> lgd;
    const int lgbpr = lgS - lgd - 5;
    const int res = b_in >> lgbpr, i0 = (b_in & ((1 << lgbpr) - 1)) << 5;
    const int tokbase = seq * S + res;
    const int hd = g * 2 + hg, hc = hd * 64;
    const int qi = i0 + lr;
    const int qtok = tokbase + (qi << lgd);
    bf16x8 qf[4];
#pragma unroll
    for (int ks = 0; ks < 4; ++ks) qf[ks] = *(const bf16x8*)(p.bqkv + (size_t)qtok * 1152 + hc + ks * 16 + lh * 8);
    f32x16 sc[5];
#pragma unroll
    for (int tt = 0; tt < 5; ++tt) {
      int ik = i0 - 64 + 32 * tt + lr;
      ik = min(max(ik, 0), L - 1);
      const u16* kp = p.bqkv + (size_t)(tokbase + (ik << lgd)) * 1152 + 384 + hc + lh * 8;
      sc[tt] = zero16();
#pragma unroll
      for (int ks = 0; ks < 4; ++ks) sc[tt] = mfma(*(const bf16x8*)(kp + ks * 16), qf[ks], sc[tt]);
    }
    float mx = -1e30f;
#pragma unroll
    for (int tt = 0; tt < 5; ++tt)
#pragma unroll
      for (int r = 0; r < 16; ++r) {
        const int ik = i0 - 64 + 32 * tt + rowmap(r, lh);
        const int rel = ik - qi;
        const bool valid = (rel >= -64) && (rel <= 64) && (ik >= 0) && (ik < L);
        const int bi = min(max(rel + 64, 0), 128);
        const float s = valid ? (sc[tt][r] * 0.125f + bt[hd * 129 + bi]) * LOG2E : -1e30f;
        sc[tt][r] = s;
        mx = fmaxf(mx, s);
      }
    mx = fmaxf(mx, __shfl_xor(mx, 32));
    float sum = 0.f;
#pragma unroll
    for (int tt = 0; tt < 5; ++tt)
#pragma unroll
      for (int r = 0; r < 16; ++r) {
        const float pv = ex2(sc[tt][r] - mx);
        sum += pv;
        sc[tt][r] = pv;
      }
    sum += __shfl_xor(sum, 32);
    f32x16 oacc[2];
    oacc[0] = zero16(); oacc[1] = zero16();
#pragma unroll
    for (int tt = 0; tt < 5; ++tt) {
#pragma unroll
      for (int e = 0; e < 4; ++e) {
        const int c = lane + 64 * e, key = c >> 3, dch = c & 7;
        int ik = i0 - 64 + 32 * tt + key;
        ik = min(max(ik, 0), L - 1);
        const u32x4 raw = *(const u32x4*)(p.bqkv + (size_t)(tokbase + (ik << lgd)) * 1152 + 768 + hc + dch * 8);
#pragma unroll
        for (int jj = 0; jj < 4; ++jj) {
          vt[(dch * 8 + 2 * jj) * 40 + key] = (u16)(raw[jj] & 0xffffu);
          vt[(dch * 8 + 2 * jj + 1) * 40 + key] = (u16)(raw[jj] >> 16);
        }
      }
      __syncthreads();
#pragma unroll
      for (int u = 0; u < 2; ++u) {
        u32x4 pk;
#pragma unroll
        for (int jj = 0; jj < 4; ++jj) pk[jj] = pack2(sc[tt][8 * u + 2 * jj], sc[tt][8 * u + 2 * jj + 1]);
        const bf16x8 pf = __builtin_bit_cast(bf16x8, pk);
#pragma unroll
        for (int dt = 0; dt < 2; ++dt) {
          const u16* vp = vt + (dt * 32 + lr) * 40 + 16 * u + 4 * lh;
          u32x4 vv;
          const u32x2 lo = *(const u32x2*)vp, hi = *(const u32x2*)(vp + 8);
          vv[0] = lo[0]; vv[1] = lo[1]; vv[2] = hi[0]; vv[3] = hi[1];
          oacc[dt] = mfma(__builtin_bit_cast(bf16x8, vv), pf, oacc[dt]);
        }
      }
      __syncthreads();
    }
    const float inv = 1.f / sum;
#pragma unroll
    for (int dt = 0; dt < 2; ++dt)
#pragma unroll
      for (int q = 0; q < 4; ++q) {
        float4 o;
        o.x = oacc[dt][4 * q] * inv; o.y = oacc[dt][4 * q + 1] * inv; o.z = oacc[dt][4 * q + 2] * inv; o.w = oacc[dt][4 * q + 3] * inv;
        *(float4*)(p.og + (size_t)qtok * 384 + hc + dt * 32 + 8 * q + 4 * lh) = o;
      }
    if (lh == 0) p.lse[(size_t)qtok * 6 + hd] = (mx + __log2f(sum)) * LN2;
  }
  base += 384;
  __syncthreads();
}

DI void phase_combb(const Prm& p) {
  const int gtid = blockIdx.x * NTH + tidx(), gn = gridDim.x * NTH;
  for (int idx = gtid; idx < TB * 32; idx += gn) {
    const int dq = idx & 15, hg = (idx >> 4) & 1, tok = idx >> 5;
    const float l0 = p.lse[(size_t)tok * 6 + hg], l1 = p.lse[(size_t)tok * 6 + 2 + hg], l2 = p.lse[(size_t)tok * 6 + 4 + hg];
    const float mx = fmaxf(l0, fmaxf(l1, l2));
    const float e0 = __expf(l0 - mx), e1 = __expf(l1 - mx), e2 = __expf(l2 - mx);
    const float inv = 1.f / (e0 + e1 + e2);
    const float4 a = *(const float4*)(p.og + (size_t)tok * 384 + hg * 64 + dq * 4);
    const float4 b = *(const float4*)(p.og + (size_t)tok * 384 + 128 + hg * 64 + dq * 4);
    const float4 c = *(const float4*)(p.og + (size_t)tok * 384 + 256 + hg * 64 + dq * 4);
    st4bf(p.ob + (size_t)tok * 128 + hg * 64 + dq * 4, (e0 * a.x + e1 * b.x + e2 * c.x) * inv, (e0 * a.y + e1 * b.y + e2 * c.y) * inv,
          (e0 * a.z + e1 * b.z + e2 * c.z) * inv, (e0 * a.w + e1 * b.w + e2 * c.w) * inv);
  }
}

constexpr int KS_ELEMS = 128 * 104, VS_ELEMS = 64 * 136;
DI void phase_mla(const Prm& p, unsigned char* smem_raw, int S, int lgS, int& base) {
  u16* Ks = (u16*)smem_raw;
  u16* Vs = Ks + 2 * KS_ELEMS;
  const int tid = tidx(), lane = tid & 63, wave = tid >> 6, lr = lane & 31, lh = lane >> 5;
  const int nkt = S >> 7;
  TASK_LOOP(t, 256, base) {
    const int head = t & 3, qb = t >> 2, tok0 = qb * 256;
    const int seqtok0 = (tok0 >> lgS) << lgS;
    const int qtok = tok0 + wave * 32 + lr;
    bf16x8 qf[6];
#pragma unroll
    for (int ks = 0; ks < 6; ++ks) qf[ks] = *(const bf16x8*)(p.qc + (size_t)qtok * 384 + head * 96 + ks * 16 + lh * 8);
    const u16* kbase = p.kc + (size_t)seqtok0 * 384 + head * 96;
    const u16* vbase = p.vT + (size_t)(head * 64) * TBP + seqtok0;
    u32x4 rk[3], rv[2];
    auto gload = [&](int kt) __attribute__((always_inline)) {
#pragma unroll
      for (int e = 0; e < 3; ++e) {
        const int c = tid + NTH * e, key = c / 12, dc = c - key * 12;
        rk[e] = *(const u32x4*)(kbase + (size_t)(kt * 128 + key) * 384 + dc * 8);
      }
#pragma unroll
      for (int e = 0; e < 2; ++e) {
        const int c = tid + NTH * e, d = c >> 4, kch = c & 15;
        rv[e] = *(const u32x4*)(vbase + (size_t)d * TBP + kt * 128 + kch * 8);
      }
    };
    auto sstore = [&](int buf) __attribute__((always_inline)) {
#pragma unroll
      for (int e = 0; e < 3; ++e) {
        const int c = tid + NTH * e, key = c / 12, dc = c - key * 12;
        *(u32x4*)(Ks + buf * KS_ELEMS + key * 104 + dc * 8) = rk[e];
      }
#pragma unroll
      for (int e = 0; e < 2; ++e) {
        const int c = tid + NTH * e, d = c >> 4, kch = c & 15;
        u16* vd = Vs + buf * VS_ELEMS + d * 136 + (kch >> 1) * 16 + (kch & 1) * 4;
        u32x2 lo, hi;
        lo[0] = rv[e][0]; lo[1] = rv[e][1]; hi[0] = rv[e][2]; hi[1] = rv[e][3];
        *(u32x2*)vd = lo;
        *(u32x2*)(vd + 8) = hi;
      }
    };
    float m = -1e30f;
    f32x2 lsum2 = {0.f, 0.f};
    f32x16 oacc[2];
    oacc[0] = zero16(); oacc[1] = zero16();
    gload(0);
    sstore(0);
    __syncthreads();
    for (int kt = 0; kt < nkt; ++kt) {
      const int buf = kt & 1;
      if (kt + 1 < nkt) gload(kt + 1);
      f32x16 s[4];
#pragma unroll
      for (int kk = 0; kk < 4; ++kk) s[kk] = zero16();
      {
        const u16* kp = Ks + buf * KS_ELEMS + lr * 104 + lh * 8;
        bf16x8 kf[4];
#pragma unroll
        for (int kk = 0; kk < 4; ++kk) kf[kk] = *(const bf16x8*)(kp + kk * 32 * 104);
#pragma unroll
        for (int ks = 0; ks < 6; ++ks) {
          bf16x8 kn[4];
          if (ks < 5) {
#pragma unroll
            for (int kk = 0; kk < 4; ++kk) kn[kk] = *(const bf16x8*)(kp + kk * 32 * 104 + (ks + 1) * 16);
          }
#pragma unroll
          for (int kk = 0; kk < 4; ++kk) s[kk] = mfma(kf[kk], qf[ks], s[kk]);
          if (ks < 5) {
#pragma unroll
            for (int kk = 0; kk < 4; ++kk) kf[kk] = kn[kk];
          }
        }
      }
      float mloc = -1e30f;
#pragma unroll
      for (int kk = 0; kk < 4; ++kk)
#pragma unroll
        for (int r = 0; r < 16; ++r) mloc = fmaxf(mloc, s[kk][r]);
      mloc = fmaxf(mloc, __shfl_xor(mloc, 32));
      const float mnew = fmaxf(m, mloc);
      const float alpha = ex2(m - mnew);
      m = mnew;
      lsum2 *= alpha;
      const f32x2 mn2 = {mnew, mnew};
#pragma unroll
      for (int kk = 0; kk < 4; ++kk)
#pragma unroll
        for (int r2 = 0; r2 < 8; ++r2) {
          f32x2 v = {s[kk][2 * r2], s[kk][2 * r2 + 1]};
          v = v - mn2;
          f32x2 pv;
          pv[0] = ex2(v[0]); pv[1] = ex2(v[1]);
          lsum2 += pv;
          s[kk][2 * r2] = pv[0]; s[kk][2 * r2 + 1] = pv[1];
        }
#pragma unroll
      for (int dt = 0; dt < 2; ++dt)
#pragma unroll
        for (int r = 0; r < 16; ++r) oacc[dt][r] *= alpha;
#pragma unroll
      for (int kk = 0; kk < 4; ++kk)
#pragma unroll
        for (int u = 0; u < 2; ++u) {
          u32x4 pk;
#pragma unroll
          for (int jj = 0; jj < 4; ++jj) pk[jj] = pack2(s[kk][8 * u + 2 * jj], s[kk][8 * u + 2 * jj + 1]);
          const bf16x8 pf = __builtin_bit_cast(bf16x8, pk);
#pragma unroll
          for (int dt = 0; dt < 2; ++dt) {
            const u16* vp = Vs + buf * VS_ELEMS + (dt * 32 + lr) * 136 + kk * 32 + 16 * u + 8 * lh;
            oacc[dt] = mfma(*(const bf16x8*)vp, pf, oacc[dt]);
          }
        }
      if (kt + 1 < nkt) sstore(buf ^ 1);
      __syncthreads();
    }
    float lsum = lsum2[0] + lsum2[1];
    lsum += __shfl_xor(lsum, 32);
    const float inv = 1.f / lsum;
#pragma unroll
    for (int dt = 0; dt < 2; ++dt)
#pragma unroll
      for (int q = 0; q < 4; ++q)
        st4bf(p.od + (size_t)qtok * 256 + head * 64 + dt * 32 + 8 * q + 4 * lh, oacc[dt][4 * q] * inv, oacc[dt][4 * q + 1] * inv,
              oacc[dt][4 * q + 2] * inv, oacc[dt][4 * q + 3] * inv);
  }
  base += 256;
}

template <class ACC>
DI void merge_branch(const Prm& p, u16* smem, const u16* W, const u16* X, int ld, int bi, int n0, int m0, ACC& macc) {
  auto la = [&](int row, int k) __attribute__((always_inline)) { return *(const u32x4*)(W + (size_t)(n0 + row) * ld + k); };
  auto lb = [&](int row, int k) __attribute__((always_inline)) { return *(const u32x4*)(X + (size_t)(m0 + row) * ld + k); };
  auto epi = [&](f32x16 (&acc)[2], int wm, int wn, int lane) __attribute__((always_inline)) {
    const int lr = lane & 31, lh = lane >> 5;
    const int tok = m0 + wn * 32 + lr;
#pragma unroll
    for (int i = 0; i < 2; ++i)
#pragma unroll
      for (int q = 0; q < 4; ++q) {
        const int n = n0 + wm * 64 + i * 32 + 8 * q + 4 * lh;
        const u32x2 gz = *(const u32x2*)(p.zg + (size_t)tok * 4096 + bi * 1024 + n);
        macc[i][4 * q] += bflo(gz[0]) * acc[i][4 * q];
        macc[i][4 * q + 1] += bfhi(gz[0]) * acc[i][4 * q + 1];
        macc[i][4 * q + 2] += bflo(gz[1]) * acc[i][4 * q + 2];
        macc[i][4 * q + 3] += bfhi(gz[1]) * acc[i][4 * q + 3];
      }
  };
  gemm_tile<false, false>(smem, ld >> 6, la, lb, epi);
}

DI void phase_merge(const Prm& p, u16* smem, int l, int& base) {
  TASK_LOOP(t, 8 * 128, base) {
    const int tn = t & 7, tm = t >> 3, n0 = tn * 128, m0 = tm * 128;
    f32x16 macc[2];
    macc[0] = zero16(); macc[1] = zero16();
    merge_branch(p, smem, p.PaT + (size_t)l * 1024 * 768, p.UT, 768, 0, n0, m0, macc);
    merge_branch(p, smem, p.PbT + (size_t)l * 1024 * 128, p.ob, 128, 1, n0, m0, macc);
    merge_branch(p, smem, p.PcT + (size_t)l * 1024 * 384, p.cu, 384, 2, n0, m0, macc);
    merge_branch(p, smem, p.PdT + (size_t)l * 1024 * 256, p.od, 256, 3, n0, m0, macc);
    const int tid2 = tidx(), lane = tid2 & 63, wave = tid2 >> 6, wm = wave >> 2, wn = wave & 3, lr = lane & 31, lh = lane >> 5;
    const int tok = m0 + wn * 32 + lr;
#pragma unroll
    for (int i = 0; i < 2; ++i)
#pragma unroll
      for (int q = 0; q < 4; ++q)
        st4bf(p.hbuf + (size_t)tok * 1024 + n0 + wm * 64 + i * 32 + 8 * q + 4 * lh, macc[i][4 * q], macc[i][4 * q + 1],
              macc[i][4 * q + 2], macc[i][4 * q + 3]);
  }
  base += 8 * 128;
}

DI void phase_resid_gemm(const Prm& p, unsigned char* smem_raw, const u16* W, const u16* X, int K, const float* xsrc, float* xdst,
                         const float* modl, int gtoff, int sb, int& base) {
  LAS u16* shm = (LAS u16*)smem_raw;
  bool pre = false;
  TASK_LOOP(t, 4 * 64, base) {
    int tn, tm;
    map256(t, 4, tn, tm);
    const int brow = tn * 256, bcol = tm * 256;
    const int tnx = t + (int)gridDim.x;
    const bool has_next = tnx < (4 * 64);
    int tn2 = 0, tm2 = 0;
    if (has_next) map256(tnx, 4, tn2, tm2);
    const int nbrow = tn2 * 256, nbcol = tm2 * 256;
    auto epi = [&](f32x4 (&acc)[2][2][4][2], int wr, int wc, int fr, int fq) __attribute__((always_inline)) {
#pragma unroll
      for (int bj = 0; bj < 2; ++bj)
#pragma unroll
        for (int n = 0; n < 2; ++n) {
          const int tok = bcol + bj * 128 + wc * 32 + n * 16 + fr;
          const float* gt = modl + condrow(sb, tok) * 6144 + gtoff;
#pragma unroll
          for (int ai = 0; ai < 2; ++ai)
#pragma unroll
            for (int m = 0; m < 4; ++m) {
              const int nn = brow + ai * 128 + wr * 64 + m * 16 + fq * 4;
              const f32x4 v = acc[ai][bj][m][n];
              const float4 g4 = *(const float4*)(gt + nn);
              const float4 xi = *(const float4*)(xsrc + (size_t)tok * 1024 + nn);
              float4 o;
              o.x = xi.x + g4.x * v[0]; o.y = xi.y + g4.y * v[1]; o.z = xi.z + g4.z * v[2]; o.w = xi.w + g4.w * v[3];
              *(float4*)(xdst + (size_t)tok * 1024 + nn) = o;
            }
        }
    };
    gemm256(shm, W, X, K, brow, bcol, pre, has_next, nbrow, nbcol, epi);
    pre = has_next;
  }
  base += 4 * 64;
}

DI void phase_w1(const Prm& p, unsigned char* smem_raw, int l, int& base) {
  const u16* W = p.W1T + (size_t)l * 4096 * 1024;
  LAS u16* shm = (LAS u16*)smem_raw;
  bool pre = false;
  TASK_LOOP(t, 16 * 64, base) {
    int tn, tm;
    map256(t, 16, tn, tm);
    const int brow = tn * 256, bcol = tm * 256;
    const int tnx = t + (int)gridDim.x;
    const bool has_next = tnx < (16 * 64);
    int tn2 = 0, tm2 = 0;
    if (has_next) map256(tnx, 16, tn2, tm2);
    const int nbrow = tn2 * 256, nbcol = tm2 * 256;
    auto epi = [&](f32x4 (&acc)[2][2][4][2], int wr, int wc, int fr, int fq) __attribute__((always_inline)) {
#pragma unroll
      for (int bj = 0; bj < 2; ++bj)
#pragma unroll
        for (int n = 0; n < 2; ++n) {
          const int tok = bcol + bj * 128 + wc * 32 + n * 16 + fr;
#pragma unroll
          for (int ai = 0; ai < 2; ++ai)
#pragma unroll
            for (int m = 0; m < 4; ++m) {
              const int nn = brow + ai * 128 + wr * 64 + m * 16 + fq * 4;
              const f32x4 v = acc[ai][bj][m][n];
              const float a0 = fmaxf(v[0], 0.f), a1 = fmaxf(v[1], 0.f), a2 = fmaxf(v[2], 0.f), a3 = fmaxf(v[3], 0.f);
              st4bf(p.zg + (size_t)tok * 4096 + nn, a0 * a0, a1 * a1, a2 * a2, a3 * a3);
            }
        }
    };
    gemm256(shm, W, p.hbuf, 1024, brow, bcol, pre, has_next, nbrow, nbcol, epi);
    pre = has_next;
  }
  base += 16 * 64;
}

DI void phase_final(const Prm& p) {
  const int tid = tidx(), lane = tid & 63;
  const int gw = blockIdx.x * 8 + (tid >> 6), nw = gridDim.x * 8;
  for (int row = gw; row < 3 * TB; row += nw) {
    float* xr = p.out + (size_t)row * 1024;
    float4 v[4];
    float ss = 0.f;
#pragma unroll
    for (int i = 0; i < 4; ++i) {
      v[i] = *(const float4*)(xr + i * 256 + lane * 4);
      ss += v[i].x * v[i].x + v[i].y * v[i].y + v[i].z * v[i].z + v[i].w * v[i].w;
    }
#pragma unroll
    for (int off = 32; off >= 1; off >>= 1) ss += __shfl_xor(ss, off);
    const float rstd = rsqrtf(ss * (1.f / 1024.f) + 1e-6f);
#pragma unroll
    for (int i = 0; i < 4; ++i) {
      const int col = i * 256 + lane * 4;
      const float4 gg = *(const float4*)(p.final_g + col);
      float4 o;
      o.x = v[i].x * rstd * gg.x; o.y = v[i].y * rstd * gg.y; o.z = v[i].z * rstd * gg.z; o.w = v[i].w * rstd * gg.w;
      *(float4*)(xr + col) = o;
    }
  }
}

__global__ void __launch_bounds__(512) mega(Prm p) {
  cg::grid_group grid = cg::this_grid();
  __shared__ __attribute__((aligned(16))) unsigned char smem_raw[SMEM_BYTES];
  __shared__ uint4 xb_words;
  u16* smem = (u16*)smem_raw;
  if (threadIdx.x == 0) xb_words = make_uint4(0u, 0u, 0u, 0u);
  __syncthreads();
  const XcdBarrier xb = xcd_barrier_post(p.bar, (volatile LAS unsigned*)&xb_words);
  int base = 0;
  prologue_a(p, smem_raw, base);
  if (PROBE == 11) prologue_a(p, smem_raw, base);
  grid.sync();
  prologue_b(p);
  xcd_barrier(xb);
  for (int sb = 0; sb < 3; ++sb) {
    const int S = sb == 0 ? 16384 : 2048, lgS = sb == 0 ? 14 : 11, nseq = sb == 0 ? 1 : 8;
    const int N1 = S >> 7, lgN1 = lgS - 7;
    const float* xin = sb == 0 ? p.x_prompt : p.x_sample + (size_t)(sb - 1) * TB * 1024;
    float* xo = p.out + (size_t)sb * TB * 1024;
    for (int l = 0; l < 4; ++l) {
      const float* xs = l == 0 ? xin : xo;
      const float* modl = p.mod + (size_t)l * 17 * 6144;
      phase_norm(p, xs, p.norm1_g + l * 1024, modl, 0, 1024, sb);
      xcd_barrier(xb);
      phase_inproj(p, smem_raw, l, S, base);
      if (PROBE == 2 || PROBE == 7) phase_inproj(p, smem_raw, l, S, base);
      if (PROBE == 12) phase_inproj_probe(p, smem_raw, l, base);
      xcd_barrier(xb);
      if (PROBE == 5) xcd_barrier(xb);
      if (N1 == 16) phase_fft1_small(p, nseq); else phase_fft1(p, smem, S, nseq, N1, lgN1, base);
      phase_mixb(p, smem_raw, S, lgS, base);
      phase_mixc(p, smem_raw, l, base);
      phase_qup(p, smem_raw, l, S, base);
      phase_kvup(p, smem_raw, l, base);
      phase_inproj_tail(p, smem_raw, l, base);
      if (PROBE == 13) phase_fft1(p, smem, S, nseq, N1, lgN1, base);
      if (PROBE == 14) phase_mixb(p, smem_raw, S, lgS, base);
      if (PROBE == 15) { phase_qup(p, smem_raw, l, S, base); phase_kvup(p, smem_raw, l, base); phase_inproj_tail(p, smem_raw, l, base); }
      if (PROBE == 4) { phase_fft1(p, smem, S, nseq, N1, lgN1, base); phase_mixb(p, smem_raw, S, lgS, base); phase_qup(p, smem_raw, l, S, base); phase_kvup(p, smem_raw, l, base); }
      xcd_barrier(xb);
      if (PROBE == 5) xcd_barrier(xb);
      phase_mla(p, smem_raw, S, lgS, base);
      if (PROBE == 1) phase_mla(p, smem_raw, S, lgS, base);
      phase_fft2(p, smem, S, nseq, N1, base);
      phase_combb(p);
      if (PROBE == 6) { phase_fft2(p, smem, S, nseq, N1, base); phase_combb(p); }
      xcd_barrier(xb);
      if (PROBE == 5) xcd_barrier(xb);
      phase_merge(p, smem, l, base);
      if (PROBE == 3) phase_merge(p, smem, l, base);
      xcd_barrier(xb);
      if (PROBE == 5) xcd_barrier(xb);
      phase_resid_gemm(p, smem_raw, p.WoT + (size_t)l * 1024 * 1024, p.hbuf, 1024, xs, xo, modl, 2048, sb, base);
      xcd_barrier(xb);
      phase_norm(p, xo, p.norm2_g + l * 1024, modl, 3072, 4096, sb);
      if (PROBE == 9) { phase_norm(p, xo, p.norm2_g + l * 1024, modl, 3072, 4096, sb); phase_norm(p, xo, p.norm2_g + l * 1024, modl, 3072, 4096, sb); }
      xcd_barrier(xb);
      phase_w1(p, smem_raw, l, base);
      if (PROBE == 2 || PROBE == 8) phase_w1(p, smem_raw, l, base);
      xcd_barrier(xb);
      if (PROBE == 5) xcd_barrier(xb);
      phase_resid_gemm(p, smem_raw, p.W2T + (size_t)l * 1024 * 4096, p.zg, 4096, xo, xo, modl, 5120, sb, base);
      xcd_barrier(xb);
    }
  }
  phase_final(p);
}

extern "C" void kernel_launch(void* const* d_in, const int* in_sizes, int n_in, void* d_out, int out_size, void* d_ws, size_t ws_size,
                              hipStream_t stream) {
  Prm p{};
  const float* const* in = (const float* const*)d_in;
  p.x_prompt = in[0]; p.x_sample = in[1]; p.c_prompt = in[2]; p.c_sample = in[3]; p.rel_bias = in[4]; p.ada_w = in[5]; p.ada_b = in[6];
  p.norm1_g = in[7]; p.w_in = in[8]; p.qn_g = in[9]; p.kvn_g = in[10]; p.w_uq = in[11]; p.w_ukv = in[12]; p.ln_g = in[13]; p.ln_b = in[14];
  p.sgu_w = in[15]; p.sgu_b = in[16]; p.p_a = in[17]; p.p_b = in[18]; p.p_c = in[19]; p.p_d = in[20]; p.w_o = in[21]; p.norm2_g = in[22];
  p.w1 = in[23]; p.w2 = in[24]; p.final_g = in[25];
  p.out = (float*)d_out;
  char* w = (char*)d_ws;
  size_t off = 0;
  auto take = [&](size_t bytes) __attribute__((always_inline)) { void* r = w + off; off += (bytes + 255) & ~(size_t)255; return r; };
  p.WinT = (u16*)take((size_t)4 * NWP * 1024 * 2);
  p.W1T = (u16*)take((size_t)4 * 4096 * 1024 * 2);
  p.W2T = (u16*)take((size_t)4 * 4096 * 1024 * 2);
  p.WoT = (u16*)take((size_t)4 * 1024 * 1024 * 2);
  p.PaT = (u16*)take((size_t)4 * 1024 * 768 * 2);
  p.PbT = (u16*)take((size_t)4 * 1024 * 128 * 2);
  p.PcT = (u16*)take((size_t)4 * 1024 * 384 * 2);
  p.PdT = (u16*)take((size_t)4 * 1024 * 256 * 2);
  p.WqT = (u16*)take((size_t)4 * 384 * 384 * 2);
  p.WkvT = (u16*)take((size_t)4 * 512 * 320 * 2);
  p.SgW = (u16*)take((size_t)4 * 4 * 128 * 128 * 2);
  p.M1a = (u16*)take(256 * 256 * 2);
  p.M1b = (u16*)take(32 * 64 * 2);
  p.M2 = (u16*)take(128 * 256 * 2);
  p.tw = (float2*)take(16384 * 8);
  p.rope = (float2*)take((size_t)16384 * 16 * 8);
  p.biasT = (float*)take(6 * 129 * 4);
  p.mod = (float*)take((size_t)4 * 17 * 6144 * 4);
  p.hbuf = (u16*)take((size_t)TB * 1024 * 2);
  p.og = (float*)take((size_t)TB * 384 * 4);
  p.UT = (u16*)take((size_t)1536 * TBP * 2);
  p.Gp = (u16*)take((size_t)1536 * TB * 2);
  p.bqkv = (u16*)take((size_t)TB * 1152 * 2);
  p.ob = (u16*)take((size_t)TB * 128 * 2);
  p.cu = (u16*)take((size_t)TB * 384 * 2);
  p.cvT = (u16*)take((size_t)TBP * 384 * 2);
  p.dcq = (u16*)take((size_t)TB * 384 * 2);
  p.dckv = (u16*)take((size_t)TB * 320 * 2);
  p.qc = (u16*)take((size_t)TB * 384 * 2);
  p.kc = (u16*)take((size_t)TB * 384 * 2);
  p.vT = (u16*)take((size_t)TBP * 256 * 2);
  p.od = (u16*)take((size_t)TB * 256 * 2);
  p.lse = (float*)take((size_t)TB * 6 * 4);
  p.zg = (u16*)take((size_t)TB * 4096 * 2);
  p.bar = (unsigned*)take(XCD_BAR_WORDS * 4);
  p.modpart = (float*)p.zg;
  if (off > ws_size) { fprintf(stderr, "workspace too small: need %zu have %zu\n", off, ws_size); return; }
  static int grid_blocks = 0;
  if (!grid_blocks) {
    int dev = 0, cus = 0, per_cu = 0;
    (void)hipGetDevice(&dev);
    (void)hipDeviceGetAttribute(&cus, hipDeviceAttributeMultiprocessorCount, dev);
    (void)hipOccupancyMaxActiveBlocksPerMultiprocessor(&per_cu, mega, NTH, 0);
    if (per_cu < 1) per_cu = 1;
    if (per_cu > 1) per_cu = 1;
    grid_blocks = cus * per_cu;
  }
  (void)hipMemsetAsync(p.bar, 0, XCD_BAR_WORDS * 4, stream);
  void* args[] = {&p};
  hipError_t e = hipLaunchCooperativeKernel((void*)mega, dim3(grid_blocks), dim3(NTH), args, 0, stream);
  if (e != hipSuccess) fprintf(stderr, "cooperative launch failed: %s (grid %d)\n", hipGetErrorString(e), grid_blocks);
}
```

```cpp
#include <hip/hip_runtime.h>
#include <hip/hip_cooperative_groups.h>
#include <stdint.h>
#include <stdio.h>
namespace cg = cooperative_groups;

#define DI __device__ __forceinline__
#define LAS __attribute__((address_space(3)))
typedef unsigned short u16;
typedef __attribute__((ext_vector_type(8))) short bf16x8;
typedef __attribute__((ext_vector_type(4))) short bf16x4;
typedef __attribute__((ext_vector_type(16))) float f32x16;
typedef __attribute__((ext_vector_type(4))) float f32x4;
typedef __attribute__((ext_vector_type(2))) float f32x2;
typedef __attribute__((ext_vector_type(4))) unsigned u32x4;
typedef __attribute__((ext_vector_type(2))) unsigned u32x2;
typedef __attribute__((ext_vector_type(2))) __bf16 bf2_t;

constexpr int TB = 16384;
constexpr int TBP = TB + 64;
constexpr int NW = 8288;
constexpr int NWP = 8320;
constexpr int LDT = 72;
constexpr int TILE_ELEMS = 128 * LDT;
constexpr int GEMM_SMEM = 4 * TILE_ELEMS * 2;
constexpr int SMEM_BYTES = 131072;
#ifndef PROBE
#define PROBE 0
#endif
constexpr int NTH = 512;
constexpr int HT = 128 * 64;
constexpr float LOG2E = 1.4426950408889634f;
constexpr float LN2 = 0.6931471805599453f;

struct Prm {
  const float *x_prompt, *x_sample, *c_prompt, *c_sample, *rel_bias, *ada_w, *ada_b, *norm1_g, *w_in,
      *qn_g, *kvn_g, *w_uq, *w_ukv, *ln_g, *ln_b, *sgu_w, *sgu_b, *p_a, *p_b, *p_c, *p_d, *w_o,
      *norm2_g, *w1, *w2, *final_g;
  float* out;
  u16 *WinT, *W1T, *W2T, *WoT, *PaT, *PbT, *PcT, *PdT, *WqT, *WkvT, *SgW, *M1a, *M1b, *M2;
  float2 *tw, *rope;
  float *biasT, *mod, *modpart;
  u16 *hbuf, *UT, *Gp, *bqkv, *ob, *cu, *cvT, *dcq, *dckv, *qc, *kc, *vT, *od, *zg;
  float *og, *lse;
  unsigned* bar;
};

DI unsigned pack2(float a, float b) { bf2_t v; v[0] = (__bf16)a; v[1] = (__bf16)b; return __builtin_bit_cast(unsigned, v); }
DI u16 f2bf(float a) { return __builtin_bit_cast(u16, (__bf16)a); }
DI float bf2f(u16 v) { return __uint_as_float(((unsigned)v) << 16); }
DI float bflo(unsigned w) { return __uint_as_float(w << 16); }
DI float bfhi(unsigned w) { return __uint_as_float(w & 0xffff0000u); }
DI void st4bf(u16* dst, float a, float b, float c, float d) { u32x2 v; v[0] = pack2(a, b); v[1] = pack2(c, d); *(u32x2*)dst = v; }
DI void st4bf_nt(u16* dst, float a, float b, float c, float d) { u32x2 v; v[0] = pack2(a, b); v[1] = pack2(c, d); __builtin_nontemporal_store(v, (u32x2*)dst); }
DI int rowmap(int r, int lh) { return (r & 3) + 8 * (r >> 2) + 4 * lh; }
DI f32x16 mfma(bf16x8 a, bf16x8 b, f32x16 c) { return __builtin_amdgcn_mfma_f32_32x32x16_bf16(a, b, c, 0, 0, 0); }
DI u32x4 zero4() { u32x4 z; z[0] = 0; z[1] = 0; z[2] = 0; z[3] = 0; return z; }
DI f32x16 zero16() { f32x16 z; for (int i = 0; i < 16; ++i) z[i] = 0.f; return z; }
DI float ex2(float x) { return __builtin_amdgcn_exp2f(x); }
DI int tidx() { int t = threadIdx.x; asm volatile("" : "+v"(t)); return t; }


#define XB_TMO      128
#define XB_XCNT(j)  (256  + 64 * (j))
#define XB_XSUB(j)  (1280 + 64 * (j))
#define XB_XGEN(j)  (2304 + 64 * (j))
#define XB_TOP      3328
#define XB_TOPGEN   3392
#define XCD_BAR_WORDS 3456
#define XB_SPIN_CAP (1u << 18)
DI unsigned xb_ld(unsigned* p) { return __hip_atomic_load(p, __ATOMIC_RELAXED, __HIP_MEMORY_SCOPE_AGENT); }
DI unsigned xb_add(unsigned* p, unsigned v) { return __hip_atomic_fetch_add(p, v, __ATOMIC_RELAXED, __HIP_MEMORY_SCOPE_AGENT); }
DI unsigned xb_xcc_id() { return (unsigned)__builtin_amdgcn_s_getreg((3 << 11) | 20) & 0xFu; }
#define XB_SPIN(cond, bar) do { unsigned _sp = 0; while (cond) { __builtin_amdgcn_s_sleep(1); \
    if ((++_sp & 255u) == 0u) { if (xb_ld(&(bar)[XB_TMO])) break; if (_sp > XB_SPIN_CAP) { atomicAdd(&(bar)[XB_TMO], 1u); break; } } } } while (0)
struct XcdBarrier { unsigned* bar; unsigned x; volatile LAS unsigned* st; };
DI XcdBarrier xcd_barrier_post(unsigned* bar, volatile LAS unsigned* st) {
  XcdBarrier b; b.bar = bar; b.x = xb_xcc_id(); b.st = st;
  if (threadIdx.x == 0) (void)xb_add(&bar[XB_XCNT(b.x)], 1u);
  return b;
}
DI void xcd_barrier_complete(unsigned* bar, unsigned x, unsigned& nloc, unsigned& nx) {
  const unsigned G = gridDim.x * gridDim.y * gridDim.z;
  unsigned sum, cnt, mine, sp = 0u;
  for (;;) {
    sum = 0u; cnt = 0u; mine = 0u;
#pragma unroll
    for (unsigned j = 0; j < 16; ++j) { const unsigned c = xb_ld(&bar[XB_XCNT(j)]); sum += c; cnt += (c > 0u) ? 1u : 0u; mine = (j == x) ? c : mine; }
    if (sum == G) break;
    __builtin_amdgcn_s_sleep(1);
    if ((++sp & 255u) == 0u) { if (xb_ld(&bar[XB_TMO])) break; if (sp > XB_SPIN_CAP) { atomicAdd(&bar[XB_TMO], 1u); break; } }
  }
  nloc = mine > 0u ? mine : 1u; nx = cnt > 0u ? cnt : 1u;
}
DI void xcd_barrier(const XcdBarrier& b) {
  asm volatile("s_waitcnt vmcnt(0)" ::: "memory");
  __syncthreads();
  if (tidx() == 0) {
    unsigned* bar = b.bar;
    const unsigned bx = (unsigned)__builtin_amdgcn_readfirstlane((int)xb_xcc_id());
    __builtin_amdgcn_s_waitcnt(0);
    unsigned nloc = b.st[0], nx = b.st[1];
    if (nloc == 0u) { xcd_barrier_complete(bar, bx, nloc, nx); b.st[0] = nloc; b.st[1] = nx; }
    const unsigned old = xb_add(&bar[XB_XSUB(bx)], 1u);
    const unsigned gen = old / nloc;
    if (old + 1u == (gen + 1u) * nloc) {
      __builtin_amdgcn_fence(__ATOMIC_RELEASE, "agent");
      asm volatile("s_waitcnt vmcnt(0)" ::: "memory");
      const unsigned og = xb_add(&bar[XB_TOP], 1u);
      const unsigned tg = og / nx;
      if (og + 1u == (tg + 1u) * nx) xb_add(&bar[XB_TOPGEN], 1u);
      else XB_SPIN(xb_ld(&bar[XB_TOPGEN]) == tg, bar);
      __builtin_amdgcn_fence(__ATOMIC_ACQUIRE, "agent");
      xb_add(&bar[XB_XGEN(bx)], 1u);
      asm volatile("s_waitcnt vmcnt(0)" ::: "memory");
    } else {
      XB_SPIN(xb_ld(&bar[XB_XGEN(bx)]) == gen, bar);
      __builtin_amdgcn_fence(__ATOMIC_ACQUIRE, "agent");
      asm volatile("s_waitcnt vmcnt(0)" ::: "memory");
    }
  }
  __syncthreads();
}

#define TASK_LOOP(t, nt, base) for (int t = (int)((blockIdx.x + gridDim.x - ((unsigned)(base) % gridDim.x)) % gridDim.x); t < (nt); t += gridDim.x)

template <bool RFA, bool RFB, class LA, class LB, class EPI>
DI void gemm_tile(u16* smem, int nk, LA la, LB lb, EPI epi) {
  const int tid = tidx(), lane = tid & 63, wave = tid >> 6;
  const int wm = wave >> 2, wn = wave & 3, lr = lane & 31, lh = lane >> 5;
  u16* As = smem;
  u16* Bs = smem + 2 * TILE_ELEMS;
  f32x16 acc[2];
  acc[0] = zero16(); acc[1] = zero16();
  u32x4 ra[2], rb[2];
#define A_ROW(c) (RFA ? ((c) & 127) : ((c) >> 3))
#define A_KC(c) (RFA ? ((c) >> 7) : ((c) & 7))
#define B_ROW(c) (RFB ? ((c) & 127) : ((c) >> 3))
#define B_KC(c) (RFB ? ((c) >> 7) : ((c) & 7))
#pragma unroll
  for (int i = 0; i < 2; ++i) { const int c = tid + NTH * i; ra[i] = la(A_ROW(c), A_KC(c) * 8); rb[i] = lb(B_ROW(c), B_KC(c) * 8); }
#pragma unroll
  for (int i = 0; i < 2; ++i) {
    const int c = tid + NTH * i;
    *(u32x4*)(As + A_ROW(c) * LDT + A_KC(c) * 8) = ra[i];
    *(u32x4*)(Bs + B_ROW(c) * LDT + B_KC(c) * 8) = rb[i];
  }
  __syncthreads();
  for (int kt = 0; kt < nk; ++kt) {
    const int buf = kt & 1;
    if (kt + 1 < nk) {
      const int k0 = (kt + 1) * 64;
#pragma unroll
      for (int i = 0; i < 2; ++i) { const int c = tid + NTH * i; ra[i] = la(A_ROW(c), k0 + A_KC(c) * 8); rb[i] = lb(B_ROW(c), k0 + B_KC(c) * 8); }
    }
    const u16* Ab = As + buf * TILE_ELEMS + (wm * 64 + lr) * LDT + lh * 8;
    const u16* Bb = Bs + buf * TILE_ELEMS + (wn * 32 + lr) * LDT + lh * 8;
#pragma unroll
    for (int ks = 0; ks < 4; ++ks) {
      const bf16x8 a0 = *(const bf16x8*)(Ab + ks * 16);
      const bf16x8 a1 = *(const bf16x8*)(Ab + 32 * LDT + ks * 16);
      const bf16x8 b = *(const bf16x8*)(Bb + ks * 16);
      acc[0] = mfma(a0, b, acc[0]);
      acc[1] = mfma(a1, b, acc[1]);
    }
    if (kt + 1 < nk) {
      u16* Aw = As + (buf ^ 1) * TILE_ELEMS;
      u16* Bw = Bs + (buf ^ 1) * TILE_ELEMS;
#pragma unroll
      for (int i = 0; i < 2; ++i) {
        const int c = tid + NTH * i;
        *(u32x4*)(Aw + A_ROW(c) * LDT + A_KC(c) * 8) = ra[i];
        *(u32x4*)(Bw + B_ROW(c) * LDT + B_KC(c) * 8) = rb[i];
      }
    }
    __syncthreads();
  }
  epi(acc, wm, wn, lane);
}

template <bool RFA, bool RFB, class LA, class LB, class EPI>
DI void gemm_tile2s(u16* smem, int nk, LA la, LB lb, EPI epi) {
  const int tid = tidx(), lane = tid & 63, wave = tid >> 6;
  const int wm = wave >> 2, wn = wave & 3, lr = lane & 31, lh = lane >> 5;
  u16* As = smem;
  u16* Bs = smem + 2 * TILE_ELEMS;
  f32x16 acc[2];
  acc[0] = zero16(); acc[1] = zero16();
  u32x4 ra0[2], rb0[2], ra1[2], rb1[2];
  auto ld = [&](u32x4 (&ra)[2], u32x4 (&rb)[2], int kt) __attribute__((always_inline)) {
    const int k0 = kt * 64;
#pragma unroll
    for (int i = 0; i < 2; ++i) { const int c = tid + NTH * i; ra[i] = la(A_ROW(c), k0 + A_KC(c) * 8); rb[i] = lb(B_ROW(c), k0 + B_KC(c) * 8); }
  };
  auto stl = [&](u32x4 (&ra)[2], u32x4 (&rb)[2], int buf) __attribute__((always_inline)) {
#pragma unroll
    for (int i = 0; i < 2; ++i) {
      const int c = tid + NTH * i;
      *(u32x4*)(As + buf * TILE_ELEMS + A_ROW(c) * LDT + A_KC(c) * 8) = ra[i];
      *(u32x4*)(Bs + buf * TILE_ELEMS + B_ROW(c) * LDT + B_KC(c) * 8) = rb[i];
    }
  };
  auto compute = [&](int buf) __attribute__((always_inline)) {
    const u16* Ab = As + buf * TILE_ELEMS + (wm * 64 + lr) * LDT + lh * 8;
    const u16* Bb = Bs + buf * TILE_ELEMS + (wn * 32 + lr) * LDT + lh * 8;
#pragma unroll
    for (int ks = 0; ks < 4; ++ks) {
      const bf16x8 a0 = *(const bf16x8*)(Ab + ks * 16);
      const bf16x8 a1 = *(const bf16x8*)(Ab + 32 * LDT + ks * 16);
      const bf16x8 b = *(const bf16x8*)(Bb + ks * 16);
      acc[0] = mfma(a0, b, acc[0]);
      acc[1] = mfma(a1, b, acc[1]);
    }
  };
  ld(ra0, rb0, 0);
  if (nk > 1) ld(ra1, rb1, 1);
  stl(ra0, rb0, 0);
  if (nk > 2) ld(ra0, rb0, 2);
  __syncthreads();
#pragma unroll 1
  for (int kt = 0; kt < nk; kt += 2) {
    compute(0);
    if (kt + 1 < nk) { stl(ra1, rb1, 1); if (kt + 3 < nk) ld(ra1, rb1, kt + 3); }
    __syncthreads();
    if (kt + 1 < nk) {
      compute(1);
      if (kt + 2 < nk) { stl(ra0, rb0, 0); if (kt + 4 < nk) ld(ra0, rb0, kt + 4); }
      __syncthreads();
    }
  }
  epi(acc, wm, wn, lane);
}

DI void stage_rc(int b, int& R, int& C) { int st = b / 1024, sb = b % 1024, swz = sb ^ (((sb >> 9) & 1) << 5); R = (st >> 1) * 16 + swz / 64; C = (st & 1) * 32 + (swz % 64) / 2; }

template <class EPI>
DI void gemm256(LAS u16* shm, const u16* __restrict__ A, const u16* __restrict__ Bt, int K, int brow, int bcol, bool pre, bool has_next, int nbrow, int nbcol, EPI epi) {
#define SA(b, h) (shm + ((b) * 2 + (h)) * HT)
#define SB(b, h) (shm + (4 + (b) * 2 + (h)) * HT)
  const int tid = tidx();
  const int wid = __builtin_amdgcn_readfirstlane(tid >> 6), lane = tid & 63, wr = wid >> 2, wc = wid & 3, fr = lane & 15, fq = lane >> 4;
  int r0, c0, r1, c1;
  stage_rc(tid * 16, r0, c0);
  stage_rc(tid * 16 + 8192, r1, c1);
  const unsigned so0 = (unsigned)(r0 * K + c0) * 2u, so1 = (unsigned)(r1 * K + c1) * 2u;
  const unsigned ldsw = (unsigned)wid * 1024u;
  const int lb = ((fr * 64 + fq * 16) ^ ((fr >> 3) << 5));
#define STAGE(P, BASE, br, kt) do { const char* _g = (const char*)((BASE) + (size_t)(br) * K + (kt) * 64); \
    __builtin_amdgcn_global_load_lds((const unsigned*)(_g + so0), (LAS unsigned*)((LAS char*)(P) + ldsw), 16, 0, 0); \
    __builtin_amdgcn_global_load_lds((const unsigned*)(_g + so1), (LAS unsigned*)((LAS char*)(P) + ldsw + 8192), 16, 0, 0); } while (0)
#define LDA(dst, b, h) _Pragma("unroll") for (int m = 0; m < 4; ++m) _Pragma("unroll") for (int k = 0; k < 2; ++k) \
    dst[m][k] = *(const LAS bf16x8*)((const LAS char*)SA(b, h) + ((wr * 4 + m) * 2 + k) * 1024 + lb)
#define LDB(dst, b, h) _Pragma("unroll") for (int n = 0; n < 2; ++n) _Pragma("unroll") for (int k = 0; k < 2; ++k) \
    dst[n][k] = *(const LAS bf16x8*)((const LAS char*)SB(b, h) + ((wc * 2 + n) * 2 + k) * 1024 + lb)
#define MMA(ai, bj, At_, Bt_) do { __builtin_amdgcn_s_setprio(1); \
    _Pragma("unroll") for (int m = 0; m < 4; ++m) _Pragma("unroll") for (int n = 0; n < 2; ++n) _Pragma("unroll") for (int k = 0; k < 2; ++k) \
      acc[ai][bj][m][n] = __builtin_amdgcn_mfma_f32_16x16x32_bf16(At_[m][k], Bt_[n][k], acc[ai][bj][m][n], 0, 0, 0); \
    __builtin_amdgcn_s_setprio(0); } while (0)
#define WAIT_V(n) asm volatile("s_waitcnt vmcnt(" #n ")" ::: "memory")
#define WAIT_L(n) asm volatile("s_waitcnt lgkmcnt(" #n ")" ::: "memory")
#define BAR __builtin_amdgcn_s_barrier()
#define SCHED __builtin_amdgcn_sched_barrier(0)
  f32x4 acc[2][2][4][2];
#pragma unroll
  for (int a = 0; a < 2; ++a)
#pragma unroll
    for (int b = 0; b < 2; ++b)
#pragma unroll
      for (int m = 0; m < 4; ++m)
#pragma unroll
        for (int n = 0; n < 2; ++n) { acc[a][b][m][n][0] = 0.f; acc[a][b][m][n][1] = 0.f; acc[a][b][m][n][2] = 0.f; acc[a][b][m][n][3] = 0.f; }
  bf16x8 At[4][2], B0[2][2], B1[2][2];
  const int nt = K / 64;
  if (!pre) {
    STAGE(SB(0, 0), Bt, bcol, 0); STAGE(SA(0, 0), A, brow, 0);
    STAGE(SB(0, 1), Bt, bcol + 128, 0); STAGE(SA(0, 1), A, brow + 128, 0);
  }
  if (wr == 1) BAR;
  WAIT_V(4); BAR;
  STAGE(SB(1, 0), Bt, bcol, 1); STAGE(SA(1, 0), A, brow, 1); STAGE(SB(1, 1), Bt, bcol + 128, 1);
  WAIT_V(6); BAR;
  for (int t = 0; t < nt - 2; t += 2) {
    LDB(B0, 0, 0); SCHED; LDA(At, 0, 0); STAGE(SA(1, 1), A, brow + 128, t + 1);
    WAIT_L(8); BAR; WAIT_L(0); MMA(0, 0, At, B0); BAR; SCHED;
    LDB(B1, 0, 1); STAGE(SB(0, 0), Bt, bcol, t + 2);
    BAR; WAIT_L(0); MMA(0, 1, At, B1); BAR;
    LDA(At, 0, 1); STAGE(SA(0, 0), A, brow, t + 2);
    BAR; WAIT_L(0); MMA(1, 0, At, B0); BAR; SCHED;
    STAGE(SB(0, 1), Bt, bcol + 128, t + 2);
    WAIT_V(6); BAR; MMA(1, 1, At, B1); BAR;
    LDB(B0, 1, 0); SCHED; LDA(At, 1, 0); STAGE(SA(0, 1), A, brow + 128, t + 2);
    WAIT_L(8); BAR; WAIT_L(0); MMA(0, 0, At, B0); BAR; SCHED;
    LDB(B1, 1, 1); STAGE(SB(1, 0), Bt, bcol, t + 3);
    BAR; WAIT_L(0); MMA(0, 1, At, B1); BAR;
    LDA(At, 1, 1); STAGE(SA(1, 0), A, brow, t + 3);
    BAR; WAIT_L(0); MMA(1, 0, At, B0); BAR; SCHED;
    STAGE(SB(1, 1), Bt, bcol + 128, t + 3);
    WAIT_V(6); BAR; MMA(1, 1, At, B1); BAR;
  }
  { LDB(B0, 0, 0); LDA(At, 0, 0); STAGE(SA(1, 1), A, brow + 128, nt - 1);
    BAR; WAIT_L(0); MMA(0, 0, At, B0); BAR;
    LDB(B1, 0, 1); BAR; WAIT_L(0); MMA(0, 1, At, B1); BAR;
    LDA(At, 0, 1); WAIT_V(4); BAR; WAIT_L(0); MMA(1, 0, At, B0); MMA(1, 1, At, B1); BAR; }
  { LDB(B0, 1, 0); LDA(At, 1, 0); WAIT_V(2); BAR; WAIT_L(0); MMA(0, 0, At, B0); BAR;
    LDB(B1, 1, 1); WAIT_V(0); BAR; WAIT_L(0); MMA(0, 1, At, B1); BAR;
    LDA(At, 1, 1); BAR; WAIT_L(0); MMA(1, 0, At, B0); MMA(1, 1, At, B1); BAR; }
  if (wr == 0) BAR;
  if (has_next) {
    STAGE(SB(0, 0), Bt, nbcol, 0); STAGE(SA(0, 0), A, nbrow, 0);
    STAGE(SB(0, 1), Bt, nbcol + 128, 0); STAGE(SA(0, 1), A, nbrow + 128, 0);
  }
  epi(acc, wr, wc, fr, fq);
  __syncthreads();
}

DI void map256(int t, int nN, int& tn, int& tm) {
  const int p = (t >> 8) * 8 + (t & 7), i = (t >> 3) & 31, pr = nN >> 2;
  const int pm = p / pr;
  tn = ((p + pm) % pr) * 4 + (i & 3);
  tm = pm * 8 + (i >> 2);
}

DI int condrow(int sb, int tok) { return sb == 0 ? 0 : 1 + (sb - 1) * 8 + (tok >> 11); }

DI void convT(float* tile, const float* src, int lds_, int K, int N, u16* dst, int ldd, const float* ksc, int& base) {
  const int tid = tidx();
  const int ntn = (N + 63) >> 6, nt = (K >> 6) * ntn;
  const int kk = tid >> 4, n4 = (tid & 15) * 4;
  float4 cur[2], nxt[2];
  auto ld = [&](float4 (&v)[2], int t) __attribute__((always_inline)) {
    const int tn = t % ntn, tk = t / ntn, k0 = tk * 64, n0 = tn * 64;
#pragma unroll
    for (int e = 0; e < 2; ++e) {
      v[e] = make_float4(0.f, 0.f, 0.f, 0.f);
      if (n0 + n4 < N) v[e] = *(const float4*)(src + (size_t)(k0 + kk + 32 * e) * lds_ + n0 + n4);
    }
  };
  int t = (int)((blockIdx.x + gridDim.x - ((unsigned)base % gridDim.x)) % gridDim.x);
  if (t < nt) ld(cur, t);
  for (; t < nt; t += gridDim.x) {
    const int tnx = t + (int)gridDim.x;
    if (tnx < nt) ld(nxt, tnx);
    const int tn = t % ntn, tk = t / ntn, k0 = tk * 64, n0 = tn * 64;
#pragma unroll
    for (int e = 0; e < 2; ++e) {
      float4 v = cur[e];
      if (ksc) { const float sc = ksc[k0 + kk + 32 * e]; v.x *= sc; v.y *= sc; v.z *= sc; v.w *= sc; }
      float* tp = tile + (kk + 32 * e) * 65 + n4;
      tp[0] = v.x; tp[1] = v.y; tp[2] = v.z; tp[3] = v.w;
    }
    __syncthreads();
#pragma unroll 4
    for (int e = 0; e < 4; ++e) {
      const int idx = tid + NTH * e, nn = idx >> 5, kp = idx & 31;
      if (n0 + nn < N)
        *(unsigned*)(dst + (size_t)(n0 + nn) * ldd + k0 + 2 * kp) = pack2(tile[(2 * kp) * 65 + nn], tile[(2 * kp + 1) * 65 + nn]);
    }
    __syncthreads();
    cur[0] = nxt[0]; cur[1] = nxt[1];
  }
  base += nt;
}

DI void prologue_a(const Prm& p, unsigned char* smem_raw, int& base) {
  float* smf = (float*)smem_raw;
  const int tid = tidx();
  const int gtid = blockIdx.x * NTH + tid, gn = gridDim.x * NTH;
  for (int l = 0; l < 4; ++l) {
    convT(smf, p.w_in + (size_t)l * 1024 * 7520 + 768, 7520, 1024, 6752, p.WinT + ((size_t)l * NWP + 1536) * 1024, 1024, nullptr, base);
    convT(smf, p.w1 + (size_t)l * 1024 * 4096, 4096, 1024, 4096, p.W1T + (size_t)l * 4096 * 1024, 1024, nullptr, base);
    convT(smf, p.w2 + (size_t)l * 4096 * 1024, 1024, 4096, 1024, p.W2T + (size_t)l * 1024 * 4096, 4096, nullptr, base);
    convT(smf, p.w_o + (size_t)l * 1024 * 1024, 1024, 1024, 1024, p.WoT + (size_t)l * 1024 * 1024, 1024, nullptr, base);
    convT(smf, p.p_a + (size_t)l * 768 * 1024, 1024, 768, 1024, p.PaT + (size_t)l * 1024 * 768, 768, nullptr, base);
    convT(smf, p.p_b + (size_t)l * 128 * 1024, 1024, 128, 1024, p.PbT + (size_t)l * 1024 * 128, 128, nullptr, base);
    convT(smf, p.p_c + (size_t)l * 384 * 1024, 1024, 384, 1024, p.PcT + (size_t)l * 1024 * 384, 384, nullptr, base);
    convT(smf, p.p_d + (size_t)l * 256 * 1024, 1024, 256, 1024, p.PdT + (size_t)l * 1024 * 256, 256, nullptr, base);
    convT(smf, p.w_uq + (size_t)l * 384 * 384, 384, 384, 384, p.WqT + (size_t)l * 384 * 384, 384, p.qn_g + l * 384, base);
    convT(smf, p.w_ukv + (size_t)l * 320 * 512, 512, 320, 512, p.WkvT + (size_t)l * 512 * 320, 320, p.kvn_g + l * 320, base);
  }
  {
    float* tab = (float*)(smem_raw + GEMM_SMEM + 1024);
    if (tid < 192) {
      float sn, cs;
      sincospif(2.f * (float)tid / 192.f, &sn, &cs);
      tab[tid] = cs; tab[192 + tid] = sn;
    }
    __syncthreads();
    u16* smem = (u16*)smem_raw;
    TASK_LOOP(t, 384, base) {
      const int kt = t & 7, rt = (t >> 3) % 3, g = (t / 24) & 3, l = t / 96;
      auto la = [&](int row, int k) __attribute__((always_inline)) {
        const int rr = rt * 128 + row, part = rr >= 192 ? 1 : 0, j = rr - part * 192;
        const float* tp = tab + part * 192;
        const float sg = part ? -1.f : 1.f;
        int m = (j * k) % 192;
        u32x4 o;
#pragma unroll
        for (int jj = 0; jj < 4; ++jj) {
          const float v0 = tp[m] * sg; m += j; if (m >= 192) m -= 192;
          const float v1 = tp[m] * sg; m += j; if (m >= 192) m -= 192;
          o[jj] = pack2(v0, v1);
        }
        return o;
      };
      auto lb = [&](int row, int k) __attribute__((always_inline)) {
        const float* src = p.w_in + ((size_t)l * 1024 + kt * 128 + row) * 7520 + g * 192 + k;
        const float4 a = *(const float4*)src, b = *(const float4*)(src + 4);
        u32x4 o;
        o[0] = pack2(a.x, a.y); o[1] = pack2(a.z, a.w); o[2] = pack2(b.x, b.y); o[3] = pack2(b.z, b.w);
        return o;
      };
      auto epi = [&](f32x16 (&acc)[2], int wm, int wn, int lane) __attribute__((always_inline)) {
        const int lr = lane & 31, lh = lane >> 5;
        const int kcol = kt * 128 + wn * 32 + lr;
#pragma unroll
        for (int i = 0; i < 2; ++i)
#pragma unroll
          for (int r = 0; r < 16; ++r) {
            const int rr = rt * 128 + wm * 64 + i * 32 + rowmap(r, lh), part = rr >= 192 ? 1 : 0, j = rr - part * 192;
            p.WinT[((size_t)l * NWP + part * 768 + g * 192 + j) * 1024 + kcol] = f2bf(acc[i][r]);
          }
      };
      gemm_tile<false, false>(smem, 3, la, lb, epi);
    }
    base += 384;
  }
  {
    float* sil = smf;
    TASK_LOOP(t, 384, base) {
      const int kc = t & 7, cb = (t >> 3) % 12, l = t / 96, k0 = kc * 128;
      for (int idx = tid; idx < 17 * 128; idx += NTH) {
        const int r = idx >> 7, kk = idx & 127;
        const float c = r == 0 ? p.c_prompt[k0 + kk] : p.c_sample[(r - 1) * 1024 + k0 + kk];
        sil[idx] = c / (1.f + __expf(-c));
      }
      __syncthreads();
      const int n = cb * 512 + tid;
      float acc[17];
#pragma unroll
      for (int r = 0; r < 17; ++r) acc[r] = 0.f;
      const float* wp = p.ada_w + ((size_t)l * 1024 + k0) * 6144 + n;
#pragma unroll 1
      for (int kb = 0; kb < 128; kb += 32) {
        float w[32];
#pragma unroll
        for (int i = 0; i < 32; ++i) w[i] = wp[(size_t)(kb + i) * 6144];
#pragma unroll
        for (int i = 0; i < 32; i += 4)
#pragma unroll
          for (int r = 0; r < 17; ++r) {
            const float4 sv = *(const float4*)(sil + r * 128 + kb + i);
            acc[r] += sv.x * w[i] + sv.y * w[i + 1] + sv.z * w[i + 2] + sv.w * w[i + 3];
          }
      }
#pragma unroll
      for (int r = 0; r < 17; ++r) p.modpart[((size_t)(kc * 4 + l) * 17 + r) * 6144 + n] = acc[r];
      __syncthreads();
    }
    base += 384;
  }
  for (int idx = gtid; idx < 4 * 32 * 1024; idx += gn) {
    const int l = idx >> 15, rem = idx & 32767;
    p.WinT[((size_t)l * NWP + NW) * 1024 + rem] = 0;
  }
  for (int idx = gtid; idx < 256 * 256; idx += gn) {
    const int row = idx >> 8, kk = idx & 255;
    const int po = row >> 7, k1 = row & 127, pi = kk >> 7, s1 = kk & 127;
    float s, c;
    sincospif(2.f * (float)((k1 * s1) & 127) / 128.f, &s, &c);
    const float v = (po == pi) ? c : (po == 0 ? s : -s);
    p.M1a[idx] = f2bf(v);
  }
  for (int idx = gtid; idx < 32 * 64; idx += gn) {
    const int row = idx >> 6, kk = idx & 63;
    const int po = row >> 4, k1 = row & 15, pi = (kk >> 4) & 1, s1 = kk & 15;
    float s, c;
    sincospif(2.f * (float)((k1 * s1) & 15) / 16.f, &s, &c);
    float v = (po == pi) ? c : (po == 0 ? s : -s);
    if (kk >= 32) v = 0.f;
    p.M1b[idx] = f2bf(v);
  }
  for (int idx = gtid; idx < 128 * 256; idx += gn) {
    const int k2 = idx >> 8, kk = idx & 255, part = kk >> 7, s2 = kk & 127;
    float s, c;
    sincospif(2.f * (float)((k2 * s2) & 127) / 128.f, &s, &c);
    p.M2[idx] = f2bf(part ? s : c);
  }
  for (int idx = gtid; idx < 16384; idx += gn) {
    float s, c;
    sincospif(2.f * (float)idx / 16384.f, &s, &c);
    p.tw[idx] = make_float2(c, s);
  }
  for (int idx = gtid; idx < 16384 * 16; idx += gn) {
    const int pos = idx >> 4, i = idx & 15;
    const float inv = (float)pow(10000.0, -(double)i / 16.0);
    const float ang = (float)pos * inv;
    double rev = (double)ang * 0.15915494309189535;
    rev -= rint(rev);
    float s, c;
    sincospif((float)(2.0 * rev), &s, &c);
    p.rope[idx] = make_float2(c, s);
  }
  for (int idx = gtid; idx < 6 * 129; idx += gn) {
    const int hd = idx / 129, rel = idx - hd * 129 - 64;
    const int dil = 1 << (2 * (hd >> 1));
    const int rd = rel * dil, n = rd < 0 ? -rd : rd;
    int b;
    if (n < 8) b = n;
    else if (n < 15) b = 8; else if (n < 27) b = 9; else if (n < 50) b = 10; else if (n < 91) b = 11;
    else if (n < 166) b = 12; else if (n < 305) b = 13; else if (n < 559) b = 14; else b = 15;
    if (rd > 0) b += 16;
    p.biasT[idx] = p.rel_bias[b * 6 + hd];
  }
  for (int idx = gtid; idx < 4 * 4 * 128 * 128; idx += gn) p.SgW[idx] = f2bf(p.sgu_w[idx]);
}

DI void prologue_b(const Prm& p) {
  const int gtid = blockIdx.x * NTH + tidx(), gn = gridDim.x * NTH;
  for (int idx = gtid; idx < 4 * 17 * 6144; idx += gn) {
    const int l = idx / (17 * 6144), n = idx % 6144;
    float s = p.ada_b[l * 6144 + n];
#pragma unroll
    for (int kc = 0; kc < 8; ++kc) s += p.modpart[(size_t)kc * 4 * 17 * 6144 + idx];
    p.mod[idx] = s;
  }
}

DI void phase_norm(const Prm& p, const float* xsrc, const float* g, const float* modl, int shoff, int scoff, int sb) {
  const int tid = tidx(), lane = tid & 63;
  const int gw = blockIdx.x * 8 + (tid >> 6), nw = gridDim.x * 8;
  for (int row = gw; row < TB; row += nw) {
    const int cond = condrow(sb, row);
    const float* xr = xsrc + (size_t)row * 1024;
    float4 v[4];
    float ss = 0.f;
#pragma unroll
    for (int i = 0; i < 4; ++i) {
      v[i] = *(const float4*)(xr + i * 256 + lane * 4);
      ss += v[i].x * v[i].x + v[i].y * v[i].y + v[i].z * v[i].z + v[i].w * v[i].w;
    }
#pragma unroll
    for (int off = 32; off >= 1; off >>= 1) ss += __shfl_xor(ss, off);
    const float rstd = rsqrtf(ss * (1.f / 1024.f) + 1e-6f);
    const float* sc = modl + cond * 6144 + scoff;
    const float* sh = modl + cond * 6144 + shoff;
#pragma unroll
    for (int i = 0; i < 4; ++i) {
      const int col = i * 256 + lane * 4;
      const float4 gg = *(const float4*)(g + col), s4 = *(const float4*)(sc + col), h4 = *(const float4*)(sh + col);
      st4bf(p.hbuf + (size_t)row * 1024 + col,
            v[i].x * rstd * gg.x * (1.f + s4.x) + h4.x, v[i].y * rstd * gg.y * (1.f + s4.y) + h4.y,
            v[i].z * rstd * gg.z * (1.f + s4.z) + h4.z, v[i].w * rstd * gg.w * (1.f + s4.w) + h4.w);
    }
  }
}

DI float sigm(float x) { return __builtin_amdgcn_rcpf(1.f + __expf(-x)); }

DI void phase_inproj(const Prm& p, unsigned char* smem_raw, int l, int S, int& base) {
  const u16* W = p.WinT + (size_t)l * NWP * 1024;
  LAS u16* shm = (LAS u16*)smem_raw;
  bool pre = false;
  TASK_LOOP(t, 32 * 64, base) {
    int tn, tm;
    map256(t, 32, tn, tm);
    const int brow = tn * 256, bcol = tm * 256;
    const int tnx = t + (int)gridDim.x;
    const bool has_next = tnx < (32 * 64);
    int tn2 = 0, tm2 = 0;
    if (has_next) map256(tnx, 32, tn2, tm2);
    const int nbrow = tn2 * 256, nbcol = tm2 * 256;
    auto epi = [&](f32x4 (&acc)[2][2][4][2], int wr, int wc, int fr, int fq) __attribute__((always_inline)) {
#pragma unroll
      for (int ai = 0; ai < 2; ++ai)
#pragma unroll
        for (int m = 0; m < 4; ++m) {
          const int nb = brow + ai * 128 + wr * 64 + m * 16;
#pragma unroll
          for (int bj = 0; bj < 2; ++bj)
#pragma unroll
            for (int n = 0; n < 2; ++n) {
              const int tok = bcol + bj * 128 + wc * 32 + n * 16 + fr;
              const f32x4 v = acc[ai][bj][m][n];
              const int nn = nb + fq * 4;
              if (nb < 1536) {
#pragma unroll
                for (int j = 0; j < 4; ++j) p.UT[(size_t)(nn + j) * TBP + tok] = f2bf(v[j]);
              } else if (nb < 2688) {
                st4bf(p.bqkv + (size_t)tok * 1152 + (nn - 1536), v[0], v[1], v[2], v[3]);
              } else if (nb < 3072) {
                st4bf(p.cu + (size_t)tok * 384 + (nn - 2688), v[0], v[1], v[2], v[3]);
              } else if (nb < 3456) {
#pragma unroll
                for (int j = 0; j < 4; ++j) p.cvT[(size_t)(nn - 3072 + j) * TBP + tok] = f2bf(v[j]);
              } else if (nb < 3840) {
                st4bf(p.dcq + (size_t)tok * 384 + (nn - 3456), v[0], v[1], v[2], v[3]);
              } else if (nb < 4160) {
                st4bf(p.dckv + (size_t)tok * 320 + (nn - 3840), v[0], v[1], v[2], v[3]);
              } else if (nb < 4192) {
                if (nb == 4160) {
                  const f32x4 v2 = acc[ai][bj][(m + 1) & 3][n];
                  const int pos = tok & (S - 1);
#pragma unroll
                  for (int j = 0; j < 4; ++j) {
                    const int ii = fq * 4 + j;
                    const float2 cs = p.rope[pos * 16 + ii];
                    const u16 o1 = f2bf(v[j] * cs.x - v2[j] * cs.y), o2 = f2bf(v[j] * cs.y + v2[j] * cs.x);
#pragma unroll
                    for (int hh = 0; hh < 4; ++hh) {
                      p.kc[(size_t)tok * 384 + hh * 96 + 64 + ii] = o1;
                      p.kc[(size_t)tok * 384 + hh * 96 + 80 + ii] = o2;
                    }
                  }
                }
              } else {
                st4bf_nt(p.zg + (size_t)tok * 4096 + (nn - 4192), sigm(v[0]), sigm(v[1]), sigm(v[2]), sigm(v[3]));
              }
            }
          __builtin_amdgcn_sched_barrier(0);
        }
    };
    gemm256(shm, W, p.hbuf, 1024, brow, bcol, pre, has_next, nbrow, nbcol, epi);
    pre = has_next;
  }
  base += 32 * 64;
}

DI void phase_inproj_tail(const Prm& p, unsigned char* smem_raw, int l, int& base) {
  const u16* W = p.WinT + (size_t)l * NWP * 1024;
  u16* smem = (u16*)smem_raw;
  TASK_LOOP(t, 128, base) {
    const int n0 = 8192, m0 = t * 128;
    auto la = [&](int row, int k) __attribute__((always_inline)) { return *(const u32x4*)(W + (size_t)(n0 + row) * 1024 + k); };
    auto lb = [&](int row, int k) __attribute__((always_inline)) { return *(const u32x4*)(p.hbuf + (size_t)(m0 + row) * 1024 + k); };
    auto epi = [&](f32x16 (&acc)[2], int wm, int wn, int lane) __attribute__((always_inline)) {
      const int lr = lane & 31, lh = lane >> 5;
      const int tok = m0 + wn * 32 + lr;
#pragma unroll
      for (int i = 0; i < 2; ++i) {
        const int nb = n0 + wm * 64 + i * 32;
        if (nb >= NW) continue;
#pragma unroll
        for (int q = 0; q < 4; ++q)
          st4bf(p.zg + (size_t)tok * 4096 + (nb - 4192) + 8 * q + 4 * lh, sigm(acc[i][4 * q]), sigm(acc[i][4 * q + 1]), sigm(acc[i][4 * q + 2]),
                sigm(acc[i][4 * q + 3]));
      }
    };
    gemm_tile2s<false, false>(smem, 16, la, lb, epi);
  }
  base += 128;
}


DI void phase_inproj_probe(const Prm& p, unsigned char* smem_raw, int l, int& base) {
  const u16* W = p.WinT + (size_t)l * NWP * 1024;
  LAS u16* shm = (LAS u16*)smem_raw;
  bool pre = false;
  TASK_LOOP(t, 32 * 64, base) {
    int tn, tm;
    map256(t, 32, tn, tm);
    const int brow = tn * 256, bcol = tm * 256;
    const int tnx = t + (int)gridDim.x;
    const bool has_next = tnx < (32 * 64);
    int tn2 = 0, tm2 = 0;
    if (has_next) map256(tnx, 32, tn2, tm2);
    const int nbrow = tn2 * 256, nbcol = tm2 * 256;
    auto epi = [&](f32x4 (&acc)[2][2][4][2], int wr, int wc, int fr, int fq) __attribute__((always_inline)) {
#pragma unroll
      for (int bj = 0; bj < 2; ++bj)
#pragma unroll
        for (int n = 0; n < 2; ++n) {
          const int tok = bcol + bj * 128 + wc * 32 + n * 16 + fr;
#pragma unroll
          for (int ai = 0; ai < 2; ++ai)
#pragma unroll
            for (int m = 0; m < 4; ++m) {
              const int nn = ((brow + ai * 128 + wr * 64 + m * 16) & 1023) + fq * 4;
              const f32x4 v = acc[ai][bj][m][n];
              st4bf(p.Gp + (size_t)tok * 1024 + nn, v[0], v[1], v[2], v[3]);
            }
        }
    };
    gemm256(shm, W, p.hbuf, 1024, brow, bcol, pre, has_next, nbrow, nbcol, epi);
    pre = has_next;
  }
  base += 32 * 64;
}

DI void phase_fft1(const Prm& p, u16* smem, int S, int nseq, int N1, int lgN1, int& base) {
  const int nkt = N1 == 128 ? 2 : 1;
  const u16* M1 = N1 == 128 ? p.M1a : p.M1b;
  const int ldm = N1 == 128 ? 256 : 64;
  const int nk = N1 == 128 ? 4 : 1;
  const int ntask = nseq * 768 * nkt;
  const int twmul = 16384 / S;
  TASK_LOOP(t, ntask, base) {
    const int k1t = t % nkt, col = (t / nkt) % 768, seq = t / (nkt * 768);
    const int k1base = k1t * 64;
    auto la = [&](int row, int k) __attribute__((always_inline)) {
      const int k1 = k1base + (row >> 6) * 32 + (row & 31), ii = (row >> 5) & 1;
      if (k1 >= N1 || k >= 2 * N1) return zero4();
      return *(const u32x4*)(M1 + (ii * N1 + k1) * ldm + k);
    };
    auto lb = [&](int row, int k) __attribute__((always_inline)) {
      if (k >= 2 * N1) return zero4();
      const int part = k >> lgN1, s1 = k & (N1 - 1);
      const u16* src = p.UT + (size_t)(part * 768 + col) * TBP + seq * S + s1 * 128 + row;
      u32x4 v;
#pragma unroll
      for (int jj = 0; jj < 4; ++jj) v[jj] = (unsigned)src[(2 * jj) * 128] | ((unsigned)src[(2 * jj + 1) * 128] << 16);
      return v;
    };
    auto epi = [&](f32x16 (&acc)[2], int wm, int wn, int lane) __attribute__((always_inline)) {
      const int lr = lane & 31, lh = lane >> 5;
      const int s2 = wn * 32 + lr;
#pragma unroll
      for (int r = 0; r < 16; ++r) {
        const int k1 = k1base + wm * 32 + rowmap(r, lh);
        if (k1 < N1) {
          const float re = acc[0][r], im = acc[1][r];
          const float2 cs = p.tw[(s2 * k1) * twmul];
          const size_t o = ((size_t)((seq * N1 + k1) * 2) * 768 + col) * 128 + s2;
          p.Gp[o] = f2bf(cs.x * re + cs.y * im);
          p.Gp[o + 768 * 128] = f2bf(cs.x * im - cs.y * re);
        }
      }
    };
    gemm_tile2s<false, true>(smem, nk, la, lb, epi);
  }
  base += ntask;
}


DI void phase_fft1_small(const Prm& p, int nseq) {
  constexpr float C16[16] = {1.f, 0.92387953251128674f, 0.70710678118654752f, 0.38268343236508977f, 0.f, -0.38268343236508977f, -0.70710678118654752f,
                             -0.92387953251128674f, -1.f, -0.92387953251128674f, -0.70710678118654752f, -0.38268343236508977f, 0.f,
                             0.38268343236508977f, 0.70710678118654752f, 0.92387953251128674f};
  constexpr float S16[16] = {0.f, 0.38268343236508977f, 0.70710678118654752f, 0.92387953251128674f, 1.f, 0.92387953251128674f, 0.70710678118654752f,
                             0.38268343236508977f, 0.f, -0.38268343236508977f, -0.70710678118654752f, -0.92387953251128674f, -1.f,
                             -0.92387953251128674f, -0.70710678118654752f, -0.38268343236508977f};
  const int gtid = blockIdx.x * NTH + tidx(), gn = gridDim.x * NTH;
  for (int idx = gtid; idx < nseq * 768 * 128; idx += gn) {
    const int s2 = idx & 127, col = (idx >> 7) % 768, seq = idx / (768 * 128);
    const u16* ur = p.UT + (size_t)col * TBP + seq * 2048 + s2;
    const u16* ui = ur + (size_t)768 * TBP;
    float xr[16], xi[16];
#pragma unroll
    for (int s1 = 0; s1 < 16; ++s1) { xr[s1] = bf2f(ur[s1 * 128]); xi[s1] = bf2f(ui[s1 * 128]); }
    u16* go = p.Gp + ((size_t)(seq * 16 * 2) * 768 + col) * 128 + s2;
#pragma unroll
    for (int k1 = 0; k1 < 16; ++k1) {
      float gr = 0.f, gi = 0.f;
#pragma unroll
      for (int s1 = 0; s1 < 16; ++s1) {
        const float c = C16[(k1 * s1) & 15], sn = S16[(k1 * s1) & 15];
        gr += c * xr[s1] + sn * xi[s1];
        gi += c * xi[s1] - sn * xr[s1];
      }
      const float2 cs = p.tw[(s2 * k1) * 8];
      go[(size_t)(k1 * 2) * 768 * 128] = f2bf(cs.x * gr + cs.y * gi);
      go[(size_t)(k1 * 2 + 1) * 768 * 128] = f2bf(cs.x * gi - cs.y * gr);
    }
  }
}

DI void phase_fft2(const Prm& p, u16* smem, int S, int nseq, int N1, int& base) {
  const int ntask = nseq * N1 * 6;
  const float scale = rsqrtf((float)S * 192.f);
  u16* fa = p.UT;
  TASK_LOOP(t, ntask, base) {
    const int ct = t % 6, k1 = (t / 6) % N1, seq = t / (6 * N1);
    const u16* gb = p.Gp + ((size_t)((seq * N1 + k1) * 2) * 768 + ct * 128) * 128;
    auto la = [&](int row, int k) __attribute__((always_inline)) { return *(const u32x4*)(p.M2 + row * 256 + k); };
    auto lb = [&](int row, int k) __attribute__((always_inline)) {
      const int part = k >> 7, s2 = k & 127;
      return *(const u32x4*)(gb + ((size_t)part * 768 + row) * 128 + s2);
    };
    auto epi = [&](f32x16 (&acc)[2], int wm, int wn, int lane) __attribute__((always_inline)) {
      const int lr = lane & 31, lh = lane >> 5;
      const int col = ct * 128 + wn * 32 + lr;
#pragma unroll
      for (int i = 0; i < 2; ++i)
#pragma unroll
        for (int r = 0; r < 16; ++r) {
          const int k2 = wm * 64 + i * 32 + rowmap(r, lh);
          const int tok = seq * S + k1 + N1 * k2;
          fa[(size_t)tok * 768 + col] = f2bf(acc[i][r] * scale);
        }
    };
    gemm_tile2s<false, false>(smem, 4, la, lb, epi);
  }
  base += ntask;
}

DI void phase_mixc(const Prm& p, unsigned char* smem_raw, int l, int& base) {
  u16* smem = (u16*)smem_raw;
  float* st = (float*)(smem_raw + GEMM_SMEM);
  float* red = (float*)smem_raw;
  const int tid = tidx();
  TASK_LOOP(t, 512, base) {
    const int h = t & 3, ch = t >> 2, tok0 = ch * 128;
    {
      const int q = tid & 127, qf = tid >> 7;
      float s = 0.f, ss = 0.f;
      const u16* src = p.cvT + (size_t)(qf * 96) * TBP + tok0 + q;
      for (int c = 0; c < 96; ++c) { const float v = bf2f(src[(size_t)c * TBP]); s += v; ss += v * v; }
      red[qf * 256 + q * 2] = s; red[qf * 256 + q * 2 + 1] = ss;
      __syncthreads();
      if (tid < 128) {
        const float s1 = red[q * 2] + red[256 + q * 2] + red[512 + q * 2] + red[768 + q * 2];
        const float s2 = red[q * 2 + 1] + red[256 + q * 2 + 1] + red[512 + q * 2 + 1] + red[768 + q * 2 + 1];
        const float mu = s1 * (1.f / 384.f);
        const float var = fmaxf(s2 * (1.f / 384.f) - mu * mu, 0.f);
        st[q] = mu; st[128 + q] = rsqrtf(var + 1e-6f);
      }
      __syncthreads();
    }
    const u16* Wm = p.SgW + (size_t)((l * 4 + h) * 128) * 128;
    auto la = [&](int row, int k) __attribute__((always_inline)) { return *(const u32x4*)(Wm + row * 128 + k); };
    auto lb = [&](int row, int k) __attribute__((always_inline)) {
      if (row >= 96) return zero4();
      const int c = h * 96 + row;
      const u32x4 raw = *(const u32x4*)(p.cvT + (size_t)c * TBP + tok0 + k);
      const float g = p.ln_g[l * 384 + c], b = p.ln_b[l * 384 + c];
      u32x4 o;
#pragma unroll
      for (int jj = 0; jj < 4; ++jj) {
        const float v0 = (bflo(raw[jj]) - st[k + 2 * jj]) * st[128 + k + 2 * jj] * g + b;
        const float v1 = (bfhi(raw[jj]) - st[k + 2 * jj + 1]) * st[128 + k + 2 * jj + 1] * g + b;
        o[jj] = pack2(v0, v1);
      }
      return o;
    };
    auto epi = [&](f32x16 (&acc)[2], int wm, int wn, int lane) __attribute__((always_inline)) {
      const int lr = lane & 31, lh = lane >> 5;
      const int cl = wn * 32 + lr;
      if (cl < 96) {
#pragma unroll
        for (int i = 0; i < 2; ++i)
#pragma unroll
          for (int r = 0; r < 16; ++r) {
            const int pp = wm * 64 + i * 32 + rowmap(r, lh);
            const float val = acc[i][r] + p.sgu_b[(l * 4 + h) * 128 + pp];
            u16* dst = p.cu + (size_t)(tok0 + pp) * 384 + h * 96 + cl;
            *dst = f2bf(bf2f(*dst) * val);
          }
      }
    };
    gemm_tile<false, false>(smem, 2, la, lb, epi);
  }
  base += 512;
}

DI void phase_qup(const Prm& p, unsigned char* smem_raw, int l, int S, int& base) {
  u16* smem = (u16*)smem_raw;
  float* st = (float*)(smem_raw + GEMM_SMEM);
  const int tid = tidx();
  const float QS = 0.10206207261596577f * LOG2E;
  TASK_LOOP(t, 3 * 128, base) {
    const int tn = t % 3, tm = t / 3, n0 = tn * 128, m0 = tm * 128;
    {
      const int row = tid >> 2, qf = tid & 3;
      const u16* src = p.dcq + (size_t)(m0 + row) * 384 + qf * 96;
      float ss = 0.f;
#pragma unroll 4
      for (int c = 0; c < 12; ++c) {
        const u32x4 v = *(const u32x4*)(src + c * 8);
#pragma unroll
        for (int jj = 0; jj < 4; ++jj) { const float a = bflo(v[jj]), b = bfhi(v[jj]); ss += a * a + b * b; }
      }
      ss += __shfl_xor(ss, 1);
      ss += __shfl_xor(ss, 2);
      if (qf == 0) st[row] = rsqrtf(ss * (1.f / 384.f) + 1e-6f);
      __syncthreads();
    }
    const u16* W = p.WqT + (size_t)l * 384 * 384;
    auto la = [&](int row, int k) __attribute__((always_inline)) { return *(const u32x4*)(W + (size_t)(n0 + row) * 384 + k); };
    auto lb = [&](int row, int k) __attribute__((always_inline)) { return *(const u32x4*)(p.dcq + (size_t)(m0 + row) * 384 + k); };
    auto epi = [&](f32x16 (&acc)[2], int wm, int wn, int lane) __attribute__((always_inline)) {
      const int lr = lane & 31, lh = lane >> 5;
      const int tokl = wn * 32 + lr, tok = m0 + tokl;
      const float sc = st[tokl] * QS;
#pragma unroll
      for (int i = 0; i < 2; ++i) {
        const int nb = n0 + wm * 64 + i * 32;
        const int head = nb / 96, within = nb - head * 96;
        const f32x16& a = acc[i];
        if (within < 64) {
#pragma unroll
          for (int q = 0; q < 4; ++q)
            st4bf(p.qc + (size_t)tok * 384 + nb + 8 * q + 4 * lh, a[4 * q] * sc, a[4 * q + 1] * sc, a[4 * q + 2] * sc, a[4 * q + 3] * sc);
        } else {
          const int pos = tok & (S - 1);
#pragma unroll
          for (int q = 0; q < 2; ++q)
#pragma unroll
            for (int e = 0; e < 4; ++e) {
              const int r = 4 * q + e, ii = 8 * q + 4 * lh + e;
              const float2 cs = p.rope[pos * 16 + ii];
              const float x1 = a[r] * sc, x2 = a[r + 8] * sc;
              p.qc[(size_t)tok * 384 + head * 96 + 64 + ii] = f2bf(x1 * cs.x - x2 * cs.y);
              p.qc[(size_t)tok * 384 + head * 96 + 80 + ii] = f2bf(x1 * cs.y + x2 * cs.x);
            }
        }
      }
    };
    gemm_tile2s<false, false>(smem, 6, la, lb, epi);
    __syncthreads();
  }
  base += 3 * 128;
}

DI void phase_kvup(const Prm& p, unsigned char* smem_raw, int l, int& base) {
  u16* smem = (u16*)smem_raw;
  float* st = (float*)(smem_raw + GEMM_SMEM);
  const int tid = tidx();
  TASK_LOOP(t, 4 * 128, base) {
    const int tn = t & 3, tm = t >> 2, n0 = tn * 128, m0 = tm * 128;
    {
      const int row = tid >> 2, qf = tid & 3;
      const u16* src = p.dckv + (size_t)(m0 + row) * 320 + qf * 80;
      float ss = 0.f;
#pragma unroll 5
      for (int c = 0; c < 10; ++c) {
        const u32x4 v = *(const u32x4*)(src + c * 8);
#pragma unroll
        for (int jj = 0; jj < 4; ++jj) { const float a = bflo(v[jj]), b = bfhi(v[jj]); ss += a * a + b * b; }
      }
      ss += __shfl_xor(ss, 1);
      ss += __shfl_xor(ss, 2);
      if (qf == 0) st[row] = rsqrtf(ss * (1.f / 320.f) + 1e-6f);
      __syncthreads();
    }
    const u16* W = p.WkvT + (size_t)l * 512 * 320;
    auto la = [&](int row, int k) __attribute__((always_inline)) { return *(const u32x4*)(W + (size_t)(n0 + row) * 320 + k); };
    auto lb = [&](int row, int k) __attribute__((always_inline)) { return *(const u32x4*)(p.dckv + (size_t)(m0 + row) * 320 + k); };
    auto epi = [&](f32x16 (&acc)[2], int wm, int wn, int lane) __attribute__((always_inline)) {
      const int lr = lane & 31, lh = lane >> 5;
      const int head = tn;
      const int tokl = wn * 32 + lr, tok = m0 + tokl;
      const float sc = st[tokl];
#pragma unroll
      for (int i = 0; i < 2; ++i) {
        const int within = wm * 64 + i * 32;
        const f32x16& a = acc[i];
        if (within < 64) {
#pragma unroll
          for (int q = 0; q < 4; ++q)
            st4bf(p.kc + (size_t)tok * 384 + head * 96 + within + 8 * q + 4 * lh, a[4 * q] * sc, a[4 * q + 1] * sc, a[4 * q + 2] * sc, a[4 * q + 3] * sc);
        } else {
#pragma unroll
          for (int r = 0; r < 16; ++r)
            p.vT[(size_t)(head * 64 + within - 64 + rowmap(r, lh)) * TBP + tok] = f2bf(a[r] * sc);
        }
      }
    };
    gemm_tile2s<false, false>(smem, 5, la, lb, epi);
    __syncthreads();
  }
  base += 4 * 128;
}

DI void phase_mixb(const Prm& p, unsigned char* smem_raw, int S, int lgS, int& base) {
  float* bt = (float*)smem_raw;
  const int tid = tidx(), lane = tid & 63, wave = tid >> 6, lr = lane & 31, lh = lane >> 5;
  u16* vt = (u16*)(smem_raw + 3328) + wave * (64 * 40);
  for (int idx = tid; idx < 774; idx += NTH) bt[idx] = p.biasT[idx];
  __syncthreads();
  TASK_LOOP(t, 384, base) {
    const int wt = t * 8 + wave;
    const int hg = wt & 1, g = (wt >> 1) % 3, blk = wt / 6;
    const int seq = blk >> (lgS - 5), b_in = blk & ((S >> 5) - 1);
    const int lgd = 2 * g, L = S >> lgd;
    const int lgbpr = lgS - lgd - 5;
    const int res = b_in >> lgbpr, i0 = (b_in & ((1 << lgbpr) - 1)) << 5;
    const int tokbase = seq * S + res;
    const int hd = g * 2 + hg, hc = hd * 64;
    const int qi = i0 + lr;
    const int qtok = tokbase + (qi << lgd);
    bf16x8 qf[4];
#pragma unroll
    for (int ks = 0; ks < 4; ++ks) qf[ks] = *(const bf16x8*)(p.bqkv + (size_t)qtok * 1152 + hc + ks * 16 + lh * 8);
    f32x16 sc[5];
#pragma unroll
    for (int tt = 0; tt < 5; ++tt) {
      int ik = i0 - 64 + 32 * tt + lr;
      ik = min(max(ik, 0), L - 1);
      const u16* kp = p.bqkv + (size_t)(tokbase + (ik << lgd)) * 1152 + 384 + hc + lh * 8;
      sc[tt] = zero16();
#pragma unroll
      for (int ks = 0; ks < 4; ++ks) sc[tt] = mfma(*(const bf16x8*)(kp + ks * 16), qf[ks], sc[tt]);
    }
    float mx = -1e30f;
#pragma unroll
    for (int tt = 0; tt < 5; ++tt)
#pragma unroll
      for (int r = 0; r < 16; ++r) {
        const int ik = i0 - 64 + 32 * tt + rowmap(r, lh);
        const int rel = ik - qi;
        const bool valid = (rel >= -64) && (rel <= 64) && (ik >= 0) && (ik < L);
        const int bi = min(max(rel + 64, 0), 128);
        const float s = valid ? (sc[tt][r] * 0.125f + bt[hd * 129 + bi]) * LOG2E : -1e30f;
        sc[tt][r] = s;
        mx = fmaxf(mx, s);
      }
    mx = fmaxf(mx, __shfl_xor(mx, 32));
    float sum = 0.f;
#pragma unroll
    for (int tt = 0; tt < 5; ++tt)
#pragma unroll
      for (int r = 0; r < 16; ++r) {
        const float pv = ex2(sc[tt][r] - mx);
        sum += pv;
        sc[tt][r] = pv;
      }
    sum += __shfl_xor(sum, 32);
    f32x16 oacc[2];
    oacc[0] = zero16(); oacc[1] = zero16();
#pragma unroll
    for (int tt = 0; tt < 5; ++tt) {
#pragma unroll
      for (int e = 0; e < 4; ++e) {
        const int c = lane + 64 * e, key = c >> 3, dch = c & 7;
        int ik = i0 - 64 + 32 * tt + key;
        ik = min(max(ik, 0), L - 1);
        const u32x4 raw = *(const u32x4*)(p.bqkv + (size_t)(tokbase + (ik << lgd)) * 1152 + 768 + hc + dch * 8);
#pragma unroll
        for (int jj = 0; jj < 4; ++jj) {
          vt[(dch * 8 + 2 * jj) * 40 + key] = (u16)(raw[jj] & 0xffffu);
          vt[(dch * 8 + 2 * jj + 1) * 40 + key] = (u16)(raw[jj] >> 16);
        }
      }
      __syncthreads();
#pragma unroll
      for (int u = 0; u < 2; ++u) {
        u32x4 pk;
#pragma unroll
        for (int jj = 0; jj < 4; ++jj) pk[jj] = pack2(sc[tt][8 * u + 2 * jj], sc[tt][8 * u + 2 * jj + 1]);
        const bf16x8 pf = __builtin_bit_cast(bf16x8, pk);
#pragma unroll
        for (int dt = 0; dt < 2; ++dt) {
          const u16* vp = vt + (dt * 32 + lr) * 40 + 16 * u + 4 * lh;
          u32x4 vv;
          const u32x2 lo = *(const u32x2*)vp, hi = *(const u32x2*)(vp + 8);
          vv[0] = lo[0]; vv[1] = lo[1]; vv[2] = hi[0]; vv[3] = hi[1];
          oacc[dt] = mfma(__builtin_bit_cast(bf16x8, vv), pf, oacc[dt]);
        }
      }
      __syncthreads();
    }
    const float inv = 1.f / sum;
#pragma unroll
    for (int dt = 0; dt < 2; ++dt)
#pragma unroll
      for (int q = 0; q < 4; ++q) {
        float4 o;
        o.x = oacc[dt][4 * q] * inv; o.y = oacc[dt][4 * q + 1] * inv; o.z = oacc[dt][4 * q + 2] * inv; o.w = oacc[dt][4 * q + 3] * inv;
        *(float4*)(p.og + (size_t)qtok * 384 + hc + dt * 32 + 8 * q + 4 * lh) = o;
      }
    if (lh == 0) p.lse[(size_t)qtok * 6 + hd] = (mx + __log2f(sum)) * LN2;
  }
  base += 384;
  __syncthreads();
}

DI void phase_combb(const Prm& p) {
  const int gtid = blockIdx.x * NTH + tidx(), gn = gridDim.x * NTH;
  for (int idx = gtid; idx < TB * 32; idx += gn) {
    const int dq = idx & 15, hg = (idx >> 4) & 1, tok = idx >> 5;
    const float l0 = p.lse[(size_t)tok * 6 + hg], l1 = p.lse[(size_t)tok * 6 + 2 + hg], l2 = p.lse[(size_t)tok * 6 + 4 + hg];
    const float mx = fmaxf(l0, fmaxf(l1, l2));
    const float e0 = __expf(l0 - mx), e1 = __expf(l1 - mx), e2 = __expf(l2 - mx);
    const float inv = 1.f / (e0 + e1 + e2);
    const float4 a = *(const float4*)(p.og + (size_t)tok * 384 + hg * 64 + dq * 4);
    const float4 b = *(const float4*)(p.og + (size_t)tok * 384 + 128 + hg * 64 + dq * 4);
    const float4 c = *(const float4*)(p.og + (size_t)tok * 384 + 256 + hg * 64 + dq * 4);
    st4bf(p.ob + (size_t)tok * 128 + hg * 64 + dq * 4, (e0 * a.x + e1 * b.x + e2 * c.x) * inv, (e0 * a.y + e1 * b.y + e2 * c.y) * inv,
          (e0 * a.z + e1 * b.z + e2 * c.z) * inv, (e0 * a.w + e1 * b.w + e2 * c.w) * inv);
  }
}

constexpr int KS_ELEMS = 128 * 104, VS_ELEMS = 64 * 136;
DI void phase_mla(const Prm& p, unsigned char* smem_raw, int S, int lgS, int& base) {
  u16* Ks = (u16*)smem_raw;
  u16* Vs = Ks + 2 * KS_ELEMS;
  const int tid = tidx(), lane = tid & 63, wave = tid >> 6, lr = lane & 31, lh = lane >> 5;
  const int nkt = S >> 7;
  TASK_LOOP(t, 256, base) {
    const int head = t & 3, qb = t >> 2, tok0 = qb * 256;
    const int seqtok0 = (tok0 >> lgS) << lgS;
    const int qtok = tok0 + wave * 32 + lr;
    bf16x8 qf[6];
#pragma unroll
    for (int ks = 0; ks < 6; ++ks) qf[ks] = *(const bf16x8*)(p.qc + (size_t)qtok * 384 + head * 96 + ks * 16 + lh * 8);
    const u16* kbase = p.kc + (size_t)seqtok0 * 384 + head * 96;
    const u16* vbase = p.vT + (size_t)(head * 64) * TBP + seqtok0;
    u32x4 rk[3], rv[2];
    auto gload = [&](int kt) __attribute__((always_inline)) {
#pragma unroll
      for (int e = 0; e < 3; ++e) {
        const int c = tid + NTH * e, key = c / 12, dc = c - key * 12;
        rk[e] = *(const u32x4*)(kbase + (size_t)(kt * 128 + key) * 384 + dc * 8);
      }
#pragma unroll
      for (int e = 0; e < 2; ++e) {
        const int c = tid + NTH * e, d = c >> 4, kch = c & 15;
        rv[e] = *(const u32x4*)(vbase + (size_t)d * TBP + kt * 128 + kch * 8);
      }
    };
    auto sstore = [&](int buf) __attribute__((always_inline)) {
#pragma unroll
      for (int e = 0; e < 3; ++e) {
        const int c = tid + NTH * e, key = c / 12, dc = c - key * 12;
        *(u32x4*)(Ks + buf * KS_ELEMS + key * 104 + dc * 8) = rk[e];
      }
#pragma unroll
      for (int e = 0; e < 2; ++e) {
        const int c = tid + NTH * e, d = c >> 4, kch = c & 15;
        u16* vd = Vs + buf * VS_ELEMS + d * 136 + (kch >> 1) * 16 + (kch & 1) * 4;
        u32x2 lo, hi;
        lo[0] = rv[e][0]; lo[1] = rv[e][1]; hi[0] = rv[e][2]; hi[1] = rv[e][3];
        *(u32x2*)vd = lo;
        *(u32x2*)(vd + 8) = hi;
      }
    };
    float m = -1e30f;
    f32x2 lsum2 = {0.f, 0.f};
    f32x16 oacc[2];
    oacc[0] = zero16(); oacc[1] = zero16();
    gload(0);
    sstore(0);
    __syncthreads();
    for (int kt = 0; kt < nkt; ++kt) {
      const int buf = kt & 1;
      if (kt + 1 < nkt) gload(kt + 1);
      f32x16 s[4];
#pragma unroll
      for (int kk = 0; kk < 4; ++kk) s[kk] = zero16();
      {
        const u16* kp = Ks + buf * KS_ELEMS + lr * 104 + lh * 8;
        bf16x8 kf[4];
#pragma unroll
        for (int kk = 0; kk < 4; ++kk) kf[kk] = *(const bf16x8*)(kp + kk * 32 * 104);
#pragma unroll
        for (int ks = 0; ks < 6; ++ks) {
          bf16x8 kn[4];
          if (ks < 5) {
#pragma unroll
            for (int kk = 0; kk < 4; ++kk) kn[kk] = *(const bf16x8*)(kp + kk * 32 * 104 + (ks + 1) * 16);
          }
#pragma unroll
          for (int kk = 0; kk < 4; ++kk) s[kk] = mfma(kf[kk], qf[ks], s[kk]);
          if (ks < 5) {
#pragma unroll
            for (int kk = 0; kk < 4; ++kk) kf[kk] = kn[kk];
          }
        }
      }
      float mloc = -1e30f;
#pragma unroll
      for (int kk = 0; kk < 4; ++kk)
#pragma unroll
        for (int r = 0; r < 16; ++r) mloc = fmaxf(mloc, s[kk][r]);
      mloc = fmaxf(mloc, __shfl_xor(mloc, 32));
      const float mnew = fmaxf(m, mloc);
      const float alpha = ex2(m - mnew);
      m = mnew;
      lsum2 *= alpha;
      const f32x2 mn2 = {mnew, mnew};
#pragma unroll
      for (int kk = 0; kk < 4; ++kk)
#pragma unroll
        for (int r2 = 0; r2 < 8; ++r2) {
          f32x2 v = {s[kk][2 * r2], s[kk][2 * r2 + 1]};
          v = v - mn2;
          f32x2 pv;
          pv[0] = ex2(v[0]); pv[1] = ex2(v[1]);
          lsum2 += pv;
          s[kk][2 * r2] = pv[0]; s[kk][2 * r2 + 1] = pv[1];
        }
#pragma unroll
      for (int dt = 0; dt < 2; ++dt)
#pragma unroll
        for (int r = 0; r < 16; ++r) oacc[dt][r] *= alpha;
#pragma unroll
      for (int kk = 0; kk < 4; ++kk)
#pragma unroll
        for (int u = 0; u < 2; ++u) {
          u32x4 pk;
#pragma unroll
          for (int jj = 0; jj < 4; ++jj) pk[jj] = pack2(s[kk][8 * u + 2 * jj], s[kk][8 * u + 2 * jj + 1]);
          const bf16x8 pf = __builtin_bit_cast(bf16x8, pk);
#pragma unroll
          for (int dt = 0; dt < 2; ++dt) {
            const u16* vp = Vs + buf * VS_ELEMS + (dt * 32 + lr) * 136 + kk * 32 + 16 * u + 8 * lh;
            oacc[dt] = mfma(*(const bf16x8*)vp, pf, oacc[dt]);
          }
        }
      if (kt + 1 < nkt) sstore(buf ^ 1);
      __syncthreads();
    }
    float lsum = lsum2[0] + lsum2[1];
    lsum += __shfl_xor(lsum, 32);
    const float inv = 1.f / lsum;
#pragma unroll
    for (int dt = 0; dt < 2; ++dt)
#pragma unroll
      for (int q = 0; q < 4; ++q)
        st4bf(p.od + (size_t)qtok * 256 + head * 64 + dt * 32 + 8 * q + 4 * lh, oacc[dt][4 * q] * inv, oacc[dt][4 * q + 1] * inv,
              oacc[dt][4 * q + 2] * inv, oacc[dt][4 * q + 3] * inv);
  }
  base += 256;
}

template <class ACC>
DI void merge_branch(const Prm& p, u16* smem, const u16* W, const u16* X, int ld, int bi, int n0, int m0, ACC& macc) {
  auto la = [&](int row, int k) __attribute__((always_inline)) { return *(const u32x4*)(W + (size_t)(n0 + row) * ld + k); };
  auto lb = [&](int row, int k) __attribute__((always_inline)) { return *(const u32x4*)(X + (size_t)(m0 + row) * ld + k); };
  auto epi = [&](f32x16 (&acc)[2], int wm, int wn, int lane) __attribute__((always_inline)) {
    const int lr = lane & 31, lh = lane >> 5;
    const int tok = m0 + wn * 32 + lr;
#pragma unroll
    for (int i = 0; i < 2; ++i)
#pragma unroll
      for (int q = 0; q < 4; ++q) {
        const int n = n0 + wm * 64 + i * 32 + 8 * q + 4 * lh;
        const u32x2 gz = *(const u32x2*)(p.zg + (size_t)tok * 4096 + bi * 1024 + n);
        macc[i][4 * q] += bflo(gz[0]) * acc[i][4 * q];
        macc[i][4 * q + 1] += bfhi(gz[0]) * acc[i][4 * q + 1];
        macc[i][4 * q + 2] += bflo(gz[1]) * acc[i][4 * q + 2];
        macc[i][4 * q + 3] += bfhi(gz[1]) * acc[i][4 * q + 3];
      }
  };
  gemm_tile<false, false>(smem, ld >> 6, la, lb, epi);
}

DI void phase_merge(const Prm& p, u16* smem, int l, int& base) {
  TASK_LOOP(t, 8 * 128, base) {
    const int tn = t & 7, tm = t >> 3, n0 = tn * 128, m0 = tm * 128;
    f32x16 macc[2];
    macc[0] = zero16(); macc[1] = zero16();
    merge_branch(p, smem, p.PaT + (size_t)l * 1024 * 768, p.UT, 768, 0, n0, m0, macc);
    merge_branch(p, smem, p.PbT + (size_t)l * 1024 * 128, p.ob, 128, 1, n0, m0, macc);
    merge_branch(p, smem, p.PcT + (size_t)l * 1024 * 384, p.cu, 384, 2, n0, m0, macc);
    merge_branch(p, smem, p.PdT + (size_t)l * 1024 * 256, p.od, 256, 3, n0, m0, macc);
    const int tid2 = tidx(), lane = tid2 & 63, wave = tid2 >> 6, wm = wave >> 2, wn = wave & 3, lr = lane & 31, lh = lane >> 5;
    const int tok = m0 + wn * 32 + lr;
#pragma unroll
    for (int i = 0; i < 2; ++i)
#pragma unroll
      for (int q = 0; q < 4; ++q)
        st4bf(p.hbuf + (size_t)tok * 1024 + n0 + wm * 64 + i * 32 + 8 * q + 4 * lh, macc[i][4 * q], macc[i][4 * q + 1],
              macc[i][4 * q + 2], macc[i][4 * q + 3]);
  }
  base += 8 * 128;
}

DI void phase_resid_gemm(const Prm& p, unsigned char* smem_raw, const u16* W, const u16* X, int K, const float* xsrc, float* xdst,
                         const float* modl, int gtoff, int sb, int& base) {
  LAS u16* shm = (LAS u16*)smem_raw;
  bool pre = false;
  TASK_LOOP(t, 4 * 64, base) {
    int tn, tm;
    map256(t, 4, tn, tm);
    const int brow = tn * 256, bcol = tm * 256;
    const int tnx = t + (int)gridDim.x;
    const bool has_next = tnx < (4 * 64);
    int tn2 = 0, tm2 = 0;
    if (has_next) map256(tnx, 4, tn2, tm2);
    const int nbrow = tn2 * 256, nbcol = tm2 * 256;
    auto epi = [&](f32x4 (&acc)[2][2][4][2], int wr, int wc, int fr, int fq) __attribute__((always_inline)) {
#pragma unroll
      for (int bj = 0; bj < 2; ++bj)
#pragma unroll
        for (int n = 0; n < 2; ++n) {
          const int tok = bcol + bj * 128 + wc * 32 + n * 16 + fr;
          const float* gt = modl + condrow(sb, tok) * 6144 + gtoff;
#pragma unroll
          for (int ai = 0; ai < 2; ++ai)
#pragma unroll
            for (int m = 0; m < 4; ++m) {
              const int nn = brow + ai * 128 + wr * 64 + m * 16 + fq * 4;
              const f32x4 v = acc[ai][bj][m][n];
              const float4 g4 = *(const float4*)(gt + nn);
              const float4 xi = *(const float4*)(xsrc + (size_t)tok * 1024 + nn);
              float4 o;
              o.x = xi.x + g4.x * v[0]; o.y = xi.y + g4.y * v[1]; o.z = xi.z + g4.z * v[2]; o.w = xi.w + g4.w * v[3];
              *(float4*)(xdst + (size_t)tok * 1024 + nn) = o;
            }
        }
    };
    gemm256(shm, W, X, K, brow, bcol, pre, has_next, nbrow, nbcol, epi);
    pre = has_next;
  }
  base += 4 * 64;
}

DI void phase_w1(const Prm& p, unsigned char* smem_raw, int l, int& base) {
  const u16* W = p.W1T + (size_t)l * 4096 * 1024;
  LAS u16* shm = (LAS u16*)smem_raw;
  bool pre = false;
  TASK_LOOP(t, 16 * 64, base) {
    int tn, tm;
    map256(t, 16, tn, tm);
    const int brow = tn * 256, bcol = tm * 256;
    const int tnx = t + (int)gridDim.x;
    const bool has_next = tnx < (16 * 64);
    int tn2 = 0, tm2 = 0;
    if (has_next) map256(tnx, 16, tn2, tm2);
    const int nbrow = tn2 * 256, nbcol = tm2 * 256;
    auto epi = [&](f32x4 (&acc)[2][2][4][2], int wr, int wc, int fr, int fq) __attribute__((always_inline)) {
#pragma unroll
      for (int bj = 0; bj < 2; ++bj)
#pragma unroll
        for (int n = 0; n < 2; ++n) {
          const int tok = bcol + bj * 128 + wc * 32 + n * 16 + fr;
#pragma unroll
          for (int ai = 0; ai < 2; ++ai)
#pragma unroll
            for (int m = 0; m < 4; ++m) {
              const int nn = brow + ai * 128 + wr * 64 + m * 16 + fq * 4;
              const f32x4 v = acc[ai][bj][m][n];
              const float a0 = fmaxf(v[0], 0.f), a1 = fmaxf(v[1], 0.f), a2 = fmaxf(v[2], 0.f), a3 = fmaxf(v[3], 0.f);
              st4bf(p.zg + (size_t)tok * 4096 + nn, a0 * a0, a1 * a1, a2 * a2, a3 * a3);
            }
        }
    };
    gemm256(shm, W, p.hbuf, 1024, brow, bcol, pre, has_next, nbrow, nbcol, epi);
    pre = has_next;
  }
  base += 16 * 64;
}

DI void phase_final(const Prm& p) {
  const int tid = tidx(), lane = tid & 63;
  const int gw = blockIdx.x * 8 + (tid >> 6), nw = gridDim.x * 8;
  for (int row = gw; row < 3 * TB; row += nw) {
    float* xr = p.out + (size_t)row * 1024;
    float4 v[4];
    float ss = 0.f;
#pragma unroll
    for (int i = 0; i < 4; ++i) {
      v[i] = *(const float4*)(xr + i * 256 + lane * 4);
      ss += v[i].x * v[i].x + v[i].y * v[i].y + v[i].z * v[i].z + v[i].w * v[i].w;
    }
#pragma unroll
    for (int off = 32; off >= 1; off >>= 1) ss += __shfl_xor(ss, off);
    const float rstd = rsqrtf(ss * (1.f / 1024.f) + 1e-6f);
#pragma unroll
    for (int i = 0; i < 4; ++i) {
      const int col = i * 256 + lane * 4;
      const float4 gg = *(const float4*)(p.final_g + col);
      float4 o;
      o.x = v[i].x * rstd * gg.x; o.y = v[i].y * rstd * gg.y; o.z = v[i].z * rstd * gg.z; o.w = v[i].w * rstd * gg.w;
      *(float4*)(xr + col) = o;
    }
  }
}

__global__ void __launch_bounds__(512) mega(Prm p) {
  cg::grid_group grid = cg::this_grid();
  __shared__ __attribute__((aligned(16))) unsigned char smem_raw[SMEM_BYTES];
  __shared__ uint4 xb_words;
  u16* smem = (u16*)smem_raw;
  if (threadIdx.x == 0) xb_words = make_uint4(0u, 0u, 0u, 0u);
  __syncthreads();
  const XcdBarrier xb = xcd_barrier_post(p.bar, (volatile LAS unsigned*)&xb_words);
  int base = 0;
  prologue_a(p, smem_raw, base);
  if (PROBE == 11) prologue_a(p, smem_raw, base);
  grid.sync();
  prologue_b(p);
  xcd_barrier(xb);
  for (int sb = 0; sb < 3; ++sb) {
    const int S = sb == 0 ? 16384 : 2048, lgS = sb == 0 ? 14 : 11, nseq = sb == 0 ? 1 : 8;
    const int N1 = S >> 7, lgN1 = lgS - 7;
    const float* xin = sb == 0 ? p.x_prompt : p.x_sample + (size_t)(sb - 1) * TB * 1024;
    float* xo = p.out + (size_t)sb * TB * 1024;
    for (int l = 0; l < 4; ++l) {
      const float* xs = l == 0 ? xin : xo;
      const float* modl = p.mod + (size_t)l * 17 * 6144;
      phase_norm(p, xs, p.norm1_g + l * 1024, modl, 0, 1024, sb);
      xcd_barrier(xb);
      phase_inproj(p, smem_raw, l, S, base);
      if (PROBE == 2 || PROBE == 7) phase_inproj(p, smem_raw, l, S, base);
      if (PROBE == 12) phase_inproj_probe(p, smem_raw, l, base);
      xcd_barrier(xb);
      if (PROBE == 5) xcd_barrier(xb);
      if (N1 == 16) phase_fft1_small(p, nseq); else phase_fft1(p, smem, S, nseq, N1, lgN1, base);
      phase_mixb(p, smem_raw, S, lgS, base);
      phase_mixc(p, smem_raw, l, base);
      phase_qup(p, smem_raw, l, S, base);
      phase_kvup(p, smem_raw, l, base);
      phase_inproj_tail(p, smem_raw, l, base);
      if (PROBE == 13) phase_fft1(p, smem, S, nseq, N1, lgN1, base);
      if (PROBE == 14) phase_mixb(p, smem_raw, S, lgS, base);
      if (PROBE == 15) { phase_qup(p, smem_raw, l, S, base); phase_kvup(p, smem_raw, l, base); phase_inproj_tail(p, smem_raw, l, base); }
      if (PROBE == 4) { phase_fft1(p, smem, S, nseq, N1, lgN1, base); phase_mixb(p, smem_raw, S, lgS, base); phase_qup(p, smem_raw, l, S, base); phase_kvup(p, smem_raw, l, base); }
      xcd_barrier(xb);
      if (PROBE == 5) xcd_barrier(xb);
      phase_mla(p, smem_raw, S, lgS, base);
      if (PROBE == 1) phase_mla(p, smem_raw, S, lgS, base);
      phase_fft2(p, smem, S, nseq, N1, base);
      phase_combb(p);
      if (PROBE == 6) { phase_fft2(p, smem, S, nseq, N1, base); phase_combb(p); }
      xcd_barrier(xb);
      if (PROBE == 5) xcd_barrier(xb);
      phase_merge(p, smem, l, base);
      if (PROBE == 3) phase_merge(p, smem, l, base);
      xcd_barrier(xb);
      if (PROBE == 5) xcd_barrier(xb);
      phase_resid_gemm(p, smem_raw, p.WoT + (size_t)l * 1024 * 1024, p.hbuf, 1024, xs, xo, modl, 2048, sb, base);
      xcd_barrier(xb);
      phase_norm(p, xo, p.norm2_g + l * 1024, modl, 3072, 4096, sb);
      if (PROBE == 9) { phase_norm(p, xo, p.norm2_g + l * 1024, modl, 3072, 4096, sb); phase_norm(p, xo, p.norm2_g + l * 1024, modl, 3072, 4096, sb); }
      xcd_barrier(xb);
      phase_w1(p, smem_raw, l, base);
      if (PROBE == 2 || PROBE == 8) phase_w1(p, smem_raw, l, base);
      xcd_barrier(xb);
      if (PROBE == 5) xcd_barrier(xb);
      phase_resid_gemm(p, smem_raw, p.W2T + (size_t)l * 1024 * 4096, p.zg, 4096, xo, xo, modl, 5120, sb, base);
      xcd_barrier(xb);
    }
  }
  phase_final(p);
}

extern "C" void kernel_launch(void* const* d_in, const int* in_sizes, int n_in, void* d_out, int out_size, void* d_ws, size_t ws_size,
                              hipStream_t stream) {
  Prm p{};
  const float* const* in = (const float* const*)d_in;
  p.x_prompt = in[0]; p.x_sample = in[1]; p.c_prompt = in[2]; p.c_sample = in[3]; p.rel_bias = in[4]; p.ada_w = in[5]; p.ada_b = in[6];
  p.norm1_g = in[7]; p.w_in = in[8]; p.qn_g = in[9]; p.kvn_g = in[10]; p.w_uq = in[11]; p.w_ukv = in[12]; p.ln_g = in[13]; p.ln_b = in[14];
  p.sgu_w = in[15]; p.sgu_b = in[16]; p.p_a = in[17]; p.p_b = in[18]; p.p_c = in[19]; p.p_d = in[20]; p.w_o = in[21]; p.norm2_g = in[22];
  p.w1 = in[23]; p.w2 = in[24]; p.final_g = in[25];
  p.out = (float*)d_out;
  char* w = (char*)d_ws;
  size_t off = 0;
  auto take = [&](size_t bytes) __attribute__((always_inline)) { void* r = w + off; off += (bytes + 255) & ~(size_t)255; return r; };
  p.WinT = (u16*)take((size_t)4 * NWP * 1024 * 2);
  p.W1T = (u16*)take((size_t)4 * 4096 * 1024 * 2);
  p.W2T = (u16*)take((size_t)4 * 4096 * 1024 * 2);
  p.WoT = (u16*)take((size_t)4 * 1024 * 1024 * 2);
  p.PaT = (u16*)take((size_t)4 * 1024 * 768 * 2);
  p.PbT = (u16*)take((size_t)4 * 1024 * 128 * 2);
  p.PcT = (u16*)take((size_t)4 * 1024 * 384 * 2);
  p.PdT = (u16*)take((size_t)4 * 1024 * 256 * 2);
  p.WqT = (u16*)take((size_t)4 * 384 * 384 * 2);
  p.WkvT = (u16*)take((size_t)4 * 512 * 320 * 2);
  p.SgW = (u16*)take((size_t)4 * 4 * 128 * 128 * 2);
  p.M1a = (u16*)take(256 * 256 * 2);
  p.M1b = (u16*)take(32 * 64 * 2);
  p.M2 = (u16*)take(128 * 256 * 2);
  p.tw = (float2*)take(16384 * 8);
  p.rope = (float2*)take((size_t)16384 * 16 * 8);
  p.biasT = (float*)take(6 * 129 * 4);
  p.mod = (float*)take((size_t)4 * 17 * 6144 * 4);
  p.hbuf = (u16*)take((size_t)TB * 1024 * 2);
  p.og = (float*)take((size_t)TB * 384 * 4);
  p.UT = (u16*)take((size_t)1536 * TBP * 2);
  p.Gp = (u16*)take((size_t)1536 * TB * 2);
  p.bqkv = (u16*)take((size_t)TB * 1152 * 2);
  p.ob = (u16*)take((size_t)TB * 128 * 2);
  p.cu = (u16*)take((size_t)TB * 384 * 2);
  p.cvT = (u16*)take((size_t)TBP * 384 * 2);
  p.dcq = (u16*)take((size_t)TB * 384 * 2);
  p.dckv = (u16*)take((size_t)TB * 320 * 2);
  p.qc = (u16*)take((size_t)TB * 384 * 2);
  p.kc = (u16*)take((size_t)TB * 384 * 2);
  p.vT = (u16*)take((size_t)TBP * 256 * 2);
  p.od = (u16*)take((size_t)TB * 256 * 2);
  p.lse = (float*)take((size_t)TB * 6 * 4);
  p.zg = (u16*)take((size_t)TB * 4096 * 2);
  p.bar = (unsigned*)take(XCD_BAR_WORDS * 4);
  p.modpart = (float*)p.zg;
  if (off > ws_size) { fprintf(stderr, "workspace too small: need %zu have %zu\n", off, ws_size); return; }
  static int grid_blocks = 0;
  if (!grid_blocks) {
    int dev = 0, cus = 0, per_cu = 0;
    (void)hipGetDevice(&dev);
    (void)hipDeviceGetAttribute(&cus, hipDeviceAttributeMultiprocessorCount, dev);
    (void)hipOccupancyMaxActiveBlocksPerMultiprocessor(&per_cu, mega, NTH, 0);
    if (per_cu < 1) per_cu = 1;
    if (per_cu > 1) per_cu = 1;
    grid_blocks = cus * per_cu;
  }
  (void)hipMemsetAsync(p.bar, 0, XCD_BAR_WORDS * 4, stream);
  void* args[] = {&p};
  hipError_t e = hipLaunchCooperativeKernel((void*)mega, dim3(grid_blocks), dim3(NTH), args, 0, stream);
  if (e != hipSuccess) fprintf(stderr, "cooperative launch failed: %s (grid %d)\n", hipGetErrorString(e), grid_blocks);
}
```

```cpp
#include <hip/hip_runtime.h>
#include <hip/hip_cooperative_groups.h>
#include <stdint.h>
#include <stdio.h>
namespace cg = cooperative_groups;

#define DI __device__ __forceinline__
#define LAS __attribute__((address_space(3)))
typedef unsigned short u16;
typedef __attribute__((ext_vector_type(8))) short bf16x8;
typedef __attribute__((ext_vector_type(4))) short bf16x4;
typedef __attribute__((ext_vector_type(16))) float f32x16;
typedef __attribute__((ext_vector_type(4))) float f32x4;
typedef __attribute__((ext_vector_type(2))) float f32x2;
typedef __attribute__((ext_vector_type(4))) unsigned u32x4;
typedef __attribute__((ext_vector_type(2))) unsigned u32x2;
typedef __attribute__((ext_vector_type(2))) __bf16 bf2_t;

constexpr int TB = 16384;
constexpr int TBP = TB + 64;
constexpr int NW = 8288;
constexpr int NWP = 8320;
constexpr int LDT = 72;
constexpr int TILE_ELEMS = 128 * LDT;
constexpr int GEMM_SMEM = 4 * TILE_ELEMS * 2;
constexpr int SMEM_BYTES = 131072;
#ifndef PROBE
#define PROBE 0
#endif
constexpr int NTH = 512;
constexpr int HT = 128 * 64;
constexpr float LOG2E = 1.4426950408889634f;
constexpr float LN2 = 0.6931471805599453f;

struct Prm {
  const float *x_prompt, *x_sample, *c_prompt, *c_sample, *rel_bias, *ada_w, *ada_b, *norm1_g, *w_in,
      *qn_g, *kvn_g, *w_uq, *w_ukv, *ln_g, *ln_b, *sgu_w, *sgu_b, *p_a, *p_b, *p_c, *p_d, *w_o,
      *norm2_g, *w1, *w2, *final_g;
  float* out;
  u16 *WinT, *W1T, *W2T, *WoT, *PaT, *PbT, *PcT, *PdT, *WqT, *WkvT, *SgW, *M1a, *M1b, *M2;
  float2 *tw, *rope;
  float *biasT, *mod, *modpart;
  u16 *hbuf, *UT, *Gp, *bqkv, *ob, *cu, *cvT, *dcq, *dckv, *qc, *kc, *vT, *od, *zg;
  float *og, *lse;
  unsigned* bar;
};

DI unsigned pack2(float a, float b) { bf2_t v; v[0] = (__bf16)a; v[1] = (__bf16)b; return __builtin_bit_cast(unsigned, v); }
DI u16 f2bf(float a) { return __builtin_bit_cast(u16, (__bf16)a); }
DI float bf2f(u16 v) { return __uint_as_float(((unsigned)v) << 16); }
DI float bflo(unsigned w) { return __uint_as_float(w << 16); }
DI float bfhi(unsigned w) { return __uint_as_float(w & 0xffff0000u); }
DI void st4bf(u16* dst, float a, float b, float c, float d) { u32x2 v; v[0] = pack2(a, b); v[1] = pack2(c, d); *(u32x2*)dst = v; }
DI void st4bf_nt(u16* dst, float a, float b, float c, float d) { u32x2 v; v[0] = pack2(a, b); v[1] = pack2(c, d); __builtin_nontemporal_store(v, (u32x2*)dst); }
DI int rowmap(int r, int lh) { return (r & 3) + 8 * (r >> 2) + 4 * lh; }
DI f32x16 mfma(bf16x8 a, bf16x8 b, f32x16 c) { return __builtin_amdgcn_mfma_f32_32x32x16_bf16(a, b, c, 0, 0, 0); }
DI u32x4 zero4() { u32x4 z; z[0] = 0; z[1] = 0; z[2] = 0; z[3] = 0; return z; }
DI f32x16 zero16() { f32x16 z; for (int i = 0; i < 16; ++i) z[i] = 0.f; return z; }
DI float ex2(float x) { return __builtin_amdgcn_exp2f(x); }
DI int tidx() { int t = threadIdx.x; asm volatile("" : "+v"(t)); return t; }


#define XB_TMO      128
#define XB_XCNT(j)  (256  + 64 * (j))
#define XB_XSUB(j)  (1280 + 64 * (j))
#define XB_XGEN(j)  (2304 + 64 * (j))
#define XB_TOP      3328
#define XB_TOPGEN   3392
#define XCD_BAR_WORDS 3456
#define XB_SPIN_CAP (1u << 18)
DI unsigned xb_ld(unsigned* p) { return __hip_atomic_load(p, __ATOMIC_RELAXED, __HIP_MEMORY_SCOPE_AGENT); }
DI unsigned xb_add(unsigned* p, unsigned v) { return __hip_atomic_fetch_add(p, v, __ATOMIC_RELAXED, __HIP_MEMORY_SCOPE_AGENT); }
DI unsigned xb_xcc_id() { return (unsigned)__builtin_amdgcn_s_getreg((3 << 11) | 20) & 0xFu; }
#define XB_SPIN(cond, bar) do { unsigned _sp = 0; while (cond) { __builtin_amdgcn_s_sleep(1); \
    if ((++_sp & 255u) == 0u) { if (xb_ld(&(bar)[XB_TMO])) break; if (_sp > XB_SPIN_CAP) { atomicAdd(&(bar)[XB_TMO], 1u); break; } } } } while (0)
struct XcdBarrier { unsigned* bar; unsigned x; volatile LAS unsigned* st; };
DI XcdBarrier xcd_barrier_post(unsigned* bar, volatile LAS unsigned* st) {
  XcdBarrier b; b.bar = bar; b.x = xb_xcc_id(); b.st = st;
  if (threadIdx.x == 0) (void)xb_add(&bar[XB_XCNT(b.x)], 1u);
  return b;
}
DI void xcd_barrier_complete(unsigned* bar, unsigned x, unsigned& nloc, unsigned& nx) {
  const unsigned G = gridDim.x * gridDim.y * gridDim.z;
  unsigned sum, cnt, mine, sp = 0u;
  for (;;) {
    sum = 0u; cnt = 0u; mine = 0u;
#pragma unroll
    for (unsigned j = 0; j < 16; ++j) { const unsigned c = xb_ld(&bar[XB_XCNT(j)]); sum += c; cnt += (c > 0u) ? 1u : 0u; mine = (j == x) ? c : mine; }
    if (sum == G) break;
    __builtin_amdgcn_s_sleep(1);
    if ((++sp & 255u) == 0u) { if (xb_ld(&bar[XB_TMO])) break; if (sp > XB_SPIN_CAP) { atomicAdd(&bar[XB_TMO], 1u); break; } }
  }
  nloc = mine > 0u ? mine : 1u; nx = cnt > 0u ? cnt : 1u;
}
DI void xcd_barrier(const XcdBarrier& b) {
  asm volatile("s_waitcnt vmcnt(0)" ::: "memory");
  __syncthreads();
  if (tidx() == 0) {
    unsigned* bar = b.bar;
    const unsigned bx = (unsigned)__builtin_amdgcn_readfirstlane((int)xb_xcc_id());
    __builtin_amdgcn_s_waitcnt(0);
    unsigned nloc = b.st[0], nx = b.st[1];
    if (nloc == 0u) { xcd_barrier_complete(bar, bx, nloc, nx); b.st[0] = nloc; b.st[1] = nx; }
    const unsigned old = xb_add(&bar[XB_XSUB(bx)], 1u);
    const unsigned gen = old / nloc;
    if (old + 1u == (gen + 1u) * nloc) {
      __builtin_amdgcn_fence(__ATOMIC_RELEASE, "agent");
      asm volatile("s_waitcnt vmcnt(0)" ::: "memory");
      const unsigned og = xb_add(&bar[XB_TOP], 1u);
      const unsigned tg = og / nx;
      if (og + 1u == (tg + 1u) * nx) xb_add(&bar[XB_TOPGEN], 1u);
      else XB_SPIN(xb_ld(&bar[XB_TOPGEN]) == tg, bar);
      __builtin_amdgcn_fence(__ATOMIC_ACQUIRE, "agent");
      xb_add(&bar[XB_XGEN(bx)], 1u);
      asm volatile("s_waitcnt vmcnt(0)" ::: "memory");
    } else {
      XB_SPIN(xb_ld(&bar[XB_XGEN(bx)]) == gen, bar);
      __builtin_amdgcn_fence(__ATOMIC_ACQUIRE, "agent");
      asm volatile("s_waitcnt vmcnt(0)" ::: "memory");
    }
  }
  __syncthreads();
}

#define TASK_LOOP(t, nt, base) for (int t = (int)((blockIdx.x + gridDim.x - ((unsigned)(base) % gridDim.x)) % gridDim.x); t < (nt); t += gridDim.x)

template <bool RFA, bool RFB, class LA, class LB, class EPI>
DI void gemm_tile(u16* smem, int nk, LA la, LB lb, EPI epi) {
  const int tid = tidx(), lane = tid & 63, wave = tid >> 6;
  const int wm = wave >> 2, wn = wave & 3, lr = lane & 31, lh = lane >> 5;
  u16* As = smem;
  u16* Bs = smem + 2 * TILE_ELEMS;
  f32x16 acc[2];
  acc[0] = zero16(); acc[1] = zero16();
  u32x4 ra[2], rb[2];
#define A_ROW(c) (RFA ? ((c) & 127) : ((c) >> 3))
#define A_KC(c) (RFA ? ((c) >> 7) : ((c) & 7))
#define B_ROW(c) (RFB ? ((c) & 127) : ((c) >> 3))
#define B_KC(c) (RFB ? ((c) >> 7) : ((c) & 7))
#pragma unroll
  for (int i = 0; i < 2; ++i) { const int c = tid + NTH * i; ra[i] = la(A_ROW(c), A_KC(c) * 8); rb[i] = lb(B_ROW(c), B_KC(c) * 8); }
#pragma unroll
  for (int i = 0; i < 2; ++i) {
    const int c = tid + NTH * i;
    *(u32x4*)(As + A_ROW(c) * LDT + A_KC(c) * 8) = ra[i];
    *(u32x4*)(Bs + B_ROW(c) * LDT + B_KC(c) * 8) = rb[i];
  }
  __syncthreads();
  for (int kt = 0; kt < nk; ++kt) {
    const int buf = kt & 1;
    if (kt + 1 < nk) {
      const int k0 = (kt + 1) * 64;
#pragma unroll
      for (int i = 0; i < 2; ++i) { const int c = tid + NTH * i; ra[i] = la(A_ROW(c), k0 + A_KC(c) * 8); rb[i] = lb(B_ROW(c), k0 + B_KC(c) * 8); }
    }
    const u16* Ab = As + buf * TILE_ELEMS + (wm * 64 + lr) * LDT + lh * 8;
    const u16* Bb = Bs + buf * TILE_ELEMS + (wn * 32 + lr) * LDT + lh * 8;
#pragma unroll
    for (int ks = 0; ks < 4; ++ks) {
      const bf16x8 a0 = *(const bf16x8*)(Ab + ks * 16);
      const bf16x8 a1 = *(const bf16x8*)(Ab + 32 * LDT + ks * 16);
      const bf16x8 b = *(const bf16x8*)(Bb + ks * 16);
      acc[0] = mfma(a0, b, acc[0]);
      acc[1] = mfma(a1, b, acc[1]);
    }
    if (kt + 1 < nk) {
      u16* Aw = As + (buf ^ 1) * TILE_ELEMS;
      u16* Bw = Bs + (buf ^ 1) * TILE_ELEMS;
#pragma unroll
      for (int i = 0; i < 2; ++i) {
        const int c = tid + NTH * i;
        *(u32x4*)(Aw + A_ROW(c) * LDT + A_KC(c) * 8) = ra[i];
        *(u32x4*)(Bw + B_ROW(c) * LDT + B_KC(c) * 8) = rb[i];
      }
    }
    __syncthreads();
  }
  epi(acc, wm, wn, lane);
}

template <bool RFA, bool RFB, class LA, class LB, class EPI>
DI void gemm_tile2s(u16* smem, int nk, LA la, LB lb, EPI epi) {
  const int tid = tidx(), lane = tid & 63, wave = tid >> 6;
  const int wm = wave >> 2, wn = wave & 3, lr = lane & 31, lh = lane >> 5;
  u16* As = smem;
  u16* Bs = smem + 2 * TILE_ELEMS;
  f32x16 acc[2];
  acc[0] = zero16(); acc[1] = zero16();
  u32x4 ra0[2], rb0[2], ra1[2], rb1[2];
  auto ld = [&](u32x4 (&ra)[2], u32x4 (&rb)[2], int kt) __attribute__((always_inline)) {
    const int k0 = kt * 64;
#pragma unroll
    for (int i = 0; i < 2; ++i) { const int c = tid + NTH * i; ra[i] = la(A_ROW(c), k0 + A_KC(c) * 8); rb[i] = lb(B_ROW(c), k0 + B_KC(c) * 8); }
  };
  auto stl = [&](u32x4 (&ra)[2], u32x4 (&rb)[2], int buf) __attribute__((always_inline)) {
#pragma unroll
    for (int i = 0; i < 2; ++i) {
      const int c = tid + NTH * i;
      *(u32x4*)(As + buf * TILE_ELEMS + A_ROW(c) * LDT + A_KC(c) * 8) = ra[i];
      *(u32x4*)(Bs + buf * TILE_ELEMS + B_ROW(c) * LDT + B_KC(c) * 8) = rb[i];
    }
  };
  auto compute = [&](int buf) __attribute__((always_inline)) {
    const u16* Ab = As + buf * TILE_ELEMS + (wm * 64 + lr) * LDT + lh * 8;
    const u16* Bb = Bs + buf * TILE_ELEMS + (wn * 32 + lr) * LDT + lh * 8;
#pragma unroll
    for (int ks = 0; ks < 4; ++ks) {
      const bf16x8 a0 = *(const bf16x8*)(Ab + ks * 16);
      const bf16x8 a1 = *(const bf16x8*)(Ab + 32 * LDT + ks * 16);
      const bf16x8 b = *(const bf16x8*)(Bb + ks * 16);
      acc[0] = mfma(a0, b, acc[0]);
      acc[1] = mfma(a1, b, acc[1]);
    }
  };
  ld(ra0, rb0, 0);
  if (nk > 1) ld(ra1, rb1, 1);
  stl(ra0, rb0, 0);
  if (nk > 2) ld(ra0, rb0, 2);
  __syncthreads();
#pragma unroll 1
  for (int kt = 0; kt < nk; kt += 2) {
    compute(0);
    if (kt + 1 < nk) { stl(ra1, rb1, 1); if (kt + 3 < nk) ld(ra1, rb1, kt + 3); }
    __syncthreads();
    if (kt + 1 < nk) {
      compute(1);
      if (kt + 2 < nk) { stl(ra0, rb0, 0); if (kt + 4 < nk) ld(ra0, rb0, kt + 4); }
      __syncthreads();
    }
  }
  epi(acc, wm, wn, lane);
}

DI void stage_rc(int b, int& R, int& C) { int st = b / 1024, sb = b % 1024, swz = sb ^ (((sb >> 9) & 1) << 5); R = (st >> 1) * 16 + swz / 64; C = (st & 1) * 32 + (swz % 64) / 2; }

template <class EPI>
DI void gemm256(LAS u16* shm, const u16* __restrict__ A, const u16* __restrict__ Bt, int K, int brow, int bcol, bool pre, bool has_next, int nbrow, int nbcol, EPI epi) {
#define SA(b, h) (shm + ((b) * 2 + (h)) * HT)
#define SB(b, h) (shm + (4 + (b) * 2 + (h)) * HT)
  const int tid = tidx();
  const int wid = __builtin_amdgcn_readfirstlane(tid >> 6), lane = tid & 63, wr = wid >> 2, wc = wid & 3, fr = lane & 15, fq = lane >> 4;
  int r0, c0, r1, c1;
  stage_rc(tid * 16, r0, c0);
  stage_rc(tid * 16 + 8192, r1, c1);
  const unsigned so0 = (unsigned)(r0 * K + c0) * 2u, so1 = (unsigned)(r1 * K + c1) * 2u;
  const unsigned ldsw = (unsigned)wid * 1024u;
  const int lb = ((fr * 64 + fq * 16) ^ ((fr >> 3) << 5));
#define STAGE(P, BASE, br, kt) do { const char* _g = (const char*)((BASE) + (size_t)(br) * K + (kt) * 64); \
    __builtin_amdgcn_global_load_lds((const unsigned*)(_g + so0), (LAS unsigned*)((LAS char*)(P) + ldsw), 16, 0, 0); \
    __builtin_amdgcn_global_load_lds((const unsigned*)(_g + so1), (LAS unsigned*)((LAS char*)(P) + ldsw + 8192), 16, 0, 0); } while (0)
#define LDA(dst, b, h) _Pragma("unroll") for (int m = 0; m < 4; ++m) _Pragma("unroll") for (int k = 0; k < 2; ++k) \
    dst[m][k] = *(const LAS bf16x8*)((const LAS char*)SA(b, h) + ((wr * 4 + m) * 2 + k) * 1024 + lb)
#define LDB(dst, b, h) _Pragma("unroll") for (int n = 0; n < 2; ++n) _Pragma("unroll") for (int k = 0; k < 2; ++k) \
    dst[n][k] = *(const LAS bf16x8*)((const LAS char*)SB(b, h) + ((wc * 2 + n) * 2 + k) * 1024 + lb)
#define MMA(ai, bj, At_, Bt_) do { __builtin_amdgcn_s_setprio(1); \
    _Pragma("unroll") for (int m = 0; m < 4; ++m) _Pragma("unroll") for (int n = 0; n < 2; ++n) _Pragma("unroll") for (int k = 0; k < 2; ++k) \
      acc[ai][bj][m][n] = __builtin_amdgcn_mfma_f32_16x16x32_bf16(At_[m][k], Bt_[n][k], acc[ai][bj][m][n], 0, 0, 0); \
    __builtin_amdgcn_s_setprio(0); } while (0)
#define WAIT_V(n) asm volatile("s_waitcnt vmcnt(" #n ")" ::: "memory")
#define WAIT_L(n) asm volatile("s_waitcnt lgkmcnt(" #n ")" ::: "memory")
#define BAR __builtin_amdgcn_s_barrier()
#define SCHED __builtin_amdgcn_sched_barrier(0)
  f32x4 acc[2][2][4][2];
#pragma unroll
  for (int a = 0; a < 2; ++a)
#pragma unroll
    for (int b = 0; b < 2; ++b)
#pragma unroll
      for (int m = 0; m < 4; ++m)
#pragma unroll
        for (int n = 0; n < 2; ++n) { acc[a][b][m][n][0] = 0.f; acc[a][b][m][n][1] = 0.f; acc[a][b][m][n][2] = 0.f; acc[a][b][m][n][3] = 0.f; }
  bf16x8 At[4][2], B0[2][2], B1[2][2];
  const int nt = K / 64;
  if (!pre) {
    STAGE(SB(0, 0), Bt, bcol, 0); STAGE(SA(0, 0), A, brow, 0);
    STAGE(SB(0, 1), Bt, bcol + 128, 0); STAGE(SA(0, 1), A, brow + 128, 0);
  }
  if (wr == 1) BAR;
  WAIT_V(4); BAR;
  STAGE(SB(1, 0), Bt, bcol, 1); STAGE(SA(1, 0), A, brow, 1); STAGE(SB(1, 1), Bt, bcol + 128, 1);
  WAIT_V(6); BAR;
  for (int t = 0; t < nt - 2; t += 2) {
    LDB(B0, 0, 0); SCHED; LDA(At, 0, 0); STAGE(SA(1, 1), A, brow + 128, t + 1);
    WAIT_L(8); BAR; WAIT_L(0); MMA(0, 0, At, B0); BAR; SCHED;
    LDB(B1, 0, 1); STAGE(SB(0, 0), Bt, bcol, t + 2);
    BAR; WAIT_L(0); MMA(0, 1, At, B1); BAR;
    LDA(At, 0, 1); STAGE(SA(0, 0), A, brow, t + 2);
    BAR; WAIT_L(0); MMA(1, 0, At, B0); BAR; SCHED;
    STAGE(SB(0, 1), Bt, bcol + 128, t + 2);
    WAIT_V(6); BAR; MMA(1, 1, At, B1); BAR;
    LDB(B0, 1, 0); SCHED; LDA(At, 1, 0); STAGE(SA(0, 1), A, brow + 128, t + 2);
    WAIT_L(8); BAR; WAIT_L(0); MMA(0, 0, At, B0); BAR; SCHED;
    LDB(B1, 1, 1); STAGE(SB(1, 0), Bt, bcol, t + 3);
    BAR; WAIT_L(0); MMA(0, 1, At, B1); BAR;
    LDA(At, 1, 1); STAGE(SA(1, 0), A, brow, t + 3);
    BAR; WAIT_L(0); MMA(1, 0, At, B0); BAR; SCHED;
    STAGE(SB(1, 1), Bt, bcol + 128, t + 3);
    WAIT_V(6); BAR; MMA(1, 1, At, B1); BAR;
  }
  { LDB(B0, 0, 0); LDA(At, 0, 0); STAGE(SA(1, 1), A, brow + 128, nt - 1);
    BAR; WAIT_L(0); MMA(0, 0, At, B0); BAR;
    LDB(B1, 0, 1); BAR; WAIT_L(0); MMA(0, 1, At, B1); BAR;
    LDA(At, 0, 1); WAIT_V(4); BAR; WAIT_L(0); MMA(1, 0, At, B0); MMA(1, 1, At, B1); BAR; }
  { LDB(B0, 1, 0); LDA(At, 1, 0); WAIT_V(2); BAR; WAIT_L(0); MMA(0, 0, At, B0); BAR;
    LDB(B1, 1, 1); WAIT_V(0); BAR; WAIT_L(0); MMA(0, 1, At, B1); BAR;
    LDA(At, 1, 1); BAR; WAIT_L(0); MMA(1, 0, At, B0); MMA(1, 1, At, B1); BAR; }
  if (wr == 0) BAR;
  if (has_next) {
    STAGE(SB(0, 0), Bt, nbcol, 0); STAGE(SA(0, 0), A, nbrow, 0);
    STAGE(SB(0, 1), Bt, nbcol + 128, 0); STAGE(SA(0, 1), A, nbrow + 128, 0);
  }
  epi(acc, wr, wc, fr, fq);
  __syncthreads();
}

DI void map256(int t, int nN, int& tn, int& tm) {
  const int p = (t >> 8) * 8 + (t & 7), i = (t >> 3) & 31, pr = nN >> 2;
  const int pm = p / pr;
  tn = ((p + pm) % pr) * 4 + (i & 3);
  tm = pm * 8 + (i >> 2);
}

DI int condrow(int sb, int tok) { return sb == 0 ? 0 : 1 + (sb - 1) * 8 + (tok >> 11); }

DI void convT(float* tile, const float* src, int lds_, int K, int N, u16* dst, int ldd, const float* ksc, int& base) {
  const int tid = tidx();
  const int ntn = (N + 63) >> 6, nt = (K >> 6) * ntn;
  const int kk = tid >> 4, n4 = (tid & 15) * 4;
  float4 cur[2], nxt[2];
  auto ld = [&](float4 (&v)[2], int t) __attribute__((always_inline)) {
    const int tn = t % ntn, tk = t / ntn, k0 = tk * 64, n0 = tn * 64;
#pragma unroll
    for (int e = 0; e < 2; ++e) {
      v[e] = make_float4(0.f, 0.f, 0.f, 0.f);
      if (n0 + n4 < N) v[e] = *(const float4*)(src + (size_t)(k0 + kk + 32 * e) * lds_ + n0 + n4);
    }
  };
  int t = (int)((blockIdx.x + gridDim.x - ((unsigned)base % gridDim.x)) % gridDim.x);
  if (t < nt) ld(cur, t);
  for (; t < nt; t += gridDim.x) {
    const int tnx = t + (int)gridDim.x;
    if (tnx < nt) ld(nxt, tnx);
    const int tn = t % ntn, tk = t / ntn, k0 = tk * 64, n0 = tn * 64;
#pragma unroll
    for (int e = 0; e < 2; ++e) {
      float4 v = cur[e];
      if (ksc) { const float sc = ksc[k0 + kk + 32 * e]; v.x *= sc; v.y *= sc; v.z *= sc; v.w *= sc; }
      float* tp = tile + (kk + 32 * e) * 65 + n4;
      tp[0] = v.x; tp[1] = v.y; tp[2] = v.z; tp[3] = v.w;
    }
    __syncthreads();
#pragma unroll 4
    for (int e = 0; e < 4; ++e) {
      const int idx = tid + NTH * e, nn = idx >> 5, kp = idx & 31;
      if (n0 + nn < N)
        *(unsigned*)(dst + (size_t)(n0 + nn) * ldd + k0 + 2 * kp) = pack2(tile[(2 * kp) * 65 + nn], tile[(2 * kp + 1) * 65 + nn]);
    }
    __syncthreads();
    cur[0] = nxt[0]; cur[1] = nxt[1];
  }
  base += nt;
}

DI void prologue_a(const Prm& p, unsigned char* smem_raw, int& base) {
  float* smf = (float*)smem_raw;
  const int tid = tidx();
  const int gtid = blockIdx.x * NTH + tid, gn = gridDim.x * NTH;
  for (int l = 0; l < 4; ++l) {
    convT(smf, p.w_in + (size_t)l * 1024 * 7520 + 768, 7520, 1024, 6752, p.WinT + ((size_t)l * NWP + 1536) * 1024, 1024, nullptr, base);
    convT(smf, p.w1 + (size_t)l * 1024 * 4096, 4096, 1024, 4096, p.W1T + (size_t)l * 4096 * 1024, 1024, nullptr, base);
    convT(smf, p.w2 + (size_t)l * 4096 * 1024, 1024, 4096, 1024, p.W2T + (size_t)l * 1024 * 4096, 4096, nullptr, base);
    convT(smf, p.w_o + (size_t)l * 1024 * 1024, 1024, 1024, 1024, p.WoT + (size_t)l * 1024 * 1024, 1024, nullptr, base);
    convT(smf, p.p_a + (size_t)l * 768 * 1024, 1024, 768, 1024, p.PaT + (size_t)l * 1024 * 768, 768, nullptr, base);
    convT(smf, p.p_b + (size_t)l * 128 * 1024, 1024, 128, 1024, p.PbT + (size_t)l * 1024 * 128, 128, nullptr, base);
    convT(smf, p.p_c + (size_t)l * 384 * 1024, 1024, 384, 1024, p.PcT + (size_t)l * 1024 * 384, 384, nullptr, base);
    convT(smf, p.p_d + (size_t)l * 256 * 1024, 1024, 256, 1024, p.PdT + (size_t)l * 1024 * 256, 256, nullptr, base);
    convT(smf, p.w_uq + (size_t)l * 384 * 384, 384, 384, 384, p.WqT + (size_t)l * 384 * 384, 384, p.qn_g + l * 384, base);
    convT(smf, p.w_ukv + (size_t)l * 320 * 512, 512, 320, 512, p.WkvT + (size_t)l * 512 * 320, 320, p.kvn_g + l * 320, base);
  }
  {
    float* tab = (float*)(smem_raw + GEMM_SMEM + 1024);
    if (tid < 192) {
      float sn, cs;
      sincospif(2.f * (float)tid / 192.f, &sn, &cs);
      tab[tid] = cs; tab[192 + tid] = sn;
    }
    __syncthreads();
    u16* smem = (u16*)smem_raw;
    TASK_LOOP(t, 384, base) {
      const int kt = t & 7, rt = (t >> 3) % 3, g = (t / 24) & 3, l = t / 96;
      auto la = [&](int row, int k) __attribute__((always_inline)) {
        const int rr = rt * 128 + row, part = rr >= 192 ? 1 : 0, j = rr - part * 192;
        const float* tp = tab + part * 192;
        const float sg = part ? -1.f : 1.f;
        int m = (j * k) % 192;
        u32x4 o;
#pragma unroll
        for (int jj = 0; jj < 4; ++jj) {
          const float v0 = tp[m] * sg; m += j; if (m >= 192) m -= 192;
          const float v1 = tp[m] * sg; m += j; if (m >= 192) m -= 192;
          o[jj] = pack2(v0, v1);
        }
        return o;
      };
      auto lb = [&](int row, int k) __attribute__((always_inline)) {
        const float* src = p.w_in + ((size_t)l * 1024 + kt * 128 + row) * 7520 + g * 192 + k;
        const float4 a = *(const float4*)src, b = *(const float4*)(src + 4);
        u32x4 o;
        o[0] = pack2(a.x, a.y); o[1] = pack2(a.z, a.w); o[2] = pack2(b.x, b.y); o[3] = pack2(b.z, b.w);
        return o;
      };
      auto epi = [&](f32x16 (&acc)[2], int wm, int wn, int lane) __attribute__((always_inline)) {
        const int lr = lane & 31, lh = lane >> 5;
        const int kcol = kt * 128 + wn * 32 + lr;
#pragma unroll
        for (int i = 0; i < 2; ++i)
#pragma unroll
          for (int r = 0; r < 16; ++r) {
            const int rr = rt * 128 + wm * 64 + i * 32 + rowmap(r, lh), part = rr >= 192 ? 1 : 0, j = rr - part * 192;
            p.WinT[((size_t)l * NWP + part * 768 + g * 192 + j) * 1024 + kcol] = f2bf(acc[i][r]);
          }
      };
      gemm_tile<false, false>(smem, 3, la, lb, epi);
    }
    base += 384;
  }
  {
    float* sil = smf;
    TASK_LOOP(t, 384, base) {
      const int kc = t & 7, cb = (t >> 3) % 12, l = t / 96, k0 = kc * 128;
      for (int idx = tid; idx < 17 * 128; idx += NTH) {
        const int r = idx >> 7, kk = idx & 127;
        const float c = r == 0 ? p.c_prompt[k0 + kk] : p.c_sample[(r - 1) * 1024 + k0 + kk];
        sil[idx] = c / (1.f + __expf(-c));
      }
      __syncthreads();
      const int n = cb * 512 + tid;
      float acc[17];
#pragma unroll
      for (int r = 0; r < 17; ++r) acc[r] = 0.f;
      const float* wp = p.ada_w + ((size_t)l * 1024 + k0) * 6144 + n;
#pragma unroll 1
      for (int kb = 0; kb < 128; kb += 32) {
        float w[32];
#pragma unroll
        for (int i = 0; i < 32; ++i) w[i] = wp[(size_t)(kb + i) * 6144];
#pragma unroll
        for (int i = 0; i < 32; i += 4)
#pragma unroll
          for (int r = 0; r < 17; ++r) {
            const float4 sv = *(const float4*)(sil + r * 128 + kb + i);
            acc[r] += sv.x * w[i] + sv.y * w[i + 1] + sv.z * w[i + 2] + sv.w * w[i + 3];
          }
      }
#pragma unroll
      for (int r = 0; r < 17; ++r) p.modpart[((size_t)(kc * 4 + l) * 17 + r) * 6144 + n] = acc[r];
      __syncthreads();
    }
    base += 384;
  }
  for (int idx = gtid; idx < 4 * 32 * 1024; idx += gn) {
    const int l = idx >> 15, rem = idx & 32767;
    p.WinT[((size_t)l * NWP + NW) * 1024 + rem] = 0;
  }
  for (int idx = gtid; idx < 256 * 256; idx += gn) {
    const int row = idx >> 8, kk = idx & 255;
    const int po = row >> 7, k1 = row & 127, pi = kk >> 7, s1 = kk & 127;
    float s, c;
    sincospif(2.f * (float)((k1 * s1) & 127) / 128.f, &s, &c);
    const float v = (po == pi) ? c : (po == 0 ? s : -s);
    p.M1a[idx] = f2bf(v);
  }
  for (int idx = gtid; idx < 32 * 64; idx += gn) {
    const int row = idx >> 6, kk = idx & 63;
    const int po = row >> 4, k1 = row & 15, pi = (kk >> 4) & 1, s1 = kk & 15;
    float s, c;
    sincospif(2.f * (float)((k1 * s1) & 15) / 16.f, &s, &c);
    float v = (po == pi) ? c : (po == 0 ? s : -s);
    if (kk >= 32) v = 0.f;
    p.M1b[idx] = f2bf(v);
  }
  for (int idx = gtid; idx < 128 * 256; idx += gn) {
    const int k2 = idx >> 8, kk = idx & 255, part = kk >> 7, s2 = kk & 127;
    float s, c;
    sincospif(2.f * (float)((k2 * s2) & 127) / 128.f, &s, &c);
    p.M2[idx] = f2bf(part ? s : c);
  }
  for (int idx = gtid; idx < 16384; idx += gn) {
    float s, c;
    sincospif(2.f * (float)idx / 16384.f, &s, &c);
    p.tw[idx] = make_float2(c, s);
  }
  for (int idx = gtid; idx < 16384 * 16; idx += gn) {
    const int pos = idx >> 4, i = idx & 15;
    const float inv = (float)pow(10000.0, -(double)i / 16.0);
    const float ang = (float)pos * inv;
    double rev = (double)ang * 0.15915494309189535;
    rev -= rint(rev);
    float s, c;
    sincospif((float)(2.0 * rev), &s, &c);
    p.rope[idx] = make_float2(c, s);
  }
  for (int idx = gtid; idx < 6 * 129; idx += gn) {
    const int hd = idx / 129, rel = idx - hd * 129 - 64;
    const int dil = 1 << (2 * (hd >> 1));
    const int rd = rel * dil, n = rd < 0 ? -rd : rd;
    int b;
    if (n < 8) b = n;
    else if (n < 15) b = 8; else if (n < 27) b = 9; else if (n < 50) b = 10; else if (n < 91) b = 11;
    else if (n < 166) b = 12; else if (n < 305) b = 13; else if (n < 559) b = 14; else b = 15;
    if (rd > 0) b += 16;
    p.biasT[idx] = p.rel_bias[b * 6 + hd];
  }
  for (int idx = gtid; idx < 4 * 4 * 128 * 128; idx += gn) p.SgW[idx] = f2bf(p.sgu_w[idx]);
}

DI void prologue_b(const Prm& p) {
  const int gtid = blockIdx.x * NTH + tidx(), gn = gridDim.x * NTH;
  for (int idx = gtid; idx < 4 * 17 * 6144; idx += gn) {
    const int l = idx / (17 * 6144), n = idx % 6144;
    float s = p.ada_b[l * 6144 + n];
#pragma unroll
    for (int kc = 0; kc < 8; ++kc) s += p.modpart[(size_t)kc * 4 * 17 * 6144 + idx];
    p.mod[idx] = s;
  }
}

DI void phase_norm(const Prm& p, const float* xsrc, const float* g, const float* modl, int shoff, int scoff, int sb) {
  const int tid = tidx(), lane = tid & 63;
  const int gw = blockIdx.x * 8 + (tid >> 6), nw = gridDim.x * 8;
  for (int row = gw; row < TB; row += nw) {
    const int cond = condrow(sb, row);
    const float* xr = xsrc + (size_t)row * 1024;
    float4 v[4];
    float ss = 0.f;
#pragma unroll
    for (int i = 0; i < 4; ++i) {
      v[i] = *(const float4*)(xr + i * 256 + lane * 4);
      ss += v[i].x * v[i].x + v[i].y * v[i].y + v[i].z * v[i].z + v[i].w * v[i].w;
    }
#pragma unroll
    for (int off = 32; off >= 1; off >>= 1) ss += __shfl_xor(ss, off);
    const float rstd = rsqrtf(ss * (1.f / 1024.f) + 1e-6f);
    const float* sc = modl + cond * 6144 + scoff;
    const float* sh = modl + cond * 6144 + shoff;
#pragma unroll
    for (int i = 0; i < 4; ++i) {
      const int col = i * 256 + lane * 4;
      const float4 gg = *(const float4*)(g + col), s4 = *(const float4*)(sc + col), h4 = *(const float4*)(sh + col);
      st4bf(p.hbuf + (size_t)row * 1024 + col,
            v[i].x * rstd * gg.x * (1.f + s4.x) + h4.x, v[i].y * rstd * gg.y * (1.f + s4.y) + h4.y,
            v[i].z * rstd * gg.z * (1.f + s4.z) + h4.z, v[i].w * rstd * gg.w * (1.f + s4.w) + h4.w);
    }
  }
}

DI float sigm(float x) { return __builtin_amdgcn_rcpf(1.f + __expf(-x)); }

DI void phase_inproj(const Prm& p, unsigned char* smem_raw, int l, int S, int& base) {
  const u16* W = p.WinT + (size_t)l * NWP * 1024;
  LAS u16* shm = (LAS u16*)smem_raw;
  bool pre = false;
  TASK_LOOP(t, 32 * 64, base) {
    int tn, tm;
    map256(t, 32, tn, tm);
    const int brow = tn * 256, bcol = tm * 256;
    const int tnx = t + (int)gridDim.x;
    const bool has_next = tnx < (32 * 64);
    int tn2 = 0, tm2 = 0;
    if (has_next) map256(tnx, 32, tn2, tm2);
    const int nbrow = tn2 * 256, nbcol = tm2 * 256;
    auto epi = [&](f32x4 (&acc)[2][2][4][2], int wr, int wc, int fr, int fq) __attribute__((always_inline)) {
#pragma unroll
      for (int ai = 0; ai < 2; ++ai)
#pragma unroll
        for (int m = 0; m < 4; ++m) {
          const int nb = brow + ai * 128 + wr * 64 + m * 16;
#pragma unroll
          for (int bj = 0; bj < 2; ++bj)
#pragma unroll
            for (int n = 0; n < 2; ++n) {
              const int tok = bcol + bj * 128 + wc * 32 + n * 16 + fr;
              const f32x4 v = acc[ai][bj][m][n];
              const int nn = nb + fq * 4;
              if (nb < 1536) {
#pragma unroll
                for (int j = 0; j < 4; ++j) p.UT[(size_t)(nn + j) * TBP + tok] = f2bf(v[j]);
              } else if (nb < 2688) {
                st4bf(p.bqkv + (size_t)tok * 1152 + (nn - 1536), v[0], v[1], v[2], v[3]);
              } else if (nb < 3072) {
                st4bf(p.cu + (size_t)tok * 384 + (nn - 2688), v[0], v[1], v[2], v[3]);
              } else if (nb < 3456) {
#pragma unroll
                for (int j = 0; j < 4; ++j) p.cvT[(size_t)(nn - 3072 + j) * TBP + tok] = f2bf(v[j]);
              } else if (nb < 3840) {
                st4bf(p.dcq + (size_t)tok * 384 + (nn - 3456), v[0], v[1], v[2], v[3]);
              } else if (nb < 4160) {
                st4bf(p.dckv + (size_t)tok * 320 + (nn - 3840), v[0], v[1], v[2], v[3]);
              } else if (nb < 4192) {
                if (nb == 4160) {
                  const f32x4 v2 = acc[ai][bj][(m + 1) & 3][n];
                  const int pos = tok & (S - 1);
#pragma unroll
                  for (int j = 0; j < 4; ++j) {
                    const int ii = fq * 4 + j;
                    const float2 cs = p.rope[pos * 16 + ii];
                    const u16 o1 = f2bf(v[j] * cs.x - v2[j] * cs.y), o2 = f2bf(v[j] * cs.y + v2[j] * cs.x);
#pragma unroll
                    for (int hh = 0; hh < 4; ++hh) {
                      p.kc[(size_t)tok * 384 + hh * 96 + 64 + ii] = o1;
                      p.kc[(size_t)tok * 384 + hh * 96 + 80 + ii] = o2;
                    }
                  }
                }
              } else {
                st4bf_nt(p.zg + (size_t)tok * 4096 + (nn - 4192), sigm(v[0]), sigm(v[1]), sigm(v[2]), sigm(v[3]));
              }
            }
          __builtin_amdgcn_sched_barrier(0);
        }
    };
    gemm256(shm, W, p.hbuf, 1024, brow, bcol, pre, has_next, nbrow, nbcol, epi);
    pre = has_next;
  }
  base += 32 * 64;
}

DI void phase_inproj_tail(const Prm& p, unsigned char* smem_raw, int l, int& base) {
  const u16* W = p.WinT + (size_t)l * NWP * 1024;
  u16* smem = (u16*)smem_raw;
  TASK_LOOP(t, 128, base) {
    const int n0 = 8192, m0 = t * 128;
    auto la = [&](int row, int k) __attribute__((always_inline)) { return *(const u32x4*)(W + (size_t)(n0 + row) * 1024 + k); };
    auto lb = [&](int row, int k) __attribute__((always_inline)) { return *(const u32x4*)(p.hbuf + (size_t)(m0 + row) * 1024 + k); };
    auto epi = [&](f32x16 (&acc)[2], int wm, int wn, int lane) __attribute__((always_inline)) {
      const int lr = lane & 31, lh = lane >> 5;
      const int tok = m0 + wn * 32 + lr;
#pragma unroll
      for (int i = 0; i < 2; ++i) {
        const int nb = n0 + wm * 64 + i * 32;
        if (nb >= NW) continue;
#pragma unroll
        for (int q = 0; q < 4; ++q)
          st4bf(p.zg + (size_t)tok * 4096 + (nb - 4192) + 8 * q + 4 * lh, sigm(acc[i][4 * q]), sigm(acc[i][4 * q + 1]), sigm(acc[i][4 * q + 2]),
                sigm(acc[i][4 * q + 3]));
      }
    };
    gemm_tile2s<false, false>(smem, 16, la, lb, epi);
  }
  base += 128;
}


DI void phase_inproj_probe(const Prm& p, unsigned char* smem_raw, int l, int& base) {
  const u16* W = p.WinT + (size_t)l * NWP * 1024;
  LAS u16* shm = (LAS u16*)smem_raw;
  bool pre = false;
  TASK_LOOP(t, 32 * 64, base) {
    int tn, tm;
    map256(t, 32, tn, tm);
    const int brow = tn * 256, bcol = tm * 256;
    const int tnx = t + (int)gridDim.x;
    const bool has_next = tnx < (32 * 64);
    int tn2 = 0, tm2 = 0;
    if (has_next) map256(tnx, 32, tn2, tm2);
    const int nbrow = tn2 * 256, nbcol = tm2 * 256;
    auto epi = [&](f32x4 (&acc)[2][2][4][2], int wr, int wc, int fr, int fq) __attribute__((always_inline)) {
#pragma unroll
      for (int bj = 0; bj < 2; ++bj)
#pragma unroll
        for (int n = 0; n < 2; ++n) {
          const int tok = bcol + bj * 128 + wc * 32 + n * 16 + fr;
#pragma unroll
          for (int ai = 0; ai < 2; ++ai)
#pragma unroll
            for (int m = 0; m < 4; ++m) {
              const int nn = ((brow + ai * 128 + wr * 64 + m * 16) & 1023) + fq * 4;
              const f32x4 v = acc[ai][bj][m][n];
              st4bf(p.Gp + (size_t)tok * 1024 + nn, v[0], v[1], v[2], v[3]);
            }
        }
    };
    gemm256(shm, W, p.hbuf, 1024, brow, bcol, pre, has_next, nbrow, nbcol, epi);
    pre = has_next;
  }
  base += 32 * 64;
}

DI void phase_fft1(const Prm& p, u16* smem, int S, int nseq, int N1, int lgN1, int& base) {
  const int nkt = N1 == 128 ? 2 : 1;
  const u16* M1 = N1 == 128 ? p.M1a : p.M1b;
  const int ldm = N1 == 128 ? 256 : 64;
  const int nk = N1 == 128 ? 4 : 1;
  const int ntask = nseq * 768 * nkt;
  const int twmul = 16384 / S;
  TASK_LOOP(t, ntask, base) {
    const int k1t = t % nkt, col = (t / nkt) % 768, seq = t / (nkt * 768);
    const int k1base = k1t * 64;
    auto la = [&](int row, int k) __attribute__((always_inline)) {
      const int k1 = k1base + (row >> 6) * 32 + (row & 31), ii = (row >> 5) & 1;
      if (k1 >= N1 || k >= 2 * N1) return zero4();
      return *(const u32x4*)(M1 + (ii * N1 + k1) * ldm + k);
    };
    auto lb = [&](int row, int k) __attribute__((always_inline)) {
      if (k >= 2 * N1) return zero4();
      const int part = k >> lgN1, s1 = k & (N1 - 1);
      const u16* src = p.UT + (size_t)(part * 768 + col) * TBP + seq * S + s1 * 128 + row;
      u32x4 v;
#pragma unroll
      for (int jj = 0; jj < 4; ++jj) v[jj] = (unsigned)src[(2 * jj) * 128] | ((unsigned)src[(2 * jj + 1) * 128] << 16);
      return v;
    };
    auto epi = [&](f32x16 (&acc)[2], int wm, int wn, int lane) __attribute__((always_inline)) {
      const int lr = lane & 31, lh = lane >> 5;
      const int s2 = wn * 32 + lr;
#pragma unroll
      for (int r = 0; r < 16; ++r) {
        const int k1 = k1base + wm * 32 + rowmap(r, lh);
        if (k1 < N1) {
          const float re = acc[0][r], im = acc[1][r];
          const float2 cs = p.tw[(s2 * k1) * twmul];
          const size_t o = ((size_t)((seq * N1 + k1) * 2) * 768 + col) * 128 + s2;
          p.Gp[o] = f2bf(cs.x * re + cs.y * im);
          p.Gp[o + 768 * 128] = f2bf(cs.x * im - cs.y * re);
        }
      }
    };
    gemm_tile2s<false, true>(smem, nk, la, lb, epi);
  }
  base += ntask;
}


DI void phase_fft1_small(const Prm& p, int nseq) {
  constexpr float C16[16] = {1.f, 0.92387953251128674f, 0.70710678118654752f, 0.38268343236508977f, 0.f, -0.38268343236508977f, -0.70710678118654752f,
                             -0.92387953251128674f, -1.f, -0.92387953251128674f, -0.70710678118654752f, -0.38268343236508977f, 0.f,
                             0.38268343236508977f, 0.70710678118654752f, 0.92387953251128674f};
  constexpr float S16[16] = {0.f, 0.38268343236508977f, 0.70710678118654752f, 0.92387953251128674f, 1.f, 0.92387953251128674f, 0.70710678118654752f,
                             0.38268343236508977f, 0.f, -0.38268343236508977f, -0.70710678118654752f, -0.92387953251128674f, -1.f,
                             -0.92387953251128674f, -0.70710678118654752f, -0.38268343236508977f};
  const int gtid = blockIdx.x * NTH + tidx(), gn = gridDim.x * NTH;
  for (int idx = gtid; idx < nseq * 768 * 128; idx += gn) {
    const int s2 = idx & 127, col = (idx >> 7) % 768, seq = idx / (768 * 128);
    const u16* ur = p.UT + (size_t)col * TBP + seq * 2048 + s2;
    const u16* ui = ur + (size_t)768 * TBP;
    float xr[16], xi[16];
#pragma unroll
    for (int s1 = 0; s1 < 16; ++s1) { xr[s1] = bf2f(ur[s1 * 128]); xi[s1] = bf2f(ui[s1 * 128]); }
    u16* go = p.Gp + ((size_t)(seq * 16 * 2) * 768 + col) * 128 + s2;
#pragma unroll
    for (int k1 = 0; k1 < 16; ++k1) {
      float gr = 0.f, gi = 0.f;
#pragma unroll
      for (int s1 = 0; s1 < 16; ++s1) {
        const float c = C16[(k1 * s1) & 15], sn = S16[(k1 * s1) & 15];
        gr += c * xr[s1] + sn * xi[s1];
        gi += c * xi[s1] - sn * xr[s1];
      }
      const float2 cs = p.tw[(s2 * k1) * 8];
      go[(size_t)(k1 * 2) * 768 * 128] = f2bf(cs.x * gr + cs.y * gi);
      go[(size_t)(k1 * 2 + 1) * 768 * 128] = f2bf(cs.x * gi - cs.y * gr);
    }
  }
}

DI void phase_fft2(const Prm& p, u16* smem, int S, int nseq, int N1, int& base) {
  const int ntask = nseq * N1 * 6;
  const float scale = rsqrtf((float)S * 192.f);
  u16* fa = p.UT;
  TASK_LOOP(t, ntask, base) {
    const int ct = t % 6, k1 = (t / 6) % N1, seq = t / (6 * N1);
    const u16* gb = p.Gp + ((size_t)((seq * N1 + k1) * 2) * 768 + ct * 128) * 128;
    auto la = [&](int row, int k) __attribute__((always_inline)) { return *(const u32x4*)(p.M2 + row * 256 + k); };
    auto lb = [&](int row, int k) __attribute__((always_inline)) {
      const int part = k >> 7, s2 = k & 127;
      return *(const u32x4*)(gb + ((size_t)part * 768 + row) * 128 + s2);
    };
    auto epi = [&](f32x16 (&acc)[2], int wm, int wn, int lane) __attribute__((always_inline)) {
      const int lr = lane & 31, lh = lane >> 5;
      const int col = ct * 128 + wn * 32 + lr;
#pragma unroll
      for (int i = 0; i < 2; ++i)
#pragma unroll
        for (int r = 0; r < 16; ++r) {
          const int k2 = wm * 64 + i * 32 + rowmap(r, lh);
          const int tok = seq * S + k1 + N1 * k2;
          fa[(size_t)tok * 768 + col] = f2bf(acc[i][r] * scale);
        }
    };
    gemm_tile2s<false, false>(smem, 4, la, lb, epi);
  }
  base += ntask;
}

DI void phase_mixc(const Prm& p, unsigned char* smem_raw, int l, int& base) {
  u16* smem = (u16*)smem_raw;
  float* st = (float*)(smem_raw + GEMM_SMEM);
  float* red = (float*)smem_raw;
  const int tid = tidx();
  TASK_LOOP(t, 512, base) {
    const int h = t & 3, ch = t >> 2, tok0 = ch * 128;
    {
      const int q = tid & 127, qf = tid >> 7;
      float s = 0.f, ss = 0.f;
      const u16* src = p.cvT + (size_t)(qf * 96) * TBP + tok0 + q;
      for (int c = 0; c < 96; ++c) { const float v = bf2f(src[(size_t)c * TBP]); s += v; ss += v * v; }
      red[qf * 256 + q * 2] = s; red[qf * 256 + q * 2 + 1] = ss;
      __syncthreads();
      if (tid < 128) {
        const float s1 = red[q * 2] + red[256 + q * 2] + red[512 + q * 2] + red[768 + q * 2];
        const float s2 = red[q * 2 + 1] + red[256 + q * 2 + 1] + red[512 + q * 2 + 1] + red[768 + q * 2 + 1];
        const float mu = s1 * (1.f / 384.f);
        const float var = fmaxf(s2 * (1.f / 384.f) - mu * mu, 0.f);
        st[q] = mu; st[128 + q] = rsqrtf(var + 1e-6f);
      }
      __syncthreads();
    }
    const u16* Wm = p.SgW + (size_t)((l * 4 + h) * 128) * 128;
    auto la = [&](int row, int k) __attribute__((always_inline)) { return *(const u32x4*)(Wm + row * 128 + k); };
    auto lb = [&](int row, int k) __attribute__((always_inline)) {
      if (row >= 96) return zero4();
      const int c = h * 96 + row;
      const u32x4 raw = *(const u32x4*)(p.cvT + (size_t)c * TBP + tok0 + k);
      const float g = p.ln_g[l * 384 + c], b = p.ln_b[l * 384 + c];
      u32x4 o;
#pragma unroll
      for (int jj = 0; jj < 4; ++jj) {
        const float v0 = (bflo(raw[jj]) - st[k + 2 * jj]) * st[128 + k + 2 * jj] * g + b;
        const float v1 = (bfhi(raw[jj]) - st[k + 2 * jj + 1]) * st[128 + k + 2 * jj + 1] * g + b;
        o[jj] = pack2(v0, v1);
      }
      return o;
    };
    auto epi = [&](f32x16 (&acc)[2], int wm, int wn, int lane) __attribute__((always_inline)) {
      const int lr = lane & 31, lh = lane >> 5;
      const int cl = wn * 32 + lr;
      if (cl < 96) {
#pragma unroll
        for (int i = 0; i < 2; ++i)
#pragma unroll
          for (int r = 0; r < 16; ++r) {
            const int pp = wm * 64 + i * 32 + rowmap(r, lh);
            const float val = acc[i][r] + p.sgu_b[(l * 4 + h) * 128 + pp];
            u16* dst = p.cu + (size_t)(tok0 + pp) * 384 + h * 96 + cl;
            *dst = f2bf(bf2f(*dst) * val);
          }
      }
    };
    gemm_tile<false, false>(smem, 2, la, lb, epi);
  }
  base += 512;
}

DI void phase_qup(const Prm& p, unsigned char* smem_raw, int l, int S, int& base) {
  u16* smem = (u16*)smem_raw;
  float* st = (float*)(smem_raw + GEMM_SMEM);
  const int tid = tidx();
  const float QS = 0.10206207261596577f * LOG2E;
  TASK_LOOP(t, 3 * 128, base) {
    const int tn = t % 3, tm = t / 3, n0 = tn * 128, m0 = tm * 128;
    {
      const int row = tid >> 2, qf = tid & 3;
      const u16* src = p.dcq + (size_t)(m0 + row) * 384 + qf * 96;
      float ss = 0.f;
#pragma unroll 4
      for (int c = 0; c < 12; ++c) {
        const u32x4 v = *(const u32x4*)(src + c * 8);
#pragma unroll
        for (int jj = 0; jj < 4; ++jj) { const float a = bflo(v[jj]), b = bfhi(v[jj]); ss += a * a + b * b; }
      }
      ss += __shfl_xor(ss, 1);
      ss += __shfl_xor(ss, 2);
      if (qf == 0) st[row] = rsqrtf(ss * (1.f / 384.f) + 1e-6f);
      __syncthreads();
    }
    const u16* W = p.WqT + (size_t)l * 384 * 384;
    auto la = [&](int row, int k) __attribute__((always_inline)) { return *(const u32x4*)(W + (size_t)(n0 + row) * 384 + k); };
    auto lb = [&](int row, int k) __attribute__((always_inline)) { return *(const u32x4*)(p.dcq + (size_t)(m0 + row) * 384 + k); };
    auto epi = [&](f32x16 (&acc)[2], int wm, int wn, int lane) __attribute__((always_inline)) {
      const int lr = lane & 31, lh = lane >> 5;
      const int tokl = wn * 32 + lr, tok = m0 + tokl;
      const float sc = st[tokl] * QS;
#pragma unroll
      for (int i = 0; i < 2; ++i) {
        const int nb = n0 + wm * 64 + i * 32;
        const int head = nb / 96, within = nb - head * 96;
        const f32x16& a = acc[i];
        if (within < 64) {
#pragma unroll
          for (int q = 0; q < 4; ++q)
            st4bf(p.qc + (size_t)tok * 384 + nb + 8 * q + 4 * lh, a[4 * q] * sc, a[4 * q + 1] * sc, a[4 * q + 2] * sc, a[4 * q + 3] * sc);
        } else {
          const int pos = tok & (S - 1);
#pragma unroll
          for (int q = 0; q < 2; ++q)
#pragma unroll
            for (int e = 0; e < 4; ++e) {
              const int r = 4 * q + e, ii = 8 * q + 4 * lh + e;
              const float2 cs = p.rope[pos * 16 + ii];
              const float x1 = a[r] * sc, x2 = a[r + 8] * sc;
              p.qc[(size_t)tok * 384 + head * 96 + 64 + ii] = f2bf(x1 * cs.x - x2 * cs.y);
              p.qc[(size_t)tok * 384 + head * 96 + 80 + ii] = f2bf(x1 * cs.y + x2 * cs.x);
            }
        }
      }
    };
    gemm_tile2s<false, false>(smem, 6, la, lb, epi);
    __syncthreads();
  }
  base += 3 * 128;
}

DI void phase_kvup(const Prm& p, unsigned char* smem_raw, int l, int& base) {
  u16* smem = (u16*)smem_raw;
  float* st = (float*)(smem_raw + GEMM_SMEM);
  const int tid = tidx();
  TASK_LOOP(t, 4 * 128, base) {
    const int tn = t & 3, tm = t >> 2, n0 = tn * 128, m0 = tm * 128;
    {
      const int row = tid >> 2, qf = tid & 3;
      const u16* src = p.dckv + (size_t)(m0 + row) * 320 + qf * 80;
      float ss = 0.f;
#pragma unroll 5
      for (int c = 0; c < 10; ++c) {
        const u32x4 v = *(const u32x4*)(src + c * 8);
#pragma unroll
        for (int jj = 0; jj < 4; ++jj) { const float a = bflo(v[jj]), b = bfhi(v[jj]); ss += a * a + b * b; }
      }
      ss += __shfl_xor(ss, 1);
      ss += __shfl_xor(ss, 2);
      if (qf == 0) st[row] = rsqrtf(ss * (1.f / 320.f) + 1e-6f);
      __syncthreads();
    }
    const u16* W = p.WkvT + (size_t)l * 512 * 320;
    auto la = [&](int row, int k) __attribute__((always_inline)) { return *(const u32x4*)(W + (size_t)(n0 + row) * 320 + k); };
    auto lb = [&](int row, int k) __attribute__((always_inline)) { return *(const u32x4*)(p.dckv + (size_t)(m0 + row) * 320 + k); };
    auto epi = [&](f32x16 (&acc)[2], int wm, int wn, int lane) __attribute__((always_inline)) {
      const int lr = lane & 31, lh = lane >> 5;
      const int head = tn;
      const int tokl = wn * 32 + lr, tok = m0 + tokl;
      const float sc = st[tokl];
#pragma unroll
      for (int i = 0; i < 2; ++i) {
        const int within = wm * 64 + i * 32;
        const f32x16& a = acc[i];
        if (within < 64) {
#pragma unroll
          for (int q = 0; q < 4; ++q)
            st4bf(p.kc + (size_t)tok * 384 + head * 96 + within + 8 * q + 4 * lh, a[4 * q] * sc, a[4 * q + 1] * sc, a[4 * q + 2] * sc, a[4 * q + 3] * sc);
        } else {
#pragma unroll
          for (int r = 0; r < 16; ++r)
            p.vT[(size_t)(head * 64 + within - 64 + rowmap(r, lh)) * TBP + tok] = f2bf(a[r] * sc);
        }
      }
    };
    gemm_tile2s<false, false>(smem, 5, la, lb, epi);
    __syncthreads();
  }
  base += 4 * 128;
}

DI void phase_mixb(const Prm& p, unsigned char* smem_raw, int S, int lgS, int& base) {
  float* bt = (float*)smem_raw;
  const int tid = tidx(), lane = tid & 63, wave = tid >> 6, lr = lane & 31, lh = lane >> 5;
  u16* vt = (u16*)(smem_raw + 3328) + wave * (64 * 40);
  for (int idx = tid; idx < 774; idx += NTH) bt[idx] = p.biasT[idx];
  __syncthreads();
  TASK_LOOP(t, 384, base) {
    const int wt = t * 8 + wave;
    const int hg = wt & 1, g = (wt >> 1) % 3, blk = wt / 6;
    const int seq = blk >> (lgS - 5), b_in = blk & ((S >> 5) - 1);
    const int lgd = 2 * g, L = S >> lgd;
    const int lgbpr = lgS - lgd - 5;
    const int res = b_in >> lgbpr, i0 = (b_in & ((1 << lgbpr) - 1)) << 5;
    const int tokbase = seq * S + res;
    const int hd = g * 2 + hg, hc = hd * 64;
    const int qi = i0 + lr;
    const int qtok = tokbase + (qi << lgd);
    bf16x8 qf[4];
#pragma unroll
    for (int ks = 0; ks < 4; ++ks) qf[ks] = *(const bf16x8*)(p.bqkv + (size_t)qtok * 1152 + hc + ks * 16 + lh * 8);
    f32x16 sc[5];
#pragma unroll
    for (int tt = 0; tt < 5; ++tt) {
      int ik = i0 - 64 + 32 * tt + lr;
      ik = min(max(ik, 0), L - 1);
      const u16* kp = p.bqkv + (size_t)(tokbase + (ik << lgd)) * 1152 + 384 + hc + lh * 8;
      sc[tt] = zero16();
#pragma unroll
      for (int ks = 0; ks < 4; ++ks) sc[tt] = mfma(*(const bf16x8*)(kp + ks * 16), qf[ks], sc[tt]);
    }
    float mx = -1e30f;
#pragma unroll
    for (int tt = 0; tt < 5; ++tt)
#pragma unroll
      for (int r = 0; r < 16; ++r) {
        const int ik = i0 - 64 + 32 * tt + rowmap(r, lh);
        const int rel = ik - qi;
        const bool valid = (rel >= -64) && (rel <= 64) && (ik >= 0) && (ik < L);
        const int bi = min(max(rel + 64, 0), 128);
        const float s = valid ? (sc[tt][r] * 0.125f + bt[hd * 129 + bi]) * LOG2E : -1e30f;
        sc[tt][r] = s;
        mx = fmaxf(mx, s);
      }
    mx = fmaxf(mx, __shfl_xor(mx, 32));
    float sum = 0.f;
#pragma unroll
    for (int tt = 0; tt < 5; ++tt)
#pragma unroll
      for (int r = 0; r < 16; ++r) {
        const float pv = ex2(sc[tt][r] - mx);
        sum += pv;
        sc[tt][r] = pv;
      }
    sum += __shfl_xor(sum, 32);
    f32x16 oacc[2];
    oacc[0] = zero16(); oacc[1] = zero16();
#pragma unroll
    for (int tt = 0; tt < 5; ++tt) {
#pragma unroll
      for (int e = 0; e < 4; ++e) {
        const int c = lane + 64 * e, key = c >> 3, dch = c & 7;
        int ik = i0 - 64 + 32 * tt + key;
        ik = min(max(ik, 0), L - 1);
        const u32x4 raw = *(const u32x4*)(p.bqkv + (size_t)(tokbase + (ik << lgd)) * 1152 + 768 + hc + dch * 8);
#pragma unroll
        for (int jj = 0; jj < 4; ++jj) {
          vt[(dch * 8 + 2 * jj) * 40 + key] = (u16)(raw[jj] & 0xffffu);
          vt[(dch * 8 + 2 * jj + 1) * 40 + key] = (u16)(raw[jj] >> 16);
        }
      }
      __syncthreads();
#pragma unroll
      for (int u = 0; u < 2; ++u) {
        u32x4 pk;
#pragma unroll
        for (int jj = 0; jj < 4; ++jj) pk[jj] = pack2(sc[tt][8 * u + 2 * jj], sc[tt][8 * u + 2 * jj + 1]);
        const bf16x8 pf = __builtin_bit_cast(bf16x8, pk);
#pragma unroll
        for (int dt = 0; dt < 2; ++dt) {
          const u16* vp = vt + (dt * 32 + lr) * 40 + 16 * u + 4 * lh;
          u32x4 vv;
          const u32x2 lo = *(const u32x2*)vp, hi = *(const u32x2*)(vp + 8);
          vv[0] = lo[0]; vv[1] = lo[1]; vv[2] = hi[0]; vv[3] = hi[1];
          oacc[dt] = mfma(__builtin_bit_cast(bf16x8, vv), pf, oacc[dt]);
        }
      }
      __syncthreads();
    }
    const float inv = 1.f / sum;
#pragma unroll
    for (int dt = 0; dt < 2; ++dt)
#pragma unroll
      for (int q = 0; q < 4; ++q) {
        float4 o;
        o.x = oacc[dt][4 * q] * inv; o.y = oacc[dt][4 * q + 1] * inv; o.z = oacc[dt][4 * q + 2] * inv; o.w = oacc[dt][4 * q + 3] * inv;
        *(float4*)(p.og + (size_t)qtok * 384 + hc + dt * 32 + 8 * q + 4 * lh) = o;
      }
    if (lh == 0) p.lse[(size_t)qtok * 6 + hd] = (mx + __log2f(sum)) * LN2;
  }
  base += 384;
  __syncthreads();
}

DI void phase_combb(const Prm& p) {
  const int gtid = blockIdx.x * NTH + tidx(), gn = gridDim.x * NTH;
  for (int idx = gtid; idx < TB * 32; idx += gn) {
    const int dq = idx & 15, hg = (idx >> 4) & 1, tok = idx >> 5;
    const float l0 = p.lse[(size_t)tok * 6 + hg], l1 = p.lse[(size_t)tok * 6 + 2 + hg], l2 = p.lse[(size_t)tok * 6 + 4 + hg];
    const float mx = fmaxf(l0, fmaxf(l1, l2));
    const float e0 = __expf(l0 - mx), e1 = __expf(l1 - mx), e2 = __expf(l2 - mx);
    const float inv = 1.f / (e0 + e1 + e2);
    const float4 a = *(const float4*)(p.og + (size_t)tok * 384 + hg * 64 + dq * 4);
    const float4 b = *(const float4*)(p.og + (size_t)tok * 384 + 128 + hg * 64 + dq * 4);
    const float4 c = *(const float4*)(p.og + (size_t)tok * 384 + 256 + hg * 64 + dq * 4);
    st4bf(p.ob + (size_t)tok * 128 + hg * 64 + dq * 4, (e0 * a.x + e1 * b.x + e2 * c.x) * inv, (e0 * a.y + e1 * b.y + e2 * c.y) * inv,
          (e0 * a.z + e1 * b.z + e2 * c.z) * inv, (e0 * a.w + e1 * b.w + e2 * c.w) * inv);
  }
}

constexpr int KS_ELEMS = 128 * 104, VS_ELEMS = 64 * 136;
DI void phase_mla(const Prm& p, unsigned char* smem_raw, int S, int lgS, int& base) {
  u16* Ks = (u16*)smem_raw;
  u16* Vs = Ks + 2 * KS_ELEMS;
  const int tid = tidx(), lane = tid & 63, wave = tid >> 6, lr = lane & 31, lh = lane >> 5;
  const int nkt = S >> 7;
  TASK_LOOP(t, 256, base) {
    const int head = t & 3, qb = t >> 2, tok0 = qb * 256;
    const int seqtok0 = (tok0 >> lgS) << lgS;
    const int qtok = tok0 + wave * 32 + lr;
    bf16x8 qf[6];
#pragma unroll
    for (int ks = 0; ks < 6; ++ks) qf[ks] = *(const bf16x8*)(p.qc + (size_t)qtok * 384 + head * 96 + ks * 16 + lh * 8);
    const u16* kbase = p.kc + (size_t)seqtok0 * 384 + head * 96;
    const u16* vbase = p.vT + (size_t)(head * 64) * TBP + seqtok0;
    u32x4 rk[3], rv[2];
    auto gload = [&](int kt) __attribute__((always_inline)) {
#pragma unroll
      for (int e = 0; e < 3; ++e) {
        const int c = tid + NTH * e, key = c / 12, dc = c - key * 12;
        rk[e] = *(const u32x4*)(kbase + (size_t)(kt * 128 + key) * 384 + dc * 8);
      }
#pragma unroll
      for (int e = 0; e < 2; ++e) {
        const int c = tid + NTH * e, d = c >> 4, kch = c & 15;
        rv[e] = *(const u32x4*)(vbase + (size_t)d * TBP + kt * 128 + kch * 8);
      }
    };
    auto sstore = [&](int buf) __attribute__((always_inline)) {
#pragma unroll
      for (int e = 0; e < 3; ++e) {
        const int c = tid + NTH * e, key = c / 12, dc = c - key * 12;
        *(u32x4*)(Ks + buf * KS_ELEMS + key * 104 + dc * 8) = rk[e];
      }
#pragma unroll
      for (int e = 0; e < 2; ++e) {
        const int c = tid + NTH * e, d = c >> 4, kch = c & 15;
        u16* vd = Vs + buf * VS_ELEMS + d * 136 + (kch >> 1) * 16 + (kch & 1) * 4;
        u32x2 lo, hi;
        lo[0] = rv[e][0]; lo[1] = rv[e][1]; hi[0] = rv[e][2]; hi[1] = rv[e][3];
        *(u32x2*)vd = lo;
        *(u32x2*)(vd + 8) = hi;
      }
    };
    float m = -1e30f;
    f32x2 lsum2 = {0.f, 0.f};
    f32x16 oacc[2];
    oacc[0] = zero16(); oacc[1] = zero16();
    gload(0);
    sstore(0);
    __syncthreads();
    for (int kt = 0; kt < nkt; ++kt) {
      const int buf = kt & 1;
      if (kt + 1 < nkt) gload(kt + 1);
      f32x16 s[4];
#pragma unroll
      for (int kk = 0; kk < 4; ++kk) s[kk] = zero16();
      {
        const u16* kp = Ks + buf * KS_ELEMS + lr * 104 + lh * 8;
        bf16x8 kf[4];
#pragma unroll
        for (int kk = 0; kk < 4; ++kk) kf[kk] = *(const bf16x8*)(kp + kk * 32 * 104);
#pragma unroll
        for (int ks = 0; ks < 6; ++ks) {
          bf16x8 kn[4];
          if (ks < 5) {
#pragma unroll
            for (int kk = 0; kk < 4; ++kk) kn[kk] = *(const bf16x8*)(kp + kk * 32 * 104 + (ks + 1) * 16);
          }
#pragma unroll
          for (int kk = 0; kk < 4; ++kk) s[kk] = mfma(kf[kk], qf[ks], s[kk]);
          if (ks < 5) {
#pragma unroll
            for (int kk = 0; kk < 4; ++kk) kf[kk] = kn[kk];
          }
        }
      }
      float mloc = -1e30f;
#pragma unroll
      for (int kk = 0; kk < 4; ++kk)
#pragma unroll
        for (int r = 0; r < 16; ++r) mloc = fmaxf(mloc, s[kk][r]);
      mloc = fmaxf(mloc, __shfl_xor(mloc, 32));
      const float mnew = fmaxf(m, mloc);
      const float alpha = ex2(m - mnew);
      m = mnew;
      lsum2 *= alpha;
      const f32x2 mn2 = {mnew, mnew};
#pragma unroll
      for (int kk = 0; kk < 4; ++kk)
#pragma unroll
        for (int r2 = 0; r2 < 8; ++r2) {
          f32x2 v = {s[kk][2 * r2], s[kk][2 * r2 + 1]};
          v = v - mn2;
          f32x2 pv;
          pv[0] = ex2(v[0]); pv[1] = ex2(v[1]);
          lsum2 += pv;
          s[kk][2 * r2] = pv[0]; s[kk][2 * r2 + 1] = pv[1];
        }
#pragma unroll
      for (int dt = 0; dt < 2; ++dt)
#pragma unroll
        for (int r = 0; r < 16; ++r) oacc[dt][r] *= alpha;
#pragma unroll
      for (int kk = 0; kk < 4; ++kk)
#pragma unroll
        for (int u = 0; u < 2; ++u) {
          u32x4 pk;
#pragma unroll
          for (int jj = 0; jj < 4; ++jj) pk[jj] = pack2(s[kk][8 * u + 2 * jj], s[kk][8 * u + 2 * jj + 1]);
          const bf16x8 pf = __builtin_bit_cast(bf16x8, pk);
#pragma unroll
          for (int dt = 0; dt < 2; ++dt) {
            const u16* vp = Vs + buf * VS_ELEMS + (dt * 32 + lr) * 136 + kk * 32 + 16 * u + 8 * lh;
            oacc[dt] = mfma(*(const bf16x8*)vp, pf, oacc[dt]);
          }
        }
      if (kt + 1 < nkt) sstore(buf ^ 1);
      __syncthreads();
    }
    float lsum = lsum2[0] + lsum2[1];
    lsum += __shfl_xor(lsum, 32);
    const float inv = 1.f / lsum;
#pragma unroll
    for (int dt = 0; dt < 2; ++dt)
#pragma unroll
      for (int q = 0; q < 4; ++q)
        st4bf(p.od + (size_t)qtok * 256 + head * 64 + dt * 32 + 8 * q + 4 * lh, oacc[dt][4 * q] * inv, oacc[dt][4 * q + 1] * inv,
              oacc[dt][4 * q + 2] * inv, oacc[dt][4 * q + 3] * inv);
  }
  base += 256;
}

template <class ACC>
DI void merge_branch(const Prm& p, u16* smem, const u16* W, const u16* X, int ld, int bi, int n0, int m0, ACC& macc) {
  auto la = [&](int row, int k) __attribute__((always_inline)) { return *(const u32x4*)(W + (size_t)(n0 + row) * ld + k); };
  auto lb = [&](int row, int k) __attribute__((always_inline)) { return *(const u32x4*)(X + (size_t)(m0 + row) * ld + k); };
  auto epi = [&](f32x16 (&acc)[2], int wm, int wn, int lane) __attribute__((always_inline)) {
    const int lr = lane & 31, lh = lane >> 5;
    const int tok = m0 + wn * 32 + lr;
#pragma unroll
    for (int i = 0; i < 2; ++i)
#pragma unroll
      for (int q = 0; q < 4; ++q) {
        const int n = n0 + wm * 64 + i * 32 + 8 * q + 4 * lh;
        const u32x2 gz = *(const u32x2*)(p.zg + (size_t)tok * 4096 + bi * 1024 + n);
        macc[i][4 * q] += bflo(gz[0]) * acc[i][4 * q];
        macc[i][4 * q + 1] += bfhi(gz[0]) * acc[i][4 * q + 1];
        macc[i][4 * q + 2] += bflo(gz[1]) * acc[i][4 * q + 2];
        macc[i][4 * q + 3] += bfhi(gz[1]) * acc[i][4 * q + 3];
      }
  };
  gemm_tile2s<false, false>(smem, ld >> 6, la, lb, epi);
}

DI void phase_merge(const Prm& p, u16* smem, int l, int& base) {
  TASK_LOOP(t, 8 * 128, base) {
    const int tn = t & 7, tm = t >> 3, n0 = tn * 128, m0 = tm * 128;
    f32x16 macc[2];
    macc[0] = zero16(); macc[1] = zero16();
    merge_branch(p, smem, p.PaT + (size_t)l * 1024 * 768, p.UT, 768, 0, n0, m0, macc);
    merge_branch(p, smem, p.PbT + (size_t)l * 1024 * 128, p.ob, 128, 1, n0, m0, macc);
    merge_branch(p, smem, p.PcT + (size_t)l * 1024 * 384, p.cu, 384, 2, n0, m0, macc);
    merge_branch(p, smem, p.PdT + (size_t)l * 1024 * 256, p.od, 256, 3, n0, m0, macc);
    const int tid2 = tidx(), lane = tid2 & 63, wave = tid2 >> 6, wm = wave >> 2, wn = wave & 3, lr = lane & 31, lh = lane >> 5;
    const int tok = m0 + wn * 32 + lr;
#pragma unroll
    for (int i = 0; i < 2; ++i)
#pragma unroll
      for (int q = 0; q < 4; ++q)
        st4bf(p.hbuf + (size_t)tok * 1024 + n0 + wm * 64 + i * 32 + 8 * q + 4 * lh, macc[i][4 * q], macc[i][4 * q + 1],
              macc[i][4 * q + 2], macc[i][4 * q + 3]);
  }
  base += 8 * 128;
}

DI void phase_resid_gemm(const Prm& p, unsigned char* smem_raw, const u16* W, const u16* X, int K, const float* xsrc, float* xdst,
                         const float* modl, int gtoff, int sb, int& base) {
  LAS u16* shm = (LAS u16*)smem_raw;
  bool pre = false;
  TASK_LOOP(t, 4 * 64, base) {
    int tn, tm;
    map256(t, 4, tn, tm);
    const int brow = tn * 256, bcol = tm * 256;
    const int tnx = t + (int)gridDim.x;
    const bool has_next = tnx < (4 * 64);
    int tn2 = 0, tm2 = 0;
    if (has_next) map256(tnx, 4, tn2, tm2);
    const int nbrow = tn2 * 256, nbcol = tm2 * 256;
    auto epi = [&](f32x4 (&acc)[2][2][4][2], int wr, int wc, int fr, int fq) __attribute__((always_inline)) {
#pragma unroll
      for (int bj = 0; bj < 2; ++bj)
#pragma unroll
        for (int n = 0; n < 2; ++n) {
          const int tok = bcol + bj * 128 + wc * 32 + n * 16 + fr;
          const float* gt = modl + condrow(sb, tok) * 6144 + gtoff;
#pragma unroll
          for (int ai = 0; ai < 2; ++ai)
#pragma unroll
            for (int m = 0; m < 4; ++m) {
              const int nn = brow + ai * 128 + wr * 64 + m * 16 + fq * 4;
              const f32x4 v = acc[ai][bj][m][n];
              const float4 g4 = *(const float4*)(gt + nn);
              const float4 xi = *(const float4*)(xsrc + (size_t)tok * 1024 + nn);
              float4 o;
              o.x = xi.x + g4.x * v[0]; o.y = xi.y + g4.y * v[1]; o.z = xi.z + g4.z * v[2]; o.w = xi.w + g4.w * v[3];
              *(float4*)(xdst + (size_t)tok * 1024 + nn) = o;
            }
        }
    };
    gemm256(shm, W, X, K, brow, bcol, pre, has_next, nbrow, nbcol, epi);
    pre = has_next;
  }
  base += 4 * 64;
}

DI void phase_w1(const Prm& p, unsigned char* smem_raw, int l, int& base) {
  const u16* W = p.W1T + (size_t)l * 4096 * 1024;
  LAS u16* shm = (LAS u16*)smem_raw;
  bool pre = false;
  TASK_LOOP(t, 16 * 64, base) {
    int tn, tm;
    map256(t, 16, tn, tm);
    const int brow = tn * 256, bcol = tm * 256;
    const int tnx = t + (int)gridDim.x;
    const bool has_next = tnx < (16 * 64);
    int tn2 = 0, tm2 = 0;
    if (has_next) map256(tnx, 16, tn2, tm2);
    const int nbrow = tn2 * 256, nbcol = tm2 * 256;
    auto epi = [&](f32x4 (&acc)[2][2][4][2], int wr, int wc, int fr, int fq) __attribute__((always_inline)) {
#pragma unroll
      for (int bj = 0; bj < 2; ++bj)
#pragma unroll
        for (int n = 0; n < 2; ++n) {
          const int tok = bcol + bj * 128 + wc * 32 + n * 16 + fr;
#pragma unroll
          for (int ai = 0; ai < 2; ++ai)
#pragma unroll
            for (int m = 0; m < 4; ++m) {
              const int nn = brow + ai * 128 + wr * 64 + m * 16 + fq * 4;
              const f32x4 v = acc[ai][bj][m][n];
              const float a0 = fmaxf(v[0], 0.f), a1 = fmaxf(v[1], 0.f), a2 = fmaxf(v[2], 0.f), a3 = fmaxf(v[3], 0.f);
              st4bf(p.zg + (size_t)tok * 4096 + nn, a0 * a0, a1 * a1, a2 * a2, a3 * a3);
            }
        }
    };
    gemm256(shm, W, p.hbuf, 1024, brow, bcol, pre, has_next, nbrow, nbcol, epi);
    pre = has_next;
  }
  base += 16 * 64;
}

DI void phase_final(const Prm& p) {
  const int tid = tidx(), lane = tid & 63;
  const int gw = blockIdx.x * 8 + (tid >> 6), nw = gridDim.x * 8;
  for (int row = gw; row < 3 * TB; row += nw) {
    float* xr = p.out + (size_t)row * 1024;
    float4 v[4];
    float ss = 0.f;
#pragma unroll
    for (int i = 0; i < 4; ++i) {
      v[i] = *(const float4*)(xr + i * 256 + lane * 4);
      ss += v[i].x * v[i].x + v[i].y * v[i].y + v[i].z * v[i].z + v[i].w * v[i].w;
    }
#pragma unroll
    for (int off = 32; off >= 1; off >>= 1) ss += __shfl_xor(ss, off);
    const float rstd = rsqrtf(ss * (1.f / 1024.f) + 1e-6f);
#pragma unroll
    for (int i = 0; i < 4; ++i) {
      const int col = i * 256 + lane * 4;
      const float4 gg = *(const float4*)(p.final_g + col);
      float4 o;
      o.x = v[i].x * rstd * gg.x; o.y = v[i].y * rstd * gg.y; o.z = v[i].z * rstd * gg.z; o.w = v[i].w * rstd * gg.w;
      *(float4*)(xr + col) = o;
    }
  }
}

__global__ void __launch_bounds__(512) mega(Prm p) {
  cg::grid_group grid = cg::this_grid();
  __shared__ __attribute__((aligned(16))) unsigned char smem_raw[SMEM_BYTES];
  __shared__ uint4 xb_words;
  u16* smem = (u16*)smem_raw;
  if (threadIdx.x == 0) xb_words = make_uint4(0u, 0u, 0u, 0u);
  __syncthreads();
  const XcdBarrier xb = xcd_barrier_post(p.bar, (volatile LAS unsigned*)&xb_words);
  int base = 0;
  prologue_a(p, smem_raw, base);
  if (PROBE == 11) prologue_a(p, smem_raw, base);
  grid.sync();
  prologue_b(p);
  xcd_barrier(xb);
  for (int sb = 0; sb < 3; ++sb) {
    const int S = sb == 0 ? 16384 : 2048, lgS = sb == 0 ? 14 : 11, nseq = sb == 0 ? 1 : 8;
    const int N1 = S >> 7, lgN1 = lgS - 7;
    const float* xin = sb == 0 ? p.x_prompt : p.x_sample + (size_t)(sb - 1) * TB * 1024;
    float* xo = p.out + (size_t)sb * TB * 1024;
    for (int l = 0; l < 4; ++l) {
      const float* xs = l == 0 ? xin : xo;
      const float* modl = p.mod + (size_t)l * 17 * 6144;
      phase_norm(p, xs, p.norm1_g + l * 1024, modl, 0, 1024, sb);
      xcd_barrier(xb);
      phase_inproj(p, smem_raw, l, S, base);
      if (PROBE == 2 || PROBE == 7) phase_inproj(p, smem_raw, l, S, base);
      if (PROBE == 12) phase_inproj_probe(p, smem_raw, l, base);
      xcd_barrier(xb);
      if (PROBE == 5) xcd_barrier(xb);
      if (N1 == 16) phase_fft1_small(p, nseq); else phase_fft1(p, smem, S, nseq, N1, lgN1, base);
      phase_mixb(p, smem_raw, S, lgS, base);
      phase_mixc(p, smem_raw, l, base);
      phase_qup(p, smem_raw, l, S, base);
      phase_kvup(p, smem_raw, l, base);
      phase_inproj_tail(p, smem_raw, l, base);
      if (PROBE == 13) phase_fft1(p, smem, S, nseq, N1, lgN1, base);
      if (PROBE == 14) phase_mixb(p, smem_raw, S, lgS, base);
      if (PROBE == 15) { phase_qup(p, smem_raw, l, S, base); phase_kvup(p, smem_raw, l, base); phase_inproj_tail(p, smem_raw, l, base); }
      if (PROBE == 4) { phase_fft1(p, smem, S, nseq, N1, lgN1, base); phase_mixb(p, smem_raw, S, lgS, base); phase_qup(p, smem_raw, l, S, base); phase_kvup(p, smem_raw, l, base); }
      xcd_barrier(xb);
      if (PROBE == 5) xcd_barrier(xb);
      phase_mla(p, smem_raw, S, lgS, base);
      if (PROBE == 1) phase_mla(p, smem_raw, S, lgS, base);
      phase_fft2(p, smem, S, nseq, N1, base);
      phase_combb(p);
      if (PROBE == 6) { phase_fft2(p, smem, S, nseq, N1, base); phase_combb(p); }
      xcd_barrier(xb);
      if (PROBE == 5) xcd_barrier(xb);
      phase_merge(p, smem, l, base);
      if (PROBE == 3) phase_merge(p, smem, l, base);
      xcd_barrier(xb);
      if (PROBE == 5) xcd_barrier(xb);
      phase_resid_gemm(p, smem_raw, p.WoT + (size_t)l * 1024 * 1024, p.hbuf, 1024, xs, xo, modl, 2048, sb, base);
      xcd_barrier(xb);
      phase_norm(p, xo, p.norm2_g + l * 1024, modl, 3072, 4096, sb);
      if (PROBE == 9) { phase_norm(p, xo, p.norm2_g + l * 1024, modl, 3072, 4096, sb); phase_norm(p, xo, p.norm2_g + l * 1024, modl, 3072, 4096, sb); }
      xcd_barrier(xb);
      phase_w1(p, smem_raw, l, base);
      if (PROBE == 2 || PROBE == 8) phase_w1(p, smem_raw, l, base);
      xcd_barrier(xb);
      if (PROBE == 5) xcd_barrier(xb);
      phase_resid_gemm(p, smem_raw, p.W2T + (size_t)l * 1024 * 4096, p.zg, 4096, xo, xo, modl, 5120, sb, base);
      xcd_barrier(xb);
    }
  }
  phase_final(p);
}

extern "C" void kernel_launch(void* const* d_in, const int* in_sizes, int n_in, void* d_out, int out_size, void* d_ws, size_t ws_size,
                              hipStream_t stream) {
  Prm p{};
  const float* const* in = (const float* const*)d_in;
  p.x_prompt = in[0]; p.x_sample = in[1]; p.c_prompt = in[2]; p.c_sample = in[3]; p.rel_bias = in[4]; p.ada_w = in[5]; p.ada_b = in[6];
  p.norm1_g = in[7]; p.w_in = in[8]; p.qn_g = in[9]; p.kvn_g = in[10]; p.w_uq = in[11]; p.w_ukv = in[12]; p.ln_g = in[13]; p.ln_b = in[14];
  p.sgu_w = in[15]; p.sgu_b = in[16]; p.p_a = in[17]; p.p_b = in[18]; p.p_c = in[19]; p.p_d = in[20]; p.w_o = in[21]; p.norm2_g = in[22];
  p.w1 = in[23]; p.w2 = in[24]; p.final_g = in[25];
  p.out = (float*)d_out;
  char* w = (char*)d_ws;
  size_t off = 0;
  auto take = [&](size_t bytes) __attribute__((always_inline)) { void* r = w + off; off += (bytes + 255) & ~(size_t)255; return r; };
  p.WinT = (u16*)take((size_t)4 * NWP * 1024 * 2);
  p.W1T = (u16*)take((size_t)4 * 4096 * 1024 * 2);
  p.W2T = (u16*)take((size_t)4 * 4096 * 1024 * 2);
  p.WoT = (u16*)take((size_t)4 * 1024 * 1024 * 2);
  p.PaT = (u16*)take((size_t)4 * 1024 * 768 * 2);
  p.PbT = (u16*)take((size_t)4 * 1024 * 128 * 2);
  p.PcT = (u16*)take((size_t)4 * 1024 * 384 * 2);
  p.PdT = (u16*)take((size_t)4 * 1024 * 256 * 2);
  p.WqT = (u16*)take((size_t)4 * 384 * 384 * 2);
  p.WkvT = (u16*)take((size_t)4 * 512 * 320 * 2);
  p.SgW = (u16*)take((size_t)4 * 4 * 128 * 128 * 2);
  p.M1a = (u16*)take(256 * 256 * 2);
  p.M1b = (u16*)take(32 * 64 * 2);
  p.M2 = (u16*)take(128 * 256 * 2);
  p.tw = (float2*)take(16384 * 8);
  p.rope = (float2*)take((size_t)16384 * 16 * 8);
  p.biasT = (float*)take(6 * 129 * 4);
  p.mod = (float*)take((size_t)4 * 17 * 6144 * 4);
  p.hbuf = (u16*)take((size_t)TB * 1024 * 2);
  p.og = (float*)take((size_t)TB * 384 * 4);
  p.UT = (u16*)take((size_t)1536 * TBP * 2);
  p.Gp = (u16*)take((size_t)1536 * TB * 2);
  p.bqkv = (u16*)take((size_t)TB * 1152 * 2);
  p.ob = (u16*)take((size_t)TB * 128 * 2);
  p.cu = (u16*)take((size_t)TB * 384 * 2);
  p.cvT = (u16*)take((size_t)TBP * 384 * 2);
  p.dcq = (u16*)take((size_t)TB * 384 * 2);
  p.dckv = (u16*)take((size_t)TB * 320 * 2);
  p.qc = (u16*)take((size_t)TB * 384 * 2);
  p.kc = (u16*)take((size_t)TB * 384 * 2);
  p.vT = (u16*)take((size_t)TBP * 256 * 2);
  p.od = (u16*)take((size_t)TB * 256 * 2);
  p.lse = (float*)take((size_t)TB * 6 * 4);
  p.zg = (u16*)take((size_t)TB * 4096 * 2);
  p.bar = (unsigned*)take(XCD_BAR_WORDS * 4);
  p.modpart = (float*)p.zg;
  if (off > ws_size) { fprintf(stderr, "workspace too small: need %zu have %zu\n", off, ws_size); return; }
  static int grid_blocks = 0;
  if (!grid_blocks) {
    int dev = 0, cus = 0, per_cu = 0;
    (void)hipGetDevice(&dev);
    (void)hipDeviceGetAttribute(&cus, hipDeviceAttributeMultiprocessorCount, dev);
    (void)hipOccupancyMaxActiveBlocksPerMultiprocessor(&per_cu, mega, NTH, 0);
    if (per_cu < 1) per_cu = 1;
    if (per_cu > 1) per_cu = 1;
    grid_blocks = cus * per_cu;
  }
  (void)hipMemsetAsync(p.bar, 0, XCD_BAR_WORDS * 4, stream);
  void* args[] = {&p};
  hipError_t e = hipLaunchCooperativeKernel((void*)mega, dim3(grid_blocks), dim3(NTH), args, 0, stream);
  if (e != hipSuccess) fprintf(stderr, "cooperative launch failed: %s (grid %d)\n", hipGetErrorString(e), grid_blocks);
}
```

```cpp
#include <hip/hip_runtime.h>
#include <hip/hip_cooperative_groups.h>
#include <stdint.h>
#include <stdio.h>
namespace cg = cooperative_groups;

#define DI __device__ __forceinline__
#define LAS __attribute__((address_space(3)))
typedef unsigned short u16;
typedef __attribute__((ext_vector_type(8))) short bf16x8;
typedef __attribute__((ext_vector_type(4))) short bf16x4;
typedef __attribute__((ext_vector_type(16))) float f32x16;
typedef __attribute__((ext_vector_type(4))) float f32x4;
typedef __attribute__((ext_vector_type(2))) float f32x2;
typedef __attribute__((ext_vector_type(4))) unsigned u32x4;
typedef __attribute__((ext_vector_type(2))) unsigned u32x2;
typedef __attribute__((ext_vector_type(2))) __bf16 bf2_t;

constexpr int TB = 16384;
constexpr int TBP = TB + 64;
constexpr int NW = 8288;
constexpr int NWP = 8320;
constexpr int LDT = 72;
constexpr int TILE_ELEMS = 128 * LDT;
constexpr int GEMM_SMEM = 4 * TILE_ELEMS * 2;
constexpr int SMEM_BYTES = 131072;
#ifndef PROBE
#define PROBE 0
#endif
constexpr int NTH = 512;
constexpr int HT = 128 * 64;
constexpr float LOG2E = 1.4426950408889634f;
constexpr float LN2 = 0.6931471805599453f;

struct Prm {
  const float *x_prompt, *x_sample, *c_prompt, *c_sample, *rel_bias, *ada_w, *ada_b, *norm1_g, *w_in,
      *qn_g, *kvn_g, *w_uq, *w_ukv, *ln_g, *ln_b, *sgu_w, *sgu_b, *p_a, *p_b, *p_c, *p_d, *w_o,
      *norm2_g, *w1, *w2, *final_g;
  float* out;
  u16 *WinT, *W1T, *W2T, *WoT, *PaT, *PbT, *PcT, *PdT, *WqT, *WkvT, *SgW, *M1a, *M1b, *M2;
  float2 *tw, *rope;
  float *biasT, *mod, *modpart;
  u16 *hbuf, *UT, *Gp, *bqkv, *ob, *cu, *cvT, *dcq, *dckv, *qc, *kc, *vT, *od, *zg;
  float *og, *lse;
  unsigned* bar;
};

DI unsigned pack2(float a, float b) { bf2_t v; v[0] = (__bf16)a; v[1] = (__bf16)b; return __builtin_bit_cast(unsigned, v); }
DI u16 f2bf(float a) { return __builtin_bit_cast(u16, (__bf16)a); }
DI float bf2f(u16 v) { return __uint_as_float(((unsigned)v) << 16); }
DI float bflo(unsigned w) { return __uint_as_float(w << 16); }
DI float bfhi(unsigned w) { return __uint_as_float(w & 0xffff0000u); }
DI void st4bf(u16* dst, float a, float b, float c, float d) { u32x2 v; v[0] = pack2(a, b); v[1] = pack2(c, d); *(u32x2*)dst = v; }
DI void st4bf_nt(u16* dst, float a, float b, float c, float d) { u32x2 v; v[0] = pack2(a, b); v[1] = pack2(c, d); __builtin_nontemporal_store(v, (u32x2*)dst); }
DI int rowmap(int r, int lh) { return (r & 3) + 8 * (r >> 2) + 4 * lh; }
DI f32x16 mfma(bf16x8 a, bf16x8 b, f32x16 c) { return __builtin_amdgcn_mfma_f32_32x32x16_bf16(a, b, c, 0, 0, 0); }
DI u32x4 zero4() { u32x4 z; z[0] = 0; z[1] = 0; z[2] = 0; z[3] = 0; return z; }
DI f32x16 zero16() { f32x16 z; for (int i = 0; i < 16; ++i) z[i] = 0.f; return z; }
DI float ex2(float x) { return __builtin_amdgcn_exp2f(x); }
DI int tidx() { int t = threadIdx.x; asm volatile("" : "+v"(t)); return t; }


#define XB_TMO      128
#define XB_XCNT(j)  (256  + 64 * (j))
#define XB_XSUB(j)  (1280 + 64 * (j))
#define XB_XGEN(j)  (2304 + 64 * (j))
#define XB_TOP      3328
#define XB_TOPGEN   3392
#define XCD_BAR_WORDS 3456
#define XB_SPIN_CAP (1u << 18)
DI unsigned xb_ld(unsigned* p) { return __hip_atomic_load(p, __ATOMIC_RELAXED, __HIP_MEMORY_SCOPE_AGENT); }
DI unsigned xb_add(unsigned* p, unsigned v) { return __hip_atomic_fetch_add(p, v, __ATOMIC_RELAXED, __HIP_MEMORY_SCOPE_AGENT); }
DI unsigned xb_xcc_id() { return (unsigned)__builtin_amdgcn_s_getreg((3 << 11) | 20) & 0xFu; }
#define XB_SPIN(cond, bar) do { unsigned _sp = 0; while (cond) { __builtin_amdgcn_s_sleep(1); \
    if ((++_sp & 255u) == 0u) { if (xb_ld(&(bar)[XB_TMO])) break; if (_sp > XB_SPIN_CAP) { atomicAdd(&(bar)[XB_TMO], 1u); break; } } } } while (0)
struct XcdBarrier { unsigned* bar; unsigned x; volatile LAS unsigned* st; };
DI XcdBarrier xcd_barrier_post(unsigned* bar, volatile LAS unsigned* st) {
  XcdBarrier b; b.bar = bar; b.x = xb_xcc_id(); b.st = st;
  if (threadIdx.x == 0) (void)xb_add(&bar[XB_XCNT(b.x)], 1u);
  return b;
}
DI void xcd_barrier_complete(unsigned* bar, unsigned x, unsigned& nloc, unsigned& nx) {
  const unsigned G = gridDim.x * gridDim.y * gridDim.z;
  unsigned sum, cnt, mine, sp = 0u;
  for (;;) {
    sum = 0u; cnt = 0u; mine = 0u;
#pragma unroll
    for (unsigned j = 0; j < 16; ++j) { const unsigned c = xb_ld(&bar[XB_XCNT(j)]); sum += c; cnt += (c > 0u) ? 1u : 0u; mine = (j == x) ? c : mine; }
    if (sum == G) break;
    __builtin_amdgcn_s_sleep(1);
    if ((++sp & 255u) == 0u) { if (xb_ld(&bar[XB_TMO])) break; if (sp > XB_SPIN_CAP) { atomicAdd(&bar[XB_TMO], 1u); break; } }
  }
  nloc = mine > 0u ? mine : 1u; nx = cnt > 0u ? cnt : 1u;
}
DI void xcd_barrier(const XcdBarrier& b) {
  asm volatile("s_waitcnt vmcnt(0)" ::: "memory");
  __syncthreads();
  if (tidx() == 0) {
    unsigned* bar = b.bar;
    const unsigned bx = (unsigned)__builtin_amdgcn_readfirstlane((int)xb_xcc_id());
    __builtin_amdgcn_s_waitcnt(0);
    unsigned nloc = b.st[0], nx = b.st[1];
    if (nloc == 0u) { xcd_barrier_complete(bar, bx, nloc, nx); b.st[0] = nloc; b.st[1] = nx; }
    const unsigned old = xb_add(&bar[XB_XSUB(bx)], 1u);
    const unsigned gen = old / nloc;
    if (old + 1u == (gen + 1u) * nloc) {
      __builtin_amdgcn_fence(__ATOMIC_RELEASE, "agent");
      asm volatile("s_waitcnt vmcnt(0)" ::: "memory");
      const unsigned og = xb_add(&bar[XB_TOP], 1u);
      const unsigned tg = og / nx;
      if (og + 1u == (tg + 1u) * nx) xb_add(&bar[XB_TOPGEN], 1u);
      else XB_SPIN(xb_ld(&bar[XB_TOPGEN]) == tg, bar);
      __builtin_amdgcn_fence(__ATOMIC_ACQUIRE, "agent");
      xb_add(&bar[XB_XGEN(bx)], 1u);
      asm volatile("s_waitcnt vmcnt(0)" ::: "memory");
    } else {
      XB_SPIN(xb_ld(&bar[XB_XGEN(bx)]) == gen, bar);
      __builtin_amdgcn_fence(__ATOMIC_ACQUIRE, "agent");
      asm volatile("s_waitcnt vmcnt(0)" ::: "memory");
    }
  }
  __syncthreads();
}

#define TASK_LOOP(t, nt, base) for (int t = (int)((blockIdx.x + gridDim.x - ((unsigned)(base) % gridDim.x)) % gridDim.x); t < (nt); t += gridDim.x)

template <bool RFA, bool RFB, class LA, class LB, class EPI>
DI void gemm_tile(u16* smem, int nk, LA la, LB lb, EPI epi) {
  const int tid = tidx(), lane = tid & 63, wave = tid >> 6;
  const int wm = wave >> 2, wn = wave & 3, lr = lane & 31, lh = lane >> 5;
  u16* As = smem;
  u16* Bs = smem + 2 * TILE_ELEMS;
  f32x16 acc[2];
  acc[0] = zero16(); acc[1] = zero16();
  u32x4 ra[2], rb[2];
#define A_ROW(c) (RFA ? ((c) & 127) : ((c) >> 3))
#define A_KC(c) (RFA ? ((c) >> 7) : ((c) & 7))
#define B_ROW(c) (RFB ? ((c) & 127) : ((c) >> 3))
#define B_KC(c) (RFB ? ((c) >> 7) : ((c) & 7))
#pragma unroll
  for (int i = 0; i < 2; ++i) { const int c = tid + NTH * i; ra[i] = la(A_ROW(c), A_KC(c) * 8); rb[i] = lb(B_ROW(c), B_KC(c) * 8); }
#pragma unroll
  for (int i = 0; i < 2; ++i) {
    const int c = tid + NTH * i;
    *(u32x4*)(As + A_ROW(c) * LDT + A_KC(c) * 8) = ra[i];
    *(u32x4*)(Bs + B_ROW(c) * LDT + B_KC(c) * 8) = rb[i];
  }
  __syncthreads();
  for (int kt = 0; kt < nk; ++kt) {
    const int buf = kt & 1;
    if (kt + 1 < nk) {
      const int k0 = (kt + 1) * 64;
#pragma unroll
      for (int i = 0; i < 2; ++i) { const int c = tid + NTH * i; ra[i] = la(A_ROW(c), k0 + A_KC(c) * 8); rb[i] = lb(B_ROW(c), k0 + B_KC(c) * 8); }
    }
    const u16* Ab = As + buf * TILE_ELEMS + (wm * 64 + lr) * LDT + lh * 8;
    const u16* Bb = Bs + buf * TILE_ELEMS + (wn * 32 + lr) * LDT + lh * 8;
#pragma unroll
    for (int ks = 0; ks < 4; ++ks) {
      const bf16x8 a0 = *(const bf16x8*)(Ab + ks * 16);
      const bf16x8 a1 = *(const bf16x8*)(Ab + 32 * LDT + ks * 16);
      const bf16x8 b = *(const bf16x8*)(Bb + ks * 16);
      acc[0] = mfma(a0, b, acc[0]);
      acc[1] = mfma(a1, b, acc[1]);
    }
    if (kt + 1 < nk) {
      u16* Aw = As + (buf ^ 1) * TILE_ELEMS;
      u16* Bw = Bs + (buf ^ 1) * TILE_ELEMS;
#pragma unroll
      for (int i = 0; i < 2; ++i) {
        const int c = tid + NTH * i;
        *(u32x4*)(Aw + A_ROW(c) * LDT + A_KC(c) * 8) = ra[i];
        *(u32x4*)(Bw + B_ROW(c) * LDT + B_KC(c) * 8) = rb[i];
      }
    }
    __syncthreads();
  }
  epi(acc, wm, wn, lane);
}

template <bool RFA, bool RFB, class LA, class LB, class EPI>
DI void gemm_tile2s(u16* smem, int nk, LA la, LB lb, EPI epi) {
  const int tid = tidx(), lane = tid & 63, wave = tid >> 6;
  const int wm = wave >> 2, wn = wave & 3, lr = lane & 31, lh = lane >> 5;
  u16* As = smem;
  u16* Bs = smem + 2 * TILE_ELEMS;
  f32x16 acc[2];
  acc[0] = zero16(); acc[1] = zero16();
  u32x4 ra0[2], rb0[2], ra1[2], rb1[2];
  auto ld = [&](u32x4 (&ra)[2], u32x4 (&rb)[2], int kt) __attribute__((always_inline)) {
    const int k0 = kt * 64;
#pragma unroll
    for (int i = 0; i < 2; ++i) { const int c = tid + NTH * i; ra[i] = la(A_ROW(c), k0 + A_KC(c) * 8); rb[i] = lb(B_ROW(c), k0 + B_KC(c) * 8); }
  };
  auto stl = [&](u32x4 (&ra)[2], u32x4 (&rb)[2], int buf) __attribute__((always_inline)) {
#pragma unroll
    for (int i = 0; i < 2; ++i) {
      const int c = tid + NTH * i;
      *(u32x4*)(As + buf * TILE_ELEMS + A_ROW(c) * LDT + A_KC(c) * 8) = ra[i];
      *(u32x4*)(Bs + buf * TILE_ELEMS + B_ROW(c) * LDT + B_KC(c) * 8) = rb[i];
    }
  };
  auto compute = [&](int buf) __attribute__((always_inline)) {
    const u16* Ab = As + buf * TILE_ELEMS + (wm * 64 + lr) * LDT + lh * 8;
    const u16* Bb = Bs + buf * TILE_ELEMS + (wn * 32 + lr) * LDT + lh * 8;
#pragma unroll
    for (int ks = 0; ks < 4; ++ks) {
      const bf16x8 a0 = *(const bf16x8*)(Ab + ks * 16);
      const bf16x8 a1 = *(const bf16x8*)(Ab + 32 * LDT + ks * 16);
      const bf16x8 b = *(const bf16x8*)(Bb + ks * 16);
      acc[0] = mfma(a0, b, acc[0]);
      acc[1] = mfma(a1, b, acc[1]);
    }
  };
  ld(ra0, rb0, 0);
  if (nk > 1) ld(ra1, rb1, 1);
  stl(ra0, rb0, 0);
  if (nk > 2) ld(ra0, rb0, 2);
  __syncthreads();
#pragma unroll 1
  for (int kt = 0; kt < nk; kt += 2) {
    compute(0);
    if (kt + 1 < nk) { stl(ra1, rb1, 1); if (kt + 3 < nk) ld(ra1, rb1, kt + 3); }
    __syncthreads();
    if (kt + 1 < nk) {
      compute(1);
      if (kt + 2 < nk) { stl(ra0, rb0, 0); if (kt + 4 < nk) ld(ra0, rb0, kt + 4); }
      __syncthreads();
    }
  }
  epi(acc, wm, wn, lane);
}

DI void stage_rc(int b, int& R, int& C) { int st = b / 1024, sb = b % 1024, swz = sb ^ (((sb >> 9) & 1) << 5); R = (st >> 1) * 16 + swz / 64; C = (st & 1) * 32 + (swz % 64) / 2; }

DI int perm32(int rho) { const int n = rho >> 4, i = rho & 15; return 8 * (i >> 2) + 4 * n + (i & 3); }

template <bool PERM, class EPI>
DI void gemm256(LAS u16* shm, const u16* __restrict__ A, const u16* __restrict__ Bt, int K, int brow, int bcol, bool pre, bool has_next, int nbrow, int nbcol, EPI epi) {
#define SA(b, h) (shm + ((b) * 2 + (h)) * HT)
#define SB(b, h) (shm + (4 + (b) * 2 + (h)) * HT)
  const int tid = tidx();
  const int wid = __builtin_amdgcn_readfirstlane(tid >> 6), lane = tid & 63, wr = wid >> 2, wc = wid & 3, fr = lane & 15, fq = lane >> 4;
  int r0, c0, r1, c1;
  stage_rc(tid * 16, r0, c0);
  stage_rc(tid * 16 + 8192, r1, c1);
  const int ra0 = PERM ? ((r0 & ~31) + perm32(r0 & 31)) : r0, ra1 = PERM ? ((r1 & ~31) + perm32(r1 & 31)) : r1;
  const unsigned so0 = (unsigned)(ra0 * K + c0) * 2u, so1 = (unsigned)(ra1 * K + c1) * 2u;
  const unsigned sb0 = (unsigned)(r0 * K + c0) * 2u, sb1 = (unsigned)(r1 * K + c1) * 2u;
  const unsigned ldsw = (unsigned)wid * 1024u;
  const int lb = ((fr * 64 + fq * 16) ^ ((fr >> 3) << 5));
#define STAGE_(P, BASE, br, kt, O0, O1) do { const char* _g = (const char*)((BASE) + (size_t)(br) * K + (kt) * 64); \
    __builtin_amdgcn_global_load_lds((const unsigned*)(_g + O0), (LAS unsigned*)((LAS char*)(P) + ldsw), 16, 0, 0); \
    __builtin_amdgcn_global_load_lds((const unsigned*)(_g + O1), (LAS unsigned*)((LAS char*)(P) + ldsw + 8192), 16, 0, 0); } while (0)
#define STAGEA(P, br, kt) STAGE_(P, A, br, kt, so0, so1)
#define STAGEB(P, br, kt) STAGE_(P, Bt, br, kt, sb0, sb1)
#define LDA(dst, b, h) _Pragma("unroll") for (int m = 0; m < 4; ++m) _Pragma("unroll") for (int k = 0; k < 2; ++k) \
    dst[m][k] = *(const LAS bf16x8*)((const LAS char*)SA(b, h) + ((wr * 4 + m) * 2 + k) * 1024 + lb)
#define LDB(dst, b, h) _Pragma("unroll") for (int n = 0; n < 2; ++n) _Pragma("unroll") for (int k = 0; k < 2; ++k) \
    dst[n][k] = *(const LAS bf16x8*)((const LAS char*)SB(b, h) + ((wc * 2 + n) * 2 + k) * 1024 + lb)
#define MMA(ai, bj, At_, Bt_) do { __builtin_amdgcn_s_setprio(1); \
    _Pragma("unroll") for (int m = 0; m < 4; ++m) _Pragma("unroll") for (int n = 0; n < 2; ++n) _Pragma("unroll") for (int k = 0; k < 2; ++k) \
      acc[ai][bj][m][n] = __builtin_amdgcn_mfma_f32_16x16x32_bf16(At_[m][k], Bt_[n][k], acc[ai][bj][m][n], 0, 0, 0); \
    __builtin_amdgcn_s_setprio(0); } while (0)
#define WAIT_V(n) asm volatile("s_waitcnt vmcnt(" #n ")" ::: "memory")
#define WAIT_L(n) asm volatile("s_waitcnt lgkmcnt(" #n ")" ::: "memory")
#define BAR __builtin_amdgcn_s_barrier()
#define SCHED __builtin_amdgcn_sched_barrier(0)
  f32x4 acc[2][2][4][2];
#pragma unroll
  for (int a = 0; a < 2; ++a)
#pragma unroll
    for (int b = 0; b < 2; ++b)
#pragma unroll
      for (int m = 0; m < 4; ++m)
#pragma unroll
        for (int n = 0; n < 2; ++n) { acc[a][b][m][n][0] = 0.f; acc[a][b][m][n][1] = 0.f; acc[a][b][m][n][2] = 0.f; acc[a][b][m][n][3] = 0.f; }
  bf16x8 At[4][2], B0[2][2], B1[2][2];
  const int nt = K / 64;
  if (!pre) {
    STAGEB(SB(0, 0), bcol, 0); STAGEA(SA(0, 0), brow, 0);
    STAGEB(SB(0, 1), bcol + 128, 0); STAGEA(SA(0, 1), brow + 128, 0);
  }
  if (wr == 1) BAR;
  WAIT_V(4); BAR;
  STAGEB(SB(1, 0), bcol, 1); STAGEA(SA(1, 0), brow, 1); STAGEB(SB(1, 1), bcol + 128, 1);
  WAIT_V(6); BAR;
  for (int t = 0; t < nt - 2; t += 2) {
    LDB(B0, 0, 0); SCHED; LDA(At, 0, 0); STAGEA(SA(1, 1), brow + 128, t + 1);
    WAIT_L(8); BAR; WAIT_L(0); MMA(0, 0, At, B0); BAR; SCHED;
    LDB(B1, 0, 1); STAGEB(SB(0, 0), bcol, t + 2);
    BAR; WAIT_L(0); MMA(0, 1, At, B1); BAR;
    LDA(At, 0, 1); STAGEA(SA(0, 0), brow, t + 2);
    BAR; WAIT_L(0); MMA(1, 0, At, B0); BAR; SCHED;
    STAGEB(SB(0, 1), bcol + 128, t + 2);
    WAIT_V(6); BAR; MMA(1, 1, At, B1); BAR;
    LDB(B0, 1, 0); SCHED; LDA(At, 1, 0); STAGEA(SA(0, 1), brow + 128, t + 2);
    WAIT_L(8); BAR; WAIT_L(0); MMA(0, 0, At, B0); BAR; SCHED;
    LDB(B1, 1, 1); STAGEB(SB(1, 0), bcol, t + 3);
    BAR; WAIT_L(0); MMA(0, 1, At, B1); BAR;
    LDA(At, 1, 1); STAGEA(SA(1, 0), brow, t + 3);
    BAR; WAIT_L(0); MMA(1, 0, At, B0); BAR; SCHED;
    STAGEB(SB(1, 1), bcol + 128, t + 3);
    WAIT_V(6); BAR; MMA(1, 1, At, B1); BAR;
  }
  { LDB(B0, 0, 0); LDA(At, 0, 0); STAGEA(SA(1, 1), brow + 128, nt - 1);
    BAR; WAIT_L(0); MMA(0, 0, At, B0); BAR;
    LDB(B1, 0, 1); BAR; WAIT_L(0); MMA(0, 1, At, B1); BAR;
    LDA(At, 0, 1); WAIT_V(4); BAR; WAIT_L(0); MMA(1, 0, At, B0); MMA(1, 1, At, B1); BAR; }
  { LDB(B0, 1, 0); LDA(At, 1, 0); WAIT_V(2); BAR; WAIT_L(0); MMA(0, 0, At, B0); BAR;
    LDB(B1, 1, 1); WAIT_V(0); BAR; WAIT_L(0); MMA(0, 1, At, B1); BAR;
    LDA(At, 1, 1); BAR; WAIT_L(0); MMA(1, 0, At, B0); MMA(1, 1, At, B1); BAR; }
  if (wr == 0) BAR;
  if (has_next) {
    STAGEB(SB(0, 0), nbcol, 0); STAGEA(SA(0, 0), nbrow, 0);
    STAGEB(SB(0, 1), nbcol + 128, 0); STAGEA(SA(0, 1), nbrow + 128, 0);
  }
  epi(acc, wr, wc, fr, fq);
  __syncthreads();
}

DI void map256(int t, int nN, int& tn, int& tm) {
  const int p = (t >> 8) * 8 + (t & 7), i = (t >> 3) & 31, pr = nN >> 2;
  const int pm = p / pr;
  tn = ((p + pm) % pr) * 4 + (i & 3);
  tm = pm * 8 + (i >> 2);
}

DI int condrow(int sb, int tok) { return sb == 0 ? 0 : 1 + (sb - 1) * 8 + (tok >> 11); }

DI void convT(float* tile, const float* src, int lds_, int K, int N, u16* dst, int ldd, const float* ksc, int& base) {
  const int tid = tidx();
  const int ntn = (N + 63) >> 6, nt = (K >> 6) * ntn;
  const int kk = tid >> 4, n4 = (tid & 15) * 4;
  float4 cur[2], nxt[2];
  auto ld = [&](float4 (&v)[2], int t) __attribute__((always_inline)) {
    const int tn = t % ntn, tk = t / ntn, k0 = tk * 64, n0 = tn * 64;
#pragma unroll
    for (int e = 0; e < 2; ++e) {
      v[e] = make_float4(0.f, 0.f, 0.f, 0.f);
      if (n0 + n4 < N) v[e] = *(const float4*)(src + (size_t)(k0 + kk + 32 * e) * lds_ + n0 + n4);
    }
  };
  int t = (int)((blockIdx.x + gridDim.x - ((unsigned)base % gridDim.x)) % gridDim.x);
  if (t < nt) ld(cur, t);
  for (; t < nt; t += gridDim.x) {
    const int tnx = t + (int)gridDim.x;
    if (tnx < nt) ld(nxt, tnx);
    const int tn = t % ntn, tk = t / ntn, k0 = tk * 64, n0 = tn * 64;
#pragma unroll
    for (int e = 0; e < 2; ++e) {
      float4 v = cur[e];
      if (ksc) { const float sc = ksc[k0 + kk + 32 * e]; v.x *= sc; v.y *= sc; v.z *= sc; v.w *= sc; }
      float* tp = tile + (kk + 32 * e) * 65 + n4;
      tp[0] = v.x; tp[1] = v.y; tp[2] = v.z; tp[3] = v.w;
    }
    __syncthreads();
#pragma unroll 4
    for (int e = 0; e < 4; ++e) {
      const int idx = tid + NTH * e, nn = idx >> 5, kp = idx & 31;
      if (n0 + nn < N)
        *(unsigned*)(dst + (size_t)(n0 + nn) * ldd + k0 + 2 * kp) = pack2(tile[(2 * kp) * 65 + nn], tile[(2 * kp + 1) * 65 + nn]);
    }
    __syncthreads();
    cur[0] = nxt[0]; cur[1] = nxt[1];
  }
  base += nt;
}

DI void prologue_a(const Prm& p, unsigned char* smem_raw, int& base) {
  float* smf = (float*)smem_raw;
  const int tid = tidx();
  const int gtid = blockIdx.x * NTH + tid, gn = gridDim.x * NTH;
  for (int l = 0; l < 4; ++l) {
    convT(smf, p.w_in + (size_t)l * 1024 * 7520 + 768, 7520, 1024, 6752, p.WinT + ((size_t)l * NWP + 1536) * 1024, 1024, nullptr, base);
    convT(smf, p.w1 + (size_t)l * 1024 * 4096, 4096, 1024, 4096, p.W1T + (size_t)l * 4096 * 1024, 1024, nullptr, base);
    convT(smf, p.w2 + (size_t)l * 4096 * 1024, 1024, 4096, 1024, p.W2T + (size_t)l * 1024 * 4096, 4096, nullptr, base);
    convT(smf, p.w_o + (size_t)l * 1024 * 1024, 1024, 1024, 1024, p.WoT + (size_t)l * 1024 * 1024, 1024, nullptr, base);
    convT(smf, p.p_a + (size_t)l * 768 * 1024, 1024, 768, 1024, p.PaT + (size_t)l * 1024 * 768, 768, nullptr, base);
    convT(smf, p.p_b + (size_t)l * 128 * 1024, 1024, 128, 1024, p.PbT + (size_t)l * 1024 * 128, 128, nullptr, base);
    convT(smf, p.p_c + (size_t)l * 384 * 1024, 1024, 384, 1024, p.PcT + (size_t)l * 1024 * 384, 384, nullptr, base);
    convT(smf, p.p_d + (size_t)l * 256 * 1024, 1024, 256, 1024, p.PdT + (size_t)l * 1024 * 256, 256, nullptr, base);
    convT(smf, p.w_uq + (size_t)l * 384 * 384, 384, 384, 384, p.WqT + (size_t)l * 384 * 384, 384, p.qn_g + l * 384, base);
    convT(smf, p.w_ukv + (size_t)l * 320 * 512, 512, 320, 512, p.WkvT + (size_t)l * 512 * 320, 320, p.kvn_g + l * 320, base);
  }
  {
    float* tab = (float*)(smem_raw + GEMM_SMEM + 1024);
    if (tid < 192) {
      float sn, cs;
      sincospif(2.f * (float)tid / 192.f, &sn, &cs);
      tab[tid] = cs; tab[192 + tid] = sn;
    }
    __syncthreads();
    u16* smem = (u16*)smem_raw;
    TASK_LOOP(t, 384, base) {
      const int kt = t & 7, rt = (t >> 3) % 3, g = (t / 24) & 3, l = t / 96;
      auto la = [&](int row, int k) __attribute__((always_inline)) {
        const int rr = rt * 128 + row, part = rr >= 192 ? 1 : 0, j = rr - part * 192;
        const float* tp = tab + part * 192;
        const float sg = part ? -1.f : 1.f;
        int m = (j * k) % 192;
        u32x4 o;
#pragma unroll
        for (int jj = 0; jj < 4; ++jj) {
          const float v0 = tp[m] * sg; m += j; if (m >= 192) m -= 192;
          const float v1 = tp[m] * sg; m += j; if (m >= 192) m -= 192;
          o[jj] = pack2(v0, v1);
        }
        return o;
      };
      auto lb = [&](int row, int k) __attribute__((always_inline)) {
        const float* src = p.w_in + ((size_t)l * 1024 + kt * 128 + row) * 7520 + g * 192 + k;
        const float4 a = *(const float4*)src, b = *(const float4*)(src + 4);
        u32x4 o;
        o[0] = pack2(a.x, a.y); o[1] = pack2(a.z, a.w); o[2] = pack2(b.x, b.y); o[3] = pack2(b.z, b.w);
        return o;
      };
      auto epi = [&](f32x16 (&acc)[2], int wm, int wn, int lane) __attribute__((always_inline)) {
        const int lr = lane & 31, lh = lane >> 5;
        const int kcol = kt * 128 + wn * 32 + lr;
#pragma unroll
        for (int i = 0; i < 2; ++i)
#pragma unroll
          for (int r = 0; r < 16; ++r) {
            const int rr = rt * 128 + wm * 64 + i * 32 + rowmap(r, lh), part = rr >= 192 ? 1 : 0, j = rr - part * 192;
            p.WinT[((size_t)l * NWP + part * 768 + g * 192 + j) * 1024 + kcol] = f2bf(acc[i][r]);
          }
      };
      gemm_tile<false, false>(smem, 3, la, lb, epi);
    }
    base += 384;
  }
  {
    float* sil = smf;
    TASK_LOOP(t, 384, base) {
      const int kc = t & 7, cb = (t >> 3) % 12, l = t / 96, k0 = kc * 128;
      for (int idx = tid; idx < 17 * 128; idx += NTH) {
        const int r = idx >> 7, kk = idx & 127;
        const float c = r == 0 ? p.c_prompt[k0 + kk] : p.c_sample[(r - 1) * 1024 + k0 + kk];
        sil[idx] = c / (1.f + __expf(-c));
      }
      __syncthreads();
      const int n = cb * 512 + tid;
      float acc[17];
#pragma unroll
      for (int r = 0; r < 17; ++r) acc[r] = 0.f;
      const float* wp = p.ada_w + ((size_t)l * 1024 + k0) * 6144 + n;
#pragma unroll 1
      for (int kb = 0; kb < 128; kb += 32) {
        float w[32];
#pragma unroll
        for (int i = 0; i < 32; ++i) w[i] = wp[(size_t)(kb + i) * 6144];
#pragma unroll
        for (int i = 0; i < 32; i += 4)
#pragma unroll
          for (int r = 0; r < 17; ++r) {
            const float4 sv = *(const float4*)(sil + r * 128 + kb + i);
            acc[r] += sv.x * w[i] + sv.y * w[i + 1] + sv.z * w[i + 2] + sv.w * w[i + 3];
          }
      }
#pragma unroll
      for (int r = 0; r < 17; ++r) p.modpart[((size_t)(kc * 4 + l) * 17 + r) * 6144 + n] = acc[r];
      __syncthreads();
    }
    base += 384;
  }
  for (int idx = gtid; idx < 4 * 32 * 1024; idx += gn) {
    const int l = idx >> 15, rem = idx & 32767;
    p.WinT[((size_t)l * NWP + NW) * 1024 + rem] = 0;
  }
  for (int idx = gtid; idx < 256 * 256; idx += gn) {
    const int row = idx >> 8, kk = idx & 255;
    const int po = row >> 7, k1 = row & 127, pi = kk >> 7, s1 = kk & 127;
    float s, c;
    sincospif(2.f * (float)((k1 * s1) & 127) / 128.f, &s, &c);
    const float v = (po == pi) ? c : (po == 0 ? s : -s);
    p.M1a[idx] = f2bf(v);
  }
  for (int idx = gtid; idx < 32 * 64; idx += gn) {
    const int row = idx >> 6, kk = idx & 63;
    const int po = row >> 4, k1 = row & 15, pi = (kk >> 4) & 1, s1 = kk & 15;
    float s, c;
    sincospif(2.f * (float)((k1 * s1) & 15) / 16.f, &s, &c);
    float v = (po == pi) ? c : (po == 0 ? s : -s);
    if (kk >= 32) v = 0.f;
    p.M1b[idx] = f2bf(v);
  }
  for (int idx = gtid; idx < 128 * 256; idx += gn) {
    const int k2 = idx >> 8, kk = idx & 255, part = kk >> 7, s2 = kk & 127;
    float s, c;
    sincospif(2.f * (float)((k2 * s2) & 127) / 128.f, &s, &c);
    p.M2[idx] = f2bf(part ? s : c);
  }
  for (int idx = gtid; idx < 16384; idx += gn) {
    float s, c;
    sincospif(2.f * (float)idx / 16384.f, &s, &c);
    p.tw[idx] = make_float2(c, s);
  }
  for (int idx = gtid; idx < 16384 * 16; idx += gn) {
    const int pos = idx >> 4, i = idx & 15;
    const float inv = (float)pow(10000.0, -(double)i / 16.0);
    const float ang = (float)pos * inv;
    double rev = (double)ang * 0.15915494309189535;
    rev -= rint(rev);
    float s, c;
    sincospif((float)(2.0 * rev), &s, &c);
    p.rope[idx] = make_float2(c, s);
  }
  for (int idx = gtid; idx < 6 * 129; idx += gn) {
    const int hd = idx / 129, rel = idx - hd * 129 - 64;
    const int dil = 1 << (2 * (hd >> 1));
    const int rd = rel * dil, n = rd < 0 ? -rd : rd;
    int b;
    if (n < 8) b = n;
    else if (n < 15) b = 8; else if (n < 27) b = 9; else if (n < 50) b = 10; else if (n < 91) b = 11;
    else if (n < 166) b = 12; else if (n < 305) b = 13; else if (n < 559) b = 14; else b = 15;
    if (rd > 0) b += 16;
    p.biasT[idx] = p.rel_bias[b * 6 + hd];
  }
  for (int idx = gtid; idx < 4 * 4 * 128 * 128; idx += gn) p.SgW[idx] = f2bf(p.sgu_w[idx]);
}

DI void prologue_b(const Prm& p) {
  const int gtid = blockIdx.x * NTH + tidx(), gn = gridDim.x * NTH;
  for (int idx = gtid; idx < 4 * 17 * 6144; idx += gn) {
    const int l = idx / (17 * 6144), n = idx % 6144;
    float s = p.ada_b[l * 6144 + n];
#pragma unroll
    for (int kc = 0; kc < 8; ++kc) s += p.modpart[(size_t)kc * 4 * 17 * 6144 + idx];
    p.mod[idx] = s;
  }
}

DI void phase_norm(const Prm& p, const float* xsrc, const float* g, const float* modl, int shoff, int scoff, int sb) {
  const int tid = tidx(), lane = tid & 63;
  const int gw = blockIdx.x * 8 + (tid >> 6), nw = gridDim.x * 8;
  for (int row = gw; row < TB; row += nw) {
    const int cond = condrow(sb, row);
    const float* xr = xsrc + (size_t)row * 1024;
    float4 v[4];
    float ss = 0.f;
#pragma unroll
    for (int i = 0; i < 4; ++i) {
      v[i] = *(const float4*)(xr + i * 256 + lane * 4);
      ss += v[i].x * v[i].x + v[i].y * v[i].y + v[i].z * v[i].z + v[i].w * v[i].w;
    }
#pragma unroll
    for (int off = 32; off >= 1; off >>= 1) ss += __shfl_xor(ss, off);
    const float rstd = rsqrtf(ss * (1.f / 1024.f) + 1e-6f);
    const float* sc = modl + cond * 6144 + scoff;
    const float* sh = modl + cond * 6144 + shoff;
#pragma unroll
    for (int i = 0; i < 4; ++i) {
      const int col = i * 256 + lane * 4;
      const float4 gg = *(const float4*)(g + col), s4 = *(const float4*)(sc + col), h4 = *(const float4*)(sh + col);
      st4bf(p.hbuf + (size_t)row * 1024 + col,
            v[i].x * rstd * gg.x * (1.f + s4.x) + h4.x, v[i].y * rstd * gg.y * (1.f + s4.y) + h4.y,
            v[i].z * rstd * gg.z * (1.f + s4.z) + h4.z, v[i].w * rstd * gg.w * (1.f + s4.w) + h4.w);
    }
  }
}

DI float sigm(float x) { return __builtin_amdgcn_rcpf(1.f + __expf(-x)); }

DI void phase_inproj(const Prm& p, unsigned char* smem_raw, int l, int S, int& base) {
  const u16* W = p.WinT + (size_t)l * NWP * 1024;
  LAS u16* shm = (LAS u16*)smem_raw;
  bool pre = false;
  TASK_LOOP(t, 32 * 64, base) {
    int tn, tm;
    map256(t, 32, tn, tm);
    const int brow = tn * 256, bcol = tm * 256;
    const int tnx = t + (int)gridDim.x;
    const bool has_next = tnx < (32 * 64);
    int tn2 = 0, tm2 = 0;
    if (has_next) map256(tnx, 32, tn2, tm2);
    const int nbrow = tn2 * 256, nbcol = tm2 * 256;
    auto epi = [&](f32x4 (&acc)[2][2][4][2], int wr, int wc, int fr, int fq) __attribute__((always_inline)) {
#pragma unroll
      for (int ai = 0; ai < 2; ++ai)
#pragma unroll
        for (int m = 0; m < 4; ++m) {
          const int nb = brow + ai * 128 + wr * 64 + m * 16;
#pragma unroll
          for (int bj = 0; bj < 2; ++bj)
#pragma unroll
            for (int n = 0; n < 2; ++n) {
              const int tok = bcol + bj * 128 + wc * 32 + n * 16 + fr;
              const f32x4 v = acc[ai][bj][m][n];
              const int nn = nb + fq * 4;
              if (nb < 1536) {
#pragma unroll
                for (int j = 0; j < 4; ++j) p.UT[(size_t)(nn + j) * TBP + tok] = f2bf(v[j]);
              } else if (nb < 2688) {
                st4bf(p.bqkv + (size_t)tok * 1152 + (nn - 1536), v[0], v[1], v[2], v[3]);
              } else if (nb < 3072) {
                st4bf(p.cu + (size_t)tok * 384 + (nn - 2688), v[0], v[1], v[2], v[3]);
              } else if (nb < 3456) {
#pragma unroll
                for (int j = 0; j < 4; ++j) p.cvT[(size_t)(nn - 3072 + j) * TBP + tok] = f2bf(v[j]);
              } else if (nb < 3840) {
                st4bf(p.dcq + (size_t)tok * 384 + (nn - 3456), v[0], v[1], v[2], v[3]);
              } else if (nb < 4160) {
                st4bf(p.dckv + (size_t)tok * 320 + (nn - 3840), v[0], v[1], v[2], v[3]);
              } else if (nb < 4192) {
                if (nb == 4160) {
                  const f32x4 v2 = acc[ai][bj][(m + 1) & 3][n];
                  const int pos = tok & (S - 1);
#pragma unroll
                  for (int j = 0; j < 4; ++j) {
                    const int ii = fq * 4 + j;
                    const float2 cs = p.rope[pos * 16 + ii];
                    const u16 o1 = f2bf(v[j] * cs.x - v2[j] * cs.y), o2 = f2bf(v[j] * cs.y + v2[j] * cs.x);
#pragma unroll
                    for (int hh = 0; hh < 4; ++hh) {
                      p.kc[(size_t)tok * 384 + hh * 96 + 64 + ii] = o1;
                      p.kc[(size_t)tok * 384 + hh * 96 + 80 + ii] = o2;
                    }
                  }
                }
              } else {
                st4bf_nt(p.zg + (size_t)tok * 4096 + (nn - 4192), sigm(v[0]), sigm(v[1]), sigm(v[2]), sigm(v[3]));
              }
            }
          __builtin_amdgcn_sched_barrier(0);
        }
    };
    gemm256<false>(shm, W, p.hbuf, 1024, brow, bcol, pre, has_next, nbrow, nbcol, epi);
    pre = has_next;
  }
  base += 32 * 64;
}

DI void phase_inproj_tail(const Prm& p, unsigned char* smem_raw, int l, int& base) {
  const u16* W = p.WinT + (size_t)l * NWP * 1024;
  u16* smem = (u16*)smem_raw;
  TASK_LOOP(t, 128, base) {
    const int n0 = 8192, m0 = t * 128;
    auto la = [&](int row, int k) __attribute__((always_inline)) { return *(const u32x4*)(W + (size_t)(n0 + row) * 1024 + k); };
    auto lb = [&](int row, int k) __attribute__((always_inline)) { return *(const u32x4*)(p.hbuf + (size_t)(m0 + row) * 1024 + k); };
    auto epi = [&](f32x16 (&acc)[2], int wm, int wn, int lane) __attribute__((always_inline)) {
      const int lr = lane & 31, lh = lane >> 5;
      const int tok = m0 + wn * 32 + lr;
#pragma unroll
      for (int i = 0; i < 2; ++i) {
        const int nb = n0 + wm * 64 + i * 32;
        if (nb >= NW) continue;
#pragma unroll
        for (int q = 0; q < 4; ++q)
          st4bf(p.zg + (size_t)tok * 4096 + (nb - 4192) + 8 * q + 4 * lh, sigm(acc[i][4 * q]), sigm(acc[i][4 * q + 1]), sigm(acc[i][4 * q + 2]),
                sigm(acc[i][4 * q + 3]));
      }
    };
    gemm_tile2s<false, false>(smem, 16, la, lb, epi);
  }
  base += 128;
}


DI void phase_inproj_probe(const Prm& p, unsigned char* smem_raw, int l, int& base) {
  const u16* W = p.WinT + (size_t)l * NWP * 1024;
  LAS u16* shm = (LAS u16*)smem_raw;
  bool pre = false;
  TASK_LOOP(t, 32 * 64, base) {
    int tn, tm;
    map256(t, 32, tn, tm);
    const int brow = tn * 256, bcol = tm * 256;
    const int tnx = t + (int)gridDim.x;
    const bool has_next = tnx < (32 * 64);
    int tn2 = 0, tm2 = 0;
    if (has_next) map256(tnx, 32, tn2, tm2);
    const int nbrow = tn2 * 256, nbcol = tm2 * 256;
    auto epi = [&](f32x4 (&acc)[2][2][4][2], int wr, int wc, int fr, int fq) __attribute__((always_inline)) {
#pragma unroll
      for (int bj = 0; bj < 2; ++bj)
#pragma unroll
        for (int n = 0; n < 2; ++n) {
          const int tok = bcol + bj * 128 + wc * 32 + n * 16 + fr;
#pragma unroll
          for (int ai = 0; ai < 2; ++ai)
#pragma unroll
            for (int m = 0; m < 4; ++m) {
              const int nn = ((brow + ai * 128 + wr * 64 + m * 16) & 1023) + fq * 4;
              const f32x4 v = acc[ai][bj][m][n];
              st4bf(p.Gp + (size_t)tok * 1024 + nn, v[0], v[1], v[2], v[3]);
            }
        }
    };
    gemm256<false>(shm, W, p.hbuf, 1024, brow, bcol, pre, has_next, nbrow, nbcol, epi);
    pre = has_next;
  }
  base += 32 * 64;
}

DI void phase_fft1(const Prm& p, u16* smem, int S, int nseq, int N1, int lgN1, int& base) {
  const int nkt = N1 == 128 ? 2 : 1;
  const u16* M1 = N1 == 128 ? p.M1a : p.M1b;
  const int ldm = N1 == 128 ? 256 : 64;
  const int nk = N1 == 128 ? 4 : 1;
  const int ntask = nseq * 768 * nkt;
  const int twmul = 16384 / S;
  TASK_LOOP(t, ntask, base) {
    const int k1t = t % nkt, col = (t / nkt) % 768, seq = t / (nkt * 768);
    const int k1base = k1t * 64;
    auto la = [&](int row, int k) __attribute__((always_inline)) {
      const int k1 = k1base + (row >> 6) * 32 + (row & 31), ii = (row >> 5) & 1;
      if (k1 >= N1 || k >= 2 * N1) return zero4();
      return *(const u32x4*)(M1 + (ii * N1 + k1) * ldm + k);
    };
    auto lb = [&](int row, int k) __attribute__((always_inline)) {
      if (k >= 2 * N1) return zero4();
      const int part = k >> lgN1, s1 = k & (N1 - 1);
      const u16* src = p.UT + (size_t)(part * 768 + col) * TBP + seq * S + s1 * 128 + row;
      u32x4 v;
#pragma unroll
      for (int jj = 0; jj < 4; ++jj) v[jj] = (unsigned)src[(2 * jj) * 128] | ((unsigned)src[(2 * jj + 1) * 128] << 16);
      return v;
    };
    auto epi = [&](f32x16 (&acc)[2], int wm, int wn, int lane) __attribute__((always_inline)) {
      const int lr = lane & 31, lh = lane >> 5;
      const int s2 = wn * 32 + lr;
#pragma unroll
      for (int r = 0; r < 16; ++r) {
        const int k1 = k1base + wm * 32 + rowmap(r, lh);
        if (k1 < N1) {
          const float re = acc[0][r], im = acc[1][r];
          const float2 cs = p.tw[(s2 * k1) * twmul];
          const size_t o = ((size_t)((seq * N1 + k1) * 2) * 768 + col) * 128 + s2;
          p.Gp[o] = f2bf(cs.x * re + cs.y * im);
          p.Gp[o + 768 * 128] = f2bf(cs.x * im - cs.y * re);
        }
      }
    };
    gemm_tile2s<false, true>(smem, nk, la, lb, epi);
  }
  base += ntask;
}


DI void phase_fft1_small(const Prm& p, int nseq) {
  constexpr float C16[16] = {1.f, 0.92387953251128674f, 0.70710678118654752f, 0.38268343236508977f, 0.f, -0.38268343236508977f, -0.70710678118654752f,
                             -0.92387953251128674f, -1.f, -0.92387953251128674f, -0.70710678118654752f, -0.38268343236508977f, 0.f,
                             0.38268343236508977f, 0.70710678118654752f, 0.92387953251128674f};
  constexpr float S16[16] = {0.f, 0.38268343236508977f, 0.70710678118654752f, 0.92387953251128674f, 1.f, 0.92387953251128674f, 0.70710678118654752f,
                             0.38268343236508977f, 0.f, -0.38268343236508977f, -0.70710678118654752f, -0.92387953251128674f, -1.f,
                             -0.92387953251128674f, -0.70710678118654752f, -0.38268343236508977f};
  const int gtid = blockIdx.x * NTH + tidx(), gn = gridDim.x * NTH;
  for (int idx = gtid; idx < nseq * 768 * 128; idx += gn) {
    const int s2 = idx & 127, col = (idx >> 7) % 768, seq = idx / (768 * 128);
    const u16* ur = p.UT + (size_t)col * TBP + seq * 2048 + s2;
    const u16* ui = ur + (size_t)768 * TBP;
    float xr[16], xi[16];
#pragma unroll
    for (int s1 = 0; s1 < 16; ++s1) { xr[s1] = bf2f(ur[s1 * 128]); xi[s1] = bf2f(ui[s1 * 128]); }
    u16* go = p.Gp + ((size_t)(seq * 16 * 2) * 768 + col) * 128 + s2;
#pragma unroll
    for (int k1 = 0; k1 < 16; ++k1) {
      float gr = 0.f, gi = 0.f;
#pragma unroll
      for (int s1 = 0; s1 < 16; ++s1) {
        const float c = C16[(k1 * s1) & 15], sn = S16[(k1 * s1) & 15];
        gr += c * xr[s1] + sn * xi[s1];
        gi += c * xi[s1] - sn * xr[s1];
      }
      const float2 cs = p.tw[(s2 * k1) * 8];
      go[(size_t)(k1 * 2) * 768 * 128] = f2bf(cs.x * gr + cs.y * gi);
      go[(size_t)(k1 * 2 + 1) * 768 * 128] = f2bf(cs.x * gi - cs.y * gr);
    }
  }
}

DI void phase_fft2(const Prm& p, u16* smem, int S, int nseq, int N1, int& base) {
  const int ntask = nseq * N1 * 6;
  const float scale = rsqrtf((float)S * 192.f);
  u16* fa = p.UT;
  TASK_LOOP(t, ntask, base) {
    const int ct = t % 6, k1 = (t / 6) % N1, seq = t / (6 * N1);
    const u16* gb = p.Gp + ((size_t)((seq * N1 + k1) * 2) * 768 + ct * 128) * 128;
    auto la = [&](int row, int k) __attribute__((always_inline)) { return *(const u32x4*)(p.M2 + row * 256 + k); };
    auto lb = [&](int row, int k) __attribute__((always_inline)) {
      const int part = k >> 7, s2 = k & 127;
      return *(const u32x4*)(gb + ((size_t)part * 768 + row) * 128 + s2);
    };
    auto epi = [&](f32x16 (&acc)[2], int wm, int wn, int lane) __attribute__((always_inline)) {
      const int lr = lane & 31, lh = lane >> 5;
      const int col = ct * 128 + wn * 32 + lr;
#pragma unroll
      for (int i = 0; i < 2; ++i)
#pragma unroll
        for (int r = 0; r < 16; ++r) {
          const int k2 = wm * 64 + i * 32 + rowmap(r, lh);
          const int tok = seq * S + k1 + N1 * k2;
          fa[(size_t)tok * 768 + col] = f2bf(acc[i][r] * scale);
        }
    };
    gemm_tile2s<false, false>(smem, 4, la, lb, epi);
  }
  base += ntask;
}

DI void phase_mixc(const Prm& p, unsigned char* smem_raw, int l, int& base) {
  u16* smem = (u16*)smem_raw;
  float* st = (float*)(smem_raw + GEMM_SMEM);
  float* red = (float*)smem_raw;
  const int tid = tidx();
  TASK_LOOP(t, 512, base) {
    const int h = t & 3, ch = t >> 2, tok0 = ch * 128;
    {
      const int q = tid & 127, qf = tid >> 7;
      float s = 0.f, ss = 0.f;
      const u16* src = p.cvT + (size_t)(qf * 96) * TBP + tok0 + q;
      for (int c = 0; c < 96; ++c) { const float v = bf2f(src[(size_t)c * TBP]); s += v; ss += v * v; }
      red[qf * 256 + q * 2] = s; red[qf * 256 + q * 2 + 1] = ss;
      __syncthreads();
      if (tid < 128) {
        const float s1 = red[q * 2] + red[256 + q * 2] + red[512 + q * 2] + red[768 + q * 2];
        const float s2 = red[q * 2 + 1] + red[256 + q * 2 + 1] + red[512 + q * 2 + 1] + red[768 + q * 2 + 1];
        const float mu = s1 * (1.f / 384.f);
        const float var = fmaxf(s2 * (1.f / 384.f) - mu * mu, 0.f);
        st[q] = mu; st[128 + q] = rsqrtf(var + 1e-6f);
      }
      __syncthreads();
    }
    const u16* Wm = p.SgW + (size_t)((l * 4 + h) * 128) * 128;
    auto la = [&](int row, int k) __attribute__((always_inline)) { return *(const u32x4*)(Wm + row * 128 + k); };
    auto lb = [&](int row, int k) __attribute__((always_inline)) {
      if (row >= 96) return zero4();
      const int c = h * 96 + row;
      const u32x4 raw = *(const u32x4*)(p.cvT + (size_t)c * TBP + tok0 + k);
      const float g = p.ln_g[l * 384 + c], b = p.ln_b[l * 384 + c];
      u32x4 o;
#pragma unroll
      for (int jj = 0; jj < 4; ++jj) {
        const float v0 = (bflo(raw[jj]) - st[k + 2 * jj]) * st[128 + k + 2 * jj] * g + b;
        const float v1 = (bfhi(raw[jj]) - st[k + 2 * jj + 1]) * st[128 + k + 2 * jj + 1] * g + b;
        o[jj] = pack2(v0, v1);
      }
      return o;
    };
    auto epi = [&](f32x16 (&acc)[2], int wm, int wn, int lane) __attribute__((always_inline)) {
      const int lr = lane & 31, lh = lane >> 5;
      const int cl = wn * 32 + lr;
      if (cl < 96) {
#pragma unroll
        for (int i = 0; i < 2; ++i)
#pragma unroll
          for (int r = 0; r < 16; ++r) {
            const int pp = wm * 64 + i * 32 + rowmap(r, lh);
            const float val = acc[i][r] + p.sgu_b[(l * 4 + h) * 128 + pp];
            u16* dst = p.cu + (size_t)(tok0 + pp) * 384 + h * 96 + cl;
            *dst = f2bf(bf2f(*dst) * val);
          }
      }
    };
    gemm_tile<false, false>(smem, 2, la, lb, epi);
  }
  base += 512;
}

DI void phase_qup(const Prm& p, unsigned char* smem_raw, int l, int S, int& base) {
  u16* smem = (u16*)smem_raw;
  float* st = (float*)(smem_raw + GEMM_SMEM);
  const int tid = tidx();
  const float QS = 0.10206207261596577f * LOG2E;
  TASK_LOOP(t, 3 * 128, base) {
    const int tn = t % 3, tm = t / 3, n0 = tn * 128, m0 = tm * 128;
    {
      const int row = tid >> 2, qf = tid & 3;
      const u16* src = p.dcq + (size_t)(m0 + row) * 384 + qf * 96;
      float ss = 0.f;
#pragma unroll 4
      for (int c = 0; c < 12; ++c) {
        const u32x4 v = *(const u32x4*)(src + c * 8);
#pragma unroll
        for (int jj = 0; jj < 4; ++jj) { const float a = bflo(v[jj]), b = bfhi(v[jj]); ss += a * a + b * b; }
      }
      ss += __shfl_xor(ss, 1);
      ss += __shfl_xor(ss, 2);
      if (qf == 0) st[row] = rsqrtf(ss * (1.f / 384.f) + 1e-6f);
      __syncthreads();
    }
    const u16* W = p.WqT + (size_t)l * 384 * 384;
    auto la = [&](int row, int k) __attribute__((always_inline)) { return *(const u32x4*)(W + (size_t)(n0 + row) * 384 + k); };
    auto lb = [&](int row, int k) __attribute__((always_inline)) { return *(const u32x4*)(p.dcq + (size_t)(m0 + row) * 384 + k); };
    auto epi = [&](f32x16 (&acc)[2], int wm, int wn, int lane) __attribute__((always_inline)) {
      const int lr = lane & 31, lh = lane >> 5;
      const int tokl = wn * 32 + lr, tok = m0 + tokl;
      const float sc = st[tokl] * QS;
#pragma unroll
      for (int i = 0; i < 2; ++i) {
        const int nb = n0 + wm * 64 + i * 32;
        const int head = nb / 96, within = nb - head * 96;
        const f32x16& a = acc[i];
        if (within < 64) {
#pragma unroll
          for (int q = 0; q < 4; ++q)
            st4bf(p.qc + (size_t)tok * 384 + nb + 8 * q + 4 * lh, a[4 * q] * sc, a[4 * q + 1] * sc, a[4 * q + 2] * sc, a[4 * q + 3] * sc);
        } else {
          const int pos = tok & (S - 1);
#pragma unroll
          for (int q = 0; q < 2; ++q)
#pragma unroll
            for (int e = 0; e < 4; ++e) {
              const int r = 4 * q + e, ii = 8 * q + 4 * lh + e;
              const float2 cs = p.rope[pos * 16 + ii];
              const float x1 = a[r] * sc, x2 = a[r + 8] * sc;
              p.qc[(size_t)tok * 384 + head * 96 + 64 + ii] = f2bf(x1 * cs.x - x2 * cs.y);
              p.qc[(size_t)tok * 384 + head * 96 + 80 + ii] = f2bf(x1 * cs.y + x2 * cs.x);
            }
        }
      }
    };
    gemm_tile2s<false, false>(smem, 6, la, lb, epi);
    __syncthreads();
  }
  base += 3 * 128;
}

DI void phase_kvup(const Prm& p, unsigned char* smem_raw, int l, int& base) {
  u16* smem = (u16*)smem_raw;
  float* st = (float*)(smem_raw + GEMM_SMEM);
  const int tid = tidx();
  TASK_LOOP(t, 4 * 128, base) {
    const int tn = t & 3, tm = t >> 2, n0 = tn * 128, m0 = tm * 128;
    {
      const int row = tid >> 2, qf = tid & 3;
      const u16* src = p.dckv + (size_t)(m0 + row) * 320 + qf * 80;
      float ss = 0.f;
#pragma unroll 5
      for (int c = 0; c < 10; ++c) {
        const u32x4 v = *(const u32x4*)(src + c * 8);
#pragma unroll
        for (int jj = 0; jj < 4; ++jj) { const float a = bflo(v[jj]), b = bfhi(v[jj]); ss += a * a + b * b; }
      }
      ss += __shfl_xor(ss, 1);
      ss += __shfl_xor(ss, 2);
      if (qf == 0) st[row] = rsqrtf(ss * (1.f / 320.f) + 1e-6f);
      __syncthreads();
    }
    const u16* W = p.WkvT + (size_t)l * 512 * 320;
    auto la = [&](int row, int k) __attribute__((always_inline)) { return *(const u32x4*)(W + (size_t)(n0 + row) * 320 + k); };
    auto lb = [&](int row, int k) __attribute__((always_inline)) { return *(const u32x4*)(p.dckv + (size_t)(m0 + row) * 320 + k); };
    auto epi = [&](f32x16 (&acc)[2], int wm, int wn, int lane) __attribute__((always_inline)) {
      const int lr = lane & 31, lh = lane >> 5;
      const int head = tn;
      const int tokl = wn * 32 + lr, tok = m0 + tokl;
      const float sc = st[tokl];
#pragma unroll
      for (int i = 0; i < 2; ++i) {
        const int within = wm * 64 + i * 32;
        const f32x16& a = acc[i];
        if (within < 64) {
#pragma unroll
          for (int q = 0; q < 4; ++q)
            st4bf(p.kc + (size_t)tok * 384 + head * 96 + within + 8 * q + 4 * lh, a[4 * q] * sc, a[4 * q + 1] * sc, a[4 * q + 2] * sc, a[4 * q + 3] * sc);
        } else {
#pragma unroll
          for (int r = 0; r < 16; ++r)
            p.vT[(size_t)(head * 64 + within - 64 + rowmap(r, lh)) * TBP + tok] = f2bf(a[r] * sc);
        }
      }
    };
    gemm_tile2s<false, false>(smem, 5, la, lb, epi);
    __syncthreads();
  }
  base += 4 * 128;
}

DI void phase_mixb(const Prm& p, unsigned char* smem_raw, int S, int lgS, int& base) {
  float* bt = (float*)smem_raw;
  const int tid = tidx(), lane = tid & 63, wave = tid >> 6, lr = lane & 31, lh = lane >> 5;
  u16* vt = (u16*)(smem_raw + 3328) + wave * (64 * 40);
  for (int idx = tid; idx < 774; idx += NTH) bt[idx] = p.biasT[idx];
  __syncthreads();
  TASK_LOOP(t, 384, base) {
    const int wt = t * 8 + wave;
    const int hg = wt & 1, g = (wt >> 1) % 3, blk = wt / 6;
    const int seq = blk >> (lgS - 5), b_in = blk & ((S >> 5) - 1);
    const int lgd = 2 * g, L = S >> lgd;
    const int lgbpr = lgS - lgd - 5;
    const int res = b_in >> lgbpr, i0 = (b_in & ((1 << lgbpr) - 1)) << 5;
    const int tokbase = seq * S + res;
    const int hd = g * 2 + hg, hc = hd * 64;
    const int qi = i0 + lr;
    const int qtok = tokbase + (qi << lgd);
    bf16x8 qf[4];
#pragma unroll
    for (int ks = 0; ks < 4; ++ks) qf[ks] = *(const bf16x8*)(p.bqkv + (size_t)qtok * 1152 + hc + ks * 16 + lh * 8);
    f32x16 sc[5];
#pragma unroll
    for (int tt = 0; tt < 5; ++tt) {
      int ik = i0 - 64 + 32 * tt + lr;
      ik = min(max(ik, 0), L - 1);
      const u16* kp = p.bqkv + (size_t)(tokbase + (ik << lgd)) * 1152 + 384 + hc + lh * 8;
      sc[tt] = zero16();
#pragma unroll
      for (int ks = 0; ks < 4; ++ks) sc[tt] = mfma(*(const bf16x8*)(kp + ks * 16), qf[ks], sc[tt]);
    }
    float mx = -1e30f;
#pragma unroll
    for (int tt = 0; tt < 5; ++tt)
#pragma unroll
      for (int r = 0; r < 16; ++r) {
        const int ik = i0 - 64 + 32 * tt + rowmap(r, lh);
        const int rel = ik - qi;
        const bool valid = (rel >= -64) && (rel <= 64) && (ik >= 0) && (ik < L);
        const int bi = min(max(rel + 64, 0), 128);
        const float s = valid ? (sc[tt][r] * 0.125f + bt[hd * 129 + bi]) * LOG2E : -1e30f;
        sc[tt][r] = s;
        mx = fmaxf(mx, s);
      }
    mx = fmaxf(mx, __shfl_xor(mx, 32));
    float sum = 0.f;
#pragma unroll
    for (int tt = 0; tt < 5; ++tt)
#pragma unroll
      for (int r = 0; r < 16; ++r) {
        const float pv = ex2(sc[tt][r] - mx);
        sum += pv;
        sc[tt][r] = pv;
      }
    sum += __shfl_xor(sum, 32);
    f32x16 oacc[2];
    oacc[0] = zero16(); oacc[1] = zero16();
#pragma unroll
    for (int tt = 0; tt < 5; ++tt) {
#pragma unroll
      for (int e = 0; e < 4; ++e) {
        const int c = lane + 64 * e, key = c >> 3, dch = c & 7;
        int ik = i0 - 64 + 32 * tt + key;
        ik = min(max(ik, 0), L - 1);
        const u32x4 raw = *(const u32x4*)(p.bqkv + (size_t)(tokbase + (ik << lgd)) * 1152 + 768 + hc + dch * 8);
#pragma unroll
        for (int jj = 0; jj < 4; ++jj) {
          vt[(dch * 8 + 2 * jj) * 40 + key] = (u16)(raw[jj] & 0xffffu);
          vt[(dch * 8 + 2 * jj + 1) * 40 + key] = (u16)(raw[jj] >> 16);
        }
      }
      __syncthreads();
#pragma unroll
      for (int u = 0; u < 2; ++u) {
        u32x4 pk;
#pragma unroll
        for (int jj = 0; jj < 4; ++jj) pk[jj] = pack2(sc[tt][8 * u + 2 * jj], sc[tt][8 * u + 2 * jj + 1]);
        const bf16x8 pf = __builtin_bit_cast(bf16x8, pk);
#pragma unroll
        for (int dt = 0; dt < 2; ++dt) {
          const u16* vp = vt + (dt * 32 + lr) * 40 + 16 * u + 4 * lh;
          u32x4 vv;
          const u32x2 lo = *(const u32x2*)vp, hi = *(const u32x2*)(vp + 8);
          vv[0] = lo[0]; vv[1] = lo[1]; vv[2] = hi[0]; vv[3] = hi[1];
          oacc[dt] = mfma(__builtin_bit_cast(bf16x8, vv), pf, oacc[dt]);
        }
      }
      __syncthreads();
    }
    const float inv = 1.f / sum;
#pragma unroll
    for (int dt = 0; dt < 2; ++dt)
#pragma unroll
      for (int q = 0; q < 4; ++q) {
        float4 o;
        o.x = oacc[dt][4 * q] * inv; o.y = oacc[dt][4 * q + 1] * inv; o.z = oacc[dt][4 * q + 2] * inv; o.w = oacc[dt][4 * q + 3] * inv;
        *(float4*)(p.og + (size_t)qtok * 384 + hc + dt * 32 + 8 * q + 4 * lh) = o;
      }
    if (lh == 0) p.lse[(size_t)qtok * 6 + hd] = (mx + __log2f(sum)) * LN2;
  }
  base += 384;
  __syncthreads();
}

DI void phase_combb(const Prm& p) {
  const int gtid = blockIdx.x * NTH + tidx(), gn = gridDim.x * NTH;
  for (int idx = gtid; idx < TB * 32; idx += gn) {
    const int dq = idx & 15, hg = (idx >> 4) & 1, tok = idx >> 5;
    const float l0 = p.lse[(size_t)tok * 6 + hg], l1 = p.lse[(size_t)tok * 6 + 2 + hg], l2 = p.lse[(size_t)tok * 6 + 4 + hg];
    const float mx = fmaxf(l0, fmaxf(l1, l2));
    const float e0 = __expf(l0 - mx), e1 = __expf(l1 - mx), e2 = __expf(l2 - mx);
    const float inv = 1.f / (e0 + e1 + e2);
    const float4 a = *(const float4*)(p.og + (size_t)tok * 384 + hg * 64 + dq * 4);
    const float4 b = *(const float4*)(p.og + (size_t)tok * 384 + 128 + hg * 64 + dq * 4);
    const float4 c = *(const float4*)(p.og + (size_t)tok * 384 + 256 + hg * 64 + dq * 4);
    st4bf(p.ob + (size_t)tok * 128 + hg * 64 + dq * 4, (e0 * a.x + e1 * b.x + e2 * c.x) * inv, (e0 * a.y + e1 * b.y + e2 * c.y) * inv,
          (e0 * a.z + e1 * b.z + e2 * c.z) * inv, (e0 * a.w + e1 * b.w + e2 * c.w) * inv);
  }
}

constexpr int KS_ELEMS = 128 * 104, VS_ELEMS = 64 * 136;
DI void phase_mla(const Prm& p, unsigned char* smem_raw, int S, int lgS, int& base) {
  u16* Ks = (u16*)smem_raw;
  u16* Vs = Ks + 2 * KS_ELEMS;
  const int tid = tidx(), lane = tid & 63, wave = tid >> 6, lr = lane & 31, lh = lane >> 5;
  const int nkt = S >> 7;
  TASK_LOOP(t, 256, base) {
    const int head = t & 3, qb = t >> 2, tok0 = qb * 256;
    const int seqtok0 = (tok0 >> lgS) << lgS;
    const int qtok = tok0 + wave * 32 + lr;
    bf16x8 qf[6];
#pragma unroll
    for (int ks = 0; ks < 6; ++ks) qf[ks] = *(const bf16x8*)(p.qc + (size_t)qtok * 384 + head * 96 + ks * 16 + lh * 8);
    const u16* kbase = p.kc + (size_t)seqtok0 * 384 + head * 96;
    const u16* vbase = p.vT + (size_t)(head * 64) * TBP + seqtok0;
    u32x4 rk[3], rv[2];
    auto gload = [&](int kt) __attribute__((always_inline)) {
#pragma unroll
      for (int e = 0; e < 3; ++e) {
        const int c = tid + NTH * e, key = c / 12, dc = c - key * 12;
        rk[e] = *(const u32x4*)(kbase + (size_t)(kt * 128 + key) * 384 + dc * 8);
      }
#pragma unroll
      for (int e = 0; e < 2; ++e) {
        const int c = tid + NTH * e, d = c >> 4, kch = c & 15;
        rv[e] = *(const u32x4*)(vbase + (size_t)d * TBP + kt * 128 + kch * 8);
      }
    };
    auto sstore = [&](int buf) __attribute__((always_inline)) {
#pragma unroll
      for (int e = 0; e < 3; ++e) {
        const int c = tid + NTH * e, key = c / 12, dc = c - key * 12;
        *(u32x4*)(Ks + buf * KS_ELEMS + key * 104 + dc * 8) = rk[e];
      }
#pragma unroll
      for (int e = 0; e < 2; ++e) {
        const int c = tid + NTH * e, d = c >> 4, kch = c & 15;
        u16* vd = Vs + buf * VS_ELEMS + d * 136 + (kch >> 1) * 16 + (kch & 1) * 4;
        u32x2 lo, hi;
        lo[0] = rv[e][0]; lo[1] = rv[e][1]; hi[0] = rv[e][2]; hi[1] = rv[e][3];
        *(u32x2*)vd = lo;
        *(u32x2*)(vd + 8) = hi;
      }
    };
    float m = -1e30f;
    f32x2 lsum2 = {0.f, 0.f};
    f32x16 oacc[2];
    oacc[0] = zero16(); oacc[1] = zero16();
    gload(0);
    sstore(0);
    __syncthreads();
    for (int kt = 0; kt < nkt; ++kt) {
      const int buf = kt & 1;
      if (kt + 1 < nkt) gload(kt + 1);
      f32x16 s[4];
#pragma unroll
      for (int kk = 0; kk < 4; ++kk) s[kk] = zero16();
      {
        const u16* kp = Ks + buf * KS_ELEMS + lr * 104 + lh * 8;
        bf16x8 kf[4];
#pragma unroll
        for (int kk = 0; kk < 4; ++kk) kf[kk] = *(const bf16x8*)(kp + kk * 32 * 104);
#pragma unroll
        for (int ks = 0; ks < 6; ++ks) {
          bf16x8 kn[4];
          if (ks < 5) {
#pragma unroll
            for (int kk = 0; kk < 4; ++kk) kn[kk] = *(const bf16x8*)(kp + kk * 32 * 104 + (ks + 1) * 16);
          }
#pragma unroll
          for (int kk = 0; kk < 4; ++kk) s[kk] = mfma(kf[kk], qf[ks], s[kk]);
          if (ks < 5) {
#pragma unroll
            for (int kk = 0; kk < 4; ++kk) kf[kk] = kn[kk];
          }
        }
      }
      float mloc = -1e30f;
#pragma unroll
      for (int kk = 0; kk < 4; ++kk)
#pragma unroll
        for (int r = 0; r < 16; ++r) mloc = fmaxf(mloc, s[kk][r]);
      mloc = fmaxf(mloc, __shfl_xor(mloc, 32));
      const float mnew = fmaxf(m, mloc);
      const float alpha = ex2(m - mnew);
      m = mnew;
      lsum2 *= alpha;
      const f32x2 mn2 = {mnew, mnew};
#pragma unroll
      for (int kk = 0; kk < 4; ++kk)
#pragma unroll
        for (int r2 = 0; r2 < 8; ++r2) {
          f32x2 v = {s[kk][2 * r2], s[kk][2 * r2 + 1]};
          v = v - mn2;
          f32x2 pv;
          pv[0] = ex2(v[0]); pv[1] = ex2(v[1]);
          lsum2 += pv;
          s[kk][2 * r2] = pv[0]; s[kk][2 * r2 + 1] = pv[1];
        }
#pragma unroll
      for (int dt = 0; dt < 2; ++dt)
#pragma unroll
        for (int r = 0; r < 16; ++r) oacc[dt][r] *= alpha;
#pragma unroll
      for (int kk = 0; kk < 4; ++kk)
#pragma unroll
        for (int u = 0; u < 2; ++u) {
          u32x4 pk;
#pragma unroll
          for (int jj = 0; jj < 4; ++jj) pk[jj] = pack2(s[kk][8 * u + 2 * jj], s[kk][8 * u + 2 * jj + 1]);
          const bf16x8 pf = __builtin_bit_cast(bf16x8, pk);
#pragma unroll
          for (int dt = 0; dt < 2; ++dt) {
            const u16* vp = Vs + buf * VS_ELEMS + (dt * 32 + lr) * 136 + kk * 32 + 16 * u + 8 * lh;
            oacc[dt] = mfma(*(const bf16x8*)vp, pf, oacc[dt]);
          }
        }
      if (kt + 1 < nkt) sstore(buf ^ 1);
      __syncthreads();
    }
    float lsum = lsum2[0] + lsum2[1];
    lsum += __shfl_xor(lsum, 32);
    const float inv = 1.f / lsum;
#pragma unroll
    for (int dt = 0; dt < 2; ++dt)
#pragma unroll
      for (int q = 0; q < 4; ++q)
        st4bf(p.od + (size_t)qtok * 256 + head * 64 + dt * 32 + 8 * q + 4 * lh, oacc[dt][4 * q] * inv, oacc[dt][4 * q + 1] * inv,
              oacc[dt][4 * q + 2] * inv, oacc[dt][4 * q + 3] * inv);
  }
  base += 256;
}

template <class ACC>
DI void merge_branch(const Prm& p, u16* smem, const u16* W, const u16* X, int ld, int bi, int n0, int m0, ACC& macc) {
  auto la = [&](int row, int k) __attribute__((always_inline)) { return *(const u32x4*)(W + (size_t)(n0 + row) * ld + k); };
  auto lb = [&](int row, int k) __attribute__((always_inline)) { return *(const u32x4*)(X + (size_t)(m0 + row) * ld + k); };
  auto epi = [&](f32x16 (&acc)[2], int wm, int wn, int lane) __attribute__((always_inline)) {
    const int lr = lane & 31, lh = lane >> 5;
    const int tok = m0 + wn * 32 + lr;
#pragma unroll
    for (int i = 0; i < 2; ++i)
#pragma unroll
      for (int q = 0; q < 4; ++q) {
        const int n = n0 + wm * 64 + i * 32 + 8 * q + 4 * lh;
        const u32x2 gz = *(const u32x2*)(p.zg + (size_t)tok * 4096 + bi * 1024 + n);
        macc[i][4 * q] += bflo(gz[0]) * acc[i][4 * q];
        macc[i][4 * q + 1] += bfhi(gz[0]) * acc[i][4 * q + 1];
        macc[i][4 * q + 2] += bflo(gz[1]) * acc[i][4 * q + 2];
        macc[i][4 * q + 3] += bfhi(gz[1]) * acc[i][4 * q + 3];
      }
  };
  gemm_tile2s<false, false>(smem, ld >> 6, la, lb, epi);
}

DI void phase_merge(const Prm& p, u16* smem, int l, int& base) {
  TASK_LOOP(t, 8 * 128, base) {
    const int tn = t & 7, tm = t >> 3, n0 = tn * 128, m0 = tm * 128;
    f32x16 macc[2];
    macc[0] = zero16(); macc[1] = zero16();
    merge_branch(p, smem, p.PaT + (size_t)l * 1024 * 768, p.UT, 768, 0, n0, m0, macc);
    merge_branch(p, smem, p.PbT + (size_t)l * 1024 * 128, p.ob, 128, 1, n0, m0, macc);
    merge_branch(p, smem, p.PcT + (size_t)l * 1024 * 384, p.cu, 384, 2, n0, m0, macc);
    merge_branch(p, smem, p.PdT + (size_t)l * 1024 * 256, p.od, 256, 3, n0, m0, macc);
    const int tid2 = tidx(), lane = tid2 & 63, wave = tid2 >> 6, wm = wave >> 2, wn = wave & 3, lr = lane & 31, lh = lane >> 5;
    const int tok = m0 + wn * 32 + lr;
#pragma unroll
    for (int i = 0; i < 2; ++i)
#pragma unroll
      for (int q = 0; q < 4; ++q)
        st4bf(p.hbuf + (size_t)tok * 1024 + n0 + wm * 64 + i * 32 + 8 * q + 4 * lh, macc[i][4 * q], macc[i][4 * q + 1],
              macc[i][4 * q + 2], macc[i][4 * q + 3]);
  }
  base += 8 * 128;
}

DI void phase_resid_gemm(const Prm& p, unsigned char* smem_raw, const u16* W, const u16* X, int K, const float* xsrc, float* xdst,
                         const float* modl, int gtoff, int sb, int& base) {
  LAS u16* shm = (LAS u16*)smem_raw;
  bool pre = false;
  TASK_LOOP(t, 4 * 64, base) {
    int tn, tm;
    map256(t, 4, tn, tm);
    const int brow = tn * 256, bcol = tm * 256;
    const int tnx = t + (int)gridDim.x;
    const bool has_next = tnx < (4 * 64);
    int tn2 = 0, tm2 = 0;
    if (has_next) map256(tnx, 4, tn2, tm2);
    const int nbrow = tn2 * 256, nbcol = tm2 * 256;
    auto epi = [&](f32x4 (&acc)[2][2][4][2], int wr, int wc, int fr, int fq) __attribute__((always_inline)) {
#pragma unroll
      for (int bj = 0; bj < 2; ++bj)
#pragma unroll
        for (int n = 0; n < 2; ++n) {
          const int tok = bcol + bj * 128 + wc * 32 + n * 16 + fr;
          const float* gt = modl + condrow(sb, tok) * 6144 + gtoff;
#pragma unroll
          for (int ai = 0; ai < 2; ++ai)
#pragma unroll
            for (int m = 0; m < 4; ++m) {
              const int nn = brow + ai * 128 + wr * 64 + m * 16 + fq * 4;
              const f32x4 v = acc[ai][bj][m][n];
              const float4 g4 = *(const float4*)(gt + nn);
              const float4 xi = *(const float4*)(xsrc + (size_t)tok * 1024 + nn);
              float4 o;
              o.x = xi.x + g4.x * v[0]; o.y = xi.y + g4.y * v[1]; o.z = xi.z + g4.z * v[2]; o.w = xi.w + g4.w * v[3];
              *(float4*)(xdst + (size_t)tok * 1024 + nn) = o;
            }
        }
    };
    gemm256<false>(shm, W, X, K, brow, bcol, pre, has_next, nbrow, nbcol, epi);
    pre = has_next;
  }
  base += 4 * 64;
}

DI void phase_w1(const Prm& p, unsigned char* smem_raw, int l, int& base) {
  const u16* W = p.W1T + (size_t)l * 4096 * 1024;
  LAS u16* shm = (LAS u16*)smem_raw;
  bool pre = false;
  TASK_LOOP(t, 16 * 64, base) {
    int tn, tm;
    map256(t, 16, tn, tm);
    const int brow = tn * 256, bcol = tm * 256;
    const int tnx = t + (int)gridDim.x;
    const bool has_next = tnx < (16 * 64);
    int tn2 = 0, tm2 = 0;
    if (has_next) map256(tnx, 16, tn2, tm2);
    const int nbrow = tn2 * 256, nbcol = tm2 * 256;
    auto epi = [&](f32x4 (&acc)[2][2][4][2], int wr, int wc, int fr, int fq) __attribute__((always_inline)) {
#pragma unroll
      for (int bj = 0; bj < 2; ++bj)
#pragma unroll
        for (int n = 0; n < 2; ++n) {
          const int tok = bcol + bj * 128 + wc * 32 + n * 16 + fr;
#pragma unroll
          for (int ai = 0; ai < 2; ++ai)
#pragma unroll
            for (int mp = 0; mp < 2; ++mp) {
              const int nn = brow + ai * 128 + wr * 64 + mp * 32 + fq * 8;
              const f32x4 v = acc[ai][bj][2 * mp][n], w = acc[ai][bj][2 * mp + 1][n];
              const float a0 = fmaxf(v[0], 0.f), a1 = fmaxf(v[1], 0.f), a2 = fmaxf(v[2], 0.f), a3 = fmaxf(v[3], 0.f);
              const float b0 = fmaxf(w[0], 0.f), b1 = fmaxf(w[1], 0.f), b2 = fmaxf(w[2], 0.f), b3 = fmaxf(w[3], 0.f);
              u32x4 o;
              o[0] = pack2(a0 * a0, a1 * a1); o[1] = pack2(a2 * a2, a3 * a3); o[2] = pack2(b0 * b0, b1 * b1); o[3] = pack2(b2 * b2, b3 * b3);
              *(u32x4*)(p.zg + (size_t)tok * 4096 + nn) = o;
            }
        }
    };
    gemm256<true>(shm, W, p.hbuf, 1024, brow, bcol, pre, has_next, nbrow, nbcol, epi);
    pre = has_next;
  }
  base += 16 * 64;
}

DI void phase_final(const Prm& p) {
  const int tid = tidx(), lane = tid & 63;
  const int gw = blockIdx.x * 8 + (tid >> 6), nw = gridDim.x * 8;
  for (int row = gw; row < 3 * TB; row += nw) {
    float* xr = p.out + (size_t)row * 1024;
    float4 v[4];
    float ss = 0.f;
#pragma unroll
    for (int i = 0; i < 4; ++i) {
      v[i] = *(const float4*)(xr + i * 256 + lane * 4);
      ss += v[i].x * v[i].x + v[i].y * v[i].y + v[i].z * v[i].z + v[i].w * v[i].w;
    }
#pragma unroll
    for (int off = 32; off >= 1; off >>= 1) ss += __shfl_xor(ss, off);
    const float rstd = rsqrtf(ss * (1.f / 1024.f) + 1e-6f);
#pragma unroll
    for (int i = 0; i < 4; ++i) {
      const int col = i * 256 + lane * 4;
      const float4 gg = *(const float4*)(p.final_g + col);
      float4 o;
      o.x = v[i].x * rstd * gg.x; o.y = v[i].y * rstd * gg.y; o.z = v[i].z * rstd * gg.z; o.w = v[i].w * rstd * gg.w;
      *(float4*)(xr + col) = o;
    }
  }
}

__global__ void __launch_bounds__(512) mega(Prm p) {
  cg::grid_group grid = cg::this_grid();
  __shared__ __attribute__((aligned(16))) unsigned char smem_raw[SMEM_BYTES];
  __shared__ uint4 xb_words;
  u16* smem = (u16*)smem_raw;
  if (threadIdx.x == 0) xb_words = make_uint4(0u, 0u, 0u, 0u);
  __syncthreads();
  const XcdBarrier xb = xcd_barrier_post(p.bar, (volatile LAS unsigned*)&xb_words);
  int base = 0;
  prologue_a(p, smem_raw, base);
  if (PROBE == 11) prologue_a(p, smem_raw, base);
  grid.sync();
  prologue_b(p);
  xcd_barrier(xb);
  for (int sb = 0; sb < 3; ++sb) {
    const int S = sb == 0 ? 16384 : 2048, lgS = sb == 0 ? 14 : 11, nseq = sb == 0 ? 1 : 8;
    const int N1 = S >> 7, lgN1 = lgS - 7;
    const float* xin = sb == 0 ? p.x_prompt : p.x_sample + (size_t)(sb - 1) * TB * 1024;
    float* xo = p.out + (size_t)sb * TB * 1024;
    for (int l = 0; l < 4; ++l) {
      const float* xs = l == 0 ? xin : xo;
      const float* modl = p.mod + (size_t)l * 17 * 6144;
      phase_norm(p, xs, p.norm1_g + l * 1024, modl, 0, 1024, sb);
      xcd_barrier(xb);
      phase_inproj(p, smem_raw, l, S, base);
      if (PROBE == 2 || PROBE == 7) phase_inproj(p, smem_raw, l, S, base);
      if (PROBE == 12) phase_inproj_probe(p, smem_raw, l, base);
      xcd_barrier(xb);
      if (PROBE == 5) xcd_barrier(xb);
      if (N1 == 16) phase_fft1_small(p, nseq); else phase_fft1(p, smem, S, nseq, N1, lgN1, base);
      phase_mixb(p, smem_raw, S, lgS, base);
      phase_mixc(p, smem_raw, l, base);
      phase_qup(p, smem_raw, l, S, base);
      phase_kvup(p, smem_raw, l, base);
      phase_inproj_tail(p, smem_raw, l, base);
      if (PROBE == 13) phase_fft1(p, smem, S, nseq, N1, lgN1, base);
      if (PROBE == 14) phase_mixb(p, smem_raw, S, lgS, base);
      if (PROBE == 15) { phase_qup(p, smem_raw, l, S, base); phase_kvup(p, smem_raw, l, base); phase_inproj_tail(p, smem_raw, l, base); }
      if (PROBE == 4) { phase_fft1(p, smem, S, nseq, N1, lgN1, base); phase_mixb(p, smem_raw, S, lgS, base); phase_qup(p, smem_raw, l, S, base); phase_kvup(p, smem_raw, l, base); }
      xcd_barrier(xb);
      if (PROBE == 5) xcd_barrier(xb);
      phase_mla(p, smem_raw, S, lgS, base);
      if (PROBE == 1) phase_mla(p, smem_raw, S, lgS, base);
      phase_fft2(p, smem, S, nseq, N1, base);
      phase_combb(p);
      if (PROBE == 6) { phase_fft2(p, smem, S, nseq, N1, base); phase_combb(p); }
      xcd_barrier(xb);
      if (PROBE == 5) xcd_barrier(xb);
      phase_merge(p, smem, l, base);
      if (PROBE == 3) phase_merge(p, smem, l, base);
      xcd_barrier(xb);
      if (PROBE == 5) xcd_barrier(xb);
      phase_resid_gemm(p, smem_raw, p.WoT + (size_t)l * 1024 * 1024, p.hbuf, 1024, xs, xo, modl, 2048, sb, base);
      xcd_barrier(xb);
      phase_norm(p, xo, p.norm2_g + l * 1024, modl, 3072, 4096, sb);
      if (PROBE == 9) { phase_norm(p, xo, p.norm2_g + l * 1024, modl, 3072, 4096, sb); phase_norm(p, xo, p.norm2_g + l * 1024, modl, 3072, 4096, sb); }
      xcd_barrier(xb);
      phase_w1(p, smem_raw, l, base);
      if (PROBE == 2 || PROBE == 8) phase_w1(p, smem_raw, l, base);
      xcd_barrier(xb);
      if (PROBE == 5) xcd_barrier(xb);
      phase_resid_gemm(p, smem_raw, p.W2T + (size_t)l * 1024 * 4096, p.zg, 4096, xo, xo, modl, 5120, sb, base);
      xcd_barrier(xb);
    }
  }
  phase_final(p);
}

extern "C" void kernel_launch(void* const* d_in, const int* in_sizes, int n_in, void* d_out, int out_size, void* d_ws, size_t ws_size,
                              hipStream_t stream) {
  Prm p{};
  const float* const* in = (const float* const*)d_in;
  p.x_prompt = in[0]; p.x_sample = in[1]; p.c_prompt = in[2]; p.c_sample = in[3]; p.rel_bias = in[4]; p.ada_w = in[5]; p.ada_b = in[6];
  p.norm1_g = in[7]; p.w_in = in[8]; p.qn_g = in[9]; p.kvn_g = in[10]; p.w_uq = in[11]; p.w_ukv = in[12]; p.ln_g = in[13]; p.ln_b = in[14];
  p.sgu_w = in[15]; p.sgu_b = in[16]; p.p_a = in[17]; p.p_b = in[18]; p.p_c = in[19]; p.p_d = in[20]; p.w_o = in[21]; p.norm2_g = in[22];
  p.w1 = in[23]; p.w2 = in[24]; p.final_g = in[25];
  p.out = (float*)d_out;
  char* w = (char*)d_ws;
  size_t off = 0;
  auto take = [&](size_t bytes) __attribute__((always_inline)) { void* r = w + off; off += (bytes + 255) & ~(size_t)255; return r; };
  p.WinT = (u16*)take((size_t)4 * NWP * 1024 * 2);
  p.W1T = (u16*)take((size_t)4 * 4096 * 1024 * 2);
  p.W2T = (u16*)take((size_t)4 * 4096 * 1024 * 2);
  p.WoT = (u16*)take((size_t)4 * 1024 * 1024 * 2);
  p.PaT = (u16*)take((size_t)4 * 1024 * 768 * 2);
  p.PbT = (u16*)take((size_t)4 * 1024 * 128 * 2);
  p.PcT = (u16*)take((size_t)4 * 1024 * 384 * 2);
  p.PdT = (u16*)take((size_t)4 * 1024 * 256 * 2);
  p.WqT = (u16*)take((size_t)4 * 384 * 384 * 2);
  p.WkvT = (u16*)take((size_t)4 * 512 * 320 * 2);
  p.SgW = (u16*)take((size_t)4 * 4 * 128 * 128 * 2);
  p.M1a = (u16*)take(256 * 256 * 2);
  p.M1b = (u16*)take(32 * 64 * 2);
  p.M2 = (u16*)take(128 * 256 * 2);
  p.tw = (float2*)take(16384 * 8);
  p.rope = (float2*)take((size_t)16384 * 16 * 8);
  p.biasT = (float*)take(6 * 129 * 4);
  p.mod = (float*)take((size_t)4 * 17 * 6144 * 4);
  p.hbuf = (u16*)take((size_t)TB * 1024 * 2);
  p.og = (float*)take((size_t)TB * 384 * 4);
  p.UT = (u16*)take((size_t)1536 * TBP * 2);
  p.Gp = (u16*)take((size_t)1536 * TB * 2);
  p.bqkv = (u16*)take((size_t)TB * 1152 * 2);
  p.ob = (u16*)take((size_t)TB * 128 * 2);
  p.cu = (u16*)take((size_t)TB * 384 * 2);
  p.cvT = (u16*)take((size_t)TBP * 384 * 2);
  p.dcq = (u16*)take((size_t)TB * 384 * 2);
  p.dckv = (u16*)take((size_t)TB * 320 * 2);
  p.qc = (u16*)take((size_t)TB * 384 * 2);
  p.kc = (u16*)take((size_t)TB * 384 * 2);
  p.vT = (u16*)take((size_t)TBP * 256 * 2);
  p.od = (u16*)take((size_t)TB * 256 * 2);
  p.lse = (float*)take((size_t)TB * 6 * 4);
  p.zg = (u16*)take((size_t)TB * 4096 * 2);
  p.bar = (unsigned*)take(XCD_BAR_WORDS * 4);
  p.modpart = (float*)p.zg;
  if (off > ws_size) { fprintf(stderr, "workspace too small: need %zu have %zu\n", off, ws_size); return; }
  static int grid_blocks = 0;
  if (!grid_blocks) {
    int dev = 0, cus = 0, per_cu = 0;
    (void)hipGetDevice(&dev);
    (void)hipDeviceGetAttribute(&cus, hipDeviceAttributeMultiprocessorCount, dev);
    (void)hipOccupancyMaxActiveBlocksPerMultiprocessor(&per_cu, mega, NTH, 0);
    if (per_cu < 1) per_cu = 1;
    if (per_cu > 1) per_cu = 1;
    grid_blocks = cus * per_cu;
  }
  (void)hipMemsetAsync(p.bar, 0, XCD_BAR_WORDS * 4, stream);
  void* args[] = {&p};
  hipError_t e = hipLaunchCooperativeKernel((void*)mega, dim3(grid_blocks), dim3(NTH), args, 0, stream);
  if (e != hipSuccess) fprintf(stderr, "cooperative launch failed: %s (grid %d)\n", hipGetErrorString(e), grid_blocks);
}
```

```cpp
#include <hip/hip_runtime.h>
#include <hip/hip_cooperative_groups.h>
#include <stdint.h>
#include <stdio.h>
namespace cg = cooperative_groups;

#define DI __device__ __forceinline__
#define LAS __attribute__((address_space(3)))
typedef unsigned short u16;
typedef __attribute__((ext_vector_type(8))) short bf16x8;
typedef __attribute__((ext_vector_type(4))) short bf16x4;
typedef __attribute__((ext_vector_type(16))) float f32x16;
typedef __attribute__((ext_vector_type(4))) float f32x4;
typedef __attribute__((ext_vector_type(2))) float f32x2;
typedef __attribute__((ext_vector_type(4))) unsigned u32x4;
typedef __attribute__((ext_vector_type(2))) unsigned u32x2;
typedef __attribute__((ext_vector_type(2))) __bf16 bf2_t;

constexpr int TB = 16384;
constexpr int TBP = TB + 64;
constexpr int NW = 8288;
constexpr int NWP = 8320;
constexpr int LDT = 72;
constexpr int TILE_ELEMS = 128 * LDT;
constexpr int GEMM_SMEM = 4 * TILE_ELEMS * 2;
constexpr int SMEM_BYTES = 131072;
#ifndef PROBE
#define PROBE 0
#endif
constexpr int NTH = 512;
constexpr int HT = 128 * 64;
constexpr float LOG2E = 1.4426950408889634f;
constexpr float LN2 = 0.6931471805599453f;

struct Prm {
  const float *x_prompt, *x_sample, *c_prompt, *c_sample, *rel_bias, *ada_w, *ada_b, *norm1_g, *w_in,
      *qn_g, *kvn_g, *w_uq, *w_ukv, *ln_g, *ln_b, *sgu_w, *sgu_b, *p_a, *p_b, *p_c, *p_d, *w_o,
      *norm2_g, *w1, *w2, *final_g;
  float* out;
  u16 *WinT, *W1T, *W2T, *WoT, *PaT, *PbT, *PcT, *PdT, *WqT, *WkvT, *SgW, *M1a, *M1b, *M2;
  float2 *tw, *rope;
  float *biasT, *mod, *modpart;
  u16 *hbuf, *UT, *Gp, *bqkv, *ob, *cu, *cvT, *dcq, *dckv, *qc, *kc, *vT, *od, *zg;
  float *og, *lse;
  unsigned* bar;
};

DI unsigned pack2(float a, float b) { bf2_t v; v[0] = (__bf16)a; v[1] = (__bf16)b; return __builtin_bit_cast(unsigned, v); }
DI u16 f2bf(float a) { return __builtin_bit_cast(u16, (__bf16)a); }
DI float bf2f(u16 v) { return __uint_as_float(((unsigned)v) << 16); }
DI float bflo(unsigned w) { return __uint_as_float(w << 16); }
DI float bfhi(unsigned w) { return __uint_as_float(w & 0xffff0000u); }
DI void st4bf(u16* dst, float a, float b, float c, float d) { u32x2 v; v[0] = pack2(a, b); v[1] = pack2(c, d); *(u32x2*)dst = v; }
DI void st4bf_nt(u16* dst, float a, float b, float c, float d) { u32x2 v; v[0] = pack2(a, b); v[1] = pack2(c, d); __builtin_nontemporal_store(v, (u32x2*)dst); }
DI void st8bf(u16* dst, const f32x4& a, const f32x4& b) { u32x4 o; o[0] = pack2(a[0], a[1]); o[1] = pack2(a[2], a[3]); o[2] = pack2(b[0], b[1]); o[3] = pack2(b[2], b[3]); *(u32x4*)dst = o; }
DI int rowmap(int r, int lh) { return (r & 3) + 8 * (r >> 2) + 4 * lh; }
DI f32x16 mfma(bf16x8 a, bf16x8 b, f32x16 c) { return __builtin_amdgcn_mfma_f32_32x32x16_bf16(a, b, c, 0, 0, 0); }
DI u32x4 zero4() { u32x4 z; z[0] = 0; z[1] = 0; z[2] = 0; z[3] = 0; return z; }
DI f32x16 zero16() { f32x16 z; for (int i = 0; i < 16; ++i) z[i] = 0.f; return z; }
DI float ex2(float x) { return __builtin_amdgcn_exp2f(x); }
DI int tidx() { int t = threadIdx.x; asm volatile("" : "+v"(t)); return t; }


#define XB_TMO      128
#define XB_XCNT(j)  (256  + 64 * (j))
#define XB_XSUB(j)  (1280 + 64 * (j))
#define XB_XGEN(j)  (2304 + 64 * (j))
#define XB_TOP      3328
#define XB_TOPGEN   3392
#define XCD_BAR_WORDS 3456
#define XB_SPIN_CAP (1u << 18)
DI unsigned xb_ld(unsigned* p) { return __hip_atomic_load(p, __ATOMIC_RELAXED, __HIP_MEMORY_SCOPE_AGENT); }
DI unsigned xb_add(unsigned* p, unsigned v) { return __hip_atomic_fetch_add(p, v, __ATOMIC_RELAXED, __HIP_MEMORY_SCOPE_AGENT); }
DI unsigned xb_xcc_id() { return (unsigned)__builtin_amdgcn_s_getreg((3 << 11) | 20) & 0xFu; }
#define XB_SPIN(cond, bar) do { unsigned _sp = 0; while (cond) { __builtin_amdgcn_s_sleep(1); \
    if ((++_sp & 255u) == 0u) { if (xb_ld(&(bar)[XB_TMO])) break; if (_sp > XB_SPIN_CAP) { atomicAdd(&(bar)[XB_TMO], 1u); break; } } } } while (0)
struct XcdBarrier { unsigned* bar; unsigned x; volatile LAS unsigned* st; };
DI XcdBarrier xcd_barrier_post(unsigned* bar, volatile LAS unsigned* st) {
  XcdBarrier b; b.bar = bar; b.x = xb_xcc_id(); b.st = st;
  if (threadIdx.x == 0) (void)xb_add(&bar[XB_XCNT(b.x)], 1u);
  return b;
}
DI void xcd_barrier_complete(unsigned* bar, unsigned x, unsigned& nloc, unsigned& nx) {
  const unsigned G = gridDim.x * gridDim.y * gridDim.z;
  unsigned sum, cnt, mine, sp = 0u;
  for (;;) {
    sum = 0u; cnt = 0u; mine = 0u;
#pragma unroll
    for (unsigned j = 0; j < 16; ++j) { const unsigned c = xb_ld(&bar[XB_XCNT(j)]); sum += c; cnt += (c > 0u) ? 1u : 0u; mine = (j == x) ? c : mine; }
    if (sum == G) break;
    __builtin_amdgcn_s_sleep(1);
    if ((++sp & 255u) == 0u) { if (xb_ld(&bar[XB_TMO])) break; if (sp > XB_SPIN_CAP) { atomicAdd(&bar[XB_TMO], 1u); break; } }
  }
  nloc = mine > 0u ? mine : 1u; nx = cnt > 0u ? cnt : 1u;
}
DI void xcd_barrier(const XcdBarrier& b) {
  asm volatile("s_waitcnt vmcnt(0)" ::: "memory");
  __syncthreads();
  if (tidx() == 0) {
    unsigned* bar = b.bar;
    const unsigned bx = (unsigned)__builtin_amdgcn_readfirstlane((int)xb_xcc_id());
    __builtin_amdgcn_s_waitcnt(0);
    unsigned nloc = b.st[0], nx = b.st[1];
    if (nloc == 0u) { xcd_barrier_complete(bar, bx, nloc, nx); b.st[0] = nloc; b.st[1] = nx; }
    const unsigned old = xb_add(&bar[XB_XSUB(bx)], 1u);
    const unsigned gen = old / nloc;
    if (old + 1u == (gen + 1u) * nloc) {
      __builtin_amdgcn_fence(__ATOMIC_RELEASE, "agent");
      asm volatile("s_waitcnt vmcnt(0)" ::: "memory");
      const unsigned og = xb_add(&bar[XB_TOP], 1u);
      const unsigned tg = og / nx;
      if (og + 1u == (tg + 1u) * nx) xb_add(&bar[XB_TOPGEN], 1u);
      else XB_SPIN(xb_ld(&bar[XB_TOPGEN]) == tg, bar);
      __builtin_amdgcn_fence(__ATOMIC_ACQUIRE, "agent");
      xb_add(&bar[XB_XGEN(bx)], 1u);
      asm volatile("s_waitcnt vmcnt(0)" ::: "memory");
    } else {
      XB_SPIN(xb_ld(&bar[XB_XGEN(bx)]) == gen, bar);
      __builtin_amdgcn_fence(__ATOMIC_ACQUIRE, "agent");
      asm volatile("s_waitcnt vmcnt(0)" ::: "memory");
    }
  }
  __syncthreads();
}

#define TASK_LOOP(t, nt, base) for (int t = (int)((blockIdx.x + gridDim.x - ((unsigned)(base) % gridDim.x)) % gridDim.x); t < (nt); t += gridDim.x)

template <bool RFA, bool RFB, class LA, class LB, class EPI>
DI void gemm_tile(u16* smem, int nk, LA la, LB lb, EPI epi) {
  const int tid = tidx(), lane = tid & 63, wave = tid >> 6;
  const int wm = wave >> 2, wn = wave & 3, lr = lane & 31, lh = lane >> 5;
  u16* As = smem;
  u16* Bs = smem + 2 * TILE_ELEMS;
  f32x16 acc[2];
  acc[0] = zero16(); acc[1] = zero16();
  u32x4 ra[2], rb[2];
#define A_ROW(c) (RFA ? ((c) & 127) : ((c) >> 3))
#define A_KC(c) (RFA ? ((c) >> 7) : ((c) & 7))
#define B_ROW(c) (RFB ? ((c) & 127) : ((c) >> 3))
#define B_KC(c) (RFB ? ((c) >> 7) : ((c) & 7))
#pragma unroll
  for (int i = 0; i < 2; ++i) { const int c = tid + NTH * i; ra[i] = la(A_ROW(c), A_KC(c) * 8); rb[i] = lb(B_ROW(c), B_KC(c) * 8); }
#pragma unroll
  for (int i = 0; i < 2; ++i) {
    const int c = tid + NTH * i;
    *(u32x4*)(As + A_ROW(c) * LDT + A_KC(c) * 8) = ra[i];
    *(u32x4*)(Bs + B_ROW(c) * LDT + B_KC(c) * 8) = rb[i];
  }
  __syncthreads();
  for (int kt = 0; kt < nk; ++kt) {
    const int buf = kt & 1;
    if (kt + 1 < nk) {
      const int k0 = (kt + 1) * 64;
#pragma unroll
      for (int i = 0; i < 2; ++i) { const int c = tid + NTH * i; ra[i] = la(A_ROW(c), k0 + A_KC(c) * 8); rb[i] = lb(B_ROW(c), k0 + B_KC(c) * 8); }
    }
    const u16* Ab = As + buf * TILE_ELEMS + (wm * 64 + lr) * LDT + lh * 8;
    const u16* Bb = Bs + buf * TILE_ELEMS + (wn * 32 + lr) * LDT + lh * 8;
#pragma unroll
    for (int ks = 0; ks < 4; ++ks) {
      const bf16x8 a0 = *(const bf16x8*)(Ab + ks * 16);
      const bf16x8 a1 = *(const bf16x8*)(Ab + 32 * LDT + ks * 16);
      const bf16x8 b = *(const bf16x8*)(Bb + ks * 16);
      acc[0] = mfma(a0, b, acc[0]);
      acc[1] = mfma(a1, b, acc[1]);
    }
    if (kt + 1 < nk) {
      u16* Aw = As + (buf ^ 1) * TILE_ELEMS;
      u16* Bw = Bs + (buf ^ 1) * TILE_ELEMS;
#pragma unroll
      for (int i = 0; i < 2; ++i) {
        const int c = tid + NTH * i;
        *(u32x4*)(Aw + A_ROW(c) * LDT + A_KC(c) * 8) = ra[i];
        *(u32x4*)(Bw + B_ROW(c) * LDT + B_KC(c) * 8) = rb[i];
      }
    }
    __syncthreads();
  }
  epi(acc, wm, wn, lane);
}

template <bool RFA, bool RFB, class LA, class LB, class EPI>
DI void gemm_tile2s(u16* smem, int nk, LA la, LB lb, EPI epi) {
  const int tid = tidx(), lane = tid & 63, wave = tid >> 6;
  const int wm = wave >> 2, wn = wave & 3, lr = lane & 31, lh = lane >> 5;
  u16* As = smem;
  u16* Bs = smem + 2 * TILE_ELEMS;
  f32x16 acc[2];
  acc[0] = zero16(); acc[1] = zero16();
  u32x4 ra0[2], rb0[2], ra1[2], rb1[2];
  auto ld = [&](u32x4 (&ra)[2], u32x4 (&rb)[2], int kt) __attribute__((always_inline)) {
    const int k0 = kt * 64;
#pragma unroll
    for (int i = 0; i < 2; ++i) { const int c = tid + NTH * i; ra[i] = la(A_ROW(c), k0 + A_KC(c) * 8); rb[i] = lb(B_ROW(c), k0 + B_KC(c) * 8); }
  };
  auto stl = [&](u32x4 (&ra)[2], u32x4 (&rb)[2], int buf) __attribute__((always_inline)) {
#pragma unroll
    for (int i = 0; i < 2; ++i) {
      const int c = tid + NTH * i;
      *(u32x4*)(As + buf * TILE_ELEMS + A_ROW(c) * LDT + A_KC(c) * 8) = ra[i];
      *(u32x4*)(Bs + buf * TILE_ELEMS + B_ROW(c) * LDT + B_KC(c) * 8) = rb[i];
    }
  };
  auto compute = [&](int buf) __attribute__((always_inline)) {
    const u16* Ab = As + buf * TILE_ELEMS + (wm * 64 + lr) * LDT + lh * 8;
    const u16* Bb = Bs + buf * TILE_ELEMS + (wn * 32 + lr) * LDT + lh * 8;
#pragma unroll
    for (int ks = 0; ks < 4; ++ks) {
      const bf16x8 a0 = *(const bf16x8*)(Ab + ks * 16);
      const bf16x8 a1 = *(const bf16x8*)(Ab + 32 * LDT + ks * 16);
      const bf16x8 b = *(const bf16x8*)(Bb + ks * 16);
      acc[0] = mfma(a0, b, acc[0]);
      acc[1] = mfma(a1, b, acc[1]);
    }
  };
  ld(ra0, rb0, 0);
  if (nk > 1) ld(ra1, rb1, 1);
  stl(ra0, rb0, 0);
  if (nk > 2) ld(ra0, rb0, 2);
  __syncthreads();
#pragma unroll 1
  for (int kt = 0; kt < nk; kt += 2) {
    compute(0);
    if (kt + 1 < nk) { stl(ra1, rb1, 1); if (kt + 3 < nk) ld(ra1, rb1, kt + 3); }
    __syncthreads();
    if (kt + 1 < nk) {
      compute(1);
      if (kt + 2 < nk) { stl(ra0, rb0, 0); if (kt + 4 < nk) ld(ra0, rb0, kt + 4); }
      __syncthreads();
    }
  }
  epi(acc, wm, wn, lane);
}

DI void stage_rc(int b, int& R, int& C) { int st = b / 1024, sb = b % 1024, swz = sb ^ (((sb >> 9) & 1) << 5); R = (st >> 1) * 16 + swz / 64; C = (st & 1) * 32 + (swz % 64) / 2; }

DI int perm32(int rho) { const int n = rho >> 4, i = rho & 15; return 8 * (i >> 2) + 4 * n + (i & 3); }

template <bool PERM, class EPI>
DI void gemm256(LAS u16* shm, const u16* __restrict__ A, const u16* __restrict__ Bt, int K, int brow, int bcol, bool pre, bool has_next, int nbrow, int nbcol, EPI epi) {
#define SA(b, h) (shm + ((b) * 2 + (h)) * HT)
#define SB(b, h) (shm + (4 + (b) * 2 + (h)) * HT)
  const int tid = tidx();
  const int wid = __builtin_amdgcn_readfirstlane(tid >> 6), lane = tid & 63, wr = wid >> 2, wc = wid & 3, fr = lane & 15, fq = lane >> 4;
  int r0, c0, r1, c1;
  stage_rc(tid * 16, r0, c0);
  stage_rc(tid * 16 + 8192, r1, c1);
  const int ra0 = PERM ? ((r0 & ~31) + perm32(r0 & 31)) : r0, ra1 = PERM ? ((r1 & ~31) + perm32(r1 & 31)) : r1;
  const unsigned so0 = (unsigned)(ra0 * K + c0) * 2u, so1 = (unsigned)(ra1 * K + c1) * 2u;
  const unsigned sb0 = (unsigned)(r0 * K + c0) * 2u, sb1 = (unsigned)(r1 * K + c1) * 2u;
  const unsigned ldsw = (unsigned)wid * 1024u;
  const int lb = ((fr * 64 + fq * 16) ^ ((fr >> 3) << 5));
#define STAGE_(P, BASE, br, kt, O0, O1) do { const char* _g = (const char*)((BASE) + (size_t)(br) * K + (kt) * 64); \
    __builtin_amdgcn_global_load_lds((const unsigned*)(_g + O0), (LAS unsigned*)((LAS char*)(P) + ldsw), 16, 0, 0); \
    __builtin_amdgcn_global_load_lds((const unsigned*)(_g + O1), (LAS unsigned*)((LAS char*)(P) + ldsw + 8192), 16, 0, 0); } while (0)
#define STAGEA(P, br, kt) STAGE_(P, A, br, kt, so0, so1)
#define STAGEB(P, br, kt) STAGE_(P, Bt, br, kt, sb0, sb1)
#define LDA(dst, b, h) _Pragma("unroll") for (int m = 0; m < 4; ++m) _Pragma("unroll") for (int k = 0; k < 2; ++k) \
    dst[m][k] = *(const LAS bf16x8*)((const LAS char*)SA(b, h) + ((wr * 4 + m) * 2 + k) * 1024 + lb)
#define LDB(dst, b, h) _Pragma("unroll") for (int n = 0; n < 2; ++n) _Pragma("unroll") for (int k = 0; k < 2; ++k) \
    dst[n][k] = *(const LAS bf16x8*)((const LAS char*)SB(b, h) + ((wc * 2 + n) * 2 + k) * 1024 + lb)
#define MMA(ai, bj, At_, Bt_) do { __builtin_amdgcn_s_setprio(1); \
    _Pragma("unroll") for (int m = 0; m < 4; ++m) _Pragma("unroll") for (int n = 0; n < 2; ++n) _Pragma("unroll") for (int k = 0; k < 2; ++k) \
      acc[ai][bj][m][n] = __builtin_amdgcn_mfma_f32_16x16x32_bf16(At_[m][k], Bt_[n][k], acc[ai][bj][m][n], 0, 0, 0); \
    __builtin_amdgcn_s_setprio(0); } while (0)
#define WAIT_V(n) asm volatile("s_waitcnt vmcnt(" #n ")" ::: "memory")
#define WAIT_L(n) asm volatile("s_waitcnt lgkmcnt(" #n ")" ::: "memory")
#define BAR __builtin_amdgcn_s_barrier()
#define SCHED __builtin_amdgcn_sched_barrier(0)
  f32x4 acc[2][2][4][2];
#pragma unroll
  for (int a = 0; a < 2; ++a)
#pragma unroll
    for (int b = 0; b < 2; ++b)
#pragma unroll
      for (int m = 0; m < 4; ++m)
#pragma unroll
        for (int n = 0; n < 2; ++n) { acc[a][b][m][n][0] = 0.f; acc[a][b][m][n][1] = 0.f; acc[a][b][m][n][2] = 0.f; acc[a][b][m][n][3] = 0.f; }
  bf16x8 At[4][2], B0[2][2], B1[2][2];
  const int nt = K / 64;
  if (!pre) {
    STAGEB(SB(0, 0), bcol, 0); STAGEA(SA(0, 0), brow, 0);
    STAGEB(SB(0, 1), bcol + 128, 0); STAGEA(SA(0, 1), brow + 128, 0);
  }
  if (wr == 1) BAR;
  WAIT_V(4); BAR;
  STAGEB(SB(1, 0), bcol, 1); STAGEA(SA(1, 0), brow, 1); STAGEB(SB(1, 1), bcol + 128, 1);
  WAIT_V(6); BAR;
  for (int t = 0; t < nt - 2; t += 2) {
    LDB(B0, 0, 0); SCHED; LDA(At, 0, 0); STAGEA(SA(1, 1), brow + 128, t + 1);
    WAIT_L(8); BAR; WAIT_L(0); MMA(0, 0, At, B0); BAR; SCHED;
    LDB(B1, 0, 1); STAGEB(SB(0, 0), bcol, t + 2);
    BAR; WAIT_L(0); MMA(0, 1, At, B1); BAR;
    LDA(At, 0, 1); STAGEA(SA(0, 0), brow, t + 2);
    BAR; WAIT_L(0); MMA(1, 0, At, B0); BAR; SCHED;
    STAGEB(SB(0, 1), bcol + 128, t + 2);
    WAIT_V(6); BAR; MMA(1, 1, At, B1); BAR;
    LDB(B0, 1, 0); SCHED; LDA(At, 1, 0); STAGEA(SA(0, 1), brow + 128, t + 2);
    WAIT_L(8); BAR; WAIT_L(0); MMA(0, 0, At, B0); BAR; SCHED;
    LDB(B1, 1, 1); STAGEB(SB(1, 0), bcol, t + 3);
    BAR; WAIT_L(0); MMA(0, 1, At, B1); BAR;
    LDA(At, 1, 1); STAGEA(SA(1, 0), brow, t + 3);
    BAR; WAIT_L(0); MMA(1, 0, At, B0); BAR; SCHED;
    STAGEB(SB(1, 1), bcol + 128, t + 3);
    WAIT_V(6); BAR; MMA(1, 1, At, B1); BAR;
  }
  { LDB(B0, 0, 0); LDA(At, 0, 0); STAGEA(SA(1, 1), brow + 128, nt - 1);
    BAR; WAIT_L(0); MMA(0, 0, At, B0); BAR;
    LDB(B1, 0, 1); BAR; WAIT_L(0); MMA(0, 1, At, B1); BAR;
    LDA(At, 0, 1); WAIT_V(4); BAR; WAIT_L(0); MMA(1, 0, At, B0); MMA(1, 1, At, B1); BAR; }
  { LDB(B0, 1, 0); LDA(At, 1, 0); WAIT_V(2); BAR; WAIT_L(0); MMA(0, 0, At, B0); BAR;
    LDB(B1, 1, 1); WAIT_V(0); BAR; WAIT_L(0); MMA(0, 1, At, B1); BAR;
    LDA(At, 1, 1); BAR; WAIT_L(0); MMA(1, 0, At, B0); MMA(1, 1, At, B1); BAR; }
  if (wr == 0) BAR;
  if (has_next) {
    STAGEB(SB(0, 0), nbcol, 0); STAGEA(SA(0, 0), nbrow, 0);
    STAGEB(SB(0, 1), nbcol + 128, 0); STAGEA(SA(0, 1), nbrow + 128, 0);
  }
  epi(acc, wr, wc, fr, fq);
  __syncthreads();
}

DI void map256(int t, int nN, int& tn, int& tm) {
  const int p = (t >> 8) * 8 + (t & 7), i = (t >> 3) & 31, pr = nN >> 2;
  const int pm = p / pr;
  tn = ((p + pm) % pr) * 4 + (i & 3);
  tm = pm * 8 + (i >> 2);
}

DI int condrow(int sb, int tok) { return sb == 0 ? 0 : 1 + (sb - 1) * 8 + (tok >> 11); }

DI void convT(float* tile, const float* src, int lds_, int K, int N, u16* dst, int ldd, const float* ksc, int& base) {
  const int tid = tidx();
  const int ntn = (N + 63) >> 6, nt = (K >> 6) * ntn;
  const int kk = tid >> 4, n4 = (tid & 15) * 4;
  float4 cur[2], nxt[2];
  auto ld = [&](float4 (&v)[2], int t) __attribute__((always_inline)) {
    const int tn = t % ntn, tk = t / ntn, k0 = tk * 64, n0 = tn * 64;
#pragma unroll
    for (int e = 0; e < 2; ++e) {
      v[e] = make_float4(0.f, 0.f, 0.f, 0.f);
      if (n0 + n4 < N) v[e] = *(const float4*)(src + (size_t)(k0 + kk + 32 * e) * lds_ + n0 + n4);
    }
  };
  int t = (int)((blockIdx.x + gridDim.x - ((unsigned)base % gridDim.x)) % gridDim.x);
  if (t < nt) ld(cur, t);
  for (; t < nt; t += gridDim.x) {
    const int tnx = t + (int)gridDim.x;
    if (tnx < nt) ld(nxt, tnx);
    const int tn = t % ntn, tk = t / ntn, k0 = tk * 64, n0 = tn * 64;
#pragma unroll
    for (int e = 0; e < 2; ++e) {
      float4 v = cur[e];
      if (ksc) { const float sc = ksc[k0 + kk + 32 * e]; v.x *= sc; v.y *= sc; v.z *= sc; v.w *= sc; }
      float* tp = tile + (kk + 32 * e) * 65 + n4;
      tp[0] = v.x; tp[1] = v.y; tp[2] = v.z; tp[3] = v.w;
    }
    __syncthreads();
#pragma unroll 4
    for (int e = 0; e < 4; ++e) {
      const int idx = tid + NTH * e, nn = idx >> 5, kp = idx & 31;
      if (n0 + nn < N)
        *(unsigned*)(dst + (size_t)(n0 + nn) * ldd + k0 + 2 * kp) = pack2(tile[(2 * kp) * 65 + nn], tile[(2 * kp + 1) * 65 + nn]);
    }
    __syncthreads();
    cur[0] = nxt[0]; cur[1] = nxt[1];
  }
  base += nt;
}

DI void prologue_a(const Prm& p, unsigned char* smem_raw, int& base) {
  float* smf = (float*)smem_raw;
  const int tid = tidx();
  const int gtid = blockIdx.x * NTH + tid, gn = gridDim.x * NTH;
  for (int l = 0; l < 4; ++l) {
    convT(smf, p.w_in + (size_t)l * 1024 * 7520 + 768, 7520, 1024, 6752, p.WinT + ((size_t)l * NWP + 1536) * 1024, 1024, nullptr, base);
    convT(smf, p.w1 + (size_t)l * 1024 * 4096, 4096, 1024, 4096, p.W1T + (size_t)l * 4096 * 1024, 1024, nullptr, base);
    convT(smf, p.w2 + (size_t)l * 4096 * 1024, 1024, 4096, 1024, p.W2T + (size_t)l * 1024 * 4096, 4096, nullptr, base);
    convT(smf, p.w_o + (size_t)l * 1024 * 1024, 1024, 1024, 1024, p.WoT + (size_t)l * 1024 * 1024, 1024, nullptr, base);
    convT(smf, p.p_a + (size_t)l * 768 * 1024, 1024, 768, 1024, p.PaT + (size_t)l * 1024 * 768, 768, nullptr, base);
    convT(smf, p.p_b + (size_t)l * 128 * 1024, 1024, 128, 1024, p.PbT + (size_t)l * 1024 * 128, 128, nullptr, base);
    convT(smf, p.p_c + (size_t)l * 384 * 1024, 1024, 384, 1024, p.PcT + (size_t)l * 1024 * 384, 384, nullptr, base);
    convT(smf, p.p_d + (size_t)l * 256 * 1024, 1024, 256, 1024, p.PdT + (size_t)l * 1024 * 256, 256, nullptr, base);
    convT(smf, p.w_uq + (size_t)l * 384 * 384, 384, 384, 384, p.WqT + (size_t)l * 384 * 384, 384, p.qn_g + l * 384, base);
    convT(smf, p.w_ukv + (size_t)l * 320 * 512, 512, 320, 512, p.WkvT + (size_t)l * 512 * 320, 320, p.kvn_g + l * 320, base);
  }
  {
    float* tab = (float*)(smem_raw + GEMM_SMEM + 1024);
    if (tid < 192) {
      float sn, cs;
      sincospif(2.f * (float)tid / 192.f, &sn, &cs);
      tab[tid] = cs; tab[192 + tid] = sn;
    }
    __syncthreads();
    u16* smem = (u16*)smem_raw;
    TASK_LOOP(t, 384, base) {
      const int kt = t & 7, rt = (t >> 3) % 3, g = (t / 24) & 3, l = t / 96;
      auto la = [&](int row, int k) __attribute__((always_inline)) {
        const int rr = rt * 128 + row, part = rr >= 192 ? 1 : 0, j = rr - part * 192;
        const float* tp = tab + part * 192;
        const float sg = part ? -1.f : 1.f;
        int m = (j * k) % 192;
        u32x4 o;
#pragma unroll
        for (int jj = 0; jj < 4; ++jj) {
          const float v0 = tp[m] * sg; m += j; if (m >= 192) m -= 192;
          const float v1 = tp[m] * sg; m += j; if (m >= 192) m -= 192;
          o[jj] = pack2(v0, v1);
        }
        return o;
      };
      auto lb = [&](int row, int k) __attribute__((always_inline)) {
        const float* src = p.w_in + ((size_t)l * 1024 + kt * 128 + row) * 7520 + g * 192 + k;
        const float4 a = *(const float4*)src, b = *(const float4*)(src + 4);
        u32x4 o;
        o[0] = pack2(a.x, a.y); o[1] = pack2(a.z, a.w); o[2] = pack2(b.x, b.y); o[3] = pack2(b.z, b.w);
        return o;
      };
      auto epi = [&](f32x16 (&acc)[2], int wm, int wn, int lane) __attribute__((always_inline)) {
        const int lr = lane & 31, lh = lane >> 5;
        const int kcol = kt * 128 + wn * 32 + lr;
#pragma unroll
        for (int i = 0; i < 2; ++i)
#pragma unroll
          for (int r = 0; r < 16; ++r) {
            const int rr = rt * 128 + wm * 64 + i * 32 + rowmap(r, lh), part = rr >= 192 ? 1 : 0, j = rr - part * 192;
            p.WinT[((size_t)l * NWP + part * 768 + g * 192 + j) * 1024 + kcol] = f2bf(acc[i][r]);
          }
      };
      gemm_tile<false, false>(smem, 3, la, lb, epi);
    }
    base += 384;
  }
  {
    float* sil = smf;
    TASK_LOOP(t, 384, base) {
      const int kc = t & 7, cb = (t >> 3) % 12, l = t / 96, k0 = kc * 128;
      for (int idx = tid; idx < 17 * 128; idx += NTH) {
        const int r = idx >> 7, kk = idx & 127;
        const float c = r == 0 ? p.c_prompt[k0 + kk] : p.c_sample[(r - 1) * 1024 + k0 + kk];
        sil[idx] = c / (1.f + __expf(-c));
      }
      __syncthreads();
      const int n = cb * 512 + tid;
      float acc[17];
#pragma unroll
      for (int r = 0; r < 17; ++r) acc[r] = 0.f;
      const float* wp = p.ada_w + ((size_t)l * 1024 + k0) * 6144 + n;
#pragma unroll 1
      for (int kb = 0; kb < 128; kb += 32) {
        float w[32];
#pragma unroll
        for (int i = 0; i < 32; ++i) w[i] = wp[(size_t)(kb + i) * 6144];
#pragma unroll
        for (int i = 0; i < 32; i += 4)
#pragma unroll
          for (int r = 0; r < 17; ++r) {
            const float4 sv = *(const float4*)(sil + r * 128 + kb + i);
            acc[r] += sv.x * w[i] + sv.y * w[i + 1] + sv.z * w[i + 2] + sv.w * w[i + 3];
          }
      }
#pragma unroll
      for (int r = 0; r < 17; ++r) p.modpart[((size_t)(kc * 4 + l) * 17 + r) * 6144 + n] = acc[r];
      __syncthreads();
    }
    base += 384;
  }
  for (int idx = gtid; idx < 4 * 32 * 1024; idx += gn) {
    const int l = idx >> 15, rem = idx & 32767;
    p.WinT[((size_t)l * NWP + NW) * 1024 + rem] = 0;
  }
  for (int idx = gtid; idx < 256 * 256; idx += gn) {
    const int row = idx >> 8, kk = idx & 255;
    const int po = row >> 7, k1 = row & 127, pi = kk >> 7, s1 = kk & 127;
    float s, c;
    sincospif(2.f * (float)((k1 * s1) & 127) / 128.f, &s, &c);
    const float v = (po == pi) ? c : (po == 0 ? s : -s);
    p.M1a[idx] = f2bf(v);
  }
  for (int idx = gtid; idx < 32 * 64; idx += gn) {
    const int row = idx >> 6, kk = idx & 63;
    const int po = row >> 4, k1 = row & 15, pi = (kk >> 4) & 1, s1 = kk & 15;
    float s, c;
    sincospif(2.f * (float)((k1 * s1) & 15) / 16.f, &s, &c);
    float v = (po == pi) ? c : (po == 0 ? s : -s);
    if (kk >= 32) v = 0.f;
    p.M1b[idx] = f2bf(v);
  }
  for (int idx = gtid; idx < 128 * 256; idx += gn) {
    const int k2 = idx >> 8, kk = idx & 255, part = kk >> 7, s2 = kk & 127;
    float s, c;
    sincospif(2.f * (float)((k2 * s2) & 127) / 128.f, &s, &c);
    p.M2[idx] = f2bf(part ? s : c);
  }
  for (int idx = gtid; idx < 16384; idx += gn) {
    float s, c;
    sincospif(2.f * (float)idx / 16384.f, &s, &c);
    p.tw[idx] = make_float2(c, s);
  }
  for (int idx = gtid; idx < 16384 * 16; idx += gn) {
    const int pos = idx >> 4, i = idx & 15;
    const float inv = (float)pow(10000.0, -(double)i / 16.0);
    const float ang = (float)pos * inv;
    double rev = (double)ang * 0.15915494309189535;
    rev -= rint(rev);
    float s, c;
    sincospif((float)(2.0 * rev), &s, &c);
    p.rope[idx] = make_float2(c, s);
  }
  for (int idx = gtid; idx < 6 * 129; idx += gn) {
    const int hd = idx / 129, rel = idx - hd * 129 - 64;
    const int dil = 1 << (2 * (hd >> 1));
    const int rd = rel * dil, n = rd < 0 ? -rd : rd;
    int b;
    if (n < 8) b = n;
    else if (n < 15) b = 8; else if (n < 27) b = 9; else if (n < 50) b = 10; else if (n < 91) b = 11;
    else if (n < 166) b = 12; else if (n < 305) b = 13; else if (n < 559) b = 14; else b = 15;
    if (rd > 0) b += 16;
    p.biasT[idx] = p.rel_bias[b * 6 + hd];
  }
  for (int idx = gtid; idx < 4 * 4 * 128 * 128; idx += gn) p.SgW[idx] = f2bf(p.sgu_w[idx]);
}

DI void prologue_b(const Prm& p) {
  const int gtid = blockIdx.x * NTH + tidx(), gn = gridDim.x * NTH;
  for (int idx = gtid; idx < 4 * 17 * 6144; idx += gn) {
    const int l = idx / (17 * 6144), n = idx % 6144;
    float s = p.ada_b[l * 6144 + n];
#pragma unroll
    for (int kc = 0; kc < 8; ++kc) s += p.modpart[(size_t)kc * 4 * 17 * 6144 + idx];
    p.mod[idx] = s;
  }
}

DI void phase_norm(const Prm& p, const float* xsrc, const float* g, const float* modl, int shoff, int scoff, int sb) {
  const int tid = tidx(), lane = tid & 63;
  const int gw = blockIdx.x * 8 + (tid >> 6), nw = gridDim.x * 8;
  for (int row = gw; row < TB; row += nw) {
    const int cond = condrow(sb, row);
    const float* xr = xsrc + (size_t)row * 1024;
    float4 v[4];
    float ss = 0.f;
#pragma unroll
    for (int i = 0; i < 4; ++i) {
      v[i] = *(const float4*)(xr + i * 256 + lane * 4);
      ss += v[i].x * v[i].x + v[i].y * v[i].y + v[i].z * v[i].z + v[i].w * v[i].w;
    }
#pragma unroll
    for (int off = 32; off >= 1; off >>= 1) ss += __shfl_xor(ss, off);
    const float rstd = rsqrtf(ss * (1.f / 1024.f) + 1e-6f);
    const float* sc = modl + cond * 6144 + scoff;
    const float* sh = modl + cond * 6144 + shoff;
#pragma unroll
    for (int i = 0; i < 4; ++i) {
      const int col = i * 256 + lane * 4;
      const float4 gg = *(const float4*)(g + col), s4 = *(const float4*)(sc + col), h4 = *(const float4*)(sh + col);
      st4bf(p.hbuf + (size_t)row * 1024 + col,
            v[i].x * rstd * gg.x * (1.f + s4.x) + h4.x, v[i].y * rstd * gg.y * (1.f + s4.y) + h4.y,
            v[i].z * rstd * gg.z * (1.f + s4.z) + h4.z, v[i].w * rstd * gg.w * (1.f + s4.w) + h4.w);
    }
  }
}

DI float sigm(float x) { return __builtin_amdgcn_rcpf(1.f + __expf(-x)); }

DI void phase_inproj(const Prm& p, unsigned char* smem_raw, int l, int S, int& base) {
  const u16* W = p.WinT + (size_t)l * NWP * 1024;
  LAS u16* shm = (LAS u16*)smem_raw;
  bool pre = false;
  TASK_LOOP(t, 32 * 64, base) {
    int tn, tm;
    map256(t, 32, tn, tm);
    const int brow = tn * 256, bcol = tm * 256;
    const int tnx = t + (int)gridDim.x;
    const bool has_next = tnx < (32 * 64);
    int tn2 = 0, tm2 = 0;
    if (has_next) map256(tnx, 32, tn2, tm2);
    const int nbrow = tn2 * 256, nbcol = tm2 * 256;
    const bool hn = has_next && ((tn2 != 16) == (tn != 16));
    auto epi = [&](f32x4 (&acc)[2][2][4][2], int wr, int wc, int fr, int fq) __attribute__((always_inline)) {
#pragma unroll
      for (int ai = 0; ai < 2; ++ai)
#pragma unroll
        for (int m = 0; m < 4; ++m) {
          const int nb = brow + ai * 128 + wr * 64 + m * 16;
#pragma unroll
          for (int bj = 0; bj < 2; ++bj)
#pragma unroll
            for (int n = 0; n < 2; ++n) {
              const int tok = bcol + bj * 128 + wc * 32 + n * 16 + fr;
              const f32x4 v = acc[ai][bj][m][n];
              const int nn = nb + fq * 4;
              if (nb < 1536) {
#pragma unroll
                for (int j = 0; j < 4; ++j) p.UT[(size_t)(nn + j) * TBP + tok] = f2bf(v[j]);
              } else if (nb < 2688) {
                st4bf(p.bqkv + (size_t)tok * 1152 + (nn - 1536), v[0], v[1], v[2], v[3]);
              } else if (nb < 3072) {
                st4bf(p.cu + (size_t)tok * 384 + (nn - 2688), v[0], v[1], v[2], v[3]);
              } else if (nb < 3456) {
#pragma unroll
                for (int j = 0; j < 4; ++j) p.cvT[(size_t)(nn - 3072 + j) * TBP + tok] = f2bf(v[j]);
              } else if (nb < 3840) {
                st4bf(p.dcq + (size_t)tok * 384 + (nn - 3456), v[0], v[1], v[2], v[3]);
              } else if (nb < 4160) {
                st4bf(p.dckv + (size_t)tok * 320 + (nn - 3840), v[0], v[1], v[2], v[3]);
              } else if (nb < 4192) {
                if (nb == 4160) {
                  const f32x4 v2 = acc[ai][bj][(m + 1) & 3][n];
                  const int pos = tok & (S - 1);
#pragma unroll
                  for (int j = 0; j < 4; ++j) {
                    const int ii = fq * 4 + j;
                    const float2 cs = p.rope[pos * 16 + ii];
                    const u16 o1 = f2bf(v[j] * cs.x - v2[j] * cs.y), o2 = f2bf(v[j] * cs.y + v2[j] * cs.x);
#pragma unroll
                    for (int hh = 0; hh < 4; ++hh) {
                      p.kc[(size_t)tok * 384 + hh * 96 + 64 + ii] = o1;
                      p.kc[(size_t)tok * 384 + hh * 96 + 80 + ii] = o2;
                    }
                  }
                }
              } else {
                st4bf_nt(p.zg + (size_t)tok * 4096 + (nn - 4192), sigm(v[0]), sigm(v[1]), sigm(v[2]), sigm(v[3]));
              }
            }
          __builtin_amdgcn_sched_barrier(0);
        }
    };
    if (tn != 16) {
      auto epi_p = [&](f32x4 (&acc)[2][2][4][2], int wr, int wc, int fr, int fq) __attribute__((always_inline)) {
#pragma unroll
        for (int ai = 0; ai < 2; ++ai)
#pragma unroll
          for (int mp = 0; mp < 2; ++mp) {
            const int nb = brow + ai * 128 + wr * 64 + mp * 32;
            const int nn = nb + fq * 8;
#pragma unroll
            for (int bj = 0; bj < 2; ++bj)
#pragma unroll
              for (int n = 0; n < 2; ++n) {
                const int tok = bcol + bj * 128 + wc * 32 + n * 16 + fr;
                const f32x4 v = acc[ai][bj][2 * mp][n], w = acc[ai][bj][2 * mp + 1][n];
                if (nb < 1536) {
#pragma unroll
                  for (int j = 0; j < 4; ++j) { p.UT[(size_t)(nn + j) * TBP + tok] = f2bf(v[j]); p.UT[(size_t)(nn + 4 + j) * TBP + tok] = f2bf(w[j]); }
                } else if (nb < 2688) {
                  st8bf(p.bqkv + (size_t)tok * 1152 + (nn - 1536), v, w);
                } else if (nb < 3072) {
                  st8bf(p.cu + (size_t)tok * 384 + (nn - 2688), v, w);
                } else if (nb < 3456) {
#pragma unroll
                  for (int j = 0; j < 4; ++j) { p.cvT[(size_t)(nn - 3072 + j) * TBP + tok] = f2bf(v[j]); p.cvT[(size_t)(nn - 3072 + 4 + j) * TBP + tok] = f2bf(w[j]); }
                } else if (nb < 3840) {
                  st8bf(p.dcq + (size_t)tok * 384 + (nn - 3456), v, w);
                } else if (nb < 4160) {
                  st8bf(p.dckv + (size_t)tok * 320 + (nn - 3840), v, w);
                } else {
                  u32x4 o;
                  o[0] = pack2(sigm(v[0]), sigm(v[1])); o[1] = pack2(sigm(v[2]), sigm(v[3]));
                  o[2] = pack2(sigm(w[0]), sigm(w[1])); o[3] = pack2(sigm(w[2]), sigm(w[3]));
                  __builtin_nontemporal_store(o, (u32x4*)(p.zg + (size_t)tok * 4096 + (nn - 4192)));
                }
              }
            __builtin_amdgcn_sched_barrier(0);
          }
      };
      gemm256<true>(shm, W, p.hbuf, 1024, brow, bcol, pre, hn, nbrow, nbcol, epi_p);
    } else {
      gemm256<false>(shm, W, p.hbuf, 1024, brow, bcol, pre, hn, nbrow, nbcol, epi);
    }
    pre = hn;
  }
  base += 32 * 64;
}

DI void phase_inproj_tail(const Prm& p, unsigned char* smem_raw, int l, int& base) {
  const u16* W = p.WinT + (size_t)l * NWP * 1024;
  u16* smem = (u16*)smem_raw;
  TASK_LOOP(t, 128, base) {
    const int n0 = 8192, m0 = t * 128;
    auto la = [&](int row, int k) __attribute__((always_inline)) { return *(const u32x4*)(W + (size_t)(n0 + row) * 1024 + k); };
    auto lb = [&](int row, int k) __attribute__((always_inline)) { return *(const u32x4*)(p.hbuf + (size_t)(m0 + row) * 1024 + k); };
    auto epi = [&](f32x16 (&acc)[2], int wm, int wn, int lane) __attribute__((always_inline)) {
      const int lr = lane & 31, lh = lane >> 5;
      const int tok = m0 + wn * 32 + lr;
#pragma unroll
      for (int i = 0; i < 2; ++i) {
        const int nb = n0 + wm * 64 + i * 32;
        if (nb >= NW) continue;
#pragma unroll
        for (int q = 0; q < 4; ++q)
          st4bf(p.zg + (size_t)tok * 4096 + (nb - 4192) + 8 * q + 4 * lh, sigm(acc[i][4 * q]), sigm(acc[i][4 * q + 1]), sigm(acc[i][4 * q + 2]),
                sigm(acc[i][4 * q + 3]));
      }
    };
    gemm_tile2s<false, false>(smem, 16, la, lb, epi);
  }
  base += 128;
}


DI void phase_inproj_probe(const Prm& p, unsigned char* smem_raw, int l, int& base) {
  const u16* W = p.WinT + (size_t)l * NWP * 1024;
  LAS u16* shm = (LAS u16*)smem_raw;
  bool pre = false;
  TASK_LOOP(t, 32 * 64, base) {
    int tn, tm;
    map256(t, 32, tn, tm);
    const int brow = tn * 256, bcol = tm * 256;
    const int tnx = t + (int)gridDim.x;
    const bool has_next = tnx < (32 * 64);
    int tn2 = 0, tm2 = 0;
    if (has_next) map256(tnx, 32, tn2, tm2);
    const int nbrow = tn2 * 256, nbcol = tm2 * 256;
    auto epi = [&](f32x4 (&acc)[2][2][4][2], int wr, int wc, int fr, int fq) __attribute__((always_inline)) {
#pragma unroll
      for (int bj = 0; bj < 2; ++bj)
#pragma unroll
        for (int n = 0; n < 2; ++n) {
          const int tok = bcol + bj * 128 + wc * 32 + n * 16 + fr;
#pragma unroll
          for (int ai = 0; ai < 2; ++ai)
#pragma unroll
            for (int m = 0; m < 4; ++m) {
              const int nn = ((brow + ai * 128 + wr * 64 + m * 16) & 1023) + fq * 4;
              const f32x4 v = acc[ai][bj][m][n];
              st4bf(p.Gp + (size_t)tok * 1024 + nn, v[0], v[1], v[2], v[3]);
            }
        }
    };
    gemm256<false>(shm, W, p.hbuf, 1024, brow, bcol, pre, has_next, nbrow, nbcol, epi);
    pre = has_next;
  }
  base += 32 * 64;
}

DI void phase_fft1(const Prm& p, u16* smem, int S, int nseq, int N1, int lgN1, int& base) {
  const int nkt = N1 == 128 ? 2 : 1;
  const u16* M1 = N1 == 128 ? p.M1a : p.M1b;
  const int ldm = N1 == 128 ? 256 : 64;
  const int nk = N1 == 128 ? 4 : 1;
  const int ntask = nseq * 768 * nkt;
  const int twmul = 16384 / S;
  TASK_LOOP(t, ntask, base) {
    const int k1t = t % nkt, col = (t / nkt) % 768, seq = t / (nkt * 768);
    const int k1base = k1t * 64;
    auto la = [&](int row, int k) __attribute__((always_inline)) {
      const int k1 = k1base + (row >> 6) * 32 + (row & 31), ii = (row >> 5) & 1;
      if (k1 >= N1 || k >= 2 * N1) return zero4();
      return *(const u32x4*)(M1 + (ii * N1 + k1) * ldm + k);
    };
    auto lb = [&](int row, int k) __attribute__((always_inline)) {
      if (k >= 2 * N1) return zero4();
      const int part = k >> lgN1, s1 = k & (N1 - 1);
      const u16* src = p.UT + (size_t)(part * 768 + col) * TBP + seq * S + s1 * 128 + row;
      u32x4 v;
#pragma unroll
      for (int jj = 0; jj < 4; ++jj) v[jj] = (unsigned)src[(2 * jj) * 128] | ((unsigned)src[(2 * jj + 1) * 128] << 16);
      return v;
    };
    auto epi = [&](f32x16 (&acc)[2], int wm, int wn, int lane) __attribute__((always_inline)) {
      const int lr = lane & 31, lh = lane >> 5;
      const int s2 = wn * 32 + lr;
#pragma unroll
      for (int r = 0; r < 16; ++r) {
        const int k1 = k1base + wm * 32 + rowmap(r, lh);
        if (k1 < N1) {
          const float re = acc[0][r], im = acc[1][r];
          const float2 cs = p.tw[(s2 * k1) * twmul];
          const size_t o = ((size_t)((seq * N1 + k1) * 2) * 768 + col) * 128 + s2;
          p.Gp[o] = f2bf(cs.x * re + cs.y * im);
          p.Gp[o + 768 * 128] = f2bf(cs.x * im - cs.y * re);
        }
      }
    };
    gemm_tile2s<false, true>(smem, nk, la, lb, epi);
  }
  base += ntask;
}


DI void phase_fft1_small(const Prm& p, int nseq) {
  constexpr float C16[16] = {1.f, 0.92387953251128674f, 0.70710678118654752f, 0.38268343236508977f, 0.f, -0.38268343236508977f, -0.70710678118654752f,
                             -0.92387953251128674f, -1.f, -0.92387953251128674f, -0.70710678118654752f, -0.38268343236508977f, 0.f,
                             0.38268343236508977f, 0.70710678118654752f, 0.92387953251128674f};
  constexpr float S16[16] = {0.f, 0.38268343236508977f, 0.70710678118654752f, 0.92387953251128674f, 1.f, 0.92387953251128674f, 0.70710678118654752f,
                             0.38268343236508977f, 0.f, -0.38268343236508977f, -0.70710678118654752f, -0.92387953251128674f, -1.f,
                             -0.92387953251128674f, -0.70710678118654752f, -0.38268343236508977f};
  const int gtid = blockIdx.x * NTH + tidx(), gn = gridDim.x * NTH;
  for (int idx = gtid; idx < nseq * 768 * 128; idx += gn) {
    const int s2 = idx & 127, col = (idx >> 7) % 768, seq = idx / (768 * 128);
    const u16* ur = p.UT + (size_t)col * TBP + seq * 2048 + s2;
    const u16* ui = ur + (size_t)768 * TBP;
    float xr[16], xi[16];
#pragma unroll
    for (int s1 = 0; s1 < 16; ++s1) { xr[s1] = bf2f(ur[s1 * 128]); xi[s1] = bf2f(ui[s1 * 128]); }
    u16* go = p.Gp + ((size_t)(seq * 16 * 2) * 768 + col) * 128 + s2;
#pragma unroll
    for (int k1 = 0; k1 < 16; ++k1) {
      float gr = 0.f, gi = 0.f;
#pragma unroll
      for (int s1 = 0; s1 < 16; ++s1) {
        const float c = C16[(k1 * s1) & 15], sn = S16[(k1 * s1) & 15];
        gr += c * xr[s1] + sn * xi[s1];
        gi += c * xi[s1] - sn * xr[s1];
      }
      const float2 cs = p.tw[(s2 * k1) * 8];
      go[(size_t)(k1 * 2) * 768 * 128] = f2bf(cs.x * gr + cs.y * gi);
      go[(size_t)(k1 * 2 + 1) * 768 * 128] = f2bf(cs.x * gi - cs.y * gr);
    }
  }
}

DI void phase_fft2(const Prm& p, u16* smem, int S, int nseq, int N1, int& base) {
  const int ntask = nseq * N1 * 6;
  const float scale = rsqrtf((float)S * 192.f);
  u16* fa = p.UT;
  TASK_LOOP(t, ntask, base) {
    const int ct = t % 6, k1 = (t / 6) % N1, seq = t / (6 * N1);
    const u16* gb = p.Gp + ((size_t)((seq * N1 + k1) * 2) * 768 + ct * 128) * 128;
    auto la = [&](int row, int k) __attribute__((always_inline)) { return *(const u32x4*)(p.M2 + row * 256 + k); };
    auto lb = [&](int row, int k) __attribute__((always_inline)) {
      const int part = k >> 7, s2 = k & 127;
      return *(const u32x4*)(gb + ((size_t)part * 768 + row) * 128 + s2);
    };
    auto epi = [&](f32x16 (&acc)[2], int wm, int wn, int lane) __attribute__((always_inline)) {
      const int lr = lane & 31, lh = lane >> 5;
      const int col = ct * 128 + wn * 32 + lr;
#pragma unroll
      for (int i = 0; i < 2; ++i)
#pragma unroll
        for (int r = 0; r < 16; ++r) {
          const int k2 = wm * 64 + i * 32 + rowmap(r, lh);
          const int tok = seq * S + k1 + N1 * k2;
          fa[(size_t)tok * 768 + col] = f2bf(acc[i][r] * scale);
        }
    };
    gemm_tile2s<false, false>(smem, 4, la, lb, epi);
  }
  base += ntask;
}

DI void phase_mixc(const Prm& p, unsigned char* smem_raw, int l, int& base) {
  u16* smem = (u16*)smem_raw;
  float* st = (float*)(smem_raw + GEMM_SMEM);
  float* red = (float*)smem_raw;
  const int tid = tidx();
  TASK_LOOP(t, 512, base) {
    const int h = t & 3, ch = t >> 2, tok0 = ch * 128;
    {
      const int q = tid & 127, qf = tid >> 7;
      float s = 0.f, ss = 0.f;
      const u16* src = p.cvT + (size_t)(qf * 96) * TBP + tok0 + q;
      for (int c = 0; c < 96; ++c) { const float v = bf2f(src[(size_t)c * TBP]); s += v; ss += v * v; }
      red[qf * 256 + q * 2] = s; red[qf * 256 + q * 2 + 1] = ss;
      __syncthreads();
      if (tid < 128) {
        const float s1 = red[q * 2] + red[256 + q * 2] + red[512 + q * 2] + red[768 + q * 2];
        const float s2 = red[q * 2 + 1] + red[256 + q * 2 + 1] + red[512 + q * 2 + 1] + red[768 + q * 2 + 1];
        const float mu = s1 * (1.f / 384.f);
        const float var = fmaxf(s2 * (1.f / 384.f) - mu * mu, 0.f);
        st[q] = mu; st[128 + q] = rsqrtf(var + 1e-6f);
      }
      __syncthreads();
    }
    const u16* Wm = p.SgW + (size_t)((l * 4 + h) * 128) * 128;
    auto la = [&](int row, int k) __attribute__((always_inline)) { return *(const u32x4*)(Wm + row * 128 + k); };
    auto lb = [&](int row, int k) __attribute__((always_inline)) {
      if (row >= 96) return zero4();
      const int c = h * 96 + row;
      const u32x4 raw = *(const u32x4*)(p.cvT + (size_t)c * TBP + tok0 + k);
      const float g = p.ln_g[l * 384 + c], b = p.ln_b[l * 384 + c];
      u32x4 o;
#pragma unroll
      for (int jj = 0; jj < 4; ++jj) {
        const float v0 = (bflo(raw[jj]) - st[k + 2 * jj]) * st[128 + k + 2 * jj] * g + b;
        const float v1 = (bfhi(raw[jj]) - st[k + 2 * jj + 1]) * st[128 + k + 2 * jj + 1] * g + b;
        o[jj] = pack2(v0, v1);
      }
      return o;
    };
    auto epi = [&](f32x16 (&acc)[2], int wm, int wn, int lane) __attribute__((always_inline)) {
      const int lr = lane & 31, lh = lane >> 5;
      const int cl = wn * 32 + lr;
      if (cl < 96) {
#pragma unroll
        for (int i = 0; i < 2; ++i)
#pragma unroll
          for (int r = 0; r < 16; ++r) {
            const int pp = wm * 64 + i * 32 + rowmap(r, lh);
            const float val = acc[i][r] + p.sgu_b[(l * 4 + h) * 128 + pp];
            u16* dst = p.cu + (size_t)(tok0 + pp) * 384 + h * 96 + cl;
            *dst = f2bf(bf2f(*dst) * val);
          }
      }
    };
    gemm_tile<false, false>(smem, 2, la, lb, epi);
  }
  base += 512;
}

DI void phase_qup(const Prm& p, unsigned char* smem_raw, int l, int S, int& base) {
  u16* smem = (u16*)smem_raw;
  float* st = (float*)(smem_raw + GEMM_SMEM);
  const int tid = tidx();
  const float QS = 0.10206207261596577f * LOG2E;
  TASK_LOOP(t, 3 * 128, base) {
    const int tn = t % 3, tm = t / 3, n0 = tn * 128, m0 = tm * 128;
    {
      const int row = tid >> 2, qf = tid & 3;
      const u16* src = p.dcq + (size_t)(m0 + row) * 384 + qf * 96;
      float ss = 0.f;
#pragma unroll 4
      for (int c = 0; c < 12; ++c) {
        const u32x4 v = *(const u32x4*)(src + c * 8);
#pragma unroll
        for (int jj = 0; jj < 4; ++jj) { const float a = bflo(v[jj]), b = bfhi(v[jj]); ss += a * a + b * b; }
      }
      ss += __shfl_xor(ss, 1);
      ss += __shfl_xor(ss, 2);
      if (qf == 0) st[row] = rsqrtf(ss * (1.f / 384.f) + 1e-6f);
      __syncthreads();
    }
    const u16* W = p.WqT + (size_t)l * 384 * 384;
    auto la = [&](int row, int k) __attribute__((always_inline)) { return *(const u32x4*)(W + (size_t)(n0 + row) * 384 + k); };
    auto lb = [&](int row, int k) __attribute__((always_inline)) { return *(const u32x4*)(p.dcq + (size_t)(m0 + row) * 384 + k); };
    auto epi = [&](f32x16 (&acc)[2], int wm, int wn, int lane) __attribute__((always_inline)) {
      const int lr = lane & 31, lh = lane >> 5;
      const int tokl = wn * 32 + lr, tok = m0 + tokl;
      const float sc = st[tokl] * QS;
#pragma unroll
      for (int i = 0; i < 2; ++i) {
        const int nb = n0 + wm * 64 + i * 32;
        const int head = nb / 96, within = nb - head * 96;
        const f32x16& a = acc[i];
        if (within < 64) {
#pragma unroll
          for (int q = 0; q < 4; ++q)
            st4bf(p.qc + (size_t)tok * 384 + nb + 8 * q + 4 * lh, a[4 * q] * sc, a[4 * q + 1] * sc, a[4 * q + 2] * sc, a[4 * q + 3] * sc);
        } else {
          const int pos = tok & (S - 1);
#pragma unroll
          for (int q = 0; q < 2; ++q)
#pragma unroll
            for (int e = 0; e < 4; ++e) {
              const int r = 4 * q + e, ii = 8 * q + 4 * lh + e;
              const float2 cs = p.rope[pos * 16 + ii];
              const float x1 = a[r] * sc, x2 = a[r + 8] * sc;
              p.qc[(size_t)tok * 384 + head * 96 + 64 + ii] = f2bf(x1 * cs.x - x2 * cs.y);
              p.qc[(size_t)tok * 384 + head * 96 + 80 + ii] = f2bf(x1 * cs.y + x2 * cs.x);
            }
        }
      }
    };
    gemm_tile2s<false, false>(smem, 6, la, lb, epi);
    __syncthreads();
  }
  base += 3 * 128;
}

DI void phase_kvup(const Prm& p, unsigned char* smem_raw, int l, int& base) {
  u16* smem = (u16*)smem_raw;
  float* st = (float*)(smem_raw + GEMM_SMEM);
  const int tid = tidx();
  TASK_LOOP(t, 4 * 128, base) {
    const int tn = t & 3, tm = t >> 2, n0 = tn * 128, m0 = tm * 128;
    {
      const int row = tid >> 2, qf = tid & 3;
      const u16* src = p.dckv + (size_t)(m0 + row) * 320 + qf * 80;
      float ss = 0.f;
#pragma unroll 5
      for (int c = 0; c < 10; ++c) {
        const u32x4 v = *(const u32x4*)(src + c * 8);
#pragma unroll
        for (int jj = 0; jj < 4; ++jj) { const float a = bflo(v[jj]), b = bfhi(v[jj]); ss += a * a + b * b; }
      }
      ss += __shfl_xor(ss, 1);
      ss += __shfl_xor(ss, 2);
      if (qf == 0) st[row] = rsqrtf(ss * (1.f / 320.f) + 1e-6f);
      __syncthreads();
    }
    const u16* W = p.WkvT + (size_t)l * 512 * 320;
    auto la = [&](int row, int k) __attribute__((always_inline)) { return *(const u32x4*)(W + (size_t)(n0 + row) * 320 + k); };
    auto lb = [&](int row, int k) __attribute__((always_inline)) { return *(const u32x4*)(p.dckv + (size_t)(m0 + row) * 320 + k); };
    auto epi = [&](f32x16 (&acc)[2], int wm, int wn, int lane) __attribute__((always_inline)) {
      const int lr = lane & 31, lh = lane >> 5;
      const int head = tn;
      const int tokl = wn * 32 + lr, tok = m0 + tokl;
      const float sc = st[tokl];
#pragma unroll
      for (int i = 0; i < 2; ++i) {
        const int within = wm * 64 + i * 32;
        const f32x16& a = acc[i];
        if (within < 64) {
#pragma unroll
          for (int q = 0; q < 4; ++q)
            st4bf(p.kc + (size_t)tok * 384 + head * 96 + within + 8 * q + 4 * lh, a[4 * q] * sc, a[4 * q + 1] * sc, a[4 * q + 2] * sc, a[4 * q + 3] * sc);
        } else {
#pragma unroll
          for (int r = 0; r < 16; ++r)
            p.vT[(size_t)(head * 64 + within - 64 + rowmap(r, lh)) * TBP + tok] = f2bf(a[r] * sc);
        }
      }
    };
    gemm_tile2s<false, false>(smem, 5, la, lb, epi);
    __syncthreads();
  }
  base += 4 * 128;
}

DI void phase_mixb(const Prm& p, unsigned char* smem_raw, int S, int lgS, int& base) {
  float* bt = (float*)smem_raw;
  const int tid = tidx(), lane = tid & 63, wave = tid >> 6, lr = lane & 31, lh = lane >> 5;
  u16* vt = (u16*)(smem_raw + 3328) + wave * (64 * 40);
  for (int idx = tid; idx < 774; idx += NTH) bt[idx] = p.biasT[idx];
  __syncthreads();
  TASK_LOOP(t, 384, base) {
    const int wt = t * 8 + wave;
    const int hg = wt & 1, g = (wt >> 1) % 3, blk = wt / 6;
    const int seq = blk >> (lgS - 5), b_in = blk & ((S >> 5) - 1);
    const int lgd = 2 * g, L = S >> lgd;
    const int lgbpr = lgS - lgd - 5;
    const int res = b_in >> lgbpr, i0 = (b_in & ((1 << lgbpr) - 1)) << 5;
    const int tokbase = seq * S + res;
    const int hd = g * 2 + hg, hc = hd * 64;
    const int qi = i0 + lr;
    const int qtok = tokbase + (qi << lgd);
    bf16x8 qf[4];
#pragma unroll
    for (int ks = 0; ks < 4; ++ks) qf[ks] = *(const bf16x8*)(p.bqkv + (size_t)qtok * 1152 + hc + ks * 16 + lh * 8);
    f32x16 sc[5];
#pragma unroll
    for (int tt = 0; tt < 5; ++tt) {
      int ik = i0 - 64 + 32 * tt + lr;
      ik = min(max(ik, 0), L - 1);
      const u16* kp = p.bqkv + (size_t)(tokbase + (ik << lgd)) * 1152 + 384 + hc + lh * 8;
      sc[tt] = zero16();
#pragma unroll
      for (int ks = 0; ks < 4; ++ks) sc[tt] = mfma(*(const bf16x8*)(kp + ks * 16), qf[ks], sc[tt]);
    }
    float mx = -1e30f;
#pragma unroll
    for (int tt = 0; tt < 5; ++tt)
#pragma unroll
      for (int r = 0; r < 16; ++r) {
        const int ik = i0 - 64 + 32 * tt + rowmap(r, lh);
        const int rel = ik - qi;
        const bool valid = (rel >= -64) && (rel <= 64) && (ik >= 0) && (ik < L);
        const int bi = min(max(rel + 64, 0), 128);
        const float s = valid ? (sc[tt][r] * 0.125f + bt[hd * 129 + bi]) * LOG2E : -1e30f;
        sc[tt][r] = s;
        mx = fmaxf(mx, s);
      }
    mx = fmaxf(mx, __shfl_xor(mx, 32));
    float sum = 0.f;
#pragma unroll
    for (int tt = 0; tt < 5; ++tt)
#pragma unroll
      for (int r = 0; r < 16; ++r) {
        const float pv = ex2(sc[tt][r] - mx);
        sum += pv;
        sc[tt][r] = pv;
      }
    sum += __shfl_xor(sum, 32);
    f32x16 oacc[2];
    oacc[0] = zero16(); oacc[1] = zero16();
#pragma unroll
    for (int tt = 0; tt < 5; ++tt) {
#pragma unroll
      for (int e = 0; e < 4; ++e) {
        const int c = lane + 64 * e, key = c >> 3, dch = c & 7;
        int ik = i0 - 64 + 32 * tt + key;
        ik = min(max(ik, 0), L - 1);
        const u32x4 raw = *(const u32x4*)(p.bqkv + (size_t)(tokbase + (ik << lgd)) * 1152 + 768 + hc + dch * 8);
#pragma unroll
        for (int jj = 0; jj < 4; ++jj) {
          vt[(dch * 8 + 2 * jj) * 40 + key] = (u16)(raw[jj] & 0xffffu);
          vt[(dch * 8 + 2 * jj + 1) * 40 + key] = (u16)(raw[jj] >> 16);
        }
      }
      __syncthreads();
#pragma unroll
      for (int u = 0; u < 2; ++u) {
        u32x4 pk;
#pragma unroll
        for (int jj = 0; jj < 4; ++jj) pk[jj] = pack2(sc[tt][8 * u + 2 * jj], sc[tt][8 * u + 2 * jj + 1]);
        const bf16x8 pf = __builtin_bit_cast(bf16x8, pk);
#pragma unroll
        for (int dt = 0; dt < 2; ++dt) {
          const u16* vp = vt + (dt * 32 + lr) * 40 + 16 * u + 4 * lh;
          u32x4 vv;
          const u32x2 lo = *(const u32x2*)vp, hi = *(const u32x2*)(vp + 8);
          vv[0] = lo[0]; vv[1] = lo[1]; vv[2] = hi[0]; vv[3] = hi[1];
          oacc[dt] = mfma(__builtin_bit_cast(bf16x8, vv), pf, oacc[dt]);
        }
      }
      __syncthreads();
    }
    const float inv = 1.f / sum;
#pragma unroll
    for (int dt = 0; dt < 2; ++dt)
#pragma unroll
      for (int q = 0; q < 4; ++q) {
        float4 o;
        o.x = oacc[dt][4 * q] * inv; o.y = oacc[dt][4 * q + 1] * inv; o.z = oacc[dt][4 * q + 2] * inv; o.w = oacc[dt][4 * q + 3] * inv;
        *(float4*)(p.og + (size_t)qtok * 384 + hc + dt * 32 + 8 * q + 4 * lh) = o;
      }
    if (lh == 0) p.lse[(size_t)qtok * 6 + hd] = (mx + __log2f(sum)) * LN2;
  }
  base += 384;
  __syncthreads();
}

DI void phase_combb(const Prm& p) {
  const int gtid = blockIdx.x * NTH + tidx(), gn = gridDim.x * NTH;
  for (int idx = gtid; idx < TB * 32; idx += gn) {
    const int dq = idx & 15, hg = (idx >> 4) & 1, tok = idx >> 5;
    const float l0 = p.lse[(size_t)tok * 6 + hg], l1 = p.lse[(size_t)tok * 6 + 2 + hg], l2 = p.lse[(size_t)tok * 6 + 4 + hg];
    const float mx = fmaxf(l0, fmaxf(l1, l2));
    const float e0 = __expf(l0 - mx), e1 = __expf(l1 - mx), e2 = __expf(l2 - mx);
    const float inv = 1.f / (e0 + e1 + e2);
    const float4 a = *(const float4*)(p.og + (size_t)tok * 384 + hg * 64 + dq * 4);
    const float4 b = *(const float4*)(p.og + (size_t)tok * 384 + 128 + hg * 64 + dq * 4);
    const float4 c = *(const float4*)(p.og + (size_t)tok * 384 + 256 + hg * 64 + dq * 4);
    st4bf(p.ob + (size_t)tok * 128 + hg * 64 + dq * 4, (e0 * a.x + e1 * b.x + e2 * c.x) * inv, (e0 * a.y + e1 * b.y + e2 * c.y) * inv,
          (e0 * a.z + e1 * b.z + e2 * c.z) * inv, (e0 * a.w + e1 * b.w + e2 * c.w) * inv);
  }
}

constexpr int KS_ELEMS = 128 * 104, VS_ELEMS = 64 * 136;
DI void phase_mla(const Prm& p, unsigned char* smem_raw, int S, int lgS, int& base) {
  u16* Ks = (u16*)smem_raw;
  u16* Vs = Ks + 2 * KS_ELEMS;
  const int tid = tidx(), lane = tid & 63, wave = tid >> 6, lr = lane & 31, lh = lane >> 5;
  const int nkt = S >> 7;
  TASK_LOOP(t, 256, base) {
    const int head = t & 3, qb = t >> 2, tok0 = qb * 256;
    const int seqtok0 = (tok0 >> lgS) << lgS;
    const int qtok = tok0 + wave * 32 + lr;
    bf16x8 qf[6];
#pragma unroll
    for (int ks = 0; ks < 6; ++ks) qf[ks] = *(const bf16x8*)(p.qc + (size_t)qtok * 384 + head * 96 + ks * 16 + lh * 8);
    const u16* kbase = p.kc + (size_t)seqtok0 * 384 + head * 96;
    const u16* vbase = p.vT + (size_t)(head * 64) * TBP + seqtok0;
    u32x4 rk[3], rv[2];
    auto gload = [&](int kt) __attribute__((always_inline)) {
#pragma unroll
      for (int e = 0; e < 3; ++e) {
        const int c = tid + NTH * e, key = c / 12, dc = c - key * 12;
        rk[e] = *(const u32x4*)(kbase + (size_t)(kt * 128 + key) * 384 + dc * 8);
      }
#pragma unroll
      for (int e = 0; e < 2; ++e) {
        const int c = tid + NTH * e, d = c >> 4, kch = c & 15;
        rv[e] = *(const u32x4*)(vbase + (size_t)d * TBP + kt * 128 + kch * 8);
      }
    };
    auto sstore = [&](int buf) __attribute__((always_inline)) {
#pragma unroll
      for (int e = 0; e < 3; ++e) {
        const int c = tid + NTH * e, key = c / 12, dc = c - key * 12;
        *(u32x4*)(Ks + buf * KS_ELEMS + key * 104 + dc * 8) = rk[e];
      }
#pragma unroll
      for (int e = 0; e < 2; ++e) {
        const int c = tid + NTH * e, d = c >> 4, kch = c & 15;
        u16* vd = Vs + buf * VS_ELEMS + d * 136 + (kch >> 1) * 16 + (kch & 1) * 4;
        u32x2 lo, hi;
        lo[0] = rv[e][0]; lo[1] = rv[e][1]; hi[0] = rv[e][2]; hi[1] = rv[e][3];
        *(u32x2*)vd = lo;
        *(u32x2*)(vd + 8) = hi;
      }
    };
    float m = -1e30f;
    f32x2 lsum2 = {0.f, 0.f};
    f32x16 oacc[2];
    oacc[0] = zero16(); oacc[1] = zero16();
    gload(0);
    sstore(0);
    __syncthreads();
    for (int kt = 0; kt < nkt; ++kt) {
      const int buf = kt & 1;
      if (kt + 1 < nkt) gload(kt + 1);
      f32x16 s[4];
#pragma unroll
      for (int kk = 0; kk < 4; ++kk) s[kk] = zero16();
      {
        const u16* kp = Ks + buf * KS_ELEMS + lr * 104 + lh * 8;
        bf16x8 kf[4];
#pragma unroll
        for (int kk = 0; kk < 4; ++kk) kf[kk] = *(const bf16x8*)(kp + kk * 32 * 104);
#pragma unroll
        for (int ks = 0; ks < 6; ++ks) {
          bf16x8 kn[4];
          if (ks < 5) {
#pragma unroll
            for (int kk = 0; kk < 4; ++kk) kn[kk] = *(const bf16x8*)(kp + kk * 32 * 104 + (ks + 1) * 16);
          }
#pragma unroll
          for (int kk = 0; kk < 4; ++kk) s[kk] = mfma(kf[kk], qf[ks], s[kk]);
          if (ks < 5) {
#pragma unroll
            for (int kk = 0; kk < 4; ++kk) kf[kk] = kn[kk];
          }
        }
      }
      float mloc = -1e30f;
#pragma unroll
      for (int kk = 0; kk < 4; ++kk)
#pragma unroll
        for (int r = 0; r < 16; ++r) mloc = fmaxf(mloc, s[kk][r]);
      mloc = fmaxf(mloc, __shfl_xor(mloc, 32));
      const float mnew = fmaxf(m, mloc);
      const float alpha = ex2(m - mnew);
      m = mnew;
      lsum2 *= alpha;
      const f32x2 mn2 = {mnew, mnew};
#pragma unroll
      for (int kk = 0; kk < 4; ++kk)
#pragma unroll
        for (int r2 = 0; r2 < 8; ++r2) {
          f32x2 v = {s[kk][2 * r2], s[kk][2 * r2 + 1]};
          v = v - mn2;
          f32x2 pv;
          pv[0] = ex2(v[0]); pv[1] = ex2(v[1]);
          lsum2 += pv;
          s[kk][2 * r2] = pv[0]; s[kk][2 * r2 + 1] = pv[1];
        }
#pragma unroll
      for (int dt = 0; dt < 2; ++dt)
#pragma unroll
        for (int r = 0; r < 16; ++r) oacc[dt][r] *= alpha;
#pragma unroll
      for (int kk = 0; kk < 4; ++kk)
#pragma unroll
        for (int u = 0; u < 2; ++u) {
          u32x4 pk;
#pragma unroll
          for (int jj = 0; jj < 4; ++jj) pk[jj] = pack2(s[kk][8 * u + 2 * jj], s[kk][8 * u + 2 * jj + 1]);
          const bf16x8 pf = __builtin_bit_cast(bf16x8, pk);
#pragma unroll
          for (int dt = 0; dt < 2; ++dt) {
            const u16* vp = Vs + buf * VS_ELEMS + (dt * 32 + lr) * 136 + kk * 32 + 16 * u + 8 * lh;
            oacc[dt] = mfma(*(const bf16x8*)vp, pf, oacc[dt]);
          }
        }
      if (kt + 1 < nkt) sstore(buf ^ 1);
      __syncthreads();
    }
    float lsum = lsum2[0] + lsum2[1];
    lsum += __shfl_xor(lsum, 32);
    const float inv = 1.f / lsum;
#pragma unroll
    for (int dt = 0; dt < 2; ++dt)
#pragma unroll
      for (int q = 0; q < 4; ++q)
        st4bf(p.od + (size_t)qtok * 256 + head * 64 + dt * 32 + 8 * q + 4 * lh, oacc[dt][4 * q] * inv, oacc[dt][4 * q + 1] * inv,
              oacc[dt][4 * q + 2] * inv, oacc[dt][4 * q + 3] * inv);
  }
  base += 256;
}

template <class ACC>
DI void merge_branch(const Prm& p, u16* smem, const u16* W, const u16* X, int ld, int bi, int n0, int m0, ACC& macc) {
  auto la = [&](int row, int k) __attribute__((always_inline)) { return *(const u32x4*)(W + (size_t)(n0 + row) * ld + k); };
  auto lb = [&](int row, int k) __attribute__((always_inline)) { return *(const u32x4*)(X + (size_t)(m0 + row) * ld + k); };
  auto epi = [&](f32x16 (&acc)[2], int wm, int wn, int lane) __attribute__((always_inline)) {
    const int lr = lane & 31, lh = lane >> 5;
    const int tok = m0 + wn * 32 + lr;
#pragma unroll
    for (int i = 0; i < 2; ++i)
#pragma unroll
      for (int q = 0; q < 4; ++q) {
        const int n = n0 + wm * 64 + i * 32 + 8 * q + 4 * lh;
        const u32x2 gz = *(const u32x2*)(p.zg + (size_t)tok * 4096 + bi * 1024 + n);
        macc[i][4 * q] += bflo(gz[0]) * acc[i][4 * q];
        macc[i][4 * q + 1] += bfhi(gz[0]) * acc[i][4 * q + 1];
        macc[i][4 * q + 2] += bflo(gz[1]) * acc[i][4 * q + 2];
        macc[i][4 * q + 3] += bfhi(gz[1]) * acc[i][4 * q + 3];
      }
  };
  gemm_tile2s<false, false>(smem, ld >> 6, la, lb, epi);
}

DI void phase_merge(const Prm& p, u16* smem, int l, int& base) {
  TASK_LOOP(t, 8 * 128, base) {
    const int tn = t & 7, tm = t >> 3, n0 = tn * 128, m0 = tm * 128;
    f32x16 macc[2];
    macc[0] = zero16(); macc[1] = zero16();
    merge_branch(p, smem, p.PaT + (size_t)l * 1024 * 768, p.UT, 768, 0, n0, m0, macc);
    merge_branch(p, smem, p.PbT + (size_t)l * 1024 * 128, p.ob, 128, 1, n0, m0, macc);
    merge_branch(p, smem, p.PcT + (size_t)l * 1024 * 384, p.cu, 384, 2, n0, m0, macc);
    merge_branch(p, smem, p.PdT + (size_t)l * 1024 * 256, p.od, 256, 3, n0, m0, macc);
    const int tid2 = tidx(), lane = tid2 & 63, wave = tid2 >> 6, wm = wave >> 2, wn = wave & 3, lr = lane & 31, lh = lane >> 5;
    const int tok = m0 + wn * 32 + lr;
#pragma unroll
    for (int i = 0; i < 2; ++i)
#pragma unroll
      for (int q = 0; q < 4; ++q)
        st4bf(p.hbuf + (size_t)tok * 1024 + n0 + wm * 64 + i * 32 + 8 * q + 4 * lh, macc[i][4 * q], macc[i][4 * q + 1],
              macc[i][4 * q + 2], macc[i][4 * q + 3]);
  }
  base += 8 * 128;
}

DI void phase_resid_gemm(const Prm& p, unsigned char* smem_raw, const u16* W, const u16* X, int K, const float* xsrc, float* xdst,
                         const float* modl, int gtoff, int sb, int& base) {
  LAS u16* shm = (LAS u16*)smem_raw;
  bool pre = false;
  TASK_LOOP(t, 4 * 64, base) {
    int tn, tm;
    map256(t, 4, tn, tm);
    const int brow = tn * 256, bcol = tm * 256;
    const int tnx = t + (int)gridDim.x;
    const bool has_next = tnx < (4 * 64);
    int tn2 = 0, tm2 = 0;
    if (has_next) map256(tnx, 4, tn2, tm2);
    const int nbrow = tn2 * 256, nbcol = tm2 * 256;
    auto epi = [&](f32x4 (&acc)[2][2][4][2], int wr, int wc, int fr, int fq) __attribute__((always_inline)) {
#pragma unroll
      for (int bj = 0; bj < 2; ++bj)
#pragma unroll
        for (int n = 0; n < 2; ++n) {
          const int tok = bcol + bj * 128 + wc * 32 + n * 16 + fr;
          const float* gt = modl + condrow(sb, tok) * 6144 + gtoff;
#pragma unroll
          for (int ai = 0; ai < 2; ++ai)
#pragma unroll
            for (int m = 0; m < 4; ++m) {
              const int nn = brow + ai * 128 + wr * 64 + m * 16 + fq * 4;
              const f32x4 v = acc[ai][bj][m][n];
              const float4 g4 = *(const float4*)(gt + nn);
              const float4 xi = *(const float4*)(xsrc + (size_t)tok * 1024 + nn);
              float4 o;
              o.x = xi.x + g4.x * v[0]; o.y = xi.y + g4.y * v[1]; o.z = xi.z + g4.z * v[2]; o.w = xi.w + g4.w * v[3];
              *(float4*)(xdst + (size_t)tok * 1024 + nn) = o;
            }
        }
    };
    gemm256<false>(shm, W, X, K, brow, bcol, pre, has_next, nbrow, nbcol, epi);
    pre = has_next;
  }
  base += 4 * 64;
}

DI void phase_w1(const Prm& p, unsigned char* smem_raw, int l, int& base) {
  const u16* W = p.W1T + (size_t)l * 4096 * 1024;
  LAS u16* shm = (LAS u16*)smem_raw;
  bool pre = false;
  TASK_LOOP(t, 16 * 64, base) {
    int tn, tm;
    map256(t, 16, tn, tm);
    const int brow = tn * 256, bcol = tm * 256;
    const int tnx = t + (int)gridDim.x;
    const bool has_next = tnx < (16 * 64);
    int tn2 = 0, tm2 = 0;
    if (has_next) map256(tnx, 16, tn2, tm2);
    const int nbrow = tn2 * 256, nbcol = tm2 * 256;
    auto epi = [&](f32x4 (&acc)[2][2][4][2], int wr, int wc, int fr, int fq) __attribute__((always_inline)) {
#pragma unroll
      for (int bj = 0; bj < 2; ++bj)
#pragma unroll
        for (int n = 0; n < 2; ++n) {
          const int tok = bcol + bj * 128 + wc * 32 + n * 16 + fr;
#pragma unroll
          for (int ai = 0; ai < 2; ++ai)
#pragma unroll
            for (int mp = 0; mp < 2; ++mp) {
              const int nn = brow + ai * 128 + wr * 64 + mp * 32 + fq * 8;
              const f32x4 v = acc[ai][bj][2 * mp][n], w = acc[ai][bj][2 * mp + 1][n];
              const float a0 = fmaxf(v[0], 0.f), a1 = fmaxf(v[1], 0.f), a2 = fmaxf(v[2], 0.f), a3 = fmaxf(v[3], 0.f);
              const float b0 = fmaxf(w[0], 0.f), b1 = fmaxf(w[1], 0.f), b2 = fmaxf(w[2], 0.f), b3 = fmaxf(w[3], 0.f);
              u32x4 o;
              o[0] = pack2(a0 * a0, a1 * a1); o[1] = pack2(a2 * a2, a3 * a3); o[2] = pack2(b0 * b0, b1 * b1); o[3] = pack2(b2 * b2, b3 * b3);
              *(u32x4*)(p.zg + (size_t)tok * 4096 + nn) = o;
            }
        }
    };
    gemm256<true>(shm, W, p.hbuf, 1024, brow, bcol, pre, has_next, nbrow, nbcol, epi);
    pre = has_next;
  }
  base += 16 * 64;
}

DI void phase_final(const Prm& p) {
  const int tid = tidx(), lane = tid & 63;
  const int gw = blockIdx.x * 8 + (tid >> 6), nw = gridDim.x * 8;
  for (int row = gw; row < 3 * TB; row += nw) {
    float* xr = p.out + (size_t)row * 1024;
    float4 v[4];
    float ss = 0.f;
#pragma unroll
    for (int i = 0; i < 4; ++i) {
      v[i] = *(const float4*)(xr + i * 256 + lane * 4);
      ss += v[i].x * v[i].x + v[i].y * v[i].y + v[i].z * v[i].z + v[i].w * v[i].w;
    }
#pragma unroll
    for (int off = 32; off >= 1; off >>= 1) ss += __shfl_xor(ss, off);
    const float rstd = rsqrtf(ss * (1.f / 1024.f) + 1e-6f);
#pragma unroll
    for (int i = 0; i < 4; ++i) {
      const int col = i * 256 + lane * 4;
      const float4 gg = *(const float4*)(p.final_g + col);
      float4 o;
      o.x = v[i].x * rstd * gg.x; o.y = v[i].y * rstd * gg.y; o.z = v[i].z * rstd * gg.z; o.w = v[i].w * rstd * gg.w;
      *(float4*)(xr + col) = o;
    }
  }
}

__global__ void __launch_bounds__(512) mega(Prm p) {
  cg::grid_group grid = cg::this_grid();
  __shared__ __attribute__((aligned(16))) unsigned char smem_raw[SMEM_BYTES];
  __shared__ uint4 xb_words;
  u16* smem = (u16*)smem_raw;
  if (threadIdx.x == 0) xb_words = make_uint4(0u, 0u, 0u, 0u);
  __syncthreads();
  const XcdBarrier xb = xcd_barrier_post(p.bar, (volatile LAS unsigned*)&xb_words);
  int base = 0;
  prologue_a(p, smem_raw, base);
  if (PROBE == 11) prologue_a(p, smem_raw, base);
  grid.sync();
  prologue_b(p);
  xcd_barrier(xb);
  for (int sb = 0; sb < 3; ++sb) {
    const int S = sb == 0 ? 16384 : 2048, lgS = sb == 0 ? 14 : 11, nseq = sb == 0 ? 1 : 8;
    const int N1 = S >> 7, lgN1 = lgS - 7;
    const float* xin = sb == 0 ? p.x_prompt : p.x_sample + (size_t)(sb - 1) * TB * 1024;
    float* xo = p.out + (size_t)sb * TB * 1024;
    for (int l = 0; l < 4; ++l) {
      const float* xs = l == 0 ? xin : xo;
      const float* modl = p.mod + (size_t)l * 17 * 6144;
      phase_norm(p, xs, p.norm1_g + l * 1024, modl, 0, 1024, sb);
      xcd_barrier(xb);
      phase_inproj(p, smem_raw, l, S, base);
      if (PROBE == 2 || PROBE == 7) phase_inproj(p, smem_raw, l, S, base);
      if (PROBE == 12) phase_inproj_probe(p, smem_raw, l, base);
      xcd_barrier(xb);
      if (PROBE == 5) xcd_barrier(xb);
      if (N1 == 16) phase_fft1_small(p, nseq); else phase_fft1(p, smem, S, nseq, N1, lgN1, base);
      phase_mixb(p, smem_raw, S, lgS, base);
      phase_mixc(p, smem_raw, l, base);
      phase_qup(p, smem_raw, l, S, base);
      phase_kvup(p, smem_raw, l, base);
      phase_inproj_tail(p, smem_raw, l, base);
      if (PROBE == 13) phase_fft1(p, smem, S, nseq, N1, lgN1, base);
      if (PROBE == 14) phase_mixb(p, smem_raw, S, lgS, base);
      if (PROBE == 15) { phase_qup(p, smem_raw, l, S, base); phase_kvup(p, smem_raw, l, base); phase_inproj_tail(p, smem_raw, l, base); }
      if (PROBE == 4) { phase_fft1(p, smem, S, nseq, N1, lgN1, base); phase_mixb(p, smem_raw, S, lgS, base); phase_qup(p, smem_raw, l, S, base); phase_kvup(p, smem_raw, l, base); }
      xcd_barrier(xb);
      if (PROBE == 5) xcd_barrier(xb);
      phase_mla(p, smem_raw, S, lgS, base);
      if (PROBE == 1) phase_mla(p, smem_raw, S, lgS, base);
      phase_fft2(p, smem, S, nseq, N1, base);
      phase_combb(p);
      if (PROBE == 6) { phase_fft2(p, smem, S, nseq, N1, base); phase_combb(p); }
      xcd_barrier(xb);
      if (PROBE == 5) xcd_barrier(xb);
      phase_merge(p, smem, l, base);
      if (PROBE == 3) phase_merge(p, smem, l, base);
      xcd_barrier(xb);
      if (PROBE == 5) xcd_barrier(xb);
      phase_resid_gemm(p, smem_raw, p.WoT + (size_t)l * 1024 * 1024, p.hbuf, 1024, xs, xo, modl, 2048, sb, base);
      xcd_barrier(xb);
      phase_norm(p, xo, p.norm2_g + l * 1024, modl, 3072, 4096, sb);
      if (PROBE == 9) { phase_norm(p, xo, p.norm2_g + l * 1024, modl, 3072, 4096, sb); phase_norm(p, xo, p.norm2_g + l * 1024, modl, 3072, 4096, sb); }
      xcd_barrier(xb);
      phase_w1(p, smem_raw, l, base);
      if (PROBE == 2 || PROBE == 8) phase_w1(p, smem_raw, l, base);
      xcd_barrier(xb);
      if (PROBE == 5) xcd_barrier(xb);
      phase_resid_gemm(p, smem_raw, p.W2T + (size_t)l * 1024 * 4096, p.zg, 4096, xo, xo, modl, 5120, sb, base);
      xcd_barrier(xb);
    }
  }
  phase_final(p);
}

extern "C" void kernel_launch(void* const* d_in, const int* in_sizes, int n_in, void* d_out, int out_size, void* d_ws, size_t ws_size,
                              hipStream_t stream) {
  Prm p{};
  const float* const* in = (const float* const*)d_in;
  p.x_prompt = in[0]; p.x_sample = in[1]; p.c_prompt = in[2]; p.c_sample = in[3]; p.rel_bias = in[4]; p.ada_w = in[5]; p.ada_b = in[6];
  p.norm1_g = in[7]; p.w_in = in[8]; p.qn_g = in[9]; p.kvn_g = in[10]; p.w_uq = in[11]; p.w_ukv = in[12]; p.ln_g = in[13]; p.ln_b = in[14];
  p.sgu_w = in[15]; p.sgu_b = in[16]; p.p_a = in[17]; p.p_b = in[18]; p.p_c = in[19]; p.p_d = in[20]; p.w_o = in[21]; p.norm2_g = in[22];
  p.w1 = in[23]; p.w2 = in[24]; p.final_g = in[25];
  p.out = (float*)d_out;
  char* w = (char*)d_ws;
  size_t off = 0;
  auto take = [&](size_t bytes) __attribute__((always_inline)) { void* r = w + off; off += (bytes + 255) & ~(size_t)255; return r; };
  p.WinT = (u16*)take((size_t)4 * NWP * 1024 * 2);
  p.W1T = (u16*)take((size_t)4 * 4096 * 1024 * 2);
  p.W2T = (u16*)take((size_t)4 * 4096 * 1024 * 2);
  p.WoT = (u16*)take((size_t)4 * 1024 * 1024 * 2);
  p.PaT = (u16*)take((size_t)4 * 1024 * 768 * 2);
  p.PbT = (u16*)take((size_t)4 * 1024 * 128 * 2);
  p.PcT = (u16*)take((size_t)4 * 1024 * 384 * 2);
  p.PdT = (u16*)take((size_t)4 * 1024 * 256 * 2);
  p.WqT = (u16*)take((size_t)4 * 384 * 384 * 2);
  p.WkvT = (u16*)take((size_t)4 * 512 * 320 * 2);
  p.SgW = (u16*)take((size_t)4 * 4 * 128 * 128 * 2);
  p.M1a = (u16*)take(256 * 256 * 2);
  p.M1b = (u16*)take(32 * 64 * 2);
  p.M2 = (u16*)take(128 * 256 * 2);
  p.tw = (float2*)take(16384 * 8);
  p.rope = (float2*)take((size_t)16384 * 16 * 8);
  p.biasT = (float*)take(6 * 129 * 4);
  p.mod = (float*)take((size_t)4 * 17 * 6144 * 4);
  p.hbuf = (u16*)take((size_t)TB * 1024 * 2);
  p.og = (float*)take((size_t)TB * 384 * 4);
  p.UT = (u16*)take((size_t)1536 * TBP * 2);
  p.Gp = (u16*)take((size_t)1536 * TB * 2);
  p.bqkv = (u16*)take((size_t)TB * 1152 * 2);
  p.ob = (u16*)take((size_t)TB * 128 * 2);
  p.cu = (u16*)take((size_t)TB * 384 * 2);
  p.cvT = (u16*)take((size_t)TBP * 384 * 2);
  p.dcq = (u16*)take((size_t)TB * 384 * 2);
  p.dckv = (u16*)take((size_t)TB * 320 * 2);
  p.qc = (u16*)take((size_t)TB * 384 * 2);
  p.kc = (u16*)take((size_t)TB * 384 * 2);
  p.vT = (u16*)take((size_t)TBP * 256 * 2);
  p.od = (u16*)take((size_t)TB * 256 * 2);
  p.lse = (float*)take((size_t)TB * 6 * 4);
  p.zg = (u16*)take((size_t)TB * 4096 * 2);
  p.bar = (unsigned*)take(XCD_BAR_WORDS * 4);
  p.modpart = (float*)p.zg;
  if (off > ws_size) { fprintf(stderr, "workspace too small: need %zu have %zu\n", off, ws_size); return; }
  static int grid_blocks = 0;
  if (!grid_blocks) {
    int dev = 0, cus = 0, per_cu = 0;
    (void)hipGetDevice(&dev);
    (void)hipDeviceGetAttribute(&cus, hipDeviceAttributeMultiprocessorCount, dev);
    (void)hipOccupancyMaxActiveBlocksPerMultiprocessor(&per_cu, mega, NTH, 0);
    if (per_cu < 1) per_cu = 1;
    if (per_cu > 1) per_cu = 1;
    grid_blocks = cus * per_cu;
  }
  (void)hipMemsetAsync(p.bar, 0, XCD_BAR_WORDS * 4, stream);
  void* args[] = {&p};
  hipError_t e = hipLaunchCooperativeKernel((void*)mega, dim3(grid_blocks), dim3(NTH), args, 0, stream);
  if (e != hipSuccess) fprintf(stderr, "cooperative launch failed: %s (grid %d)\n", hipGetErrorString(e), grid_blocks);
}
```

```cpp
#include <hip/hip_runtime.h>
#include <hip/hip_cooperative_groups.h>
#include <stdint.h>
#include <stdio.h>
namespace cg = cooperative_groups;

#define DI __device__ __forceinline__
#define LAS __attribute__((address_space(3)))
typedef unsigned short u16;
typedef __attribute__((ext_vector_type(8))) short bf16x8;
typedef __attribute__((ext_vector_type(4))) short bf16x4;
typedef __attribute__((ext_vector_type(16))) float f32x16;
typedef __attribute__((ext_vector_type(4))) float f32x4;
typedef __attribute__((ext_vector_type(2))) float f32x2;
typedef __attribute__((ext_vector_type(4))) unsigned u32x4;
typedef __attribute__((ext_vector_type(2))) unsigned u32x2;
typedef __attribute__((ext_vector_type(2))) __bf16 bf2_t;

constexpr int TB = 16384;
constexpr int TBP = TB + 64;
constexpr int NW = 8288;
constexpr int NWP = 8320;
constexpr int LDT = 72;
constexpr int TILE_ELEMS = 128 * LDT;
constexpr int GEMM_SMEM = 4 * TILE_ELEMS * 2;
constexpr int SMEM_BYTES = 131072;
#ifndef PROBE
#define PROBE 0
#endif
constexpr int NTH = 512;
constexpr int HT = 128 * 64;
constexpr float LOG2E = 1.4426950408889634f;
constexpr float LN2 = 0.6931471805599453f;

struct Prm {
  const float *x_prompt, *x_sample, *c_prompt, *c_sample, *rel_bias, *ada_w, *ada_b, *norm1_g, *w_in,
      *qn_g, *kvn_g, *w_uq, *w_ukv, *ln_g, *ln_b, *sgu_w, *sgu_b, *p_a, *p_b, *p_c, *p_d, *w_o,
      *norm2_g, *w1, *w2, *final_g;
  float* out;
  u16 *WinT, *W1T, *W2T, *WoT, *PaT, *PbT, *PcT, *PdT, *WqT, *WkvT, *SgW, *M1a, *M1b, *M2;
  float2 *tw, *rope;
  float *biasT, *mod, *modpart;
  u16 *hbuf, *UT, *Gp, *bqkv, *ob, *cu, *cvT, *dcq, *dckv, *qc, *kc, *vT, *od, *zg;
  float *og, *lse;
  unsigned* bar;
};

DI unsigned pack2(float a, float b) { bf2_t v; v[0] = (__bf16)a; v[1] = (__bf16)b; return __builtin_bit_cast(unsigned, v); }
DI u16 f2bf(float a) { return __builtin_bit_cast(u16, (__bf16)a); }
DI float bf2f(u16 v) { return __uint_as_float(((unsigned)v) << 16); }
DI float bflo(unsigned w) { return __uint_as_float(w << 16); }
DI float bfhi(unsigned w) { return __uint_as_float(w & 0xffff0000u); }
DI void st4bf(u16* dst, float a, float b, float c, float d) { u32x2 v; v[0] = pack2(a, b); v[1] = pack2(c, d); *(u32x2*)dst = v; }
DI void st4bf_nt(u16* dst, float a, float b, float c, float d) { u32x2 v; v[0] = pack2(a, b); v[1] = pack2(c, d); __builtin_nontemporal_store(v, (u32x2*)dst); }
DI void st8bf(u16* dst, const f32x4& a, const f32x4& b) { u32x4 o; o[0] = pack2(a[0], a[1]); o[1] = pack2(a[2], a[3]); o[2] = pack2(b[0], b[1]); o[3] = pack2(b[2], b[3]); *(u32x4*)dst = o; }
DI int rowmap(int r, int lh) { return (r & 3) + 8 * (r >> 2) + 4 * lh; }
DI f32x16 mfma(bf16x8 a, bf16x8 b, f32x16 c) { return __builtin_amdgcn_mfma_f32_32x32x16_bf16(a, b, c, 0, 0, 0); }
DI u32x4 zero4() { u32x4 z; z[0] = 0; z[1] = 0; z[2] = 0; z[3] = 0; return z; }
DI f32x16 zero16() { f32x16 z; for (int i = 0; i < 16; ++i) z[i] = 0.f; return z; }
DI float ex2(float x) { return __builtin_amdgcn_exp2f(x); }
DI int tidx() { int t = threadIdx.x; asm volatile("" : "+v"(t)); return t; }


#define XB_TMO      128
#define XB_XCNT(j)  (256  + 64 * (j))
#define XB_XSUB(j)  (1280 + 64 * (j))
#define XB_XGEN(j)  (2304 + 64 * (j))
#define XB_TOP      3328
#define XB_TOPGEN   3392
#define XCD_BAR_WORDS 3456
#define XB_SPIN_CAP (1u << 18)
DI unsigned xb_ld(unsigned* p) { return __hip_atomic_load(p, __ATOMIC_RELAXED, __HIP_MEMORY_SCOPE_AGENT); }
DI unsigned xb_add(unsigned* p, unsigned v) { return __hip_atomic_fetch_add(p, v, __ATOMIC_RELAXED, __HIP_MEMORY_SCOPE_AGENT); }
DI unsigned xb_xcc_id() { return (unsigned)__builtin_amdgcn_s_getreg((3 << 11) | 20) & 0xFu; }
#define XB_SPIN(cond, bar) do { unsigned _sp = 0; while (cond) { __builtin_amdgcn_s_sleep(1); \
    if ((++_sp & 255u) == 0u) { if (xb_ld(&(bar)[XB_TMO])) break; if (_sp > XB_SPIN_CAP) { atomicAdd(&(bar)[XB_TMO], 1u); break; } } } } while (0)
struct XcdBarrier { unsigned* bar; unsigned x; volatile LAS unsigned* st; };
DI XcdBarrier xcd_barrier_post(unsigned* bar, volatile LAS unsigned* st) {
  XcdBarrier b; b.bar = bar; b.x = xb_xcc_id(); b.st = st;
  if (threadIdx.x == 0) (void)xb_add(&bar[XB_XCNT(b.x)], 1u);
  return b;
}
DI void xcd_barrier_complete(unsigned* bar, unsigned x, unsigned& nloc, unsigned& nx) {
  const unsigned G = gridDim.x * gridDim.y * gridDim.z;
  unsigned sum, cnt, mine, sp = 0u;
  for (;;) {
    sum = 0u; cnt = 0u; mine = 0u;
#pragma unroll
    for (unsigned j = 0; j < 16; ++j) { const unsigned c = xb_ld(&bar[XB_XCNT(j)]); sum += c; cnt += (c > 0u) ? 1u : 0u; mine = (j == x) ? c : mine; }
    if (sum == G) break;
    __builtin_amdgcn_s_sleep(1);
    if ((++sp & 255u) == 0u) { if (xb_ld(&bar[XB_TMO])) break; if (sp > XB_SPIN_CAP) { atomicAdd(&bar[XB_TMO], 1u); break; } }
  }
  nloc = mine > 0u ? mine : 1u; nx = cnt > 0u ? cnt : 1u;
}
DI void xcd_barrier(const XcdBarrier& b) {
  asm volatile("s_waitcnt vmcnt(0)" ::: "memory");
  __syncthreads();
  if (tidx() == 0) {
    unsigned* bar = b.bar;
    const unsigned bx = (unsigned)__builtin_amdgcn_readfirstlane((int)xb_xcc_id());
    __builtin_amdgcn_s_waitcnt(0);
    unsigned nloc = b.st[0], nx = b.st[1];
    if (nloc == 0u) { xcd_barrier_complete(bar, bx, nloc, nx); b.st[0] = nloc; b.st[1] = nx; }
    const unsigned old = xb_add(&bar[XB_XSUB(bx)], 1u);
    const unsigned gen = old / nloc;
    if (old + 1u == (gen + 1u) * nloc) {
      __builtin_amdgcn_fence(__ATOMIC_RELEASE, "agent");
      asm volatile("s_waitcnt vmcnt(0)" ::: "memory");
      const unsigned og = xb_add(&bar[XB_TOP], 1u);
      const unsigned tg = og / nx;
      if (og + 1u == (tg + 1u) * nx) xb_add(&bar[XB_TOPGEN], 1u);
      else XB_SPIN(xb_ld(&bar[XB_TOPGEN]) == tg, bar);
      __builtin_amdgcn_fence(__ATOMIC_ACQUIRE, "agent");
      xb_add(&bar[XB_XGEN(bx)], 1u);
      asm volatile("s_waitcnt vmcnt(0)" ::: "memory");
    } else {
      XB_SPIN(xb_ld(&bar[XB_XGEN(bx)]) == gen, bar);
      __builtin_amdgcn_fence(__ATOMIC_ACQUIRE, "agent");
      asm volatile("s_waitcnt vmcnt(0)" ::: "memory");
    }
  }
  __syncthreads();
}

#define TASK_LOOP(t, nt, base) for (int t = (int)((blockIdx.x + gridDim.x - ((unsigned)(base) % gridDim.x)) % gridDim.x); t < (nt); t += gridDim.x)

template <bool RFA, bool RFB, class LA, class LB, class EPI>
DI void gemm_tile(u16* smem, int nk, LA la, LB lb, EPI epi) {
  const int tid = tidx(), lane = tid & 63, wave = tid >> 6;
  const int wm = wave >> 2, wn = wave & 3, lr = lane & 31, lh = lane >> 5;
  u16* As = smem;
  u16* Bs = smem + 2 * TILE_ELEMS;
  f32x16 acc[2];
  acc[0] = zero16(); acc[1] = zero16();
  u32x4 ra[2], rb[2];
#define A_ROW(c) (RFA ? ((c) & 127) : ((c) >> 3))
#define A_KC(c) (RFA ? ((c) >> 7) : ((c) & 7))
#define B_ROW(c) (RFB ? ((c) & 127) : ((c) >> 3))
#define B_KC(c) (RFB ? ((c) >> 7) : ((c) & 7))
#pragma unroll
  for (int i = 0; i < 2; ++i) { const int c = tid + NTH * i; ra[i] = la(A_ROW(c), A_KC(c) * 8); rb[i] = lb(B_ROW(c), B_KC(c) * 8); }
#pragma unroll
  for (int i = 0; i < 2; ++i) {
    const int c = tid + NTH * i;
    *(u32x4*)(As + A_ROW(c) * LDT + A_KC(c) * 8) = ra[i];
    *(u32x4*)(Bs + B_ROW(c) * LDT + B_KC(c) * 8) = rb[i];
  }
  __syncthreads();
  for (int kt = 0; kt < nk; ++kt) {
    const int buf = kt & 1;
    if (kt + 1 < nk) {
      const int k0 = (kt + 1) * 64;
#pragma unroll
      for (int i = 0; i < 2; ++i) { const int c = tid + NTH * i; ra[i] = la(A_ROW(c), k0 + A_KC(c) * 8); rb[i] = lb(B_ROW(c), k0 + B_KC(c) * 8); }
    }
    const u16* Ab = As + buf * TILE_ELEMS + (wm * 64 + lr) * LDT + lh * 8;
    const u16* Bb = Bs + buf * TILE_ELEMS + (wn * 32 + lr) * LDT + lh * 8;
#pragma unroll
    for (int ks = 0; ks < 4; ++ks) {
      const bf16x8 a0 = *(const bf16x8*)(Ab + ks * 16);
      const bf16x8 a1 = *(const bf16x8*)(Ab + 32 * LDT + ks * 16);
      const bf16x8 b = *(const bf16x8*)(Bb + ks * 16);
      acc[0] = mfma(a0, b, acc[0]);
      acc[1] = mfma(a1, b, acc[1]);
    }
    if (kt + 1 < nk) {
      u16* Aw = As + (buf ^ 1) * TILE_ELEMS;
      u16* Bw = Bs + (buf ^ 1) * TILE_ELEMS;
#pragma unroll
      for (int i = 0; i < 2; ++i) {
        const int c = tid + NTH * i;
        *(u32x4*)(Aw + A_ROW(c) * LDT + A_KC(c) * 8) = ra[i];
        *(u32x4*)(Bw + B_ROW(c) * LDT + B_KC(c) * 8) = rb[i];
      }
    }
    __syncthreads();
  }
  epi(acc, wm, wn, lane);
}

template <bool RFA, bool RFB, class LA, class LB, class EPI>
DI void gemm_tile2s(u16* smem, int nk, LA la, LB lb, EPI epi) {
  const int tid = tidx(), lane = tid & 63, wave = tid >> 6;
  const int wm = wave >> 2, wn = wave & 3, lr = lane & 31, lh = lane >> 5;
  u16* As = smem;
  u16* Bs = smem + 2 * TILE_ELEMS;
  f32x16 acc[2];
  acc[0] = zero16(); acc[1] = zero16();
  u32x4 ra0[2], rb0[2], ra1[2], rb1[2];
  auto ld = [&](u32x4 (&ra)[2], u32x4 (&rb)[2], int kt) __attribute__((always_inline)) {
    const int k0 = kt * 64;
#pragma unroll
    for (int i = 0; i < 2; ++i) { const int c = tid + NTH * i; ra[i] = la(A_ROW(c), k0 + A_KC(c) * 8); rb[i] = lb(B_ROW(c), k0 + B_KC(c) * 8); }
  };
  auto stl = [&](u32x4 (&ra)[2], u32x4 (&rb)[2], int buf) __attribute__((always_inline)) {
#pragma unroll
    for (int i = 0; i < 2; ++i) {
      const int c = tid + NTH * i;
      *(u32x4*)(As + buf * TILE_ELEMS + A_ROW(c) * LDT + A_KC(c) * 8) = ra[i];
      *(u32x4*)(Bs + buf * TILE_ELEMS + B_ROW(c) * LDT + B_KC(c) * 8) = rb[i];
    }
  };
  auto compute = [&](int buf) __attribute__((always_inline)) {
    const u16* Ab = As + buf * TILE_ELEMS + (wm * 64 + lr) * LDT + lh * 8;
    const u16* Bb = Bs + buf * TILE_ELEMS + (wn * 32 + lr) * LDT + lh * 8;
#pragma unroll
    for (int ks = 0; ks < 4; ++ks) {
      const bf16x8 a0 = *(const bf16x8*)(Ab + ks * 16);
      const bf16x8 a1 = *(const bf16x8*)(Ab + 32 * LDT + ks * 16);
      const bf16x8 b = *(const bf16x8*)(Bb + ks * 16);
      acc[0] = mfma(a0, b, acc[0]);
      acc[1] = mfma(a1, b, acc[1]);
    }
  };
  ld(ra0, rb0, 0);
  if (nk > 1) ld(ra1, rb1, 1);
  stl(ra0, rb0, 0);
  if (nk > 2) ld(ra0, rb0, 2);
  __syncthreads();
#pragma unroll 1
  for (int kt = 0; kt < nk; kt += 2) {
    compute(0);
    if (kt + 1 < nk) { stl(ra1, rb1, 1); if (kt + 3 < nk) ld(ra1, rb1, kt + 3); }
    __syncthreads();
    if (kt + 1 < nk) {
      compute(1);
      if (kt + 2 < nk) { stl(ra0, rb0, 0); if (kt + 4 < nk) ld(ra0, rb0, kt + 4); }
      __syncthreads();
    }
  }
  epi(acc, wm, wn, lane);
}

DI void stage_rc(int b, int& R, int& C) { int st = b / 1024, sb = b % 1024, swz = sb ^ (((sb >> 9) & 1) << 5); R = (st >> 1) * 16 + swz / 64; C = (st & 1) * 32 + (swz % 64) / 2; }

DI int perm32(int rho) { const int n = rho >> 4, i = rho & 15; return 8 * (i >> 2) + 4 * n + (i & 3); }

template <bool PERM, class EPI>
DI void gemm256(LAS u16* shm, const u16* __restrict__ A, const u16* __restrict__ Bt, int K, int brow, int bcol, bool pre, bool has_next, int nbrow, int nbcol, EPI epi) {
#define SA(b, h) (shm + ((b) * 2 + (h)) * HT)
#define SB(b, h) (shm + (4 + (b) * 2 + (h)) * HT)
  const int tid = tidx();
  const int wid = __builtin_amdgcn_readfirstlane(tid >> 6), lane = tid & 63, wr = wid >> 2, wc = wid & 3, fr = lane & 15, fq = lane >> 4;
  int r0, c0, r1, c1;
  stage_rc(tid * 16, r0, c0);
  stage_rc(tid * 16 + 8192, r1, c1);
  const int ra0 = PERM ? ((r0 & ~31) + perm32(r0 & 31)) : r0, ra1 = PERM ? ((r1 & ~31) + perm32(r1 & 31)) : r1;
  const unsigned so0 = (unsigned)(ra0 * K + c0) * 2u, so1 = (unsigned)(ra1 * K + c1) * 2u;
  const unsigned sb0 = (unsigned)(r0 * K + c0) * 2u, sb1 = (unsigned)(r1 * K + c1) * 2u;
  const unsigned ldsw = (unsigned)wid * 1024u;
  const int lb = ((fr * 64 + fq * 16) ^ ((fr >> 3) << 5));
#define STAGE_(P, BASE, br, kt, O0, O1) do { const char* _g = (const char*)((BASE) + (size_t)(br) * K + (kt) * 64); \
    __builtin_amdgcn_global_load_lds((const unsigned*)(_g + O0), (LAS unsigned*)((LAS char*)(P) + ldsw), 16, 0, 0); \
    __builtin_amdgcn_global_load_lds((const unsigned*)(_g + O1), (LAS unsigned*)((LAS char*)(P) + ldsw + 8192), 16, 0, 0); } while (0)
#define STAGEA(P, br, kt) STAGE_(P, A, br, kt, so0, so1)
#define STAGEB(P, br, kt) STAGE_(P, Bt, br, kt, sb0, sb1)
#define LDA(dst, b, h) _Pragma("unroll") for (int m = 0; m < 4; ++m) _Pragma("unroll") for (int k = 0; k < 2; ++k) \
    dst[m][k] = *(const LAS bf16x8*)((const LAS char*)SA(b, h) + ((wr * 4 + m) * 2 + k) * 1024 + lb)
#define LDB(dst, b, h) _Pragma("unroll") for (int n = 0; n < 2; ++n) _Pragma("unroll") for (int k = 0; k < 2; ++k) \
    dst[n][k] = *(const LAS bf16x8*)((const LAS char*)SB(b, h) + ((wc * 2 + n) * 2 + k) * 1024 + lb)
#define MMA(ai, bj, At_, Bt_) do { __builtin_amdgcn_s_setprio(1); \
    _Pragma("unroll") for (int m = 0; m < 4; ++m) _Pragma("unroll") for (int n = 0; n < 2; ++n) _Pragma("unroll") for (int k = 0; k < 2; ++k) \
      acc[ai][bj][m][n] = __builtin_amdgcn_mfma_f32_16x16x32_bf16(At_[m][k], Bt_[n][k], acc[ai][bj][m][n], 0, 0, 0); \
    __builtin_amdgcn_s_setprio(0); } while (0)
#define WAIT_V(n) asm volatile("s_waitcnt vmcnt(" #n ")" ::: "memory")
#define WAIT_L(n) asm volatile("s_waitcnt lgkmcnt(" #n ")" ::: "memory")
#define BAR __builtin_amdgcn_s_barrier()
#define SCHED __builtin_amdgcn_sched_barrier(0)
  f32x4 acc[2][2][4][2];
#pragma unroll
  for (int a = 0; a < 2; ++a)
#pragma unroll
    for (int b = 0; b < 2; ++b)
#pragma unroll
      for (int m = 0; m < 4; ++m)
#pragma unroll
        for (int n = 0; n < 2; ++n) { acc[a][b][m][n][0] = 0.f; acc[a][b][m][n][1] = 0.f; acc[a][b][m][n][2] = 0.f; acc[a][b][m][n][3] = 0.f; }
  bf16x8 At[4][2], B0[2][2], B1[2][2];
  const int nt = K / 64;
  if (!pre) {
    STAGEB(SB(0, 0), bcol, 0); STAGEA(SA(0, 0), brow, 0);
    STAGEB(SB(0, 1), bcol + 128, 0); STAGEA(SA(0, 1), brow + 128, 0);
  }
  if (wr == 1) BAR;
  WAIT_V(4); BAR;
  STAGEB(SB(1, 0), bcol, 1); STAGEA(SA(1, 0), brow, 1); STAGEB(SB(1, 1), bcol + 128, 1);
  WAIT_V(6); BAR;
  for (int t = 0; t < nt - 2; t += 2) {
    LDB(B0, 0, 0); SCHED; LDA(At, 0, 0); STAGEA(SA(1, 1), brow + 128, t + 1);
    WAIT_L(8); BAR; WAIT_L(0); MMA(0, 0, At, B0); BAR; SCHED;
    LDB(B1, 0, 1); STAGEB(SB(0, 0), bcol, t + 2);
    BAR; WAIT_L(0); MMA(0, 1, At, B1); BAR;
    LDA(At, 0, 1); STAGEA(SA(0, 0), brow, t + 2);
    BAR; WAIT_L(0); MMA(1, 0, At, B0); BAR; SCHED;
    STAGEB(SB(0, 1), bcol + 128, t + 2);
    WAIT_V(6); BAR; MMA(1, 1, At, B1); BAR;
    LDB(B0, 1, 0); SCHED; LDA(At, 1, 0); STAGEA(SA(0, 1), brow + 128, t + 2);
    WAIT_L(8); BAR; WAIT_L(0); MMA(0, 0, At, B0); BAR; SCHED;
    LDB(B1, 1, 1); STAGEB(SB(1, 0), bcol, t + 3);
    BAR; WAIT_L(0); MMA(0, 1, At, B1); BAR;
    LDA(At, 1, 1); STAGEA(SA(1, 0), brow, t + 3);
    BAR; WAIT_L(0); MMA(1, 0, At, B0); BAR; SCHED;
    STAGEB(SB(1, 1), bcol + 128, t + 3);
    WAIT_V(6); BAR; MMA(1, 1, At, B1); BAR;
  }
  { LDB(B0, 0, 0); LDA(At, 0, 0); STAGEA(SA(1, 1), brow + 128, nt - 1);
    BAR; WAIT_L(0); MMA(0, 0, At, B0); BAR;
    LDB(B1, 0, 1); BAR; WAIT_L(0); MMA(0, 1, At, B1); BAR;
    LDA(At, 0, 1); WAIT_V(4); BAR; WAIT_L(0); MMA(1, 0, At, B0); MMA(1, 1, At, B1); BAR; }
  { LDB(B0, 1, 0); LDA(At, 1, 0); WAIT_V(2); BAR; WAIT_L(0); MMA(0, 0, At, B0); BAR;
    LDB(B1, 1, 1); WAIT_V(0); BAR; WAIT_L(0); MMA(0, 1, At, B1); BAR;
    LDA(At, 1, 1); BAR; WAIT_L(0); MMA(1, 0, At, B0); MMA(1, 1, At, B1); BAR; }
  if (wr == 0) BAR;
  if (has_next) {
    STAGEB(SB(0, 0), nbcol, 0); STAGEA(SA(0, 0), nbrow, 0);
    STAGEB(SB(0, 1), nbcol + 128, 0); STAGEA(SA(0, 1), nbrow + 128, 0);
  }
  epi(acc, wr, wc, fr, fq);
  __syncthreads();
}

DI void map256(int t, int nN, int& tn, int& tm) {
  const int p = (t >> 8) * 8 + (t & 7), i = (t >> 3) & 31, pr = nN >> 2;
  const int pm = p / pr;
  tn = ((p + pm) % pr) * 4 + (i & 3);
  tm = pm * 8 + (i >> 2);
}

DI int condrow(int sb, int tok) { return sb == 0 ? 0 : 1 + (sb - 1) * 8 + (tok >> 11); }

DI void convT(float* tile, const float* src, int lds_, int K, int N, u16* dst, int ldd, const float* ksc, int& base) {
  const int tid = tidx();
  const int ntn = (N + 63) >> 6, nt = (K >> 6) * ntn;
  const int kk = tid >> 4, n4 = (tid & 15) * 4;
  float4 cur[2], nxt[2];
  auto ld = [&](float4 (&v)[2], int t) __attribute__((always_inline)) {
    const int tn = t % ntn, tk = t / ntn, k0 = tk * 64, n0 = tn * 64;
#pragma unroll
    for (int e = 0; e < 2; ++e) {
      v[e] = make_float4(0.f, 0.f, 0.f, 0.f);
      if (n0 + n4 < N) v[e] = *(const float4*)(src + (size_t)(k0 + kk + 32 * e) * lds_ + n0 + n4);
    }
  };
  int t = (int)((blockIdx.x + gridDim.x - ((unsigned)base % gridDim.x)) % gridDim.x);
  if (t < nt) ld(cur, t);
  for (; t < nt; t += gridDim.x) {
    const int tnx = t + (int)gridDim.x;
    if (tnx < nt) ld(nxt, tnx);
    const int tn = t % ntn, tk = t / ntn, k0 = tk * 64, n0 = tn * 64;
#pragma unroll
    for (int e = 0; e < 2; ++e) {
      float4 v = cur[e];
      if (ksc) { const float sc = ksc[k0 + kk + 32 * e]; v.x *= sc; v.y *= sc; v.z *= sc; v.w *= sc; }
      float* tp = tile + (kk + 32 * e) * 65 + n4;
      tp[0] = v.x; tp[1] = v.y; tp[2] = v.z; tp[3] = v.w;
    }
    __syncthreads();
#pragma unroll 4
    for (int e = 0; e < 4; ++e) {
      const int idx = tid + NTH * e, nn = idx >> 5, kp = idx & 31;
      if (n0 + nn < N)
        *(unsigned*)(dst + (size_t)(n0 + nn) * ldd + k0 + 2 * kp) = pack2(tile[(2 * kp) * 65 + nn], tile[(2 * kp + 1) * 65 + nn]);
    }
    __syncthreads();
    cur[0] = nxt[0]; cur[1] = nxt[1];
  }
  base += nt;
}

DI void prologue_a(const Prm& p, unsigned char* smem_raw, int& base) {
  float* smf = (float*)smem_raw;
  const int tid = tidx();
  const int gtid = blockIdx.x * NTH + tid, gn = gridDim.x * NTH;
  for (int l = 0; l < 4; ++l) {
    convT(smf, p.w_in + (size_t)l * 1024 * 7520 + 768, 7520, 1024, 6752, p.WinT + ((size_t)l * NWP + 1536) * 1024, 1024, nullptr, base);
    convT(smf, p.w1 + (size_t)l * 1024 * 4096, 4096, 1024, 4096, p.W1T + (size_t)l * 4096 * 1024, 1024, nullptr, base);
    convT(smf, p.w2 + (size_t)l * 4096 * 1024, 1024, 4096, 1024, p.W2T + (size_t)l * 1024 * 4096, 4096, nullptr, base);
    convT(smf, p.w_o + (size_t)l * 1024 * 1024, 1024, 1024, 1024, p.WoT + (size_t)l * 1024 * 1024, 1024, nullptr, base);
    convT(smf, p.p_a + (size_t)l * 768 * 1024, 1024, 768, 1024, p.PaT + (size_t)l * 1024 * 768, 768, nullptr, base);
    convT(smf, p.p_b + (size_t)l * 128 * 1024, 1024, 128, 1024, p.PbT + (size_t)l * 1024 * 128, 128, nullptr, base);
    convT(smf, p.p_c + (size_t)l * 384 * 1024, 1024, 384, 1024, p.PcT + (size_t)l * 1024 * 384, 384, nullptr, base);
    convT(smf, p.p_d + (size_t)l * 256 * 1024, 1024, 256, 1024, p.PdT + (size_t)l * 1024 * 256, 256, nullptr, base);
    convT(smf, p.w_uq + (size_t)l * 384 * 384, 384, 384, 384, p.WqT + (size_t)l * 384 * 384, 384, p.qn_g + l * 384, base);
    convT(smf, p.w_ukv + (size_t)l * 320 * 512, 512, 320, 512, p.WkvT + (size_t)l * 512 * 320, 320, p.kvn_g + l * 320, base);
  }
  {
    float* tab = (float*)(smem_raw + GEMM_SMEM + 1024);
    if (tid < 192) {
      float sn, cs;
      sincospif(2.f * (float)tid / 192.f, &sn, &cs);
      tab[tid] = cs; tab[192 + tid] = sn;
    }
    __syncthreads();
    u16* smem = (u16*)smem_raw;
    TASK_LOOP(t, 384, base) {
      const int kt = t & 7, rt = (t >> 3) % 3, g = (t / 24) & 3, l = t / 96;
      auto la = [&](int row, int k) __attribute__((always_inline)) {
        const int rr = rt * 128 + row, part = rr >= 192 ? 1 : 0, j = rr - part * 192;
        const float* tp = tab + part * 192;
        const float sg = part ? -1.f : 1.f;
        int m = (j * k) % 192;
        u32x4 o;
#pragma unroll
        for (int jj = 0; jj < 4; ++jj) {
          const float v0 = tp[m] * sg; m += j; if (m >= 192) m -= 192;
          const float v1 = tp[m] * sg; m += j; if (m >= 192) m -= 192;
          o[jj] = pack2(v0, v1);
        }
        return o;
      };
      auto lb = [&](int row, int k) __attribute__((always_inline)) {
        const float* src = p.w_in + ((size_t)l * 1024 + kt * 128 + row) * 7520 + g * 192 + k;
        const float4 a = *(const float4*)src, b = *(const float4*)(src + 4);
        u32x4 o;
        o[0] = pack2(a.x, a.y); o[1] = pack2(a.z, a.w); o[2] = pack2(b.x, b.y); o[3] = pack2(b.z, b.w);
        return o;
      };
      auto epi = [&](f32x16 (&acc)[2], int wm, int wn, int lane) __attribute__((always_inline)) {
        const int lr = lane & 31, lh = lane >> 5;
        const int kcol = kt * 128 + wn * 32 + lr;
#pragma unroll
        for (int i = 0; i < 2; ++i)
#pragma unroll
          for (int r = 0; r < 16; ++r) {
            const int rr = rt * 128 + wm * 64 + i * 32 + rowmap(r, lh), part = rr >= 192 ? 1 : 0, j = rr - part * 192;
            p.WinT[((size_t)l * NWP + part * 768 + g * 192 + j) * 1024 + kcol] = f2bf(acc[i][r]);
          }
      };
      gemm_tile<false, false>(smem, 3, la, lb, epi);
    }
    base += 384;
  }
  {
    float* sil = smf;
    TASK_LOOP(t, 384, base) {
      const int kc = t & 7, cb = (t >> 3) % 12, l = t / 96, k0 = kc * 128;
      for (int idx = tid; idx < 17 * 128; idx += NTH) {
        const int r = idx >> 7, kk = idx & 127;
        const float c = r == 0 ? p.c_prompt[k0 + kk] : p.c_sample[(r - 1) * 1024 + k0 + kk];
        sil[idx] = c / (1.f + __expf(-c));
      }
      __syncthreads();
      const int n = cb * 512 + tid;
      float acc[17];
#pragma unroll
      for (int r = 0; r < 17; ++r) acc[r] = 0.f;
      const float* wp = p.ada_w + ((size_t)l * 1024 + k0) * 6144 + n;
#pragma unroll 1
      for (int kb = 0; kb < 128; kb += 32) {
        float w[32];
#pragma unroll
        for (int i = 0; i < 32; ++i) w[i] = wp[(size_t)(kb + i) * 6144];
#pragma unroll
        for (int i = 0; i < 32; i += 4)
#pragma unroll
          for (int r = 0; r < 17; ++r) {
            const float4 sv = *(const float4*)(sil + r * 128 + kb + i);
            acc[r] += sv.x * w[i] + sv.y * w[i + 1] + sv.z * w[i + 2] + sv.w * w[i + 3];
          }
      }
#pragma unroll
      for (int r = 0; r < 17; ++r) p.modpart[((size_t)(kc * 4 + l) * 17 + r) * 6144 + n] = acc[r];
      __syncthreads();
    }
    base += 384;
  }
  for (int idx = gtid; idx < 4 * 32 * 1024; idx += gn) {
    const int l = idx >> 15, rem = idx & 32767;
    p.WinT[((size_t)l * NWP + NW) * 1024 + rem] = 0;
  }
  for (int idx = gtid; idx < 256 * 256; idx += gn) {
    const int row = idx >> 8, kk = idx & 255;
    const int po = row >> 7, k1 = row & 127, pi = kk >> 7, s1 = kk & 127;
    float s, c;
    sincospif(2.f * (float)((k1 * s1) & 127) / 128.f, &s, &c);
    const float v = (po == pi) ? c : (po == 0 ? s : -s);
    p.M1a[idx] = f2bf(v);
  }
  for (int idx = gtid; idx < 32 * 64; idx += gn) {
    const int row = idx >> 6, kk = idx & 63;
    const int po = row >> 4, k1 = row & 15, pi = (kk >> 4) & 1, s1 = kk & 15;
    float s, c;
    sincospif(2.f * (float)((k1 * s1) & 15) / 16.f, &s, &c);
    float v = (po == pi) ? c : (po == 0 ? s : -s);
    if (kk >= 32) v = 0.f;
    p.M1b[idx] = f2bf(v);
  }
  for (int idx = gtid; idx < 128 * 256; idx += gn) {
    const int k2 = idx >> 8, kk = idx & 255, part = kk >> 7, s2 = kk & 127;
    float s, c;
    sincospif(2.f * (float)((k2 * s2) & 127) / 128.f, &s, &c);
    p.M2[idx] = f2bf(part ? s : c);
  }
  for (int idx = gtid; idx < 16384; idx += gn) {
    float s, c;
    sincospif(2.f * (float)idx / 16384.f, &s, &c);
    p.tw[idx] = make_float2(c, s);
  }
  for (int idx = gtid; idx < 16384 * 16; idx += gn) {
    const int pos = idx >> 4, i = idx & 15;
    const float inv = (float)pow(10000.0, -(double)i / 16.0);
    const float ang = (float)pos * inv;
    double rev = (double)ang * 0.15915494309189535;
    rev -= rint(rev);
    float s, c;
    sincospif((float)(2.0 * rev), &s, &c);
    p.rope[idx] = make_float2(c, s);
  }
  for (int idx = gtid; idx < 6 * 129; idx += gn) {
    const int hd = idx / 129, rel = idx - hd * 129 - 64;
    const int dil = 1 << (2 * (hd >> 1));
    const int rd = rel * dil, n = rd < 0 ? -rd : rd;
    int b;
    if (n < 8) b = n;
    else if (n < 15) b = 8; else if (n < 27) b = 9; else if (n < 50) b = 10; else if (n < 91) b = 11;
    else if (n < 166) b = 12; else if (n < 305) b = 13; else if (n < 559) b = 14; else b = 15;
    if (rd > 0) b += 16;
    p.biasT[idx] = p.rel_bias[b * 6 + hd];
  }
  for (int idx = gtid; idx < 4 * 4 * 128 * 128; idx += gn) p.SgW[idx] = f2bf(p.sgu_w[idx]);
}

DI void prologue_b(const Prm& p) {
  const int gtid = blockIdx.x * NTH + tidx(), gn = gridDim.x * NTH;
  for (int idx = gtid; idx < 4 * 17 * 6144; idx += gn) {
    const int l = idx / (17 * 6144), n = idx % 6144;
    float s = p.ada_b[l * 6144 + n];
#pragma unroll
    for (int kc = 0; kc < 8; ++kc) s += p.modpart[(size_t)kc * 4 * 17 * 6144 + idx];
    p.mod[idx] = s;
  }
}

DI void phase_norm(const Prm& p, const float* xsrc, const float* g, const float* modl, int shoff, int scoff, int sb) {
  const int tid = tidx(), lane = tid & 63;
  const int gw = blockIdx.x * 8 + (tid >> 6), nw = gridDim.x * 8;
  for (int row = gw; row < TB; row += nw) {
    const int cond = condrow(sb, row);
    const float* xr = xsrc + (size_t)row * 1024;
    float4 v[4];
    float ss = 0.f;
#pragma unroll
    for (int i = 0; i < 4; ++i) {
      v[i] = *(const float4*)(xr + i * 256 + lane * 4);
      ss += v[i].x * v[i].x + v[i].y * v[i].y + v[i].z * v[i].z + v[i].w * v[i].w;
    }
#pragma unroll
    for (int off = 32; off >= 1; off >>= 1) ss += __shfl_xor(ss, off);
    const float rstd = rsqrtf(ss * (1.f / 1024.f) + 1e-6f);
    const float* sc = modl + cond * 6144 + scoff;
    const float* sh = modl + cond * 6144 + shoff;
#pragma unroll
    for (int i = 0; i < 4; ++i) {
      const int col = i * 256 + lane * 4;
      const float4 gg = *(const float4*)(g + col), s4 = *(const float4*)(sc + col), h4 = *(const float4*)(sh + col);
      st4bf(p.hbuf + (size_t)row * 1024 + col,
            v[i].x * rstd * gg.x * (1.f + s4.x) + h4.x, v[i].y * rstd * gg.y * (1.f + s4.y) + h4.y,
            v[i].z * rstd * gg.z * (1.f + s4.z) + h4.z, v[i].w * rstd * gg.w * (1.f + s4.w) + h4.w);
    }
  }
}

DI float sigm(float x) { return __builtin_amdgcn_rcpf(1.f + __expf(-x)); }

DI void phase_inproj(const Prm& p, unsigned char* smem_raw, int l, int S, int& base) {
  const u16* W = p.WinT + (size_t)l * NWP * 1024;
  LAS u16* shm = (LAS u16*)smem_raw;
  bool pre = false;
  TASK_LOOP(t, 32 * 64, base) {
    int tn, tm;
    map256(t, 32, tn, tm);
    const int brow = tn * 256, bcol = tm * 256;
    const int tnx = t + (int)gridDim.x;
    const bool has_next = tnx < (32 * 64);
    int tn2 = 0, tm2 = 0;
    if (has_next) map256(tnx, 32, tn2, tm2);
    const int nbrow = tn2 * 256, nbcol = tm2 * 256;
    const bool hn = has_next && ((tn2 != 16) == (tn != 16));
    auto epi = [&](f32x4 (&acc)[2][2][4][2], int wr, int wc, int fr, int fq) __attribute__((always_inline)) {
#pragma unroll
      for (int ai = 0; ai < 2; ++ai)
#pragma unroll
        for (int m = 0; m < 4; ++m) {
          const int nb = brow + ai * 128 + wr * 64 + m * 16;
#pragma unroll
          for (int bj = 0; bj < 2; ++bj)
#pragma unroll
            for (int n = 0; n < 2; ++n) {
              const int tok = bcol + bj * 128 + wc * 32 + n * 16 + fr;
              const f32x4 v = acc[ai][bj][m][n];
              const int nn = nb + fq * 4;
              if (nb < 1536) {
#pragma unroll
                for (int j = 0; j < 4; ++j) p.UT[(size_t)(nn + j) * TBP + tok] = f2bf(v[j]);
              } else if (nb < 2688) {
                st4bf(p.bqkv + (size_t)tok * 1152 + (nn - 1536), v[0], v[1], v[2], v[3]);
              } else if (nb < 3072) {
                st4bf(p.cu + (size_t)tok * 384 + (nn - 2688), v[0], v[1], v[2], v[3]);
              } else if (nb < 3456) {
#pragma unroll
                for (int j = 0; j < 4; ++j) p.cvT[(size_t)(nn - 3072 + j) * TBP + tok] = f2bf(v[j]);
              } else if (nb < 3840) {
                st4bf(p.dcq + (size_t)tok * 384 + (nn - 3456), v[0], v[1], v[2], v[3]);
              } else if (nb < 4160) {
                st4bf(p.dckv + (size_t)tok * 320 + (nn - 3840), v[0], v[1], v[2], v[3]);
              } else if (nb < 4192) {
                if (nb == 4160) {
                  const f32x4 v2 = acc[ai][bj][(m + 1) & 3][n];
                  const int pos = tok & (S - 1);
#pragma unroll
                  for (int j = 0; j < 4; ++j) {
                    const int ii = fq * 4 + j;
                    const float2 cs = p.rope[pos * 16 + ii];
                    const u16 o1 = f2bf(v[j] * cs.x - v2[j] * cs.y), o2 = f2bf(v[j] * cs.y + v2[j] * cs.x);
#pragma unroll
                    for (int hh = 0; hh < 4; ++hh) {
                      p.kc[(size_t)tok * 384 + hh * 96 + 64 + ii] = o1;
                      p.kc[(size_t)tok * 384 + hh * 96 + 80 + ii] = o2;
                    }
                  }
                }
              } else {
                st4bf_nt(p.zg + (size_t)tok * 4096 + (nn - 4192), sigm(v[0]), sigm(v[1]), sigm(v[2]), sigm(v[3]));
              }
            }
          __builtin_amdgcn_sched_barrier(0);
        }
    };
    if (tn != 16) {
      auto epi_p = [&](f32x4 (&acc)[2][2][4][2], int wr, int wc, int fr, int fq) __attribute__((always_inline)) {
#pragma unroll
        for (int ai = 0; ai < 2; ++ai)
#pragma unroll
          for (int mp = 0; mp < 2; ++mp) {
            const int nb = brow + ai * 128 + wr * 64 + mp * 32;
            const int nn = nb + fq * 8;
#pragma unroll
            for (int bj = 0; bj < 2; ++bj)
#pragma unroll
              for (int n = 0; n < 2; ++n) {
                const int tok = bcol + bj * 128 + wc * 32 + n * 16 + fr;
                const f32x4 v = acc[ai][bj][2 * mp][n], w = acc[ai][bj][2 * mp + 1][n];
                if (nb < 1536) {
#pragma unroll
                  for (int j = 0; j < 4; ++j) { p.UT[(size_t)(nn + j) * TBP + tok] = f2bf(v[j]); p.UT[(size_t)(nn + 4 + j) * TBP + tok] = f2bf(w[j]); }
                } else if (nb < 2688) {
                  st8bf(p.bqkv + (size_t)tok * 1152 + (nn - 1536), v, w);
                } else if (nb < 3072) {
                  st8bf(p.cu + (size_t)tok * 384 + (nn - 2688), v, w);
                } else if (nb < 3456) {
#pragma unroll
                  for (int j = 0; j < 4; ++j) { p.cvT[(size_t)(nn - 3072 + j) * TBP + tok] = f2bf(v[j]); p.cvT[(size_t)(nn - 3072 + 4 + j) * TBP + tok] = f2bf(w[j]); }
                } else if (nb < 3840) {
                  st8bf(p.dcq + (size_t)tok * 384 + (nn - 3456), v, w);
                } else if (nb < 4160) {
                  st8bf(p.dckv + (size_t)tok * 320 + (nn - 3840), v, w);
                } else {
                  u32x4 o;
                  o[0] = pack2(sigm(v[0]), sigm(v[1])); o[1] = pack2(sigm(v[2]), sigm(v[3]));
                  o[2] = pack2(sigm(w[0]), sigm(w[1])); o[3] = pack2(sigm(w[2]), sigm(w[3]));
                  __builtin_nontemporal_store(o, (u32x4*)(p.zg + (size_t)tok * 4096 + (nn - 4192)));
                }
              }
            __builtin_amdgcn_sched_barrier(0);
          }
      };
      gemm256<true>(shm, W, p.hbuf, 1024, brow, bcol, pre, hn, nbrow, nbcol, epi_p);
    } else {
      gemm256<false>(shm, W, p.hbuf, 1024, brow, bcol, pre, hn, nbrow, nbcol, epi);
    }
    pre = hn;
  }
  base += 32 * 64;
}

DI void phase_inproj_tail(const Prm& p, unsigned char* smem_raw, int l, int& base) {
  const u16* W = p.WinT + (size_t)l * NWP * 1024;
  u16* smem = (u16*)smem_raw;
  TASK_LOOP(t, 128, base) {
    const int n0 = 8192, m0 = t * 128;
    auto la = [&](int row, int k) __attribute__((always_inline)) { return *(const u32x4*)(W + (size_t)(n0 + row) * 1024 + k); };
    auto lb = [&](int row, int k) __attribute__((always_inline)) { return *(const u32x4*)(p.hbuf + (size_t)(m0 + row) * 1024 + k); };
    auto epi = [&](f32x16 (&acc)[2], int wm, int wn, int lane) __attribute__((always_inline)) {
      const int lr = lane & 31, lh = lane >> 5;
      const int tok = m0 + wn * 32 + lr;
#pragma unroll
      for (int i = 0; i < 2; ++i) {
        const int nb = n0 + wm * 64 + i * 32;
        if (nb >= NW) continue;
#pragma unroll
        for (int q = 0; q < 4; ++q)
          st4bf(p.zg + (size_t)tok * 4096 + (nb - 4192) + 8 * q + 4 * lh, sigm(acc[i][4 * q]), sigm(acc[i][4 * q + 1]), sigm(acc[i][4 * q + 2]),
                sigm(acc[i][4 * q + 3]));
      }
    };
    gemm_tile2s<false, false>(smem, 16, la, lb, epi);
  }
  base += 128;
}


DI void phase_inproj_probe(const Prm& p, unsigned char* smem_raw, int l, int& base) {
  const u16* W = p.WinT + (size_t)l * NWP * 1024;
  LAS u16* shm = (LAS u16*)smem_raw;
  bool pre = false;
  TASK_LOOP(t, 32 * 64, base) {
    int tn, tm;
    map256(t, 32, tn, tm);
    const int brow = tn * 256, bcol = tm * 256;
    const int tnx = t + (int)gridDim.x;
    const bool has_next = tnx < (32 * 64);
    int tn2 = 0, tm2 = 0;
    if (has_next) map256(tnx, 32, tn2, tm2);
    const int nbrow = tn2 * 256, nbcol = tm2 * 256;
    auto epi = [&](f32x4 (&acc)[2][2][4][2], int wr, int wc, int fr, int fq) __attribute__((always_inline)) {
#pragma unroll
      for (int bj = 0; bj < 2; ++bj)
#pragma unroll
        for (int n = 0; n < 2; ++n) {
          const int tok = bcol + bj * 128 + wc * 32 + n * 16 + fr;
#pragma unroll
          for (int ai = 0; ai < 2; ++ai)
#pragma unroll
            for (int m = 0; m < 4; ++m) {
              const int nn = ((brow + ai * 128 + wr * 64 + m * 16) & 1023) + fq * 4;
              const f32x4 v = acc[ai][bj][m][n];
              st4bf(p.Gp + (size_t)tok * 1024 + nn, v[0], v[1], v[2], v[3]);
            }
        }
    };
    gemm256<false>(shm, W, p.hbuf, 1024, brow, bcol, pre, has_next, nbrow, nbcol, epi);
    pre = has_next;
  }
  base += 32 * 64;
}

DI void phase_fft1(const Prm& p, u16* smem, int S, int nseq, int N1, int lgN1, int& base) {
  const int nkt = N1 == 128 ? 2 : 1;
  const u16* M1 = N1 == 128 ? p.M1a : p.M1b;
  const int ldm = N1 == 128 ? 256 : 64;
  const int nk = N1 == 128 ? 4 : 1;
  const int ntask = nseq * 768 * nkt;
  const int twmul = 16384 / S;
  TASK_LOOP(t, ntask, base) {
    const int k1t = t % nkt, col = (t / nkt) % 768, seq = t / (nkt * 768);
    const int k1base = k1t * 64;
    auto la = [&](int row, int k) __attribute__((always_inline)) {
      const int k1 = k1base + (row >> 6) * 32 + (row & 31), ii = (row >> 5) & 1;
      if (k1 >= N1 || k >= 2 * N1) return zero4();
      return *(const u32x4*)(M1 + (ii * N1 + k1) * ldm + k);
    };
    auto lb = [&](int row, int k) __attribute__((always_inline)) {
      if (k >= 2 * N1) return zero4();
      const int part = k >> lgN1, s1 = k & (N1 - 1);
      const u16* src = p.UT + (size_t)(part * 768 + col) * TBP + seq * S + s1 * 128 + row;
      u32x4 v;
#pragma unroll
      for (int jj = 0; jj < 4; ++jj) v[jj] = (unsigned)src[(2 * jj) * 128] | ((unsigned)src[(2 * jj + 1) * 128] << 16);
      return v;
    };
    auto epi = [&](f32x16 (&acc)[2], int wm, int wn, int lane) __attribute__((always_inline)) {
      const int lr = lane & 31, lh = lane >> 5;
      const int s2 = wn * 32 + lr;
#pragma unroll
      for (int r = 0; r < 16; ++r) {
        const int k1 = k1base + wm * 32 + rowmap(r, lh);
        if (k1 < N1) {
          const float re = acc[0][r], im = acc[1][r];
          const float2 cs = p.tw[(s2 * k1) * twmul];
          const size_t o = ((size_t)((seq * N1 + k1) * 2) * 768 + col) * 128 + s2;
          p.Gp[o] = f2bf(cs.x * re + cs.y * im);
          p.Gp[o + 768 * 128] = f2bf(cs.x * im - cs.y * re);
        }
      }
    };
    gemm_tile2s<false, true>(smem, nk, la, lb, epi);
  }
  base += ntask;
}


DI void phase_fft1_small(const Prm& p, int nseq) {
  constexpr float C16[16] = {1.f, 0.92387953251128674f, 0.70710678118654752f, 0.38268343236508977f, 0.f, -0.38268343236508977f, -0.70710678118654752f,
                             -0.92387953251128674f, -1.f, -0.92387953251128674f, -0.70710678118654752f, -0.38268343236508977f, 0.f,
                             0.38268343236508977f, 0.70710678118654752f, 0.92387953251128674f};
  constexpr float S16[16] = {0.f, 0.38268343236508977f, 0.70710678118654752f, 0.92387953251128674f, 1.f, 0.92387953251128674f, 0.70710678118654752f,
                             0.38268343236508977f, 0.f, -0.38268343236508977f, -0.70710678118654752f, -0.92387953251128674f, -1.f,
                             -0.92387953251128674f, -0.70710678118654752f, -0.38268343236508977f};
  const int gtid = blockIdx.x * NTH + tidx(), gn = gridDim.x * NTH;
  for (int idx = gtid; idx < nseq * 768 * 128; idx += gn) {
    const int s2 = idx & 127, col = (idx >> 7) % 768, seq = idx / (768 * 128);
    const u16* ur = p.UT + (size_t)col * TBP + seq * 2048 + s2;
    const u16* ui = ur + (size_t)768 * TBP;
    float xr[16], xi[16];
#pragma unroll
    for (int s1 = 0; s1 < 16; ++s1) { xr[s1] = bf2f(ur[s1 * 128]); xi[s1] = bf2f(ui[s1 * 128]); }
    u16* go = p.Gp + ((size_t)(seq * 16 * 2) * 768 + col) * 128 + s2;
#pragma unroll
    for (int k1 = 0; k1 < 16; ++k1) {
      float gr = 0.f, gi = 0.f;
#pragma unroll
      for (int s1 = 0; s1 < 16; ++s1) {
        const float c = C16[(k1 * s1) & 15], sn = S16[(k1 * s1) & 15];
        gr += c * xr[s1] + sn * xi[s1];
        gi += c * xi[s1] - sn * xr[s1];
      }
      const float2 cs = p.tw[(s2 * k1) * 8];
      go[(size_t)(k1 * 2) * 768 * 128] = f2bf(cs.x * gr + cs.y * gi);
      go[(size_t)(k1 * 2 + 1) * 768 * 128] = f2bf(cs.x * gi - cs.y * gr);
    }
  }
}

DI void phase_fft2(const Prm& p, u16* smem, int S, int nseq, int N1, int& base) {
  const int ntask = nseq * N1 * 6;
  const float scale = rsqrtf((float)S * 192.f);
  u16* fa = p.UT;
  TASK_LOOP(t, ntask, base) {
    const int ct = t % 6, k1 = (t / 6) % N1, seq = t / (6 * N1);
    const u16* gb = p.Gp + ((size_t)((seq * N1 + k1) * 2) * 768 + ct * 128) * 128;
    auto la = [&](int row, int k) __attribute__((always_inline)) { return *(const u32x4*)(p.M2 + row * 256 + k); };
    auto lb = [&](int row, int k) __attribute__((always_inline)) {
      const int part = k >> 7, s2 = k & 127;
      return *(const u32x4*)(gb + ((size_t)part * 768 + row) * 128 + s2);
    };
    auto epi = [&](f32x16 (&acc)[2], int wm, int wn, int lane) __attribute__((always_inline)) {
      const int lr = lane & 31, lh = lane >> 5;
      const int col = ct * 128 + wn * 32 + lr;
#pragma unroll
      for (int i = 0; i < 2; ++i)
#pragma unroll
        for (int r = 0; r < 16; ++r) {
          const int k2 = wm * 64 + i * 32 + rowmap(r, lh);
          const int tok = seq * S + k1 + N1 * k2;
          fa[(size_t)tok * 768 + col] = f2bf(acc[i][r] * scale);
        }
    };
    gemm_tile2s<false, false>(smem, 4, la, lb, epi);
  }
  base += ntask;
}

DI void phase_mixc(const Prm& p, unsigned char* smem_raw, int l, int& base) {
  u16* smem = (u16*)smem_raw;
  float* st = (float*)(smem_raw + GEMM_SMEM);
  float* red = (float*)smem_raw;
  const int tid = tidx();
  TASK_LOOP(t, 512, base) {
    const int h = t & 3, ch = t >> 2, tok0 = ch * 128;
    {
      const int q = tid & 127, qf = tid >> 7;
      float s = 0.f, ss = 0.f;
      const u16* src = p.cvT + (size_t)(qf * 96) * TBP + tok0 + q;
      for (int c = 0; c < 96; ++c) { const float v = bf2f(src[(size_t)c * TBP]); s += v; ss += v * v; }
      red[qf * 256 + q * 2] = s; red[qf * 256 + q * 2 + 1] = ss;
      __syncthreads();
      if (tid < 128) {
        const float s1 = red[q * 2] + red[256 + q * 2] + red[512 + q * 2] + red[768 + q * 2];
        const float s2 = red[q * 2 + 1] + red[256 + q * 2 + 1] + red[512 + q * 2 + 1] + red[768 + q * 2 + 1];
        const float mu = s1 * (1.f / 384.f);
        const float var = fmaxf(s2 * (1.f / 384.f) - mu * mu, 0.f);
        st[q] = mu; st[128 + q] = rsqrtf(var + 1e-6f);
      }
      __syncthreads();
    }
    const u16* Wm = p.SgW + (size_t)((l * 4 + h) * 128) * 128;
    auto la = [&](int row, int k) __attribute__((always_inline)) { return *(const u32x4*)(Wm + row * 128 + k); };
    auto lb = [&](int row, int k) __attribute__((always_inline)) {
      if (row >= 96) return zero4();
      const int c = h * 96 + row;
      const u32x4 raw = *(const u32x4*)(p.cvT + (size_t)c * TBP + tok0 + k);
      const float g = p.ln_g[l * 384 + c], b = p.ln_b[l * 384 + c];
      u32x4 o;
#pragma unroll
      for (int jj = 0; jj < 4; ++jj) {
        const float v0 = (bflo(raw[jj]) - st[k + 2 * jj]) * st[128 + k + 2 * jj] * g + b;
        const float v1 = (bfhi(raw[jj]) - st[k + 2 * jj + 1]) * st[128 + k + 2 * jj + 1] * g + b;
        o[jj] = pack2(v0, v1);
      }
      return o;
    };
    auto epi = [&](f32x16 (&acc)[2], int wm, int wn, int lane) __attribute__((always_inline)) {
      const int lr = lane & 31, lh = lane >> 5;
      const int cl = wn * 32 + lr;
      if (cl < 96) {
#pragma unroll
        for (int i = 0; i < 2; ++i)
#pragma unroll
          for (int r = 0; r < 16; ++r) {
            const int pp = wm * 64 + i * 32 + rowmap(r, lh);
            const float val = acc[i][r] + p.sgu_b[(l * 4 + h) * 128 + pp];
            u16* dst = p.cu + (size_t)(tok0 + pp) * 384 + h * 96 + cl;
            *dst = f2bf(bf2f(*dst) * val);
          }
      }
    };
    gemm_tile<false, false>(smem, 2, la, lb, epi);
  }
  base += 512;
}

DI void phase_qup(const Prm& p, unsigned char* smem_raw, int l, int S, int& base) {
  u16* smem = (u16*)smem_raw;
  float* st = (float*)(smem_raw + GEMM_SMEM);
  const int tid = tidx();
  const float QS = 0.10206207261596577f * LOG2E;
  TASK_LOOP(t, 3 * 128, base) {
    const int tn = t % 3, tm = t / 3, n0 = tn * 128, m0 = tm * 128;
    {
      const int row = tid >> 2, qf = tid & 3;
      const u16* src = p.dcq + (size_t)(m0 + row) * 384 + qf * 96;
      float ss = 0.f;
#pragma unroll 4
      for (int c = 0; c < 12; ++c) {
        const u32x4 v = *(const u32x4*)(src + c * 8);
#pragma unroll
        for (int jj = 0; jj < 4; ++jj) { const float a = bflo(v[jj]), b = bfhi(v[jj]); ss += a * a + b * b; }
      }
      ss += __shfl_xor(ss, 1);
      ss += __shfl_xor(ss, 2);
      if (qf == 0) st[row] = rsqrtf(ss * (1.f / 384.f) + 1e-6f);
      __syncthreads();
    }
    const u16* W = p.WqT + (size_t)l * 384 * 384;
    auto la = [&](int row, int k) __attribute__((always_inline)) { return *(const u32x4*)(W + (size_t)(n0 + row) * 384 + k); };
    auto lb = [&](int row, int k) __attribute__((always_inline)) { return *(const u32x4*)(p.dcq + (size_t)(m0 + row) * 384 + k); };
    auto epi = [&](f32x16 (&acc)[2], int wm, int wn, int lane) __attribute__((always_inline)) {
      const int lr = lane & 31, lh = lane >> 5;
      const int tokl = wn * 32 + lr, tok = m0 + tokl;
      const float sc = st[tokl] * QS;
#pragma unroll
      for (int i = 0; i < 2; ++i) {
        const int nb = n0 + wm * 64 + i * 32;
        const int head = nb / 96, within = nb - head * 96;
        const f32x16& a = acc[i];
        if (within < 64) {
#pragma unroll
          for (int q = 0; q < 4; ++q)
            st4bf(p.qc + (size_t)tok * 384 + nb + 8 * q + 4 * lh, a[4 * q] * sc, a[4 * q + 1] * sc, a[4 * q + 2] * sc, a[4 * q + 3] * sc);
        } else {
          const int pos = tok & (S - 1);
#pragma unroll
          for (int q = 0; q < 2; ++q)
#pragma unroll
            for (int e = 0; e < 4; ++e) {
              const int r = 4 * q + e, ii = 8 * q + 4 * lh + e;
              const float2 cs = p.rope[pos * 16 + ii];
              const float x1 = a[r] * sc, x2 = a[r + 8] * sc;
              p.qc[(size_t)tok * 384 + head * 96 + 64 + ii] = f2bf(x1 * cs.x - x2 * cs.y);
              p.qc[(size_t)tok * 384 + head * 96 + 80 + ii] = f2bf(x1 * cs.y + x2 * cs.x);
            }
        }
      }
    };
    gemm_tile2s<false, false>(smem, 6, la, lb, epi);
    __syncthreads();
  }
  base += 3 * 128;
}

DI void phase_kvup(const Prm& p, unsigned char* smem_raw, int l, int& base) {
  u16* smem = (u16*)smem_raw;
  float* st = (float*)(smem_raw + GEMM_SMEM);
  const int tid = tidx();
  TASK_LOOP(t, 4 * 128, base) {
    const int tn = t & 3, tm = t >> 2, n0 = tn * 128, m0 = tm * 128;
    {
      const int row = tid >> 2, qf = tid & 3;
      const u16* src = p.dckv + (size_t)(m0 + row) * 320 + qf * 80;
      float ss = 0.f;
#pragma unroll 5
      for (int c = 0; c < 10; ++c) {
        const u32x4 v = *(const u32x4*)(src + c * 8);
#pragma unroll
        for (int jj = 0; jj < 4; ++jj) { const float a = bflo(v[jj]), b = bfhi(v[jj]); ss += a * a + b * b; }
      }
      ss += __shfl_xor(ss, 1);
      ss += __shfl_xor(ss, 2);
      if (qf == 0) st[row] = rsqrtf(ss * (1.f / 320.f) + 1e-6f);
      __syncthreads();
    }
    const u16* W = p.WkvT + (size_t)l * 512 * 320;
    auto la = [&](int row, int k) __attribute__((always_inline)) { return *(const u32x4*)(W + (size_t)(n0 + row) * 320 + k); };
    auto lb = [&](int row, int k) __attribute__((always_inline)) { return *(const u32x4*)(p.dckv + (size_t)(m0 + row) * 320 + k); };
    auto epi = [&](f32x16 (&acc)[2], int wm, int wn, int lane) __attribute__((always_inline)) {
      const int lr = lane & 31, lh = lane >> 5;
      const int head = tn;
      const int tokl = wn * 32 + lr, tok = m0 + tokl;
      const float sc = st[tokl];
#pragma unroll
      for (int i = 0; i < 2; ++i) {
        const int within = wm * 64 + i * 32;
        const f32x16& a = acc[i];
        if (within < 64) {
#pragma unroll
          for (int q = 0; q < 4; ++q)
            st4bf(p.kc + (size_t)tok * 384 + head * 96 + within + 8 * q + 4 * lh, a[4 * q] * sc, a[4 * q + 1] * sc, a[4 * q + 2] * sc, a[4 * q + 3] * sc);
        } else {
#pragma unroll
          for (int r = 0; r < 16; ++r)
            p.vT[(size_t)(head * 64 + within - 64 + rowmap(r, lh)) * TBP + tok] = f2bf(a[r] * sc);
        }
      }
    };
    gemm_tile2s<false, false>(smem, 5, la, lb, epi);
    __syncthreads();
  }
  base += 4 * 128;
}

DI void phase_mixb(const Prm& p, unsigned char* smem_raw, int S, int lgS, int& base) {
  float* bt = (float*)smem_raw;
  const int tid = tidx(), lane = tid & 63, wave = tid >> 6, lr = lane & 31, lh = lane >> 5;
  u16* vt = (u16*)(smem_raw + 3328) + wave * (64 * 40);
  for (int idx = tid; idx < 774; idx += NTH) bt[idx] = p.biasT[idx];
  __syncthreads();
  TASK_LOOP(t, 384, base) {
    const int wt = t * 8 + wave;
    const int hg = wt & 1, g = (wt >> 1) % 3, blk = wt / 6;
    const int seq = blk >> (lgS - 5), b_in = blk & ((S >> 5) - 1);
    const int lgd = 2 * g, L = S >> lgd;
    const int lgbpr = lgS - lgd - 5;
    const int res = b_in >> lgbpr, i0 = (b_in & ((1 << lgbpr) - 1)) << 5;
    const int tokbase = seq * S + res;
    const int hd = g * 2 + hg, hc = hd * 64;
    const int qi = i0 + lr;
    const int qtok = tokbase + (qi << lgd);
    bf16x8 qf[4];
#pragma unroll
    for (int ks = 0; ks < 4; ++ks) qf[ks] = *(const bf16x8*)(p.bqkv + (size_t)qtok * 1152 + hc + ks * 16 + lh * 8);
    f32x16 sc[5];
#pragma unroll
    for (int tt = 0; tt < 5; ++tt) {
      int ik = i0 - 64 + 32 * tt + lr;
      ik = min(max(ik, 0), L - 1);
      const u16* kp = p.bqkv + (size_t)(tokbase + (ik << lgd)) * 1152 + 384 + hc + lh * 8;
      sc[tt] = zero16();
#pragma unroll
      for (int ks = 0; ks < 4; ++ks) sc[tt] = mfma(*(const bf16x8*)(kp + ks * 16), qf[ks], sc[tt]);
    }
    float mx = -1e30f;
#pragma unroll
    for (int tt = 0; tt < 5; ++tt)
#pragma unroll
      for (int r = 0; r < 16; ++r) {
        const int ik = i0 - 64 + 32 * tt + rowmap(r, lh);
        const int rel = ik - qi;
        const bool valid = (rel >= -64) && (rel <= 64) && (ik >= 0) && (ik < L);
        const int bi = min(max(rel + 64, 0), 128);
        const float s = valid ? (sc[tt][r] * 0.125f + bt[hd * 129 + bi]) * LOG2E : -1e30f;
        sc[tt][r] = s;
        mx = fmaxf(mx, s);
      }
    mx = fmaxf(mx, __shfl_xor(mx, 32));
    float sum = 0.f;
#pragma unroll
    for (int tt = 0; tt < 5; ++tt)
#pragma unroll
      for (int r = 0; r < 16; ++r) {
        const float pv = ex2(sc[tt][r] - mx);
        sum += pv;
        sc[tt][r] = pv;
      }
    sum += __shfl_xor(sum, 32);
    f32x16 oacc[2];
    oacc[0] = zero16(); oacc[1] = zero16();
#pragma unroll
    for (int tt = 0; tt < 5; ++tt) {
#pragma unroll
      for (int e = 0; e < 4; ++e) {
        const int c = lane + 64 * e, key = c >> 3, dch = c & 7;
        int ik = i0 - 64 + 32 * tt + key;
        ik = min(max(ik, 0), L - 1);
        const u32x4 raw = *(const u32x4*)(p.bqkv + (size_t)(tokbase + (ik << lgd)) * 1152 + 768 + hc + dch * 8);
#pragma unroll
        for (int jj = 0; jj < 4; ++jj) {
          vt[(dch * 8 + 2 * jj) * 40 + key] = (u16)(raw[jj] & 0xffffu);
          vt[(dch * 8 + 2 * jj + 1) * 40 + key] = (u16)(raw[jj] >> 16);
        }
      }
      __syncthreads();
#pragma unroll
      for (int u = 0; u < 2; ++u) {
        u32x4 pk;
#pragma unroll
        for (int jj = 0; jj < 4; ++jj) pk[jj] = pack2(sc[tt][8 * u + 2 * jj], sc[tt][8 * u + 2 * jj + 1]);
        const bf16x8 pf = __builtin_bit_cast(bf16x8, pk);
#pragma unroll
        for (int dt = 0; dt < 2; ++dt) {
          const u16* vp = vt + (dt * 32 + lr) * 40 + 16 * u + 4 * lh;
          u32x4 vv;
          const u32x2 lo = *(const u32x2*)vp, hi = *(const u32x2*)(vp + 8);
          vv[0] = lo[0]; vv[1] = lo[1]; vv[2] = hi[0]; vv[3] = hi[1];
          oacc[dt] = mfma(__builtin_bit_cast(bf16x8, vv), pf, oacc[dt]);
        }
      }
      __syncthreads();
    }
    const float inv = 1.f / sum;
#pragma unroll
    for (int dt = 0; dt < 2; ++dt)
#pragma unroll
      for (int q = 0; q < 4; ++q) {
        float4 o;
        o.x = oacc[dt][4 * q] * inv; o.y = oacc[dt][4 * q + 1] * inv; o.z = oacc[dt][4 * q + 2] * inv; o.w = oacc[dt][4 * q + 3] * inv;
        *(float4*)(p.og + (size_t)qtok * 384 + hc + dt * 32 + 8 * q + 4 * lh) = o;
      }
    if (lh == 0) p.lse[(size_t)qtok * 6 + hd] = (mx + __log2f(sum)) * LN2;
  }
  base += 384;
  __syncthreads();
}

DI void phase_combb(const Prm& p) {
  const int gtid = blockIdx.x * NTH + tidx(), gn = gridDim.x * NTH;
  for (int idx = gtid; idx < TB * 32; idx += gn) {
    const int dq = idx & 15, hg = (idx >> 4) & 1, tok = idx >> 5;
    const float l0 = p.lse[(size_t)tok * 6 + hg], l1 = p.lse[(size_t)tok * 6 + 2 + hg], l2 = p.lse[(size_t)tok * 6 + 4 + hg];
    const float mx = fmaxf(l0, fmaxf(l1, l2));
    const float e0 = __expf(l0 - mx), e1 = __expf(l1 - mx), e2 = __expf(l2 - mx);
    const float inv = 1.f / (e0 + e1 + e2);
    const float4 a = *(const float4*)(p.og + (size_t)tok * 384 + hg * 64 + dq * 4);
    const float4 b = *(const float4*)(p.og + (size_t)tok * 384 + 128 + hg * 64 + dq * 4);
    const float4 c = *(const float4*)(p.og + (size_t)tok * 384 + 256 + hg * 64 + dq * 4);
    st4bf(p.ob + (size_t)tok * 128 + hg * 64 + dq * 4, (e0 * a.x + e1 * b.x + e2 * c.x) * inv, (e0 * a.y + e1 * b.y + e2 * c.y) * inv,
          (e0 * a.z + e1 * b.z + e2 * c.z) * inv, (e0 * a.w + e1 * b.w + e2 * c.w) * inv);
  }
}

constexpr int KS_ELEMS = 128 * 104, VS_ELEMS = 64 * 136;
DI void phase_mla(const Prm& p, unsigned char* smem_raw, int S, int lgS, int& base) {
  u16* Ks = (u16*)smem_raw;
  u16* Vs = Ks + 2 * KS_ELEMS;
  const int tid = tidx(), lane = tid & 63, wave = tid >> 6, lr = lane & 31, lh = lane >> 5;
  const int nkt = S >> 7;
  TASK_LOOP(t, 256, base) {
    const int head = t & 3, qb = t >> 2, tok0 = qb * 256;
    const int seqtok0 = (tok0 >> lgS) << lgS;
    const int qtok = tok0 + wave * 32 + lr;
    bf16x8 qf[6];
#pragma unroll
    for (int ks = 0; ks < 6; ++ks) qf[ks] = *(const bf16x8*)(p.qc + (size_t)qtok * 384 + head * 96 + ks * 16 + lh * 8);
    const u16* kbase = p.kc + (size_t)seqtok0 * 384 + head * 96;
    const u16* vbase = p.vT + (size_t)(head * 64) * TBP + seqtok0;
    u32x4 rk[3], rv[2];
    auto gload = [&](int kt) __attribute__((always_inline)) {
#pragma unroll
      for (int e = 0; e < 3; ++e) {
        const int c = tid + NTH * e, key = c / 12, dc = c - key * 12;
        rk[e] = *(const u32x4*)(kbase + (size_t)(kt * 128 + key) * 384 + dc * 8);
      }
#pragma unroll
      for (int e = 0; e < 2; ++e) {
        const int c = tid + NTH * e, d = c >> 4, kch = c & 15;
        rv[e] = *(const u32x4*)(vbase + (size_t)d * TBP + kt * 128 + kch * 8);
      }
    };
    auto sstore = [&](int buf) __attribute__((always_inline)) {
#pragma unroll
      for (int e = 0; e < 3; ++e) {
        const int c = tid + NTH * e, key = c / 12, dc = c - key * 12;
        *(u32x4*)(Ks + buf * KS_ELEMS + key * 104 + dc * 8) = rk[e];
      }
#pragma unroll
      for (int e = 0; e < 2; ++e) {
        const int c = tid + NTH * e, d = c >> 4, kch = c & 15;
        u16* vd = Vs + buf * VS_ELEMS + d * 136 + (kch >> 1) * 16 + (kch & 1) * 4;
        u32x2 lo, hi;
        lo[0] = rv[e][0]; lo[1] = rv[e][1]; hi[0] = rv[e][2]; hi[1] = rv[e][3];
        *(u32x2*)vd = lo;
        *(u32x2*)(vd + 8) = hi;
      }
    };
    float m = -1e30f;
    f32x2 lsum2 = {0.f, 0.f};
    f32x16 oacc[2];
    oacc[0] = zero16(); oacc[1] = zero16();
    gload(0);
    sstore(0);
    __syncthreads();
    for (int kt = 0; kt < nkt; ++kt) {
      const int buf = kt & 1;
      if (kt + 1 < nkt) gload(kt + 1);
      f32x16 s[4];
#pragma unroll
      for (int kk = 0; kk < 4; ++kk) s[kk] = zero16();
      {
        const u16* kp = Ks + buf * KS_ELEMS + lr * 104 + lh * 8;
        bf16x8 kf[4];
#pragma unroll
        for (int kk = 0; kk < 4; ++kk) kf[kk] = *(const bf16x8*)(kp + kk * 32 * 104);
#pragma unroll
        for (int ks = 0; ks < 6; ++ks) {
          bf16x8 kn[4];
          if (ks < 5) {
#pragma unroll
            for (int kk = 0; kk < 4; ++kk) kn[kk] = *(const bf16x8*)(kp + kk * 32 * 104 + (ks + 1) * 16);
          }
#pragma unroll
          for (int kk = 0; kk < 4; ++kk) s[kk] = mfma(kf[kk], qf[ks], s[kk]);
          if (ks < 5) {
#pragma unroll
            for (int kk = 0; kk < 4; ++kk) kf[kk] = kn[kk];
          }
        }
      }
      float mloc = -1e30f;
#pragma unroll
      for (int kk = 0; kk < 4; ++kk)
#pragma unroll
        for (int r = 0; r < 16; ++r) mloc = fmaxf(mloc, s[kk][r]);
      mloc = fmaxf(mloc, __shfl_xor(mloc, 32));
      const float mnew = fmaxf(m, mloc);
      const float alpha = ex2(m - mnew);
      m = mnew;
      lsum2 *= alpha;
      const f32x2 mn2 = {mnew, mnew};
#pragma unroll
      for (int kk = 0; kk < 4; ++kk)
#pragma unroll
        for (int r2 = 0; r2 < 8; ++r2) {
          f32x2 v = {s[kk][2 * r2], s[kk][2 * r2 + 1]};
          v = v - mn2;
          f32x2 pv;
          pv[0] = ex2(v[0]); pv[1] = ex2(v[1]);
          lsum2 += pv;
          s[kk][2 * r2] = pv[0]; s[kk][2 * r2 + 1] = pv[1];
        }
#pragma unroll
      for (int dt = 0; dt < 2; ++dt)
#pragma unroll
        for (int r = 0; r < 16; ++r) oacc[dt][r] *= alpha;
#pragma unroll
      for (int kk = 0; kk < 4; ++kk)
#pragma unroll
        for (int u = 0; u < 2; ++u) {
          u32x4 pk;
#pragma unroll
          for (int jj = 0; jj < 4; ++jj) pk[jj] = pack2(s[kk][8 * u + 2 * jj], s[kk][8 * u + 2 * jj + 1]);
          const bf16x8 pf = __builtin_bit_cast(bf16x8, pk);
#pragma unroll
          for (int dt = 0; dt < 2; ++dt) {
            const u16* vp = Vs + buf * VS_ELEMS + (dt * 32 + lr) * 136 + kk * 32 + 16 * u + 8 * lh;
            oacc[dt] = mfma(*(const bf16x8*)vp, pf, oacc[dt]);
          }
        }
      if (kt + 1 < nkt) sstore(buf ^ 1);
      __syncthreads();
    }
    float lsum = lsum2[0] + lsum2[1];
    lsum += __shfl_xor(lsum, 32);
    const float inv = 1.f / lsum;
#pragma unroll
    for (int dt = 0; dt < 2; ++dt)
#pragma unroll
      for (int q = 0; q < 4; ++q)
        st4bf(p.od + (size_t)qtok * 256 + head * 64 + dt * 32 + 8 * q + 4 * lh, oacc[dt][4 * q] * inv, oacc[dt][4 * q + 1] * inv,
              oacc[dt][4 * q + 2] * inv, oacc[dt][4 * q + 3] * inv);
  }
  base += 256;
}

DI int perm_m(int s) { return 16 * ((s >> 2) & 1) + 4 * (s >> 3) + (s & 3); }

template <class ACC>
DI void merge_branch(const Prm& p, u16* smem, const u16* W, const u16* X, int ld, int bi, int n0, int m0, ACC& macc) {
  auto la = [&](int row, int k) __attribute__((always_inline)) { return *(const u32x4*)(W + (size_t)(n0 + (row & ~31) + perm_m(row & 31)) * ld + k); };
  auto lb = [&](int row, int k) __attribute__((always_inline)) { return *(const u32x4*)(X + (size_t)(m0 + row) * ld + k); };
  auto epi = [&](f32x16 (&acc)[2], int wm, int wn, int lane) __attribute__((always_inline)) {
    const int lr = lane & 31, lh = lane >> 5;
    const int tok = m0 + wn * 32 + lr;
#pragma unroll
    for (int i = 0; i < 2; ++i)
#pragma unroll
      for (int h2 = 0; h2 < 2; ++h2) {
        const int n = n0 + wm * 64 + i * 32 + 16 * lh + 8 * h2;
        const u32x4 gz = *(const u32x4*)(p.zg + (size_t)tok * 4096 + bi * 1024 + n);
#pragma unroll
        for (int e = 0; e < 4; ++e) {
          macc[i][8 * h2 + 2 * e] += bflo(gz[e]) * acc[i][8 * h2 + 2 * e];
          macc[i][8 * h2 + 2 * e + 1] += bfhi(gz[e]) * acc[i][8 * h2 + 2 * e + 1];
        }
      }
  };
  gemm_tile2s<false, false>(smem, ld >> 6, la, lb, epi);
}

DI void phase_merge(const Prm& p, u16* smem, int l, int& base) {
  TASK_LOOP(t, 8 * 128, base) {
    const int tn = t & 7, tm = t >> 3, n0 = tn * 128, m0 = tm * 128;
    f32x16 macc[2];
    macc[0] = zero16(); macc[1] = zero16();
    merge_branch(p, smem, p.PaT + (size_t)l * 1024 * 768, p.UT, 768, 0, n0, m0, macc);
    merge_branch(p, smem, p.PbT + (size_t)l * 1024 * 128, p.ob, 128, 1, n0, m0, macc);
    merge_branch(p, smem, p.PcT + (size_t)l * 1024 * 384, p.cu, 384, 2, n0, m0, macc);
    merge_branch(p, smem, p.PdT + (size_t)l * 1024 * 256, p.od, 256, 3, n0, m0, macc);
    const int tid2 = tidx(), lane = tid2 & 63, wave = tid2 >> 6, wm = wave >> 2, wn = wave & 3, lr = lane & 31, lh = lane >> 5;
    const int tok = m0 + wn * 32 + lr;
#pragma unroll
    for (int i = 0; i < 2; ++i)
#pragma unroll
      for (int h2 = 0; h2 < 2; ++h2) {
        u32x4 o;
#pragma unroll
        for (int e = 0; e < 4; ++e) o[e] = pack2(macc[i][8 * h2 + 2 * e], macc[i][8 * h2 + 2 * e + 1]);
        *(u32x4*)(p.hbuf + (size_t)tok * 1024 + n0 + wm * 64 + i * 32 + 16 * lh + 8 * h2) = o;
      }
  }
  base += 8 * 128;
}

DI void phase_resid_gemm(const Prm& p, unsigned char* smem_raw, const u16* W, const u16* X, int K, const float* xsrc, float* xdst,
                         const float* modl, int gtoff, int sb, int& base) {
  LAS u16* shm = (LAS u16*)smem_raw;
  bool pre = false;
  TASK_LOOP(t, 4 * 64, base) {
    int tn, tm;
    map256(t, 4, tn, tm);
    const int brow = tn * 256, bcol = tm * 256;
    const int tnx = t + (int)gridDim.x;
    const bool has_next = tnx < (4 * 64);
    int tn2 = 0, tm2 = 0;
    if (has_next) map256(tnx, 4, tn2, tm2);
    const int nbrow = tn2 * 256, nbcol = tm2 * 256;
    auto epi = [&](f32x4 (&acc)[2][2][4][2], int wr, int wc, int fr, int fq) __attribute__((always_inline)) {
#pragma unroll
      for (int bj = 0; bj < 2; ++bj)
#pragma unroll
        for (int n = 0; n < 2; ++n) {
          const int tok = bcol + bj * 128 + wc * 32 + n * 16 + fr;
          const float* gt = modl + condrow(sb, tok) * 6144 + gtoff;
#pragma unroll
          for (int ai = 0; ai < 2; ++ai)
#pragma unroll
            for (int m = 0; m < 4; ++m) {
              const int nn = brow + ai * 128 + wr * 64 + m * 16 + fq * 4;
              const f32x4 v = acc[ai][bj][m][n];
              const float4 g4 = *(const float4*)(gt + nn);
              const float4 xi = *(const float4*)(xsrc + (size_t)tok * 1024 + nn);
              float4 o;
              o.x = xi.x + g4.x * v[0]; o.y = xi.y + g4.y * v[1]; o.z = xi.z + g4.z * v[2]; o.w = xi.w + g4.w * v[3];
              *(float4*)(xdst + (size_t)tok * 1024 + nn) = o;
            }
        }
    };
    gemm256<false>(shm, W, X, K, brow, bcol, pre, has_next, nbrow, nbcol, epi);
    pre = has_next;
  }
  base += 4 * 64;
}

DI void phase_w1(const Prm& p, unsigned char* smem_raw, int l, int& base) {
  const u16* W = p.W1T + (size_t)l * 4096 * 1024;
  LAS u16* shm = (LAS u16*)smem_raw;
  bool pre = false;
  TASK_LOOP(t, 16 * 64, base) {
    int tn, tm;
    map256(t, 16, tn, tm);
    const int brow = tn * 256, bcol = tm * 256;
    const int tnx = t + (int)gridDim.x;
    const bool has_next = tnx < (16 * 64);
    int tn2 = 0, tm2 = 0;
    if (has_next) map256(tnx, 16, tn2, tm2);
    const int nbrow = tn2 * 256, nbcol = tm2 * 256;
    auto epi = [&](f32x4 (&acc)[2][2][4][2], int wr, int wc, int fr, int fq) __attribute__((always_inline)) {
#pragma unroll
      for (int bj = 0; bj < 2; ++bj)
#pragma unroll
        for (int n = 0; n < 2; ++n) {
          const int tok = bcol + bj * 128 + wc * 32 + n * 16 + fr;
#pragma unroll
          for (int ai = 0; ai < 2; ++ai)
#pragma unroll
            for (int mp = 0; mp < 2; ++mp) {
              const int nn = brow + ai * 128 + wr * 64 + mp * 32 + fq * 8;
              const f32x4 v = acc[ai][bj][2 * mp][n], w = acc[ai][bj][2 * mp + 1][n];
              const float a0 = fmaxf(v[0], 0.f), a1 = fmaxf(v[1], 0.f), a2 = fmaxf(v[2], 0.f), a3 = fmaxf(v[3], 0.f);
              const float b0 = fmaxf(w[0], 0.f), b1 = fmaxf(w[1], 0.f), b2 = fmaxf(w[2], 0.f), b3 = fmaxf(w[3], 0.f);
              u32x4 o;
              o[0] = pack2(a0 * a0, a1 * a1); o[1] = pack2(a2 * a2, a3 * a3); o[2] = pack2(b0 * b0, b1 * b1); o[3] = pack2(b2 * b2, b3 * b3);
              *(u32x4*)(p.zg + (size_t)tok * 4096 + nn) = o;
            }
        }
    };
    gemm256<true>(shm, W, p.hbuf, 1024, brow, bcol, pre, has_next, nbrow, nbcol, epi);
    pre = has_next;
  }
  base += 16 * 64;
}

DI void phase_final(const Prm& p) {
  const int tid = tidx(), lane = tid & 63;
  const int gw = blockIdx.x * 8 + (tid >> 6), nw = gridDim.x * 8;
  for (int row = gw; row < 3 * TB; row += nw) {
    float* xr = p.out + (size_t)row * 1024;
    float4 v[4];
    float ss = 0.f;
#pragma unroll
    for (int i = 0; i < 4; ++i) {
      v[i] = *(const float4*)(xr + i * 256 + lane * 4);
      ss += v[i].x * v[i].x + v[i].y * v[i].y + v[i].z * v[i].z + v[i].w * v[i].w;
    }
#pragma unroll
    for (int off = 32; off >= 1; off >>= 1) ss += __shfl_xor(ss, off);
    const float rstd = rsqrtf(ss * (1.f / 1024.f) + 1e-6f);
#pragma unroll
    for (int i = 0; i < 4; ++i) {
      const int col = i * 256 + lane * 4;
      const float4 gg = *(const float4*)(p.final_g + col);
      float4 o;
      o.x = v[i].x * rstd * gg.x; o.y = v[i].y * rstd * gg.y; o.z = v[i].z * rstd * gg.z; o.w = v[i].w * rstd * gg.w;
      *(float4*)(xr + col) = o;
    }
  }
}

__global__ void __launch_bounds__(512) mega(Prm p) {
  cg::grid_group grid = cg::this_grid();
  __shared__ __attribute__((aligned(16))) unsigned char smem_raw[SMEM_BYTES];
  __shared__ uint4 xb_words;
  u16* smem = (u16*)smem_raw;
  if (threadIdx.x == 0) xb_words = make_uint4(0u, 0u, 0u, 0u);
  __syncthreads();
  const XcdBarrier xb = xcd_barrier_post(p.bar, (volatile LAS unsigned*)&xb_words);
  int base = 0;
  prologue_a(p, smem_raw, base);
  if (PROBE == 11) prologue_a(p, smem_raw, base);
  grid.sync();
  prologue_b(p);
  xcd_barrier(xb);
  for (int sb = 0; sb < 3; ++sb) {
    const int S = sb == 0 ? 16384 : 2048, lgS = sb == 0 ? 14 : 11, nseq = sb == 0 ? 1 : 8;
    const int N1 = S >> 7, lgN1 = lgS - 7;
    const float* xin = sb == 0 ? p.x_prompt : p.x_sample + (size_t)(sb - 1) * TB * 1024;
    float* xo = p.out + (size_t)sb * TB * 1024;
    for (int l = 0; l < 4; ++l) {
      const float* xs = l == 0 ? xin : xo;
      const float* modl = p.mod + (size_t)l * 17 * 6144;
      phase_norm(p, xs, p.norm1_g + l * 1024, modl, 0, 1024, sb);
      xcd_barrier(xb);
      phase_inproj(p, smem_raw, l, S, base);
      if (PROBE == 2 || PROBE == 7) phase_inproj(p, smem_raw, l, S, base);
      if (PROBE == 12) phase_inproj_probe(p, smem_raw, l, base);
      xcd_barrier(xb);
      if (PROBE == 5) xcd_barrier(xb);
      if (N1 == 16) phase_fft1_small(p, nseq); else phase_fft1(p, smem, S, nseq, N1, lgN1, base);
      phase_mixb(p, smem_raw, S, lgS, base);
      phase_mixc(p, smem_raw, l, base);
      phase_qup(p, smem_raw, l, S, base);
      phase_kvup(p, smem_raw, l, base);
      phase_inproj_tail(p, smem_raw, l, base);
      if (PROBE == 13) phase_fft1(p, smem, S, nseq, N1, lgN1, base);
      if (PROBE == 14) phase_mixb(p, smem_raw, S, lgS, base);
      if (PROBE == 15) { phase_qup(p, smem_raw, l, S, base); phase_kvup(p, smem_raw, l, base); phase_inproj_tail(p, smem_raw, l, base); }
      if (PROBE == 4) { phase_fft1(p, smem, S, nseq, N1, lgN1, base); phase_mixb(p, smem_raw, S, lgS, base); phase_qup(p, smem_raw, l, S, base); phase_kvup(p, smem_raw, l, base); }
      xcd_barrier(xb);
      if (PROBE == 5) xcd_barrier(xb);
      phase_mla(p, smem_raw, S, lgS, base);
      if (PROBE == 1) phase_mla(p, smem_raw, S, lgS, base);
      phase_fft2(p, smem, S, nseq, N1, base);
      phase_combb(p);
      if (PROBE == 6) { phase_fft2(p, smem, S, nseq, N1, base); phase_combb(p); }
      xcd_barrier(xb);
      if (PROBE == 5) xcd_barrier(xb);
      phase_merge(p, smem, l, base);
      if (PROBE == 3) phase_merge(p, smem, l, base);
      xcd_barrier(xb);
      if (PROBE == 5) xcd_barrier(xb);
      phase_resid_gemm(p, smem_raw, p.WoT + (size_t)l * 1024 * 1024, p.hbuf, 1024, xs, xo, modl, 2048, sb, base);
      xcd_barrier(xb);
      phase_norm(p, xo, p.norm2_g + l * 1024, modl, 3072, 4096, sb);
      if (PROBE == 9) { phase_norm(p, xo, p.norm2_g + l * 1024, modl, 3072, 4096, sb); phase_norm(p, xo, p.norm2_g + l * 1024, modl, 3072, 4096, sb); }
      xcd_barrier(xb);
      phase_w1(p, smem_raw, l, base);
      if (PROBE == 2 || PROBE == 8) phase_w1(p, smem_raw, l, base);
      xcd_barrier(xb);
      if (PROBE == 5) xcd_barrier(xb);
      phase_resid_gemm(p, smem_raw, p.W2T + (size_t)l * 1024 * 4096, p.zg, 4096, xo, xo, modl, 5120, sb, base);
      xcd_barrier(xb);
    }
  }
  phase_final(p);
}

extern "C" void kernel_launch(void* const* d_in, const int* in_sizes, int n_in, void* d_out, int out_size, void* d_ws, size_t ws_size,
                              hipStream_t stream) {
  Prm p{};
  const float* const* in = (const float* const*)d_in;
  p.x_prompt = in[0]; p.x_sample = in[1]; p.c_prompt = in[2]; p.c_sample = in[3]; p.rel_bias = in[4]; p.ada_w = in[5]; p.ada_b = in[6];
  p.norm1_g = in[7]; p.w_in = in[8]; p.qn_g = in[9]; p.kvn_g = in[10]; p.w_uq = in[11]; p.w_ukv = in[12]; p.ln_g = in[13]; p.ln_b = in[14];
  p.sgu_w = in[15]; p.sgu_b = in[16]; p.p_a = in[17]; p.p_b = in[18]; p.p_c = in[19]; p.p_d = in[20]; p.w_o = in[21]; p.norm2_g = in[22];
  p.w1 = in[23]; p.w2 = in[24]; p.final_g = in[25];
  p.out = (float*)d_out;
  char* w = (char*)d_ws;
  size_t off = 0;
  auto take = [&](size_t bytes) __attribute__((always_inline)) { void* r = w + off; off += (bytes + 255) & ~(size_t)255; return r; };
  p.WinT = (u16*)take((size_t)4 * NWP * 1024 * 2);
  p.W1T = (u16*)take((size_t)4 * 4096 * 1024 * 2);
  p.W2T = (u16*)take((size_t)4 * 4096 * 1024 * 2);
  p.WoT = (u16*)take((size_t)4 * 1024 * 1024 * 2);
  p.PaT = (u16*)take((size_t)4 * 1024 * 768 * 2);
  p.PbT = (u16*)take((size_t)4 * 1024 * 128 * 2);
  p.PcT = (u16*)take((size_t)4 * 1024 * 384 * 2);
  p.PdT = (u16*)take((size_t)4 * 1024 * 256 * 2);
  p.WqT = (u16*)take((size_t)4 * 384 * 384 * 2);
  p.WkvT = (u16*)take((size_t)4 * 512 * 320 * 2);
  p.SgW = (u16*)take((size_t)4 * 4 * 128 * 128 * 2);
  p.M1a = (u16*)take(256 * 256 * 2);
  p.M1b = (u16*)take(32 * 64 * 2);
  p.M2 = (u16*)take(128 * 256 * 2);
  p.tw = (float2*)take(16384 * 8);
  p.rope = (float2*)take((size_t)16384 * 16 * 8);
  p.biasT = (float*)take(6 * 129 * 4);
  p.mod = (float*)take((size_t)4 * 17 * 6144 * 4);
  p.hbuf = (u16*)take((size_t)TB * 1024 * 2);
  p.og = (float*)take((size_t)TB * 384 * 4);
  p.UT = (u16*)take((size_t)1536 * TBP * 2);
  p.Gp = (u16*)take((size_t)1536 * TB * 2);
  p.bqkv = (u16*)take((size_t)TB * 1152 * 2);
  p.ob = (u16*)take((size_t)TB * 128 * 2);
  p.cu = (u16*)take((size_t)TB * 384 * 2);
  p.cvT = (u16*)take((size_t)TBP * 384 * 2);
  p.dcq = (u16*)take((size_t)TB * 384 * 2);
  p.dckv = (u16*)take((size_t)TB * 320 * 2);
  p.qc = (u16*)take((size_t)TB * 384 * 2);
  p.kc = (u16*)take((size_t)TB * 384 * 2);
  p.vT = (u16*)take((size_t)TBP * 256 * 2);
  p.od = (u16*)take((size_t)TB * 256 * 2);
  p.lse = (float*)take((size_t)TB * 6 * 4);
  p.zg = (u16*)take((size_t)TB * 4096 * 2);
  p.bar = (unsigned*)take(XCD_BAR_WORDS * 4);
  p.modpart = (float*)p.zg;
  if (off > ws_size) { fprintf(stderr, "workspace too small: need %zu have %zu\n", off, ws_size); return; }
  static int grid_blocks = 0;
  if (!grid_blocks) {
    int dev = 0, cus = 0, per_cu = 0;
    (void)hipGetDevice(&dev);
    (void)hipDeviceGetAttribute(&cus, hipDeviceAttributeMultiprocessorCount, dev);
    (void)hipOccupancyMaxActiveBlocksPerMultiprocessor(&per_cu, mega, NTH, 0);
    if (per_cu < 1) per_cu = 1;
    if (per_cu > 1) per_cu = 1;
    grid_blocks = cus * per_cu;
  }
  (void)hipMemsetAsync(p.bar, 0, XCD_BAR_WORDS * 4, stream);
  void* args[] = {&p};
  hipError_t e = hipLaunchCooperativeKernel((void*)mega, dim3(grid_blocks), dim3(NTH), args, 0, stream);
  if (e != hipSuccess) fprintf(stderr, "cooperative launch failed: %s (grid %d)\n", hipGetErrorString(e), grid_blocks);
}
```

```cpp
#include <hip/hip_runtime.h>
#include <hip/hip_cooperative_groups.h>
#include <stdint.h>
#include <stdio.h>
namespace cg = cooperative_groups;

#define DI __device__ __forceinline__
#define LAS __attribute__((address_space(3)))
typedef unsigned short u16;
typedef __attribute__((ext_vector_type(8))) short bf16x8;
typedef __attribute__((ext_vector_type(4))) short bf16x4;
typedef __attribute__((ext_vector_type(16))) float f32x16;
typedef __attribute__((ext_vector_type(4))) float f32x4;
typedef __attribute__((ext_vector_type(2))) float f32x2;
typedef __attribute__((ext_vector_type(4))) unsigned u32x4;
typedef __attribute__((ext_vector_type(2))) unsigned u32x2;
typedef __attribute__((ext_vector_type(2))) __bf16 bf2_t;

constexpr int TB = 16384;
constexpr int TBP = TB + 64;
constexpr int NW = 8288;
constexpr int NWP = 8320;
constexpr int LDT = 72;
constexpr int TILE_ELEMS = 128 * LDT;
constexpr int GEMM_SMEM = 4 * TILE_ELEMS * 2;
constexpr int SMEM_BYTES = 131072;
#ifndef PROBE
#define PROBE 0
#endif
constexpr int NTH = 512;
constexpr int HT = 128 * 64;
constexpr float LOG2E = 1.4426950408889634f;
constexpr float LN2 = 0.6931471805599453f;

struct Prm {
  const float *x_prompt, *x_sample, *c_prompt, *c_sample, *rel_bias, *ada_w, *ada_b, *norm1_g, *w_in,
      *qn_g, *kvn_g, *w_uq, *w_ukv, *ln_g, *ln_b, *sgu_w, *sgu_b, *p_a, *p_b, *p_c, *p_d, *w_o,
      *norm2_g, *w1, *w2, *final_g;
  float* out;
  u16 *WinT, *W1T, *W2T, *WoT, *PaT, *PbT, *PcT, *PdT, *WqT, *WkvT, *SgW, *M1a, *M1b, *M2;
  float2 *tw, *rope;
  float *biasT, *mod, *modpart;
  u16 *hbuf, *UT, *Gp, *bqkv, *ob, *cu, *cvT, *dcq, *dckv, *qc, *kc, *vT, *od, *zg;
  float *og, *lse;
  unsigned* bar;
};

DI unsigned pack2(float a, float b) { bf2_t v; v[0] = (__bf16)a; v[1] = (__bf16)b; return __builtin_bit_cast(unsigned, v); }
DI u16 f2bf(float a) { return __builtin_bit_cast(u16, (__bf16)a); }
DI float bf2f(u16 v) { return __uint_as_float(((unsigned)v) << 16); }
DI float bflo(unsigned w) { return __uint_as_float(w << 16); }
DI float bfhi(unsigned w) { return __uint_as_float(w & 0xffff0000u); }
DI void st4bf(u16* dst, float a, float b, float c, float d) { u32x2 v; v[0] = pack2(a, b); v[1] = pack2(c, d); *(u32x2*)dst = v; }
DI void st4bf_nt(u16* dst, float a, float b, float c, float d) { u32x2 v; v[0] = pack2(a, b); v[1] = pack2(c, d); __builtin_nontemporal_store(v, (u32x2*)dst); }
DI void st8bf(u16* dst, const f32x4& a, const f32x4& b) { u32x4 o; o[0] = pack2(a[0], a[1]); o[1] = pack2(a[2], a[3]); o[2] = pack2(b[0], b[1]); o[3] = pack2(b[2], b[3]); *(u32x4*)dst = o; }
DI int perm_m(int s) { return 16 * ((s >> 2) & 1) + 4 * (s >> 3) + (s & 3); }
DI int rowmap(int r, int lh) { return (r & 3) + 8 * (r >> 2) + 4 * lh; }
DI f32x16 mfma(bf16x8 a, bf16x8 b, f32x16 c) { return __builtin_amdgcn_mfma_f32_32x32x16_bf16(a, b, c, 0, 0, 0); }
DI u32x4 zero4() { u32x4 z; z[0] = 0; z[1] = 0; z[2] = 0; z[3] = 0; return z; }
DI f32x16 zero16() { f32x16 z; for (int i = 0; i < 16; ++i) z[i] = 0.f; return z; }
DI float ex2(float x) { return __builtin_amdgcn_exp2f(x); }
DI int tidx() { int t = threadIdx.x; asm volatile("" : "+v"(t)); return t; }


#define XB_TMO      128
#define XB_XCNT(j)  (256  + 64 * (j))
#define XB_XSUB(j)  (1280 + 64 * (j))
#define XB_XGEN(j)  (2304 + 64 * (j))
#define XB_TOP      3328
#define XB_TOPGEN   3392
#define XCD_BAR_WORDS 3456
#define XB_SPIN_CAP (1u << 18)
DI unsigned xb_ld(unsigned* p) { return __hip_atomic_load(p, __ATOMIC_RELAXED, __HIP_MEMORY_SCOPE_AGENT); }
DI unsigned xb_add(unsigned* p, unsigned v) { return __hip_atomic_fetch_add(p, v, __ATOMIC_RELAXED, __HIP_MEMORY_SCOPE_AGENT); }
DI unsigned xb_xcc_id() { return (unsigned)__builtin_amdgcn_s_getreg((3 << 11) | 20) & 0xFu; }
#define XB_SPIN(cond, bar) do { unsigned _sp = 0; while (cond) { __builtin_amdgcn_s_sleep(1); \
    if ((++_sp & 255u) == 0u) { if (xb_ld(&(bar)[XB_TMO])) break; if (_sp > XB_SPIN_CAP) { atomicAdd(&(bar)[XB_TMO], 1u); break; } } } } while (0)
struct XcdBarrier { unsigned* bar; unsigned x; volatile LAS unsigned* st; };
DI XcdBarrier xcd_barrier_post(unsigned* bar, volatile LAS unsigned* st) {
  XcdBarrier b; b.bar = bar; b.x = xb_xcc_id(); b.st = st;
  if (threadIdx.x == 0) (void)xb_add(&bar[XB_XCNT(b.x)], 1u);
  return b;
}
DI void xcd_barrier_complete(unsigned* bar, unsigned x, unsigned& nloc, unsigned& nx) {
  const unsigned G = gridDim.x * gridDim.y * gridDim.z;
  unsigned sum, cnt, mine, sp = 0u;
  for (;;) {
    sum = 0u; cnt = 0u; mine = 0u;
#pragma unroll
    for (unsigned j = 0; j < 16; ++j) { const unsigned c = xb_ld(&bar[XB_XCNT(j)]); sum += c; cnt += (c > 0u) ? 1u : 0u; mine = (j == x) ? c : mine; }
    if (sum == G) break;
    __builtin_amdgcn_s_sleep(1);
    if ((++sp & 255u) == 0u) { if (xb_ld(&bar[XB_TMO])) break; if (sp > XB_SPIN_CAP) { atomicAdd(&bar[XB_TMO], 1u); break; } }
  }
  nloc = mine > 0u ? mine : 1u; nx = cnt > 0u ? cnt : 1u;
}
DI void xcd_barrier(const XcdBarrier& b) {
  asm volatile("s_waitcnt vmcnt(0)" ::: "memory");
  __syncthreads();
  if (tidx() == 0) {
    unsigned* bar = b.bar;
    const unsigned bx = (unsigned)__builtin_amdgcn_readfirstlane((int)xb_xcc_id());
    __builtin_amdgcn_s_waitcnt(0);
    unsigned nloc = b.st[0], nx = b.st[1];
    if (nloc == 0u) { xcd_barrier_complete(bar, bx, nloc, nx); b.st[0] = nloc; b.st[1] = nx; }
    const unsigned old = xb_add(&bar[XB_XSUB(bx)], 1u);
    const unsigned gen = old / nloc;
    if (old + 1u == (gen + 1u) * nloc) {
      __builtin_amdgcn_fence(__ATOMIC_RELEASE, "agent");
      asm volatile("s_waitcnt vmcnt(0)" ::: "memory");
      const unsigned og = xb_add(&bar[XB_TOP], 1u);
      const unsigned tg = og / nx;
      if (og + 1u == (tg + 1u) * nx) xb_add(&bar[XB_TOPGEN], 1u);
      else XB_SPIN(xb_ld(&bar[XB_TOPGEN]) == tg, bar);
      __builtin_amdgcn_fence(__ATOMIC_ACQUIRE, "agent");
      xb_add(&bar[XB_XGEN(bx)], 1u);
      asm volatile("s_waitcnt vmcnt(0)" ::: "memory");
    } else {
      XB_SPIN(xb_ld(&bar[XB_XGEN(bx)]) == gen, bar);
      __builtin_amdgcn_fence(__ATOMIC_ACQUIRE, "agent");
      asm volatile("s_waitcnt vmcnt(0)" ::: "memory");
    }
  }
  __syncthreads();
}

#define TASK_LOOP(t, nt, base) for (int t = (int)((blockIdx.x + gridDim.x - ((unsigned)(base) % gridDim.x)) % gridDim.x); t < (nt); t += gridDim.x)

template <bool RFA, bool RFB, class LA, class LB, class EPI>
DI void gemm_tile(u16* smem, int nk, LA la, LB lb, EPI epi) {
  const int tid = tidx(), lane = tid & 63, wave = tid >> 6;
  const int wm = wave >> 2, wn = wave & 3, lr = lane & 31, lh = lane >> 5;
  u16* As = smem;
  u16* Bs = smem + 2 * TILE_ELEMS;
  f32x16 acc[2];
  acc[0] = zero16(); acc[1] = zero16();
  u32x4 ra[2], rb[2];
#define A_ROW(c) (RFA ? ((c) & 127) : ((c) >> 3))
#define A_KC(c) (RFA ? ((c) >> 7) : ((c) & 7))
#define B_ROW(c) (RFB ? ((c) & 127) : ((c) >> 3))
#define B_KC(c) (RFB ? ((c) >> 7) : ((c) & 7))
#pragma unroll
  for (int i = 0; i < 2; ++i) { const int c = tid + NTH * i; ra[i] = la(A_ROW(c), A_KC(c) * 8); rb[i] = lb(B_ROW(c), B_KC(c) * 8); }
#pragma unroll
  for (int i = 0; i < 2; ++i) {
    const int c = tid + NTH * i;
    *(u32x4*)(As + A_ROW(c) * LDT + A_KC(c) * 8) = ra[i];
    *(u32x4*)(Bs + B_ROW(c) * LDT + B_KC(c) * 8) = rb[i];
  }
  __syncthreads();
  for (int kt = 0; kt < nk; ++kt) {
    const int buf = kt & 1;
    if (kt + 1 < nk) {
      const int k0 = (kt + 1) * 64;
#pragma unroll
      for (int i = 0; i < 2; ++i) { const int c = tid + NTH * i; ra[i] = la(A_ROW(c), k0 + A_KC(c) * 8); rb[i] = lb(B_ROW(c), k0 + B_KC(c) * 8); }
    }
    const u16* Ab = As + buf * TILE_ELEMS + (wm * 64 + lr) * LDT + lh * 8;
    const u16* Bb = Bs + buf * TILE_ELEMS + (wn * 32 + lr) * LDT + lh * 8;
#pragma unroll
    for (int ks = 0; ks < 4; ++ks) {
      const bf16x8 a0 = *(const bf16x8*)(Ab + ks * 16);
      const bf16x8 a1 = *(const bf16x8*)(Ab + 32 * LDT + ks * 16);
      const bf16x8 b = *(const bf16x8*)(Bb + ks * 16);
      acc[0] = mfma(a0, b, acc[0]);
      acc[1] = mfma(a1, b, acc[1]);
    }
    if (kt + 1 < nk) {
      u16* Aw = As + (buf ^ 1) * TILE_ELEMS;
      u16* Bw = Bs + (buf ^ 1) * TILE_ELEMS;
#pragma unroll
      for (int i = 0; i < 2; ++i) {
        const int c = tid + NTH * i;
        *(u32x4*)(Aw + A_ROW(c) * LDT + A_KC(c) * 8) = ra[i];
        *(u32x4*)(Bw + B_ROW(c) * LDT + B_KC(c) * 8) = rb[i];
      }
    }
    __syncthreads();
  }
  epi(acc, wm, wn, lane);
}

template <bool RFA, bool RFB, class LA, class LB, class EPI>
DI void gemm_tile2s(u16* smem, int nk, LA la, LB lb, EPI epi) {
  const int tid = tidx(), lane = tid & 63, wave = tid >> 6;
  const int wm = wave >> 2, wn = wave & 3, lr = lane & 31, lh = lane >> 5;
  u16* As = smem;
  u16* Bs = smem + 2 * TILE_ELEMS;
  f32x16 acc[2];
  acc[0] = zero16(); acc[1] = zero16();
  u32x4 ra0[2], rb0[2], ra1[2], rb1[2];
  auto ld = [&](u32x4 (&ra)[2], u32x4 (&rb)[2], int kt) __attribute__((always_inline)) {
    const int k0 = kt * 64;
#pragma unroll
    for (int i = 0; i < 2; ++i) { const int c = tid + NTH * i; ra[i] = la(A_ROW(c), k0 + A_KC(c) * 8); rb[i] = lb(B_ROW(c), k0 + B_KC(c) * 8); }
  };
  auto stl = [&](u32x4 (&ra)[2], u32x4 (&rb)[2], int buf) __attribute__((always_inline)) {
#pragma unroll
    for (int i = 0; i < 2; ++i) {
      const int c = tid + NTH * i;
      *(u32x4*)(As + buf * TILE_ELEMS + A_ROW(c) * LDT + A_KC(c) * 8) = ra[i];
      *(u32x4*)(Bs + buf * TILE_ELEMS + B_ROW(c) * LDT + B_KC(c) * 8) = rb[i];
    }
  };
  auto compute = [&](int buf) __attribute__((always_inline)) {
    const u16* Ab = As + buf * TILE_ELEMS + (wm * 64 + lr) * LDT + lh * 8;
    const u16* Bb = Bs + buf * TILE_ELEMS + (wn * 32 + lr) * LDT + lh * 8;
#pragma unroll
    for (int ks = 0; ks < 4; ++ks) {
      const bf16x8 a0 = *(const bf16x8*)(Ab + ks * 16);
      const bf16x8 a1 = *(const bf16x8*)(Ab + 32 * LDT + ks * 16);
      const bf16x8 b = *(const bf16x8*)(Bb + ks * 16);
      acc[0] = mfma(a0, b, acc[0]);
      acc[1] = mfma(a1, b, acc[1]);
    }
  };
  ld(ra0, rb0, 0);
  if (nk > 1) ld(ra1, rb1, 1);
  stl(ra0, rb0, 0);
  if (nk > 2) ld(ra0, rb0, 2);
  __syncthreads();
#pragma unroll 1
  for (int kt = 0; kt < nk; kt += 2) {
    compute(0);
    if (kt + 1 < nk) { stl(ra1, rb1, 1); if (kt + 3 < nk) ld(ra1, rb1, kt + 3); }
    __syncthreads();
    if (kt + 1 < nk) {
      compute(1);
      if (kt + 2 < nk) { stl(ra0, rb0, 0); if (kt + 4 < nk) ld(ra0, rb0, kt + 4); }
      __syncthreads();
    }
  }
  epi(acc, wm, wn, lane);
}

DI void stage_rc(int b, int& R, int& C) { int st = b / 1024, sb = b % 1024, swz = sb ^ (((sb >> 9) & 1) << 5); R = (st >> 1) * 16 + swz / 64; C = (st & 1) * 32 + (swz % 64) / 2; }

DI int perm32(int rho) { const int n = rho >> 4, i = rho & 15; return 8 * (i >> 2) + 4 * n + (i & 3); }

template <bool PERM, class EPI>
DI void gemm256(LAS u16* shm, const u16* __restrict__ A, const u16* __restrict__ Bt, int K, int brow, int bcol, bool pre, bool has_next, int nbrow, int nbcol, EPI epi) {
#define SA(b, h) (shm + ((b) * 2 + (h)) * HT)
#define SB(b, h) (shm + (4 + (b) * 2 + (h)) * HT)
  const int tid = tidx();
  const int wid = __builtin_amdgcn_readfirstlane(tid >> 6), lane = tid & 63, wr = wid >> 2, wc = wid & 3, fr = lane & 15, fq = lane >> 4;
  int r0, c0, r1, c1;
  stage_rc(tid * 16, r0, c0);
  stage_rc(tid * 16 + 8192, r1, c1);
  const int ra0 = PERM ? ((r0 & ~31) + perm32(r0 & 31)) : r0, ra1 = PERM ? ((r1 & ~31) + perm32(r1 & 31)) : r1;
  const unsigned so0 = (unsigned)(ra0 * K + c0) * 2u, so1 = (unsigned)(ra1 * K + c1) * 2u;
  const unsigned sb0 = (unsigned)(r0 * K + c0) * 2u, sb1 = (unsigned)(r1 * K + c1) * 2u;
  const unsigned ldsw = (unsigned)wid * 1024u;
  const int lb = ((fr * 64 + fq * 16) ^ ((fr >> 3) << 5));
#define STAGE_(P, BASE, br, kt, O0, O1) do { const char* _g = (const char*)((BASE) + (size_t)(br) * K + (kt) * 64); \
    __builtin_amdgcn_global_load_lds((const unsigned*)(_g + O0), (LAS unsigned*)((LAS char*)(P) + ldsw), 16, 0, 0); \
    __builtin_amdgcn_global_load_lds((const unsigned*)(_g + O1), (LAS unsigned*)((LAS char*)(P) + ldsw + 8192), 16, 0, 0); } while (0)
#define STAGEA(P, br, kt) STAGE_(P, A, br, kt, so0, so1)
#define STAGEB(P, br, kt) STAGE_(P, Bt, br, kt, sb0, sb1)
#define LDA(dst, b, h) _Pragma("unroll") for (int m = 0; m < 4; ++m) _Pragma("unroll") for (int k = 0; k < 2; ++k) \
    dst[m][k] = *(const LAS bf16x8*)((const LAS char*)SA(b, h) + ((wr * 4 + m) * 2 + k) * 1024 + lb)
#define LDB(dst, b, h) _Pragma("unroll") for (int n = 0; n < 2; ++n) _Pragma("unroll") for (int k = 0; k < 2; ++k) \
    dst[n][k] = *(const LAS bf16x8*)((const LAS char*)SB(b, h) + ((wc * 2 + n) * 2 + k) * 1024 + lb)
#define MMA(ai, bj, At_, Bt_) do { __builtin_amdgcn_s_setprio(1); \
    _Pragma("unroll") for (int m = 0; m < 4; ++m) _Pragma("unroll") for (int n = 0; n < 2; ++n) _Pragma("unroll") for (int k = 0; k < 2; ++k) \
      acc[ai][bj][m][n] = __builtin_amdgcn_mfma_f32_16x16x32_bf16(At_[m][k], Bt_[n][k], acc[ai][bj][m][n], 0, 0, 0); \
    __builtin_amdgcn_s_setprio(0); } while (0)
#define WAIT_V(n) asm volatile("s_waitcnt vmcnt(" #n ")" ::: "memory")
#define WAIT_L(n) asm volatile("s_waitcnt lgkmcnt(" #n ")" ::: "memory")
#define BAR __builtin_amdgcn_s_barrier()
#define SCHED __builtin_amdgcn_sched_barrier(0)
  f32x4 acc[2][2][4][2];
#pragma unroll
  for (int a = 0; a < 2; ++a)
#pragma unroll
    for (int b = 0; b < 2; ++b)
#pragma unroll
      for (int m = 0; m < 4; ++m)
#pragma unroll
        for (int n = 0; n < 2; ++n) { acc[a][b][m][n][0] = 0.f; acc[a][b][m][n][1] = 0.f; acc[a][b][m][n][2] = 0.f; acc[a][b][m][n][3] = 0.f; }
  bf16x8 At[4][2], B0[2][2], B1[2][2];
  const int nt = K / 64;
  if (!pre) {
    STAGEB(SB(0, 0), bcol, 0); STAGEA(SA(0, 0), brow, 0);
    STAGEB(SB(0, 1), bcol + 128, 0); STAGEA(SA(0, 1), brow + 128, 0);
  }
  if (wr == 1) BAR;
  WAIT_V(4); BAR;
  STAGEB(SB(1, 0), bcol, 1); STAGEA(SA(1, 0), brow, 1); STAGEB(SB(1, 1), bcol + 128, 1);
  WAIT_V(6); BAR;
  for (int t = 0; t < nt - 2; t += 2) {
    LDB(B0, 0, 0); SCHED; LDA(At, 0, 0); STAGEA(SA(1, 1), brow + 128, t + 1);
    WAIT_L(8); BAR; WAIT_L(0); MMA(0, 0, At, B0); BAR; SCHED;
    LDB(B1, 0, 1); STAGEB(SB(0, 0), bcol, t + 2);
    BAR; WAIT_L(0); MMA(0, 1, At, B1); BAR;
    LDA(At, 0, 1); STAGEA(SA(0, 0), brow, t + 2);
    BAR; WAIT_L(0); MMA(1, 0, At, B0); BAR; SCHED;
    STAGEB(SB(0, 1), bcol + 128, t + 2);
    WAIT_V(6); BAR; MMA(1, 1, At, B1); BAR;
    LDB(B0, 1, 0); SCHED; LDA(At, 1, 0); STAGEA(SA(0, 1), brow + 128, t + 2);
    WAIT_L(8); BAR; WAIT_L(0); MMA(0, 0, At, B0); BAR; SCHED;
    LDB(B1, 1, 1); STAGEB(SB(1, 0), bcol, t + 3);
    BAR; WAIT_L(0); MMA(0, 1, At, B1); BAR;
    LDA(At, 1, 1); STAGEA(SA(1, 0), brow, t + 3);
    BAR; WAIT_L(0); MMA(1, 0, At, B0); BAR; SCHED;
    STAGEB(SB(1, 1), bcol + 128, t + 3);
    WAIT_V(6); BAR; MMA(1, 1, At, B1); BAR;
  }
  { LDB(B0, 0, 0); LDA(At, 0, 0); STAGEA(SA(1, 1), brow + 128, nt - 1);
    BAR; WAIT_L(0); MMA(0, 0, At, B0); BAR;
    LDB(B1, 0, 1); BAR; WAIT_L(0); MMA(0, 1, At, B1); BAR;
    LDA(At, 0, 1); WAIT_V(4); BAR; WAIT_L(0); MMA(1, 0, At, B0); MMA(1, 1, At, B1); BAR; }
  { LDB(B0, 1, 0); LDA(At, 1, 0); WAIT_V(2); BAR; WAIT_L(0); MMA(0, 0, At, B0); BAR;
    LDB(B1, 1, 1); WAIT_V(0); BAR; WAIT_L(0); MMA(0, 1, At, B1); BAR;
    LDA(At, 1, 1); BAR; WAIT_L(0); MMA(1, 0, At, B0); MMA(1, 1, At, B1); BAR; }
  if (wr == 0) BAR;
  if (has_next) {
    STAGEB(SB(0, 0), nbcol, 0); STAGEA(SA(0, 0), nbrow, 0);
    STAGEB(SB(0, 1), nbcol + 128, 0); STAGEA(SA(0, 1), nbrow + 128, 0);
  }
  epi(acc, wr, wc, fr, fq);
  __syncthreads();
}

DI void map256(int t, int nN, int& tn, int& tm) {
  const int p = (t >> 8) * 8 + (t & 7), i = (t >> 3) & 31, pr = nN >> 2;
  const int pm = p / pr;
  tn = ((p + pm) % pr) * 4 + (i & 3);
  tm = pm * 8 + (i >> 2);
}

DI int condrow(int sb, int tok) { return sb == 0 ? 0 : 1 + (sb - 1) * 8 + (tok >> 11); }

DI void convT(float* tile, const float* src, int lds_, int K, int N, u16* dst, int ldd, const float* ksc, int& base) {
  const int tid = tidx();
  const int ntn = (N + 63) >> 6, nt = (K >> 6) * ntn;
  const int kk = tid >> 4, n4 = (tid & 15) * 4;
  float4 cur[2], nxt[2];
  auto ld = [&](float4 (&v)[2], int t) __attribute__((always_inline)) {
    const int tn = t % ntn, tk = t / ntn, k0 = tk * 64, n0 = tn * 64;
#pragma unroll
    for (int e = 0; e < 2; ++e) {
      v[e] = make_float4(0.f, 0.f, 0.f, 0.f);
      if (n0 + n4 < N) v[e] = *(const float4*)(src + (size_t)(k0 + kk + 32 * e) * lds_ + n0 + n4);
    }
  };
  int t = (int)((blockIdx.x + gridDim.x - ((unsigned)base % gridDim.x)) % gridDim.x);
  if (t < nt) ld(cur, t);
  for (; t < nt; t += gridDim.x) {
    const int tnx = t + (int)gridDim.x;
    if (tnx < nt) ld(nxt, tnx);
    const int tn = t % ntn, tk = t / ntn, k0 = tk * 64, n0 = tn * 64;
#pragma unroll
    for (int e = 0; e < 2; ++e) {
      float4 v = cur[e];
      if (ksc) { const float sc = ksc[k0 + kk + 32 * e]; v.x *= sc; v.y *= sc; v.z *= sc; v.w *= sc; }
      float* tp = tile + (kk + 32 * e) * 65 + n4;
      tp[0] = v.x; tp[1] = v.y; tp[2] = v.z; tp[3] = v.w;
    }
    __syncthreads();
#pragma unroll 4
    for (int e = 0; e < 4; ++e) {
      const int idx = tid + NTH * e, nn = idx >> 5, kp = idx & 31;
      if (n0 + nn < N)
        *(unsigned*)(dst + (size_t)(n0 + nn) * ldd + k0 + 2 * kp) = pack2(tile[(2 * kp) * 65 + nn], tile[(2 * kp + 1) * 65 + nn]);
    }
    __syncthreads();
    cur[0] = nxt[0]; cur[1] = nxt[1];
  }
  base += nt;
}

DI void prologue_a(const Prm& p, unsigned char* smem_raw, int& base) {
  float* smf = (float*)smem_raw;
  const int tid = tidx();
  const int gtid = blockIdx.x * NTH + tid, gn = gridDim.x * NTH;
  for (int l = 0; l < 4; ++l) {
    convT(smf, p.w_in + (size_t)l * 1024 * 7520 + 768, 7520, 1024, 6752, p.WinT + ((size_t)l * NWP + 1536) * 1024, 1024, nullptr, base);
    convT(smf, p.w1 + (size_t)l * 1024 * 4096, 4096, 1024, 4096, p.W1T + (size_t)l * 4096 * 1024, 1024, nullptr, base);
    convT(smf, p.w2 + (size_t)l * 4096 * 1024, 1024, 4096, 1024, p.W2T + (size_t)l * 1024 * 4096, 4096, nullptr, base);
    convT(smf, p.w_o + (size_t)l * 1024 * 1024, 1024, 1024, 1024, p.WoT + (size_t)l * 1024 * 1024, 1024, nullptr, base);
    convT(smf, p.p_a + (size_t)l * 768 * 1024, 1024, 768, 1024, p.PaT + (size_t)l * 1024 * 768, 768, nullptr, base);
    convT(smf, p.p_b + (size_t)l * 128 * 1024, 1024, 128, 1024, p.PbT + (size_t)l * 1024 * 128, 128, nullptr, base);
    convT(smf, p.p_c + (size_t)l * 384 * 1024, 1024, 384, 1024, p.PcT + (size_t)l * 1024 * 384, 384, nullptr, base);
    convT(smf, p.p_d + (size_t)l * 256 * 1024, 1024, 256, 1024, p.PdT + (size_t)l * 1024 * 256, 256, nullptr, base);
    convT(smf, p.w_uq + (size_t)l * 384 * 384, 384, 384, 384, p.WqT + (size_t)l * 384 * 384, 384, p.qn_g + l * 384, base);
    convT(smf, p.w_ukv + (size_t)l * 320 * 512, 512, 320, 512, p.WkvT + (size_t)l * 512 * 320, 320, p.kvn_g + l * 320, base);
  }
  {
    float* tab = (float*)(smem_raw + GEMM_SMEM + 1024);
    if (tid < 192) {
      float sn, cs;
      sincospif(2.f * (float)tid / 192.f, &sn, &cs);
      tab[tid] = cs; tab[192 + tid] = sn;
    }
    __syncthreads();
    u16* smem = (u16*)smem_raw;
    TASK_LOOP(t, 384, base) {
      const int kt = t & 7, rt = (t >> 3) % 3, g = (t / 24) & 3, l = t / 96;
      auto la = [&](int row, int k) __attribute__((always_inline)) {
        const int rr = rt * 128 + row, part = rr >= 192 ? 1 : 0, j = rr - part * 192;
        const float* tp = tab + part * 192;
        const float sg = part ? -1.f : 1.f;
        int m = (j * k) % 192;
        u32x4 o;
#pragma unroll
        for (int jj = 0; jj < 4; ++jj) {
          const float v0 = tp[m] * sg; m += j; if (m >= 192) m -= 192;
          const float v1 = tp[m] * sg; m += j; if (m >= 192) m -= 192;
          o[jj] = pack2(v0, v1);
        }
        return o;
      };
      auto lb = [&](int row, int k) __attribute__((always_inline)) {
        const float* src = p.w_in + ((size_t)l * 1024 + kt * 128 + row) * 7520 + g * 192 + k;
        const float4 a = *(const float4*)src, b = *(const float4*)(src + 4);
        u32x4 o;
        o[0] = pack2(a.x, a.y); o[1] = pack2(a.z, a.w); o[2] = pack2(b.x, b.y); o[3] = pack2(b.z, b.w);
        return o;
      };
      auto epi = [&](f32x16 (&acc)[2], int wm, int wn, int lane) __attribute__((always_inline)) {
        const int lr = lane & 31, lh = lane >> 5;
        const int kcol = kt * 128 + wn * 32 + lr;
#pragma unroll
        for (int i = 0; i < 2; ++i)
#pragma unroll
          for (int r = 0; r < 16; ++r) {
            const int rr = rt * 128 + wm * 64 + i * 32 + rowmap(r, lh), part = rr >= 192 ? 1 : 0, j = rr - part * 192;
            p.WinT[((size_t)l * NWP + part * 768 + g * 192 + j) * 1024 + kcol] = f2bf(acc[i][r]);
          }
      };
      gemm_tile<false, false>(smem, 3, la, lb, epi);
    }
    base += 384;
  }
  {
    float* sil = smf;
    TASK_LOOP(t, 384, base) {
      const int kc = t & 7, cb = (t >> 3) % 12, l = t / 96, k0 = kc * 128;
      for (int idx = tid; idx < 17 * 128; idx += NTH) {
        const int r = idx >> 7, kk = idx & 127;
        const float c = r == 0 ? p.c_prompt[k0 + kk] : p.c_sample[(r - 1) * 1024 + k0 + kk];
        sil[idx] = c / (1.f + __expf(-c));
      }
      __syncthreads();
      const int n = cb * 512 + tid;
      float acc[17];
#pragma unroll
      for (int r = 0; r < 17; ++r) acc[r] = 0.f;
      const float* wp = p.ada_w + ((size_t)l * 1024 + k0) * 6144 + n;
#pragma unroll 1
      for (int kb = 0; kb < 128; kb += 32) {
        float w[32];
#pragma unroll
        for (int i = 0; i < 32; ++i) w[i] = wp[(size_t)(kb + i) * 6144];
#pragma unroll
        for (int i = 0; i < 32; i += 4)
#pragma unroll
          for (int r = 0; r < 17; ++r) {
            const float4 sv = *(const float4*)(sil + r * 128 + kb + i);
            acc[r] += sv.x * w[i] + sv.y * w[i + 1] + sv.z * w[i + 2] + sv.w * w[i + 3];
          }
      }
#pragma unroll
      for (int r = 0; r < 17; ++r) p.modpart[((size_t)(kc * 4 + l) * 17 + r) * 6144 + n] = acc[r];
      __syncthreads();
    }
    base += 384;
  }
  for (int idx = gtid; idx < 4 * 32 * 1024; idx += gn) {
    const int l = idx >> 15, rem = idx & 32767;
    p.WinT[((size_t)l * NWP + NW) * 1024 + rem] = 0;
  }
  for (int idx = gtid; idx < 256 * 256; idx += gn) {
    const int row = idx >> 8, kk = idx & 255;
    const int po = row >> 7, k1 = row & 127, pi = kk >> 7, s1 = kk & 127;
    float s, c;
    sincospif(2.f * (float)((k1 * s1) & 127) / 128.f, &s, &c);
    const float v = (po == pi) ? c : (po == 0 ? s : -s);
    p.M1a[idx] = f2bf(v);
  }
  for (int idx = gtid; idx < 32 * 64; idx += gn) {
    const int row = idx >> 6, kk = idx & 63;
    const int po = row >> 4, k1 = row & 15, pi = (kk >> 4) & 1, s1 = kk & 15;
    float s, c;
    sincospif(2.f * (float)((k1 * s1) & 15) / 16.f, &s, &c);
    float v = (po == pi) ? c : (po == 0 ? s : -s);
    if (kk >= 32) v = 0.f;
    p.M1b[idx] = f2bf(v);
  }
  for (int idx = gtid; idx < 128 * 256; idx += gn) {
    const int k2 = idx >> 8, kk = idx & 255, part = kk >> 7, s2 = kk & 127;
    float s, c;
    sincospif(2.f * (float)((k2 * s2) & 127) / 128.f, &s, &c);
    p.M2[idx] = f2bf(part ? s : c);
  }
  for (int idx = gtid; idx < 16384; idx += gn) {
    float s, c;
    sincospif(2.f * (float)idx / 16384.f, &s, &c);
    p.tw[idx] = make_float2(c, s);
  }
  for (int idx = gtid; idx < 16384 * 16; idx += gn) {
    const int pos = idx >> 4, i = idx & 15;
    const float inv = (float)pow(10000.0, -(double)i / 16.0);
    const float ang = (float)pos * inv;
    double rev = (double)ang * 0.15915494309189535;
    rev -= rint(rev);
    float s, c;
    sincospif((float)(2.0 * rev), &s, &c);
    p.rope[idx] = make_float2(c, s);
  }
  for (int idx = gtid; idx < 6 * 129; idx += gn) {
    const int hd = idx / 129, rel = idx - hd * 129 - 64;
    const int dil = 1 << (2 * (hd >> 1));
    const int rd = rel * dil, n = rd < 0 ? -rd : rd;
    int b;
    if (n < 8) b = n;
    else if (n < 15) b = 8; else if (n < 27) b = 9; else if (n < 50) b = 10; else if (n < 91) b = 11;
    else if (n < 166) b = 12; else if (n < 305) b = 13; else if (n < 559) b = 14; else b = 15;
    if (rd > 0) b += 16;
    p.biasT[idx] = p.rel_bias[b * 6 + hd];
  }
  for (int idx = gtid; idx < 4 * 4 * 128 * 128; idx += gn) p.SgW[idx] = f2bf(p.sgu_w[idx]);
}

DI void prologue_b(const Prm& p) {
  const int gtid = blockIdx.x * NTH + tidx(), gn = gridDim.x * NTH;
  for (int idx = gtid; idx < 4 * 17 * 6144; idx += gn) {
    const int l = idx / (17 * 6144), n = idx % 6144;
    float s = p.ada_b[l * 6144 + n];
#pragma unroll
    for (int kc = 0; kc < 8; ++kc) s += p.modpart[(size_t)kc * 4 * 17 * 6144 + idx];
    p.mod[idx] = s;
  }
}

DI void phase_norm(const Prm& p, const float* xsrc, const float* g, const float* modl, int shoff, int scoff, int sb) {
  const int tid = tidx(), lane = tid & 63;
  const int gw = blockIdx.x * 8 + (tid >> 6), nw = gridDim.x * 8;
  for (int row = gw; row < TB; row += nw) {
    const int cond = condrow(sb, row);
    const float* xr = xsrc + (size_t)row * 1024;
    float4 v[4];
    float ss = 0.f;
#pragma unroll
    for (int i = 0; i < 4; ++i) {
      v[i] = *(const float4*)(xr + i * 256 + lane * 4);
      ss += v[i].x * v[i].x + v[i].y * v[i].y + v[i].z * v[i].z + v[i].w * v[i].w;
    }
#pragma unroll
    for (int off = 32; off >= 1; off >>= 1) ss += __shfl_xor(ss, off);
    const float rstd = rsqrtf(ss * (1.f / 1024.f) + 1e-6f);
    const float* sc = modl + cond * 6144 + scoff;
    const float* sh = modl + cond * 6144 + shoff;
#pragma unroll
    for (int i = 0; i < 4; ++i) {
      const int col = i * 256 + lane * 4;
      const float4 gg = *(const float4*)(g + col), s4 = *(const float4*)(sc + col), h4 = *(const float4*)(sh + col);
      st4bf(p.hbuf + (size_t)row * 1024 + col,
            v[i].x * rstd * gg.x * (1.f + s4.x) + h4.x, v[i].y * rstd * gg.y * (1.f + s4.y) + h4.y,
            v[i].z * rstd * gg.z * (1.f + s4.z) + h4.z, v[i].w * rstd * gg.w * (1.f + s4.w) + h4.w);
    }
  }
}

DI float sigm(float x) { return __builtin_amdgcn_rcpf(1.f + __expf(-x)); }

DI void phase_inproj(const Prm& p, unsigned char* smem_raw, int l, int S, int& base) {
  const u16* W = p.WinT + (size_t)l * NWP * 1024;
  LAS u16* shm = (LAS u16*)smem_raw;
  bool pre = false;
  TASK_LOOP(t, 32 * 64, base) {
    int tn, tm;
    map256(t, 32, tn, tm);
    const int brow = tn * 256, bcol = tm * 256;
    const int tnx = t + (int)gridDim.x;
    const bool has_next = tnx < (32 * 64);
    int tn2 = 0, tm2 = 0;
    if (has_next) map256(tnx, 32, tn2, tm2);
    const int nbrow = tn2 * 256, nbcol = tm2 * 256;
    const bool hn = has_next && ((tn2 != 16) == (tn != 16));
    auto epi = [&](f32x4 (&acc)[2][2][4][2], int wr, int wc, int fr, int fq) __attribute__((always_inline)) {
#pragma unroll
      for (int ai = 0; ai < 2; ++ai)
#pragma unroll
        for (int m = 0; m < 4; ++m) {
          const int nb = brow + ai * 128 + wr * 64 + m * 16;
#pragma unroll
          for (int bj = 0; bj < 2; ++bj)
#pragma unroll
            for (int n = 0; n < 2; ++n) {
              const int tok = bcol + bj * 128 + wc * 32 + n * 16 + fr;
              const f32x4 v = acc[ai][bj][m][n];
              const int nn = nb + fq * 4;
              if (nb < 1536) {
#pragma unroll
                for (int j = 0; j < 4; ++j) p.UT[(size_t)(nn + j) * TBP + tok] = f2bf(v[j]);
              } else if (nb < 2688) {
                st4bf(p.bqkv + (size_t)tok * 1152 + (nn - 1536), v[0], v[1], v[2], v[3]);
              } else if (nb < 3072) {
                st4bf(p.cu + (size_t)tok * 384 + (nn - 2688), v[0], v[1], v[2], v[3]);
              } else if (nb < 3456) {
#pragma unroll
                for (int j = 0; j < 4; ++j) p.cvT[(size_t)(nn - 3072 + j) * TBP + tok] = f2bf(v[j]);
              } else if (nb < 3840) {
                st4bf(p.dcq + (size_t)tok * 384 + (nn - 3456), v[0], v[1], v[2], v[3]);
              } else if (nb < 4160) {
                st4bf(p.dckv + (size_t)tok * 320 + (nn - 3840), v[0], v[1], v[2], v[3]);
              } else if (nb < 4192) {
                if (nb == 4160) {
                  const f32x4 v2 = acc[ai][bj][(m + 1) & 3][n];
                  const int pos = tok & (S - 1);
#pragma unroll
                  for (int j = 0; j < 4; ++j) {
                    const int ii = fq * 4 + j;
                    const float2 cs = p.rope[pos * 16 + ii];
                    const u16 o1 = f2bf(v[j] * cs.x - v2[j] * cs.y), o2 = f2bf(v[j] * cs.y + v2[j] * cs.x);
#pragma unroll
                    for (int hh = 0; hh < 4; ++hh) {
                      p.kc[(size_t)tok * 384 + hh * 96 + 64 + ii] = o1;
                      p.kc[(size_t)tok * 384 + hh * 96 + 80 + ii] = o2;
                    }
                  }
                }
              } else {
                st4bf_nt(p.zg + (size_t)tok * 4096 + (nn - 4192), sigm(v[0]), sigm(v[1]), sigm(v[2]), sigm(v[3]));
              }
            }
          __builtin_amdgcn_sched_barrier(0);
        }
    };
    if (tn != 16) {
      auto epi_p = [&](f32x4 (&acc)[2][2][4][2], int wr, int wc, int fr, int fq) __attribute__((always_inline)) {
#pragma unroll
        for (int ai = 0; ai < 2; ++ai)
#pragma unroll
          for (int mp = 0; mp < 2; ++mp) {
            const int nb = brow + ai * 128 + wr * 64 + mp * 32;
            const int nn = nb + fq * 8;
#pragma unroll
            for (int bj = 0; bj < 2; ++bj)
#pragma unroll
              for (int n = 0; n < 2; ++n) {
                const int tok = bcol + bj * 128 + wc * 32 + n * 16 + fr;
                const f32x4 v = acc[ai][bj][2 * mp][n], w = acc[ai][bj][2 * mp + 1][n];
                if (nb < 1536) {
#pragma unroll
                  for (int j = 0; j < 4; ++j) { p.UT[(size_t)(nn + j) * TBP + tok] = f2bf(v[j]); p.UT[(size_t)(nn + 4 + j) * TBP + tok] = f2bf(w[j]); }
                } else if (nb < 2688) {
                  st8bf(p.bqkv + (size_t)tok * 1152 + (nn - 1536), v, w);
                } else if (nb < 3072) {
                  st8bf(p.cu + (size_t)tok * 384 + (nn - 2688), v, w);
                } else if (nb < 3456) {
#pragma unroll
                  for (int j = 0; j < 4; ++j) { p.cvT[(size_t)(nn - 3072 + j) * TBP + tok] = f2bf(v[j]); p.cvT[(size_t)(nn - 3072 + 4 + j) * TBP + tok] = f2bf(w[j]); }
                } else if (nb < 3840) {
                  st8bf(p.dcq + (size_t)tok * 384 + (nn - 3456), v, w);
                } else if (nb < 4160) {
                  st8bf(p.dckv + (size_t)tok * 320 + (nn - 3840), v, w);
                } else {
                  u32x4 o;
                  o[0] = pack2(sigm(v[0]), sigm(v[1])); o[1] = pack2(sigm(v[2]), sigm(v[3]));
                  o[2] = pack2(sigm(w[0]), sigm(w[1])); o[3] = pack2(sigm(w[2]), sigm(w[3]));
                  __builtin_nontemporal_store(o, (u32x4*)(p.zg + (size_t)tok * 4096 + (nn - 4192)));
                }
              }
            __builtin_amdgcn_sched_barrier(0);
          }
      };
      gemm256<true>(shm, W, p.hbuf, 1024, brow, bcol, pre, hn, nbrow, nbcol, epi_p);
    } else {
      gemm256<false>(shm, W, p.hbuf, 1024, brow, bcol, pre, hn, nbrow, nbcol, epi);
    }
    pre = hn;
  }
  base += 32 * 64;
}

DI void phase_inproj_tail(const Prm& p, unsigned char* smem_raw, int l, int& base) {
  const u16* W = p.WinT + (size_t)l * NWP * 1024;
  u16* smem = (u16*)smem_raw;
  TASK_LOOP(t, 128, base) {
    const int n0 = 8192, m0 = t * 128;
    auto la = [&](int row, int k) __attribute__((always_inline)) { return *(const u32x4*)(W + (size_t)(n0 + row) * 1024 + k); };
    auto lb = [&](int row, int k) __attribute__((always_inline)) { return *(const u32x4*)(p.hbuf + (size_t)(m0 + row) * 1024 + k); };
    auto epi = [&](f32x16 (&acc)[2], int wm, int wn, int lane) __attribute__((always_inline)) {
      const int lr = lane & 31, lh = lane >> 5;
      const int tok = m0 + wn * 32 + lr;
#pragma unroll
      for (int i = 0; i < 2; ++i) {
        const int nb = n0 + wm * 64 + i * 32;
        if (nb >= NW) continue;
#pragma unroll
        for (int q = 0; q < 4; ++q)
          st4bf(p.zg + (size_t)tok * 4096 + (nb - 4192) + 8 * q + 4 * lh, sigm(acc[i][4 * q]), sigm(acc[i][4 * q + 1]), sigm(acc[i][4 * q + 2]),
                sigm(acc[i][4 * q + 3]));
      }
    };
    gemm_tile2s<false, false>(smem, 16, la, lb, epi);
  }
  base += 128;
}


DI void phase_inproj_probe(const Prm& p, unsigned char* smem_raw, int l, int& base) {
  const u16* W = p.WinT + (size_t)l * NWP * 1024;
  LAS u16* shm = (LAS u16*)smem_raw;
  bool pre = false;
  TASK_LOOP(t, 32 * 64, base) {
    int tn, tm;
    map256(t, 32, tn, tm);
    const int brow = tn * 256, bcol = tm * 256;
    const int tnx = t + (int)gridDim.x;
    const bool has_next = tnx < (32 * 64);
    int tn2 = 0, tm2 = 0;
    if (has_next) map256(tnx, 32, tn2, tm2);
    const int nbrow = tn2 * 256, nbcol = tm2 * 256;
    auto epi = [&](f32x4 (&acc)[2][2][4][2], int wr, int wc, int fr, int fq) __attribute__((always_inline)) {
#pragma unroll
      for (int bj = 0; bj < 2; ++bj)
#pragma unroll
        for (int n = 0; n < 2; ++n) {
          const int tok = bcol + bj * 128 + wc * 32 + n * 16 + fr;
#pragma unroll
          for (int ai = 0; ai < 2; ++ai)
#pragma unroll
            for (int m = 0; m < 4; ++m) {
              const int nn = ((brow + ai * 128 + wr * 64 + m * 16) & 1023) + fq * 4;
              const f32x4 v = acc[ai][bj][m][n];
              st4bf(p.Gp + (size_t)tok * 1024 + nn, v[0], v[1], v[2], v[3]);
            }
        }
    };
    gemm256<false>(shm, W, p.hbuf, 1024, brow, bcol, pre, has_next, nbrow, nbcol, epi);
    pre = has_next;
  }
  base += 32 * 64;
}

DI void phase_fft1(const Prm& p, u16* smem, int S, int nseq, int N1, int lgN1, int& base) {
  const int nkt = N1 == 128 ? 2 : 1;
  const u16* M1 = N1 == 128 ? p.M1a : p.M1b;
  const int ldm = N1 == 128 ? 256 : 64;
  const int nk = N1 == 128 ? 4 : 1;
  const int ntask = nseq * 768 * nkt;
  const int twmul = 16384 / S;
  TASK_LOOP(t, ntask, base) {
    const int k1t = t % nkt, col = (t / nkt) % 768, seq = t / (nkt * 768);
    const int k1base = k1t * 64;
    auto la = [&](int row, int k) __attribute__((always_inline)) {
      const int k1 = k1base + (row >> 6) * 32 + (row & 31), ii = (row >> 5) & 1;
      if (k1 >= N1 || k >= 2 * N1) return zero4();
      return *(const u32x4*)(M1 + (ii * N1 + k1) * ldm + k);
    };
    auto lb = [&](int row, int k) __attribute__((always_inline)) {
      if (k >= 2 * N1) return zero4();
      const int part = k >> lgN1, s1 = k & (N1 - 1);
      const u16* src = p.UT + (size_t)(part * 768 + col) * TBP + seq * S + s1 * 128 + row;
      u32x4 v;
#pragma unroll
      for (int jj = 0; jj < 4; ++jj) v[jj] = (unsigned)src[(2 * jj) * 128] | ((unsigned)src[(2 * jj + 1) * 128] << 16);
      return v;
    };
    auto epi = [&](f32x16 (&acc)[2], int wm, int wn, int lane) __attribute__((always_inline)) {
      const int lr = lane & 31, lh = lane >> 5;
      const int s2 = wn * 32 + lr;
#pragma unroll
      for (int r = 0; r < 16; ++r) {
        const int k1 = k1base + wm * 32 + rowmap(r, lh);
        if (k1 < N1) {
          const float re = acc[0][r], im = acc[1][r];
          const float2 cs = p.tw[(s2 * k1) * twmul];
          const size_t o = ((size_t)((seq * N1 + k1) * 2) * 768 + col) * 128 + s2;
          p.Gp[o] = f2bf(cs.x * re + cs.y * im);
          p.Gp[o + 768 * 128] = f2bf(cs.x * im - cs.y * re);
        }
      }
    };
    gemm_tile2s<false, true>(smem, nk, la, lb, epi);
  }
  base += ntask;
}


DI void phase_fft1_small(const Prm& p, int nseq) {
  constexpr float C16[16] = {1.f, 0.92387953251128674f, 0.70710678118654752f, 0.38268343236508977f, 0.f, -0.38268343236508977f, -0.70710678118654752f,
                             -0.92387953251128674f, -1.f, -0.92387953251128674f, -0.70710678118654752f, -0.38268343236508977f, 0.f,
                             0.38268343236508977f, 0.70710678118654752f, 0.92387953251128674f};
  constexpr float S16[16] = {0.f, 0.38268343236508977f, 0.70710678118654752f, 0.92387953251128674f, 1.f, 0.92387953251128674f, 0.70710678118654752f,
                             0.38268343236508977f, 0.f, -0.38268343236508977f, -0.70710678118654752f, -0.92387953251128674f, -1.f,
                             -0.92387953251128674f, -0.70710678118654752f, -0.38268343236508977f};
  const int gtid = blockIdx.x * NTH + tidx(), gn = gridDim.x * NTH;
  for (int idx = gtid; idx < nseq * 768 * 128; idx += gn) {
    const int s2 = idx & 127, col = (idx >> 7) % 768, seq = idx / (768 * 128);
    const u16* ur = p.UT + (size_t)col * TBP + seq * 2048 + s2;
    const u16* ui = ur + (size_t)768 * TBP;
    float xr[16], xi[16];
#pragma unroll
    for (int s1 = 0; s1 < 16; ++s1) { xr[s1] = bf2f(ur[s1 * 128]); xi[s1] = bf2f(ui[s1 * 128]); }
    u16* go = p.Gp + ((size_t)(seq * 16 * 2) * 768 + col) * 128 + s2;
#pragma unroll
    for (int k1 = 0; k1 < 16; ++k1) {
      float gr = 0.f, gi = 0.f;
#pragma unroll
      for (int s1 = 0; s1 < 16; ++s1) {
        const float c = C16[(k1 * s1) & 15], sn = S16[(k1 * s1) & 15];
        gr += c * xr[s1] + sn * xi[s1];
        gi += c * xi[s1] - sn * xr[s1];
      }
      const float2 cs = p.tw[(s2 * k1) * 8];
      go[(size_t)(k1 * 2) * 768 * 128] = f2bf(cs.x * gr + cs.y * gi);
      go[(size_t)(k1 * 2 + 1) * 768 * 128] = f2bf(cs.x * gi - cs.y * gr);
    }
  }
}

DI void phase_fft2(const Prm& p, u16* smem, int S, int nseq, int N1, int& base) {
  const int ntask = nseq * N1 * 6;
  const float scale = rsqrtf((float)S * 192.f);
  u16* fa = p.UT;
  TASK_LOOP(t, ntask, base) {
    const int ct = t % 6, k1 = (t / 6) % N1, seq = t / (6 * N1);
    const u16* gb = p.Gp + ((size_t)((seq * N1 + k1) * 2) * 768 + ct * 128) * 128;
    auto la = [&](int row, int k) __attribute__((always_inline)) { return *(const u32x4*)(p.M2 + row * 256 + k); };
    auto lb = [&](int row, int k) __attribute__((always_inline)) {
      const int part = k >> 7, s2 = k & 127;
      return *(const u32x4*)(gb + ((size_t)part * 768 + row) * 128 + s2);
    };
    auto epi = [&](f32x16 (&acc)[2], int wm, int wn, int lane) __attribute__((always_inline)) {
      const int lr = lane & 31, lh = lane >> 5;
      const int col = ct * 128 + wn * 32 + lr;
#pragma unroll
      for (int i = 0; i < 2; ++i)
#pragma unroll
        for (int r = 0; r < 16; ++r) {
          const int k2 = wm * 64 + i * 32 + rowmap(r, lh);
          const int tok = seq * S + k1 + N1 * k2;
          fa[(size_t)tok * 768 + col] = f2bf(acc[i][r] * scale);
        }
    };
    gemm_tile2s<false, false>(smem, 4, la, lb, epi);
  }
  base += ntask;
}

DI void phase_mixc(const Prm& p, unsigned char* smem_raw, int l, int& base) {
  u16* smem = (u16*)smem_raw;
  float* st = (float*)(smem_raw + GEMM_SMEM);
  float* red = (float*)smem_raw;
  const int tid = tidx();
  TASK_LOOP(t, 512, base) {
    const int h = t & 3, ch = t >> 2, tok0 = ch * 128;
    {
      const int q = tid & 127, qf = tid >> 7;
      float s = 0.f, ss = 0.f;
      const u16* src = p.cvT + (size_t)(qf * 96) * TBP + tok0 + q;
      for (int c = 0; c < 96; ++c) { const float v = bf2f(src[(size_t)c * TBP]); s += v; ss += v * v; }
      red[qf * 256 + q * 2] = s; red[qf * 256 + q * 2 + 1] = ss;
      __syncthreads();
      if (tid < 128) {
        const float s1 = red[q * 2] + red[256 + q * 2] + red[512 + q * 2] + red[768 + q * 2];
        const float s2 = red[q * 2 + 1] + red[256 + q * 2 + 1] + red[512 + q * 2 + 1] + red[768 + q * 2 + 1];
        const float mu = s1 * (1.f / 384.f);
        const float var = fmaxf(s2 * (1.f / 384.f) - mu * mu, 0.f);
        st[q] = mu; st[128 + q] = rsqrtf(var + 1e-6f);
      }
      __syncthreads();
    }
    const u16* Wm = p.SgW + (size_t)((l * 4 + h) * 128) * 128;
    auto la = [&](int row, int k) __attribute__((always_inline)) { return *(const u32x4*)(Wm + row * 128 + k); };
    auto lb = [&](int row, int k) __attribute__((always_inline)) {
      if (row >= 96) return zero4();
      const int c = h * 96 + row;
      const u32x4 raw = *(const u32x4*)(p.cvT + (size_t)c * TBP + tok0 + k);
      const float g = p.ln_g[l * 384 + c], b = p.ln_b[l * 384 + c];
      u32x4 o;
#pragma unroll
      for (int jj = 0; jj < 4; ++jj) {
        const float v0 = (bflo(raw[jj]) - st[k + 2 * jj]) * st[128 + k + 2 * jj] * g + b;
        const float v1 = (bfhi(raw[jj]) - st[k + 2 * jj + 1]) * st[128 + k + 2 * jj + 1] * g + b;
        o[jj] = pack2(v0, v1);
      }
      return o;
    };
    auto epi = [&](f32x16 (&acc)[2], int wm, int wn, int lane) __attribute__((always_inline)) {
      const int lr = lane & 31, lh = lane >> 5;
      const int cl = wn * 32 + lr;
      if (cl < 96) {
#pragma unroll
        for (int i = 0; i < 2; ++i)
#pragma unroll
          for (int r = 0; r < 16; ++r) {
            const int pp = wm * 64 + i * 32 + rowmap(r, lh);
            const float val = acc[i][r] + p.sgu_b[(l * 4 + h) * 128 + pp];
            u16* dst = p.cu + (size_t)(tok0 + pp) * 384 + h * 96 + cl;
            *dst = f2bf(bf2f(*dst) * val);
          }
      }
    };
    gemm_tile<false, false>(smem, 2, la, lb, epi);
  }
  base += 512;
}

DI void phase_qup(const Prm& p, unsigned char* smem_raw, int l, int S, int& base) {
  u16* smem = (u16*)smem_raw;
  float* st = (float*)(smem_raw + GEMM_SMEM);
  const int tid = tidx();
  const float QS = 0.10206207261596577f * LOG2E;
  TASK_LOOP(t, 3 * 128, base) {
    const int tn = t % 3, tm = t / 3, n0 = tn * 128, m0 = tm * 128;
    {
      const int row = tid >> 2, qf = tid & 3;
      const u16* src = p.dcq + (size_t)(m0 + row) * 384 + qf * 96;
      float ss = 0.f;
#pragma unroll 4
      for (int c = 0; c < 12; ++c) {
        const u32x4 v = *(const u32x4*)(src + c * 8);
#pragma unroll
        for (int jj = 0; jj < 4; ++jj) { const float a = bflo(v[jj]), b = bfhi(v[jj]); ss += a * a + b * b; }
      }
      ss += __shfl_xor(ss, 1);
      ss += __shfl_xor(ss, 2);
      if (qf == 0) st[row] = rsqrtf(ss * (1.f / 384.f) + 1e-6f);
      __syncthreads();
    }
    const u16* W = p.WqT + (size_t)l * 384 * 384;
    auto la = [&](int row, int k) __attribute__((always_inline)) {
      const int g32 = row & ~31;
      const bool pe = ((n0 + g32) % 96) == 64;
      return *(const u32x4*)(W + (size_t)(n0 + g32 + (pe ? (row & 31) : perm_m(row & 31))) * 384 + k);
    };
    auto lb = [&](int row, int k) __attribute__((always_inline)) { return *(const u32x4*)(p.dcq + (size_t)(m0 + row) * 384 + k); };
    auto epi = [&](f32x16 (&acc)[2], int wm, int wn, int lane) __attribute__((always_inline)) {
      const int lr = lane & 31, lh = lane >> 5;
      const int tokl = wn * 32 + lr, tok = m0 + tokl;
      const float sc = st[tokl] * QS;
#pragma unroll
      for (int i = 0; i < 2; ++i) {
        const int nb = n0 + wm * 64 + i * 32;
        const int head = nb / 96, within = nb - head * 96;
        const f32x16& a = acc[i];
        if (within < 64) {
#pragma unroll
          for (int h2 = 0; h2 < 2; ++h2) {
            u32x4 o;
#pragma unroll
            for (int e = 0; e < 4; ++e) o[e] = pack2(a[8 * h2 + 2 * e] * sc, a[8 * h2 + 2 * e + 1] * sc);
            *(u32x4*)(p.qc + (size_t)tok * 384 + nb + 16 * lh + 8 * h2) = o;
          }
        } else {
          const int pos = tok & (S - 1);
#pragma unroll
          for (int q = 0; q < 2; ++q)
#pragma unroll
            for (int e = 0; e < 4; ++e) {
              const int r = 4 * q + e, ii = 8 * q + 4 * lh + e;
              const float2 cs = p.rope[pos * 16 + ii];
              const float x1 = a[r] * sc, x2 = a[r + 8] * sc;
              p.qc[(size_t)tok * 384 + head * 96 + 64 + ii] = f2bf(x1 * cs.x - x2 * cs.y);
              p.qc[(size_t)tok * 384 + head * 96 + 80 + ii] = f2bf(x1 * cs.y + x2 * cs.x);
            }
        }
      }
    };
    gemm_tile2s<false, false>(smem, 6, la, lb, epi);
    __syncthreads();
  }
  base += 3 * 128;
}

DI void phase_kvup(const Prm& p, unsigned char* smem_raw, int l, int& base) {
  u16* smem = (u16*)smem_raw;
  float* st = (float*)(smem_raw + GEMM_SMEM);
  const int tid = tidx();
  TASK_LOOP(t, 4 * 128, base) {
    const int tn = t & 3, tm = t >> 2, n0 = tn * 128, m0 = tm * 128;
    {
      const int row = tid >> 2, qf = tid & 3;
      const u16* src = p.dckv + (size_t)(m0 + row) * 320 + qf * 80;
      float ss = 0.f;
#pragma unroll 5
      for (int c = 0; c < 10; ++c) {
        const u32x4 v = *(const u32x4*)(src + c * 8);
#pragma unroll
        for (int jj = 0; jj < 4; ++jj) { const float a = bflo(v[jj]), b = bfhi(v[jj]); ss += a * a + b * b; }
      }
      ss += __shfl_xor(ss, 1);
      ss += __shfl_xor(ss, 2);
      if (qf == 0) st[row] = rsqrtf(ss * (1.f / 320.f) + 1e-6f);
      __syncthreads();
    }
    const u16* W = p.WkvT + (size_t)l * 512 * 320;
    auto la = [&](int row, int k) __attribute__((always_inline)) {
      const int g32 = row & ~31;
      return *(const u32x4*)(W + (size_t)(n0 + g32 + (g32 < 64 ? perm_m(row & 31) : (row & 31))) * 320 + k);
    };
    auto lb = [&](int row, int k) __attribute__((always_inline)) { return *(const u32x4*)(p.dckv + (size_t)(m0 + row) * 320 + k); };
    auto epi = [&](f32x16 (&acc)[2], int wm, int wn, int lane) __attribute__((always_inline)) {
      const int lr = lane & 31, lh = lane >> 5;
      const int head = tn;
      const int tokl = wn * 32 + lr, tok = m0 + tokl;
      const float sc = st[tokl];
#pragma unroll
      for (int i = 0; i < 2; ++i) {
        const int within = wm * 64 + i * 32;
        const f32x16& a = acc[i];
        if (within < 64) {
#pragma unroll
          for (int h2 = 0; h2 < 2; ++h2) {
            u32x4 o;
#pragma unroll
            for (int e = 0; e < 4; ++e) o[e] = pack2(a[8 * h2 + 2 * e] * sc, a[8 * h2 + 2 * e + 1] * sc);
            *(u32x4*)(p.kc + (size_t)tok * 384 + head * 96 + within + 16 * lh + 8 * h2) = o;
          }
        } else {
#pragma unroll
          for (int r = 0; r < 16; ++r)
            p.vT[(size_t)(head * 64 + within - 64 + rowmap(r, lh)) * TBP + tok] = f2bf(a[r] * sc);
        }
      }
    };
    gemm_tile2s<false, false>(smem, 5, la, lb, epi);
    __syncthreads();
  }
  base += 4 * 128;
}

DI void phase_mixb(const Prm& p, unsigned char* smem_raw, int S, int lgS, int& base) {
  float* bt = (float*)smem_raw;
  const int tid = tidx(), lane = tid & 63, wave = tid >> 6, lr = lane & 31, lh = lane >> 5;
  u16* vt = (u16*)(smem_raw + 3328) + wave * (64 * 40);
  for (int idx = tid; idx < 774; idx += NTH) bt[idx] = p.biasT[idx];
  __syncthreads();
  TASK_LOOP(t, 384, base) {
    const int wt = t * 8 + wave;
    const int hg = wt & 1, g = (wt >> 1) % 3, blk = wt / 6;
    const int seq = blk >> (lgS - 5), b_in = blk & ((S >> 5) - 1);
    const int lgd = 2 * g, L = S >> lgd;
    const int lgbpr = lgS - lgd - 5;
    const int res = b_in >> lgbpr, i0 = (b_in & ((1 << lgbpr) - 1)) << 5;
    const int tokbase = seq * S + res;
    const int hd = g * 2 + hg, hc = hd * 64;
    const int qi = i0 + lr;
    const int qtok = tokbase + (qi << lgd);
    bf16x8 qf[4];
#pragma unroll
    for (int ks = 0; ks < 4; ++ks) qf[ks] = *(const bf16x8*)(p.bqkv + (size_t)qtok * 1152 + hc + ks * 16 + lh * 8);
    f32x16 sc[5];
#pragma unroll
    for (int tt = 0; tt < 5; ++tt) {
      int ik = i0 - 64 + 32 * tt + lr;
      ik = min(max(ik, 0), L - 1);
      const u16* kp = p.bqkv + (size_t)(tokbase + (ik << lgd)) * 1152 + 384 + hc + lh * 8;
      sc[tt] = zero16();
#pragma unroll
      for (int ks = 0; ks < 4; ++ks) sc[tt] = mfma(*(const bf16x8*)(kp + ks * 16), qf[ks], sc[tt]);
    }
    float mx = -1e30f;
#pragma unroll
    for (int tt = 0; tt < 5; ++tt)
#pragma unroll
      for (int r = 0; r < 16; ++r) {
        const int ik = i0 - 64 + 32 * tt + rowmap(r, lh);
        const int rel = ik - qi;
        const bool valid = (rel >= -64) && (rel <= 64) && (ik >= 0) && (ik < L);
        const int bi = min(max(rel + 64, 0), 128);
        const float s = valid ? (sc[tt][r] * 0.125f + bt[hd * 129 + bi]) * LOG2E : -1e30f;
        sc[tt][r] = s;
        mx = fmaxf(mx, s);
      }
    mx = fmaxf(mx, __shfl_xor(mx, 32));
    float sum = 0.f;
#pragma unroll
    for (int tt = 0; tt < 5; ++tt)
#pragma unroll
      for (int r = 0; r < 16; ++r) {
        const float pv = ex2(sc[tt][r] - mx);
        sum += pv;
        sc[tt][r] = pv;
      }
    sum += __shfl_xor(sum, 32);
    f32x16 oacc[2];
    oacc[0] = zero16(); oacc[1] = zero16();
#pragma unroll
    for (int tt = 0; tt < 5; ++tt) {
#pragma unroll
      for (int e = 0; e < 4; ++e) {
        const int c = lane + 64 * e, key = c >> 3, dch = c & 7;
        int ik = i0 - 64 + 32 * tt + key;
        ik = min(max(ik, 0), L - 1);
        const u32x4 raw = *(const u32x4*)(p.bqkv + (size_t)(tokbase + (ik << lgd)) * 1152 + 768 + hc + dch * 8);
#pragma unroll
        for (int jj = 0; jj < 4; ++jj) {
          vt[(dch * 8 + 2 * jj) * 40 + key] = (u16)(raw[jj] & 0xffffu);
          vt[(dch * 8 + 2 * jj + 1) * 40 + key] = (u16)(raw[jj] >> 16);
        }
      }
      __syncthreads();
#pragma unroll
      for (int u = 0; u < 2; ++u) {
        u32x4 pk;
#pragma unroll
        for (int jj = 0; jj < 4; ++jj) pk[jj] = pack2(sc[tt][8 * u + 2 * jj], sc[tt][8 * u + 2 * jj + 1]);
        const bf16x8 pf = __builtin_bit_cast(bf16x8, pk);
#pragma unroll
        for (int dt = 0; dt < 2; ++dt) {
          const u16* vp = vt + (dt * 32 + lr) * 40 + 16 * u + 4 * lh;
          u32x4 vv;
          const u32x2 lo = *(const u32x2*)vp, hi = *(const u32x2*)(vp + 8);
          vv[0] = lo[0]; vv[1] = lo[1]; vv[2] = hi[0]; vv[3] = hi[1];
          oacc[dt] = mfma(__builtin_bit_cast(bf16x8, vv), pf, oacc[dt]);
        }
      }
      __syncthreads();
    }
    const float inv = 1.f / sum;
#pragma unroll
    for (int dt = 0; dt < 2; ++dt)
#pragma unroll
      for (int q = 0; q < 4; ++q) {
        float4 o;
        o.x = oacc[dt][4 * q] * inv; o.y = oacc[dt][4 * q + 1] * inv; o.z = oacc[dt][4 * q + 2] * inv; o.w = oacc[dt][4 * q + 3] * inv;
        *(float4*)(p.og + (size_t)qtok * 384 + hc + dt * 32 + 8 * q + 4 * lh) = o;
      }
    if (lh == 0) p.lse[(size_t)qtok * 6 + hd] = (mx + __log2f(sum)) * LN2;
  }
  base += 384;
  __syncthreads();
}

DI void phase_combb(const Prm& p) {
  const int gtid = blockIdx.x * NTH + tidx(), gn = gridDim.x * NTH;
  for (int idx = gtid; idx < TB * 32; idx += gn) {
    const int dq = idx & 15, hg = (idx >> 4) & 1, tok = idx >> 5;
    const float l0 = p.lse[(size_t)tok * 6 + hg], l1 = p.lse[(size_t)tok * 6 + 2 + hg], l2 = p.lse[(size_t)tok * 6 + 4 + hg];
    const float mx = fmaxf(l0, fmaxf(l1, l2));
    const float e0 = __expf(l0 - mx), e1 = __expf(l1 - mx), e2 = __expf(l2 - mx);
    const float inv = 1.f / (e0 + e1 + e2);
    const float4 a = *(const float4*)(p.og + (size_t)tok * 384 + hg * 64 + dq * 4);
    const float4 b = *(const float4*)(p.og + (size_t)tok * 384 + 128 + hg * 64 + dq * 4);
    const float4 c = *(const float4*)(p.og + (size_t)tok * 384 + 256 + hg * 64 + dq * 4);
    st4bf(p.ob + (size_t)tok * 128 + hg * 64 + dq * 4, (e0 * a.x + e1 * b.x + e2 * c.x) * inv, (e0 * a.y + e1 * b.y + e2 * c.y) * inv,
          (e0 * a.z + e1 * b.z + e2 * c.z) * inv, (e0 * a.w + e1 * b.w + e2 * c.w) * inv);
  }
}

constexpr int KS_ELEMS = 128 * 104, VS_ELEMS = 64 * 136;
DI void phase_mla(const Prm& p, unsigned char* smem_raw, int S, int lgS, int& base) {
  u16* Ks = (u16*)smem_raw;
  u16* Vs = Ks + 2 * KS_ELEMS;
  const int tid = tidx(), lane = tid & 63, wave = tid >> 6, lr = lane & 31, lh = lane >> 5;
  const int nkt = S >> 7;
  TASK_LOOP(t, 256, base) {
    const int head = t & 3, qb = t >> 2, tok0 = qb * 256;
    const int seqtok0 = (tok0 >> lgS) << lgS;
    const int qtok = tok0 + wave * 32 + lr;
    bf16x8 qf[6];
#pragma unroll
    for (int ks = 0; ks < 6; ++ks) qf[ks] = *(const bf16x8*)(p.qc + (size_t)qtok * 384 + head * 96 + ks * 16 + lh * 8);
    const u16* kbase = p.kc + (size_t)seqtok0 * 384 + head * 96;
    const u16* vbase = p.vT + (size_t)(head * 64) * TBP + seqtok0;
    u32x4 rk[3], rv[2];
    auto gload = [&](int kt) __attribute__((always_inline)) {
#pragma unroll
      for (int e = 0; e < 3; ++e) {
        const int c = tid + NTH * e, key = c / 12, dc = c - key * 12;
        rk[e] = *(const u32x4*)(kbase + (size_t)(kt * 128 + key) * 384 + dc * 8);
      }
#pragma unroll
      for (int e = 0; e < 2; ++e) {
        const int c = tid + NTH * e, d = c >> 4, kch = c & 15;
        rv[e] = *(const u32x4*)(vbase + (size_t)d * TBP + kt * 128 + kch * 8);
      }
    };
    auto sstore = [&](int buf) __attribute__((always_inline)) {
#pragma unroll
      for (int e = 0; e < 3; ++e) {
        const int c = tid + NTH * e, key = c / 12, dc = c - key * 12;
        *(u32x4*)(Ks + buf * KS_ELEMS + key * 104 + dc * 8) = rk[e];
      }
#pragma unroll
      for (int e = 0; e < 2; ++e) {
        const int c = tid + NTH * e, d = c >> 4, kch = c & 15;
        u16* vd = Vs + buf * VS_ELEMS + d * 136 + (kch >> 1) * 16 + (kch & 1) * 4;
        u32x2 lo, hi;
        lo[0] = rv[e][0]; lo[1] = rv[e][1]; hi[0] = rv[e][2]; hi[1] = rv[e][3];
        *(u32x2*)vd = lo;
        *(u32x2*)(vd + 8) = hi;
      }
    };
    float m = -1e30f;
    f32x2 lsum2 = {0.f, 0.f};
    f32x16 oacc[2];
    oacc[0] = zero16(); oacc[1] = zero16();
    gload(0);
    sstore(0);
    __syncthreads();
    for (int kt = 0; kt < nkt; ++kt) {
      const int buf = kt & 1;
      if (kt + 1 < nkt) gload(kt + 1);
      f32x16 s[4];
#pragma unroll
      for (int kk = 0; kk < 4; ++kk) s[kk] = zero16();
      {
        const u16* kp = Ks + buf * KS_ELEMS + lr * 104 + lh * 8;
        bf16x8 kf[4];
#pragma unroll
        for (int kk = 0; kk < 4; ++kk) kf[kk] = *(const bf16x8*)(kp + kk * 32 * 104);
#pragma unroll
        for (int ks = 0; ks < 6; ++ks) {
          bf16x8 kn[4];
          if (ks < 5) {
#pragma unroll
            for (int kk = 0; kk < 4; ++kk) kn[kk] = *(const bf16x8*)(kp + kk * 32 * 104 + (ks + 1) * 16);
          }
#pragma unroll
          for (int kk = 0; kk < 4; ++kk) s[kk] = mfma(kf[kk], qf[ks], s[kk]);
          if (ks < 5) {
#pragma unroll
            for (int kk = 0; kk < 4; ++kk) kf[kk] = kn[kk];
          }
        }
      }
      float mloc = -1e30f;
#pragma unroll
      for (int kk = 0; kk < 4; ++kk)
#pragma unroll
        for (int r = 0; r < 16; ++r) mloc = fmaxf(mloc, s[kk][r]);
      mloc = fmaxf(mloc, __shfl_xor(mloc, 32));
      const float mnew = fmaxf(m, mloc);
      const float alpha = ex2(m - mnew);
      m = mnew;
      lsum2 *= alpha;
      const f32x2 mn2 = {mnew, mnew};
#pragma unroll
      for (int kk = 0; kk < 4; ++kk)
#pragma unroll
        for (int r2 = 0; r2 < 8; ++r2) {
          f32x2 v = {s[kk][2 * r2], s[kk][2 * r2 + 1]};
          v = v - mn2;
          f32x2 pv;
          pv[0] = ex2(v[0]); pv[1] = ex2(v[1]);
          lsum2 += pv;
          s[kk][2 * r2] = pv[0]; s[kk][2 * r2 + 1] = pv[1];
        }
#pragma unroll
      for (int dt = 0; dt < 2; ++dt)
#pragma unroll
        for (int r = 0; r < 16; ++r) oacc[dt][r] *= alpha;
#pragma unroll
      for (int kk = 0; kk < 4; ++kk)
#pragma unroll
        for (int u = 0; u < 2; ++u) {
          u32x4 pk;
#pragma unroll
          for (int jj = 0; jj < 4; ++jj) pk[jj] = pack2(s[kk][8 * u + 2 * jj], s[kk][8 * u + 2 * jj + 1]);
          const bf16x8 pf = __builtin_bit_cast(bf16x8, pk);
#pragma unroll
          for (int dt = 0; dt < 2; ++dt) {
            const u16* vp = Vs + buf * VS_ELEMS + (dt * 32 + lr) * 136 + kk * 32 + 16 * u + 8 * lh;
            oacc[dt] = mfma(*(const bf16x8*)vp, pf, oacc[dt]);
          }
        }
      if (kt + 1 < nkt) sstore(buf ^ 1);
      __syncthreads();
    }
    float lsum = lsum2[0] + lsum2[1];
    lsum += __shfl_xor(lsum, 32);
    const float inv = 1.f / lsum;
#pragma unroll
    for (int dt = 0; dt < 2; ++dt)
#pragma unroll
      for (int q = 0; q < 4; ++q)
        st4bf(p.od + (size_t)qtok * 256 + head * 64 + dt * 32 + 8 * q + 4 * lh, oacc[dt][4 * q] * inv, oacc[dt][4 * q + 1] * inv,
              oacc[dt][4 * q + 2] * inv, oacc[dt][4 * q + 3] * inv);
  }
  base += 256;
}


template <class ACC>
DI void merge_branch(const Prm& p, u16* smem, const u16* W, const u16* X, int ld, int bi, int n0, int m0, ACC& macc) {
  auto la = [&](int row, int k) __attribute__((always_inline)) { return *(const u32x4*)(W + (size_t)(n0 + (row & ~31) + perm_m(row & 31)) * ld + k); };
  auto lb = [&](int row, int k) __attribute__((always_inline)) { return *(const u32x4*)(X + (size_t)(m0 + row) * ld + k); };
  auto epi = [&](f32x16 (&acc)[2], int wm, int wn, int lane) __attribute__((always_inline)) {
    const int lr = lane & 31, lh = lane >> 5;
    const int tok = m0 + wn * 32 + lr;
#pragma unroll
    for (int i = 0; i < 2; ++i)
#pragma unroll
      for (int h2 = 0; h2 < 2; ++h2) {
        const int n = n0 + wm * 64 + i * 32 + 16 * lh + 8 * h2;
        const u32x4 gz = *(const u32x4*)(p.zg + (size_t)tok * 4096 + bi * 1024 + n);
#pragma unroll
        for (int e = 0; e < 4; ++e) {
          macc[i][8 * h2 + 2 * e] += bflo(gz[e]) * acc[i][8 * h2 + 2 * e];
          macc[i][8 * h2 + 2 * e + 1] += bfhi(gz[e]) * acc[i][8 * h2 + 2 * e + 1];
        }
      }
  };
  gemm_tile2s<false, false>(smem, ld >> 6, la, lb, epi);
}

DI void phase_merge(const Prm& p, u16* smem, int l, int& base) {
  TASK_LOOP(t, 8 * 128, base) {
    const int tn = t & 7, tm = t >> 3, n0 = tn * 128, m0 = tm * 128;
    f32x16 macc[2];
    macc[0] = zero16(); macc[1] = zero16();
    merge_branch(p, smem, p.PaT + (size_t)l * 1024 * 768, p.UT, 768, 0, n0, m0, macc);
    merge_branch(p, smem, p.PbT + (size_t)l * 1024 * 128, p.ob, 128, 1, n0, m0, macc);
    merge_branch(p, smem, p.PcT + (size_t)l * 1024 * 384, p.cu, 384, 2, n0, m0, macc);
    merge_branch(p, smem, p.PdT + (size_t)l * 1024 * 256, p.od, 256, 3, n0, m0, macc);
    const int tid2 = tidx(), lane = tid2 & 63, wave = tid2 >> 6, wm = wave >> 2, wn = wave & 3, lr = lane & 31, lh = lane >> 5;
    const int tok = m0 + wn * 32 + lr;
#pragma unroll
    for (int i = 0; i < 2; ++i)
#pragma unroll
      for (int h2 = 0; h2 < 2; ++h2) {
        u32x4 o;
#pragma unroll
        for (int e = 0; e < 4; ++e) o[e] = pack2(macc[i][8 * h2 + 2 * e], macc[i][8 * h2 + 2 * e + 1]);
        *(u32x4*)(p.hbuf + (size_t)tok * 1024 + n0 + wm * 64 + i * 32 + 16 * lh + 8 * h2) = o;
      }
  }
  base += 8 * 128;
}

DI void phase_resid_gemm(const Prm& p, unsigned char* smem_raw, const u16* W, const u16* X, int K, const float* xsrc, float* xdst,
                         const float* modl, int gtoff, int sb, int& base) {
  LAS u16* shm = (LAS u16*)smem_raw;
  bool pre = false;
  TASK_LOOP(t, 4 * 64, base) {
    int tn, tm;
    map256(t, 4, tn, tm);
    const int brow = tn * 256, bcol = tm * 256;
    const int tnx = t + (int)gridDim.x;
    const bool has_next = tnx < (4 * 64);
    int tn2 = 0, tm2 = 0;
    if (has_next) map256(tnx, 4, tn2, tm2);
    const int nbrow = tn2 * 256, nbcol = tm2 * 256;
    auto epi = [&](f32x4 (&acc)[2][2][4][2], int wr, int wc, int fr, int fq) __attribute__((always_inline)) {
#pragma unroll
      for (int bj = 0; bj < 2; ++bj)
#pragma unroll
        for (int n = 0; n < 2; ++n) {
          const int tok = bcol + bj * 128 + wc * 32 + n * 16 + fr;
          const float* gt = modl + condrow(sb, tok) * 6144 + gtoff;
#pragma unroll
          for (int ai = 0; ai < 2; ++ai)
#pragma unroll
            for (int m = 0; m < 4; ++m) {
              const int nn = brow + ai * 128 + wr * 64 + m * 16 + fq * 4;
              const f32x4 v = acc[ai][bj][m][n];
              const float4 g4 = *(const float4*)(gt + nn);
              const float4 xi = *(const float4*)(xsrc + (size_t)tok * 1024 + nn);
              float4 o;
              o.x = xi.x + g4.x * v[0]; o.y = xi.y + g4.y * v[1]; o.z = xi.z + g4.z * v[2]; o.w = xi.w + g4.w * v[3];
              *(float4*)(xdst + (size_t)tok * 1024 + nn) = o;
            }
        }
    };
    gemm256<false>(shm, W, X, K, brow, bcol, pre, has_next, nbrow, nbcol, epi);
    pre = has_next;
  }
  base += 4 * 64;
}

DI void phase_w1(const Prm& p, unsigned char* smem_raw, int l, int& base) {
  const u16* W = p.W1T + (size_t)l * 4096 * 1024;
  LAS u16* shm = (LAS u16*)smem_raw;
  bool pre = false;
  TASK_LOOP(t, 16 * 64, base) {
    int tn, tm;
    map256(t, 16, tn, tm);
    const int brow = tn * 256, bcol = tm * 256;
    const int tnx = t + (int)gridDim.x;
    const bool has_next = tnx < (16 * 64);
    int tn2 = 0, tm2 = 0;
    if (has_next) map256(tnx, 16, tn2, tm2);
    const int nbrow = tn2 * 256, nbcol = tm2 * 256;
    auto epi = [&](f32x4 (&acc)[2][2][4][2], int wr, int wc, int fr, int fq) __attribute__((always_inline)) {
#pragma unroll
      for (int bj = 0; bj < 2; ++bj)
#pragma unroll
        for (int n = 0; n < 2; ++n) {
          const int tok = bcol + bj * 128 + wc * 32 + n * 16 + fr;
#pragma unroll
          for (int ai = 0; ai < 2; ++ai)
#pragma unroll
            for (int mp = 0; mp < 2; ++mp) {
              const int nn = brow + ai * 128 + wr * 64 + mp * 32 + fq * 8;
              const f32x4 v = acc[ai][bj][2 * mp][n], w = acc[ai][bj][2 * mp + 1][n];
              const float a0 = fmaxf(v[0], 0.f), a1 = fmaxf(v[1], 0.f), a2 = fmaxf(v[2], 0.f), a3 = fmaxf(v[3], 0.f);
              const float b0 = fmaxf(w[0], 0.f), b1 = fmaxf(w[1], 0.f), b2 = fmaxf(w[2], 0.f), b3 = fmaxf(w[3], 0.f);
              u32x4 o;
              o[0] = pack2(a0 * a0, a1 * a1); o[1] = pack2(a2 * a2, a3 * a3); o[2] = pack2(b0 * b0, b1 * b1); o[3] = pack2(b2 * b2, b3 * b3);
              *(u32x4*)(p.zg + (size_t)tok * 4096 + nn) = o;
            }
        }
    };
    gemm256<true>(shm, W, p.hbuf, 1024, brow, bcol, pre, has_next, nbrow, nbcol, epi);
    pre = has_next;
  }
  base += 16 * 64;
}

DI void phase_final(const Prm& p) {
  const int tid = tidx(), lane = tid & 63;
  const int gw = blockIdx.x * 8 + (tid >> 6), nw = gridDim.x * 8;
  for (int row = gw; row < 3 * TB; row += nw) {
    float* xr = p.out + (size_t)row * 1024;
    float4 v[4];
    float ss = 0.f;
#pragma unroll
    for (int i = 0; i < 4; ++i) {
      v[i] = *(const float4*)(xr + i * 256 + lane * 4);
      ss += v[i].x * v[i].x + v[i].y * v[i].y + v[i].z * v[i].z + v[i].w * v[i].w;
    }
#pragma unroll
    for (int off = 32; off >= 1; off >>= 1) ss += __shfl_xor(ss, off);
    const float rstd = rsqrtf(ss * (1.f / 1024.f) + 1e-6f);
#pragma unroll
    for (int i = 0; i < 4; ++i) {
      const int col = i * 256 + lane * 4;
      const float4 gg = *(const float4*)(p.final_g + col);
      float4 o;
      o.x = v[i].x * rstd * gg.x; o.y = v[i].y * rstd * gg.y; o.z = v[i].z * rstd * gg.z; o.w = v[i].w * rstd * gg.w;
      *(float4*)(xr + col) = o;
    }
  }
}

__global__ void __launch_bounds__(512) mega(Prm p) {
  cg::grid_group grid = cg::this_grid();
  __shared__ __attribute__((aligned(16))) unsigned char smem_raw[SMEM_BYTES];
  __shared__ uint4 xb_words;
  u16* smem = (u16*)smem_raw;
  if (threadIdx.x == 0) xb_words = make_uint4(0u, 0u, 0u, 0u);
  __syncthreads();
  const XcdBarrier xb = xcd_barrier_post(p.bar, (volatile LAS unsigned*)&xb_words);
  int base = 0;
  prologue_a(p, smem_raw, base);
  if (PROBE == 11) prologue_a(p, smem_raw, base);
  grid.sync();
  prologue_b(p);
  xcd_barrier(xb);
  for (int sb = 0; sb < 3; ++sb) {
    const int S = sb == 0 ? 16384 : 2048, lgS = sb == 0 ? 14 : 11, nseq = sb == 0 ? 1 : 8;
    const int N1 = S >> 7, lgN1 = lgS - 7;
    const float* xin = sb == 0 ? p.x_prompt : p.x_sample + (size_t)(sb - 1) * TB * 1024;
    float* xo = p.out + (size_t)sb * TB * 1024;
    for (int l = 0; l < 4; ++l) {
      const float* xs = l == 0 ? xin : xo;
      const float* modl = p.mod + (size_t)l * 17 * 6144;
      phase_norm(p, xs, p.norm1_g + l * 1024, modl, 0, 1024, sb);
      xcd_barrier(xb);
      phase_inproj(p, smem_raw, l, S, base);
      if (PROBE == 2 || PROBE == 7) phase_inproj(p, smem_raw, l, S, base);
      if (PROBE == 12) phase_inproj_probe(p, smem_raw, l, base);
      xcd_barrier(xb);
      if (PROBE == 5) xcd_barrier(xb);
      if (N1 == 16) phase_fft1_small(p, nseq); else phase_fft1(p, smem, S, nseq, N1, lgN1, base);
      phase_mixb(p, smem_raw, S, lgS, base);
      phase_mixc(p, smem_raw, l, base);
      phase_qup(p, smem_raw, l, S, base);
      phase_kvup(p, smem_raw, l, base);
      phase_inproj_tail(p, smem_raw, l, base);
      if (PROBE == 13) phase_fft1(p, smem, S, nseq, N1, lgN1, base);
      if (PROBE == 14) phase_mixb(p, smem_raw, S, lgS, base);
      if (PROBE == 15) { phase_qup(p, smem_raw, l, S, base); phase_kvup(p, smem_raw, l, base); phase_inproj_tail(p, smem_raw, l, base); }
      if (PROBE == 4) { phase_fft1(p, smem, S, nseq, N1, lgN1, base); phase_mixb(p, smem_raw, S, lgS, base); phase_qup(p, smem_raw, l, S, base); phase_kvup(p, smem_raw, l, base); }
      xcd_barrier(xb);
      if (PROBE == 5) xcd_barrier(xb);
      phase_mla(p, smem_raw, S, lgS, base);
      if (PROBE == 1) phase_mla(p, smem_raw, S, lgS, base);
      phase_fft2(p, smem, S, nseq, N1, base);
      phase_combb(p);
      if (PROBE == 6) { phase_fft2(p, smem, S, nseq, N1, base); phase_combb(p); }
      xcd_barrier(xb);
      if (PROBE == 5) xcd_barrier(xb);
      phase_merge(p, smem, l, base);
      if (PROBE == 3) phase_merge(p, smem, l, base);
      xcd_barrier(xb);
      if (PROBE == 5) xcd_barrier(xb);
      phase_resid_gemm(p, smem_raw, p.WoT + (size_t)l * 1024 * 1024, p.hbuf, 1024, xs, xo, modl, 2048, sb, base);
      xcd_barrier(xb);
      phase_norm(p, xo, p.norm2_g + l * 1024, modl, 3072, 4096, sb);
      if (PROBE == 9) { phase_norm(p, xo, p.norm2_g + l * 1024, modl, 3072, 4096, sb); phase_norm(p, xo, p.norm2_g + l * 1024, modl, 3072, 4096, sb); }
      xcd_barrier(xb);
      phase_w1(p, smem_raw, l, base);
      if (PROBE == 2 || PROBE == 8) phase_w1(p, smem_raw, l, base);
      xcd_barrier(xb);
      if (PROBE == 5) xcd_barrier(xb);
      phase_resid_gemm(p, smem_raw, p.W2T + (size_t)l * 1024 * 4096, p.zg, 4096, xo, xo, modl, 5120, sb, base);
      xcd_barrier(xb);
    }
  }
  phase_final(p);
}

extern "C" void kernel_launch(void* const* d_in, const int* in_sizes, int n_in, void* d_out, int out_size, void* d_ws, size_t ws_size,
                              hipStream_t stream) {
  Prm p{};
  const float* const* in = (const float* const*)d_in;
  p.x_prompt = in[0]; p.x_sample = in[1]; p.c_prompt = in[2]; p.c_sample = in[3]; p.rel_bias = in[4]; p.ada_w = in[5]; p.ada_b = in[6];
  p.norm1_g = in[7]; p.w_in = in[8]; p.qn_g = in[9]; p.kvn_g = in[10]; p.w_uq = in[11]; p.w_ukv = in[12]; p.ln_g = in[13]; p.ln_b = in[14];
  p.sgu_w = in[15]; p.sgu_b = in[16]; p.p_a = in[17]; p.p_b = in[18]; p.p_c = in[19]; p.p_d = in[20]; p.w_o = in[21]; p.norm2_g = in[22];
  p.w1 = in[23]; p.w2 = in[24]; p.final_g = in[25];
  p.out = (float*)d_out;
  char* w = (char*)d_ws;
  size_t off = 0;
  auto take = [&](size_t bytes) __attribute__((always_inline)) { void* r = w + off; off += (bytes + 255) & ~(size_t)255; return r; };
  p.WinT = (u16*)take((size_t)4 * NWP * 1024 * 2);
  p.W1T = (u16*)take((size_t)4 * 4096 * 1024 * 2);
  p.W2T = (u16*)take((size_t)4 * 4096 * 1024 * 2);
  p.WoT = (u16*)take((size_t)4 * 1024 * 1024 * 2);
  p.PaT = (u16*)take((size_t)4 * 1024 * 768 * 2);
  p.PbT = (u16*)take((size_t)4 * 1024 * 128 * 2);
  p.PcT = (u16*)take((size_t)4 * 1024 * 384 * 2);
  p.PdT = (u16*)take((size_t)4 * 1024 * 256 * 2);
  p.WqT = (u16*)take((size_t)4 * 384 * 384 * 2);
  p.WkvT = (u16*)take((size_t)4 * 512 * 320 * 2);
  p.SgW = (u16*)take((size_t)4 * 4 * 128 * 128 * 2);
  p.M1a = (u16*)take(256 * 256 * 2);
  p.M1b = (u16*)take(32 * 64 * 2);
  p.M2 = (u16*)take(128 * 256 * 2);
  p.tw = (float2*)take(16384 * 8);
  p.rope = (float2*)take((size_t)16384 * 16 * 8);
  p.biasT = (float*)take(6 * 129 * 4);
  p.mod = (float*)take((size_t)4 * 17 * 6144 * 4);
  p.hbuf = (u16*)take((size_t)TB * 1024 * 2);
  p.og = (float*)take((size_t)TB * 384 * 4);
  p.UT = (u16*)take((size_t)1536 * TBP * 2);
  p.Gp = (u16*)take((size_t)1536 * TB * 2);
  p.bqkv = (u16*)take((size_t)TB * 1152 * 2);
  p.ob = (u16*)take((size_t)TB * 128 * 2);
  p.cu = (u16*)take((size_t)TB * 384 * 2);
  p.cvT = (u16*)take((size_t)TBP * 384 * 2);
  p.dcq = (u16*)take((size_t)TB * 384 * 2);
  p.dckv = (u16*)take((size_t)TB * 320 * 2);
  p.qc = (u16*)take((size_t)TB * 384 * 2);
  p.kc = (u16*)take((size_t)TB * 384 * 2);
  p.vT = (u16*)take((size_t)TBP * 256 * 2);
  p.od = (u16*)take((size_t)TB * 256 * 2);
  p.lse = (float*)take((size_t)TB * 6 * 4);
  p.zg = (u16*)take((size_t)TB * 4096 * 2);
  p.bar = (unsigned*)take(XCD_BAR_WORDS * 4);
  p.modpart = (float*)p.zg;
  if (off > ws_size) { fprintf(stderr, "workspace too small: need %zu have %zu\n", off, ws_size); return; }
  static int grid_blocks = 0;
  if (!grid_blocks) {
    int dev = 0, cus = 0, per_cu = 0;
    (void)hipGetDevice(&dev);
    (void)hipDeviceGetAttribute(&cus, hipDeviceAttributeMultiprocessorCount, dev);
    (void)hipOccupancyMaxActiveBlocksPerMultiprocessor(&per_cu, mega, NTH, 0);
    if (per_cu < 1) per_cu = 1;
    if (per_cu > 1) per_cu = 1;
    grid_blocks = cus * per_cu;
  }
  (void)hipMemsetAsync(p.bar, 0, XCD_BAR_WORDS * 4, stream);
  void* args[] = {&p};
  hipError_t e = hipLaunchCooperativeKernel((void*)mega, dim3(grid_blocks), dim3(NTH), args, 0, stream);
  if (e != hipSuccess) fprintf(stderr, "cooperative launch failed: %s (grid %d)\n", hipGetErrorString(e), grid_blocks);
}
```

```cpp
#include <hip/hip_runtime.h>
#include <hip/hip_cooperative_groups.h>
#include <stdint.h>
#include <stdio.h>
namespace cg = cooperative_groups;

#define DI __device__ __forceinline__
#define LAS __attribute__((address_space(3)))
typedef unsigned short u16;
typedef __attribute__((ext_vector_type(8))) short bf16x8;
typedef __attribute__((ext_vector_type(4))) short bf16x4;
typedef __attribute__((ext_vector_type(16))) float f32x16;
typedef __attribute__((ext_vector_type(4))) float f32x4;
typedef __attribute__((ext_vector_type(2))) float f32x2;
typedef __attribute__((ext_vector_type(4))) unsigned u32x4;
typedef __attribute__((ext_vector_type(2))) unsigned u32x2;
typedef __attribute__((ext_vector_type(2))) __bf16 bf2_t;

constexpr int TB = 16384;
constexpr int TBP = TB + 64;
constexpr int NW = 8288;
constexpr int NWP = 8320;
constexpr int LDT = 72;
constexpr int TILE_ELEMS = 128 * LDT;
constexpr int GEMM_SMEM = 4 * TILE_ELEMS * 2;
constexpr int SMEM_BYTES = 131072;
#ifndef PROBE
#define PROBE 0
#endif
constexpr int NTH = 512;
constexpr int HT = 128 * 64;
constexpr float LOG2E = 1.4426950408889634f;
constexpr float LN2 = 0.6931471805599453f;

struct Prm {
  const float *x_prompt, *x_sample, *c_prompt, *c_sample, *rel_bias, *ada_w, *ada_b, *norm1_g, *w_in,
      *qn_g, *kvn_g, *w_uq, *w_ukv, *ln_g, *ln_b, *sgu_w, *sgu_b, *p_a, *p_b, *p_c, *p_d, *w_o,
      *norm2_g, *w1, *w2, *final_g;
  float* out;
  u16 *WinT, *W1T, *W2T, *WoT, *PaT, *PbT, *PcT, *PdT, *WqT, *WkvT, *SgW, *M1a, *M1b, *M2;
  float2 *tw, *rope;
  float *biasT, *mod, *modpart;
  u16 *hbuf, *UT, *Gp, *bqkv, *ob, *cu, *cvT, *dcq, *dckv, *qc, *kc, *vT, *od, *zg;
  float *og, *lse;
  unsigned* bar;
};

DI unsigned pack2(float a, float b) { bf2_t v; v[0] = (__bf16)a; v[1] = (__bf16)b; return __builtin_bit_cast(unsigned, v); }
DI u16 f2bf(float a) { return __builtin_bit_cast(u16, (__bf16)a); }
DI float bf2f(u16 v) { return __uint_as_float(((unsigned)v) << 16); }
DI float bflo(unsigned w) { return __uint_as_float(w << 16); }
DI float bfhi(unsigned w) { return __uint_as_float(w & 0xffff0000u); }
DI void st4bf(u16* dst, float a, float b, float c, float d) { u32x2 v; v[0] = pack2(a, b); v[1] = pack2(c, d); *(u32x2*)dst = v; }
DI void st4bf_nt(u16* dst, float a, float b, float c, float d) { u32x2 v; v[0] = pack2(a, b); v[1] = pack2(c, d); __builtin_nontemporal_store(v, (u32x2*)dst); }
DI void st8bf(u16* dst, const f32x4& a, const f32x4& b) { u32x4 o; o[0] = pack2(a[0], a[1]); o[1] = pack2(a[2], a[3]); o[2] = pack2(b[0], b[1]); o[3] = pack2(b[2], b[3]); *(u32x4*)dst = o; }
DI int perm_m(int s) { return 16 * ((s >> 2) & 1) + 4 * (s >> 3) + (s & 3); }
DI int rowmap(int r, int lh) { return (r & 3) + 8 * (r >> 2) + 4 * lh; }
DI f32x16 mfma(bf16x8 a, bf16x8 b, f32x16 c) { return __builtin_amdgcn_mfma_f32_32x32x16_bf16(a, b, c, 0, 0, 0); }
DI u32x4 zero4() { u32x4 z; z[0] = 0; z[1] = 0; z[2] = 0; z[3] = 0; return z; }
DI f32x16 zero16() { f32x16 z; for (int i = 0; i < 16; ++i) z[i] = 0.f; return z; }
DI float ex2(float x) { return __builtin_amdgcn_exp2f(x); }
DI int tidx() { int t = threadIdx.x; asm volatile("" : "+v"(t)); return t; }


#define XB_TMO      128
#define XB_XCNT(j)  (256  + 64 * (j))
#define XB_XSUB(j)  (1280 + 64 * (j))
#define XB_XGEN(j)  (2304 + 64 * (j))
#define XB_TOP      3328
#define XB_TOPGEN   3392
#define XCD_BAR_WORDS 3456
#define XB_SPIN_CAP (1u << 18)
DI unsigned xb_ld(unsigned* p) { return __hip_atomic_load(p, __ATOMIC_RELAXED, __HIP_MEMORY_SCOPE_AGENT); }
DI unsigned xb_add(unsigned* p, unsigned v) { return __hip_atomic_fetch_add(p, v, __ATOMIC_RELAXED, __HIP_MEMORY_SCOPE_AGENT); }
DI unsigned xb_xcc_id() { return (unsigned)__builtin_amdgcn_s_getreg((3 << 11) | 20) & 0xFu; }
#define XB_SPIN(cond, bar) do { unsigned _sp = 0; while (cond) { __builtin_amdgcn_s_sleep(1); \
    if ((++_sp & 255u) == 0u) { if (xb_ld(&(bar)[XB_TMO])) break; if (_sp > XB_SPIN_CAP) { atomicAdd(&(bar)[XB_TMO], 1u); break; } } } } while (0)
struct XcdBarrier { unsigned* bar; unsigned x; volatile LAS unsigned* st; };
DI XcdBarrier xcd_barrier_post(unsigned* bar, volatile LAS unsigned* st) {
  XcdBarrier b; b.bar = bar; b.x = xb_xcc_id(); b.st = st;
  if (threadIdx.x == 0) (void)xb_add(&bar[XB_XCNT(b.x)], 1u);
  return b;
}
DI void xcd_barrier_complete(unsigned* bar, unsigned x, unsigned& nloc, unsigned& nx) {
  const unsigned G = gridDim.x * gridDim.y * gridDim.z;
  unsigned sum, cnt, mine, sp = 0u;
  for (;;) {
    sum = 0u; cnt = 0u; mine = 0u;
#pragma unroll
    for (unsigned j = 0; j < 16; ++j) { const unsigned c = xb_ld(&bar[XB_XCNT(j)]); sum += c; cnt += (c > 0u) ? 1u : 0u; mine = (j == x) ? c : mine; }
    if (sum == G) break;
    __builtin_amdgcn_s_sleep(1);
    if ((++sp & 255u) == 0u) { if (xb_ld(&bar[XB_TMO])) break; if (sp > XB_SPIN_CAP) { atomicAdd(&bar[XB_TMO], 1u); break; } }
  }
  nloc = mine > 0u ? mine : 1u; nx = cnt > 0u ? cnt : 1u;
}
DI void xcd_barrier(const XcdBarrier& b) {
  asm volatile("s_waitcnt vmcnt(0)" ::: "memory");
  __syncthreads();
  if (tidx() == 0) {
    unsigned* bar = b.bar;
    const unsigned bx = (unsigned)__builtin_amdgcn_readfirstlane((int)xb_xcc_id());
    __builtin_amdgcn_s_waitcnt(0);
    unsigned nloc = b.st[0], nx = b.st[1];
    if (nloc == 0u) { xcd_barrier_complete(bar, bx, nloc, nx); b.st[0] = nloc; b.st[1] = nx; }
    const unsigned old = xb_add(&bar[XB_XSUB(bx)], 1u);
    const unsigned gen = old / nloc;
    if (old + 1u == (gen + 1u) * nloc) {
      __builtin_amdgcn_fence(__ATOMIC_RELEASE, "agent");
      asm volatile("s_waitcnt vmcnt(0)" ::: "memory");
      const unsigned og = xb_add(&bar[XB_TOP], 1u);
      const unsigned tg = og / nx;
      if (og + 1u == (tg + 1u) * nx) xb_add(&bar[XB_TOPGEN], 1u);
      else XB_SPIN(xb_ld(&bar[XB_TOPGEN]) == tg, bar);
      __builtin_amdgcn_fence(__ATOMIC_ACQUIRE, "agent");
      xb_add(&bar[XB_XGEN(bx)], 1u);
      asm volatile("s_waitcnt vmcnt(0)" ::: "memory");
    } else {
      XB_SPIN(xb_ld(&bar[XB_XGEN(bx)]) == gen, bar);
      __builtin_amdgcn_fence(__ATOMIC_ACQUIRE, "agent");
      asm volatile("s_waitcnt vmcnt(0)" ::: "memory");
    }
  }
  __syncthreads();
}

#define TASK_LOOP(t, nt, base) for (int t = (int)((blockIdx.x + gridDim.x - ((unsigned)(base) % gridDim.x)) % gridDim.x); t < (nt); t += gridDim.x)

template <bool RFA, bool RFB, class LA, class LB, class EPI>
DI void gemm_tile(u16* smem, int nk, LA la, LB lb, EPI epi) {
  const int tid = tidx(), lane = tid & 63, wave = tid >> 6;
  const int wm = wave >> 2, wn = wave & 3, lr = lane & 31, lh = lane >> 5;
  u16* As = smem;
  u16* Bs = smem + 2 * TILE_ELEMS;
  f32x16 acc[2];
  acc[0] = zero16(); acc[1] = zero16();
  u32x4 ra[2], rb[2];
#define A_ROW(c) (RFA ? ((c) & 127) : ((c) >> 3))
#define A_KC(c) (RFA ? ((c) >> 7) : ((c) & 7))
#define B_ROW(c) (RFB ? ((c) & 127) : ((c) >> 3))
#define B_KC(c) (RFB ? ((c) >> 7) : ((c) & 7))
#pragma unroll
  for (int i = 0; i < 2; ++i) { const int c = tid + NTH * i; ra[i] = la(A_ROW(c), A_KC(c) * 8); rb[i] = lb(B_ROW(c), B_KC(c) * 8); }
#pragma unroll
  for (int i = 0; i < 2; ++i) {
    const int c = tid + NTH * i;
    *(u32x4*)(As + A_ROW(c) * LDT + A_KC(c) * 8) = ra[i];
    *(u32x4*)(Bs + B_ROW(c) * LDT + B_KC(c) * 8) = rb[i];
  }
  __syncthreads();
  for (int kt = 0; kt < nk; ++kt) {
    const int buf = kt & 1;
    if (kt + 1 < nk) {
      const int k0 = (kt + 1) * 64;
#pragma unroll
      for (int i = 0; i < 2; ++i) { const int c = tid + NTH * i; ra[i] = la(A_ROW(c), k0 + A_KC(c) * 8); rb[i] = lb(B_ROW(c), k0 + B_KC(c) * 8); }
    }
    const u16* Ab = As + buf * TILE_ELEMS + (wm * 64 + lr) * LDT + lh * 8;
    const u16* Bb = Bs + buf * TILE_ELEMS + (wn * 32 + lr) * LDT + lh * 8;
#pragma unroll
    for (int ks = 0; ks < 4; ++ks) {
      const bf16x8 a0 = *(const bf16x8*)(Ab + ks * 16);
      const bf16x8 a1 = *(const bf16x8*)(Ab + 32 * LDT + ks * 16);
      const bf16x8 b = *(const bf16x8*)(Bb + ks * 16);
      acc[0] = mfma(a0, b, acc[0]);
      acc[1] = mfma(a1, b, acc[1]);
    }
    if (kt + 1 < nk) {
      u16* Aw = As + (buf ^ 1) * TILE_ELEMS;
      u16* Bw = Bs + (buf ^ 1) * TILE_ELEMS;
#pragma unroll
      for (int i = 0; i < 2; ++i) {
        const int c = tid + NTH * i;
        *(u32x4*)(Aw + A_ROW(c) * LDT + A_KC(c) * 8) = ra[i];
        *(u32x4*)(Bw + B_ROW(c) * LDT + B_KC(c) * 8) = rb[i];
      }
    }
    __syncthreads();
  }
  epi(acc, wm, wn, lane);
}

template <bool RFA, bool RFB, class LA, class LB, class EPI>
DI void gemm_tile2s(u16* smem, int nk, LA la, LB lb, EPI epi) {
  const int tid = tidx(), lane = tid & 63, wave = tid >> 6;
  const int wm = wave >> 2, wn = wave & 3, lr = lane & 31, lh = lane >> 5;
  u16* As = smem;
  u16* Bs = smem + 2 * TILE_ELEMS;
  f32x16 acc[2];
  acc[0] = zero16(); acc[1] = zero16();
  u32x4 ra0[2], rb0[2], ra1[2], rb1[2];
  auto ld = [&](u32x4 (&ra)[2], u32x4 (&rb)[2], int kt) __attribute__((always_inline)) {
    const int k0 = kt * 64;
#pragma unroll
    for (int i = 0; i < 2; ++i) { const int c = tid + NTH * i; ra[i] = la(A_ROW(c), k0 + A_KC(c) * 8); rb[i] = lb(B_ROW(c), k0 + B_KC(c) * 8); }
  };
  auto stl = [&](u32x4 (&ra)[2], u32x4 (&rb)[2], int buf) __attribute__((always_inline)) {
#pragma unroll
    for (int i = 0; i < 2; ++i) {
      const int c = tid + NTH * i;
      *(u32x4*)(As + buf * TILE_ELEMS + A_ROW(c) * LDT + A_KC(c) * 8) = ra[i];
      *(u32x4*)(Bs + buf * TILE_ELEMS + B_ROW(c) * LDT + B_KC(c) * 8) = rb[i];
    }
  };
  auto compute = [&](int buf) __attribute__((always_inline)) {
    const u16* Ab = As + buf * TILE_ELEMS + (wm * 64 + lr) * LDT + lh * 8;
    const u16* Bb = Bs + buf * TILE_ELEMS + (wn * 32 + lr) * LDT + lh * 8;
#pragma unroll
    for (int ks = 0; ks < 4; ++ks) {
      const bf16x8 a0 = *(const bf16x8*)(Ab + ks * 16);
      const bf16x8 a1 = *(const bf16x8*)(Ab + 32 * LDT + ks * 16);
      const bf16x8 b = *(const bf16x8*)(Bb + ks * 16);
      acc[0] = mfma(a0, b, acc[0]);
      acc[1] = mfma(a1, b, acc[1]);
    }
  };
  ld(ra0, rb0, 0);
  if (nk > 1) ld(ra1, rb1, 1);
  stl(ra0, rb0, 0);
  if (nk > 2) ld(ra0, rb0, 2);
  __syncthreads();
#pragma unroll 1
  for (int kt = 0; kt < nk; kt += 2) {
    compute(0);
    if (kt + 1 < nk) { stl(ra1, rb1, 1); if (kt + 3 < nk) ld(ra1, rb1, kt + 3); }
    __syncthreads();
    if (kt + 1 < nk) {
      compute(1);
      if (kt + 2 < nk) { stl(ra0, rb0, 0); if (kt + 4 < nk) ld(ra0, rb0, kt + 4); }
      __syncthreads();
    }
  }
  epi(acc, wm, wn, lane);
}

DI void stage_rc(int b, int& R, int& C) { int st = b / 1024, sb = b % 1024, swz = sb ^ (((sb >> 9) & 1) << 5); R = (st >> 1) * 16 + swz / 64; C = (st & 1) * 32 + (swz % 64) / 2; }

DI int perm32(int rho) { const int n = rho >> 4, i = rho & 15; return 8 * (i >> 2) + 4 * n + (i & 3); }

template <bool PERM, class EPI>
DI void gemm256(LAS u16* shm, const u16* __restrict__ A, const u16* __restrict__ Bt, int K, int brow, int bcol, bool pre, bool has_next, int nbrow, int nbcol, EPI epi) {
#define SA(b, h) (shm + ((b) * 2 + (h)) * HT)
#define SB(b, h) (shm + (4 + (b) * 2 + (h)) * HT)
  const int tid = tidx();
  const int wid = __builtin_amdgcn_readfirstlane(tid >> 6), lane = tid & 63, wr = wid >> 2, wc = wid & 3, fr = lane & 15, fq = lane >> 4;
  int r0, c0, r1, c1;
  stage_rc(tid * 16, r0, c0);
  stage_rc(tid * 16 + 8192, r1, c1);
  const int ra0 = PERM ? ((r0 & ~31) + perm32(r0 & 31)) : r0, ra1 = PERM ? ((r1 & ~31) + perm32(r1 & 31)) : r1;
  const unsigned so0 = (unsigned)(ra0 * K + c0) * 2u, so1 = (unsigned)(ra1 * K + c1) * 2u;
  const unsigned sb0 = (unsigned)(r0 * K + c0) * 2u, sb1 = (unsigned)(r1 * K + c1) * 2u;
  const unsigned ldsw = (unsigned)wid * 1024u;
  const int lb = ((fr * 64 + fq * 16) ^ ((fr >> 3) << 5));
#define STAGE_(P, BASE, br, kt, O0, O1) do { const char* _g = (const char*)((BASE) + (size_t)(br) * K + (kt) * 64); \
    __builtin_amdgcn_global_load_lds((const unsigned*)(_g + O0), (LAS unsigned*)((LAS char*)(P) + ldsw), 16, 0, 0); \
    __builtin_amdgcn_global_load_lds((const unsigned*)(_g + O1), (LAS unsigned*)((LAS char*)(P) + ldsw + 8192), 16, 0, 0); } while (0)
#define STAGEA(P, br, kt) STAGE_(P, A, br, kt, so0, so1)
#define STAGEB(P, br, kt) STAGE_(P, Bt, br, kt, sb0, sb1)
#define LDA(dst, b, h) _Pragma("unroll") for (int m = 0; m < 4; ++m) _Pragma("unroll") for (int k = 0; k < 2; ++k) \
    dst[m][k] = *(const LAS bf16x8*)((const LAS char*)SA(b, h) + ((wr * 4 + m) * 2 + k) * 1024 + lb)
#define LDB(dst, b, h) _Pragma("unroll") for (int n = 0; n < 2; ++n) _Pragma("unroll") for (int k = 0; k < 2; ++k) \
    dst[n][k] = *(const LAS bf16x8*)((const LAS char*)SB(b, h) + ((wc * 2 + n) * 2 + k) * 1024 + lb)
#define MMA(ai, bj, At_, Bt_) do { __builtin_amdgcn_s_setprio(1); \
    _Pragma("unroll") for (int m = 0; m < 4; ++m) _Pragma("unroll") for (int n = 0; n < 2; ++n) _Pragma("unroll") for (int k = 0; k < 2; ++k) \
      acc[ai][bj][m][n] = __builtin_amdgcn_mfma_f32_16x16x32_bf16(At_[m][k], Bt_[n][k], acc[ai][bj][m][n], 0, 0, 0); \
    __builtin_amdgcn_s_setprio(0); } while (0)
#define WAIT_V(n) asm volatile("s_waitcnt vmcnt(" #n ")" ::: "memory")
#define WAIT_L(n) asm volatile("s_waitcnt lgkmcnt(" #n ")" ::: "memory")
#define BAR __builtin_amdgcn_s_barrier()
#define SCHED __builtin_amdgcn_sched_barrier(0)
  f32x4 acc[2][2][4][2];
#pragma unroll
  for (int a = 0; a < 2; ++a)
#pragma unroll
    for (int b = 0; b < 2; ++b)
#pragma unroll
      for (int m = 0; m < 4; ++m)
#pragma unroll
        for (int n = 0; n < 2; ++n) { acc[a][b][m][n][0] = 0.f; acc[a][b][m][n][1] = 0.f; acc[a][b][m][n][2] = 0.f; acc[a][b][m][n][3] = 0.f; }
  bf16x8 At[4][2], B0[2][2], B1[2][2];
  const int nt = K / 64;
  if (!pre) {
    STAGEB(SB(0, 0), bcol, 0); STAGEA(SA(0, 0), brow, 0);
    STAGEB(SB(0, 1), bcol + 128, 0); STAGEA(SA(0, 1), brow + 128, 0);
  }
  if (wr == 1) BAR;
  WAIT_V(4); BAR;
  STAGEB(SB(1, 0), bcol, 1); STAGEA(SA(1, 0), brow, 1); STAGEB(SB(1, 1), bcol + 128, 1);
  WAIT_V(6); BAR;
  for (int t = 0; t < nt - 2; t += 2) {
    LDB(B0, 0, 0); SCHED; LDA(At, 0, 0); STAGEA(SA(1, 1), brow + 128, t + 1);
    WAIT_L(8); BAR; WAIT_L(0); MMA(0, 0, At, B0); BAR; SCHED;
    LDB(B1, 0, 1); STAGEB(SB(0, 0), bcol, t + 2);
    BAR; WAIT_L(0); MMA(0, 1, At, B1); BAR;
    LDA(At, 0, 1); STAGEA(SA(0, 0), brow, t + 2);
    BAR; WAIT_L(0); MMA(1, 0, At, B0); BAR; SCHED;
    STAGEB(SB(0, 1), bcol + 128, t + 2);
    WAIT_V(6); BAR; MMA(1, 1, At, B1); BAR;
    LDB(B0, 1, 0); SCHED; LDA(At, 1, 0); STAGEA(SA(0, 1), brow + 128, t + 2);
    WAIT_L(8); BAR; WAIT_L(0); MMA(0, 0, At, B0); BAR; SCHED;
    LDB(B1, 1, 1); STAGEB(SB(1, 0), bcol, t + 3);
    BAR; WAIT_L(0); MMA(0, 1, At, B1); BAR;
    LDA(At, 1, 1); STAGEA(SA(1, 0), brow, t + 3);
    BAR; WAIT_L(0); MMA(1, 0, At, B0); BAR; SCHED;
    STAGEB(SB(1, 1), bcol + 128, t + 3);
    WAIT_V(6); BAR; MMA(1, 1, At, B1); BAR;
  }
  { LDB(B0, 0, 0); LDA(At, 0, 0); STAGEA(SA(1, 1), brow + 128, nt - 1);
    BAR; WAIT_L(0); MMA(0, 0, At, B0); BAR;
    LDB(B1, 0, 1); BAR; WAIT_L(0); MMA(0, 1, At, B1); BAR;
    LDA(At, 0, 1); WAIT_V(4); BAR; WAIT_L(0); MMA(1, 0, At, B0); MMA(1, 1, At, B1); BAR; }
  { LDB(B0, 1, 0); LDA(At, 1, 0); WAIT_V(2); BAR; WAIT_L(0); MMA(0, 0, At, B0); BAR;
    LDB(B1, 1, 1); WAIT_V(0); BAR; WAIT_L(0); MMA(0, 1, At, B1); BAR;
    LDA(At, 1, 1); BAR; WAIT_L(0); MMA(1, 0, At, B0); MMA(1, 1, At, B1); BAR; }
  if (wr == 0) BAR;
  if (has_next) {
    STAGEB(SB(0, 0), nbcol, 0); STAGEA(SA(0, 0), nbrow, 0);
    STAGEB(SB(0, 1), nbcol + 128, 0); STAGEA(SA(0, 1), nbrow + 128, 0);
  }
  epi(acc, wr, wc, fr, fq);
  __syncthreads();
}

DI void map256(int t, int nN, int& tn, int& tm) {
  const int p = (t >> 8) * 8 + (t & 7), i = (t >> 3) & 31, pr = nN >> 2;
  const int pm = p / pr;
  tn = ((p + pm) % pr) * 4 + (i & 3);
  tm = pm * 8 + (i >> 2);
}

DI int condrow(int sb, int tok) { return sb == 0 ? 0 : 1 + (sb - 1) * 8 + (tok >> 11); }

DI void convT(float* tile, const float* src, int lds_, int K, int N, u16* dst, int ldd, const float* ksc, int& base) {
  const int tid = tidx();
  const int ntn = (N + 63) >> 6, nt = (K >> 6) * ntn;
  const int kk = tid >> 4, n4 = (tid & 15) * 4;
  float4 cur[2], nxt[2];
  auto ld = [&](float4 (&v)[2], int t) __attribute__((always_inline)) {
    const int tn = t % ntn, tk = t / ntn, k0 = tk * 64, n0 = tn * 64;
#pragma unroll
    for (int e = 0; e < 2; ++e) {
      v[e] = make_float4(0.f, 0.f, 0.f, 0.f);
      if (n0 + n4 < N) v[e] = *(const float4*)(src + (size_t)(k0 + kk + 32 * e) * lds_ + n0 + n4);
    }
  };
  int t = (int)((blockIdx.x + gridDim.x - ((unsigned)base % gridDim.x)) % gridDim.x);
  if (t < nt) ld(cur, t);
  for (; t < nt; t += gridDim.x) {
    const int tnx = t + (int)gridDim.x;
    if (tnx < nt) ld(nxt, tnx);
    const int tn = t % ntn, tk = t / ntn, k0 = tk * 64, n0 = tn * 64;
#pragma unroll
    for (int e = 0; e < 2; ++e) {
      float4 v = cur[e];
      if (ksc) { const float sc = ksc[k0 + kk + 32 * e]; v.x *= sc; v.y *= sc; v.z *= sc; v.w *= sc; }
      float* tp = tile + (kk + 32 * e) * 65 + n4;
      tp[0] = v.x; tp[1] = v.y; tp[2] = v.z; tp[3] = v.w;
    }
    __syncthreads();
#pragma unroll 4
    for (int e = 0; e < 4; ++e) {
      const int idx = tid + NTH * e, nn = idx >> 5, kp = idx & 31;
      if (n0 + nn < N)
        *(unsigned*)(dst + (size_t)(n0 + nn) * ldd + k0 + 2 * kp) = pack2(tile[(2 * kp) * 65 + nn], tile[(2 * kp + 1) * 65 + nn]);
    }
    __syncthreads();
    cur[0] = nxt[0]; cur[1] = nxt[1];
  }
  base += nt;
}

DI void prologue_a(const Prm& p, unsigned char* smem_raw, int& base) {
  float* smf = (float*)smem_raw;
  const int tid = tidx();
  const int gtid = blockIdx.x * NTH + tid, gn = gridDim.x * NTH;
  for (int l = 0; l < 4; ++l) {
    convT(smf, p.w_in + (size_t)l * 1024 * 7520 + 768, 7520, 1024, 6752, p.WinT + ((size_t)l * NWP + 1536) * 1024, 1024, nullptr, base);
    convT(smf, p.w1 + (size_t)l * 1024 * 4096, 4096, 1024, 4096, p.W1T + (size_t)l * 4096 * 1024, 1024, nullptr, base);
    convT(smf, p.w2 + (size_t)l * 4096 * 1024, 1024, 4096, 1024, p.W2T + (size_t)l * 1024 * 4096, 4096, nullptr, base);
    convT(smf, p.w_o + (size_t)l * 1024 * 1024, 1024, 1024, 1024, p.WoT + (size_t)l * 1024 * 1024, 1024, nullptr, base);
    convT(smf, p.p_a + (size_t)l * 768 * 1024, 1024, 768, 1024, p.PaT + (size_t)l * 1024 * 768, 768, nullptr, base);
    convT(smf, p.p_b + (size_t)l * 128 * 1024, 1024, 128, 1024, p.PbT + (size_t)l * 1024 * 128, 128, nullptr, base);
    convT(smf, p.p_c + (size_t)l * 384 * 1024, 1024, 384, 1024, p.PcT + (size_t)l * 1024 * 384, 384, nullptr, base);
    convT(smf, p.p_d + (size_t)l * 256 * 1024, 1024, 256, 1024, p.PdT + (size_t)l * 1024 * 256, 256, nullptr, base);
    convT(smf, p.w_uq + (size_t)l * 384 * 384, 384, 384, 384, p.WqT + (size_t)l * 384 * 384, 384, p.qn_g + l * 384, base);
    convT(smf, p.w_ukv + (size_t)l * 320 * 512, 512, 320, 512, p.WkvT + (size_t)l * 512 * 320, 320, p.kvn_g + l * 320, base);
  }
  {
    float* tab = (float*)(smem_raw + GEMM_SMEM + 1024);
    if (tid < 192) {
      float sn, cs;
      sincospif(2.f * (float)tid / 192.f, &sn, &cs);
      tab[tid] = cs; tab[192 + tid] = sn;
    }
    __syncthreads();
    u16* smem = (u16*)smem_raw;
    TASK_LOOP(t, 384, base) {
      const int kt = t & 7, rt = (t >> 3) % 3, g = (t / 24) & 3, l = t / 96;
      auto la = [&](int row, int k) __attribute__((always_inline)) {
        const int rr = rt * 128 + row, part = rr >= 192 ? 1 : 0, j = rr - part * 192;
        const float* tp = tab + part * 192;
        const float sg = part ? -1.f : 1.f;
        int m = (j * k) % 192;
        u32x4 o;
#pragma unroll
        for (int jj = 0; jj < 4; ++jj) {
          const float v0 = tp[m] * sg; m += j; if (m >= 192) m -= 192;
          const float v1 = tp[m] * sg; m += j; if (m >= 192) m -= 192;
          o[jj] = pack2(v0, v1);
        }
        return o;
      };
      auto lb = [&](int row, int k) __attribute__((always_inline)) {
        const float* src = p.w_in + ((size_t)l * 1024 + kt * 128 + row) * 7520 + g * 192 + k;
        const float4 a = *(const float4*)src, b = *(const float4*)(src + 4);
        u32x4 o;
        o[0] = pack2(a.x, a.y); o[1] = pack2(a.z, a.w); o[2] = pack2(b.x, b.y); o[3] = pack2(b.z, b.w);
        return o;
      };
      auto epi = [&](f32x16 (&acc)[2], int wm, int wn, int lane) __attribute__((always_inline)) {
        const int lr = lane & 31, lh = lane >> 5;
        const int kcol = kt * 128 + wn * 32 + lr;
#pragma unroll
        for (int i = 0; i < 2; ++i)
#pragma unroll
          for (int r = 0; r < 16; ++r) {
            const int rr = rt * 128 + wm * 64 + i * 32 + rowmap(r, lh), part = rr >= 192 ? 1 : 0, j = rr - part * 192;
            p.WinT[((size_t)l * NWP + part * 768 + g * 192 + j) * 1024 + kcol] = f2bf(acc[i][r]);
          }
      };
      gemm_tile<false, false>(smem, 3, la, lb, epi);
    }
    base += 384;
  }
  {
    float* sil = smf;
    TASK_LOOP(t, 384, base) {
      const int kc = t & 7, cb = (t >> 3) % 12, l = t / 96, k0 = kc * 128;
      for (int idx = tid; idx < 17 * 128; idx += NTH) {
        const int r = idx >> 7, kk = idx & 127;
        const float c = r == 0 ? p.c_prompt[k0 + kk] : p.c_sample[(r - 1) * 1024 + k0 + kk];
        sil[idx] = c / (1.f + __expf(-c));
      }
      __syncthreads();
      const int n = cb * 512 + tid;
      float acc[17];
#pragma unroll
      for (int r = 0; r < 17; ++r) acc[r] = 0.f;
      const float* wp = p.ada_w + ((size_t)l * 1024 + k0) * 6144 + n;
#pragma unroll 1
      for (int kb = 0; kb < 128; kb += 32) {
        float w[32];
#pragma unroll
        for (int i = 0; i < 32; ++i) w[i] = wp[(size_t)(kb + i) * 6144];
#pragma unroll
        for (int i = 0; i < 32; i += 4)
#pragma unroll
          for (int r = 0; r < 17; ++r) {
            const float4 sv = *(const float4*)(sil + r * 128 + kb + i);
            acc[r] += sv.x * w[i] + sv.y * w[i + 1] + sv.z * w[i + 2] + sv.w * w[i + 3];
          }
      }
#pragma unroll
      for (int r = 0; r < 17; ++r) p.modpart[((size_t)(kc * 4 + l) * 17 + r) * 6144 + n] = acc[r];
      __syncthreads();
    }
    base += 384;
  }
  for (int idx = gtid; idx < 4 * 32 * 1024; idx += gn) {
    const int l = idx >> 15, rem = idx & 32767;
    p.WinT[((size_t)l * NWP + NW) * 1024 + rem] = 0;
  }
  for (int idx = gtid; idx < 256 * 256; idx += gn) {
    const int row = idx >> 8, kk = idx & 255;
    const int po = row >> 7, k1 = row & 127, pi = kk >> 7, s1 = kk & 127;
    float s, c;
    sincospif(2.f * (float)((k1 * s1) & 127) / 128.f, &s, &c);
    const float v = (po == pi) ? c : (po == 0 ? s : -s);
    p.M1a[idx] = f2bf(v);
  }
  for (int idx = gtid; idx < 32 * 64; idx += gn) {
    const int row = idx >> 6, kk = idx & 63;
    const int po = row >> 4, k1 = row & 15, pi = (kk >> 4) & 1, s1 = kk & 15;
    float s, c;
    sincospif(2.f * (float)((k1 * s1) & 15) / 16.f, &s, &c);
    float v = (po == pi) ? c : (po == 0 ? s : -s);
    if (kk >= 32) v = 0.f;
    p.M1b[idx] = f2bf(v);
  }
  for (int idx = gtid; idx < 128 * 256; idx += gn) {
    const int k2 = idx >> 8, kk = idx & 255, part = kk >> 7, s2 = kk & 127;
    float s, c;
    sincospif(2.f * (float)((k2 * s2) & 127) / 128.f, &s, &c);
    p.M2[idx] = f2bf(part ? s : c);
  }
  for (int idx = gtid; idx < 16384; idx += gn) {
    float s, c;
    sincospif(2.f * (float)idx / 16384.f, &s, &c);
    p.tw[idx] = make_float2(c, s);
  }
  for (int idx = gtid; idx < 16384 * 16; idx += gn) {
    const int pos = idx >> 4, i = idx & 15;
    const float inv = (float)pow(10000.0, -(double)i / 16.0);
    const float ang = (float)pos * inv;
    double rev = (double)ang * 0.15915494309189535;
    rev -= rint(rev);
    float s, c;
    sincospif((float)(2.0 * rev), &s, &c);
    p.rope[idx] = make_float2(c, s);
  }
  for (int idx = gtid; idx < 6 * 129; idx += gn) {
    const int hd = idx / 129, rel = idx - hd * 129 - 64;
    const int dil = 1 << (2 * (hd >> 1));
    const int rd = rel * dil, n = rd < 0 ? -rd : rd;
    int b;
    if (n < 8) b = n;
    else if (n < 15) b = 8; else if (n < 27) b = 9; else if (n < 50) b = 10; else if (n < 91) b = 11;
    else if (n < 166) b = 12; else if (n < 305) b = 13; else if (n < 559) b = 14; else b = 15;
    if (rd > 0) b += 16;
    p.biasT[idx] = p.rel_bias[b * 6 + hd];
  }
  for (int idx = gtid; idx < 4 * 4 * 128 * 128; idx += gn) p.SgW[idx] = f2bf(p.sgu_w[idx]);
}

DI void prologue_b(const Prm& p) {
  const int gtid = blockIdx.x * NTH + tidx(), gn = gridDim.x * NTH;
  for (int idx = gtid; idx < 4 * 17 * 6144; idx += gn) {
    const int l = idx / (17 * 6144), n = idx % 6144;
    float s = p.ada_b[l * 6144 + n];
#pragma unroll
    for (int kc = 0; kc < 8; ++kc) s += p.modpart[(size_t)kc * 4 * 17 * 6144 + idx];
    p.mod[idx] = s;
  }
}

DI void phase_norm(const Prm& p, const float* xsrc, const float* g, const float* modl, int shoff, int scoff, int sb) {
  const int tid = tidx(), lane = tid & 63;
  const int gw = blockIdx.x * 8 + (tid >> 6), nw = gridDim.x * 8;
  for (int row = gw; row < TB; row += nw) {
    const int cond = condrow(sb, row);
    const float* xr = xsrc + (size_t)row * 1024;
    float4 v[4];
    float ss = 0.f;
#pragma unroll
    for (int i = 0; i < 4; ++i) {
      v[i] = *(const float4*)(xr + i * 256 + lane * 4);
      ss += v[i].x * v[i].x + v[i].y * v[i].y + v[i].z * v[i].z + v[i].w * v[i].w;
    }
#pragma unroll
    for (int off = 32; off >= 1; off >>= 1) ss += __shfl_xor(ss, off);
    const float rstd = rsqrtf(ss * (1.f / 1024.f) + 1e-6f);
    const float* sc = modl + cond * 6144 + scoff;
    const float* sh = modl + cond * 6144 + shoff;
#pragma unroll
    for (int i = 0; i < 4; ++i) {
      const int col = i * 256 + lane * 4;
      const float4 gg = *(const float4*)(g + col), s4 = *(const float4*)(sc + col), h4 = *(const float4*)(sh + col);
      st4bf(p.hbuf + (size_t)row * 1024 + col,
            v[i].x * rstd * gg.x * (1.f + s4.x) + h4.x, v[i].y * rstd * gg.y * (1.f + s4.y) + h4.y,
            v[i].z * rstd * gg.z * (1.f + s4.z) + h4.z, v[i].w * rstd * gg.w * (1.f + s4.w) + h4.w);
    }
  }
}

DI float sigm(float x) { return __builtin_amdgcn_rcpf(1.f + __expf(-x)); }

DI void phase_inproj(const Prm& p, unsigned char* smem_raw, int l, int S, int& base) {
  const u16* W = p.WinT + (size_t)l * NWP * 1024;
  LAS u16* shm = (LAS u16*)smem_raw;
  bool pre = false;
  TASK_LOOP(t, 32 * 64, base) {
    int tn, tm;
    map256(t, 32, tn, tm);
    const int brow = tn * 256, bcol = tm * 256;
    const int tnx = t + (int)gridDim.x;
    const bool has_next = tnx < (32 * 64);
    int tn2 = 0, tm2 = 0;
    if (has_next) map256(tnx, 32, tn2, tm2);
    const int nbrow = tn2 * 256, nbcol = tm2 * 256;
    const bool hn = has_next && ((tn2 != 16) == (tn != 16));
    auto epi = [&](f32x4 (&acc)[2][2][4][2], int wr, int wc, int fr, int fq) __attribute__((always_inline)) {
#pragma unroll
      for (int ai = 0; ai < 2; ++ai)
#pragma unroll
        for (int m = 0; m < 4; ++m) {
          const int nb = brow + ai * 128 + wr * 64 + m * 16;
#pragma unroll
          for (int bj = 0; bj < 2; ++bj)
#pragma unroll
            for (int n = 0; n < 2; ++n) {
              const int tok = bcol + bj * 128 + wc * 32 + n * 16 + fr;
              const f32x4 v = acc[ai][bj][m][n];
              const int nn = nb + fq * 4;
              if (nb < 1536) {
#pragma unroll
                for (int j = 0; j < 4; ++j) p.UT[(size_t)(nn + j) * TBP + tok] = f2bf(v[j]);
              } else if (nb < 2688) {
                st4bf(p.bqkv + (size_t)tok * 1152 + (nn - 1536), v[0], v[1], v[2], v[3]);
              } else if (nb < 3072) {
                st4bf(p.cu + (size_t)tok * 384 + (nn - 2688), v[0], v[1], v[2], v[3]);
              } else if (nb < 3456) {
#pragma unroll
                for (int j = 0; j < 4; ++j) p.cvT[(size_t)(nn - 3072 + j) * TBP + tok] = f2bf(v[j]);
              } else if (nb < 3840) {
                st4bf(p.dcq + (size_t)tok * 384 + (nn - 3456), v[0], v[1], v[2], v[3]);
              } else if (nb < 4160) {
                st4bf(p.dckv + (size_t)tok * 320 + (nn - 3840), v[0], v[1], v[2], v[3]);
              } else if (nb < 4192) {
                if (nb == 4160) {
                  const f32x4 v2 = acc[ai][bj][(m + 1) & 3][n];
                  const int pos = tok & (S - 1);
#pragma unroll
                  for (int j = 0; j < 4; ++j) {
                    const int ii = fq * 4 + j;
                    const float2 cs = p.rope[pos * 16 + ii];
                    const u16 o1 = f2bf(v[j] * cs.x - v2[j] * cs.y), o2 = f2bf(v[j] * cs.y + v2[j] * cs.x);
#pragma unroll
                    for (int hh = 0; hh < 4; ++hh) {
                      p.kc[(size_t)tok * 384 + hh * 96 + 64 + ii] = o1;
                      p.kc[(size_t)tok * 384 + hh * 96 + 80 + ii] = o2;
                    }
                  }
                }
              } else {
                st4bf_nt(p.zg + (size_t)tok * 4096 + (nn - 4192), sigm(v[0]), sigm(v[1]), sigm(v[2]), sigm(v[3]));
              }
            }
          __builtin_amdgcn_sched_barrier(0);
        }
    };
    if (tn != 16) {
      auto epi_p = [&](f32x4 (&acc)[2][2][4][2], int wr, int wc, int fr, int fq) __attribute__((always_inline)) {
#pragma unroll
        for (int ai = 0; ai < 2; ++ai)
#pragma unroll
          for (int mp = 0; mp < 2; ++mp) {
            const int nb = brow + ai * 128 + wr * 64 + mp * 32;
            const int nn = nb + fq * 8;
#pragma unroll
            for (int bj = 0; bj < 2; ++bj)
#pragma unroll
              for (int n = 0; n < 2; ++n) {
                const int tok = bcol + bj * 128 + wc * 32 + n * 16 + fr;
                const f32x4 v = acc[ai][bj][2 * mp][n], w = acc[ai][bj][2 * mp + 1][n];
                if (nb < 1536) {
#pragma unroll
                  for (int j = 0; j < 4; ++j) { p.UT[(size_t)(nn + j) * TBP + tok] = f2bf(v[j]); p.UT[(size_t)(nn + 4 + j) * TBP + tok] = f2bf(w[j]); }
                } else if (nb < 2688) {
                  st8bf(p.bqkv + (size_t)tok * 1152 + (nn - 1536), v, w);
                } else if (nb < 3072) {
                  st8bf(p.cu + (size_t)tok * 384 + (nn - 2688), v, w);
                } else if (nb < 3456) {
#pragma unroll
                  for (int j = 0; j < 4; ++j) { p.cvT[(size_t)(nn - 3072 + j) * TBP + tok] = f2bf(v[j]); p.cvT[(size_t)(nn - 3072 + 4 + j) * TBP + tok] = f2bf(w[j]); }
                } else if (nb < 3840) {
                  st8bf(p.dcq + (size_t)tok * 384 + (nn - 3456), v, w);
                } else if (nb < 4160) {
                  st8bf(p.dckv + (size_t)tok * 320 + (nn - 3840), v, w);
                } else {
                  u32x4 o;
                  o[0] = pack2(sigm(v[0]), sigm(v[1])); o[1] = pack2(sigm(v[2]), sigm(v[3]));
                  o[2] = pack2(sigm(w[0]), sigm(w[1])); o[3] = pack2(sigm(w[2]), sigm(w[3]));
                  __builtin_nontemporal_store(o, (u32x4*)(p.zg + (size_t)tok * 4096 + (nn - 4192)));
                }
              }
            __builtin_amdgcn_sched_barrier(0);
          }
      };
      gemm256<true>(shm, W, p.hbuf, 1024, brow, bcol, pre, hn, nbrow, nbcol, epi_p);
    } else {
      gemm256<false>(shm, W, p.hbuf, 1024, brow, bcol, pre, hn, nbrow, nbcol, epi);
    }
    pre = hn;
  }
  base += 32 * 64;
}

DI void phase_inproj_tail(const Prm& p, unsigned char* smem_raw, int l, int& base) {
  const u16* W = p.WinT + (size_t)l * NWP * 1024;
  u16* smem = (u16*)smem_raw;
  TASK_LOOP(t, 128, base) {
    const int n0 = 8192, m0 = t * 128;
    auto la = [&](int row, int k) __attribute__((always_inline)) { return *(const u32x4*)(W + (size_t)(n0 + row) * 1024 + k); };
    auto lb = [&](int row, int k) __attribute__((always_inline)) { return *(const u32x4*)(p.hbuf + (size_t)(m0 + row) * 1024 + k); };
    auto epi = [&](f32x16 (&acc)[2], int wm, int wn, int lane) __attribute__((always_inline)) {
      const int lr = lane & 31, lh = lane >> 5;
      const int tok = m0 + wn * 32 + lr;
#pragma unroll
      for (int i = 0; i < 2; ++i) {
        const int nb = n0 + wm * 64 + i * 32;
        if (nb >= NW) continue;
#pragma unroll
        for (int q = 0; q < 4; ++q)
          st4bf(p.zg + (size_t)tok * 4096 + (nb - 4192) + 8 * q + 4 * lh, sigm(acc[i][4 * q]), sigm(acc[i][4 * q + 1]), sigm(acc[i][4 * q + 2]),
                sigm(acc[i][4 * q + 3]));
      }
    };
    gemm_tile2s<false, false>(smem, 16, la, lb, epi);
  }
  base += 128;
}


DI void phase_inproj_probe(const Prm& p, unsigned char* smem_raw, int l, int& base) {
  const u16* W = p.WinT + (size_t)l * NWP * 1024;
  LAS u16* shm = (LAS u16*)smem_raw;
  bool pre = false;
  TASK_LOOP(t, 32 * 64, base) {
    int tn, tm;
    map256(t, 32, tn, tm);
    const int brow = tn * 256, bcol = tm * 256;
    const int tnx = t + (int)gridDim.x;
    const bool has_next = tnx < (32 * 64);
    int tn2 = 0, tm2 = 0;
    if (has_next) map256(tnx, 32, tn2, tm2);
    const int nbrow = tn2 * 256, nbcol = tm2 * 256;
    auto epi = [&](f32x4 (&acc)[2][2][4][2], int wr, int wc, int fr, int fq) __attribute__((always_inline)) {
#pragma unroll
      for (int bj = 0; bj < 2; ++bj)
#pragma unroll
        for (int n = 0; n < 2; ++n) {
          const int tok = bcol + bj * 128 + wc * 32 + n * 16 + fr;
#pragma unroll
          for (int ai = 0; ai < 2; ++ai)
#pragma unroll
            for (int m = 0; m < 4; ++m) {
              const int nn = ((brow + ai * 128 + wr * 64 + m * 16) & 1023) + fq * 4;
              const f32x4 v = acc[ai][bj][m][n];
              st4bf(p.Gp + (size_t)tok * 1024 + nn, v[0], v[1], v[2], v[3]);
            }
        }
    };
    gemm256<false>(shm, W, p.hbuf, 1024, brow, bcol, pre, has_next, nbrow, nbcol, epi);
    pre = has_next;
  }
  base += 32 * 64;
}

DI void phase_fft1(const Prm& p, u16* smem, int S, int nseq, int N1, int lgN1, int& base) {
  const int nkt = N1 == 128 ? 2 : 1;
  const u16* M1 = N1 == 128 ? p.M1a : p.M1b;
  const int ldm = N1 == 128 ? 256 : 64;
  const int nk = N1 == 128 ? 4 : 1;
  const int ntask = nseq * 768 * nkt;
  const int twmul = 16384 / S;
  TASK_LOOP(t, ntask, base) {
    const int k1t = t % nkt, col = (t / nkt) % 768, seq = t / (nkt * 768);
    const int k1base = k1t * 64;
    auto la = [&](int row, int k) __attribute__((always_inline)) {
      const int k1 = k1base + (row >> 6) * 32 + (row & 31), ii = (row >> 5) & 1;
      if (k1 >= N1 || k >= 2 * N1) return zero4();
      return *(const u32x4*)(M1 + (ii * N1 + k1) * ldm + k);
    };
    auto lb = [&](int row, int k) __attribute__((always_inline)) {
      if (k >= 2 * N1) return zero4();
      const int part = k >> lgN1, s1 = k & (N1 - 1);
      const u16* src = p.UT + (size_t)(part * 768 + col) * TBP + seq * S + s1 * 128 + row;
      u32x4 v;
#pragma unroll
      for (int jj = 0; jj < 4; ++jj) v[jj] = (unsigned)src[(2 * jj) * 128] | ((unsigned)src[(2 * jj + 1) * 128] << 16);
      return v;
    };
    auto epi = [&](f32x16 (&acc)[2], int wm, int wn, int lane) __attribute__((always_inline)) {
      const int lr = lane & 31, lh = lane >> 5;
      const int s2 = wn * 32 + lr;
#pragma unroll
      for (int r = 0; r < 16; ++r) {
        const int k1 = k1base + wm * 32 + rowmap(r, lh);
        if (k1 < N1) {
          const float re = acc[0][r], im = acc[1][r];
          const float2 cs = p.tw[(s2 * k1) * twmul];
          const size_t o = ((size_t)((seq * N1 + k1) * 2) * 768 + col) * 128 + s2;
          p.Gp[o] = f2bf(cs.x * re + cs.y * im);
          p.Gp[o + 768 * 128] = f2bf(cs.x * im - cs.y * re);
        }
      }
    };
    gemm_tile2s<false, true>(smem, nk, la, lb, epi);
  }
  base += ntask;
}


DI void phase_fft1_small(const Prm& p, int nseq) {
  constexpr float C16[16] = {1.f, 0.92387953251128674f, 0.70710678118654752f, 0.38268343236508977f, 0.f, -0.38268343236508977f, -0.70710678118654752f,
                             -0.92387953251128674f, -1.f, -0.92387953251128674f, -0.70710678118654752f, -0.38268343236508977f, 0.f,
                             0.38268343236508977f, 0.70710678118654752f, 0.92387953251128674f};
  constexpr float S16[16] = {0.f, 0.38268343236508977f, 0.70710678118654752f, 0.92387953251128674f, 1.f, 0.92387953251128674f, 0.70710678118654752f,
                             0.38268343236508977f, 0.f, -0.38268343236508977f, -0.70710678118654752f, -0.92387953251128674f, -1.f,
                             -0.92387953251128674f, -0.70710678118654752f, -0.38268343236508977f};
  const int gtid = blockIdx.x * NTH + tidx(), gn = gridDim.x * NTH;
  for (int idx = gtid; idx < nseq * 768 * 128; idx += gn) {
    const int s2 = idx & 127, col = (idx >> 7) % 768, seq = idx / (768 * 128);
    const u16* ur = p.UT + (size_t)col * TBP + seq * 2048 + s2;
    const u16* ui = ur + (size_t)768 * TBP;
    float xr[16], xi[16];
#pragma unroll
    for (int s1 = 0; s1 < 16; ++s1) { xr[s1] = bf2f(ur[s1 * 128]); xi[s1] = bf2f(ui[s1 * 128]); }
    u16* go = p.Gp + ((size_t)(seq * 16 * 2) * 768 + col) * 128 + s2;
#pragma unroll
    for (int k1 = 0; k1 < 16; ++k1) {
      float gr = 0.f, gi = 0.f;
#pragma unroll
      for (int s1 = 0; s1 < 16; ++s1) {
        const float c = C16[(k1 * s1) & 15], sn = S16[(k1 * s1) & 15];
        gr += c * xr[s1] + sn * xi[s1];
        gi += c * xi[s1] - sn * xr[s1];
      }
      const float2 cs = p.tw[(s2 * k1) * 8];
      go[(size_t)(k1 * 2) * 768 * 128] = f2bf(cs.x * gr + cs.y * gi);
      go[(size_t)(k1 * 2 + 1) * 768 * 128] = f2bf(cs.x * gi - cs.y * gr);
    }
  }
}

DI void phase_fft2(const Prm& p, u16* smem, int S, int nseq, int N1, int& base) {
  const int ntask = nseq * N1 * 6;
  const float scale = rsqrtf((float)S * 192.f);
  u16* fa = p.UT;
  TASK_LOOP(t, ntask, base) {
    const int ct = t % 6, k1 = (t / 6) % N1, seq = t / (6 * N1);
    const u16* gb = p.Gp + ((size_t)((seq * N1 + k1) * 2) * 768 + ct * 128) * 128;
    auto la = [&](int row, int k) __attribute__((always_inline)) {
      const int part = k >> 7, s2 = k & 127, col = (row & ~31) + perm_m(row & 31);
      return __builtin_nontemporal_load((const u32x4*)(gb + ((size_t)part * 768 + col) * 128 + s2));
    };
    auto lb = [&](int row, int k) __attribute__((always_inline)) { return *(const u32x4*)(p.M2 + row * 256 + k); };
    auto epi = [&](f32x16 (&acc)[2], int wm, int wn, int lane) __attribute__((always_inline)) {
      const int lr = lane & 31, lh = lane >> 5;
      const int k2 = wn * 32 + lr;
      const int tok = seq * S + k1 + N1 * k2;
#pragma unroll
      for (int i = 0; i < 2; ++i)
#pragma unroll
        for (int h2 = 0; h2 < 2; ++h2) {
          u32x4 o;
#pragma unroll
          for (int e = 0; e < 4; ++e) o[e] = pack2(acc[i][8 * h2 + 2 * e] * scale, acc[i][8 * h2 + 2 * e + 1] * scale);
          *(u32x4*)(fa + (size_t)tok * 768 + ct * 128 + wm * 64 + i * 32 + 16 * lh + 8 * h2) = o;
        }
    };
    gemm_tile2s<false, false>(smem, 4, la, lb, epi);
  }
  base += ntask;
}

DI void phase_mixc(const Prm& p, unsigned char* smem_raw, int l, int& base) {
  u16* smem = (u16*)smem_raw;
  float* st = (float*)(smem_raw + GEMM_SMEM);
  float* red = (float*)smem_raw;
  const int tid = tidx();
  TASK_LOOP(t, 512, base) {
    const int h = t & 3, ch = t >> 2, tok0 = ch * 128;
    {
      const int q = tid & 127, qf = tid >> 7;
      float s = 0.f, ss = 0.f;
      const u16* src = p.cvT + (size_t)(qf * 96) * TBP + tok0 + q;
      for (int c = 0; c < 96; ++c) { const float v = bf2f(src[(size_t)c * TBP]); s += v; ss += v * v; }
      red[qf * 256 + q * 2] = s; red[qf * 256 + q * 2 + 1] = ss;
      __syncthreads();
      if (tid < 128) {
        const float s1 = red[q * 2] + red[256 + q * 2] + red[512 + q * 2] + red[768 + q * 2];
        const float s2 = red[q * 2 + 1] + red[256 + q * 2 + 1] + red[512 + q * 2 + 1] + red[768 + q * 2 + 1];
        const float mu = s1 * (1.f / 384.f);
        const float var = fmaxf(s2 * (1.f / 384.f) - mu * mu, 0.f);
        st[q] = mu; st[128 + q] = rsqrtf(var + 1e-6f);
      }
      __syncthreads();
    }
    const u16* Wm = p.SgW + (size_t)((l * 4 + h) * 128) * 128;
    auto la = [&](int row, int k) __attribute__((always_inline)) { return *(const u32x4*)(Wm + row * 128 + k); };
    auto lb = [&](int row, int k) __attribute__((always_inline)) {
      if (row >= 96) return zero4();
      const int c = h * 96 + row;
      const u32x4 raw = *(const u32x4*)(p.cvT + (size_t)c * TBP + tok0 + k);
      const float g = p.ln_g[l * 384 + c], b = p.ln_b[l * 384 + c];
      u32x4 o;
#pragma unroll
      for (int jj = 0; jj < 4; ++jj) {
        const float v0 = (bflo(raw[jj]) - st[k + 2 * jj]) * st[128 + k + 2 * jj] * g + b;
        const float v1 = (bfhi(raw[jj]) - st[k + 2 * jj + 1]) * st[128 + k + 2 * jj + 1] * g + b;
        o[jj] = pack2(v0, v1);
      }
      return o;
    };
    auto epi = [&](f32x16 (&acc)[2], int wm, int wn, int lane) __attribute__((always_inline)) {
      const int lr = lane & 31, lh = lane >> 5;
      const int cl = wn * 32 + lr;
      if (cl < 96) {
#pragma unroll
        for (int i = 0; i < 2; ++i)
#pragma unroll
          for (int r = 0; r < 16; ++r) {
            const int pp = wm * 64 + i * 32 + rowmap(r, lh);
            const float val = acc[i][r] + p.sgu_b[(l * 4 + h) * 128 + pp];
            u16* dst = p.cu + (size_t)(tok0 + pp) * 384 + h * 96 + cl;
            *dst = f2bf(bf2f(*dst) * val);
          }
      }
    };
    gemm_tile<false, false>(smem, 2, la, lb, epi);
  }
  base += 512;
}

DI void phase_qup(const Prm& p, unsigned char* smem_raw, int l, int S, int& base) {
  u16* smem = (u16*)smem_raw;
  float* st = (float*)(smem_raw + GEMM_SMEM);
  const int tid = tidx();
  const float QS = 0.10206207261596577f * LOG2E;
  TASK_LOOP(t, 3 * 128, base) {
    const int tn = t % 3, tm = t / 3, n0 = tn * 128, m0 = tm * 128;
    {
      const int row = tid >> 2, qf = tid & 3;
      const u16* src = p.dcq + (size_t)(m0 + row) * 384 + qf * 96;
      float ss = 0.f;
#pragma unroll 4
      for (int c = 0; c < 12; ++c) {
        const u32x4 v = *(const u32x4*)(src + c * 8);
#pragma unroll
        for (int jj = 0; jj < 4; ++jj) { const float a = bflo(v[jj]), b = bfhi(v[jj]); ss += a * a + b * b; }
      }
      ss += __shfl_xor(ss, 1);
      ss += __shfl_xor(ss, 2);
      if (qf == 0) st[row] = rsqrtf(ss * (1.f / 384.f) + 1e-6f);
      __syncthreads();
    }
    const u16* W = p.WqT + (size_t)l * 384 * 384;
    auto la = [&](int row, int k) __attribute__((always_inline)) {
      const int g32 = row & ~31;
      const bool pe = ((n0 + g32) % 96) == 64;
      return *(const u32x4*)(W + (size_t)(n0 + g32 + (pe ? (row & 31) : perm_m(row & 31))) * 384 + k);
    };
    auto lb = [&](int row, int k) __attribute__((always_inline)) { return *(const u32x4*)(p.dcq + (size_t)(m0 + row) * 384 + k); };
    auto epi = [&](f32x16 (&acc)[2], int wm, int wn, int lane) __attribute__((always_inline)) {
      const int lr = lane & 31, lh = lane >> 5;
      const int tokl = wn * 32 + lr, tok = m0 + tokl;
      const float sc = st[tokl] * QS;
#pragma unroll
      for (int i = 0; i < 2; ++i) {
        const int nb = n0 + wm * 64 + i * 32;
        const int head = nb / 96, within = nb - head * 96;
        const f32x16& a = acc[i];
        if (within < 64) {
#pragma unroll
          for (int h2 = 0; h2 < 2; ++h2) {
            u32x4 o;
#pragma unroll
            for (int e = 0; e < 4; ++e) o[e] = pack2(a[8 * h2 + 2 * e] * sc, a[8 * h2 + 2 * e + 1] * sc);
            *(u32x4*)(p.qc + (size_t)tok * 384 + nb + 16 * lh + 8 * h2) = o;
          }
        } else {
          const int pos = tok & (S - 1);
#pragma unroll
          for (int q = 0; q < 2; ++q)
#pragma unroll
            for (int e = 0; e < 4; ++e) {
              const int r = 4 * q + e, ii = 8 * q + 4 * lh + e;
              const float2 cs = p.rope[pos * 16 + ii];
              const float x1 = a[r] * sc, x2 = a[r + 8] * sc;
              p.qc[(size_t)tok * 384 + head * 96 + 64 + ii] = f2bf(x1 * cs.x - x2 * cs.y);
              p.qc[(size_t)tok * 384 + head * 96 + 80 + ii] = f2bf(x1 * cs.y + x2 * cs.x);
            }
        }
      }
    };
    gemm_tile2s<false, false>(smem, 6, la, lb, epi);
    __syncthreads();
  }
  base += 3 * 128;
}

DI void phase_kvup(const Prm& p, unsigned char* smem_raw, int l, int& base) {
  u16* smem = (u16*)smem_raw;
  float* st = (float*)(smem_raw + GEMM_SMEM);
  const int tid = tidx();
  TASK_LOOP(t, 4 * 128, base) {
    const int tn = t & 3, tm = t >> 2, n0 = tn * 128, m0 = tm * 128;
    {
      const int row = tid >> 2, qf = tid & 3;
      const u16* src = p.dckv + (size_t)(m0 + row) * 320 + qf * 80;
      float ss = 0.f;
#pragma unroll 5
      for (int c = 0; c < 10; ++c) {
        const u32x4 v = *(const u32x4*)(src + c * 8);
#pragma unroll
        for (int jj = 0; jj < 4; ++jj) { const float a = bflo(v[jj]), b = bfhi(v[jj]); ss += a * a + b * b; }
      }
      ss += __shfl_xor(ss, 1);
      ss += __shfl_xor(ss, 2);
      if (qf == 0) st[row] = rsqrtf(ss * (1.f / 320.f) + 1e-6f);
      __syncthreads();
    }
    const u16* W = p.WkvT + (size_t)l * 512 * 320;
    auto la = [&](int row, int k) __attribute__((always_inline)) {
      const int g32 = row & ~31;
      return *(const u32x4*)(W + (size_t)(n0 + g32 + (g32 < 64 ? perm_m(row & 31) : (row & 31))) * 320 + k);
    };
    auto lb = [&](int row, int k) __attribute__((always_inline)) { return *(const u32x4*)(p.dckv + (size_t)(m0 + row) * 320 + k); };
    auto epi = [&](f32x16 (&acc)[2], int wm, int wn, int lane) __attribute__((always_inline)) {
      const int lr = lane & 31, lh = lane >> 5;
      const int head = tn;
      const int tokl = wn * 32 + lr, tok = m0 + tokl;
      const float sc = st[tokl];
#pragma unroll
      for (int i = 0; i < 2; ++i) {
        const int within = wm * 64 + i * 32;
        const f32x16& a = acc[i];
        if (within < 64) {
#pragma unroll
          for (int h2 = 0; h2 < 2; ++h2) {
            u32x4 o;
#pragma unroll
            for (int e = 0; e < 4; ++e) o[e] = pack2(a[8 * h2 + 2 * e] * sc, a[8 * h2 + 2 * e + 1] * sc);
            *(u32x4*)(p.kc + (size_t)tok * 384 + head * 96 + within + 16 * lh + 8 * h2) = o;
          }
        } else {
#pragma unroll
          for (int r = 0; r < 16; ++r)
            p.vT[(size_t)(head * 64 + within - 64 + rowmap(r, lh)) * TBP + tok] = f2bf(a[r] * sc);
        }
      }
    };
    gemm_tile2s<false, false>(smem, 5, la, lb, epi);
    __syncthreads();
  }
  base += 4 * 128;
}

DI void phase_mixb(const Prm& p, unsigned char* smem_raw, int S, int lgS, int& base) {
  float* bt = (float*)smem_raw;
  const int tid = tidx(), lane = tid & 63, wave = tid >> 6, lr = lane & 31, lh = lane >> 5;
  u16* vt = (u16*)(smem_raw + 3328) + wave * (64 * 40);
  for (int idx = tid; idx < 774; idx += NTH) bt[idx] = p.biasT[idx];
  __syncthreads();
  TASK_LOOP(t, 384, base) {
    const int wt = t * 8 + wave;
    const int hg = wt & 1, g = (wt >> 1) % 3, blk = wt / 6;
    const int seq = blk >> (lgS - 5), b_in = blk & ((S >> 5) - 1);
    const int lgd = 2 * g, L = S >> lgd;
    const int lgbpr = lgS - lgd - 5;
    const int res = b_in >> lgbpr, i0 = (b_in & ((1 << lgbpr) - 1)) << 5;
    const int tokbase = seq * S + res;
    const int hd = g * 2 + hg, hc = hd * 64;
    const int qi = i0 + lr;
    const int qtok = tokbase + (qi << lgd);
    bf16x8 qf[4];
#pragma unroll
    for (int ks = 0; ks < 4; ++ks) qf[ks] = *(const bf16x8*)(p.bqkv + (size_t)qtok * 1152 + hc + ks * 16 + lh * 8);
    f32x16 sc[5];
#pragma unroll
    for (int tt = 0; tt < 5; ++tt) {
      int ik = i0 - 64 + 32 * tt + lr;
      ik = min(max(ik, 0), L - 1);
      const u16* kp = p.bqkv + (size_t)(tokbase + (ik << lgd)) * 1152 + 384 + hc + lh * 8;
      sc[tt] = zero16();
#pragma unroll
      for (int ks = 0; ks < 4; ++ks) sc[tt] = mfma(*(const bf16x8*)(kp + ks * 16), qf[ks], sc[tt]);
    }
    float mx = -1e30f;
#pragma unroll
    for (int tt = 0; tt < 5; ++tt)
#pragma unroll
      for (int r = 0; r < 16; ++r) {
        const int ik = i0 - 64 + 32 * tt + rowmap(r, lh);
        const int rel = ik - qi;
        const bool valid = (rel >= -64) && (rel <= 64) && (ik >= 0) && (ik < L);
        const int bi = min(max(rel + 64, 0), 128);
        const float s = valid ? (sc[tt][r] * 0.125f + bt[hd * 129 + bi]) * LOG2E : -1e30f;
        sc[tt][r] = s;
        mx = fmaxf(mx, s);
      }
    mx = fmaxf(mx, __shfl_xor(mx, 32));
    float sum = 0.f;
#pragma unroll
    for (int tt = 0; tt < 5; ++tt)
#pragma unroll
      for (int r = 0; r < 16; ++r) {
        const float pv = ex2(sc[tt][r] - mx);
        sum += pv;
        sc[tt][r] = pv;
      }
    sum += __shfl_xor(sum, 32);
    f32x16 oacc[2];
    oacc[0] = zero16(); oacc[1] = zero16();
#pragma unroll
    for (int tt = 0; tt < 5; ++tt) {
#pragma unroll
      for (int e = 0; e < 4; ++e) {
        const int c = lane + 64 * e, key = c >> 3, dch = c & 7;
        int ik = i0 - 64 + 32 * tt + key;
        ik = min(max(ik, 0), L - 1);
        const u32x4 raw = *(const u32x4*)(p.bqkv + (size_t)(tokbase + (ik << lgd)) * 1152 + 768 + hc + dch * 8);
#pragma unroll
        for (int jj = 0; jj < 4; ++jj) {
          vt[(dch * 8 + 2 * jj) * 40 + key] = (u16)(raw[jj] & 0xffffu);
          vt[(dch * 8 + 2 * jj + 1) * 40 + key] = (u16)(raw[jj] >> 16);
        }
      }
      __syncthreads();
#pragma unroll
      for (int u = 0; u < 2; ++u) {
        u32x4 pk;
#pragma unroll
        for (int jj = 0; jj < 4; ++jj) pk[jj] = pack2(sc[tt][8 * u + 2 * jj], sc[tt][8 * u + 2 * jj + 1]);
        const bf16x8 pf = __builtin_bit_cast(bf16x8, pk);
#pragma unroll
        for (int dt = 0; dt < 2; ++dt) {
          const u16* vp = vt + (dt * 32 + lr) * 40 + 16 * u + 4 * lh;
          u32x4 vv;
          const u32x2 lo = *(const u32x2*)vp, hi = *(const u32x2*)(vp + 8);
          vv[0] = lo[0]; vv[1] = lo[1]; vv[2] = hi[0]; vv[3] = hi[1];
          oacc[dt] = mfma(__builtin_bit_cast(bf16x8, vv), pf, oacc[dt]);
        }
      }
      __syncthreads();
    }
    const float inv = 1.f / sum;
#pragma unroll
    for (int dt = 0; dt < 2; ++dt)
#pragma unroll
      for (int q = 0; q < 4; ++q) {
        float4 o;
        o.x = oacc[dt][4 * q] * inv; o.y = oacc[dt][4 * q + 1] * inv; o.z = oacc[dt][4 * q + 2] * inv; o.w = oacc[dt][4 * q + 3] * inv;
        *(float4*)(p.og + (size_t)qtok * 384 + hc + dt * 32 + 8 * q + 4 * lh) = o;
      }
    if (lh == 0) p.lse[(size_t)qtok * 6 + hd] = (mx + __log2f(sum)) * LN2;
  }
  base += 384;
  __syncthreads();
}

DI void phase_combb(const Prm& p) {
  const int gtid = blockIdx.x * NTH + tidx(), gn = gridDim.x * NTH;
  for (int idx = gtid; idx < TB * 32; idx += gn) {
    const int dq = idx & 15, hg = (idx >> 4) & 1, tok = idx >> 5;
    const float l0 = p.lse[(size_t)tok * 6 + hg], l1 = p.lse[(size_t)tok * 6 + 2 + hg], l2 = p.lse[(size_t)tok * 6 + 4 + hg];
    const float mx = fmaxf(l0, fmaxf(l1, l2));
    const float e0 = __expf(l0 - mx), e1 = __expf(l1 - mx), e2 = __expf(l2 - mx);
    const float inv = 1.f / (e0 + e1 + e2);
    const float4 a = *(const float4*)(p.og + (size_t)tok * 384 + hg * 64 + dq * 4);
    const float4 b = *(const float4*)(p.og + (size_t)tok * 384 + 128 + hg * 64 + dq * 4);
    const float4 c = *(const float4*)(p.og + (size_t)tok * 384 + 256 + hg * 64 + dq * 4);
    st4bf(p.ob + (size_t)tok * 128 + hg * 64 + dq * 4, (e0 * a.x + e1 * b.x + e2 * c.x) * inv, (e0 * a.y + e1 * b.y + e2 * c.y) * inv,
          (e0 * a.z + e1 * b.z + e2 * c.z) * inv, (e0 * a.w + e1 * b.w + e2 * c.w) * inv);
  }
}

constexpr int KS_ELEMS = 128 * 104, VS_ELEMS = 64 * 136;
DI void phase_mla(const Prm& p, unsigned char* smem_raw, int S, int lgS, int& base) {
  u16* Ks = (u16*)smem_raw;
  u16* Vs = Ks + 2 * KS_ELEMS;
  const int tid = tidx(), lane = tid & 63, wave = tid >> 6, lr = lane & 31, lh = lane >> 5;
  const int nkt = S >> 7;
  TASK_LOOP(t, 256, base) {
    const int head = t & 3, qb = t >> 2, tok0 = qb * 256;
    const int seqtok0 = (tok0 >> lgS) << lgS;
    const int qtok = tok0 + wave * 32 + lr;
    bf16x8 qf[6];
#pragma unroll
    for (int ks = 0; ks < 6; ++ks) qf[ks] = *(const bf16x8*)(p.qc + (size_t)qtok * 384 + head * 96 + ks * 16 + lh * 8);
    const u16* kbase = p.kc + (size_t)seqtok0 * 384 + head * 96;
    const u16* vbase = p.vT + (size_t)(head * 64) * TBP + seqtok0;
    u32x4 rk[3], rv[2];
    auto gload = [&](int kt) __attribute__((always_inline)) {
#pragma unroll
      for (int e = 0; e < 3; ++e) {
        const int c = tid + NTH * e, key = c / 12, dc = c - key * 12;
        rk[e] = *(const u32x4*)(kbase + (size_t)(kt * 128 + key) * 384 + dc * 8);
      }
#pragma unroll
      for (int e = 0; e < 2; ++e) {
        const int c = tid + NTH * e, d = c >> 4, kch = c & 15;
        rv[e] = *(const u32x4*)(vbase + (size_t)d * TBP + kt * 128 + kch * 8);
      }
    };
    auto sstore = [&](int buf) __attribute__((always_inline)) {
#pragma unroll
      for (int e = 0; e < 3; ++e) {
        const int c = tid + NTH * e, key = c / 12, dc = c - key * 12;
        *(u32x4*)(Ks + buf * KS_ELEMS + key * 104 + dc * 8) = rk[e];
      }
#pragma unroll
      for (int e = 0; e < 2; ++e) {
        const int c = tid + NTH * e, d = c >> 4, kch = c & 15;
        u16* vd = Vs + buf * VS_ELEMS + d * 136 + (kch >> 1) * 16 + (kch & 1) * 4;
        u32x2 lo, hi;
        lo[0] = rv[e][0]; lo[1] = rv[e][1]; hi[0] = rv[e][2]; hi[1] = rv[e][3];
        *(u32x2*)vd = lo;
        *(u32x2*)(vd + 8) = hi;
      }
    };
    float m = -1e30f;
    f32x2 lsum2 = {0.f, 0.f};
    f32x16 oacc[2];
    oacc[0] = zero16(); oacc[1] = zero16();
    gload(0);
    sstore(0);
    __syncthreads();
    for (int kt = 0; kt < nkt; ++kt) {
      const int buf = kt & 1;
      if (kt + 1 < nkt) gload(kt + 1);
      f32x16 s[4];
#pragma unroll
      for (int kk = 0; kk < 4; ++kk) s[kk] = zero16();
      {
        const u16* kp = Ks + buf * KS_ELEMS + lr * 104 + lh * 8;
        bf16x8 kf[4];
#pragma unroll
        for (int kk = 0; kk < 4; ++kk) kf[kk] = *(const bf16x8*)(kp + kk * 32 * 104);
#pragma unroll
        for (int ks = 0; ks < 6; ++ks) {
          bf16x8 kn[4];
          if (ks < 5) {
#pragma unroll
            for (int kk = 0; kk < 4; ++kk) kn[kk] = *(const bf16x8*)(kp + kk * 32 * 104 + (ks + 1) * 16);
          }
#pragma unroll
          for (int kk = 0; kk < 4; ++kk) s[kk] = mfma(kf[kk], qf[ks], s[kk]);
          if (ks < 5) {
#pragma unroll
            for (int kk = 0; kk < 4; ++kk) kf[kk] = kn[kk];
          }
        }
      }
      float mloc = -1e30f;
#pragma unroll
      for (int kk = 0; kk < 4; ++kk)
#pragma unroll
        for (int r = 0; r < 16; ++r) mloc = fmaxf(mloc, s[kk][r]);
      mloc = fmaxf(mloc, __shfl_xor(mloc, 32));
      const float mnew = fmaxf(m, mloc);
      const float alpha = ex2(m - mnew);
      m = mnew;
      lsum2 *= alpha;
      const f32x2 mn2 = {mnew, mnew};
#pragma unroll
      for (int kk = 0; kk < 4; ++kk)
#pragma unroll
        for (int r2 = 0; r2 < 8; ++r2) {
          f32x2 v = {s[kk][2 * r2], s[kk][2 * r2 + 1]};
          v = v - mn2;
          f32x2 pv;
          pv[0] = ex2(v[0]); pv[1] = ex2(v[1]);
          lsum2 += pv;
          s[kk][2 * r2] = pv[0]; s[kk][2 * r2 + 1] = pv[1];
        }
#pragma unroll
      for (int dt = 0; dt < 2; ++dt)
#pragma unroll
        for (int r = 0; r < 16; ++r) oacc[dt][r] *= alpha;
#pragma unroll
      for (int kk = 0; kk < 4; ++kk)
#pragma unroll
        for (int u = 0; u < 2; ++u) {
          u32x4 pk;
#pragma unroll
          for (int jj = 0; jj < 4; ++jj) pk[jj] = pack2(s[kk][8 * u + 2 * jj], s[kk][8 * u + 2 * jj + 1]);
          const bf16x8 pf = __builtin_bit_cast(bf16x8, pk);
#pragma unroll
          for (int dt = 0; dt < 2; ++dt) {
            const u16* vp = Vs + buf * VS_ELEMS + (dt * 32 + lr) * 136 + kk * 32 + 16 * u + 8 * lh;
            oacc[dt] = mfma(*(const bf16x8*)vp, pf, oacc[dt]);
          }
        }
      if (kt + 1 < nkt) sstore(buf ^ 1);
      __syncthreads();
    }
    float lsum = lsum2[0] + lsum2[1];
    lsum += __shfl_xor(lsum, 32);
    const float inv = 1.f / lsum;
#pragma unroll
    for (int dt = 0; dt < 2; ++dt)
#pragma unroll
      for (int q = 0; q < 4; ++q)
        st4bf(p.od + (size_t)qtok * 256 + head * 64 + dt * 32 + 8 * q + 4 * lh, oacc[dt][4 * q] * inv, oacc[dt][4 * q + 1] * inv,
              oacc[dt][4 * q + 2] * inv, oacc[dt][4 * q + 3] * inv);
  }
  base += 256;
}


template <class ACC>
DI void merge_branch(const Prm& p, u16* smem, const u16* W, const u16* X, int ld, int bi, int n0, int m0, ACC& macc) {
  auto la = [&](int row, int k) __attribute__((always_inline)) { return *(const u32x4*)(W + (size_t)(n0 + (row & ~31) + perm_m(row & 31)) * ld + k); };
  auto lb = [&](int row, int k) __attribute__((always_inline)) { return *(const u32x4*)(X + (size_t)(m0 + row) * ld + k); };
  auto epi = [&](f32x16 (&acc)[2], int wm, int wn, int lane) __attribute__((always_inline)) {
    const int lr = lane & 31, lh = lane >> 5;
    const int tok = m0 + wn * 32 + lr;
#pragma unroll
    for (int i = 0; i < 2; ++i)
#pragma unroll
      for (int h2 = 0; h2 < 2; ++h2) {
        const int n = n0 + wm * 64 + i * 32 + 16 * lh + 8 * h2;
        const u32x4 gz = *(const u32x4*)(p.zg + (size_t)tok * 4096 + bi * 1024 + n);
#pragma unroll
        for (int e = 0; e < 4; ++e) {
          macc[i][8 * h2 + 2 * e] += bflo(gz[e]) * acc[i][8 * h2 + 2 * e];
          macc[i][8 * h2 + 2 * e + 1] += bfhi(gz[e]) * acc[i][8 * h2 + 2 * e + 1];
        }
      }
  };
  gemm_tile2s<false, false>(smem, ld >> 6, la, lb, epi);
}

DI void phase_merge(const Prm& p, u16* smem, int l, int& base) {
  TASK_LOOP(t, 8 * 128, base) {
    const int tn = t & 7, tm = t >> 3, n0 = tn * 128, m0 = tm * 128;
    f32x16 macc[2];
    macc[0] = zero16(); macc[1] = zero16();
    merge_branch(p, smem, p.PaT + (size_t)l * 1024 * 768, p.UT, 768, 0, n0, m0, macc);
    merge_branch(p, smem, p.PbT + (size_t)l * 1024 * 128, p.ob, 128, 1, n0, m0, macc);
    merge_branch(p, smem, p.PcT + (size_t)l * 1024 * 384, p.cu, 384, 2, n0, m0, macc);
    merge_branch(p, smem, p.PdT + (size_t)l * 1024 * 256, p.od, 256, 3, n0, m0, macc);
    const int tid2 = tidx(), lane = tid2 & 63, wave = tid2 >> 6, wm = wave >> 2, wn = wave & 3, lr = lane & 31, lh = lane >> 5;
    const int tok = m0 + wn * 32 + lr;
#pragma unroll
    for (int i = 0; i < 2; ++i)
#pragma unroll
      for (int h2 = 0; h2 < 2; ++h2) {
        u32x4 o;
#pragma unroll
        for (int e = 0; e < 4; ++e) o[e] = pack2(macc[i][8 * h2 + 2 * e], macc[i][8 * h2 + 2 * e + 1]);
        *(u32x4*)(p.hbuf + (size_t)tok * 1024 + n0 + wm * 64 + i * 32 + 16 * lh + 8 * h2) = o;
      }
  }
  base += 8 * 128;
}

DI void phase_resid_gemm(const Prm& p, unsigned char* smem_raw, const u16* W, const u16* X, int K, const float* xsrc, float* xdst,
                         const float* modl, int gtoff, int sb, int& base) {
  LAS u16* shm = (LAS u16*)smem_raw;
  bool pre = false;
  TASK_LOOP(t, 4 * 64, base) {
    int tn, tm;
    map256(t, 4, tn, tm);
    const int brow = tn * 256, bcol = tm * 256;
    const int tnx = t + (int)gridDim.x;
    const bool has_next = tnx < (4 * 64);
    int tn2 = 0, tm2 = 0;
    if (has_next) map256(tnx, 4, tn2, tm2);
    const int nbrow = tn2 * 256, nbcol = tm2 * 256;
    auto epi = [&](f32x4 (&acc)[2][2][4][2], int wr, int wc, int fr, int fq) __attribute__((always_inline)) {
#pragma unroll
      for (int bj = 0; bj < 2; ++bj)
#pragma unroll
        for (int n = 0; n < 2; ++n) {
          const int tok = bcol + bj * 128 + wc * 32 + n * 16 + fr;
          const float* gt = modl + condrow(sb, tok) * 6144 + gtoff;
#pragma unroll
          for (int ai = 0; ai < 2; ++ai)
#pragma unroll
            for (int m = 0; m < 4; ++m) {
              const int nn = brow + ai * 128 + wr * 64 + m * 16 + fq * 4;
              const f32x4 v = acc[ai][bj][m][n];
              const float4 g4 = *(const float4*)(gt + nn);
              const float4 xi = *(const float4*)(xsrc + (size_t)tok * 1024 + nn);
              float4 o;
              o.x = xi.x + g4.x * v[0]; o.y = xi.y + g4.y * v[1]; o.z = xi.z + g4.z * v[2]; o.w = xi.w + g4.w * v[3];
              *(float4*)(xdst + (size_t)tok * 1024 + nn) = o;
            }
        }
    };
    gemm256<false>(shm, W, X, K, brow, bcol, pre, has_next, nbrow, nbcol, epi);
    pre = has_next;
  }
  base += 4 * 64;
}

DI void phase_w1(const Prm& p, unsigned char* smem_raw, int l, int& base) {
  const u16* W = p.W1T + (size_t)l * 4096 * 1024;
  LAS u16* shm = (LAS u16*)smem_raw;
  bool pre = false;
  TASK_LOOP(t, 16 * 64, base) {
    int tn, tm;
    map256(t, 16, tn, tm);
    const int brow = tn * 256, bcol = tm * 256;
    const int tnx = t + (int)gridDim.x;
    const bool has_next = tnx < (16 * 64);
    int tn2 = 0, tm2 = 0;
    if (has_next) map256(tnx, 16, tn2, tm2);
    const int nbrow = tn2 * 256, nbcol = tm2 * 256;
    auto epi = [&](f32x4 (&acc)[2][2][4][2], int wr, int wc, int fr, int fq) __attribute__((always_inline)) {
#pragma unroll
      for (int bj = 0; bj < 2; ++bj)
#pragma unroll
        for (int n = 0; n < 2; ++n) {
          const int tok = bcol + bj * 128 + wc * 32 + n * 16 + fr;
#pragma unroll
          for (int ai = 0; ai < 2; ++ai)
#pragma unroll
            for (int mp = 0; mp < 2; ++mp) {
              const int nn = brow + ai * 128 + wr * 64 + mp * 32 + fq * 8;
              const f32x4 v = acc[ai][bj][2 * mp][n], w = acc[ai][bj][2 * mp + 1][n];
              const float a0 = fmaxf(v[0], 0.f), a1 = fmaxf(v[1], 0.f), a2 = fmaxf(v[2], 0.f), a3 = fmaxf(v[3], 0.f);
              const float b0 = fmaxf(w[0], 0.f), b1 = fmaxf(w[1], 0.f), b2 = fmaxf(w[2], 0.f), b3 = fmaxf(w[3], 0.f);
              u32x4 o;
              o[0] = pack2(a0 * a0, a1 * a1); o[1] = pack2(a2 * a2, a3 * a3); o[2] = pack2(b0 * b0, b1 * b1); o[3] = pack2(b2 * b2, b3 * b3);
              *(u32x4*)(p.zg + (size_t)tok * 4096 + nn) = o;
            }
        }
    };
    gemm256<true>(shm, W, p.hbuf, 1024, brow, bcol, pre, has_next, nbrow, nbcol, epi);
    pre = has_next;
  }
  base += 16 * 64;
}

DI void phase_final(const Prm& p) {
  const int tid = tidx(), lane = tid & 63;
  const int gw = blockIdx.x * 8 + (tid >> 6), nw = gridDim.x * 8;
  for (int row = gw; row < 3 * TB; row += nw) {
    float* xr = p.out + (size_t)row * 1024;
    float4 v[4];
    float ss = 0.f;
#pragma unroll
    for (int i = 0; i < 4; ++i) {
      v[i] = *(const float4*)(xr + i * 256 + lane * 4);
      ss += v[i].x * v[i].x + v[i].y * v[i].y + v[i].z * v[i].z + v[i].w * v[i].w;
    }
#pragma unroll
    for (int off = 32; off >= 1; off >>= 1) ss += __shfl_xor(ss, off);
    const float rstd = rsqrtf(ss * (1.f / 1024.f) + 1e-6f);
#pragma unroll
    for (int i = 0; i < 4; ++i) {
      const int col = i * 256 + lane * 4;
      const float4 gg = *(const float4*)(p.final_g + col);
      float4 o;
      o.x = v[i].x * rstd * gg.x; o.y = v[i].y * rstd * gg.y; o.z = v[i].z * rstd * gg.z; o.w = v[i].w * rstd * gg.w;
      *(float4*)(xr + col) = o;
    }
  }
}

__global__ void __launch_bounds__(512) mega(Prm p) {
  cg::grid_group grid = cg::this_grid();
  __shared__ __attribute__((aligned(16))) unsigned char smem_raw[SMEM_BYTES];
  __shared__ uint4 xb_words;
  u16* smem = (u16*)smem_raw;
  if (threadIdx.x == 0) xb_words = make_uint4(0u, 0u, 0u, 0u);
  __syncthreads();
  const XcdBarrier xb = xcd_barrier_post(p.bar, (volatile LAS unsigned*)&xb_words);
  int base = 0;
  prologue_a(p, smem_raw, base);
  if (PROBE == 11) prologue_a(p, smem_raw, base);
  grid.sync();
  prologue_b(p);
  xcd_barrier(xb);
  for (int sb = 0; sb < 3; ++sb) {
    const int S = sb == 0 ? 16384 : 2048, lgS = sb == 0 ? 14 : 11, nseq = sb == 0 ? 1 : 8;
    const int N1 = S >> 7, lgN1 = lgS - 7;
    const float* xin = sb == 0 ? p.x_prompt : p.x_sample + (size_t)(sb - 1) * TB * 1024;
    float* xo = p.out + (size_t)sb * TB * 1024;
    for (int l = 0; l < 4; ++l) {
      const float* xs = l == 0 ? xin : xo;
      const float* modl = p.mod + (size_t)l * 17 * 6144;
      phase_norm(p, xs, p.norm1_g + l * 1024, modl, 0, 1024, sb);
      xcd_barrier(xb);
      phase_inproj(p, smem_raw, l, S, base);
      if (PROBE == 2 || PROBE == 7) phase_inproj(p, smem_raw, l, S, base);
      if (PROBE == 12) phase_inproj_probe(p, smem_raw, l, base);
      xcd_barrier(xb);
      if (PROBE == 5) xcd_barrier(xb);
      if (N1 == 16) phase_fft1_small(p, nseq); else phase_fft1(p, smem, S, nseq, N1, lgN1, base);
      phase_mixb(p, smem_raw, S, lgS, base);
      phase_mixc(p, smem_raw, l, base);
      phase_qup(p, smem_raw, l, S, base);
      phase_kvup(p, smem_raw, l, base);
      phase_inproj_tail(p, smem_raw, l, base);
      if (PROBE == 13) phase_fft1(p, smem, S, nseq, N1, lgN1, base);
      if (PROBE == 14) phase_mixb(p, smem_raw, S, lgS, base);
      if (PROBE == 15) { phase_qup(p, smem_raw, l, S, base); phase_kvup(p, smem_raw, l, base); phase_inproj_tail(p, smem_raw, l, base); }
      if (PROBE == 4) { phase_fft1(p, smem, S, nseq, N1, lgN1, base); phase_mixb(p, smem_raw, S, lgS, base); phase_qup(p, smem_raw, l, S, base); phase_kvup(p, smem_raw, l, base); }
      xcd_barrier(xb);
      if (PROBE == 5) xcd_barrier(xb);
      phase_mla(p, smem_raw, S, lgS, base);
      if (PROBE == 1) phase_mla(p, smem_raw, S, lgS, base);
      phase_fft2(p, smem, S, nseq, N1, base);
      phase_combb(p);
      if (PROBE == 6) { phase_fft2(p, smem, S, nseq, N1, base); phase_combb(p); }
      xcd_barrier(xb);
      if (PROBE == 5) xcd_barrier(xb);
      phase_merge(p, smem, l, base);
      if (PROBE == 3) phase_merge(p, smem, l, base);
      xcd_barrier(xb);
      if (PROBE == 5) xcd_barrier(xb);
      phase_resid_gemm(p, smem_raw, p.WoT + (size_t)l * 1024 * 1024, p.hbuf, 1024, xs, xo, modl, 2048, sb, base);
      xcd_barrier(xb);
      phase_norm(p, xo, p.norm2_g + l * 1024, modl, 3072, 4096, sb);
      if (PROBE == 9) { phase_norm(p, xo, p.norm2_g + l * 1024, modl, 3072, 4096, sb); phase_norm(p, xo, p.norm2_g + l * 1024, modl, 3072, 4096, sb); }
      xcd_barrier(xb);
      phase_w1(p, smem_raw, l, base);
      if (PROBE == 2 || PROBE == 8) phase_w1(p, smem_raw, l, base);
      xcd_barrier(xb);
      if (PROBE == 5) xcd_barrier(xb);
      phase_resid_gemm(p, smem_raw, p.W2T + (size_t)l * 1024 * 4096, p.zg, 4096, xo, xo, modl, 5120, sb, base);
      xcd_barrier(xb);
    }
  }
  phase_final(p);
}

extern "C" void kernel_launch(void* const* d_in, const int* in_sizes, int n_in, void* d_out, int out_size, void* d_ws, size_t ws_size,
                              hipStream_t stream) {
  Prm p{};
  const float* const* in = (const float* const*)d_in;
  p.x_prompt = in[0]; p.x_sample = in[1]; p.c_prompt = in[2]; p.c_sample = in[3]; p.rel_bias = in[4]; p.ada_w = in[5]; p.ada_b = in[6];
  p.norm1_g = in[7]; p.w_in = in[8]; p.qn_g = in[9]; p.kvn_g = in[10]; p.w_uq = in[11]; p.w_ukv = in[12]; p.ln_g = in[13]; p.ln_b = in[14];
  p.sgu_w = in[15]; p.sgu_b = in[16]; p.p_a = in[17]; p.p_b = in[18]; p.p_c = in[19]; p.p_d = in[20]; p.w_o = in[21]; p.norm2_g = in[22];
  p.w1 = in[23]; p.w2 = in[24]; p.final_g = in[25];
  p.out = (float*)d_out;
  char* w = (char*)d_ws;
  size_t off = 0;
  auto take = [&](size_t bytes) __attribute__((always_inline)) { void* r = w + off; off += (bytes + 255) & ~(size_t)255; return r; };
  p.WinT = (u16*)take((size_t)4 * NWP * 1024 * 2);
  p.W1T = (u16*)take((size_t)4 * 4096 * 1024 * 2);
  p.W2T = (u16*)take((size_t)4 * 4096 * 1024 * 2);
  p.WoT = (u16*)take((size_t)4 * 1024 * 1024 * 2);
  p.PaT = (u16*)take((size_t)4 * 1024 * 768 * 2);
  p.PbT = (u16*)take((size_t)4 * 1024 * 128 * 2);
  p.PcT = (u16*)take((size_t)4 * 1024 * 384 * 2);
  p.PdT = (u16*)take((size_t)4 * 1024 * 256 * 2);
  p.WqT = (u16*)take((size_t)4 * 384 * 384 * 2);
  p.WkvT = (u16*)take((size_t)4 * 512 * 320 * 2);
  p.SgW = (u16*)take((size_t)4 * 4 * 128 * 128 * 2);
  p.M1a = (u16*)take(256 * 256 * 2);
  p.M1b = (u16*)take(32 * 64 * 2);
  p.M2 = (u16*)take(128 * 256 * 2);
  p.tw = (float2*)take(16384 * 8);
  p.rope = (float2*)take((size_t)16384 * 16 * 8);
  p.biasT = (float*)take(6 * 129 * 4);
  p.mod = (float*)take((size_t)4 * 17 * 6144 * 4);
  p.hbuf = (u16*)take((size_t)TB * 1024 * 2);
  p.og = (float*)take((size_t)TB * 384 * 4);
  p.UT = (u16*)take((size_t)1536 * TBP * 2);
  p.Gp = (u16*)take((size_t)1536 * TB * 2);
  p.bqkv = (u16*)take((size_t)TB * 1152 * 2);
  p.ob = (u16*)take((size_t)TB * 128 * 2);
  p.cu = (u16*)take((size_t)TB * 384 * 2);
  p.cvT = (u16*)take((size_t)TBP * 384 * 2);
  p.dcq = (u16*)take((size_t)TB * 384 * 2);
  p.dckv = (u16*)take((size_t)TB * 320 * 2);
  p.qc = (u16*)take((size_t)TB * 384 * 2);
  p.kc = (u16*)take((size_t)TB * 384 * 2);
  p.vT = (u16*)take((size_t)TBP * 256 * 2);
  p.od = (u16*)take((size_t)TB * 256 * 2);
  p.lse = (float*)take((size_t)TB * 6 * 4);
  p.zg = (u16*)take((size_t)TB * 4096 * 2);
  p.bar = (unsigned*)take(XCD_BAR_WORDS * 4);
  p.modpart = (float*)p.zg;
  if (off > ws_size) { fprintf(stderr, "workspace too small: need %zu have %zu\n", off, ws_size); return; }
  static int grid_blocks = 0;
  if (!grid_blocks) {
    int dev = 0, cus = 0, per_cu = 0;
    (void)hipGetDevice(&dev);
    (void)hipDeviceGetAttribute(&cus, hipDeviceAttributeMultiprocessorCount, dev);
    (void)hipOccupancyMaxActiveBlocksPerMultiprocessor(&per_cu, mega, NTH, 0);
    if (per_cu < 1) per_cu = 1;
    if (per_cu > 1) per_cu = 1;
    grid_blocks = cus * per_cu;
  }
  (void)hipMemsetAsync(p.bar, 0, XCD_BAR_WORDS * 4, stream);
  void* args[] = {&p};
  hipError_t e = hipLaunchCooperativeKernel((void*)mega, dim3(grid_blocks), dim3(NTH), args, 0, stream);
  if (e != hipSuccess) fprintf(stderr, "cooperative launch failed: %s (grid %d)\n", hipGetErrorString(e), grid_blocks);
}
```
